# Optimizing an MI355X kernel written in HIP

```python
import jax, jax.numpy as jnp
from jax import lax
import numpy as np

D_MODEL = 1024
BATCH = 4
SEQ = 8192
DEPTH = 4

HEAD_DIM = 64
Q_BLOCK = 128
ROPE_THETA = 10000.0
EPS = 1e-6
NSA_HEADS = 8
NSA_KV_GROUPS = 2
NSA_CMP_LEN = 32
NSA_CMP_STRIDE = 16
NSA_CMP_HIDDEN = 128
NSA_SEL_LEN = 64
NSA_SEL_TOPK = 16
NSA_WINDOW = 512
FORCE_SCORE = 1e9
NSA_WIDTH = NSA_HEADS * HEAD_DIM
NSA_KV_WIDTH = NSA_KV_GROUPS * HEAD_DIM
FOX_HEADS = 8
FOX_WIDTH = FOX_HEADS * HEAD_DIM
MEM_LEN = 256
MEM_HEADS = 4
MEM_HEAD_DIM = 128
MEM_WIDTH = MEM_HEADS * MEM_HEAD_DIM
N_BRANCH = 3
IN_SPLITS = (NSA_WIDTH, 6 * NSA_KV_WIDTH, 3 * NSA_HEADS, NSA_WIDTH,
             3 * FOX_WIDTH, FOX_HEADS, FOX_WIDTH,
             MEM_WIDTH, MEM_WIDTH,
             N_BRANCH * D_MODEL)
IN_WIDTH = sum(IN_SPLITS)

kernel_name = 'hybrid_nsa_fox_memory_block'


def _rmsnorm(x, g):
    xf = x.astype(jnp.float32)
    y = xf * lax.rsqrt(jnp.mean(xf * xf, axis=-1, keepdims=True) + EPS)
    return (y * g.astype(jnp.float32)).astype(x.dtype)


def _rope(x, pos):
    half = x.shape[-1] // 2
    inv_freq = ROPE_THETA ** (-jnp.arange(half, dtype=jnp.float32) / half)
    ang = pos.astype(jnp.float32)[:, None] * inv_freq[None, :]
    cos = jnp.cos(ang)[None, :, None, :]
    sin = jnp.sin(ang)[None, :, None, :]
    xf = x.astype(jnp.float32)
    x1, x2 = xf[..., :half], xf[..., half:]
    return jnp.concatenate([x1 * cos - x2 * sin, x2 * cos + x1 * sin], axis=-1).astype(x.dtype)


def _masked_softmax(s, mask):
    s = jnp.where(mask, s.astype(jnp.float32), -jnp.inf)
    m = jnp.max(s, axis=-1, keepdims=True)
    m = jnp.where(jnp.isfinite(m), m, 0.0)
    e = jnp.exp(s - m)
    d = jnp.sum(e, axis=-1, keepdims=True)
    return e / jnp.where(d > 0.0, d, 1.0)


def _split(z, sizes):
    return jnp.split(z, np.cumsum(sizes)[:-1].tolist(), axis=-1)


def _compress(x, pe, w1, w2):
    B, T, G, dk = x.shape
    r = NSA_CMP_LEN // NSA_CMP_STRIDE
    n_chunk = T // NSA_CMP_STRIDE
    n_cmp = n_chunk - r + 1
    ch = x.reshape(B, n_chunk, NSA_CMP_STRIDE, G, dk)
    blk = jnp.concatenate([ch[:, i:i + n_cmp] for i in range(r)], axis=2)
    blk = blk + pe[None, None, :, None, :].astype(x.dtype)
    flat = blk.transpose(0, 1, 3, 2, 4).reshape(B, n_cmp, G, NSA_CMP_LEN * dk)
    return jax.nn.silu(flat @ w1) @ w2


def _overlap(n_cmp, n_slc):
    cs = np.arange(n_cmp)[:, None] * NSA_CMP_STRIDE
    ss = np.arange(n_slc)[None, :] * NSA_SEL_LEN
    ov = np.clip(np.minimum(cs + NSA_CMP_LEN, ss + NSA_SEL_LEN) - np.maximum(cs, ss), 0, None)
    return jnp.asarray(ov / NSA_CMP_LEN, dtype=jnp.float32)


def _nsa(q, kv, gate, pe_k, w1_k, w2_k, pe_v, w1_v, w2_v, q_g, k_g):
    B, T, _ = q.shape
    G, R, dk = NSA_KV_GROUPS, NSA_HEADS // NSA_KV_GROUPS, HEAD_DIM
    pos = jnp.arange(T)
    nqb = T // Q_BLOCK
    n_slc = T // NSA_SEL_LEN
    n_top = min(NSA_SEL_TOPK, n_slc)
    scale = dk ** -0.5
    qh = _rope(_rmsnorm(q.reshape(B, T, NSA_HEADS, dk), q_g), pos)
    k_c, v_c, k_s, v_s, k_w, v_w = [a.reshape(B, T, G, dk) for a in jnp.split(kv, 6, axis=-1)]
    k_c = _rmsnorm(_compress(_rope(k_c, pos), pe_k, w1_k, w2_k), k_g[0])
    v_c = _compress(v_c, pe_v, w1_v, w2_v)
    n_cmp = k_c.shape[1]
    k_s = _rope(_rmsnorm(k_s, k_g[1]), pos)
    k_w = _rope(_rmsnorm(k_w, k_g[2]), pos)
    ov = _overlap(n_cmp, n_slc)
    ks_blk = k_s.reshape(B, n_slc, NSA_SEL_LEN, G, dk).transpose(0, 3, 1, 2, 4)
    vs_blk = v_s.reshape(B, n_slc, NSA_SEL_LEN, G, dk).transpose(0, 3, 1, 2, 4)
    kw_pad = jnp.pad(k_w, ((0, 0), (NSA_WINDOW, 0), (0, 0), (0, 0)))
    vw_pad = jnp.pad(v_w, ((0, 0), (NSA_WINDOW, 0), (0, 0), (0, 0)))
    gather = jax.vmap(jax.vmap(lambda blocks, ix: blocks[ix]))
    cmp_end = jnp.arange(n_cmp) * NSA_CMP_STRIDE + NSA_CMP_LEN - 1
    jblk = jnp.arange(n_slc)
    qblocks = qh.reshape(B, nqb, Q_BLOCK, G, R, dk).transpose(1, 0, 2, 3, 4, 5)

    def block(args):
        qb, i = args
        t = i * Q_BLOCK + jnp.arange(Q_BLOCK)
        s = jnp.einsum('bqgrd,bngd->bgrqn', qb, k_c) * scale
        p_c = _masked_softmax(s, cmp_end[None, :] <= t[:, None])
        o_c = jnp.einsum('bgrqn,bngd->bqgrd', p_c.astype(v_c.dtype), v_c)
        imp = jnp.einsum('bgrqn,nj->bgqj', p_c, ov)
        cur = t // NSA_SEL_LEN
        forced = (jblk[None] == 0) | (jblk[None] == cur[:, None]) | (jblk[None] == cur[:, None] - 1)
        score = jnp.where(forced, FORCE_SCORE, imp)
        score = jnp.where(jblk[None] <= cur[:, None], score, -jnp.inf)
        _, idx = lax.top_k(score, n_top)
        sel_ok = idx <= cur[None, None, :, None]
        kg = gather(ks_blk, idx)
        vg = gather(vs_blk, idx)
        s = jnp.einsum('bqgrd,bgqnkd->bgrqnk', qb, kg) * scale
        kpos = idx[..., None] * NSA_SEL_LEN + jnp.arange(NSA_SEL_LEN)
        smask = sel_ok[..., None] & (kpos <= t[None, None, :, None, None])
        m_sel = n_top * NSA_SEL_LEN
        p_s = _masked_softmax(s.reshape(B, G, R, Q_BLOCK, m_sel),
                              smask[:, :, None].reshape(B, G, 1, Q_BLOCK, m_sel))
        o_s = jnp.einsum('bgrqm,bgqmd->bqgrd', p_s.astype(vg.dtype), vg.reshape(B, G, Q_BLOCK, m_sel, dk))
        kw = lax.dynamic_slice_in_dim(kw_pad, i * Q_BLOCK, Q_BLOCK + NSA_WINDOW, axis=1)
        vw = lax.dynamic_slice_in_dim(vw_pad, i * Q_BLOCK, Q_BLOCK + NSA_WINDOW, axis=1)
        spos = i * Q_BLOCK - NSA_WINDOW + jnp.arange(Q_BLOCK + NSA_WINDOW)
        diff = t[:, None] - spos[None, :]
        wmask = (diff >= 0) & (diff < NSA_WINDOW) & (spos[None, :] >= 0)
        s = jnp.einsum('bqgrd,bkgd->bgrqk', qb, kw) * scale
        p_w = _masked_softmax(s, wmask)
        o_w = jnp.einsum('bgrqk,bkgd->bqgrd', p_w.astype(vw.dtype), vw)
        return o_c, o_s, o_w

    o_c, o_s, o_w = lax.map(block, (qblocks, jnp.arange(nqb)))
    to_bthd = lambda o: o.transpose(1, 0, 2, 3, 4, 5).reshape(B, T, NSA_HEADS, dk)
    g = jax.nn.sigmoid(gate.astype(jnp.float32)).reshape(B, T, NSA_HEADS, 3, 1).astype(q.dtype)
    o = g[..., 0, :] * to_bthd(o_c) + g[..., 1, :] * to_bthd(o_s) + g[..., 2, :] * to_bthd(o_w)
    return o.reshape(B, T, NSA_WIDTH)


def _fox(qkv, f_logit, q_g, k_g, f_bias):
    B, T, _ = qkv.shape
    H, dk = FOX_HEADS, HEAD_DIM
    nqb = T // Q_BLOCK
    scale = dk ** -0.5
    q, k, v = [a.reshape(B, T, H, dk) for a in jnp.split(qkv, 3, axis=-1)]
    q = _rmsnorm(q, q_g)
    k = _rmsnorm(k, k_g)
    log_f = jax.nn.log_sigmoid(f_logit.astype(jnp.float32) + f_bias.astype(jnp.float32))
    c = jnp.cumsum(log_f, axis=1).transpose(0, 2, 1)
    qblocks = q.reshape(B, nqb, Q_BLOCK, H, dk).transpose(1, 0, 2, 3, 4)
    cblocks = c.reshape(B, H, nqb, Q_BLOCK).transpose(2, 0, 1, 3)
    kpos = jnp.arange(T)

    def block(args):
        qb, cq, i = args
        t = i * Q_BLOCK + jnp.arange(Q_BLOCK)
        s = jnp.einsum('bqhd,bkhd->bhqk', qb, k).astype(jnp.float32) * scale
        s = s + cq[..., None] - c[:, :, None, :]
        p = _masked_softmax(s, kpos[None, :] <= t[:, None])
        return jnp.einsum('bhqk,bkhd->bqhd', p.astype(v.dtype), v)

    o = lax.map(block, (qblocks, cblocks, jnp.arange(nqb)))
    return o.transpose(1, 0, 2, 3, 4).reshape(B, T, FOX_WIDTH)


def _memory_xattn(q, mem_kv, q_g, k_g):
    B, T, _ = q.shape
    M = mem_kv.shape[1]
    q = _rmsnorm(q.reshape(B, T, MEM_HEADS, MEM_HEAD_DIM), q_g)
    k, v = [a.reshape(B, M, MEM_HEADS, MEM_HEAD_DIM) for a in jnp.split(mem_kv, 2, axis=-1)]
    k = _rmsnorm(k, k_g)
    s = jnp.einsum('bthd,bmhd->bhtm', q, k).astype(jnp.float32) * (MEM_HEAD_DIM ** -0.5)
    p = jax.nn.softmax(s, axis=-1)
    return jnp.einsum('bhtm,bmhd->bthd', p.astype(v.dtype), v).reshape(B, T, MEM_WIDTH)


def setup_inputs(seed: int = 0) -> dict:
    key = jax.random.key(seed)
    ks = jax.random.split(key, 24)
    f32 = jnp.float32
    L = DEPTH

    def nrm(k, shape, scale):
        return jax.random.normal(k, shape, f32) * scale

    def gain(k, shape):
        return 1.0 + 0.05 * jax.random.normal(k, shape, f32)

    cmp_in = NSA_CMP_LEN * HEAD_DIM
    return {
        'x': nrm(ks[0], (BATCH, SEQ, D_MODEL), 1.0),
        'mem': nrm(ks[1], (BATCH, MEM_LEN, D_MODEL), 1.0),
        'norm_g': gain(ks[2], (L, D_MODEL)),
        'mem_norm_g': gain(ks[3], (L, D_MODEL)),
        'w_in': nrm(ks[4], (L, D_MODEL, IN_WIDTH), D_MODEL ** -0.5),
        'nsa_q_norm': gain(ks[5], (L, HEAD_DIM)),
        'nsa_k_norm': gain(ks[6], (L, 3, HEAD_DIM)),
        'cmp_pe_k': nrm(ks[7], (L, NSA_CMP_LEN, HEAD_DIM), 0.1),
        'cmp_w1_k': nrm(ks[8], (L, cmp_in, NSA_CMP_HIDDEN), cmp_in ** -0.5),
        'cmp_w2_k': nrm(ks[9], (L, NSA_CMP_HIDDEN, HEAD_DIM), NSA_CMP_HIDDEN ** -0.5),
        'cmp_pe_v': nrm(ks[10], (L, NSA_CMP_LEN, HEAD_DIM), 0.1),
        'cmp_w1_v': nrm(ks[11], (L, cmp_in, NSA_CMP_HIDDEN), cmp_in ** -0.5),
        'cmp_w2_v': nrm(ks[12], (L, NSA_CMP_HIDDEN, HEAD_DIM), NSA_CMP_HIDDEN ** -0.5),
        'fox_q_norm': gain(ks[13], (L, HEAD_DIM)),
        'fox_k_norm': gain(ks[14], (L, HEAD_DIM)),
        'fox_f_bias': jax.random.uniform(ks[15], (L, FOX_HEADS), f32, 1.0, 4.0),
        'mem_q_norm': gain(ks[16], (L, MEM_HEAD_DIM)),
        'mem_k_norm': gain(ks[17], (L, MEM_HEAD_DIM)),
        'w_mem_kv': nrm(ks[18], (L, D_MODEL, 2 * MEM_WIDTH), D_MODEL ** -0.5),
        'w_branch_a': nrm(ks[19], (L, NSA_WIDTH, D_MODEL), NSA_WIDTH ** -0.5),
        'w_branch_b': nrm(ks[20], (L, FOX_WIDTH, D_MODEL), FOX_WIDTH ** -0.5),
        'w_branch_m': nrm(ks[21], (L, MEM_WIDTH, D_MODEL), MEM_WIDTH ** -0.5),
        'w_out': nrm(ks[22], (L, D_MODEL, D_MODEL), D_MODEL ** -0.5),
    }


def reference(x, mem, norm_g, mem_norm_g, w_in, nsa_q_norm, nsa_k_norm,
              cmp_pe_k, cmp_w1_k, cmp_w2_k, cmp_pe_v, cmp_w1_v, cmp_w2_v,
              fox_q_norm, fox_k_norm, fox_f_bias, mem_q_norm, mem_k_norm, w_mem_kv,
              w_branch_a, w_branch_b, w_branch_m, w_out):
    B, T, D = x.shape
    for l in range(DEPTH):
        h = _rmsnorm(x, norm_g[l])
        z = h @ w_in[l]
        (nsa_q, nsa_kv, nsa_gate, nsa_silu, fox_qkv, fox_f, fox_silu,
         mem_q, mem_silu, merge_g) = _split(z, IN_SPLITS)
        o_a = _nsa(nsa_q, nsa_kv, nsa_gate, cmp_pe_k[l], cmp_w1_k[l], cmp_w2_k[l],
                   cmp_pe_v[l], cmp_w1_v[l], cmp_w2_v[l], nsa_q_norm[l], nsa_k_norm[l])
        o_a = o_a * jax.nn.silu(nsa_silu)
        o_b = _fox(fox_qkv, fox_f, fox_q_norm[l], fox_k_norm[l], fox_f_bias[l]) * jax.nn.silu(fox_silu)
        mem_kv = _rmsnorm(mem, mem_norm_g[l]) @ w_mem_kv[l]
        o_m = _memory_xattn(mem_q, mem_kv, mem_q_norm[l], mem_k_norm[l]) * jax.nn.silu(mem_silu)
        g = jax.nn.sigmoid(merge_g.astype(jnp.float32)).reshape(B, T, N_BRANCH, D).astype(x.dtype)
        u = (g[:, :, 0] * (o_a @ w_branch_a[l])
             + g[:, :, 1] * (o_b @ w_branch_b[l])
             + g[:, :, 2] * (o_m @ w_branch_m[l]))
        x = x + u @ w_out[l]
    return x
```

```cpp
#include <hip/hip_runtime.h>
#include <hip/hip_cooperative_groups.h>
#include <stdint.h>
#include <cstdio>
namespace cg = cooperative_groups;

typedef unsigned short bf16_t;
typedef short bf16x8 __attribute__((ext_vector_type(8)));
typedef float f32x4 __attribute__((ext_vector_type(4)));
typedef unsigned u32x2 __attribute__((ext_vector_type(2)));
typedef unsigned u32x4 __attribute__((ext_vector_type(4)));
typedef float f32x2_t __attribute__((ext_vector_type(2)));
typedef __bf16 bf16x2_t __attribute__((ext_vector_type(2)));

constexpr int NB = 4, T = 8192, M = NB * T;
constexpr int NTHREADS = 256, NWAVES = NTHREADS / 64;
constexpr float EPS = 1e-6f;
constexpr float LOG2E = 1.4426950408889634f;
#define NEG_INF (-__builtin_inff())

constexpr size_t MiB = 1u << 20;
constexpr size_t OFF_CTL = 0;
constexpr size_t OFF_ROPE = 1 * MiB;
constexpr size_t OFF_W_IN = 3 * MiB;
constexpr size_t OFF_W_G = 13 * MiB;
constexpr size_t OFF_W_MKV = 19 * MiB;
constexpr size_t OFF_W_BR = 21 * MiB;
constexpr size_t OFF_W_OUT = 24 * MiB;
constexpr size_t OFF_W1 = 26 * MiB;
constexpr size_t OFF_W2 = 27 * MiB;
constexpr size_t OFF_C1 = 27 * MiB + 256 * 1024;
constexpr size_t OFF_MEMN = 28 * MiB;
constexpr size_t OFF_MK = 30 * MiB;
constexpr size_t OFF_MVT = 31 * MiB;
constexpr size_t OFF_H = 32 * MiB;
constexpr size_t OFF_QN = 96 * MiB;
constexpr size_t OFF_KC = 128 * MiB;
constexpr size_t OFF_VC = 136 * MiB;
constexpr size_t OFF_KS = 144 * MiB;
constexpr size_t OFF_VST = 152 * MiB;
constexpr size_t OFF_KW = 160 * MiB;
constexpr size_t OFF_VWT = 168 * MiB;
constexpr size_t OFF_OA = 176 * MiB;
constexpr size_t OFF_FQ = 208 * MiB;
constexpr size_t OFF_FK = 240 * MiB;
constexpr size_t OFF_FVT = 272 * MiB;
constexpr size_t OFF_OB = 304 * MiB;
constexpr size_t OFF_MQ = 336 * MiB;
constexpr size_t OFF_OM = 368 * MiB;
constexpr size_t OFF_GATE = 400 * MiB;
constexpr size_t OFF_FLOG = 403 * MiB;
constexpr size_t OFF_FC = 404 * MiB;
constexpr size_t OFF_KCMP = 405 * MiB;
constexpr size_t OFF_VCT = 405 * MiB + 512 * 1024;
constexpr size_t OFF_SCR = 406 * MiB;
constexpr size_t OFF_U = OFF_FQ;

struct Params {
  const float *x, *mem, *norm_g, *mem_norm_g, *w_in, *nsa_q_norm, *nsa_k_norm, *cmp_pe_k, *cmp_w1_k, *cmp_w2_k,
      *cmp_pe_v, *cmp_w1_v, *cmp_w2_v, *fox_q_norm, *fox_k_norm, *fox_f_bias, *mem_q_norm, *mem_k_norm, *w_mem_kv,
      *w_branch_a, *w_branch_b, *w_branch_m, *w_out;
  float* out;
  char* ws;
};
#define WSP(TYPE, off) ((TYPE*)(p.ws + (off)))

__constant__ float c_inv_freq[32] = {
    1.000000000e+00f, 7.498942018e-01f, 5.623413324e-01f, 4.216965139e-01f, 3.162277639e-01f, 2.371373773e-01f,
    1.778279394e-01f, 1.333521456e-01f, 1.000000015e-01f, 7.498942316e-02f, 5.623413250e-02f, 4.216964915e-02f,
    3.162277490e-02f, 2.371373773e-02f, 1.778279431e-02f, 1.333521400e-02f, 9.999999776e-03f, 7.498942316e-03f,
    5.623413250e-03f, 4.216964822e-03f, 3.162277630e-03f, 2.371373819e-03f, 1.778279431e-03f, 1.333521446e-03f,
    1.000000047e-03f, 7.498941850e-04f, 5.623413017e-04f, 4.216965172e-04f, 3.162277571e-04f, 2.371373703e-04f,
    1.778279402e-04f, 1.333521504e-04f};

__device__ __forceinline__ int tidx() { int t = threadIdx.x; asm volatile("" : "+v"(t)); return t; }
__device__ __forceinline__ unsigned cvtpk(float lo, float hi) {
  f32x2_t v = {lo, hi};
  bf16x2_t b = __builtin_convertvector(v, bf16x2_t);
  return __builtin_bit_cast(unsigned, b);
}
__device__ __forceinline__ float bf2f(unsigned short v) { return __uint_as_float(((unsigned)v) << 16); }
__device__ __forceinline__ float bflo(unsigned w) { return __uint_as_float(w << 16); }
__device__ __forceinline__ float bfhi(unsigned w) { return __uint_as_float(w & 0xffff0000u); }
__device__ __forceinline__ f32x4 mfma16(bf16x8 a, bf16x8 b, f32x4 c) {
  return __builtin_amdgcn_mfma_f32_16x16x32_bf16(a, b, c, 0, 0, 0);
}
__device__ __forceinline__ bf16x8 pack8(f32x4 a, f32x4 b) {
  u32x4 w = {cvtpk(a[0], a[1]), cvtpk(a[2], a[3]), cvtpk(b[0], b[1]), cvtpk(b[2], b[3])};
  return __builtin_bit_cast(bf16x8, w);
}
__device__ __forceinline__ float sigmoidf_(float v) { return 1.0f / (1.0f + __expf(-v)); }
__device__ __forceinline__ float siluf_(float v) { return v / (1.0f + __expf(-v)); }
__device__ __forceinline__ float wave_sum(float v) {
#pragma unroll
  for (int o = 1; o < 64; o <<= 1) v += __shfl_xor(v, o);
  return v;
}

template <bool SWAP>
__device__ __forceinline__ void wave_gemm(const bf16_t* __restrict__ A, int lda, const bf16_t* __restrict__ Bt,
                                          int ldb, int K, f32x4 (&acc)[4][4], int lane) {
  const int r = lane & 15, g = lane >> 4;
  const bf16_t* ap = A + (size_t)r * lda + g * 8;
  const bf16_t* bp = Bt + (size_t)r * ldb + g * 8;
#pragma unroll 2
  for (int k0 = 0; k0 < K; k0 += 32) {
    bf16x8 af[4], bf[4];
#pragma unroll
    for (int mt = 0; mt < 4; ++mt) af[mt] = *(const bf16x8*)(ap + (size_t)mt * 16 * lda + k0);
#pragma unroll
    for (int nt = 0; nt < 4; ++nt) bf[nt] = *(const bf16x8*)(bp + (size_t)nt * 16 * ldb + k0);
#pragma unroll
    for (int mt = 0; mt < 4; ++mt)
#pragma unroll
      for (int nt = 0; nt < 4; ++nt)
        acc[mt][nt] = SWAP ? mfma16(bf[nt], af[mt], acc[mt][nt]) : mfma16(af[mt], bf[nt], acc[mt][nt]);
  }
}
__device__ __forceinline__ void zero_acc(f32x4 (&acc)[4][4]) {
#pragma unroll
  for (int a = 0; a < 4; ++a)
#pragma unroll
    for (int b = 0; b < 4; ++b) acc[a][b] = (f32x4){0.f, 0.f, 0.f, 0.f};
}

__device__ __forceinline__ void epi_rowmajor(f32x4 (&acc)[4][4], int row0, bf16_t* dst, int ld, int col0,
                                             const float* gain, bool rope, bool silu, const float* ropetab, int lane) {
  const int r = lane & 15, g = lane >> 4;
  if (gain) {
    f32x4 gv[4];
#pragma unroll
    for (int nt = 0; nt < 4; ++nt) gv[nt] = *(const f32x4*)(gain + 16 * nt + 4 * g);
#pragma unroll
    for (int mt = 0; mt < 4; ++mt) {
      float ss = 0.f;
#pragma unroll
      for (int nt = 0; nt < 4; ++nt)
#pragma unroll
        for (int i = 0; i < 4; ++i) ss += acc[mt][nt][i] * acc[mt][nt][i];
      ss += __shfl_xor(ss, 16);
      ss += __shfl_xor(ss, 32);
      const float rstd = rsqrtf(ss * (1.0f / 64.0f) + EPS);
#pragma unroll
      for (int nt = 0; nt < 4; ++nt) acc[mt][nt] = acc[mt][nt] * rstd * gv[nt];
    }
  }
  if (rope) {
#pragma unroll
    for (int mt = 0; mt < 4; ++mt) {
      const int pos = (row0 + 16 * mt + r) & (T - 1);
#pragma unroll
      for (int nt = 0; nt < 2; ++nt) {
        const f32x4* tp = (const f32x4*)(ropetab + ((size_t)pos * 32 + 16 * nt + 4 * g) * 2);
        const f32x4 t0 = tp[0], t1 = tp[1];
        const float cs[4] = {t0[0], t0[2], t1[0], t1[2]}, sn[4] = {t0[1], t0[3], t1[1], t1[3]};
#pragma unroll
        for (int i = 0; i < 4; ++i) {
          const float y1 = acc[mt][nt][i], y2 = acc[mt][nt + 2][i];
          acc[mt][nt][i] = y1 * cs[i] - y2 * sn[i];
          acc[mt][nt + 2][i] = y2 * cs[i] + y1 * sn[i];
        }
      }
    }
  }
#pragma unroll
  for (int mt = 0; mt < 4; ++mt)
#pragma unroll
    for (int nt = 0; nt < 4; ++nt) {
      f32x4 v = acc[mt][nt];
      if (silu) {
#pragma unroll
        for (int i = 0; i < 4; ++i) v[i] = siluf_(v[i]);
      }
      u32x2 w = {cvtpk(v[0], v[1]), cvtpk(v[2], v[3])};
      *(u32x2*)(dst + (size_t)(row0 + 16 * mt + r) * ld + col0 + 16 * nt + 4 * g) = w;
    }
}
__device__ __forceinline__ void epi_transposed(const f32x4 (&acc)[4][4], bf16_t* dst, size_t ldt, int tok0, int lane) {
  const int r = lane & 15, g = lane >> 4;
#pragma unroll
  for (int mt = 0; mt < 4; ++mt)
#pragma unroll
    for (int nt = 0; nt < 4; ++nt) {
      const f32x4 v = acc[mt][nt];
      u32x2 w = {cvtpk(v[0], v[1]), cvtpk(v[2], v[3])};
      *(u32x2*)(dst + (size_t)(16 * nt + r) * ldt + tok0 + 16 * mt + 4 * g) = w;
    }
}

__device__ __forceinline__ int map_in(int n) {
  const int i = n >> 6, c = n & 63;
  if (i < 20) return n;
  if (i < 28) return 1304 + (n - 1280);
  if (i < 52) return 1816 + (n - 1792);
  if (i < 60) return 3360 + (n - 3328);
  if (i < 68) return 3872 + (n - 3840);
  if (i < 76) return 4384 + (n - 4352);
  if (i == 76) return c < 24 ? 1280 + c : (c < 32 ? 3352 + (c - 24) : -1);
  return -1;
}
__device__ void transpose_tile(const float* __restrict__ src, int ld_src, int k0, int n0, bf16_t* __restrict__ dst,
                               int Kdim, int maptype, int srccol0, float* tile) {
  const int tid = tidx();
  for (int e = tid; e < 4096; e += NTHREADS) {
    const int kk = e >> 6, nn = e & 63;
    const int sc = maptype ? map_in(n0 + nn) : srccol0 + n0 + nn;
    tile[kk * 65 + nn] = sc >= 0 ? src[(size_t)(k0 + kk) * ld_src + sc] : 0.f;
  }
  __syncthreads();
  for (int e = tid; e < 2048; e += NTHREADS) {
    const int nn = e >> 5, kp = e & 31;
    const float a = tile[(2 * kp) * 65 + nn], b = tile[(2 * kp + 1) * 65 + nn];
    *(unsigned*)(dst + (size_t)(n0 + nn) * Kdim + k0 + 2 * kp) = cvtpk(a, b);
  }
  __syncthreads();
}
__device__ void rmsnorm_rows(const float* __restrict__ x, const float* __restrict__ gain, bf16_t* __restrict__ dst,
                             int row_begin, int nrows) {
  const int wave = tidx() >> 6, lane = tidx() & 63;
  for (int rr = wave; rr < nrows; rr += NWAVES) {
    const size_t row = (size_t)row_begin + rr;
    const float* xp = x + row * 1024;
    f32x4 v[4];
    float ss = 0.f;
#pragma unroll
    for (int i = 0; i < 4; ++i) {
      v[i] = *(const f32x4*)(xp + lane * 4 + 256 * i);
      ss += v[i][0] * v[i][0] + v[i][1] * v[i][1] + v[i][2] * v[i][2] + v[i][3] * v[i][3];
    }
    ss = wave_sum(ss);
    const float rstd = rsqrtf(ss * (1.0f / 1024.0f) + EPS);
#pragma unroll
    for (int i = 0; i < 4; ++i) {
      const f32x4 gv = *(const f32x4*)(gain + lane * 4 + 256 * i);
      const f32x4 y = v[i] * rstd * gv;
      u32x2 w = {cvtpk(y[0], y[1]), cvtpk(y[2], y[3])};
      *(u32x2*)(dst + row * 1024 + lane * 4 + 256 * i) = w;
    }
  }
}
__device__ void phase_prep(const Params& p, int l, float* smem) {
  const int tid = tidx();
  constexpr int NT_TR = 3044, NT_H = 512, NT_MEMN = 16, NT_C1 = 2, NT_ROPE = 512;
  const int total = NT_TR + NT_H + NT_MEMN + NT_C1 + (l == 0 ? NT_ROPE : 0);
  if (l == 0 && blockIdx.x == 0 && tid < 64) WSP(unsigned, OFF_CTL)[tid] = 0u;
  const float* xin = (l == 0) ? p.x : p.out;
  for (int u0 = blockIdx.x; u0 < total; u0 += gridDim.x) {
    int u = u0;
    if (u < NT_TR) {
      const float* src; int ld, kt, nt, Kd, mt = 0, c0 = 0; bf16_t* dst;
      if (u < 1248) { kt = u / 78; nt = u % 78; src = p.w_in + (size_t)l * 1024 * 7968; ld = 7968; Kd = 1024; dst = WSP(bf16_t, OFF_W_IN); mt = 1; }
      else if ((u -= 1248) < 768) { kt = u / 48; nt = u % 48; src = p.w_in + (size_t)l * 1024 * 7968; ld = 7968; Kd = 1024; dst = WSP(bf16_t, OFF_W_G); c0 = 4896; }
      else if ((u -= 768) < 256) { kt = u / 16; nt = u % 16; src = p.w_mem_kv + (size_t)l * 1024 * 1024; ld = 1024; Kd = 1024; dst = WSP(bf16_t, OFF_W_MKV); }
      else if ((u -= 256) < 384) { const int br = u / 128, uu = u % 128; kt = uu / 16; nt = uu % 16;
        src = (br == 0 ? p.w_branch_a : br == 1 ? p.w_branch_b : p.w_branch_m) + (size_t)l * 512 * 1024; ld = 1024; Kd = 512; dst = WSP(bf16_t, OFF_W_BR + (size_t)br * MiB); }
      else if ((u -= 384) < 256) { kt = u / 16; nt = u % 16; src = p.w_out + (size_t)l * 1024 * 1024; ld = 1024; Kd = 1024; dst = WSP(bf16_t, OFF_W_OUT); }
      else if ((u -= 256) < 128) { const int kv = u / 64, uu = u % 64; kt = uu / 2; nt = uu % 2;
        src = (kv ? p.cmp_w1_v : p.cmp_w1_k) + (size_t)l * 2048 * 128; ld = 128; Kd = 2048; dst = WSP(bf16_t, OFF_W1 + (size_t)kv * 512 * 1024); }
      else { u -= 128; const int kv = u / 2; kt = u % 2; nt = 0;
        src = (kv ? p.cmp_w2_v : p.cmp_w2_k) + (size_t)l * 128 * 64; ld = 64; Kd = 128; dst = WSP(bf16_t, OFF_W2 + (size_t)kv * 64 * 1024); }
      transpose_tile(src, ld, kt * 64, nt * 64, dst, Kd, mt, c0, smem);
    } else if ((u -= NT_TR) < NT_H) {
      rmsnorm_rows(xin, p.norm_g + l * 1024, WSP(bf16_t, OFF_H), u * 64, 64);
    } else if ((u -= NT_H) < NT_MEMN) {
      rmsnorm_rows(p.mem, p.mem_norm_g + l * 1024, WSP(bf16_t, OFF_MEMN), u * 64, 64);
    } else if ((u -= NT_MEMN) < NT_C1) {
      const float* pe = (u ? p.cmp_pe_v : p.cmp_pe_k) + (size_t)l * 2048;
      const float* w1 = (u ? p.cmp_w1_v : p.cmp_w1_k) + (size_t)l * 2048 * 128;
      constexpr int NPART = NTHREADS / 128, KPER = 2048 / NPART;
      const int n = tid & 127, part = tid >> 7;
      float s = 0.f;
      for (int kk = part * KPER; kk < part * KPER + KPER; ++kk) s += pe[kk] * w1[(size_t)kk * 128 + n];
      smem[part * 128 + n] = s;
      __syncthreads();
      if (tid < 128) { float tot = 0.f; for (int q = 0; q < NPART; ++q) tot += smem[q * 128 + tid]; WSP(float, OFF_C1)[u * 128 + tid] = tot; }
      __syncthreads();
    } else {
      u -= NT_C1;
      for (int e = tid; e < 512; e += NTHREADS) {
        const int idx = u * 512 + e, pos = idx >> 5, f = idx & 31;
        const float ang = (float)pos * c_inv_freq[f];
        const double a = (double)ang;
        const double k = rint(a * 0.15915494309189535);
        const float rr = (float)(a - k * 6.283185307179586);
        float2 cs; cs.x = __cosf(rr); cs.y = __sinf(rr);
        WSP(float2, OFF_ROPE)[idx] = cs;
      }
    }
  }
}

__device__ void phase_gemm_in(const Params& p, int l) {
  const int wave = tidx() >> 6, lane = tidx() & 63, r = lane & 15, g = lane >> 4;
  const int wm = wave >> 1, wn = wave & 1;
  const float* ropetab = WSP(float, OFF_ROPE);
  for (int tile = blockIdx.x; tile < 9984 + 64; tile += gridDim.x) {
    f32x4 acc[4][4];
    zero_acc(acc);
    if (tile < 9984) {
      const int pm = tile / 39, pn = tile % 39;
      const int row0 = pm * 128 + wm * 64, ct = pn * 2 + wn;
      if (ct >= 77) continue;
      const bf16_t* A = WSP(bf16_t, OFF_H) + (size_t)row0 * 1024;
      const bf16_t* Bt = WSP(bf16_t, OFF_W_IN) + (size_t)ct * 64 * 1024;
      const bool vt = (ct == 14 || ct == 15 || ct == 18 || ct == 19 || (ct >= 44 && ct < 52));
      const int b = row0 / T, t0 = row0 % T;
      if (vt) {
        wave_gemm<false>(A, 1024, Bt, 1024, 1024, acc, lane);
        bf16_t* dst;
        if (ct < 16) dst = WSP(bf16_t, OFF_VST) + (size_t)((b * 2 + (ct - 14)) * 64) * T;
        else if (ct < 20) dst = WSP(bf16_t, OFF_VWT) + (size_t)((b * 2 + (ct - 18)) * 64) * T;
        else dst = WSP(bf16_t, OFF_FVT) + (size_t)((b * 8 + (ct - 44)) * 64) * T;
        epi_transposed(acc, dst, T, t0, lane);
      } else {
        wave_gemm<true>(A, 1024, Bt, 1024, 1024, acc, lane);
        if (ct < 8) epi_rowmajor(acc, row0, WSP(bf16_t, OFF_QN), 512, ct * 64, p.nsa_q_norm + l * 64, true, false, ropetab, lane);
        else if (ct < 10) epi_rowmajor(acc, row0, WSP(bf16_t, OFF_KC), 128, (ct - 8) * 64, nullptr, true, false, ropetab, lane);
        else if (ct < 12) epi_rowmajor(acc, row0, WSP(bf16_t, OFF_VC), 128, (ct - 10) * 64, nullptr, false, false, ropetab, lane);
        else if (ct < 14) epi_rowmajor(acc, row0, WSP(bf16_t, OFF_KS), 128, (ct - 12) * 64, p.nsa_k_norm + (l * 3 + 1) * 64, true, false, ropetab, lane);
        else if (ct < 18) epi_rowmajor(acc, row0, WSP(bf16_t, OFF_KW), 128, (ct - 16) * 64, p.nsa_k_norm + (l * 3 + 2) * 64, true, false, ropetab, lane);
        else if (ct < 28) epi_rowmajor(acc, row0, WSP(bf16_t, OFF_OA), 512, (ct - 20) * 64, nullptr, false, true, ropetab, lane);
        else if (ct < 36) epi_rowmajor(acc, row0, WSP(bf16_t, OFF_FQ), 512, (ct - 28) * 64, p.fox_q_norm + l * 64, false, false, ropetab, lane);
        else if (ct < 44) epi_rowmajor(acc, row0, WSP(bf16_t, OFF_FK), 512, (ct - 36) * 64, p.fox_k_norm + l * 64, false, false, ropetab, lane);
        else if (ct < 60) epi_rowmajor(acc, row0, WSP(bf16_t, OFF_OB), 512, (ct - 52) * 64, nullptr, false, true, ropetab, lane);
        else if (ct < 68) epi_rowmajor(acc, row0, WSP(bf16_t, OFF_MQ), 512, (ct - 60) * 64, nullptr, false, false, ropetab, lane);
        else if (ct < 76) epi_rowmajor(acc, row0, WSP(bf16_t, OFF_OM), 512, (ct - 68) * 64, nullptr, false, true, ropetab, lane);
        else {
          float* gate = WSP(float, OFF_GATE);
          float* flog = WSP(float, OFF_FLOG);
#pragma unroll
          for (int mt = 0; mt < 4; ++mt) {
            const size_t row = (size_t)row0 + 16 * mt + r;
#pragma unroll
            for (int nt = 0; nt < 2; ++nt)
#pragma unroll
              for (int i = 0; i < 4; ++i) {
                const int n = 16 * nt + 4 * g + i;
                const float v = acc[mt][nt][i];
                if (n < 24) gate[row * 24 + n] = sigmoidf_(v);
                else if (n < 32) {
                  const float xx = v + p.fox_f_bias[l * 8 + (n - 24)];
                  flog[row * 8 + (n - 24)] = xx >= 0.f ? -log1pf(expf(-xx)) : xx - log1pf(expf(xx));
                }
              }
          }
        }
      }
    } else {
      const int t2 = tile - 9984, pm = t2 / 8, pn = t2 % 8;
      const int row0 = pm * 128 + wm * 64, ct = pn * 2 + wn;
      const bf16_t* A = WSP(bf16_t, OFF_MEMN) + (size_t)row0 * 1024;
      const bf16_t* Bt = WSP(bf16_t, OFF_W_MKV) + (size_t)ct * 64 * 1024;
      if (ct < 8) {
        wave_gemm<true>(A, 1024, Bt, 1024, 1024, acc, lane);
        epi_rowmajor(acc, row0, WSP(bf16_t, OFF_MK), 512, ct * 64, nullptr, false, false, ropetab, lane);
      } else {
        wave_gemm<false>(A, 1024, Bt, 1024, 1024, acc, lane);
        const int b = row0 / 256, m0 = row0 % 256, col = (ct - 8) * 64, h = col / 128, d0 = col % 128;
        epi_transposed(acc, WSP(bf16_t, OFF_MVT) + (size_t)((b * 4 + h) * 128 + d0) * 256, 256, m0, lane);
      }
    }
  }
}

__device__ void compress_unit(const Params& p, int l, int u) {
  const int lane = tidx() & 63, r = lane & 15, g4 = lane >> 4;
  const int kv = u >> 6, rem = u & 63, b = rem >> 4, grp = (rem >> 3) & 1, it = rem & 7, i0 = it * 64;
  const bf16_t* src = WSP(bf16_t, kv ? OFF_VC : OFF_KC);
  const bf16_t* w1t = WSP(bf16_t, OFF_W1 + (size_t)kv * 512 * 1024);
  const bf16_t* w2t = WSP(bf16_t, OFF_W2 + (size_t)kv * 64 * 1024);
  const float* c1 = WSP(float, OFF_C1) + kv * 128;
  const bf16_t* arow[4];
#pragma unroll
  for (int mt = 0; mt < 4; ++mt) {
    int i = i0 + 16 * mt + r;
    if (i > 510) i = 510;
    arow[mt] = src + ((size_t)b * T + 16 * i) * 128 + grp * 64 + g4 * 8;
  }
  f32x4 acc[4][8];
#pragma unroll
  for (int a = 0; a < 4; ++a)
#pragma unroll
    for (int c = 0; c < 8; ++c) acc[a][c] = (f32x4){0.f, 0.f, 0.f, 0.f};
  const bf16_t* bp = w1t + (size_t)r * 2048 + g4 * 8;
  for (int k0 = 0; k0 < 2048; k0 += 32) {
    const int pp = k0 >> 6, d = k0 & 63;
    bf16x8 af[4], bf[8];
#pragma unroll
    for (int mt = 0; mt < 4; ++mt) af[mt] = *(const bf16x8*)(arow[mt] + (size_t)pp * 128 + d);
#pragma unroll
    for (int nt = 0; nt < 8; ++nt) bf[nt] = *(const bf16x8*)(bp + (size_t)nt * 16 * 2048 + k0);
#pragma unroll
    for (int mt = 0; mt < 4; ++mt)
#pragma unroll
      for (int nt = 0; nt < 8; ++nt) acc[mt][nt] = mfma16(bf[nt], af[mt], acc[mt][nt]);
  }
#pragma unroll
  for (int nt = 0; nt < 8; ++nt) {
    const f32x4 cv = *(const f32x4*)(c1 + 16 * nt + 4 * g4);
#pragma unroll
    for (int mt = 0; mt < 4; ++mt)
#pragma unroll
      for (int i = 0; i < 4; ++i) acc[mt][nt][i] = siluf_(acc[mt][nt][i] + cv[i]);
  }
  bf16x8 wf[4][4];
#pragma unroll
  for (int ks = 0; ks < 4; ++ks)
#pragma unroll
    for (int et = 0; et < 4; ++et) {
      const bf16_t* wp = w2t + (size_t)(16 * et + r) * 128 + 32 * ks + 4 * g4;
      const u32x2 lo = *(const u32x2*)wp, hi = *(const u32x2*)(wp + 16);
      u32x4 w = {lo[0], lo[1], hi[0], hi[1]};
      wf[ks][et] = __builtin_bit_cast(bf16x8, w);
    }
  if (kv == 0) {
    const float* gain = p.nsa_k_norm + (size_t)(l * 3 + 0) * 64;
    bf16_t* dst = WSP(bf16_t, OFF_KCMP) + (size_t)((b * 2 + grp) * 512) * 64;
    f32x4 gv[4];
#pragma unroll
    for (int et = 0; et < 4; ++et) gv[et] = *(const f32x4*)(gain + 16 * et + 4 * g4);
#pragma unroll
    for (int mt = 0; mt < 4; ++mt) {
      f32x4 o[4];
#pragma unroll
      for (int et = 0; et < 4; ++et) o[et] = (f32x4){0.f, 0.f, 0.f, 0.f};
#pragma unroll
      for (int ks = 0; ks < 4; ++ks) {
        const bf16x8 xf = pack8(acc[mt][2 * ks], acc[mt][2 * ks + 1]);
#pragma unroll
        for (int et = 0; et < 4; ++et) o[et] = mfma16(wf[ks][et], xf, o[et]);
      }
      float ss = 0.f;
#pragma unroll
      for (int et = 0; et < 4; ++et)
#pragma unroll
        for (int i = 0; i < 4; ++i) ss += o[et][i] * o[et][i];
      ss += __shfl_xor(ss, 16);
      ss += __shfl_xor(ss, 32);
      const float rstd = rsqrtf(ss * (1.0f / 64.0f) + EPS);
      const int i = i0 + 16 * mt + r;
#pragma unroll
      for (int et = 0; et < 4; ++et) {
        f32x4 y = o[et] * rstd * gv[et];
        if (i > 510) y = (f32x4){0.f, 0.f, 0.f, 0.f};
        u32x2 w = {cvtpk(y[0], y[1]), cvtpk(y[2], y[3])};
        *(u32x2*)(dst + (size_t)i * 64 + 16 * et + 4 * g4) = w;
      }
    }
  } else {
    bf16_t* dst = WSP(bf16_t, OFF_VCT) + (size_t)((b * 2 + grp) * 64) * 512;
#pragma unroll
    for (int mt = 0; mt < 4; ++mt) {
      f32x4 o[4];
#pragma unroll
      for (int et = 0; et < 4; ++et) o[et] = (f32x4){0.f, 0.f, 0.f, 0.f};
#pragma unroll
      for (int ks = 0; ks < 4; ++ks) {
        const bf16x8 xf = pack8(acc[mt][2 * ks], acc[mt][2 * ks + 1]);
#pragma unroll
        for (int et = 0; et < 4; ++et) o[et] = mfma16(xf, wf[ks][et], o[et]);
      }
#pragma unroll
      for (int et = 0; et < 4; ++et) {
        f32x4 y = o[et];
        const int ib = i0 + 16 * mt + 4 * g4;
#pragma unroll
        for (int i = 0; i < 4; ++i)
          if (ib + i > 510) y[i] = 0.f;
        u32x2 w = {cvtpk(y[0], y[1]), cvtpk(y[2], y[3])};
        *(u32x2*)(dst + (size_t)(16 * et + r) * 512 + ib) = w;
      }
    }
  }
}
__device__ void cumsum_unit(const Params& p, int u) {
  const int lane = tidx() & 63, b = u >> 3, h = u & 7;
  const float* fl = WSP(float, OFF_FLOG) + ((size_t)b * T) * 8 + h;
  float* fc = WSP(float, OFF_FC) + (size_t)(b * 8 + h) * T;
  const int tb = lane * 128;
  double s = 0.0;
  for (int i = 0; i < 128; ++i) s += (double)fl[(size_t)(tb + i) * 8];
  double incl = s;
#pragma unroll
  for (int o = 1; o < 64; o <<= 1) {
    const double y = __shfl_up(incl, o);
    if (lane >= o) incl += y;
  }
  double run = incl - s;
  for (int i = 0; i < 128; ++i) {
    run += (double)fl[(size_t)(tb + i) * 8];
    fc[tb + i] = (float)run;
  }
}
__device__ void memk_norm_unit(const Params& p, int l, int u) {
  const int lane = tidx() & 63;
  bf16_t* mk = WSP(bf16_t, OFF_MK);
  const float* gain = p.mem_k_norm + l * 128 + (lane & 15) * 8;
  for (int rr = 0; rr < 16; ++rr) {
    bf16_t* ptr = mk + (size_t)(u * 16 + rr) * 512 + lane * 8;
    const u32x4 w = *(const u32x4*)ptr;
    float v[8];
#pragma unroll
    for (int j = 0; j < 4; ++j) { v[2 * j] = bflo(w[j]); v[2 * j + 1] = bfhi(w[j]); }
    float ss = 0.f;
#pragma unroll
    for (int j = 0; j < 8; ++j) ss += v[j] * v[j];
#pragma unroll
    for (int o = 1; o < 16; o <<= 1) ss += __shfl_xor(ss, o);
    const float rstd = rsqrtf(ss * (1.0f / 128.0f) + EPS);
    u32x4 ow;
#pragma unroll
    for (int j = 0; j < 4; ++j) ow[j] = cvtpk(v[2 * j] * rstd * gain[2 * j], v[2 * j + 1] * rstd * gain[2 * j + 1]);
    *(u32x4*)ptr = ow;
  }
}
__device__ void phase_mid(const Params& p, int l) {
  const int wave = tidx() >> 6;
  const int gw = wave * gridDim.x + blockIdx.x, nw = NWAVES * gridDim.x;
  for (int u = gw; u < 128 + 32 + 64; u += nw) {
    if (u < 128) compress_unit(p, l, u);
    else if (u < 160) cumsum_unit(p, u - 128);
    else memk_norm_unit(p, l, u - 160);
  }
}

template <int NCT, int NDK>
__device__ __forceinline__ void qk_scores(const bf16_t* __restrict__ kbase, int ldk, int key0,
                                          const bf16x8 (&qf)[NCT][NDK], f32x4 (&s)[2][NCT], int lane) {
  const int r = lane & 15, grp = lane >> 4;
#pragma unroll
  for (int kt = 0; kt < 2; ++kt) {
    const bf16_t* kp = kbase + (size_t)(key0 + 8 * (r >> 2) + 4 * kt + (r & 3)) * ldk + grp * 8;
    bf16x8 kf[NDK];
#pragma unroll
    for (int dk = 0; dk < NDK; ++dk) kf[dk] = *(const bf16x8*)(kp + dk * 32);
#pragma unroll
    for (int ct = 0; ct < NCT; ++ct) {
      f32x4 a = {0.f, 0.f, 0.f, 0.f};
#pragma unroll
      for (int dk = 0; dk < NDK; ++dk) a = mfma16(kf[dk], qf[ct][dk], a);
      s[kt][ct] = a;
    }
  }
}
template <int NCT, int NDT>
__device__ __forceinline__ void pv_accum(const bf16_t* __restrict__ vt, size_t ldv, int key0,
                                         const f32x4 (&s)[2][NCT], f32x4 (&o)[NDT][NCT], int lane) {
  const int r = lane & 15, grp = lane >> 4;
  bf16x8 pb[NCT];
#pragma unroll
  for (int ct = 0; ct < NCT; ++ct) pb[ct] = pack8(s[0][ct], s[1][ct]);
#pragma unroll
  for (int dt = 0; dt < NDT; ++dt) {
    const bf16x8 vf = *(const bf16x8*)(vt + (size_t)(16 * dt + r) * ldv + key0 + 8 * grp);
#pragma unroll
    for (int ct = 0; ct < NCT; ++ct) o[dt][ct] = mfma16(vf, pb[ct], o[dt][ct]);
  }
}
template <int NCT, int NDT, bool HAS_O>
__device__ __forceinline__ void softmax_update(f32x4 (&s)[2][NCT], float (&m)[NCT], float (&lsum)[NCT],
                                               f32x4 (&o)[NDT][NCT]) {
#pragma unroll
  for (int ct = 0; ct < NCT; ++ct) {
    float mx = fmaxf(fmaxf(fmaxf(s[0][ct][0], s[0][ct][1]), fmaxf(s[0][ct][2], s[0][ct][3])),
                     fmaxf(fmaxf(s[1][ct][0], s[1][ct][1]), fmaxf(s[1][ct][2], s[1][ct][3])));
    mx = fmaxf(mx, __shfl_xor(mx, 16));
    mx = fmaxf(mx, __shfl_xor(mx, 32));
    const float mnew = fmaxf(m[ct], mx);
    const float msafe = (mnew == NEG_INF) ? 0.f : mnew;
    const float alpha = __builtin_amdgcn_exp2f(m[ct] - msafe);
    m[ct] = mnew;
    float ps = 0.f;
#pragma unroll
    for (int kt = 0; kt < 2; ++kt)
#pragma unroll
      for (int i = 0; i < 4; ++i) {
        const float pv = __builtin_amdgcn_exp2f(s[kt][ct][i] - msafe);
        s[kt][ct][i] = pv;
        ps += pv;
      }
    lsum[ct] = lsum[ct] * alpha + ps;
    if (HAS_O) {
#pragma unroll
      for (int dt = 0; dt < NDT; ++dt) o[dt][ct] = o[dt][ct] * alpha;
    }
  }
}
__device__ __forceinline__ float finish_l(float lsum) {
  lsum += __shfl_xor(lsum, 16);
  lsum += __shfl_xor(lsum, 32);
  return lsum > 0.f ? 1.0f / lsum : 0.f;
}

__device__ void nsa_unit(const Params& p, int b, int g, int tq, float* imp, float* scr) {
  const int lane = tidx() & 63, r = lane & 15, grp = lane >> 4;
  const int t0 = tq * 16, t = t0 + r;
  const size_t row = (size_t)b * T + t;
  const float SC = 0.125f * LOG2E;
  bf16x8 qf[4][2];
#pragma unroll
  for (int ct = 0; ct < 4; ++ct)
#pragma unroll
    for (int dk = 0; dk < 2; ++dk)
      qf[ct][dk] = *(const bf16x8*)(WSP(bf16_t, OFF_QN) + row * 512 + (g * 4 + ct) * 64 + dk * 32 + grp * 8);
  const float* gatep = WSP(float, OFF_GATE) + row * 24 + g * 12;
  f32x4 o[4][4];
  float m[4], lsum[4];
  {
    const bf16_t* kc = WSP(bf16_t, OFF_KCMP) + (size_t)((b * 2 + g) * 512) * 64;
    const bf16_t* vct = WSP(bf16_t, OFF_VCT) + (size_t)((b * 2 + g) * 64) * 512;
    const int nblk = (tq + 31) >> 5;
#pragma unroll
    for (int ct = 0; ct < 4; ++ct) { m[ct] = NEG_INF; lsum[ct] = 0.f; }
#pragma unroll 1
    for (int blk = 0; blk < nblk; ++blk) {
      f32x4 s[2][4];
      qk_scores<4, 2>(kc, 64, blk * 32, qf, s, lane);
#pragma unroll
      for (int kt = 0; kt < 2; ++kt)
#pragma unroll
        for (int i = 0; i < 4; ++i) {
          const int n = blk * 32 + 8 * grp + 4 * kt + i;
          const bool ok = (16 * n + 31 <= t);
#pragma unroll
          for (int ct = 0; ct < 4; ++ct) s[kt][ct][i] = ok ? s[kt][ct][i] * SC : NEG_INF;
        }
      softmax_update<4, 4, false>(s, m, lsum, o);
    }
    float invl[4], msafe[4];
#pragma unroll
    for (int ct = 0; ct < 4; ++ct) { invl[ct] = finish_l(lsum[ct]); msafe[ct] = (m[ct] == NEG_INF) ? 0.f : m[ct]; }
    for (int e = lane; e < 16 * 132; e += 64) imp[e] = 0.f;
    __builtin_amdgcn_fence(__ATOMIC_SEQ_CST, "workgroup");
    __builtin_amdgcn_wave_barrier();
#pragma unroll
    for (int dt = 0; dt < 4; ++dt)
#pragma unroll
      for (int ct = 0; ct < 4; ++ct) o[dt][ct] = (f32x4){0.f, 0.f, 0.f, 0.f};
#pragma unroll 1
    for (int blk = 0; blk < nblk; ++blk) {
      f32x4 s[2][4];
      qk_scores<4, 2>(kc, 64, blk * 32, qf, s, lane);
      float pq[2][4];
#pragma unroll
      for (int kt = 0; kt < 2; ++kt)
#pragma unroll
        for (int i = 0; i < 4; ++i) {
          const int n = blk * 32 + 8 * grp + 4 * kt + i;
          const bool ok = (16 * n + 31 <= t);
          float acc_p = 0.f;
#pragma unroll
          for (int ct = 0; ct < 4; ++ct) {
            const float pv = ok ? __builtin_amdgcn_exp2f(s[kt][ct][i] * SC - msafe[ct]) * invl[ct] : 0.f;
            s[kt][ct][i] = pv;
            acc_p += pv;
          }
          pq[kt][i] = acc_p;
        }
      float* ir = imp + r * 132 + blk * 8 + 2 * grp;
      ir[0] += pq[0][0] + pq[0][1] + pq[0][2] + 0.5f * pq[0][3];
      __builtin_amdgcn_fence(__ATOMIC_SEQ_CST, "workgroup");
      __builtin_amdgcn_wave_barrier();
      ir[1] += pq[1][0] + pq[1][1] + pq[1][2] + 0.5f * pq[1][3] + 0.5f * pq[0][3];
      __builtin_amdgcn_fence(__ATOMIC_SEQ_CST, "workgroup");
      __builtin_amdgcn_wave_barrier();
      ir[2] += 0.5f * pq[1][3];
      __builtin_amdgcn_fence(__ATOMIC_SEQ_CST, "workgroup");
      __builtin_amdgcn_wave_barrier();
      pv_accum<4, 4>(vct, 512, blk * 32, s, o, lane);
    }
    f32x4 gt[4];
#pragma unroll
    for (int ct = 0; ct < 4; ++ct) gt[ct][0] = gatep[ct * 3 + 0];
#pragma unroll
    for (int dt = 0; dt < 4; ++dt) {
#pragma unroll
      for (int ct = 0; ct < 4; ++ct)
#pragma unroll
        for (int i = 0; i < 4; ++i) scr[((dt * 4 + ct) * 4 + i) * 64 + lane] = o[dt][ct][i] * gt[ct][0];
      asm volatile("" ::: "memory");
    }
  }
  const int cur = t0 >> 6;
  unsigned long long sel_lo = 0ull, sel_hi = 0ull;
  if (cur <= 15) {
    sel_lo = (cur == 63) ? ~0ull : ((1ull << (cur + 1)) - 1ull);
  } else {
    __builtin_amdgcn_fence(__ATOMIC_SEQ_CST, "workgroup");
    __builtin_amdgcn_wave_barrier();
    float v[32];
#pragma unroll
    for (int k = 0; k < 32; ++k) {
      const int j = grp + 4 * k;
      const float x = imp[r * 132 + j];
      v[k] = (j >= 1 && j <= cur - 2) ? x : NEG_INF;
    }
#pragma unroll 1
    for (int round = 0; round < 13; ++round) {
      float best = NEG_INF;
      int bj = 1 << 20;
#pragma unroll
      for (int k = 0; k < 32; ++k) {
        const bool tk = v[k] > best;
        best = tk ? v[k] : best;
        bj = tk ? (grp + 4 * k) : bj;
      }
#pragma unroll
      for (int off = 16; off <= 32; off <<= 1) {
        const float ob = __shfl_xor(best, off);
        const int oj = __shfl_xor(bj, off);
        const bool tk = (ob > best) || (ob == best && oj < bj);
        best = tk ? ob : best;
        bj = tk ? oj : bj;
      }
      if (bj < 64) sel_lo |= 1ull << bj; else if (bj < 128) sel_hi |= 1ull << (bj - 64);
#pragma unroll
      for (int k = 0; k < 32; ++k) v[k] = (bj == grp + 4 * k) ? NEG_INF : v[k];
    }
    sel_lo |= 1ull;
    if (cur < 64) sel_lo |= 1ull << cur; else sel_hi |= 1ull << (cur - 64);
    if (cur - 1 < 64) sel_lo |= 1ull << (cur - 1); else sel_hi |= 1ull << (cur - 1 - 64);
  }
  {
    const bf16_t* ks = WSP(bf16_t, OFF_KS) + ((size_t)b * T) * 128 + g * 64;
    const bf16_t* vst = WSP(bf16_t, OFF_VST) + (size_t)((b * 2 + g) * 64) * T;
#pragma unroll
    for (int ct = 0; ct < 4; ++ct) { m[ct] = NEG_INF; lsum[ct] = 0.f; }
#pragma unroll
    for (int dt = 0; dt < 4; ++dt)
#pragma unroll
      for (int ct = 0; ct < 4; ++ct) o[dt][ct] = (f32x4){0.f, 0.f, 0.f, 0.f};
#pragma unroll 1
    for (int j = 0; j <= cur; ++j) {
      const bool mine = ((j < 64 ? (sel_lo >> j) : (sel_hi >> (j - 64))) & 1ull) != 0ull;
      if (!__any(mine)) continue;
#pragma unroll 1
      for (int half = 0; half < 2; ++half) {
        const int key0 = j * 64 + half * 32;
        f32x4 s[2][4];
        qk_scores<4, 2>(ks, 128, key0, qf, s, lane);
#pragma unroll
        for (int kt = 0; kt < 2; ++kt)
#pragma unroll
          for (int i = 0; i < 4; ++i) {
            const int key = key0 + 8 * grp + 4 * kt + i;
            const bool ok = mine && (key <= t);
#pragma unroll
            for (int ct = 0; ct < 4; ++ct) s[kt][ct][i] = ok ? s[kt][ct][i] * SC : NEG_INF;
          }
        softmax_update<4, 4, true>(s, m, lsum, o);
        pv_accum<4, 4>(vst, T, key0, s, o, lane);
      }
    }
    float sc2[4];
#pragma unroll
    for (int ct = 0; ct < 4; ++ct) sc2[ct] = finish_l(lsum[ct]) * gatep[ct * 3 + 1];
#pragma unroll
    for (int dt = 0; dt < 4; ++dt) {
#pragma unroll
      for (int ct = 0; ct < 4; ++ct)
#pragma unroll
        for (int i = 0; i < 4; ++i) scr[((dt * 4 + ct) * 4 + i) * 64 + lane] += o[dt][ct][i] * sc2[ct];
      asm volatile("" ::: "memory");
    }
  }
  {
    const bf16_t* kw = WSP(bf16_t, OFF_KW) + ((size_t)b * T) * 128 + g * 64;
    const bf16_t* vwt = WSP(bf16_t, OFF_VWT) + (size_t)((b * 2 + g) * 64) * T;
#pragma unroll
    for (int ct = 0; ct < 4; ++ct) { m[ct] = NEG_INF; lsum[ct] = 0.f; }
#pragma unroll
    for (int dt = 0; dt < 4; ++dt)
#pragma unroll
      for (int ct = 0; ct < 4; ++ct) o[dt][ct] = (f32x4){0.f, 0.f, 0.f, 0.f};
    int kstart = t0 - 511;
    if (kstart < 0) kstart = 0;
    kstart &= ~31;
#pragma unroll 1
    for (int key0 = kstart; key0 <= t0 + 15; key0 += 32) {
      f32x4 s[2][4];
      qk_scores<4, 2>(kw, 128, key0, qf, s, lane);
#pragma unroll
      for (int kt = 0; kt < 2; ++kt)
#pragma unroll
        for (int i = 0; i < 4; ++i) {
          const int key = key0 + 8 * grp + 4 * kt + i;
          const bool ok = (key <= t) && (key + 512 > t);
#pragma unroll
          for (int ct = 0; ct < 4; ++ct) s[kt][ct][i] = ok ? s[kt][ct][i] * SC : NEG_INF;
        }
      softmax_update<4, 4, true>(s, m, lsum, o);
      pv_accum<4, 4>(vwt, T, key0, s, o, lane);
    }
    float sc2[4];
#pragma unroll
    for (int ct = 0; ct < 4; ++ct) sc2[ct] = finish_l(lsum[ct]) * gatep[ct * 3 + 2];
    bf16_t* oa = WSP(bf16_t, OFF_OA) + row * 512 + g * 256;
#pragma unroll
    for (int dt = 0; dt < 4; ++dt)
#pragma unroll
      for (int ct = 0; ct < 4; ++ct) {
        bf16_t* ptr = oa + ct * 64 + 16 * dt + 4 * grp;
        const u32x2 sw = *(const u32x2*)ptr;
        float val[4];
#pragma unroll
        for (int i = 0; i < 4; ++i) val[i] = scr[((dt * 4 + ct) * 4 + i) * 64 + lane] + o[dt][ct][i] * sc2[ct];
        u32x2 w = {cvtpk(val[0] * bflo(sw[0]), val[1] * bfhi(sw[0])), cvtpk(val[2] * bflo(sw[1]), val[3] * bfhi(sw[1]))};
        *(u32x2*)ptr = w;
        asm volatile("" ::: "memory");
      }
  }
}

__device__ void fox_unit(const Params& p, int b, int h, int c) {
  const int lane = tidx() & 63, r = lane & 15, grp = lane >> 4;
  const int t0 = c * 64;
  const float SC = 0.125f * LOG2E;
  bf16x8 qf[4][2];
  float cq[4];
  const float* fc = WSP(float, OFF_FC) + (size_t)(b * 8 + h) * T;
#pragma unroll
  for (int ct = 0; ct < 4; ++ct) {
    const size_t row = (size_t)b * T + t0 + 16 * ct + r;
#pragma unroll
    for (int dk = 0; dk < 2; ++dk)
      qf[ct][dk] = *(const bf16x8*)(WSP(bf16_t, OFF_FQ) + row * 512 + h * 64 + dk * 32 + grp * 8);
    cq[ct] = fc[t0 + 16 * ct + r] * LOG2E;
  }
  const bf16_t* kb = WSP(bf16_t, OFF_FK) + ((size_t)b * T) * 512 + h * 64;
  const bf16_t* vt = WSP(bf16_t, OFF_FVT) + (size_t)((b * 8 + h) * 64) * T;
  f32x4 o[4][4];
  float m[4], lsum[4];
#pragma unroll
  for (int ct = 0; ct < 4; ++ct) { m[ct] = NEG_INF; lsum[ct] = 0.f; }
#pragma unroll
  for (int dt = 0; dt < 4; ++dt)
#pragma unroll
    for (int ct = 0; ct < 4; ++ct) o[dt][ct] = (f32x4){0.f, 0.f, 0.f, 0.f};
#pragma unroll 1
  for (int key0 = 0; key0 < t0 + 64; key0 += 32) {
    f32x4 s[2][4];
    qk_scores<4, 2>(kb, 512, key0, qf, s, lane);
    const f32x4 ck0 = *(const f32x4*)(fc + key0 + 8 * grp), ck1 = *(const f32x4*)(fc + key0 + 8 * grp + 4);
#pragma unroll
    for (int kt = 0; kt < 2; ++kt)
#pragma unroll
      for (int i = 0; i < 4; ++i) {
        const int key = key0 + 8 * grp + 4 * kt + i;
        const float ck = (kt ? ck1[i] : ck0[i]) * LOG2E;
#pragma unroll
        for (int ct = 0; ct < 4; ++ct) {
          const bool ok = key <= t0 + 16 * ct + r;
          s[kt][ct][i] = ok ? (s[kt][ct][i] * SC + (cq[ct] - ck)) : NEG_INF;
        }
      }
    softmax_update<4, 4, true>(s, m, lsum, o);
    pv_accum<4, 4>(vt, T, key0, s, o, lane);
  }
  float invl[4];
#pragma unroll
  for (int ct = 0; ct < 4; ++ct) invl[ct] = finish_l(lsum[ct]);
#pragma unroll
  for (int ct = 0; ct < 4; ++ct) {
    bf16_t* ob = WSP(bf16_t, OFF_OB) + ((size_t)b * T + t0 + 16 * ct + r) * 512 + h * 64;
#pragma unroll
    for (int dt = 0; dt < 4; ++dt) {
      bf16_t* ptr = ob + 16 * dt + 4 * grp;
      const u32x2 sw = *(const u32x2*)ptr;
      const f32x4 v = o[dt][ct] * invl[ct];
      u32x2 w = {cvtpk(v[0] * bflo(sw[0]), v[1] * bfhi(sw[0])), cvtpk(v[2] * bflo(sw[1]), v[3] * bfhi(sw[1]))};
      *(u32x2*)ptr = w;
    }
  }
}

__device__ void mem_unit(const Params& p, int l, int b, int h, int t0) {
  const int lane = tidx() & 63, r = lane & 15, grp = lane >> 4;
  const float SC = 0.08838834764831845f * LOG2E;
  bf16x8 qf[2][4];
  const float* gq = p.mem_q_norm + l * 128;
#pragma unroll
  for (int ct = 0; ct < 2; ++ct) {
    const size_t row = (size_t)b * T + t0 + 16 * ct + r;
    float v[4][8];
    float ss = 0.f;
#pragma unroll
    for (int dk = 0; dk < 4; ++dk) {
      const u32x4 w = *(const u32x4*)(WSP(bf16_t, OFF_MQ) + row * 512 + h * 128 + dk * 32 + grp * 8);
#pragma unroll
      for (int j = 0; j < 4; ++j) { v[dk][2 * j] = bflo(w[j]); v[dk][2 * j + 1] = bfhi(w[j]); }
#pragma unroll
      for (int j = 0; j < 8; ++j) ss += v[dk][j] * v[dk][j];
    }
    ss += __shfl_xor(ss, 16);
    ss += __shfl_xor(ss, 32);
    const float rstd = rsqrtf(ss * (1.0f / 128.0f) + EPS);
#pragma unroll
    for (int dk = 0; dk < 4; ++dk) {
      const f32x4 g0 = *(const f32x4*)(gq + dk * 32 + grp * 8), g1 = *(const f32x4*)(gq + dk * 32 + grp * 8 + 4);
      u32x4 w = {cvtpk(v[dk][0] * rstd * g0[0], v[dk][1] * rstd * g0[1]), cvtpk(v[dk][2] * rstd * g0[2], v[dk][3] * rstd * g0[3]),
                 cvtpk(v[dk][4] * rstd * g1[0], v[dk][5] * rstd * g1[1]), cvtpk(v[dk][6] * rstd * g1[2], v[dk][7] * rstd * g1[3])};
      qf[ct][dk] = __builtin_bit_cast(bf16x8, w);
    }
  }
  const bf16_t* kb = WSP(bf16_t, OFF_MK) + ((size_t)b * 256) * 512 + h * 128;
  const bf16_t* vt = WSP(bf16_t, OFF_MVT) + (size_t)((b * 4 + h) * 128) * 256;
  f32x4 o[8][2];
  float m[2], lsum[2];
#pragma unroll
  for (int ct = 0; ct < 2; ++ct) { m[ct] = NEG_INF; lsum[ct] = 0.f; }
#pragma unroll
  for (int dt = 0; dt < 8; ++dt)
#pragma unroll
    for (int ct = 0; ct < 2; ++ct) o[dt][ct] = (f32x4){0.f, 0.f, 0.f, 0.f};
#pragma unroll 1
  for (int key0 = 0; key0 < 256; key0 += 32) {
    f32x4 s[2][2];
    qk_scores<2, 4>(kb, 512, key0, qf, s, lane);
#pragma unroll
    for (int kt = 0; kt < 2; ++kt)
#pragma unroll
      for (int ct = 0; ct < 2; ++ct) s[kt][ct] = s[kt][ct] * SC;
    softmax_update<2, 8, true>(s, m, lsum, o);
    pv_accum<2, 8>(vt, 256, key0, s, o, lane);
  }
#pragma unroll
  for (int ct = 0; ct < 2; ++ct) {
    const float invl = finish_l(lsum[ct]);
    bf16_t* om = WSP(bf16_t, OFF_OM) + ((size_t)b * T + t0 + 16 * ct + r) * 512 + h * 128;
#pragma unroll
    for (int dt = 0; dt < 8; ++dt) {
      bf16_t* ptr = om + 16 * dt + 4 * grp;
      const u32x2 sw = *(const u32x2*)ptr;
      const f32x4 v = o[dt][ct] * invl;
      u32x2 w = {cvtpk(v[0] * bflo(sw[0]), v[1] * bfhi(sw[0])), cvtpk(v[2] * bflo(sw[1]), v[3] * bfhi(sw[1]))};
      *(u32x2*)ptr = w;
    }
  }
}

__device__ void phase_attn(const Params& p, int l, float* smem) {
  const int wave = tidx() >> 6, lane = tidx() & 63;
  float* imp = smem + wave * 2112;
  float* scr = WSP(float, OFF_SCR) + (size_t)(blockIdx.x * NWAVES + wave) * 4096;
  unsigned* ctr = WSP(unsigned, OFF_CTL) + l;
  constexpr int NUNITS = 128 * 96;
  for (;;) {
    int u = 0;
    if (lane == 0) u = (int)atomicAdd(ctr, 1u);
    u = __builtin_amdgcn_readfirstlane(u);
    if (u >= NUNITS) break;
    const int s = u / 96, rr = u % 96, c = 127 - s;
    if (rr < 32) fox_unit(p, rr >> 3, rr & 7, c);
    else if (rr < 64) { const int q = rr - 32, bg = q >> 2, sub = q & 3; nsa_unit(p, bg >> 1, bg & 1, 4 * c + sub, imp, scr); }
    else { const int q = rr - 64, bh = q >> 1, half = q & 1; mem_unit(p, l, bh >> 2, bh & 3, 64 * c + 32 * half); }
  }
}

__device__ void phase_branch(const Params& p, int l) {
  const int wave = tidx() >> 6, lane = tidx() & 63, r = lane & 15, g = lane >> 4;
  const int wm = wave >> 1, wn = wave & 1;
  for (int tile = blockIdx.x; tile < 2048; tile += gridDim.x) {
    const int pm = tile >> 3, pn = tile & 7;
    const int row0 = pm * 128 + wm * 64, col0 = pn * 128 + wn * 64;
    f32x4 uacc[4][4];
    zero_acc(uacc);
#pragma unroll 1
    for (int br = 0; br < 3; ++br) {
      u32x2 gpk[4][4];
      {
        f32x4 acc[4][4];
        zero_acc(acc);
        wave_gemm<true>(WSP(bf16_t, OFF_H) + (size_t)row0 * 1024, 1024,
                        WSP(bf16_t, OFF_W_G) + (size_t)(br * 1024 + col0) * 1024, 1024, 1024, acc, lane);
#pragma unroll
        for (int mt = 0; mt < 4; ++mt)
#pragma unroll
          for (int nt = 0; nt < 4; ++nt) {
            const f32x4 v = acc[mt][nt];
            gpk[mt][nt] = (u32x2){cvtpk(sigmoidf_(v[0]), sigmoidf_(v[1])), cvtpk(sigmoidf_(v[2]), sigmoidf_(v[3]))};
          }
      }
      {
        f32x4 acc[4][4];
        zero_acc(acc);
        const bf16_t* O = WSP(bf16_t, br == 0 ? OFF_OA : br == 1 ? OFF_OB : OFF_OM);
        wave_gemm<true>(O + (size_t)row0 * 512, 512, WSP(bf16_t, OFF_W_BR + (size_t)br * MiB) + (size_t)col0 * 512, 512, 512, acc, lane);
#pragma unroll
        for (int mt = 0; mt < 4; ++mt)
#pragma unroll
          for (int nt = 0; nt < 4; ++nt) {
            const u32x2 gw = gpk[mt][nt];
            uacc[mt][nt][0] += acc[mt][nt][0] * bflo(gw[0]);
            uacc[mt][nt][1] += acc[mt][nt][1] * bfhi(gw[0]);
            uacc[mt][nt][2] += acc[mt][nt][2] * bflo(gw[1]);
            uacc[mt][nt][3] += acc[mt][nt][3] * bfhi(gw[1]);
          }
      }
    }
    bf16_t* U = WSP(bf16_t, OFF_U);
#pragma unroll
    for (int mt = 0; mt < 4; ++mt)
#pragma unroll
      for (int nt = 0; nt < 4; ++nt) {
        const f32x4 v = uacc[mt][nt];
        u32x2 w = {cvtpk(v[0], v[1]), cvtpk(v[2], v[3])};
        *(u32x2*)(U + (size_t)(row0 + 16 * mt + r) * 1024 + col0 + 16 * nt + 4 * g) = w;
      }
  }
}

__device__ void phase_out(const Params& p, int l) {
  const int wave = tidx() >> 6, lane = tidx() & 63, r = lane & 15, g = lane >> 4;
  const int wm = wave >> 1, wn = wave & 1;
  const float* xin = (l == 0) ? p.x : p.out;
  for (int tile = blockIdx.x; tile < 2048; tile += gridDim.x) {
    const int pm = tile >> 3, pn = tile & 7;
    const int row0 = pm * 128 + wm * 64, col0 = pn * 128 + wn * 64;
    f32x4 acc[4][4];
    zero_acc(acc);
    wave_gemm<true>(WSP(bf16_t, OFF_U) + (size_t)row0 * 1024, 1024, WSP(bf16_t, OFF_W_OUT) + (size_t)col0 * 1024, 1024, 1024, acc, lane);
#pragma unroll
    for (int mt = 0; mt < 4; ++mt)
#pragma unroll
      for (int nt = 0; nt < 4; ++nt) {
        const size_t off = (size_t)(row0 + 16 * mt + r) * 1024 + col0 + 16 * nt + 4 * g;
        const f32x4 xv = *(const f32x4*)(xin + off);
        *(f32x4*)(p.out + off) = xv + acc[mt][nt];
      }
  }
}

__global__ void __launch_bounds__(NTHREADS) hybrid_megakernel(Params p) {
  cg::grid_group grid = cg::this_grid();
  __shared__ float smem[NWAVES * 2112];
  for (int l = 0; l < 4; ++l) {
    phase_prep(p, l, smem);
    grid.sync();
    phase_gemm_in(p, l);
    grid.sync();
    phase_mid(p, l);
    grid.sync();
    phase_attn(p, l, smem);
    grid.sync();
    phase_branch(p, l);
    grid.sync();
    phase_out(p, l);
    grid.sync();
  }
}

extern "C" void kernel_launch(void* const* d_in, const int* in_sizes, int n_in, void* d_out, int out_size, void* d_ws,
                              size_t ws_size, hipStream_t stream) {
  static int grid_blocks = 0;
  if (!grid_blocks) {
    int dev = 0, cus = 0, per_cu = 0;
    hipGetDevice(&dev);
    hipDeviceGetAttribute(&cus, hipDeviceAttributeMultiprocessorCount, dev);
    hipOccupancyMaxActiveBlocksPerMultiprocessor(&per_cu, hybrid_megakernel, NTHREADS, 0);
    if (per_cu < 1) per_cu = 1;
    if (per_cu > 2) per_cu = 2;
    grid_blocks = cus * per_cu;
    if (grid_blocks > 512) grid_blocks = 512;
  }
  Params p{};
  const float** pp = (const float**)&p;
  for (int i = 0; i < 23; ++i) pp[i] = (const float*)d_in[i];
  p.out = (float*)d_out;
  p.ws = (char*)d_ws;
  void* args[] = {&p};
  hipError_t e = hipLaunchCooperativeKernel((void*)hybrid_megakernel, dim3(grid_blocks), dim3(NTHREADS), args, 0, stream);
  if (e != hipSuccess) fprintf(stderr, "cooperative launch failed: %s (grid %d)\n", hipGetErrorString(e), grid_blocks);
}
```

```cpp
#include <hip/hip_runtime.h>
#include <hip/hip_cooperative_groups.h>
#include <stdint.h>
#include <cstdio>
namespace cg = cooperative_groups;


typedef unsigned short bf16_t;
typedef short bf16x8 __attribute__((ext_vector_type(8)));
typedef float f32x4 __attribute__((ext_vector_type(4)));
typedef unsigned u32x2 __attribute__((ext_vector_type(2)));
typedef unsigned u32x4 __attribute__((ext_vector_type(4)));
typedef float f32x2_t __attribute__((ext_vector_type(2)));
typedef __bf16 bf16x2_t __attribute__((ext_vector_type(2)));

constexpr int NB = 4, T = 8192, M = NB * T;
constexpr int NTHREADS = 512, NWAVES = NTHREADS / 64;
constexpr int LDS_BYTES = 147456;
constexpr float EPS = 1e-6f;
constexpr float LOG2E = 1.4426950408889634f;
#define NEG_INF (-__builtin_inff())

constexpr size_t MiB = 1u << 20;
constexpr size_t OFF_CTL = 0;
constexpr size_t OFF_ROPE = 1 * MiB;
constexpr size_t OFF_W_IN = 3 * MiB;
constexpr size_t OFF_W_G = 13 * MiB;
constexpr size_t OFF_W_MKV = 19 * MiB;
constexpr size_t OFF_W_BR = 21 * MiB;
constexpr size_t OFF_W_OUT = 24 * MiB;
constexpr size_t OFF_W1 = 26 * MiB;
constexpr size_t OFF_W2 = 27 * MiB;
constexpr size_t OFF_C1 = 27 * MiB + 256 * 1024;
constexpr size_t OFF_MEMN = 28 * MiB;
constexpr size_t OFF_MK = 30 * MiB;
constexpr size_t OFF_MVT = 31 * MiB;
constexpr size_t OFF_H = 32 * MiB;
constexpr size_t OFF_U = OFF_H;
constexpr size_t OFF_OA = 96 * MiB;
constexpr size_t OFF_OB = 128 * MiB;
constexpr size_t OFF_OM = 160 * MiB;
constexpr size_t OFF_QN = 192 * MiB;
constexpr size_t OFF_G = 192 * MiB;
constexpr size_t OFF_KC = 224 * MiB;
constexpr size_t OFF_VC = 232 * MiB;
constexpr size_t OFF_KS = 240 * MiB;
constexpr size_t OFF_VST = 248 * MiB;
constexpr size_t OFF_KW = 256 * MiB;
constexpr size_t OFF_VWT = 264 * MiB;
constexpr size_t OFF_FQ = 272 * MiB;
constexpr size_t OFF_FK = 304 * MiB;
constexpr size_t OFF_FVT = 336 * MiB;
constexpr size_t OFF_MQ = 368 * MiB;
constexpr size_t OFF_GATE = 400 * MiB;
constexpr size_t OFF_FLOG = 403 * MiB;
constexpr size_t OFF_FC = 404 * MiB;
constexpr size_t OFF_KCMP = 405 * MiB;
constexpr size_t OFF_VCT = 405 * MiB + 512 * 1024;
constexpr size_t OFF_SCR = 406 * MiB;

struct Params {
  const float *x, *mem, *norm_g, *mem_norm_g, *w_in, *nsa_q_norm, *nsa_k_norm, *cmp_pe_k, *cmp_w1_k, *cmp_w2_k,
      *cmp_pe_v, *cmp_w1_v, *cmp_w2_v, *fox_q_norm, *fox_k_norm, *fox_f_bias, *mem_q_norm, *mem_k_norm, *w_mem_kv,
      *w_branch_a, *w_branch_b, *w_branch_m, *w_out;
  float* out;
  char* ws;
};
#define WSP(TYPE, off) ((TYPE*)(p.ws + (off)))

__constant__ float c_inv_freq[32] = {
    1.000000000e+00f, 7.498942018e-01f, 5.623413324e-01f, 4.216965139e-01f, 3.162277639e-01f, 2.371373773e-01f,
    1.778279394e-01f, 1.333521456e-01f, 1.000000015e-01f, 7.498942316e-02f, 5.623413250e-02f, 4.216964915e-02f,
    3.162277490e-02f, 2.371373773e-02f, 1.778279431e-02f, 1.333521400e-02f, 9.999999776e-03f, 7.498942316e-03f,
    5.623413250e-03f, 4.216964822e-03f, 3.162277630e-03f, 2.371373819e-03f, 1.778279431e-03f, 1.333521446e-03f,
    1.000000047e-03f, 7.498941850e-04f, 5.623413017e-04f, 4.216965172e-04f, 3.162277571e-04f, 2.371373703e-04f,
    1.778279402e-04f, 1.333521504e-04f};

__device__ __forceinline__ int tidx() { int t = threadIdx.x; asm volatile("" : "+v"(t)); return t; }
__device__ __forceinline__ unsigned cvtpk(float lo, float hi) {
  f32x2_t v = {lo, hi};
  bf16x2_t b = __builtin_convertvector(v, bf16x2_t);
  return __builtin_bit_cast(unsigned, b);
}
__device__ __forceinline__ float bf2f(unsigned short v) { return __uint_as_float(((unsigned)v) << 16); }
__device__ __forceinline__ float bflo(unsigned w) { return __uint_as_float(w << 16); }
__device__ __forceinline__ float bfhi(unsigned w) { return __uint_as_float(w & 0xffff0000u); }
__device__ __forceinline__ f32x4 mfma16(bf16x8 a, bf16x8 b, f32x4 c) {
  return __builtin_amdgcn_mfma_f32_16x16x32_bf16(a, b, c, 0, 0, 0);
}
__device__ __forceinline__ bf16x8 pack8(f32x4 a, f32x4 b) {
  u32x4 w = {cvtpk(a[0], a[1]), cvtpk(a[2], a[3]), cvtpk(b[0], b[1]), cvtpk(b[2], b[3])};
  return __builtin_bit_cast(bf16x8, w);
}
__device__ __forceinline__ float sigmoidf_(float v) { return 1.0f / (1.0f + __expf(-v)); }
__device__ __forceinline__ float siluf_(float v) { return v / (1.0f + __expf(-v)); }
__device__ __forceinline__ float wave_sum(float v) {
#pragma unroll
  for (int o = 1; o < 64; o <<= 1) v += __shfl_xor(v, o);
  return v;
}

namespace pg8 {
#define PG8_LAS __attribute__((address_space(3)))
typedef unsigned short bf16_t;
typedef short bf16x8 __attribute__((ext_vector_type(8)));
typedef float f32x4 __attribute__((ext_vector_type(4)));
typedef unsigned u32x4 __attribute__((ext_vector_type(4)));
constexpr int BM = 256, BK = 64, HALF = 128, HTB = HALF * BK * 2  , STAGE_BYTES = 8 * HTB, NXCD = 8, WGM = 8;

__host__ __device__ __forceinline__ int lds_byte(int r, int c) { const int st = (r >> 4) * 2 + (c >> 5), rr = r & 15, cc = c & 31, ob = rr * 64 + cc * 2; return st * 1024 + (ob ^ (((ob >> 9) & 1) << 5)); }
__host__ __device__ __forceinline__ void stage_rc(int b, int& R, int& C) { const int st = b / 1024, sb = b % 1024, swz = sb ^ (((sb >> 9) & 1) << 5); R = (st >> 1) * 16 + swz / 64; C = (st & 1) * 32 + (swz % 64) / 2; }
__host__ __device__ __forceinline__ int perm32(int rho) { const int n = rho >> 4, i = rho & 15; return 8 * (i >> 2) + 4 * n + (i & 3); }

struct Unit { int pm, pn; };
struct Gemm { const bf16_t* A; const bf16_t* Bt; int M, N, K; };

struct StaticOrder {
    int nM, nN, nwg, G, c;
    __host__ __device__ void init(int M, int N, int G_, int c_) { nM = M / BM; nN = N / BM; nwg = nM * nN; G = G_; c = c_; }
    __host__ __device__ bool next(int i, Unit& u) const {
        const long L = (long)i * G + c; if (L >= nwg) return false;
        int wgid = (int)L; { const int q = nwg / NXCD, r = nwg % NXCD, xcd = wgid % NXCD, off = wgid / NXCD; wgid = (xcd < r ? xcd * (q + 1) : r * (q + 1) + (xcd - r) * q) + off; }
        const int nig = WGM * nN, gid = wgid / nig, fm = gid * WGM, gsz = (nM - fm) < WGM ? (nM - fm) : WGM;
        u.pm = fm + ((wgid % nig) % gsz); u.pn = (wgid % nig) / gsz; return true;
    }
    __device__ __forceinline__ void a_ready(const Unit&) const {}
    __device__ __forceinline__ void done(const Unit&) const {}
};
__device__ __forceinline__ unsigned cvt_pk_bf16(float lo, float hi) { unsigned r; asm volatile("v_cvt_pk_bf16_f32 %0, %1, %2" : "=v"(r) : "v"(lo), "v"(hi)); return r; }
template <class Epi, class Sched, bool ALIGN_EPI = false, bool SP2 = false>
__device__ __forceinline__ void gemm_phase(PG8_LAS unsigned char* lds, const Gemm g, const Sched& S, const Epi& E) {
    const int tid = tidx(), wid = __builtin_amdgcn_readfirstlane(tid >> 6), lane = tid & 63, wr = wid >> 2, wc = wid & 3, fr = lane & 15, fq = lane >> 4;
    const int K = g.K, nt = K / BK;
    unsigned voffA[2], voffB[2];
#pragma unroll
    for (int i = 0; i < 2; ++i) { int R, C; stage_rc(tid * 16 + i * 8192, R, C); const int Rb = Epi::PERM ? ((R & ~31) + perm32(R & 31)) : R;
        voffA[i] = (unsigned)(R * K + C) * 2u; voffB[i] = (unsigned)(Rb * K + C) * 2u; }
    const size_t kstep = (size_t)(BK * 2);
    const size_t hstep = (size_t)HALF * K * 2;
    const size_t tstep = 2 * hstep;
    const unsigned ldsw = (unsigned)wid * 1024u;
    const int aoff = lds_byte(wr * 64 + fr, fq * 8), boff = lds_byte(wc * 32 + fr, fq * 8);
#define PG8_SA(b, h) (((b) * 2 + (h)) * HTB)
#define PG8_SB(b, h) ((4 + (b) * 2 + (h)) * HTB)
#define PG8_STAGE(bufoff, gbase, voff) do { _Pragma("unroll") for (int _i = 0; _i < 2; ++_i) \
        __builtin_amdgcn_global_load_lds((const unsigned*)((const char*)(gbase) + (voff)[_i]), (PG8_LAS unsigned*)(lds + (bufoff) + ldsw + _i * 8192), 16, 0, 0); } while (0)
#define PG8_LDA(dst, b, h) do { _Pragma("unroll") for (int m = 0; m < 4; ++m) _Pragma("unroll") for (int k = 0; k < 2; ++k) dst[m][k] = *(const PG8_LAS bf16x8*)(lds + PG8_SA(b, h) + aoff + m * 2048 + k * 1024); } while (0)
#define PG8_LDB(dst, b, h) do { _Pragma("unroll") for (int n = 0; n < 2; ++n) _Pragma("unroll") for (int k = 0; k < 2; ++k) dst[n][k] = *(const PG8_LAS bf16x8*)(lds + PG8_SB(b, h) + boff + n * 2048 + k * 1024); } while (0)
#define PG8_MMA(ai, bj, At, Bt) do { __builtin_amdgcn_s_setprio(1); _Pragma("unroll") for (int m = 0; m < 4; ++m) _Pragma("unroll") for (int n = 0; n < 2; ++n) _Pragma("unroll") for (int k = 0; k < 2; ++k) \
        acc[ai][bj][m][n] = __builtin_amdgcn_mfma_f32_16x16x32_bf16(Bt[n][k], At[m][k], acc[ai][bj][m][n], 0, 0, 0); __builtin_amdgcn_s_setprio(0); } while (0)
#define PG8_WAIT_V(n) asm volatile("s_waitcnt vmcnt(" #n ")" ::: "memory")
#define PG8_WAIT_L(n) asm volatile("s_waitcnt lgkmcnt(" #n ")" ::: "memory")
#define PG8_BAR __builtin_amdgcn_s_barrier()
#define PG8_SCHED __builtin_amdgcn_sched_barrier(0)
    Unit cur, nxt; int ui = 0;
    if (!S.next(0, cur)) return;
    f32x4 acc[2][2][4][2];
#pragma unroll
    for (int a = 0; a < 2; ++a)
#pragma unroll
        for (int b = 0; b < 2; ++b)
#pragma unroll
            for (int m = 0; m < 4; ++m)
#pragma unroll
                for (int n = 0; n < 2; ++n) acc[a][b][m][n] = (f32x4){0.f, 0.f, 0.f, 0.f};
    bf16x8 At[4][2], B0[2][2], B1[2][2];
    const char* cA = (const char*)g.A + (size_t)cur.pm * tstep; const char* cB = (const char*)g.Bt + (size_t)cur.pn * tstep;
    S.a_ready(cur);
    if constexpr (SP2) {
        PG8_STAGE(PG8_SB(0, 0), cB, voffB); PG8_STAGE(PG8_SB(0, 1), cB + hstep, voffB); PG8_STAGE(PG8_SA(0, 0), cA, voffA); PG8_STAGE(PG8_SA(0, 1), cA + hstep, voffA);
        if (wr == 1) PG8_BAR;
        PG8_WAIT_V(2); PG8_BAR;
        PG8_STAGE(PG8_SB(1, 0), cB + kstep, voffB); PG8_STAGE(PG8_SA(1, 0), cA + kstep, voffA); PG8_STAGE(PG8_SB(1, 1), cB + hstep + kstep, voffB);
        PG8_WAIT_V(6); PG8_BAR;
    } else {
        PG8_STAGE(PG8_SB(0, 0), cB, voffB); PG8_STAGE(PG8_SA(0, 0), cA, voffA); PG8_STAGE(PG8_SB(0, 1), cB + hstep, voffB); PG8_STAGE(PG8_SA(0, 1), cA + hstep, voffA);
        if (wr == 1) PG8_BAR;
        PG8_WAIT_V(4); PG8_BAR;
        PG8_STAGE(PG8_SB(1, 0), cB + kstep, voffB); PG8_STAGE(PG8_SA(1, 0), cA + kstep, voffA); PG8_STAGE(PG8_SB(1, 1), cB + hstep + kstep, voffB);
        PG8_WAIT_V(6); PG8_BAR;
    }
    for (;;) {
        const bool has_next = S.next(ui + 1, nxt);
        const char* nA = has_next ? (const char*)g.A + (size_t)nxt.pm * tstep : cA; const char* nB = has_next ? (const char*)g.Bt + (size_t)nxt.pn * tstep : cB;
        for (int t = 0; t < nt; t += 2) {
            const bool last = (t == nt - 2);
            const char* a1 = cA + (size_t)(t + 1) * kstep;
            const char* a2 = last ? nA : cA + (size_t)(t + 2) * kstep; const char* b2 = last ? nB : cB + (size_t)(t + 2) * kstep;
            const char* a3 = a2 + kstep; const char* b3 = b2 + kstep;
            if (last && has_next) S.a_ready(nxt);
            if constexpr (SP2) {
            PG8_LDB(B0, 0, 0); PG8_LDB(B1, 0, 1); PG8_SCHED; PG8_LDA(At, 0, 0); PG8_STAGE(PG8_SA(1, 1), a1 + hstep, voffA);
            PG8_WAIT_V(8); PG8_WAIT_L(0); PG8_BAR; PG8_MMA(0, 0, At, B0); PG8_MMA(0, 1, At, B1); PG8_BAR; PG8_SCHED;
            PG8_LDA(At, 0, 1); PG8_STAGE(PG8_SB(0, 0), b2, voffB); PG8_STAGE(PG8_SB(0, 1), b2 + hstep, voffB); PG8_STAGE(PG8_SA(0, 0), a2, voffA);
            PG8_WAIT_V(8); PG8_WAIT_L(0); PG8_BAR; PG8_MMA(1, 0, At, B0); PG8_MMA(1, 1, At, B1); PG8_BAR; PG8_SCHED;
            PG8_LDB(B0, 1, 0); PG8_LDB(B1, 1, 1); PG8_SCHED; PG8_LDA(At, 1, 0); PG8_STAGE(PG8_SA(0, 1), a2 + hstep, voffA);
            PG8_WAIT_V(8); PG8_WAIT_L(0); PG8_BAR; PG8_MMA(0, 0, At, B0); PG8_MMA(0, 1, At, B1); PG8_BAR; PG8_SCHED;
            PG8_LDA(At, 1, 1); PG8_STAGE(PG8_SB(1, 0), b3, voffB); PG8_STAGE(PG8_SB(1, 1), b3 + hstep, voffB); PG8_STAGE(PG8_SA(1, 0), a3, voffA);
            PG8_WAIT_V(8); PG8_WAIT_L(0); PG8_BAR; PG8_MMA(1, 0, At, B0); PG8_MMA(1, 1, At, B1); PG8_BAR; PG8_SCHED;
            } else {
            PG8_LDB(B0, 0, 0); PG8_SCHED; PG8_LDA(At, 0, 0); PG8_STAGE(PG8_SA(1, 1), a1 + hstep, voffA);
            PG8_WAIT_L(8); PG8_BAR; PG8_WAIT_L(0); PG8_MMA(0, 0, At, B0); PG8_BAR; PG8_SCHED;
            PG8_LDB(B1, 0, 1); PG8_STAGE(PG8_SB(0, 0), b2, voffB);
            PG8_BAR; PG8_WAIT_L(0); PG8_MMA(0, 1, At, B1); PG8_BAR;
            PG8_LDA(At, 0, 1); PG8_STAGE(PG8_SA(0, 0), a2, voffA);
            PG8_BAR; PG8_WAIT_L(0); PG8_MMA(1, 0, At, B0); PG8_BAR; PG8_SCHED;
            PG8_STAGE(PG8_SB(0, 1), b2 + hstep, voffB);
            PG8_WAIT_V(6); PG8_BAR; PG8_MMA(1, 1, At, B1); PG8_BAR;
            PG8_LDB(B0, 1, 0); PG8_SCHED; PG8_LDA(At, 1, 0); PG8_STAGE(PG8_SA(0, 1), a2 + hstep, voffA);
            PG8_WAIT_L(8); PG8_BAR; PG8_WAIT_L(0); PG8_MMA(0, 0, At, B0); PG8_BAR; PG8_SCHED;
            PG8_LDB(B1, 1, 1); PG8_STAGE(PG8_SB(1, 0), b3, voffB);
            PG8_BAR; PG8_WAIT_L(0); PG8_MMA(0, 1, At, B1); PG8_BAR;
            PG8_LDA(At, 1, 1); PG8_STAGE(PG8_SA(1, 0), a3, voffA);
            PG8_BAR; PG8_WAIT_L(0); PG8_MMA(1, 0, At, B0); PG8_BAR; PG8_SCHED;
            PG8_STAGE(PG8_SB(1, 1), b3 + hstep, voffB);
            PG8_WAIT_V(6); PG8_BAR; PG8_MMA(1, 1, At, B1); PG8_BAR;
            }
        }
        if constexpr (ALIGN_EPI) { if (wr == 0) PG8_BAR; }
        if constexpr (!Epi::AFTER_DRAIN) { E(acc, cur, wr, wc, fr, fq); S.done(cur); }
        if (!has_next) break;
#pragma unroll
        for (int a = 0; a < 2; ++a)
#pragma unroll
            for (int b = 0; b < 2; ++b)
#pragma unroll
                for (int m = 0; m < 4; ++m)
#pragma unroll
                    for (int n = 0; n < 2; ++n) acc[a][b][m][n] = (f32x4){0.f, 0.f, 0.f, 0.f};
        cur = nxt; cA = nA; cB = nB; ++ui;
        if constexpr (ALIGN_EPI) { if (wr == 1) PG8_BAR; }
    }
    PG8_WAIT_V(0);
    if constexpr (!ALIGN_EPI) { if (wr == 0) PG8_BAR; }
    PG8_BAR;
    if constexpr (Epi::AFTER_DRAIN) { E.fused(acc, cur, wr, wc, fr, fq, lds, wid, lane); S.done(cur); }
#undef PG8_SA
#undef PG8_SB
#undef PG8_STAGE
#undef PG8_LDA
#undef PG8_LDB
#undef PG8_MMA
#undef PG8_WAIT_V
#undef PG8_WAIT_L
#undef PG8_BAR
#undef PG8_SCHED
}
}

struct EpiIn {
  static constexpr bool PERM = false, AFTER_DRAIN = false;
  const Params* pp; int l;
  __device__ __forceinline__ void operator()(f32x4 (&acc)[2][2][4][2], const pg8::Unit& u, int wr, int wc, int fr, int fq) const {
    const Params& p = *pp;
    const int U = u.pn * 4 + wc;
    if (U >= 77) return;
    const int rowb = u.pm * 256 + wr * 64 + fr;
    const int bq = (u.pm * 256) / T, tb = rowb % T;
    bf16_t* dst = nullptr; int ld = 0, col0 = 0; const float* gain = nullptr; bool rope = false, silu = false;
    bf16_t* vt = nullptr;
    if (U < 8) { dst = WSP(bf16_t, OFF_QN); ld = 512; col0 = U * 64; gain = p.nsa_q_norm + l * 64; rope = true; }
    else if (U < 10) { dst = WSP(bf16_t, OFF_KC); ld = 128; col0 = (U - 8) * 64; rope = true; }
    else if (U < 12) { dst = WSP(bf16_t, OFF_VC); ld = 128; col0 = (U - 10) * 64; }
    else if (U < 14) { dst = WSP(bf16_t, OFF_KS); ld = 128; col0 = (U - 12) * 64; gain = p.nsa_k_norm + (l * 3 + 1) * 64; rope = true; }
    else if (U < 16) { vt = WSP(bf16_t, OFF_VST) + (size_t)((bq * 2 + (U - 14)) * 64) * T; }
    else if (U < 18) { dst = WSP(bf16_t, OFF_KW); ld = 128; col0 = (U - 16) * 64; gain = p.nsa_k_norm + (l * 3 + 2) * 64; rope = true; }
    else if (U < 20) { vt = WSP(bf16_t, OFF_VWT) + (size_t)((bq * 2 + (U - 18)) * 64) * T; }
    else if (U < 28) { dst = WSP(bf16_t, OFF_OA); ld = 512; col0 = (U - 20) * 64; silu = true; }
    else if (U < 36) { dst = WSP(bf16_t, OFF_FQ); ld = 512; col0 = (U - 28) * 64; gain = p.fox_q_norm + l * 64; }
    else if (U < 44) { dst = WSP(bf16_t, OFF_FK); ld = 512; col0 = (U - 36) * 64; gain = p.fox_k_norm + l * 64; }
    else if (U < 52) { vt = WSP(bf16_t, OFF_FVT) + (size_t)((bq * 8 + (U - 44)) * 64) * T; }
    else if (U < 60) { dst = WSP(bf16_t, OFF_OB); ld = 512; col0 = (U - 52) * 64; silu = true; }
    else if (U < 68) { dst = WSP(bf16_t, OFF_MQ); ld = 512; col0 = (U - 60) * 64; }
    else if (U < 76) { dst = WSP(bf16_t, OFF_OM); ld = 512; col0 = (U - 68) * 64; silu = true; }
    if (U == 76) {
      float* gate = WSP(float, OFF_GATE);
      float* flog = WSP(float, OFF_FLOG);
#pragma unroll
      for (int ai = 0; ai < 2; ++ai)
#pragma unroll
        for (int m = 0; m < 4; ++m) {
          const size_t row = (size_t)rowb + 128 * ai + 16 * m;
#pragma unroll
          for (int n = 0; n < 2; ++n)
#pragma unroll
            for (int i = 0; i < 4; ++i) {
              const int e = 16 * n + 4 * fq + i;
              const float v = acc[ai][0][m][n][i];
              if (e < 24) gate[row * 24 + e] = sigmoidf_(v);
              else {
                const float xx = v + p.fox_f_bias[l * 8 + (e - 24)];
                flog[row * 8 + (e - 24)] = xx >= 0.f ? -log1pf(expf(-xx)) : xx - log1pf(expf(xx));
              }
            }
        }
      return;
    }
    if (vt) {
#pragma unroll
      for (int ai = 0; ai < 2; ++ai)
#pragma unroll
        for (int m = 0; m < 4; ++m) {
          const int t = tb + 128 * ai + 16 * m;
#pragma unroll
          for (int bj = 0; bj < 2; ++bj)
#pragma unroll
            for (int n = 0; n < 2; ++n) {
              const f32x4 v = acc[ai][bj][m][n];
              const unsigned w0 = cvtpk(v[0], v[1]), w1 = cvtpk(v[2], v[3]);
              bf16_t* q = vt + (size_t)(32 * bj + 16 * n + 4 * fq) * T + t;
              q[0] = (bf16_t)(w0 & 0xffffu); q[T] = (bf16_t)(w0 >> 16); q[2 * (size_t)T] = (bf16_t)(w1 & 0xffffu); q[3 * (size_t)T] = (bf16_t)(w1 >> 16);
            }
        }
      return;
    }
    const float* ropetab = WSP(float, OFF_ROPE);
    f32x4 gv[2][2];
    if (gain) {
#pragma unroll
      for (int bj = 0; bj < 2; ++bj)
#pragma unroll
        for (int n = 0; n < 2; ++n) gv[bj][n] = *(const f32x4*)(gain + 32 * bj + 16 * n + 4 * fq);
    }
#pragma unroll
    for (int ai = 0; ai < 2; ++ai)
#pragma unroll
      for (int m = 0; m < 4; ++m) {
        f32x4 v[2][2];
#pragma unroll
        for (int bj = 0; bj < 2; ++bj)
#pragma unroll
          for (int n = 0; n < 2; ++n) v[bj][n] = acc[ai][bj][m][n];
        const int row = rowb + 128 * ai + 16 * m;
        if (gain) {
          float ss = 0.f;
#pragma unroll
          for (int bj = 0; bj < 2; ++bj)
#pragma unroll
            for (int n = 0; n < 2; ++n)
#pragma unroll
              for (int i = 0; i < 4; ++i) ss += v[bj][n][i] * v[bj][n][i];
          ss += __shfl_xor(ss, 16);
          ss += __shfl_xor(ss, 32);
          const float rstd = rsqrtf(ss * (1.0f / 64.0f) + EPS);
#pragma unroll
          for (int bj = 0; bj < 2; ++bj)
#pragma unroll
            for (int n = 0; n < 2; ++n) v[bj][n] = v[bj][n] * rstd * gv[bj][n];
        }
        if (rope) {
          const int pos = row & (T - 1);
#pragma unroll
          for (int n = 0; n < 2; ++n) {
            const f32x4* tp = (const f32x4*)(ropetab + ((size_t)pos * 32 + 16 * n + 4 * fq) * 2);
            const f32x4 t0 = tp[0], t1 = tp[1];
            const float cs[4] = {t0[0], t0[2], t1[0], t1[2]}, sn[4] = {t0[1], t0[3], t1[1], t1[3]};
#pragma unroll
            for (int i = 0; i < 4; ++i) {
              const float y1 = v[0][n][i], y2 = v[1][n][i];
              v[0][n][i] = y1 * cs[i] - y2 * sn[i];
              v[1][n][i] = y2 * cs[i] + y1 * sn[i];
            }
          }
        }
#pragma unroll
        for (int bj = 0; bj < 2; ++bj)
#pragma unroll
          for (int n = 0; n < 2; ++n) {
            f32x4 y = v[bj][n];
            if (silu) {
#pragma unroll
              for (int i = 0; i < 4; ++i) y[i] = siluf_(y[i]);
            }
            u32x2 w = {cvtpk(y[0], y[1]), cvtpk(y[2], y[3])};
            *(u32x2*)(dst + (size_t)row * ld + col0 + 32 * bj + 16 * n + 4 * fq) = w;
          }
      }
  }
};
struct EpiMemKV {
  static constexpr bool PERM = false, AFTER_DRAIN = false;
  const Params* pp;
  __device__ __forceinline__ void operator()(f32x4 (&acc)[2][2][4][2], const pg8::Unit& u, int wr, int wc, int fr, int fq) const {
    const Params& p = *pp;
    const int U = u.pn * 4 + wc;
    const int rowb = u.pm * 256 + wr * 64 + fr;
#pragma unroll
    for (int ai = 0; ai < 2; ++ai)
#pragma unroll
      for (int m = 0; m < 4; ++m) {
        const int row = rowb + 128 * ai + 16 * m;
#pragma unroll
        for (int bj = 0; bj < 2; ++bj)
#pragma unroll
          for (int n = 0; n < 2; ++n) {
            const f32x4 v = acc[ai][bj][m][n];
            const unsigned w0 = cvtpk(v[0], v[1]), w1 = cvtpk(v[2], v[3]);
            const int e = 32 * bj + 16 * n + 4 * fq;
            if (U < 8) {
              u32x2 w = {w0, w1};
              *(u32x2*)(WSP(bf16_t, OFF_MK) + (size_t)row * 512 + U * 64 + e) = w;
            } else {
              const int col = (U - 8) * 64 + e, h = col >> 7, d = col & 127, b = row >> 8, mm = row & 255;
              bf16_t* q = WSP(bf16_t, OFF_MVT) + (size_t)((b * 4 + h) * 128 + d) * 256 + mm;
              q[0] = (bf16_t)(w0 & 0xffffu); q[256] = (bf16_t)(w0 >> 16); q[512] = (bf16_t)(w1 & 0xffffu); q[768] = (bf16_t)(w1 >> 16);
            }
          }
      }
  }
};
struct EpiGate {
  static constexpr bool PERM = false, AFTER_DRAIN = false;
  bf16_t* G;
  __device__ __forceinline__ void operator()(f32x4 (&acc)[2][2][4][2], const pg8::Unit& u, int wr, int wc, int fr, int fq) const {
    const int br = u.pn >> 2, colt = (u.pn & 3) * 256 + wc * 32 + 4 * fq;
    bf16_t* base = G + (size_t)br * M * 1024;
    const int rowb = u.pm * 256 + wr * 64 + fr;
#pragma unroll
    for (int ai = 0; ai < 2; ++ai)
#pragma unroll
      for (int m = 0; m < 4; ++m) {
        bf16_t* rp = base + (size_t)(rowb + 128 * ai + 16 * m) * 1024 + colt;
#pragma unroll
        for (int bj = 0; bj < 2; ++bj)
#pragma unroll
          for (int n = 0; n < 2; ++n) {
            const f32x4 v = acc[ai][bj][m][n];
            u32x2 w = {cvtpk(sigmoidf_(v[0]), sigmoidf_(v[1])), cvtpk(sigmoidf_(v[2]), sigmoidf_(v[3]))};
            *(u32x2*)(rp + 128 * bj + 16 * n) = w;
          }
      }
  }
};
struct EpiBranch {
  static constexpr bool PERM = false, AFTER_DRAIN = false;
  const bf16_t* G; bf16_t* Uo; int first;
  __device__ __forceinline__ void operator()(f32x4 (&acc)[2][2][4][2], const pg8::Unit& u, int wr, int wc, int fr, int fq) const {
    const int colt = u.pn * 256 + wc * 32 + 4 * fq;
    const int rowb = u.pm * 256 + wr * 64 + fr;
#pragma unroll
    for (int ai = 0; ai < 2; ++ai)
#pragma unroll
      for (int m = 0; m < 4; ++m) {
        const size_t ro = (size_t)(rowb + 128 * ai + 16 * m) * 1024 + colt;
#pragma unroll
        for (int bj = 0; bj < 2; ++bj)
#pragma unroll
          for (int n = 0; n < 2; ++n) {
            const f32x4 v = acc[ai][bj][m][n];
            const size_t off = ro + 128 * bj + 16 * n;
            const u32x2 gw = *(const u32x2*)(G + off);
            float y0 = v[0] * bflo(gw[0]), y1 = v[1] * bfhi(gw[0]), y2 = v[2] * bflo(gw[1]), y3 = v[3] * bfhi(gw[1]);
            if (!first) {
              const u32x2 uw = *(const u32x2*)(Uo + off);
              y0 += bflo(uw[0]); y1 += bfhi(uw[0]); y2 += bflo(uw[1]); y3 += bfhi(uw[1]);
            }
            u32x2 w = {cvtpk(y0, y1), cvtpk(y2, y3)};
            *(u32x2*)(Uo + off) = w;
          }
      }
  }
};
struct EpiOut {
  static constexpr bool PERM = false, AFTER_DRAIN = false;
  const float* xin; float* xout;
  __device__ __forceinline__ void operator()(f32x4 (&acc)[2][2][4][2], const pg8::Unit& u, int wr, int wc, int fr, int fq) const {
    const int colt = u.pn * 256 + wc * 32 + 4 * fq;
    const int rowb = u.pm * 256 + wr * 64 + fr;
#pragma unroll
    for (int ai = 0; ai < 2; ++ai)
#pragma unroll
      for (int m = 0; m < 4; ++m) {
        const size_t ro = (size_t)(rowb + 128 * ai + 16 * m) * 1024 + colt;
#pragma unroll
        for (int bj = 0; bj < 2; ++bj)
#pragma unroll
          for (int n = 0; n < 2; ++n) {
            const size_t off = ro + 128 * bj + 16 * n;
            const f32x4 xv = *(const f32x4*)(xin + off);
            *(f32x4*)(xout + off) = xv + acc[ai][bj][m][n];
          }
      }
  }
};
template <class Epi>
__device__ __forceinline__ void run_gemm(PG8_LAS unsigned char* lds, const bf16_t* A, const bf16_t* Bt, int Mr, int Nc, int K, const Epi& E) {
  pg8::Gemm g{A, Bt, Mr, Nc, K};
  pg8::StaticOrder S;
  S.init(Mr, Nc, (int)gridDim.x, (int)blockIdx.x);
  pg8::gemm_phase<Epi, pg8::StaticOrder, true, true>(lds, g, S, E);
}

__device__ __forceinline__ int map_in(int n) {
  const int i = n >> 6, c = n & 63;
  if (i < 20) return n;
  if (i < 28) return 1304 + (n - 1280);
  if (i < 52) return 1816 + (n - 1792);
  if (i < 60) return 3360 + (n - 3328);
  if (i < 68) return 3872 + (n - 3840);
  if (i < 76) return 4384 + (n - 4352);
  if (i == 76) return c < 24 ? 1280 + c : (c < 32 ? 3352 + (c - 24) : -1);
  return -1;
}
__device__ void transpose_tile(const float* __restrict__ src, int ld_src, int k0, int n0, bf16_t* __restrict__ dst,
                               int Kdim, int maptype, int srccol0, float* tile) {
  const int tid = tidx();
  for (int e = tid; e < 4096; e += NTHREADS) {
    const int kk = e >> 6, nn = e & 63;
    int nlog = n0 + nn;
    if (maptype) { const int w = nlog & 255; nlog = (nlog & ~255) + (((w & 127) >> 5) << 6) + (((w >> 7) << 5) | (w & 31)); }
    const int sc = (maptype == 1) ? map_in(nlog) : srccol0 + nlog;
    tile[kk * 65 + nn] = sc >= 0 ? src[(size_t)(k0 + kk) * ld_src + sc] : 0.f;
  }
  __syncthreads();
  for (int e = tid; e < 2048; e += NTHREADS) {
    const int nn = e >> 5, kp = e & 31;
    const float a = tile[(2 * kp) * 65 + nn], b = tile[(2 * kp + 1) * 65 + nn];
    *(unsigned*)(dst + (size_t)(n0 + nn) * Kdim + k0 + 2 * kp) = cvtpk(a, b);
  }
  __syncthreads();
}
__device__ void rmsnorm_rows(const float* __restrict__ x, const float* __restrict__ gain, bf16_t* __restrict__ dst,
                             int row_begin, int nrows) {
  const int wave = tidx() >> 6, lane = tidx() & 63;
  for (int rr = wave; rr < nrows; rr += NWAVES) {
    const size_t row = (size_t)row_begin + rr;
    const float* xp = x + row * 1024;
    f32x4 v[4];
    float ss = 0.f;
#pragma unroll
    for (int i = 0; i < 4; ++i) {
      v[i] = *(const f32x4*)(xp + lane * 4 + 256 * i);
      ss += v[i][0] * v[i][0] + v[i][1] * v[i][1] + v[i][2] * v[i][2] + v[i][3] * v[i][3];
    }
    ss = wave_sum(ss);
    const float rstd = rsqrtf(ss * (1.0f / 1024.0f) + EPS);
#pragma unroll
    for (int i = 0; i < 4; ++i) {
      const f32x4 gv = *(const f32x4*)(gain + lane * 4 + 256 * i);
      const f32x4 y = v[i] * rstd * gv;
      u32x2 w = {cvtpk(y[0], y[1]), cvtpk(y[2], y[3])};
      *(u32x2*)(dst + row * 1024 + lane * 4 + 256 * i) = w;
    }
  }
}
__device__ void phase_prep(const Params& p, int l, float* smem) {
  const int tid = tidx();
  constexpr int NT_TR = 3076, NT_H = 512, NT_MEMN = 16, NT_C1 = 2, NT_ROPE = 512;
  const int total = NT_TR + NT_H + NT_MEMN + NT_C1 + (l == 0 ? NT_ROPE : 0);
  if (l == 0 && blockIdx.x == 0 && tid < 64) WSP(unsigned, OFF_CTL)[tid] = 0u;
  const float* xin = (l == 0) ? p.x : p.out;
  for (int u0 = blockIdx.x; u0 < total; u0 += gridDim.x) {
    int u = u0;
    if (u < NT_TR) {
      const float* src; int ld, kt, nt, Kd, mt = 0, c0 = 0; bf16_t* dst;
      if (u < 1280) { kt = u / 80; nt = u % 80; src = p.w_in + (size_t)l * 1024 * 7968; ld = 7968; Kd = 1024; dst = WSP(bf16_t, OFF_W_IN); mt = 1; }
      else if ((u -= 1280) < 768) { kt = u / 48; nt = u % 48; src = p.w_in + (size_t)l * 1024 * 7968; ld = 7968; Kd = 1024; dst = WSP(bf16_t, OFF_W_G); c0 = 4896; }
      else if ((u -= 768) < 256) { kt = u / 16; nt = u % 16; src = p.w_mem_kv + (size_t)l * 1024 * 1024; ld = 1024; Kd = 1024; dst = WSP(bf16_t, OFF_W_MKV); mt = 2; }
      else if ((u -= 256) < 384) { const int br = u / 128, uu = u % 128; kt = uu / 16; nt = uu % 16;
        src = (br == 0 ? p.w_branch_a : br == 1 ? p.w_branch_b : p.w_branch_m) + (size_t)l * 512 * 1024; ld = 1024; Kd = 512; dst = WSP(bf16_t, OFF_W_BR + (size_t)br * MiB); }
      else if ((u -= 384) < 256) { kt = u / 16; nt = u % 16; src = p.w_out + (size_t)l * 1024 * 1024; ld = 1024; Kd = 1024; dst = WSP(bf16_t, OFF_W_OUT); }
      else if ((u -= 256) < 128) { const int kv = u / 64, uu = u % 64; kt = uu / 2; nt = uu % 2;
        src = (kv ? p.cmp_w1_v : p.cmp_w1_k) + (size_t)l * 2048 * 128; ld = 128; Kd = 2048; dst = WSP(bf16_t, OFF_W1 + (size_t)kv * 512 * 1024); }
      else { u -= 128; const int kv = u / 2; kt = u % 2; nt = 0;
        src = (kv ? p.cmp_w2_v : p.cmp_w2_k) + (size_t)l * 128 * 64; ld = 64; Kd = 128; dst = WSP(bf16_t, OFF_W2 + (size_t)kv * 64 * 1024); }
      transpose_tile(src, ld, kt * 64, nt * 64, dst, Kd, mt, c0, smem);
    } else if ((u -= NT_TR) < NT_H) {
      rmsnorm_rows(xin, p.norm_g + l * 1024, WSP(bf16_t, OFF_H), u * 64, 64);
    } else if ((u -= NT_H) < NT_MEMN) {
      rmsnorm_rows(p.mem, p.mem_norm_g + l * 1024, WSP(bf16_t, OFF_MEMN), u * 64, 64);
    } else if ((u -= NT_MEMN) < NT_C1) {
      const float* pe = (u ? p.cmp_pe_v : p.cmp_pe_k) + (size_t)l * 2048;
      const float* w1 = (u ? p.cmp_w1_v : p.cmp_w1_k) + (size_t)l * 2048 * 128;
      constexpr int NPART = NTHREADS / 128, KPER = 2048 / NPART;
      const int n = tid & 127, part = tid >> 7;
      float s = 0.f;
      for (int kk = part * KPER; kk < part * KPER + KPER; ++kk) s += pe[kk] * w1[(size_t)kk * 128 + n];
      smem[part * 128 + n] = s;
      __syncthreads();
      if (tid < 128) { float tot = 0.f; for (int q = 0; q < NPART; ++q) tot += smem[q * 128 + tid]; WSP(float, OFF_C1)[u * 128 + tid] = tot; }
      __syncthreads();
    } else {
      u -= NT_C1;
      for (int e = tid; e < 512; e += NTHREADS) {
        const int idx = u * 512 + e, pos = idx >> 5, f = idx & 31;
        const float ang = (float)pos * c_inv_freq[f];
        const double a = (double)ang;
        const double k = rint(a * 0.15915494309189535);
        const float rr = (float)(a - k * 6.283185307179586);
        float2 cs; cs.x = __cosf(rr); cs.y = __sinf(rr);
        WSP(float2, OFF_ROPE)[idx] = cs;
      }
    }
  }
}

__device__ void compress_unit(const Params& p, int l, int u) {
  const int lane = tidx() & 63, r = lane & 15, g4 = lane >> 4;
  const int kv = u >> 6, rem = u & 63, b = rem >> 4, grp = (rem >> 3) & 1, it = rem & 7, i0 = it * 64;
  const bf16_t* src = WSP(bf16_t, kv ? OFF_VC : OFF_KC);
  const bf16_t* w1t = WSP(bf16_t, OFF_W1 + (size_t)kv * 512 * 1024);
  const bf16_t* w2t = WSP(bf16_t, OFF_W2 + (size_t)kv * 64 * 1024);
  const float* c1 = WSP(float, OFF_C1) + kv * 128;
  const bf16_t* arow[4];
#pragma unroll
  for (int mt = 0; mt < 4; ++mt) {
    int i = i0 + 16 * mt + r;
    if (i > 510) i = 510;
    arow[mt] = src + ((size_t)b * T + 16 * i) * 128 + grp * 64 + g4 * 8;
  }
  f32x4 acc[4][8];
#pragma unroll
  for (int a = 0; a < 4; ++a)
#pragma unroll
    for (int c = 0; c < 8; ++c) acc[a][c] = (f32x4){0.f, 0.f, 0.f, 0.f};
  const bf16_t* bp = w1t + (size_t)r * 2048 + g4 * 8;
  for (int k0 = 0; k0 < 2048; k0 += 32) {
    const int pp = k0 >> 6, d = k0 & 63;
    bf16x8 af[4], bf[8];
#pragma unroll
    for (int mt = 0; mt < 4; ++mt) af[mt] = *(const bf16x8*)(arow[mt] + (size_t)pp * 128 + d);
#pragma unroll
    for (int nt = 0; nt < 8; ++nt) bf[nt] = *(const bf16x8*)(bp + (size_t)nt * 16 * 2048 + k0);
#pragma unroll
    for (int mt = 0; mt < 4; ++mt)
#pragma unroll
      for (int nt = 0; nt < 8; ++nt) acc[mt][nt] = mfma16(bf[nt], af[mt], acc[mt][nt]);
  }
#pragma unroll
  for (int nt = 0; nt < 8; ++nt) {
    const f32x4 cv = *(const f32x4*)(c1 + 16 * nt + 4 * g4);
#pragma unroll
    for (int mt = 0; mt < 4; ++mt)
#pragma unroll
      for (int i = 0; i < 4; ++i) acc[mt][nt][i] = siluf_(acc[mt][nt][i] + cv[i]);
  }
  bf16x8 wf[4][4];
#pragma unroll
  for (int ks = 0; ks < 4; ++ks)
#pragma unroll
    for (int et = 0; et < 4; ++et) {
      const bf16_t* wp = w2t + (size_t)(16 * et + r) * 128 + 32 * ks + 4 * g4;
      const u32x2 lo = *(const u32x2*)wp, hi = *(const u32x2*)(wp + 16);
      u32x4 w = {lo[0], lo[1], hi[0], hi[1]};
      wf[ks][et] = __builtin_bit_cast(bf16x8, w);
    }
  if (kv == 0) {
    const float* gain = p.nsa_k_norm + (size_t)(l * 3 + 0) * 64;
    bf16_t* dst = WSP(bf16_t, OFF_KCMP) + (size_t)((b * 2 + grp) * 512) * 64;
    f32x4 gv[4];
#pragma unroll
    for (int et = 0; et < 4; ++et) gv[et] = *(const f32x4*)(gain + 16 * et + 4 * g4);
#pragma unroll
    for (int mt = 0; mt < 4; ++mt) {
      f32x4 o[4];
#pragma unroll
      for (int et = 0; et < 4; ++et) o[et] = (f32x4){0.f, 0.f, 0.f, 0.f};
#pragma unroll
      for (int ks = 0; ks < 4; ++ks) {
        const bf16x8 xf = pack8(acc[mt][2 * ks], acc[mt][2 * ks + 1]);
#pragma unroll
        for (int et = 0; et < 4; ++et) o[et] = mfma16(wf[ks][et], xf, o[et]);
      }
      float ss = 0.f;
#pragma unroll
      for (int et = 0; et < 4; ++et)
#pragma unroll
        for (int i = 0; i < 4; ++i) ss += o[et][i] * o[et][i];
      ss += __shfl_xor(ss, 16);
      ss += __shfl_xor(ss, 32);
      const float rstd = rsqrtf(ss * (1.0f / 64.0f) + EPS);
      const int i = i0 + 16 * mt + r;
#pragma unroll
      for (int et = 0; et < 4; ++et) {
        f32x4 y = o[et] * rstd * gv[et];
        if (i > 510) y = (f32x4){0.f, 0.f, 0.f, 0.f};
        u32x2 w = {cvtpk(y[0], y[1]), cvtpk(y[2], y[3])};
        *(u32x2*)(dst + (size_t)i * 64 + 16 * et + 4 * g4) = w;
      }
    }
  } else {
    bf16_t* dst = WSP(bf16_t, OFF_VCT) + (size_t)((b * 2 + grp) * 64) * 512;
#pragma unroll
    for (int mt = 0; mt < 4; ++mt) {
      f32x4 o[4];
#pragma unroll
      for (int et = 0; et < 4; ++et) o[et] = (f32x4){0.f, 0.f, 0.f, 0.f};
#pragma unroll
      for (int ks = 0; ks < 4; ++ks) {
        const bf16x8 xf = pack8(acc[mt][2 * ks], acc[mt][2 * ks + 1]);
#pragma unroll
        for (int et = 0; et < 4; ++et) o[et] = mfma16(xf, wf[ks][et], o[et]);
      }
#pragma unroll
      for (int et = 0; et < 4; ++et) {
        f32x4 y = o[et];
        const int ib = i0 + 16 * mt + 4 * g4;
#pragma unroll
        for (int i = 0; i < 4; ++i)
          if (ib + i > 510) y[i] = 0.f;
        u32x2 w = {cvtpk(y[0], y[1]), cvtpk(y[2], y[3])};
        *(u32x2*)(dst + (size_t)(16 * et + r) * 512 + ib) = w;
      }
    }
  }
}
__device__ void cumsum_unit(const Params& p, int u) {
  const int lane = tidx() & 63, b = u >> 3, h = u & 7;
  const float* fl = WSP(float, OFF_FLOG) + ((size_t)b * T) * 8 + h;
  float* fc = WSP(float, OFF_FC) + (size_t)(b * 8 + h) * T;
  const int tb = lane * 128;
  double s = 0.0;
  for (int i = 0; i < 128; ++i) s += (double)fl[(size_t)(tb + i) * 8];
  double incl = s;
#pragma unroll
  for (int o = 1; o < 64; o <<= 1) {
    const double y = __shfl_up(incl, o);
    if (lane >= o) incl += y;
  }
  double run = incl - s;
  for (int i = 0; i < 128; ++i) {
    run += (double)fl[(size_t)(tb + i) * 8];
    fc[tb + i] = (float)run;
  }
}
__device__ void memk_norm_unit(const Params& p, int l, int u) {
  const int lane = tidx() & 63;
  bf16_t* mk = WSP(bf16_t, OFF_MK);
  const float* gain = p.mem_k_norm + l * 128 + (lane & 15) * 8;
  for (int rr = 0; rr < 16; ++rr) {
    bf16_t* ptr = mk + (size_t)(u * 16 + rr) * 512 + lane * 8;
    const u32x4 w = *(const u32x4*)ptr;
    float v[8];
#pragma unroll
    for (int j = 0; j < 4; ++j) { v[2 * j] = bflo(w[j]); v[2 * j + 1] = bfhi(w[j]); }
    float ss = 0.f;
#pragma unroll
    for (int j = 0; j < 8; ++j) ss += v[j] * v[j];
#pragma unroll
    for (int o = 1; o < 16; o <<= 1) ss += __shfl_xor(ss, o);
    const float rstd = rsqrtf(ss * (1.0f / 128.0f) + EPS);
    u32x4 ow;
#pragma unroll
    for (int j = 0; j < 4; ++j) ow[j] = cvtpk(v[2 * j] * rstd * gain[2 * j], v[2 * j + 1] * rstd * gain[2 * j + 1]);
    *(u32x4*)ptr = ow;
  }
}
__device__ void phase_mid(const Params& p, int l) {
  const int wave = tidx() >> 6;
  const int gw = wave * gridDim.x + blockIdx.x, nw = NWAVES * gridDim.x;
  for (int u = gw; u < 128 + 32 + 64; u += nw) {
    if (u < 128) compress_unit(p, l, u);
    else if (u < 160) cumsum_unit(p, u - 128);
    else memk_norm_unit(p, l, u - 160);
  }
}

template <int NCT, int NDK, bool QL = false>
__device__ __forceinline__ void qk_scores(const bf16_t* __restrict__ kbase, int ldk, int key0,
                                          const bf16x8 (&qf)[NCT][NDK], f32x4 (&s)[2][NCT], int lane, const bf16x8* qlds = nullptr) {
  const int r = lane & 15, grp = lane >> 4;
#pragma unroll
  for (int kt = 0; kt < 2; ++kt) {
    const bf16_t* kp = kbase + (size_t)(key0 + 8 * (r >> 2) + 4 * kt + (r & 3)) * ldk + grp * 8;
    bf16x8 kf[NDK];
#pragma unroll
    for (int dk = 0; dk < NDK; ++dk) kf[dk] = *(const bf16x8*)(kp + dk * 32);
#pragma unroll
    for (int ct = 0; ct < NCT; ++ct) {
      f32x4 a = {0.f, 0.f, 0.f, 0.f};
#pragma unroll
      for (int dk = 0; dk < NDK; ++dk) a = mfma16(kf[dk], QL ? qlds[(ct * NDK + dk) * 64 + lane] : qf[ct][dk], a);
      s[kt][ct] = a;
    }
  }
}
template <int NCT, int NDT>
__device__ __forceinline__ void pv_accum(const bf16_t* __restrict__ vt, size_t ldv, int key0,
                                         const f32x4 (&s)[2][NCT], f32x4 (&o)[NDT][NCT], int lane) {
  const int r = lane & 15, grp = lane >> 4;
  bf16x8 pb[NCT];
#pragma unroll
  for (int ct = 0; ct < NCT; ++ct) pb[ct] = pack8(s[0][ct], s[1][ct]);
#pragma unroll
  for (int dt = 0; dt < NDT; ++dt) {
    const bf16x8 vf = *(const bf16x8*)(vt + (size_t)(16 * dt + r) * ldv + key0 + 8 * grp);
#pragma unroll
    for (int ct = 0; ct < NCT; ++ct) o[dt][ct] = mfma16(vf, pb[ct], o[dt][ct]);
  }
}
template <int NCT, int NDT, bool HAS_O>
__device__ __forceinline__ void softmax_update(f32x4 (&s)[2][NCT], float (&m)[NCT], float (&lsum)[NCT],
                                               f32x4 (&o)[NDT][NCT]) {
#pragma unroll
  for (int ct = 0; ct < NCT; ++ct) {
    float mx = fmaxf(fmaxf(fmaxf(s[0][ct][0], s[0][ct][1]), fmaxf(s[0][ct][2], s[0][ct][3])),
                     fmaxf(fmaxf(s[1][ct][0], s[1][ct][1]), fmaxf(s[1][ct][2], s[1][ct][3])));
    mx = fmaxf(mx, __shfl_xor(mx, 16));
    mx = fmaxf(mx, __shfl_xor(mx, 32));
    const float mnew = fmaxf(m[ct], mx);
    const float msafe = (mnew == NEG_INF) ? 0.f : mnew;
    const float alpha = __builtin_amdgcn_exp2f(m[ct] - msafe);
    m[ct] = mnew;
    float ps = 0.f;
#pragma unroll
    for (int kt = 0; kt < 2; ++kt)
#pragma unroll
      for (int i = 0; i < 4; ++i) {
        const float pv = __builtin_amdgcn_exp2f(s[kt][ct][i] - msafe);
        s[kt][ct][i] = pv;
        ps += pv;
      }
    lsum[ct] = lsum[ct] * alpha + ps;
    if (HAS_O) {
#pragma unroll
      for (int dt = 0; dt < NDT; ++dt) o[dt][ct] = o[dt][ct] * alpha;
    }
  }
}
__device__ __forceinline__ float finish_l(float lsum) {
  lsum += __shfl_xor(lsum, 16);
  lsum += __shfl_xor(lsum, 32);
  return lsum > 0.f ? 1.0f / lsum : 0.f;
}

__device__ void nsa_unit(const Params& p, int b, int g, int tq, float* imp, bf16x8* qlds, float* scr, bool st) {
  const int lane0 = tidx() & 63;
  const int t0 = tq * 16;
  const float SC = 0.125f * LOG2E;
  const bf16x8 (&qf)[4][2] = *(const bf16x8 (*)[4][2])nullptr;
#define NSA_SECTION_VARS \
  int lane = lane0; asm volatile("" : "+v"(lane)); \
  const int r = lane & 15, grp = lane >> 4, t = t0 + r; \
  const size_t row = (size_t)b * T + t; \
  const float* gatep = WSP(float, OFF_GATE) + row * 24 + g * 12; (void)gatep; (void)grp; (void)t;
  {
    NSA_SECTION_VARS
#pragma unroll
    for (int ct = 0; ct < 4; ++ct)
#pragma unroll
      for (int dk = 0; dk < 2; ++dk)
        qlds[(ct * 2 + dk) * 64 + lane] = *(const bf16x8*)(WSP(bf16_t, OFF_QN) + row * 512 + (g * 4 + ct) * 64 + dk * 32 + grp * 8);
  }
  f32x4 o[4][4];
  float m[4], lsum[4];
  {
    NSA_SECTION_VARS
    const bf16_t* kc = WSP(bf16_t, OFF_KCMP) + (size_t)((b * 2 + g) * 512) * 64;
    const bf16_t* vct = WSP(bf16_t, OFF_VCT) + (size_t)((b * 2 + g) * 64) * 512;
    const int nblk = (tq + 31) >> 5;
#pragma unroll
    for (int ct = 0; ct < 4; ++ct) { m[ct] = NEG_INF; lsum[ct] = 0.f; }
#pragma unroll 1
    for (int blk = 0; blk < nblk; ++blk) {
      f32x4 s[2][4];
      qk_scores<4, 2, true>(kc, 64, blk * 32, qf, s, lane, qlds);
#pragma unroll
      for (int kt = 0; kt < 2; ++kt)
#pragma unroll
        for (int i = 0; i < 4; ++i) {
          const int n = blk * 32 + 8 * grp + 4 * kt + i;
          const bool ok = (16 * n + 31 <= t);
#pragma unroll
          for (int ct = 0; ct < 4; ++ct) s[kt][ct][i] = ok ? s[kt][ct][i] * SC : NEG_INF;
        }
      softmax_update<4, 4, false>(s, m, lsum, o);
    }
    float invl[4], msafe[4];
#pragma unroll
    for (int ct = 0; ct < 4; ++ct) { invl[ct] = finish_l(lsum[ct]); msafe[ct] = (m[ct] == NEG_INF) ? 0.f : m[ct]; }
    for (int e = lane; e < 16 * 132; e += 64) imp[e] = 0.f;
    __builtin_amdgcn_fence(__ATOMIC_SEQ_CST, "workgroup");
    __builtin_amdgcn_wave_barrier();
#pragma unroll
    for (int dt = 0; dt < 4; ++dt)
#pragma unroll
      for (int ct = 0; ct < 4; ++ct) o[dt][ct] = (f32x4){0.f, 0.f, 0.f, 0.f};
#pragma unroll 1
    for (int blk = 0; blk < nblk; ++blk) {
      f32x4 s[2][4];
      qk_scores<4, 2, true>(kc, 64, blk * 32, qf, s, lane, qlds);
      float pq[2][4];
#pragma unroll
      for (int kt = 0; kt < 2; ++kt)
#pragma unroll
        for (int i = 0; i < 4; ++i) {
          const int n = blk * 32 + 8 * grp + 4 * kt + i;
          const bool ok = (16 * n + 31 <= t);
          float acc_p = 0.f;
#pragma unroll
          for (int ct = 0; ct < 4; ++ct) {
            const float pv = ok ? __builtin_amdgcn_exp2f(s[kt][ct][i] * SC - msafe[ct]) * invl[ct] : 0.f;
            s[kt][ct][i] = pv;
            acc_p += pv;
          }
          pq[kt][i] = acc_p;
        }
      float* ir = imp + r * 132 + blk * 8 + 2 * grp;
      ir[0] += pq[0][0] + pq[0][1] + pq[0][2] + 0.5f * pq[0][3];
      __builtin_amdgcn_fence(__ATOMIC_SEQ_CST, "workgroup");
      __builtin_amdgcn_wave_barrier();
      ir[1] += pq[1][0] + pq[1][1] + pq[1][2] + 0.5f * pq[1][3] + 0.5f * pq[0][3];
      __builtin_amdgcn_fence(__ATOMIC_SEQ_CST, "workgroup");
      __builtin_amdgcn_wave_barrier();
      ir[2] += 0.5f * pq[1][3];
      __builtin_amdgcn_fence(__ATOMIC_SEQ_CST, "workgroup");
      __builtin_amdgcn_wave_barrier();
      pv_accum<4, 4>(vct, 512, blk * 32, s, o, lane);
    }
    f32x4 gt[4];
#pragma unroll
    for (int ct = 0; ct < 4; ++ct) gt[ct][0] = gatep[ct * 3 + 0];
#pragma unroll
    for (int dt = 0; dt < 4; ++dt) {
#pragma unroll
      for (int ct = 0; ct < 4; ++ct)
#pragma unroll
        for (int i = 0; i < 4; ++i) scr[((dt * 4 + ct) * 4 + i) * 64 + lane] = o[dt][ct][i] * gt[ct][0];
      asm volatile("" ::: "memory");
    }
  }
  const int cur = t0 >> 6;
  unsigned long long sel_lo = 0ull, sel_hi = 0ull;
  {
  NSA_SECTION_VARS
  if (cur <= 15) {
    sel_lo = (cur == 63) ? ~0ull : ((1ull << (cur + 1)) - 1ull);
  } else {
    __builtin_amdgcn_fence(__ATOMIC_SEQ_CST, "workgroup");
    __builtin_amdgcn_wave_barrier();
    float v[32];
#pragma unroll
    for (int k = 0; k < 32; ++k) {
      const int j = grp + 4 * k;
      const float x = imp[r * 132 + j];
      v[k] = (j >= 1 && j <= cur - 2) ? x : NEG_INF;
    }
#pragma unroll 1
    for (int round = 0; round < 13; ++round) {
      float best = NEG_INF;
      int bj = 1 << 20;
#pragma unroll
      for (int k = 0; k < 32; ++k) {
        const bool tk = v[k] > best;
        best = tk ? v[k] : best;
        bj = tk ? (grp + 4 * k) : bj;
      }
#pragma unroll
      for (int off = 16; off <= 32; off <<= 1) {
        const float ob = __shfl_xor(best, off);
        const int oj = __shfl_xor(bj, off);
        const bool tk = (ob > best) || (ob == best && oj < bj);
        best = tk ? ob : best;
        bj = tk ? oj : bj;
      }
      if (bj < 64) sel_lo |= 1ull << bj; else if (bj < 128) sel_hi |= 1ull << (bj - 64);
#pragma unroll
      for (int k = 0; k < 32; ++k) v[k] = (bj == grp + 4 * k) ? NEG_INF : v[k];
    }
    sel_lo |= 1ull;
    if (cur < 64) sel_lo |= 1ull << cur; else sel_hi |= 1ull << (cur - 64);
    if (cur - 1 < 64) sel_lo |= 1ull << (cur - 1); else sel_hi |= 1ull << (cur - 1 - 64);
  }
  }
  asm volatile("" : "+v"(sel_lo), "+v"(sel_hi));
  {
    NSA_SECTION_VARS
    const bf16_t* ks = WSP(bf16_t, OFF_KS) + ((size_t)b * T) * 128 + g * 64;
    const bf16_t* vst = WSP(bf16_t, OFF_VST) + (size_t)((b * 2 + g) * 64) * T;
#pragma unroll
    for (int ct = 0; ct < 4; ++ct) { m[ct] = NEG_INF; lsum[ct] = 0.f; }
#pragma unroll
    for (int dt = 0; dt < 4; ++dt)
#pragma unroll
      for (int ct = 0; ct < 4; ++ct) o[dt][ct] = (f32x4){0.f, 0.f, 0.f, 0.f};
#pragma unroll 1
    for (int j = 0; j <= cur; ++j) {
      const bool mine = ((j < 64 ? (sel_lo >> j) : (sel_hi >> (j - 64))) & 1ull) != 0ull;
      if (!__any(mine)) continue;
#pragma unroll 1
      for (int half = 0; half < 2; ++half) {
        const int key0 = j * 64 + half * 32;
        f32x4 s[2][4];
        qk_scores<4, 2, true>(ks, 128, key0, qf, s, lane, qlds);
#pragma unroll
        for (int kt = 0; kt < 2; ++kt)
#pragma unroll
          for (int i = 0; i < 4; ++i) {
            const int key = key0 + 8 * grp + 4 * kt + i;
            const bool ok = mine && (key <= t);
#pragma unroll
            for (int ct = 0; ct < 4; ++ct) s[kt][ct][i] = ok ? s[kt][ct][i] * SC : NEG_INF;
          }
        softmax_update<4, 4, true>(s, m, lsum, o);
        pv_accum<4, 4>(vst, T, key0, s, o, lane);
      }
    }
    float sc2[4];
#pragma unroll
    for (int ct = 0; ct < 4; ++ct) sc2[ct] = finish_l(lsum[ct]) * gatep[ct * 3 + 1];
#pragma unroll
    for (int dt = 0; dt < 4; ++dt) {
#pragma unroll
      for (int ct = 0; ct < 4; ++ct)
#pragma unroll
        for (int i = 0; i < 4; ++i) scr[((dt * 4 + ct) * 4 + i) * 64 + lane] += o[dt][ct][i] * sc2[ct];
      asm volatile("" ::: "memory");
    }
  }
  {
    NSA_SECTION_VARS
    const bf16_t* kw = WSP(bf16_t, OFF_KW) + ((size_t)b * T) * 128 + g * 64;
    const bf16_t* vwt = WSP(bf16_t, OFF_VWT) + (size_t)((b * 2 + g) * 64) * T;
#pragma unroll
    for (int ct = 0; ct < 4; ++ct) { m[ct] = NEG_INF; lsum[ct] = 0.f; }
#pragma unroll
    for (int dt = 0; dt < 4; ++dt)
#pragma unroll
      for (int ct = 0; ct < 4; ++ct) o[dt][ct] = (f32x4){0.f, 0.f, 0.f, 0.f};
    int kstart = t0 - 511;
    if (kstart < 0) kstart = 0;
    kstart &= ~31;
#pragma unroll 1
    for (int key0 = kstart; key0 <= t0 + 15; key0 += 32) {
      f32x4 s[2][4];
      qk_scores<4, 2, true>(kw, 128, key0, qf, s, lane, qlds);
#pragma unroll
      for (int kt = 0; kt < 2; ++kt)
#pragma unroll
        for (int i = 0; i < 4; ++i) {
          const int key = key0 + 8 * grp + 4 * kt + i;
          const bool ok = (key <= t) && (key + 512 > t);
#pragma unroll
          for (int ct = 0; ct < 4; ++ct) s[kt][ct][i] = ok ? s[kt][ct][i] * SC : NEG_INF;
        }
      softmax_update<4, 4, true>(s, m, lsum, o);
      pv_accum<4, 4>(vwt, T, key0, s, o, lane);
    }
    float sc2[4];
#pragma unroll
    for (int ct = 0; ct < 4; ++ct) sc2[ct] = finish_l(lsum[ct]) * gatep[ct * 3 + 2];
    bf16_t* oa = WSP(bf16_t, OFF_OA) + row * 512 + g * 256;
#pragma unroll
    for (int dt = 0; dt < 4; ++dt)
#pragma unroll
      for (int ct = 0; ct < 4; ++ct) {
        bf16_t* ptr = oa + ct * 64 + 16 * dt + 4 * grp;
        const u32x2 sw = *(const u32x2*)ptr;
        float val[4];
#pragma unroll
        for (int i = 0; i < 4; ++i) val[i] = scr[((dt * 4 + ct) * 4 + i) * 64 + lane] + o[dt][ct][i] * sc2[ct];
        u32x2 w = {cvtpk(val[0] * bflo(sw[0]), val[1] * bfhi(sw[0])), cvtpk(val[2] * bflo(sw[1]), val[3] * bfhi(sw[1]))};
        if (st) *(u32x2*)ptr = w;
        asm volatile("" ::: "memory");
      }
  }
}
#undef NSA_SECTION_VARS

__device__ void fox_unit(const Params& p, int b, int h, int c, bool st) {
  const int lane = tidx() & 63, r = lane & 15, grp = lane >> 4;
  const int t0 = c * 64;
  const float SC = 0.125f * LOG2E;
  bf16x8 qf[4][2];
  float cq[4];
  const float* fc = WSP(float, OFF_FC) + (size_t)(b * 8 + h) * T;
#pragma unroll
  for (int ct = 0; ct < 4; ++ct) {
    const size_t row = (size_t)b * T + t0 + 16 * ct + r;
#pragma unroll
    for (int dk = 0; dk < 2; ++dk)
      qf[ct][dk] = *(const bf16x8*)(WSP(bf16_t, OFF_FQ) + row * 512 + h * 64 + dk * 32 + grp * 8);
    cq[ct] = fc[t0 + 16 * ct + r] * LOG2E;
  }
  const bf16_t* kb = WSP(bf16_t, OFF_FK) + ((size_t)b * T) * 512 + h * 64;
  const bf16_t* vt = WSP(bf16_t, OFF_FVT) + (size_t)((b * 8 + h) * 64) * T;
  f32x4 o[4][4];
  float m[4], lsum[4];
#pragma unroll
  for (int ct = 0; ct < 4; ++ct) { m[ct] = NEG_INF; lsum[ct] = 0.f; }
#pragma unroll
  for (int dt = 0; dt < 4; ++dt)
#pragma unroll
    for (int ct = 0; ct < 4; ++ct) o[dt][ct] = (f32x4){0.f, 0.f, 0.f, 0.f};
#pragma unroll 1
  for (int key0 = 0; key0 < t0 + 64; key0 += 32) {
    f32x4 s[2][4];
    qk_scores<4, 2>(kb, 512, key0, qf, s, lane);
    const f32x4 ck0 = *(const f32x4*)(fc + key0 + 8 * grp), ck1 = *(const f32x4*)(fc + key0 + 8 * grp + 4);
#pragma unroll
    for (int kt = 0; kt < 2; ++kt)
#pragma unroll
      for (int i = 0; i < 4; ++i) {
        const int key = key0 + 8 * grp + 4 * kt + i;
        const float ck = (kt ? ck1[i] : ck0[i]) * LOG2E;
#pragma unroll
        for (int ct = 0; ct < 4; ++ct) {
          const bool ok = key <= t0 + 16 * ct + r;
          s[kt][ct][i] = ok ? (s[kt][ct][i] * SC + (cq[ct] - ck)) : NEG_INF;
        }
      }
    softmax_update<4, 4, true>(s, m, lsum, o);
    pv_accum<4, 4>(vt, T, key0, s, o, lane);
  }
  float invl[4];
#pragma unroll
  for (int ct = 0; ct < 4; ++ct) invl[ct] = finish_l(lsum[ct]);
#pragma unroll
  for (int ct = 0; ct < 4; ++ct) {
    bf16_t* ob = WSP(bf16_t, OFF_OB) + ((size_t)b * T + t0 + 16 * ct + r) * 512 + h * 64;
#pragma unroll
    for (int dt = 0; dt < 4; ++dt) {
      bf16_t* ptr = ob + 16 * dt + 4 * grp;
      const u32x2 sw = *(const u32x2*)ptr;
      const f32x4 v = o[dt][ct] * invl[ct];
      u32x2 w = {cvtpk(v[0] * bflo(sw[0]), v[1] * bfhi(sw[0])), cvtpk(v[2] * bflo(sw[1]), v[3] * bfhi(sw[1]))};
      if (st) *(u32x2*)ptr = w;
    }
  }
}

__device__ void mem_unit(const Params& p, int l, int b, int h, int t0, bool st) {
  const int lane = tidx() & 63, r = lane & 15, grp = lane >> 4;
  const float SC = 0.08838834764831845f * LOG2E;
  bf16x8 qf[2][4];
  const float* gq = p.mem_q_norm + l * 128;
#pragma unroll
  for (int ct = 0; ct < 2; ++ct) {
    const size_t row = (size_t)b * T + t0 + 16 * ct + r;
    float v[4][8];
    float ss = 0.f;
#pragma unroll
    for (int dk = 0; dk < 4; ++dk) {
      const u32x4 w = *(const u32x4*)(WSP(bf16_t, OFF_MQ) + row * 512 + h * 128 + dk * 32 + grp * 8);
#pragma unroll
      for (int j = 0; j < 4; ++j) { v[dk][2 * j] = bflo(w[j]); v[dk][2 * j + 1] = bfhi(w[j]); }
#pragma unroll
      for (int j = 0; j < 8; ++j) ss += v[dk][j] * v[dk][j];
    }
    ss += __shfl_xor(ss, 16);
    ss += __shfl_xor(ss, 32);
    const float rstd = rsqrtf(ss * (1.0f / 128.0f) + EPS);
#pragma unroll
    for (int dk = 0; dk < 4; ++dk) {
      const f32x4 g0 = *(const f32x4*)(gq + dk * 32 + grp * 8), g1 = *(const f32x4*)(gq + dk * 32 + grp * 8 + 4);
      u32x4 w = {cvtpk(v[dk][0] * rstd * g0[0], v[dk][1] * rstd * g0[1]), cvtpk(v[dk][2] * rstd * g0[2], v[dk][3] * rstd * g0[3]),
                 cvtpk(v[dk][4] * rstd * g1[0], v[dk][5] * rstd * g1[1]), cvtpk(v[dk][6] * rstd * g1[2], v[dk][7] * rstd * g1[3])};
      qf[ct][dk] = __builtin_bit_cast(bf16x8, w);
    }
  }
  const bf16_t* kb = WSP(bf16_t, OFF_MK) + ((size_t)b * 256) * 512 + h * 128;
  const bf16_t* vt = WSP(bf16_t, OFF_MVT) + (size_t)((b * 4 + h) * 128) * 256;
  f32x4 o[8][2];
  float m[2], lsum[2];
#pragma unroll
  for (int ct = 0; ct < 2; ++ct) { m[ct] = NEG_INF; lsum[ct] = 0.f; }
#pragma unroll
  for (int dt = 0; dt < 8; ++dt)
#pragma unroll
    for (int ct = 0; ct < 2; ++ct) o[dt][ct] = (f32x4){0.f, 0.f, 0.f, 0.f};
#pragma unroll 1
  for (int key0 = 0; key0 < 256; key0 += 32) {
    f32x4 s[2][2];
    qk_scores<2, 4>(kb, 512, key0, qf, s, lane);
#pragma unroll
    for (int kt = 0; kt < 2; ++kt)
#pragma unroll
      for (int ct = 0; ct < 2; ++ct) s[kt][ct] = s[kt][ct] * SC;
    softmax_update<2, 8, true>(s, m, lsum, o);
    pv_accum<2, 8>(vt, 256, key0, s, o, lane);
  }
#pragma unroll
  for (int ct = 0; ct < 2; ++ct) {
    const float invl = finish_l(lsum[ct]);
    bf16_t* om = WSP(bf16_t, OFF_OM) + ((size_t)b * T + t0 + 16 * ct + r) * 512 + h * 128;
#pragma unroll
    for (int dt = 0; dt < 8; ++dt) {
      bf16_t* ptr = om + 16 * dt + 4 * grp;
      const u32x2 sw = *(const u32x2*)ptr;
      const f32x4 v = o[dt][ct] * invl;
      u32x2 w = {cvtpk(v[0] * bflo(sw[0]), v[1] * bfhi(sw[0])), cvtpk(v[2] * bflo(sw[1]), v[3] * bfhi(sw[1]))};
      if (st) *(u32x2*)ptr = w;
    }
  }
}

__device__ void phase_attn(const Params& p, int l, float* smem, bool st, int cidx) {
  const int wave = tidx() >> 6, lane = tidx() & 63;
  float* imp = smem + wave * 2112;
  bf16x8* qlds = (bf16x8*)((char*)smem + 69632 + wave * 8192);
  float* scr = WSP(float, OFF_SCR) + (size_t)(blockIdx.x * NWAVES + wave) * 4096;
  unsigned* ctr = WSP(unsigned, OFF_CTL) + cidx;
  constexpr int NUNITS = 128 * 96;
  for (;;) {
    int u = 0;
    if (lane == 0) u = (int)atomicAdd(ctr, 1u);
    u = __builtin_amdgcn_readfirstlane(u);
    if (u >= NUNITS) break;
    const int s = u / 96, rr = u % 96, c = 127 - s;
    if (rr < 32) fox_unit(p, rr >> 3, rr & 7, c, st);
    else if (rr < 64) { const int q = rr - 32, bg = q >> 2, sub = q & 3; nsa_unit(p, bg >> 1, bg & 1, 4 * c + sub, imp, qlds, scr, st); }
    else { const int q = rr - 64, bh = q >> 1, half = q & 1; mem_unit(p, l, bh >> 2, bh & 3, 64 * c + 32 * half, st); }
  }
}

__global__ void __launch_bounds__(NTHREADS) hybrid_megakernel(Params p) {
  cg::grid_group grid = cg::this_grid();
  extern __shared__ __attribute__((aligned(16))) unsigned char dynlds[];
  float* smem = (float*)dynlds;
  PG8_LAS unsigned char* glds = (PG8_LAS unsigned char*)dynlds;
  for (int l = 0; l < 4; ++l) {
    phase_prep(p, l, smem);
    grid.sync();
    {
      EpiIn E{&p, l};
      run_gemm(glds, WSP(bf16_t, OFF_H), WSP(bf16_t, OFF_W_IN), M, 5120, 1024, E);
      EpiMemKV E2{&p};
      run_gemm(glds, WSP(bf16_t, OFF_MEMN), WSP(bf16_t, OFF_W_MKV), 1024, 1024, 1024, E2);
    }
    grid.sync();
    phase_mid(p, l);
    grid.sync();
    phase_attn(p, l, smem, true, l);
    grid.sync();
    {
      EpiGate E{WSP(bf16_t, OFF_G)};
      run_gemm(glds, WSP(bf16_t, OFF_H), WSP(bf16_t, OFF_W_G), M, 3072, 1024, E);
    }
    grid.sync();
    {
      EpiBranch Ea{WSP(bf16_t, OFF_G), WSP(bf16_t, OFF_U), 1};
      run_gemm(glds, WSP(bf16_t, OFF_OA), WSP(bf16_t, OFF_W_BR), M, 1024, 512, Ea);
      EpiBranch Eb{WSP(bf16_t, OFF_G) + (size_t)M * 1024, WSP(bf16_t, OFF_U), 0};
      run_gemm(glds, WSP(bf16_t, OFF_OB), WSP(bf16_t, OFF_W_BR + MiB), M, 1024, 512, Eb);
      EpiBranch Ec{WSP(bf16_t, OFF_G) + (size_t)2 * M * 1024, WSP(bf16_t, OFF_U), 0};
      run_gemm(glds, WSP(bf16_t, OFF_OM), WSP(bf16_t, OFF_W_BR + 2 * MiB), M, 1024, 512, Ec);
    }
    grid.sync();
    {
      EpiOut E{l == 0 ? p.x : p.out, p.out};
      run_gemm(glds, WSP(bf16_t, OFF_U), WSP(bf16_t, OFF_W_OUT), M, 1024, 1024, E);
    }
    grid.sync();
  }
}

extern "C" void kernel_launch(void* const* d_in, const int* in_sizes, int n_in, void* d_out, int out_size, void* d_ws,
                              size_t ws_size, hipStream_t stream) {
  static int grid_blocks = 0;
  if (!grid_blocks) {
    int dev = 0, cus = 0, per_cu = 0;
    (void)hipGetDevice(&dev);
    (void)hipDeviceGetAttribute(&cus, hipDeviceAttributeMultiprocessorCount, dev);
    if (hipFuncSetAttribute((const void*)hybrid_megakernel, hipFuncAttributeMaxDynamicSharedMemorySize, LDS_BYTES) != hipSuccess)
      fprintf(stderr, "hipFuncSetAttribute(dynamic LDS %d) failed\n", LDS_BYTES);
    (void)hipOccupancyMaxActiveBlocksPerMultiprocessor(&per_cu, hybrid_megakernel, NTHREADS, LDS_BYTES);
    (void)hipGetLastError();
    grid_blocks = cus;
    if (grid_blocks > 256) grid_blocks = 256;
    if (ws_size < OFF_SCR + (size_t)32 * MiB) fprintf(stderr, "workspace too small: %zu\n", ws_size);
  }
  Params p{};
  const float** pp = (const float**)&p;
  for (int i = 0; i < 23; ++i) pp[i] = (const float*)d_in[i];
  p.out = (float*)d_out;
  p.ws = (char*)d_ws;
  void* args[] = {&p};
  hipError_t e = hipLaunchCooperativeKernel((void*)hybrid_megakernel, dim3(grid_blocks), dim3(NTHREADS), args, LDS_BYTES, stream);
  if (e != hipSuccess) fprintf(stderr, "cooperative launch failed: %s (grid %d)\n", hipGetErrorString(e), grid_blocks);
}
```

```cpp
#include <hip/hip_runtime.h>
#include <hip/hip_cooperative_groups.h>
#include <stdint.h>
#include <cstdio>
namespace cg = cooperative_groups;


typedef unsigned short bf16_t;
typedef short bf16x8 __attribute__((ext_vector_type(8)));
typedef float f32x4 __attribute__((ext_vector_type(4)));
typedef unsigned u32x2 __attribute__((ext_vector_type(2)));
typedef unsigned u32x4 __attribute__((ext_vector_type(4)));
typedef float f32x2_t __attribute__((ext_vector_type(2)));
typedef __bf16 bf16x2_t __attribute__((ext_vector_type(2)));

constexpr int NB = 4, T = 8192, M = NB * T;
constexpr int NTHREADS = 512, NWAVES = NTHREADS / 64;
constexpr int LDS_BYTES = 147456;
constexpr float EPS = 1e-6f;
constexpr float LOG2E = 1.4426950408889634f;
#define NEG_INF (-__builtin_inff())

constexpr size_t MiB = 1u << 20;
constexpr size_t OFF_CTL = 0;
constexpr size_t OFF_ROPE = 1 * MiB;
constexpr size_t OFF_W_IN = 3 * MiB;
constexpr size_t OFF_W_G = 13 * MiB;
constexpr size_t OFF_W_MKV = 19 * MiB;
constexpr size_t OFF_W_BR = 21 * MiB;
constexpr size_t OFF_W_OUT = 24 * MiB;
constexpr size_t OFF_W1 = 26 * MiB;
constexpr size_t OFF_W2 = 27 * MiB;
constexpr size_t OFF_C1 = 27 * MiB + 256 * 1024;
constexpr size_t OFF_MEMN = 28 * MiB;
constexpr size_t OFF_MK = 30 * MiB;
constexpr size_t OFF_MVT = 31 * MiB;
constexpr size_t OFF_H = 32 * MiB;
constexpr size_t OFF_U = OFF_H;
constexpr size_t OFF_OA = 96 * MiB;
constexpr size_t OFF_OB = 128 * MiB;
constexpr size_t OFF_OM = 160 * MiB;
constexpr size_t OFF_QN = 192 * MiB;
constexpr size_t OFF_G = 192 * MiB;
constexpr size_t OFF_KC = 224 * MiB;
constexpr size_t OFF_VC = 232 * MiB;
constexpr size_t OFF_KS = 240 * MiB;
constexpr size_t OFF_VST = 248 * MiB;
constexpr size_t OFF_KW = 256 * MiB;
constexpr size_t OFF_VWT = 264 * MiB;
constexpr size_t OFF_FQ = 272 * MiB;
constexpr size_t OFF_FK = 304 * MiB;
constexpr size_t OFF_FVT = 336 * MiB;
constexpr size_t OFF_MQ = 368 * MiB;
constexpr size_t OFF_GATE = 400 * MiB;
constexpr size_t OFF_FLOG = 403 * MiB;
constexpr size_t OFF_FC = 404 * MiB;
constexpr size_t OFF_KCMP = 405 * MiB;
constexpr size_t OFF_VCT = 405 * MiB + 512 * 1024;
constexpr size_t OFF_SCR = 406 * MiB;

struct Params {
  const float *x, *mem, *norm_g, *mem_norm_g, *w_in, *nsa_q_norm, *nsa_k_norm, *cmp_pe_k, *cmp_w1_k, *cmp_w2_k,
      *cmp_pe_v, *cmp_w1_v, *cmp_w2_v, *fox_q_norm, *fox_k_norm, *fox_f_bias, *mem_q_norm, *mem_k_norm, *w_mem_kv,
      *w_branch_a, *w_branch_b, *w_branch_m, *w_out;
  float* out;
  char* ws;
};
#define WSP(TYPE, off) ((TYPE*)(p.ws + (off)))

__constant__ float c_inv_freq[32] = {
    1.000000000e+00f, 7.498942018e-01f, 5.623413324e-01f, 4.216965139e-01f, 3.162277639e-01f, 2.371373773e-01f,
    1.778279394e-01f, 1.333521456e-01f, 1.000000015e-01f, 7.498942316e-02f, 5.623413250e-02f, 4.216964915e-02f,
    3.162277490e-02f, 2.371373773e-02f, 1.778279431e-02f, 1.333521400e-02f, 9.999999776e-03f, 7.498942316e-03f,
    5.623413250e-03f, 4.216964822e-03f, 3.162277630e-03f, 2.371373819e-03f, 1.778279431e-03f, 1.333521446e-03f,
    1.000000047e-03f, 7.498941850e-04f, 5.623413017e-04f, 4.216965172e-04f, 3.162277571e-04f, 2.371373703e-04f,
    1.778279402e-04f, 1.333521504e-04f};

__device__ __forceinline__ int tidx() { int t = threadIdx.x; asm volatile("" : "+v"(t)); return t; }
__device__ __forceinline__ unsigned cvtpk(float lo, float hi) {
  f32x2_t v = {lo, hi};
  bf16x2_t b = __builtin_convertvector(v, bf16x2_t);
  return __builtin_bit_cast(unsigned, b);
}
__device__ __forceinline__ float bf2f(unsigned short v) { return __uint_as_float(((unsigned)v) << 16); }
__device__ __forceinline__ float bflo(unsigned w) { return __uint_as_float(w << 16); }
__device__ __forceinline__ float bfhi(unsigned w) { return __uint_as_float(w & 0xffff0000u); }
__device__ __forceinline__ f32x4 mfma16(bf16x8 a, bf16x8 b, f32x4 c) {
  return __builtin_amdgcn_mfma_f32_16x16x32_bf16(a, b, c, 0, 0, 0);
}
__device__ __forceinline__ bf16x8 pack8(f32x4 a, f32x4 b) {
  u32x4 w = {cvtpk(a[0], a[1]), cvtpk(a[2], a[3]), cvtpk(b[0], b[1]), cvtpk(b[2], b[3])};
  return __builtin_bit_cast(bf16x8, w);
}
__device__ __forceinline__ float sigmoidf_(float v) { return 1.0f / (1.0f + __expf(-v)); }
__device__ __forceinline__ float siluf_(float v) { return v / (1.0f + __expf(-v)); }
__device__ __forceinline__ float wave_sum(float v) {
#pragma unroll
  for (int o = 1; o < 64; o <<= 1) v += __shfl_xor(v, o);
  return v;
}

namespace pg8 {
#define PG8_LAS __attribute__((address_space(3)))
typedef unsigned short bf16_t;
typedef short bf16x8 __attribute__((ext_vector_type(8)));
typedef float f32x4 __attribute__((ext_vector_type(4)));
typedef unsigned u32x4 __attribute__((ext_vector_type(4)));
constexpr int BM = 256, BK = 64, HALF = 128, HTB = HALF * BK * 2  , STAGE_BYTES = 8 * HTB, NXCD = 8, WGM = 8;

__host__ __device__ __forceinline__ int lds_byte(int r, int c) { const int st = (r >> 4) * 2 + (c >> 5), rr = r & 15, cc = c & 31, ob = rr * 64 + cc * 2; return st * 1024 + (ob ^ (((ob >> 9) & 1) << 5)); }
__host__ __device__ __forceinline__ void stage_rc(int b, int& R, int& C) { const int st = b / 1024, sb = b % 1024, swz = sb ^ (((sb >> 9) & 1) << 5); R = (st >> 1) * 16 + swz / 64; C = (st & 1) * 32 + (swz % 64) / 2; }
__host__ __device__ __forceinline__ int perm32(int rho) { const int n = rho >> 4, i = rho & 15; return 8 * (i >> 2) + 4 * n + (i & 3); }

struct Unit { int pm, pn; };
struct Gemm { const bf16_t* A; const bf16_t* Bt; int M, N, K; };

struct StaticOrder {
    int nM, nN, nwg, G, c;
    __host__ __device__ void init(int M, int N, int G_, int c_) { nM = M / BM; nN = N / BM; nwg = nM * nN; G = G_; c = c_; }
    __host__ __device__ bool next(int i, Unit& u) const {
        const long L = (long)i * G + c; if (L >= nwg) return false;
        int wgid = (int)L; { const int q = nwg / NXCD, r = nwg % NXCD, xcd = wgid % NXCD, off = wgid / NXCD; wgid = (xcd < r ? xcd * (q + 1) : r * (q + 1) + (xcd - r) * q) + off; }
        const int nig = WGM * nN, gid = wgid / nig, fm = gid * WGM, gsz = (nM - fm) < WGM ? (nM - fm) : WGM;
        u.pm = fm + ((wgid % nig) % gsz); u.pn = (wgid % nig) / gsz; return true;
    }
    __device__ __forceinline__ void a_ready(const Unit&) const {}
    __device__ __forceinline__ void done(const Unit&) const {}
};
__device__ __forceinline__ unsigned cvt_pk_bf16(float lo, float hi) { unsigned r; asm volatile("v_cvt_pk_bf16_f32 %0, %1, %2" : "=v"(r) : "v"(lo), "v"(hi)); return r; }
template <class Epi, class Sched, bool ALIGN_EPI = false, bool SP2 = false>
__device__ __forceinline__ void gemm_phase(PG8_LAS unsigned char* lds, const Gemm g, const Sched& S, const Epi& E) {
    const int tid = tidx(), wid = __builtin_amdgcn_readfirstlane(tid >> 6), lane = tid & 63, wr = wid >> 2, wc = wid & 3, fr = lane & 15, fq = lane >> 4;
    const int K = g.K, nt = K / BK;
    unsigned voffA[2], voffB[2];
#pragma unroll
    for (int i = 0; i < 2; ++i) { int R, C; stage_rc(tid * 16 + i * 8192, R, C); const int Rb = Epi::PERM ? ((R & ~31) + perm32(R & 31)) : R;
        voffA[i] = (unsigned)(R * K + C) * 2u; voffB[i] = (unsigned)(Rb * K + C) * 2u; }
    const size_t kstep = (size_t)(BK * 2);
    const size_t hstep = (size_t)HALF * K * 2;
    const size_t tstep = 2 * hstep;
    const unsigned ldsw = (unsigned)wid * 1024u;
    const int aoff = lds_byte(wr * 64 + fr, fq * 8), boff = lds_byte(wc * 32 + fr, fq * 8);
#define PG8_SA(b, h) (((b) * 2 + (h)) * HTB)
#define PG8_SB(b, h) ((4 + (b) * 2 + (h)) * HTB)
#define PG8_STAGE(bufoff, gbase, voff) do { _Pragma("unroll") for (int _i = 0; _i < 2; ++_i) \
        __builtin_amdgcn_global_load_lds((const unsigned*)((const char*)(gbase) + (voff)[_i]), (PG8_LAS unsigned*)(lds + (bufoff) + ldsw + _i * 8192), 16, 0, 0); } while (0)
#define PG8_LDA(dst, b, h) do { _Pragma("unroll") for (int m = 0; m < 4; ++m) _Pragma("unroll") for (int k = 0; k < 2; ++k) dst[m][k] = *(const PG8_LAS bf16x8*)(lds + PG8_SA(b, h) + aoff + m * 2048 + k * 1024); } while (0)
#define PG8_LDB(dst, b, h) do { _Pragma("unroll") for (int n = 0; n < 2; ++n) _Pragma("unroll") for (int k = 0; k < 2; ++k) dst[n][k] = *(const PG8_LAS bf16x8*)(lds + PG8_SB(b, h) + boff + n * 2048 + k * 1024); } while (0)
#define PG8_MMA(ai, bj, At, Bt) do { __builtin_amdgcn_s_setprio(1); _Pragma("unroll") for (int m = 0; m < 4; ++m) _Pragma("unroll") for (int n = 0; n < 2; ++n) _Pragma("unroll") for (int k = 0; k < 2; ++k) \
        acc[ai][bj][m][n] = __builtin_amdgcn_mfma_f32_16x16x32_bf16(Bt[n][k], At[m][k], acc[ai][bj][m][n], 0, 0, 0); __builtin_amdgcn_s_setprio(0); } while (0)
#define PG8_WAIT_V(n) asm volatile("s_waitcnt vmcnt(" #n ")" ::: "memory")
#define PG8_WAIT_L(n) asm volatile("s_waitcnt lgkmcnt(" #n ")" ::: "memory")
#define PG8_BAR __builtin_amdgcn_s_barrier()
#define PG8_SCHED __builtin_amdgcn_sched_barrier(0)
    Unit cur, nxt; int ui = 0;
    if (!S.next(0, cur)) return;
    f32x4 acc[2][2][4][2];
#pragma unroll
    for (int a = 0; a < 2; ++a)
#pragma unroll
        for (int b = 0; b < 2; ++b)
#pragma unroll
            for (int m = 0; m < 4; ++m)
#pragma unroll
                for (int n = 0; n < 2; ++n) acc[a][b][m][n] = (f32x4){0.f, 0.f, 0.f, 0.f};
    bf16x8 At[4][2], B0[2][2], B1[2][2];
    const char* cA = (const char*)g.A + (size_t)cur.pm * tstep; const char* cB = (const char*)g.Bt + (size_t)cur.pn * tstep;
    S.a_ready(cur);
    if constexpr (SP2) {
        PG8_STAGE(PG8_SB(0, 0), cB, voffB); PG8_STAGE(PG8_SB(0, 1), cB + hstep, voffB); PG8_STAGE(PG8_SA(0, 0), cA, voffA); PG8_STAGE(PG8_SA(0, 1), cA + hstep, voffA);
        if (wr == 1) PG8_BAR;
        PG8_WAIT_V(2); PG8_BAR;
        PG8_STAGE(PG8_SB(1, 0), cB + kstep, voffB); PG8_STAGE(PG8_SA(1, 0), cA + kstep, voffA); PG8_STAGE(PG8_SB(1, 1), cB + hstep + kstep, voffB);
        PG8_WAIT_V(6); PG8_BAR;
    } else {
        PG8_STAGE(PG8_SB(0, 0), cB, voffB); PG8_STAGE(PG8_SA(0, 0), cA, voffA); PG8_STAGE(PG8_SB(0, 1), cB + hstep, voffB); PG8_STAGE(PG8_SA(0, 1), cA + hstep, voffA);
        if (wr == 1) PG8_BAR;
        PG8_WAIT_V(4); PG8_BAR;
        PG8_STAGE(PG8_SB(1, 0), cB + kstep, voffB); PG8_STAGE(PG8_SA(1, 0), cA + kstep, voffA); PG8_STAGE(PG8_SB(1, 1), cB + hstep + kstep, voffB);
        PG8_WAIT_V(6); PG8_BAR;
    }
    for (;;) {
        const bool has_next = S.next(ui + 1, nxt);
        const char* nA = has_next ? (const char*)g.A + (size_t)nxt.pm * tstep : cA; const char* nB = has_next ? (const char*)g.Bt + (size_t)nxt.pn * tstep : cB;
        for (int t = 0; t < nt; t += 2) {
            const bool last = (t == nt - 2);
            const char* a1 = cA + (size_t)(t + 1) * kstep;
            const char* a2 = last ? nA : cA + (size_t)(t + 2) * kstep; const char* b2 = last ? nB : cB + (size_t)(t + 2) * kstep;
            const char* a3 = a2 + kstep; const char* b3 = b2 + kstep;
            if (last && has_next) S.a_ready(nxt);
            if constexpr (SP2) {
            PG8_LDB(B0, 0, 0); PG8_LDB(B1, 0, 1); PG8_SCHED; PG8_LDA(At, 0, 0); PG8_STAGE(PG8_SA(1, 1), a1 + hstep, voffA);
            PG8_WAIT_V(8); PG8_WAIT_L(0); PG8_BAR; PG8_MMA(0, 0, At, B0); PG8_MMA(0, 1, At, B1); PG8_BAR; PG8_SCHED;
            PG8_LDA(At, 0, 1); PG8_STAGE(PG8_SB(0, 0), b2, voffB); PG8_STAGE(PG8_SB(0, 1), b2 + hstep, voffB); PG8_STAGE(PG8_SA(0, 0), a2, voffA);
            PG8_WAIT_V(8); PG8_WAIT_L(0); PG8_BAR; PG8_MMA(1, 0, At, B0); PG8_MMA(1, 1, At, B1); PG8_BAR; PG8_SCHED;
            PG8_LDB(B0, 1, 0); PG8_LDB(B1, 1, 1); PG8_SCHED; PG8_LDA(At, 1, 0); PG8_STAGE(PG8_SA(0, 1), a2 + hstep, voffA);
            PG8_WAIT_V(8); PG8_WAIT_L(0); PG8_BAR; PG8_MMA(0, 0, At, B0); PG8_MMA(0, 1, At, B1); PG8_BAR; PG8_SCHED;
            PG8_LDA(At, 1, 1); PG8_STAGE(PG8_SB(1, 0), b3, voffB); PG8_STAGE(PG8_SB(1, 1), b3 + hstep, voffB); PG8_STAGE(PG8_SA(1, 0), a3, voffA);
            PG8_WAIT_V(8); PG8_WAIT_L(0); PG8_BAR; PG8_MMA(1, 0, At, B0); PG8_MMA(1, 1, At, B1); PG8_BAR; PG8_SCHED;
            } else {
            PG8_LDB(B0, 0, 0); PG8_SCHED; PG8_LDA(At, 0, 0); PG8_STAGE(PG8_SA(1, 1), a1 + hstep, voffA);
            PG8_WAIT_L(8); PG8_BAR; PG8_WAIT_L(0); PG8_MMA(0, 0, At, B0); PG8_BAR; PG8_SCHED;
            PG8_LDB(B1, 0, 1); PG8_STAGE(PG8_SB(0, 0), b2, voffB);
            PG8_BAR; PG8_WAIT_L(0); PG8_MMA(0, 1, At, B1); PG8_BAR;
            PG8_LDA(At, 0, 1); PG8_STAGE(PG8_SA(0, 0), a2, voffA);
            PG8_BAR; PG8_WAIT_L(0); PG8_MMA(1, 0, At, B0); PG8_BAR; PG8_SCHED;
            PG8_STAGE(PG8_SB(0, 1), b2 + hstep, voffB);
            PG8_WAIT_V(6); PG8_BAR; PG8_MMA(1, 1, At, B1); PG8_BAR;
            PG8_LDB(B0, 1, 0); PG8_SCHED; PG8_LDA(At, 1, 0); PG8_STAGE(PG8_SA(0, 1), a2 + hstep, voffA);
            PG8_WAIT_L(8); PG8_BAR; PG8_WAIT_L(0); PG8_MMA(0, 0, At, B0); PG8_BAR; PG8_SCHED;
            PG8_LDB(B1, 1, 1); PG8_STAGE(PG8_SB(1, 0), b3, voffB);
            PG8_BAR; PG8_WAIT_L(0); PG8_MMA(0, 1, At, B1); PG8_BAR;
            PG8_LDA(At, 1, 1); PG8_STAGE(PG8_SA(1, 0), a3, voffA);
            PG8_BAR; PG8_WAIT_L(0); PG8_MMA(1, 0, At, B0); PG8_BAR; PG8_SCHED;
            PG8_STAGE(PG8_SB(1, 1), b3 + hstep, voffB);
            PG8_WAIT_V(6); PG8_BAR; PG8_MMA(1, 1, At, B1); PG8_BAR;
            }
        }
        if constexpr (ALIGN_EPI) { if (wr == 0) PG8_BAR; }
        if constexpr (!Epi::AFTER_DRAIN) { E(acc, cur, wr, wc, fr, fq); S.done(cur); }
        if (!has_next) break;
#pragma unroll
        for (int a = 0; a < 2; ++a)
#pragma unroll
            for (int b = 0; b < 2; ++b)
#pragma unroll
                for (int m = 0; m < 4; ++m)
#pragma unroll
                    for (int n = 0; n < 2; ++n) acc[a][b][m][n] = (f32x4){0.f, 0.f, 0.f, 0.f};
        cur = nxt; cA = nA; cB = nB; ++ui;
        if constexpr (ALIGN_EPI) { if (wr == 1) PG8_BAR; }
    }
    PG8_WAIT_V(0);
    if constexpr (!ALIGN_EPI) { if (wr == 0) PG8_BAR; }
    PG8_BAR;
    if constexpr (Epi::AFTER_DRAIN) { E.fused(acc, cur, wr, wc, fr, fq, lds, wid, lane); S.done(cur); }
#undef PG8_SA
#undef PG8_SB
#undef PG8_STAGE
#undef PG8_LDA
#undef PG8_LDB
#undef PG8_MMA
#undef PG8_WAIT_V
#undef PG8_WAIT_L
#undef PG8_BAR
#undef PG8_SCHED
}
}

struct EpiIn {
  static constexpr bool PERM = false, AFTER_DRAIN = false;
  const Params* pp; int l;
  __device__ __forceinline__ void operator()(f32x4 (&acc)[2][2][4][2], const pg8::Unit& u, int wr, int wc, int fr, int fq) const {
    const Params& p = *pp;
    const int U = u.pn * 4 + wc;
    if (U >= 77) return;
    const int rowb = u.pm * 256 + wr * 64 + fr;
    const int bq = (u.pm * 256) / T, tb = rowb % T;
    bf16_t* dst = nullptr; int ld = 0, col0 = 0; const float* gain = nullptr; bool rope = false, silu = false;
    bf16_t* vt = nullptr;
    if (U < 8) { dst = WSP(bf16_t, OFF_QN); ld = 512; col0 = U * 64; gain = p.nsa_q_norm + l * 64; rope = true; }
    else if (U < 10) { dst = WSP(bf16_t, OFF_KC); ld = 128; col0 = (U - 8) * 64; rope = true; }
    else if (U < 12) { dst = WSP(bf16_t, OFF_VC); ld = 128; col0 = (U - 10) * 64; }
    else if (U < 14) { dst = WSP(bf16_t, OFF_KS); ld = 128; col0 = (U - 12) * 64; gain = p.nsa_k_norm + (l * 3 + 1) * 64; rope = true; }
    else if (U < 16) { vt = WSP(bf16_t, OFF_VST) + (size_t)((bq * 2 + (U - 14)) * 64) * T; }
    else if (U < 18) { dst = WSP(bf16_t, OFF_KW); ld = 128; col0 = (U - 16) * 64; gain = p.nsa_k_norm + (l * 3 + 2) * 64; rope = true; }
    else if (U < 20) { vt = WSP(bf16_t, OFF_VWT) + (size_t)((bq * 2 + (U - 18)) * 64) * T; }
    else if (U < 28) { dst = WSP(bf16_t, OFF_OA); ld = 512; col0 = (U - 20) * 64; silu = true; }
    else if (U < 36) { dst = WSP(bf16_t, OFF_FQ); ld = 512; col0 = (U - 28) * 64; gain = p.fox_q_norm + l * 64; }
    else if (U < 44) { dst = WSP(bf16_t, OFF_FK); ld = 512; col0 = (U - 36) * 64; gain = p.fox_k_norm + l * 64; }
    else if (U < 52) { vt = WSP(bf16_t, OFF_FVT) + (size_t)((bq * 8 + (U - 44)) * 64) * T; }
    else if (U < 60) { dst = WSP(bf16_t, OFF_OB); ld = 512; col0 = (U - 52) * 64; silu = true; }
    else if (U < 68) { dst = WSP(bf16_t, OFF_MQ); ld = 512; col0 = (U - 60) * 64; }
    else if (U < 76) { dst = WSP(bf16_t, OFF_OM); ld = 512; col0 = (U - 68) * 64; silu = true; }
    if (U == 76) {
      float* gate = WSP(float, OFF_GATE);
      float* flog = WSP(float, OFF_FLOG);
#pragma unroll
      for (int ai = 0; ai < 2; ++ai)
#pragma unroll
        for (int m = 0; m < 4; ++m) {
          const size_t row = (size_t)rowb + 128 * ai + 16 * m;
#pragma unroll
          for (int n = 0; n < 2; ++n)
#pragma unroll
            for (int i = 0; i < 4; ++i) {
              const int e = 16 * n + 4 * fq + i;
              const float v = acc[ai][0][m][n][i];
              if (e < 24) gate[row * 24 + e] = sigmoidf_(v);
              else {
                const float xx = v + p.fox_f_bias[l * 8 + (e - 24)];
                flog[row * 8 + (e - 24)] = xx >= 0.f ? -log1pf(expf(-xx)) : xx - log1pf(expf(xx));
              }
            }
        }
      return;
    }
    if (vt) {
#pragma unroll
      for (int ai = 0; ai < 2; ++ai)
#pragma unroll
        for (int m = 0; m < 4; ++m) {
          const int t = tb + 128 * ai + 16 * m;
#pragma unroll
          for (int bj = 0; bj < 2; ++bj)
#pragma unroll
            for (int n = 0; n < 2; ++n) {
              const f32x4 v = acc[ai][bj][m][n];
              const unsigned w0 = cvtpk(v[0], v[1]), w1 = cvtpk(v[2], v[3]);
              bf16_t* q = vt + (size_t)(32 * bj + 16 * n + 4 * fq) * T + t;
              q[0] = (bf16_t)(w0 & 0xffffu); q[T] = (bf16_t)(w0 >> 16); q[2 * (size_t)T] = (bf16_t)(w1 & 0xffffu); q[3 * (size_t)T] = (bf16_t)(w1 >> 16);
            }
        }
      return;
    }
    const float* ropetab = WSP(float, OFF_ROPE);
    f32x4 gv[2][2];
    if (gain) {
#pragma unroll
      for (int bj = 0; bj < 2; ++bj)
#pragma unroll
        for (int n = 0; n < 2; ++n) gv[bj][n] = *(const f32x4*)(gain + 32 * bj + 16 * n + 4 * fq);
    }
#pragma unroll
    for (int ai = 0; ai < 2; ++ai)
#pragma unroll
      for (int m = 0; m < 4; ++m) {
        f32x4 v[2][2];
#pragma unroll
        for (int bj = 0; bj < 2; ++bj)
#pragma unroll
          for (int n = 0; n < 2; ++n) v[bj][n] = acc[ai][bj][m][n];
        const int row = rowb + 128 * ai + 16 * m;
        if (gain) {
          float ss = 0.f;
#pragma unroll
          for (int bj = 0; bj < 2; ++bj)
#pragma unroll
            for (int n = 0; n < 2; ++n)
#pragma unroll
              for (int i = 0; i < 4; ++i) ss += v[bj][n][i] * v[bj][n][i];
          ss += __shfl_xor(ss, 16);
          ss += __shfl_xor(ss, 32);
          const float rstd = rsqrtf(ss * (1.0f / 64.0f) + EPS);
#pragma unroll
          for (int bj = 0; bj < 2; ++bj)
#pragma unroll
            for (int n = 0; n < 2; ++n) v[bj][n] = v[bj][n] * rstd * gv[bj][n];
        }
        if (rope) {
          const int pos = row & (T - 1);
#pragma unroll
          for (int n = 0; n < 2; ++n) {
            const f32x4* tp = (const f32x4*)(ropetab + ((size_t)pos * 32 + 16 * n + 4 * fq) * 2);
            const f32x4 t0 = tp[0], t1 = tp[1];
            const float cs[4] = {t0[0], t0[2], t1[0], t1[2]}, sn[4] = {t0[1], t0[3], t1[1], t1[3]};
#pragma unroll
            for (int i = 0; i < 4; ++i) {
              const float y1 = v[0][n][i], y2 = v[1][n][i];
              v[0][n][i] = y1 * cs[i] - y2 * sn[i];
              v[1][n][i] = y2 * cs[i] + y1 * sn[i];
            }
          }
        }
#pragma unroll
        for (int bj = 0; bj < 2; ++bj)
#pragma unroll
          for (int n = 0; n < 2; ++n) {
            f32x4 y = v[bj][n];
            if (silu) {
#pragma unroll
              for (int i = 0; i < 4; ++i) y[i] = siluf_(y[i]);
            }
            u32x2 w = {cvtpk(y[0], y[1]), cvtpk(y[2], y[3])};
            *(u32x2*)(dst + (size_t)row * ld + col0 + 32 * bj + 16 * n + 4 * fq) = w;
          }
      }
  }
};
struct EpiMemKV {
  static constexpr bool PERM = false, AFTER_DRAIN = false;
  const Params* pp;
  __device__ __forceinline__ void operator()(f32x4 (&acc)[2][2][4][2], const pg8::Unit& u, int wr, int wc, int fr, int fq) const {
    const Params& p = *pp;
    const int U = u.pn * 4 + wc;
    const int rowb = u.pm * 256 + wr * 64 + fr;
#pragma unroll
    for (int ai = 0; ai < 2; ++ai)
#pragma unroll
      for (int m = 0; m < 4; ++m) {
        const int row = rowb + 128 * ai + 16 * m;
#pragma unroll
        for (int bj = 0; bj < 2; ++bj)
#pragma unroll
          for (int n = 0; n < 2; ++n) {
            const f32x4 v = acc[ai][bj][m][n];
            const unsigned w0 = cvtpk(v[0], v[1]), w1 = cvtpk(v[2], v[3]);
            const int e = 32 * bj + 16 * n + 4 * fq;
            if (U < 8) {
              u32x2 w = {w0, w1};
              *(u32x2*)(WSP(bf16_t, OFF_MK) + (size_t)row * 512 + U * 64 + e) = w;
            } else {
              const int col = (U - 8) * 64 + e, h = col >> 7, d = col & 127, b = row >> 8, mm = row & 255;
              bf16_t* q = WSP(bf16_t, OFF_MVT) + (size_t)((b * 4 + h) * 128 + d) * 256 + mm;
              q[0] = (bf16_t)(w0 & 0xffffu); q[256] = (bf16_t)(w0 >> 16); q[512] = (bf16_t)(w1 & 0xffffu); q[768] = (bf16_t)(w1 >> 16);
            }
          }
      }
  }
};
struct EpiGate {
  static constexpr bool PERM = false, AFTER_DRAIN = false;
  bf16_t* G;
  __device__ __forceinline__ void operator()(f32x4 (&acc)[2][2][4][2], const pg8::Unit& u, int wr, int wc, int fr, int fq) const {
    const int br = u.pn >> 2, colt = (u.pn & 3) * 256 + wc * 32 + 4 * fq;
    bf16_t* base = G + (size_t)br * M * 1024;
    const int rowb = u.pm * 256 + wr * 64 + fr;
#pragma unroll
    for (int ai = 0; ai < 2; ++ai)
#pragma unroll
      for (int m = 0; m < 4; ++m) {
        bf16_t* rp = base + (size_t)(rowb + 128 * ai + 16 * m) * 1024 + colt;
#pragma unroll
        for (int bj = 0; bj < 2; ++bj)
#pragma unroll
          for (int n = 0; n < 2; ++n) {
            const f32x4 v = acc[ai][bj][m][n];
            u32x2 w = {cvtpk(sigmoidf_(v[0]), sigmoidf_(v[1])), cvtpk(sigmoidf_(v[2]), sigmoidf_(v[3]))};
            *(u32x2*)(rp + 128 * bj + 16 * n) = w;
          }
      }
  }
};
struct EpiBranch {
  static constexpr bool PERM = false, AFTER_DRAIN = false;
  const bf16_t* G; bf16_t* Uo; int first;
  __device__ __forceinline__ void operator()(f32x4 (&acc)[2][2][4][2], const pg8::Unit& u, int wr, int wc, int fr, int fq) const {
    const int colt = u.pn * 256 + wc * 32 + 4 * fq;
    const int rowb = u.pm * 256 + wr * 64 + fr;
#pragma unroll
    for (int ai = 0; ai < 2; ++ai)
#pragma unroll
      for (int m = 0; m < 4; ++m) {
        const size_t ro = (size_t)(rowb + 128 * ai + 16 * m) * 1024 + colt;
#pragma unroll
        for (int bj = 0; bj < 2; ++bj)
#pragma unroll
          for (int n = 0; n < 2; ++n) {
            const f32x4 v = acc[ai][bj][m][n];
            const size_t off = ro + 128 * bj + 16 * n;
            const u32x2 gw = *(const u32x2*)(G + off);
            float y0 = v[0] * bflo(gw[0]), y1 = v[1] * bfhi(gw[0]), y2 = v[2] * bflo(gw[1]), y3 = v[3] * bfhi(gw[1]);
            if (!first) {
              const u32x2 uw = *(const u32x2*)(Uo + off);
              y0 += bflo(uw[0]); y1 += bfhi(uw[0]); y2 += bflo(uw[1]); y3 += bfhi(uw[1]);
            }
            u32x2 w = {cvtpk(y0, y1), cvtpk(y2, y3)};
            *(u32x2*)(Uo + off) = w;
          }
      }
  }
};
struct EpiOut {
  static constexpr bool PERM = false, AFTER_DRAIN = false;
  const float* xin; float* xout;
  __device__ __forceinline__ void operator()(f32x4 (&acc)[2][2][4][2], const pg8::Unit& u, int wr, int wc, int fr, int fq) const {
    const int colt = u.pn * 256 + wc * 32 + 4 * fq;
    const int rowb = u.pm * 256 + wr * 64 + fr;
#pragma unroll
    for (int ai = 0; ai < 2; ++ai)
#pragma unroll
      for (int m = 0; m < 4; ++m) {
        const size_t ro = (size_t)(rowb + 128 * ai + 16 * m) * 1024 + colt;
#pragma unroll
        for (int bj = 0; bj < 2; ++bj)
#pragma unroll
          for (int n = 0; n < 2; ++n) {
            const size_t off = ro + 128 * bj + 16 * n;
            const f32x4 xv = *(const f32x4*)(xin + off);
            *(f32x4*)(xout + off) = xv + acc[ai][bj][m][n];
          }
      }
  }
};
template <class Epi>
__device__ __forceinline__ void run_gemm(PG8_LAS unsigned char* lds, const bf16_t* A, const bf16_t* Bt, int Mr, int Nc, int K, const Epi& E) {
  pg8::Gemm g{A, Bt, Mr, Nc, K};
  pg8::StaticOrder S;
  S.init(Mr, Nc, (int)gridDim.x, (int)blockIdx.x);
  pg8::gemm_phase<Epi, pg8::StaticOrder, true, true>(lds, g, S, E);
}

__device__ __forceinline__ int map_in(int n) {
  const int i = n >> 6, c = n & 63;
  if (i < 20) return n;
  if (i < 28) return 1304 + (n - 1280);
  if (i < 52) return 1816 + (n - 1792);
  if (i < 60) return 3360 + (n - 3328);
  if (i < 68) return 3872 + (n - 3840);
  if (i < 76) return 4384 + (n - 4352);
  if (i == 76) return c < 24 ? 1280 + c : (c < 32 ? 3352 + (c - 24) : -1);
  return -1;
}
__device__ void transpose_tile(const float* __restrict__ src, int ld_src, int k0, int n0, bf16_t* __restrict__ dst,
                               int Kdim, int maptype, int srccol0, float* tile) {
  const int tid = tidx();
  for (int e = tid; e < 4096; e += NTHREADS) {
    const int kk = e >> 6, nn = e & 63;
    int nlog = n0 + nn;
    if (maptype) { const int w = nlog & 255; nlog = (nlog & ~255) + (((w & 127) >> 5) << 6) + (((w >> 7) << 5) | (w & 31)); }
    const int sc = (maptype == 1) ? map_in(nlog) : srccol0 + nlog;
    tile[kk * 65 + nn] = sc >= 0 ? src[(size_t)(k0 + kk) * ld_src + sc] : 0.f;
  }
  __syncthreads();
  for (int e = tid; e < 2048; e += NTHREADS) {
    const int nn = e >> 5, kp = e & 31;
    const float a = tile[(2 * kp) * 65 + nn], b = tile[(2 * kp + 1) * 65 + nn];
    *(unsigned*)(dst + (size_t)(n0 + nn) * Kdim + k0 + 2 * kp) = cvtpk(a, b);
  }
  __syncthreads();
}
__device__ void rmsnorm_rows(const float* __restrict__ x, const float* __restrict__ gain, bf16_t* __restrict__ dst,
                             int row_begin, int nrows) {
  const int wave = tidx() >> 6, lane = tidx() & 63;
  for (int rr = wave; rr < nrows; rr += NWAVES) {
    const size_t row = (size_t)row_begin + rr;
    const float* xp = x + row * 1024;
    f32x4 v[4];
    float ss = 0.f;
#pragma unroll
    for (int i = 0; i < 4; ++i) {
      v[i] = *(const f32x4*)(xp + lane * 4 + 256 * i);
      ss += v[i][0] * v[i][0] + v[i][1] * v[i][1] + v[i][2] * v[i][2] + v[i][3] * v[i][3];
    }
    ss = wave_sum(ss);
    const float rstd = rsqrtf(ss * (1.0f / 1024.0f) + EPS);
#pragma unroll
    for (int i = 0; i < 4; ++i) {
      const f32x4 gv = *(const f32x4*)(gain + lane * 4 + 256 * i);
      const f32x4 y = v[i] * rstd * gv;
      u32x2 w = {cvtpk(y[0], y[1]), cvtpk(y[2], y[3])};
      *(u32x2*)(dst + row * 1024 + lane * 4 + 256 * i) = w;
    }
  }
}
__device__ void phase_prep(const Params& p, int l, float* smem) {
  const int tid = tidx();
  constexpr int NT_TR = 3076, NT_H = 512, NT_MEMN = 16, NT_C1 = 2, NT_ROPE = 512;
  const int total = NT_TR + NT_H + NT_MEMN + NT_C1 + (l == 0 ? NT_ROPE : 0);
  if (l == 0 && blockIdx.x == 0 && tid < 64) WSP(unsigned, OFF_CTL)[tid] = 0u;
  const float* xin = (l == 0) ? p.x : p.out;
  for (int u0 = blockIdx.x; u0 < total; u0 += gridDim.x) {
    int u = u0;
    if (u < NT_TR) {
      const float* src; int ld, kt, nt, Kd, mt = 0, c0 = 0; bf16_t* dst;
      if (u < 1280) { kt = u / 80; nt = u % 80; src = p.w_in + (size_t)l * 1024 * 7968; ld = 7968; Kd = 1024; dst = WSP(bf16_t, OFF_W_IN); mt = 1; }
      else if ((u -= 1280) < 768) { kt = u / 48; nt = u % 48; src = p.w_in + (size_t)l * 1024 * 7968; ld = 7968; Kd = 1024; dst = WSP(bf16_t, OFF_W_G); c0 = 4896; }
      else if ((u -= 768) < 256) { kt = u / 16; nt = u % 16; src = p.w_mem_kv + (size_t)l * 1024 * 1024; ld = 1024; Kd = 1024; dst = WSP(bf16_t, OFF_W_MKV); mt = 2; }
      else if ((u -= 256) < 384) { const int br = u / 128, uu = u % 128; kt = uu / 16; nt = uu % 16;
        src = (br == 0 ? p.w_branch_a : br == 1 ? p.w_branch_b : p.w_branch_m) + (size_t)l * 512 * 1024; ld = 1024; Kd = 512; dst = WSP(bf16_t, OFF_W_BR + (size_t)br * MiB); }
      else if ((u -= 384) < 256) { kt = u / 16; nt = u % 16; src = p.w_out + (size_t)l * 1024 * 1024; ld = 1024; Kd = 1024; dst = WSP(bf16_t, OFF_W_OUT); }
      else if ((u -= 256) < 128) { const int kv = u / 64, uu = u % 64; kt = uu / 2; nt = uu % 2;
        src = (kv ? p.cmp_w1_v : p.cmp_w1_k) + (size_t)l * 2048 * 128; ld = 128; Kd = 2048; dst = WSP(bf16_t, OFF_W1 + (size_t)kv * 512 * 1024); }
      else { u -= 128; const int kv = u / 2; kt = u % 2; nt = 0;
        src = (kv ? p.cmp_w2_v : p.cmp_w2_k) + (size_t)l * 128 * 64; ld = 64; Kd = 128; dst = WSP(bf16_t, OFF_W2 + (size_t)kv * 64 * 1024); }
      transpose_tile(src, ld, kt * 64, nt * 64, dst, Kd, mt, c0, smem);
    } else if ((u -= NT_TR) < NT_H) {
      rmsnorm_rows(xin, p.norm_g + l * 1024, WSP(bf16_t, OFF_H), u * 64, 64);
    } else if ((u -= NT_H) < NT_MEMN) {
      rmsnorm_rows(p.mem, p.mem_norm_g + l * 1024, WSP(bf16_t, OFF_MEMN), u * 64, 64);
    } else if ((u -= NT_MEMN) < NT_C1) {
      const float* pe = (u ? p.cmp_pe_v : p.cmp_pe_k) + (size_t)l * 2048;
      const float* w1 = (u ? p.cmp_w1_v : p.cmp_w1_k) + (size_t)l * 2048 * 128;
      constexpr int NPART = NTHREADS / 128, KPER = 2048 / NPART;
      const int n = tid & 127, part = tid >> 7;
      float s = 0.f;
      for (int kk = part * KPER; kk < part * KPER + KPER; ++kk) s += pe[kk] * w1[(size_t)kk * 128 + n];
      smem[part * 128 + n] = s;
      __syncthreads();
      if (tid < 128) { float tot = 0.f; for (int q = 0; q < NPART; ++q) tot += smem[q * 128 + tid]; WSP(float, OFF_C1)[u * 128 + tid] = tot; }
      __syncthreads();
    } else {
      u -= NT_C1;
      for (int e = tid; e < 512; e += NTHREADS) {
        const int idx = u * 512 + e, pos = idx >> 5, f = idx & 31;
        const float ang = (float)pos * c_inv_freq[f];
        const double a = (double)ang;
        const double k = rint(a * 0.15915494309189535);
        const float rr = (float)(a - k * 6.283185307179586);
        float2 cs; cs.x = __cosf(rr); cs.y = __sinf(rr);
        WSP(float2, OFF_ROPE)[idx] = cs;
      }
    }
  }
}

__device__ void compress_unit(const Params& p, int l, int u) {
  const int lane = tidx() & 63, r = lane & 15, g4 = lane >> 4;
  const int kv = u >> 6, rem = u & 63, b = rem >> 4, grp = (rem >> 3) & 1, it = rem & 7, i0 = it * 64;
  const bf16_t* src = WSP(bf16_t, kv ? OFF_VC : OFF_KC);
  const bf16_t* w1t = WSP(bf16_t, OFF_W1 + (size_t)kv * 512 * 1024);
  const bf16_t* w2t = WSP(bf16_t, OFF_W2 + (size_t)kv * 64 * 1024);
  const float* c1 = WSP(float, OFF_C1) + kv * 128;
  const bf16_t* arow[4];
#pragma unroll
  for (int mt = 0; mt < 4; ++mt) {
    int i = i0 + 16 * mt + r;
    if (i > 510) i = 510;
    arow[mt] = src + ((size_t)b * T + 16 * i) * 128 + grp * 64 + g4 * 8;
  }
  f32x4 acc[4][8];
#pragma unroll
  for (int a = 0; a < 4; ++a)
#pragma unroll
    for (int c = 0; c < 8; ++c) acc[a][c] = (f32x4){0.f, 0.f, 0.f, 0.f};
  const bf16_t* bp = w1t + (size_t)r * 2048 + g4 * 8;
  for (int k0 = 0; k0 < 2048; k0 += 32) {
    const int pp = k0 >> 6, d = k0 & 63;
    bf16x8 af[4], bf[8];
#pragma unroll
    for (int mt = 0; mt < 4; ++mt) af[mt] = *(const bf16x8*)(arow[mt] + (size_t)pp * 128 + d);
#pragma unroll
    for (int nt = 0; nt < 8; ++nt) bf[nt] = *(const bf16x8*)(bp + (size_t)nt * 16 * 2048 + k0);
#pragma unroll
    for (int mt = 0; mt < 4; ++mt)
#pragma unroll
      for (int nt = 0; nt < 8; ++nt) acc[mt][nt] = mfma16(bf[nt], af[mt], acc[mt][nt]);
  }
#pragma unroll
  for (int nt = 0; nt < 8; ++nt) {
    const f32x4 cv = *(const f32x4*)(c1 + 16 * nt + 4 * g4);
#pragma unroll
    for (int mt = 0; mt < 4; ++mt)
#pragma unroll
      for (int i = 0; i < 4; ++i) acc[mt][nt][i] = siluf_(acc[mt][nt][i] + cv[i]);
  }
  bf16x8 wf[4][4];
#pragma unroll
  for (int ks = 0; ks < 4; ++ks)
#pragma unroll
    for (int et = 0; et < 4; ++et) {
      const bf16_t* wp = w2t + (size_t)(16 * et + r) * 128 + 32 * ks + 4 * g4;
      const u32x2 lo = *(const u32x2*)wp, hi = *(const u32x2*)(wp + 16);
      u32x4 w = {lo[0], lo[1], hi[0], hi[1]};
      wf[ks][et] = __builtin_bit_cast(bf16x8, w);
    }
  if (kv == 0) {
    const float* gain = p.nsa_k_norm + (size_t)(l * 3 + 0) * 64;
    bf16_t* dst = WSP(bf16_t, OFF_KCMP) + (size_t)((b * 2 + grp) * 512) * 64;
    f32x4 gv[4];
#pragma unroll
    for (int et = 0; et < 4; ++et) gv[et] = *(const f32x4*)(gain + 16 * et + 4 * g4);
#pragma unroll
    for (int mt = 0; mt < 4; ++mt) {
      f32x4 o[4];
#pragma unroll
      for (int et = 0; et < 4; ++et) o[et] = (f32x4){0.f, 0.f, 0.f, 0.f};
#pragma unroll
      for (int ks = 0; ks < 4; ++ks) {
        const bf16x8 xf = pack8(acc[mt][2 * ks], acc[mt][2 * ks + 1]);
#pragma unroll
        for (int et = 0; et < 4; ++et) o[et] = mfma16(wf[ks][et], xf, o[et]);
      }
      float ss = 0.f;
#pragma unroll
      for (int et = 0; et < 4; ++et)
#pragma unroll
        for (int i = 0; i < 4; ++i) ss += o[et][i] * o[et][i];
      ss += __shfl_xor(ss, 16);
      ss += __shfl_xor(ss, 32);
      const float rstd = rsqrtf(ss * (1.0f / 64.0f) + EPS);
      const int i = i0 + 16 * mt + r;
#pragma unroll
      for (int et = 0; et < 4; ++et) {
        f32x4 y = o[et] * rstd * gv[et];
        if (i > 510) y = (f32x4){0.f, 0.f, 0.f, 0.f};
        u32x2 w = {cvtpk(y[0], y[1]), cvtpk(y[2], y[3])};
        *(u32x2*)(dst + (size_t)i * 64 + 16 * et + 4 * g4) = w;
      }
    }
  } else {
    bf16_t* dst = WSP(bf16_t, OFF_VCT) + (size_t)((b * 2 + grp) * 64) * 512;
#pragma unroll
    for (int mt = 0; mt < 4; ++mt) {
      f32x4 o[4];
#pragma unroll
      for (int et = 0; et < 4; ++et) o[et] = (f32x4){0.f, 0.f, 0.f, 0.f};
#pragma unroll
      for (int ks = 0; ks < 4; ++ks) {
        const bf16x8 xf = pack8(acc[mt][2 * ks], acc[mt][2 * ks + 1]);
#pragma unroll
        for (int et = 0; et < 4; ++et) o[et] = mfma16(xf, wf[ks][et], o[et]);
      }
#pragma unroll
      for (int et = 0; et < 4; ++et) {
        f32x4 y = o[et];
        const int ib = i0 + 16 * mt + 4 * g4;
#pragma unroll
        for (int i = 0; i < 4; ++i)
          if (ib + i > 510) y[i] = 0.f;
        u32x2 w = {cvtpk(y[0], y[1]), cvtpk(y[2], y[3])};
        *(u32x2*)(dst + (size_t)(16 * et + r) * 512 + ib) = w;
      }
    }
  }
}
__device__ void cumsum_unit(const Params& p, int u) {
  const int lane = tidx() & 63, b = u >> 3, h = u & 7;
  const float* fl = WSP(float, OFF_FLOG) + ((size_t)b * T) * 8 + h;
  float* fc = WSP(float, OFF_FC) + (size_t)(b * 8 + h) * T;
  const int tb = lane * 128;
  double s = 0.0;
  for (int i = 0; i < 128; ++i) s += (double)fl[(size_t)(tb + i) * 8];
  double incl = s;
#pragma unroll
  for (int o = 1; o < 64; o <<= 1) {
    const double y = __shfl_up(incl, o);
    if (lane >= o) incl += y;
  }
  double run = incl - s;
  for (int i = 0; i < 128; ++i) {
    run += (double)fl[(size_t)(tb + i) * 8];
    fc[tb + i] = (float)run;
  }
}
__device__ void memk_norm_unit(const Params& p, int l, int u) {
  const int lane = tidx() & 63;
  bf16_t* mk = WSP(bf16_t, OFF_MK);
  const float* gain = p.mem_k_norm + l * 128 + (lane & 15) * 8;
  for (int rr = 0; rr < 16; ++rr) {
    bf16_t* ptr = mk + (size_t)(u * 16 + rr) * 512 + lane * 8;
    const u32x4 w = *(const u32x4*)ptr;
    float v[8];
#pragma unroll
    for (int j = 0; j < 4; ++j) { v[2 * j] = bflo(w[j]); v[2 * j + 1] = bfhi(w[j]); }
    float ss = 0.f;
#pragma unroll
    for (int j = 0; j < 8; ++j) ss += v[j] * v[j];
#pragma unroll
    for (int o = 1; o < 16; o <<= 1) ss += __shfl_xor(ss, o);
    const float rstd = rsqrtf(ss * (1.0f / 128.0f) + EPS);
    u32x4 ow;
#pragma unroll
    for (int j = 0; j < 4; ++j) ow[j] = cvtpk(v[2 * j] * rstd * gain[2 * j], v[2 * j + 1] * rstd * gain[2 * j + 1]);
    *(u32x4*)ptr = ow;
  }
}
__device__ void phase_mid(const Params& p, int l) {
  const int wave = tidx() >> 6;
  const int gw = wave * gridDim.x + blockIdx.x, nw = NWAVES * gridDim.x;
  for (int u = gw; u < 128 + 32 + 64; u += nw) {
    if (u < 128) compress_unit(p, l, u);
    else if (u < 160) cumsum_unit(p, u - 128);
    else memk_norm_unit(p, l, u - 160);
  }
}

template <int NCT, int NDK, bool QL = false>
__device__ __forceinline__ void qk_scores(const bf16_t* __restrict__ kbase, int ldk, int key0,
                                          const bf16x8 (&qf)[NCT][NDK], f32x4 (&s)[2][NCT], int lane, const bf16x8* qlds = nullptr) {
  const int r = lane & 15, grp = lane >> 4;
#pragma unroll
  for (int kt = 0; kt < 2; ++kt) {
    const bf16_t* kp = kbase + (size_t)(key0 + 8 * (r >> 2) + 4 * kt + (r & 3)) * ldk + grp * 8;
    bf16x8 kf[NDK];
#pragma unroll
    for (int dk = 0; dk < NDK; ++dk) kf[dk] = *(const bf16x8*)(kp + dk * 32);
#pragma unroll
    for (int ct = 0; ct < NCT; ++ct) {
      f32x4 a = {0.f, 0.f, 0.f, 0.f};
#pragma unroll
      for (int dk = 0; dk < NDK; ++dk) a = mfma16(kf[dk], QL ? qlds[(ct * NDK + dk) * 64 + lane] : qf[ct][dk], a);
      s[kt][ct] = a;
    }
  }
}
template <int NCT, int NDT>
__device__ __forceinline__ void pv_accum(const bf16_t* __restrict__ vt, size_t ldv, int key0,
                                         const f32x4 (&s)[2][NCT], f32x4 (&o)[NDT][NCT], int lane) {
  const int r = lane & 15, grp = lane >> 4;
  bf16x8 pb[NCT];
#pragma unroll
  for (int ct = 0; ct < NCT; ++ct) pb[ct] = pack8(s[0][ct], s[1][ct]);
#pragma unroll
  for (int dt = 0; dt < NDT; ++dt) {
    const bf16x8 vf = *(const bf16x8*)(vt + (size_t)(16 * dt + r) * ldv + key0 + 8 * grp);
#pragma unroll
    for (int ct = 0; ct < NCT; ++ct) o[dt][ct] = mfma16(vf, pb[ct], o[dt][ct]);
  }
}
template <int NCT, int NDT, bool HAS_O>
__device__ __forceinline__ void softmax_update(f32x4 (&s)[2][NCT], float (&m)[NCT], float (&lsum)[NCT],
                                               f32x4 (&o)[NDT][NCT]) {
#pragma unroll
  for (int ct = 0; ct < NCT; ++ct) {
    float mx = fmaxf(fmaxf(fmaxf(s[0][ct][0], s[0][ct][1]), fmaxf(s[0][ct][2], s[0][ct][3])),
                     fmaxf(fmaxf(s[1][ct][0], s[1][ct][1]), fmaxf(s[1][ct][2], s[1][ct][3])));
    mx = fmaxf(mx, __shfl_xor(mx, 16));
    mx = fmaxf(mx, __shfl_xor(mx, 32));
    const float mnew = fmaxf(m[ct], mx);
    const float msafe = (mnew == NEG_INF) ? 0.f : mnew;
    const float alpha = __builtin_amdgcn_exp2f(m[ct] - msafe);
    m[ct] = mnew;
    float ps = 0.f;
#pragma unroll
    for (int kt = 0; kt < 2; ++kt)
#pragma unroll
      for (int i = 0; i < 4; ++i) {
        const float pv = __builtin_amdgcn_exp2f(s[kt][ct][i] - msafe);
        s[kt][ct][i] = pv;
        ps += pv;
      }
    lsum[ct] = lsum[ct] * alpha + ps;
    if (HAS_O) {
#pragma unroll
      for (int dt = 0; dt < NDT; ++dt) o[dt][ct] = o[dt][ct] * alpha;
    }
  }
}
__device__ __forceinline__ float finish_l(float lsum) {
  lsum += __shfl_xor(lsum, 16);
  lsum += __shfl_xor(lsum, 32);
  return lsum > 0.f ? 1.0f / lsum : 0.f;
}

typedef __attribute__((address_space(3))) unsigned char lds_u8;
constexpr int TILE_ROWB = 144, TILE_HALF = 64 * TILE_ROWB, TILE_STAGE = 2 * TILE_HALF;
struct TileRegs { u32x4 k, v; };
__device__ __forceinline__ void tile_gload(TileRegs& tr, const bf16_t* __restrict__ kbase, int ldk, const bf16_t* __restrict__ vtbase,
                                           size_t ldv, int key0, int tid) {
  const int row = tid >> 3, ch = tid & 7;
  tr.k = *(const u32x4*)(kbase + (size_t)(key0 + row) * ldk + ch * 8);
  tr.v = *(const u32x4*)(vtbase + (size_t)row * ldv + key0 + ch * 8);
}
__device__ __forceinline__ void tile_swrite(const TileRegs& tr, lds_u8* stage, int tid) {
  const int row = tid >> 3, ch = tid & 7;
  *(__attribute__((address_space(3))) u32x4*)(stage + row * TILE_ROWB + ch * 16) = tr.k;
  *(__attribute__((address_space(3))) u32x4*)(stage + TILE_HALF + row * TILE_ROWB + ch * 16) = tr.v;
}
template <int NCT, int NDK, bool QL>
__device__ __forceinline__ void qk_scores_lds(const lds_u8* stage, int hf, const bf16x8 (&qf)[NCT][NDK], f32x4 (&s)[2][NCT], int lane,
                                              const bf16x8* qlds) {
  const int r = lane & 15, grp = lane >> 4;
#pragma unroll
  for (int kt = 0; kt < 2; ++kt) {
    const lds_u8* kp = stage + (32 * hf + 8 * (r >> 2) + 4 * kt + (r & 3)) * TILE_ROWB + grp * 16;
    bf16x8 kf[NDK];
#pragma unroll
    for (int dk = 0; dk < NDK; ++dk) kf[dk] = *(const __attribute__((address_space(3))) bf16x8*)(kp + dk * 64);
#pragma unroll
    for (int ct = 0; ct < NCT; ++ct) {
      f32x4 a = {0.f, 0.f, 0.f, 0.f};
#pragma unroll
      for (int dk = 0; dk < NDK; ++dk) a = mfma16(kf[dk], QL ? qlds[(ct * NDK + dk) * 64 + lane] : qf[ct][dk], a);
      s[kt][ct] = a;
    }
  }
}
template <int NCT, int NDT>
__device__ __forceinline__ void pv_accum_lds(const lds_u8* stage, int hf, const f32x4 (&s)[2][NCT], f32x4 (&o)[NDT][NCT], int lane) {
  const int r = lane & 15, grp = lane >> 4;
  bf16x8 pb[NCT];
#pragma unroll
  for (int ct = 0; ct < NCT; ++ct) pb[ct] = pack8(s[0][ct], s[1][ct]);
#pragma unroll
  for (int dt = 0; dt < NDT; ++dt) {
    const bf16x8 vf = *(const __attribute__((address_space(3))) bf16x8*)(stage + TILE_HALF + (16 * dt + r) * TILE_ROWB + (32 * hf + 8 * grp) * 2);
#pragma unroll
    for (int ct = 0; ct < NCT; ++ct) o[dt][ct] = mfma16(vf, pb[ct], o[dt][ct]);
  }
}
__device__ __forceinline__ int next_bit(unsigned long long lo, unsigned long long hi, int from) {
  if (from < 64) { const unsigned long long mm = lo & (~0ull << from); if (mm) return __ffsll(mm) - 1; from = 64; }
  if (from < 128) { const unsigned long long mm = hi & (~0ull << (from - 64)); if (mm) return 64 + __ffsll(mm) - 1; }
  return 128;
}

__device__ void nsa_wg_unit(const Params& p, int b, int g, int qi, float* imp, bf16x8* qlds, float* scr, lds_u8* tiles, unsigned* misc) {
  const int tid0 = tidx();
  const int wave = __builtin_amdgcn_readfirstlane(tid0 >> 6);
  const int lane0 = tid0 & 63;
  const int tq = qi * 8 + wave;
  const int t0 = tq * 16;
  const float SC = 0.125f * LOG2E;
  const bf16x8 (&qf)[4][2] = *(const bf16x8 (*)[4][2])nullptr;
#define NSA_SECTION_VARS \
  int lane = lane0; asm volatile("" : "+v"(lane)); \
  const int r = lane & 15, grp = lane >> 4, t = t0 + r; \
  const size_t row = (size_t)b * T + t; \
  const float* gatep = WSP(float, OFF_GATE) + row * 24 + g * 12; (void)gatep; (void)grp; (void)t;
  {
    NSA_SECTION_VARS
#pragma unroll
    for (int ct = 0; ct < 4; ++ct)
#pragma unroll
      for (int dk = 0; dk < 2; ++dk)
        qlds[(ct * 2 + dk) * 64 + lane] = *(const bf16x8*)(WSP(bf16_t, OFF_QN) + row * 512 + (g * 4 + ct) * 64 + dk * 32 + grp * 8);
  }
  f32x4 o[4][4];
  float m[4], lsum[4];
  {
    NSA_SECTION_VARS
    const bf16_t* kc = WSP(bf16_t, OFF_KCMP) + (size_t)((b * 2 + g) * 512) * 64;
    const bf16_t* vct = WSP(bf16_t, OFF_VCT) + (size_t)((b * 2 + g) * 64) * 512;
    const int nblk = (tq + 31) >> 5;
#pragma unroll
    for (int ct = 0; ct < 4; ++ct) { m[ct] = NEG_INF; lsum[ct] = 0.f; }
#pragma unroll 1
    for (int blk = 0; blk < nblk; ++blk) {
      f32x4 s[2][4];
      qk_scores<4, 2, true>(kc, 64, blk * 32, qf, s, lane, qlds);
#pragma unroll
      for (int kt = 0; kt < 2; ++kt)
#pragma unroll
        for (int i = 0; i < 4; ++i) {
          const int n = blk * 32 + 8 * grp + 4 * kt + i;
          const bool ok = (16 * n + 31 <= t);
#pragma unroll
          for (int ct = 0; ct < 4; ++ct) s[kt][ct][i] = ok ? s[kt][ct][i] * SC : NEG_INF;
        }
      softmax_update<4, 4, false>(s, m, lsum, o);
    }
    float invl[4], msafe[4];
#pragma unroll
    for (int ct = 0; ct < 4; ++ct) { invl[ct] = finish_l(lsum[ct]); msafe[ct] = (m[ct] == NEG_INF) ? 0.f : m[ct]; }
    for (int e = lane; e < 16 * 132; e += 64) imp[e] = 0.f;
    __builtin_amdgcn_fence(__ATOMIC_SEQ_CST, "workgroup");
    __builtin_amdgcn_wave_barrier();
#pragma unroll
    for (int dt = 0; dt < 4; ++dt)
#pragma unroll
      for (int ct = 0; ct < 4; ++ct) o[dt][ct] = (f32x4){0.f, 0.f, 0.f, 0.f};
#pragma unroll 1
    for (int blk = 0; blk < nblk; ++blk) {
      f32x4 s[2][4];
      qk_scores<4, 2, true>(kc, 64, blk * 32, qf, s, lane, qlds);
      float pq[2][4];
#pragma unroll
      for (int kt = 0; kt < 2; ++kt)
#pragma unroll
        for (int i = 0; i < 4; ++i) {
          const int n = blk * 32 + 8 * grp + 4 * kt + i;
          const bool ok = (16 * n + 31 <= t);
          float acc_p = 0.f;
#pragma unroll
          for (int ct = 0; ct < 4; ++ct) {
            const float pv = ok ? __builtin_amdgcn_exp2f(s[kt][ct][i] * SC - msafe[ct]) * invl[ct] : 0.f;
            s[kt][ct][i] = pv;
            acc_p += pv;
          }
          pq[kt][i] = acc_p;
        }
      float* ir = imp + r * 132 + blk * 8 + 2 * grp;
      ir[0] += pq[0][0] + pq[0][1] + pq[0][2] + 0.5f * pq[0][3];
      __builtin_amdgcn_fence(__ATOMIC_SEQ_CST, "workgroup");
      __builtin_amdgcn_wave_barrier();
      ir[1] += pq[1][0] + pq[1][1] + pq[1][2] + 0.5f * pq[1][3] + 0.5f * pq[0][3];
      __builtin_amdgcn_fence(__ATOMIC_SEQ_CST, "workgroup");
      __builtin_amdgcn_wave_barrier();
      ir[2] += 0.5f * pq[1][3];
      __builtin_amdgcn_fence(__ATOMIC_SEQ_CST, "workgroup");
      __builtin_amdgcn_wave_barrier();
      pv_accum<4, 4>(vct, 512, blk * 32, s, o, lane);
    }
    f32x4 gt[4];
#pragma unroll
    for (int ct = 0; ct < 4; ++ct) gt[ct][0] = gatep[ct * 3 + 0];
#pragma unroll
    for (int dt = 0; dt < 4; ++dt) {
#pragma unroll
      for (int ct = 0; ct < 4; ++ct)
#pragma unroll
        for (int i = 0; i < 4; ++i) scr[((dt * 4 + ct) * 4 + i) * 64 + lane] = o[dt][ct][i] * gt[ct][0];
      asm volatile("" ::: "memory");
    }
  }
  const int cur = t0 >> 6;
  unsigned long long sel_lo = 0ull, sel_hi = 0ull;
  {
  NSA_SECTION_VARS
  if (cur <= 15) {
    sel_lo = (1ull << (cur + 1)) - 1ull;
  } else {
    __builtin_amdgcn_fence(__ATOMIC_SEQ_CST, "workgroup");
    __builtin_amdgcn_wave_barrier();
    float v[32];
#pragma unroll
    for (int k = 0; k < 32; ++k) {
      const int j = grp + 4 * k;
      const float x = imp[r * 132 + j];
      v[k] = (j >= 1 && j <= cur - 2) ? x : NEG_INF;
    }
#pragma unroll 1
    for (int round = 0; round < 13; ++round) {
      float best = NEG_INF;
      int bj = 1 << 20;
#pragma unroll
      for (int k = 0; k < 32; ++k) {
        const bool tk = v[k] > best;
        best = tk ? v[k] : best;
        bj = tk ? (grp + 4 * k) : bj;
      }
#pragma unroll
      for (int off = 16; off <= 32; off <<= 1) {
        const float ob = __shfl_xor(best, off);
        const int oj = __shfl_xor(bj, off);
        const bool tk = (ob > best) || (ob == best && oj < bj);
        best = tk ? ob : best;
        bj = tk ? oj : bj;
      }
      if (bj < 64) sel_lo |= 1ull << bj; else if (bj < 128) sel_hi |= 1ull << (bj - 64);
#pragma unroll
      for (int k = 0; k < 32; ++k) v[k] = (bj == grp + 4 * k) ? NEG_INF : v[k];
    }
    sel_lo |= 1ull;
    if (cur < 64) sel_lo |= 1ull << cur; else sel_hi |= 1ull << (cur - 64);
    if (cur - 1 < 64) sel_lo |= 1ull << (cur - 1); else sel_hi |= 1ull << (cur - 1 - 64);
  }
  }
  asm volatile("" : "+v"(sel_lo), "+v"(sel_hi));
  atomicOr(&misc[4], (unsigned)sel_lo); atomicOr(&misc[5], (unsigned)(sel_lo >> 32));
  atomicOr(&misc[6], (unsigned)sel_hi); atomicOr(&misc[7], (unsigned)(sel_hi >> 32));
  __syncthreads();
  unsigned long long ulo, uhi;
  {
    const unsigned u0 = __builtin_amdgcn_readfirstlane(misc[4]), u1 = __builtin_amdgcn_readfirstlane(misc[5]);
    const unsigned u2 = __builtin_amdgcn_readfirstlane(misc[6]), u3 = __builtin_amdgcn_readfirstlane(misc[7]);
    ulo = ((unsigned long long)u1 << 32) | u0; uhi = ((unsigned long long)u3 << 32) | u2;
  }
  {
    NSA_SECTION_VARS
    const int tid = (wave << 6) | lane;
    const bf16_t* ks = WSP(bf16_t, OFF_KS) + ((size_t)b * T) * 128 + g * 64;
    const bf16_t* vst = WSP(bf16_t, OFF_VST) + (size_t)((b * 2 + g) * 64) * T;
#pragma unroll
    for (int ct = 0; ct < 4; ++ct) { m[ct] = NEG_INF; lsum[ct] = 0.f; }
#pragma unroll
    for (int dt = 0; dt < 4; ++dt)
#pragma unroll
      for (int ct = 0; ct < 4; ++ct) o[dt][ct] = (f32x4){0.f, 0.f, 0.f, 0.f};
    TileRegs tr;
    int j = next_bit(ulo, uhi, 0), it = 0;
    tile_gload(tr, ks, 128, vst, T, 64 * j, tid);
    tile_swrite(tr, tiles, tid);
    __syncthreads();
#pragma unroll 1
    while (j < 128) {
      const int jn = next_bit(ulo, uhi, j + 1);
      if (jn < 128) tile_gload(tr, ks, 128, vst, T, 64 * jn, tid);
      const lds_u8* stage = tiles + (it & 1) * TILE_STAGE;
      const bool mine = ((j < 64 ? (sel_lo >> j) : (sel_hi >> (j - 64))) & 1ull) != 0ull;
      if (__any(mine)) {
#pragma unroll 1
        for (int hf = 0; hf < 2; ++hf) {
          const int key0 = j * 64 + hf * 32;
          f32x4 s[2][4];
          qk_scores_lds<4, 2, true>(stage, hf, qf, s, lane, qlds);
#pragma unroll
          for (int kt = 0; kt < 2; ++kt)
#pragma unroll
            for (int i = 0; i < 4; ++i) {
              const int key = key0 + 8 * grp + 4 * kt + i;
              const bool ok = mine && (key <= t);
#pragma unroll
              for (int ct = 0; ct < 4; ++ct) s[kt][ct][i] = ok ? s[kt][ct][i] * SC : NEG_INF;
            }
          softmax_update<4, 4, true>(s, m, lsum, o);
          pv_accum_lds<4, 4>(stage, hf, s, o, lane);
        }
      }
      if (jn < 128) tile_swrite(tr, tiles + ((it + 1) & 1) * TILE_STAGE, tid);
      __syncthreads();
      j = jn; ++it;
    }
    float sc2[4];
#pragma unroll
    for (int ct = 0; ct < 4; ++ct) sc2[ct] = finish_l(lsum[ct]) * gatep[ct * 3 + 1];
#pragma unroll
    for (int dt = 0; dt < 4; ++dt) {
#pragma unroll
      for (int ct = 0; ct < 4; ++ct)
#pragma unroll
        for (int i = 0; i < 4; ++i) scr[((dt * 4 + ct) * 4 + i) * 64 + lane] += o[dt][ct][i] * sc2[ct];
      asm volatile("" ::: "memory");
    }
  }
  {
    NSA_SECTION_VARS
    const int tid = (wave << 6) | lane;
    const bf16_t* kw = WSP(bf16_t, OFF_KW) + ((size_t)b * T) * 128 + g * 64;
    const bf16_t* vwt = WSP(bf16_t, OFF_VWT) + (size_t)((b * 2 + g) * 64) * T;
#pragma unroll
    for (int ct = 0; ct < 4; ++ct) { m[ct] = NEG_INF; lsum[ct] = 0.f; }
#pragma unroll
    for (int dt = 0; dt < 4; ++dt)
#pragma unroll
      for (int ct = 0; ct < 4; ++ct) o[dt][ct] = (f32x4){0.f, 0.f, 0.f, 0.f};
    int kstart = qi * 128 - 512;
    if (kstart < 0) kstart = 0;
    const int kend = qi * 128 + 64;
    TileRegs tr;
    int it = 0;
    tile_gload(tr, kw, 128, vwt, T, kstart, tid);
    tile_swrite(tr, tiles, tid);
    __syncthreads();
#pragma unroll 1
    for (int k0 = kstart; k0 <= kend; k0 += 64, ++it) {
      if (k0 + 64 <= kend) tile_gload(tr, kw, 128, vwt, T, k0 + 64, tid);
      const lds_u8* stage = tiles + (it & 1) * TILE_STAGE;
      if (k0 <= t0 + 15 && k0 + 63 + 512 > t0) {
#pragma unroll 1
        for (int hf = 0; hf < 2; ++hf) {
          const int key0 = k0 + hf * 32;
          f32x4 s[2][4];
          qk_scores_lds<4, 2, true>(stage, hf, qf, s, lane, qlds);
#pragma unroll
          for (int kt = 0; kt < 2; ++kt)
#pragma unroll
            for (int i = 0; i < 4; ++i) {
              const int key = key0 + 8 * grp + 4 * kt + i;
              const bool ok = (key <= t) && (key + 512 > t);
#pragma unroll
              for (int ct = 0; ct < 4; ++ct) s[kt][ct][i] = ok ? s[kt][ct][i] * SC : NEG_INF;
            }
          softmax_update<4, 4, true>(s, m, lsum, o);
          pv_accum_lds<4, 4>(stage, hf, s, o, lane);
        }
      }
      if (k0 + 64 <= kend) tile_swrite(tr, tiles + ((it + 1) & 1) * TILE_STAGE, tid);
      __syncthreads();
    }
    float sc2[4];
#pragma unroll
    for (int ct = 0; ct < 4; ++ct) sc2[ct] = finish_l(lsum[ct]) * gatep[ct * 3 + 2];
    bf16_t* oa = WSP(bf16_t, OFF_OA) + row * 512 + g * 256;
#pragma unroll
    for (int dt = 0; dt < 4; ++dt)
#pragma unroll
      for (int ct = 0; ct < 4; ++ct) {
        bf16_t* ptr = oa + ct * 64 + 16 * dt + 4 * grp;
        const u32x2 sw = *(const u32x2*)ptr;
        float val[4];
#pragma unroll
        for (int i = 0; i < 4; ++i) val[i] = scr[((dt * 4 + ct) * 4 + i) * 64 + lane] + o[dt][ct][i] * sc2[ct];
        u32x2 w = {cvtpk(val[0] * bflo(sw[0]), val[1] * bfhi(sw[0])), cvtpk(val[2] * bflo(sw[1]), val[3] * bfhi(sw[1]))};
        *(u32x2*)ptr = w;
        asm volatile("" ::: "memory");
      }
  }
#undef NSA_SECTION_VARS
}

__device__ void fox_wg_unit(const Params& p, int b, int h, int qb, lds_u8* tiles) {
  const int tid = tidx();
  const int wave = __builtin_amdgcn_readfirstlane(tid >> 6);
  const int lane = tid & 63, r = lane & 15, grp = lane >> 4;
  const int t0 = qb * 512 + wave * 64;
  const float SC = 0.125f * LOG2E;
  bf16x8 qf[4][2];
  float cq[4];
  const float* fc = WSP(float, OFF_FC) + (size_t)(b * 8 + h) * T;
#pragma unroll
  for (int ct = 0; ct < 4; ++ct) {
    const size_t row = (size_t)b * T + t0 + 16 * ct + r;
#pragma unroll
    for (int dk = 0; dk < 2; ++dk)
      qf[ct][dk] = *(const bf16x8*)(WSP(bf16_t, OFF_FQ) + row * 512 + h * 64 + dk * 32 + grp * 8);
    cq[ct] = fc[t0 + 16 * ct + r] * LOG2E;
  }
  const bf16_t* kb = WSP(bf16_t, OFF_FK) + ((size_t)b * T) * 512 + h * 64;
  const bf16_t* vt = WSP(bf16_t, OFF_FVT) + (size_t)((b * 8 + h) * 64) * T;
  f32x4 o[4][4];
  float m[4], lsum[4];
#pragma unroll
  for (int ct = 0; ct < 4; ++ct) { m[ct] = NEG_INF; lsum[ct] = 0.f; }
#pragma unroll
  for (int dt = 0; dt < 4; ++dt)
#pragma unroll
    for (int ct = 0; ct < 4; ++ct) o[dt][ct] = (f32x4){0.f, 0.f, 0.f, 0.f};
  const int ntiles = (qb + 1) * 8;
  TileRegs tr;
  tile_gload(tr, kb, 512, vt, T, 0, tid);
  tile_swrite(tr, tiles, tid);
  __syncthreads();
#pragma unroll 1
  for (int it = 0; it < ntiles; ++it) {
    const int k0 = it * 64;
    if (it + 1 < ntiles) tile_gload(tr, kb, 512, vt, T, k0 + 64, tid);
    const lds_u8* stage = tiles + (it & 1) * TILE_STAGE;
    if (k0 <= t0 + 63) {
      const bool diag = (k0 + 63 > t0);
#pragma unroll 1
      for (int hf = 0; hf < 2; ++hf) {
        const int key0 = k0 + hf * 32;
        f32x4 s[2][4];
        qk_scores_lds<4, 2, false>(stage, hf, qf, s, lane, nullptr);
        const f32x4 ck0 = *(const f32x4*)(fc + key0 + 8 * grp), ck1 = *(const f32x4*)(fc + key0 + 8 * grp + 4);
#pragma unroll
        for (int kt = 0; kt < 2; ++kt)
#pragma unroll
          for (int i = 0; i < 4; ++i) {
            const int key = key0 + 8 * grp + 4 * kt + i;
            const float ck = (kt ? ck1[i] : ck0[i]) * LOG2E;
#pragma unroll
            for (int ct = 0; ct < 4; ++ct) {
              const bool ok = !diag || (key <= t0 + 16 * ct + r);
              s[kt][ct][i] = ok ? (s[kt][ct][i] * SC + (cq[ct] - ck)) : NEG_INF;
            }
          }
        softmax_update<4, 4, true>(s, m, lsum, o);
        pv_accum_lds<4, 4>(stage, hf, s, o, lane);
      }
    }
    if (it + 1 < ntiles) tile_swrite(tr, tiles + ((it + 1) & 1) * TILE_STAGE, tid);
    __syncthreads();
  }
  float invl[4];
#pragma unroll
  for (int ct = 0; ct < 4; ++ct) invl[ct] = finish_l(lsum[ct]);
#pragma unroll
  for (int ct = 0; ct < 4; ++ct) {
    bf16_t* ob = WSP(bf16_t, OFF_OB) + ((size_t)b * T + t0 + 16 * ct + r) * 512 + h * 64;
#pragma unroll
    for (int dt = 0; dt < 4; ++dt) {
      bf16_t* ptr = ob + 16 * dt + 4 * grp;
      const u32x2 sw = *(const u32x2*)ptr;
      const f32x4 v = o[dt][ct] * invl[ct];
      u32x2 w = {cvtpk(v[0] * bflo(sw[0]), v[1] * bfhi(sw[0])), cvtpk(v[2] * bflo(sw[1]), v[3] * bfhi(sw[1]))};
      *(u32x2*)ptr = w;
    }
  }
}

__device__ void mem_unit(const Params& p, int l, int b, int h, int t0, bool st) {
  const int lane = tidx() & 63, r = lane & 15, grp = lane >> 4;
  const float SC = 0.08838834764831845f * LOG2E;
  bf16x8 qf[2][4];
  const float* gq = p.mem_q_norm + l * 128;
#pragma unroll
  for (int ct = 0; ct < 2; ++ct) {
    const size_t row = (size_t)b * T + t0 + 16 * ct + r;
    float v[4][8];
    float ss = 0.f;
#pragma unroll
    for (int dk = 0; dk < 4; ++dk) {
      const u32x4 w = *(const u32x4*)(WSP(bf16_t, OFF_MQ) + row * 512 + h * 128 + dk * 32 + grp * 8);
#pragma unroll
      for (int j = 0; j < 4; ++j) { v[dk][2 * j] = bflo(w[j]); v[dk][2 * j + 1] = bfhi(w[j]); }
#pragma unroll
      for (int j = 0; j < 8; ++j) ss += v[dk][j] * v[dk][j];
    }
    ss += __shfl_xor(ss, 16);
    ss += __shfl_xor(ss, 32);
    const float rstd = rsqrtf(ss * (1.0f / 128.0f) + EPS);
#pragma unroll
    for (int dk = 0; dk < 4; ++dk) {
      const f32x4 g0 = *(const f32x4*)(gq + dk * 32 + grp * 8), g1 = *(const f32x4*)(gq + dk * 32 + grp * 8 + 4);
      u32x4 w = {cvtpk(v[dk][0] * rstd * g0[0], v[dk][1] * rstd * g0[1]), cvtpk(v[dk][2] * rstd * g0[2], v[dk][3] * rstd * g0[3]),
                 cvtpk(v[dk][4] * rstd * g1[0], v[dk][5] * rstd * g1[1]), cvtpk(v[dk][6] * rstd * g1[2], v[dk][7] * rstd * g1[3])};
      qf[ct][dk] = __builtin_bit_cast(bf16x8, w);
    }
  }
  const bf16_t* kb = WSP(bf16_t, OFF_MK) + ((size_t)b * 256) * 512 + h * 128;
  const bf16_t* vt = WSP(bf16_t, OFF_MVT) + (size_t)((b * 4 + h) * 128) * 256;
  f32x4 o[8][2];
  float m[2], lsum[2];
#pragma unroll
  for (int ct = 0; ct < 2; ++ct) { m[ct] = NEG_INF; lsum[ct] = 0.f; }
#pragma unroll
  for (int dt = 0; dt < 8; ++dt)
#pragma unroll
    for (int ct = 0; ct < 2; ++ct) o[dt][ct] = (f32x4){0.f, 0.f, 0.f, 0.f};
#pragma unroll 1
  for (int key0 = 0; key0 < 256; key0 += 32) {
    f32x4 s[2][2];
    qk_scores<2, 4>(kb, 512, key0, qf, s, lane);
#pragma unroll
    for (int kt = 0; kt < 2; ++kt)
#pragma unroll
      for (int ct = 0; ct < 2; ++ct) s[kt][ct] = s[kt][ct] * SC;
    softmax_update<2, 8, true>(s, m, lsum, o);
    pv_accum<2, 8>(vt, 256, key0, s, o, lane);
  }
#pragma unroll
  for (int ct = 0; ct < 2; ++ct) {
    const float invl = finish_l(lsum[ct]);
    bf16_t* om = WSP(bf16_t, OFF_OM) + ((size_t)b * T + t0 + 16 * ct + r) * 512 + h * 128;
#pragma unroll
    for (int dt = 0; dt < 8; ++dt) {
      bf16_t* ptr = om + 16 * dt + 4 * grp;
      const u32x2 sw = *(const u32x2*)ptr;
      const f32x4 v = o[dt][ct] * invl;
      u32x2 w = {cvtpk(v[0] * bflo(sw[0]), v[1] * bfhi(sw[0])), cvtpk(v[2] * bflo(sw[1]), v[3] * bfhi(sw[1]))};
      if (st) *(u32x2*)ptr = w;
    }
  }
}

__device__ void phase_attn(const Params& p, int l, unsigned char* ldsraw) {
  const int tid = tidx();
  const int wave = __builtin_amdgcn_readfirstlane(tid >> 6);
  float* imp = (float*)ldsraw + wave * 2112;
  lds_u8* tiles = (lds_u8*)ldsraw;
  bf16x8* qlds = (bf16x8*)(ldsraw + 69632 + wave * 8192);
  unsigned* misc = (unsigned*)(ldsraw + 135168);
  float* scr = WSP(float, OFF_SCR) + (size_t)(blockIdx.x * NWAVES + wave) * 4096;
  unsigned* ctr = WSP(unsigned, OFF_CTL) + l;
  constexpr int NUNITS = 1536;
  for (;;) {
    __syncthreads();
    if (tid == 0) misc[0] = atomicAdd(ctr, 1u);
    if (tid >= 4 && tid < 8) misc[tid] = 0u;
    __syncthreads();
    const int u = __builtin_amdgcn_readfirstlane((int)misc[0]);
    if (u >= NUNITS) break;
    if (u < 1024) {
      const int g4 = u >> 6, w = u & 63;
      if (w < 32) fox_wg_unit(p, w >> 3, w & 7, 15 - g4, tiles);
      else { const int w2 = w - 32, kk = w2 >> 3, bg = w2 & 7; nsa_wg_unit(p, bg >> 1, bg & 1, 63 - (4 * g4 + kk), imp, qlds, scr, tiles, misc); }
    } else {
      const int mu = u - 1024, bh = mu >> 5, qblk = mu & 31;
      mem_unit(p, l, bh >> 2, bh & 3, 256 * qblk + 32 * wave, true);
    }
  }
}

__global__ void __launch_bounds__(NTHREADS) hybrid_megakernel(Params p) {
  cg::grid_group grid = cg::this_grid();
  extern __shared__ __attribute__((aligned(16))) unsigned char dynlds[];
  float* smem = (float*)dynlds;
  PG8_LAS unsigned char* glds = (PG8_LAS unsigned char*)dynlds;
  for (int l = 0; l < 4; ++l) {
    phase_prep(p, l, smem);
    grid.sync();
    {
      EpiIn E{&p, l};
      run_gemm(glds, WSP(bf16_t, OFF_H), WSP(bf16_t, OFF_W_IN), M, 5120, 1024, E);
      EpiMemKV E2{&p};
      run_gemm(glds, WSP(bf16_t, OFF_MEMN), WSP(bf16_t, OFF_W_MKV), 1024, 1024, 1024, E2);
    }
    grid.sync();
    phase_mid(p, l);
    grid.sync();
    phase_attn(p, l, dynlds);
    grid.sync();
    {
      EpiGate E{WSP(bf16_t, OFF_G)};
      run_gemm(glds, WSP(bf16_t, OFF_H), WSP(bf16_t, OFF_W_G), M, 3072, 1024, E);
    }
    grid.sync();
    {
      EpiBranch Ea{WSP(bf16_t, OFF_G), WSP(bf16_t, OFF_U), 1};
      run_gemm(glds, WSP(bf16_t, OFF_OA), WSP(bf16_t, OFF_W_BR), M, 1024, 512, Ea);
      EpiBranch Eb{WSP(bf16_t, OFF_G) + (size_t)M * 1024, WSP(bf16_t, OFF_U), 0};
      run_gemm(glds, WSP(bf16_t, OFF_OB), WSP(bf16_t, OFF_W_BR + MiB), M, 1024, 512, Eb);
      EpiBranch Ec{WSP(bf16_t, OFF_G) + (size_t)2 * M * 1024, WSP(bf16_t, OFF_U), 0};
      run_gemm(glds, WSP(bf16_t, OFF_OM), WSP(bf16_t, OFF_W_BR + 2 * MiB), M, 1024, 512, Ec);
    }
    grid.sync();
    {
      EpiOut E{l == 0 ? p.x : p.out, p.out};
      run_gemm(glds, WSP(bf16_t, OFF_U), WSP(bf16_t, OFF_W_OUT), M, 1024, 1024, E);
    }
    grid.sync();
  }
}

extern "C" void kernel_launch(void* const* d_in, const int* in_sizes, int n_in, void* d_out, int out_size, void* d_ws,
                              size_t ws_size, hipStream_t stream) {
  static int grid_blocks = 0;
  if (!grid_blocks) {
    int dev = 0, cus = 0, per_cu = 0;
    (void)hipGetDevice(&dev);
    (void)hipDeviceGetAttribute(&cus, hipDeviceAttributeMultiprocessorCount, dev);
    if (hipFuncSetAttribute((const void*)hybrid_megakernel, hipFuncAttributeMaxDynamicSharedMemorySize, LDS_BYTES) != hipSuccess)
      fprintf(stderr, "hipFuncSetAttribute(dynamic LDS %d) failed\n", LDS_BYTES);
    (void)hipOccupancyMaxActiveBlocksPerMultiprocessor(&per_cu, hybrid_megakernel, NTHREADS, LDS_BYTES);
    (void)hipGetLastError();
    grid_blocks = cus;
    if (grid_blocks > 256) grid_blocks = 256;
    if (ws_size < OFF_SCR + (size_t)32 * MiB) fprintf(stderr, "workspace too small: %zu\n", ws_size);
  }
  Params p{};
  const float** pp = (const float**)&p;
  for (int i = 0; i < 23; ++i) pp[i] = (const float*)d_in[i];
  p.out = (float*)d_out;
  p.ws = (char*)d_ws;
  void* args[] = {&p};
  hipError_t e = hipLaunchCooperativeKernel((void*)hybrid_megakernel, dim3(grid_blocks), dim3(NTHREADS), args, LDS_BYTES, stream);
  if (e != hipSuccess) fprintf(stderr, "cooperative launch failed: %s (grid %d)\n", hipGetErrorString(e), grid_blocks);
}
```

```cpp
#include <hip/hip_runtime.h>
#include <hip/hip_cooperative_groups.h>
#include <stdint.h>
#include <cstdio>
namespace cg = cooperative_groups;
#ifndef PROBE_ATTN2
#define PROBE_ATTN2 0
#endif
#ifndef PROBE_PM2
#define PROBE_PM2 0
#endif
#ifndef PROBE_GEMM2
#define PROBE_GEMM2 0
#endif


typedef unsigned short bf16_t;
typedef short bf16x8 __attribute__((ext_vector_type(8)));
typedef float f32x4 __attribute__((ext_vector_type(4)));
typedef unsigned u32x2 __attribute__((ext_vector_type(2)));
typedef unsigned u32x4 __attribute__((ext_vector_type(4)));
typedef float f32x2_t __attribute__((ext_vector_type(2)));
typedef __bf16 bf16x2_t __attribute__((ext_vector_type(2)));

constexpr int NB = 4, T = 8192, M = NB * T;
constexpr int NTHREADS = 512, NWAVES = NTHREADS / 64;
constexpr int LDS_BYTES = 147456;
constexpr float EPS = 1e-6f;
constexpr float LOG2E = 1.4426950408889634f;
#define NEG_INF (-__builtin_inff())

constexpr size_t MiB = 1u << 20;
constexpr size_t OFF_CTL = 0;
constexpr size_t OFF_BAR = 64 * 1024;
constexpr size_t OFF_ROPE = 1 * MiB;
constexpr size_t OFF_W_IN = 3 * MiB;
constexpr size_t OFF_W_G = 13 * MiB;
constexpr size_t OFF_W_MKV = 19 * MiB;
constexpr size_t OFF_W_BR = 21 * MiB;
constexpr size_t OFF_W_OUT = 24 * MiB;
constexpr size_t OFF_W1 = 26 * MiB;
constexpr size_t OFF_W2 = 27 * MiB;
constexpr size_t OFF_C1 = 27 * MiB + 256 * 1024;
constexpr size_t OFF_MEMN = 28 * MiB;
constexpr size_t OFF_MK = 30 * MiB;
constexpr size_t OFF_MVT = 31 * MiB;
constexpr size_t OFF_H = 32 * MiB;
constexpr size_t OFF_U = OFF_H;
constexpr size_t OFF_OA = 96 * MiB;
constexpr size_t OFF_OB = 128 * MiB;
constexpr size_t OFF_OM = 160 * MiB;
constexpr size_t OFF_QN = 192 * MiB;
constexpr size_t OFF_G = 192 * MiB;
constexpr size_t OFF_KC = 224 * MiB;
constexpr size_t OFF_VC = 232 * MiB;
constexpr size_t OFF_KS = 240 * MiB;
constexpr size_t OFF_VST = 248 * MiB;
constexpr size_t OFF_KW = 256 * MiB;
constexpr size_t OFF_VWT = 264 * MiB;
constexpr size_t OFF_FQ = 272 * MiB;
constexpr size_t OFF_FK = 304 * MiB;
constexpr size_t OFF_FVT = 336 * MiB;
constexpr size_t OFF_MQ = 368 * MiB;
constexpr size_t OFF_GATE = 400 * MiB;
constexpr size_t OFF_FLOG = 403 * MiB;
constexpr size_t OFF_FC = 404 * MiB;
constexpr size_t OFF_KCMP = 405 * MiB;
constexpr size_t OFF_VCT = 405 * MiB + 512 * 1024;
constexpr size_t OFF_SCR = 406 * MiB;

struct Params {
  const float *x, *mem, *norm_g, *mem_norm_g, *w_in, *nsa_q_norm, *nsa_k_norm, *cmp_pe_k, *cmp_w1_k, *cmp_w2_k,
      *cmp_pe_v, *cmp_w1_v, *cmp_w2_v, *fox_q_norm, *fox_k_norm, *fox_f_bias, *mem_q_norm, *mem_k_norm, *w_mem_kv,
      *w_branch_a, *w_branch_b, *w_branch_m, *w_out;
  float* out;
  char* ws;
};
__device__ __forceinline__ char* ws_base(char* w) {
  unsigned lo = __builtin_amdgcn_readfirstlane((unsigned)(uintptr_t)w), hi = __builtin_amdgcn_readfirstlane((unsigned)((uintptr_t)w >> 32));
  asm volatile("" : "+s"(lo), "+s"(hi));
  return (char*)(__attribute__((address_space(1))) char*)(((uintptr_t)hi << 32) | (uintptr_t)lo);
}
#define WSP(TYPE, off) ((TYPE*)(ws_base(p.ws) + (off)))

__constant__ float c_inv_freq[32] = {
    1.000000000e+00f, 7.498942018e-01f, 5.623413324e-01f, 4.216965139e-01f, 3.162277639e-01f, 2.371373773e-01f,
    1.778279394e-01f, 1.333521456e-01f, 1.000000015e-01f, 7.498942316e-02f, 5.623413250e-02f, 4.216964915e-02f,
    3.162277490e-02f, 2.371373773e-02f, 1.778279431e-02f, 1.333521400e-02f, 9.999999776e-03f, 7.498942316e-03f,
    5.623413250e-03f, 4.216964822e-03f, 3.162277630e-03f, 2.371373819e-03f, 1.778279431e-03f, 1.333521446e-03f,
    1.000000047e-03f, 7.498941850e-04f, 5.623413017e-04f, 4.216965172e-04f, 3.162277571e-04f, 2.371373703e-04f,
    1.778279402e-04f, 1.333521504e-04f};

__device__ __forceinline__ int bidx() { int b = blockIdx.x; asm volatile("" : "+s"(b)); return b; }
__device__ __forceinline__ int gdim() { int g = gridDim.x; asm volatile("" : "+s"(g)); return g; }
__device__ __forceinline__ int tidx() { int t = threadIdx.x; asm volatile("" : "+v"(t)); return t; }
__device__ __forceinline__ unsigned cvtpk(float lo, float hi) {
  f32x2_t v = {lo, hi};
  bf16x2_t b = __builtin_convertvector(v, bf16x2_t);
  return __builtin_bit_cast(unsigned, b);
}
__device__ __forceinline__ float bf2f(unsigned short v) { return __uint_as_float(((unsigned)v) << 16); }
__device__ __forceinline__ float bflo(unsigned w) { return __uint_as_float(w << 16); }
__device__ __forceinline__ float bfhi(unsigned w) { return __uint_as_float(w & 0xffff0000u); }
__device__ __forceinline__ f32x4 mfma16(bf16x8 a, bf16x8 b, f32x4 c) {
  return __builtin_amdgcn_mfma_f32_16x16x32_bf16(a, b, c, 0, 0, 0);
}
__device__ __forceinline__ bf16x8 pack8(f32x4 a, f32x4 b) {
  u32x4 w = {cvtpk(a[0], a[1]), cvtpk(a[2], a[3]), cvtpk(b[0], b[1]), cvtpk(b[2], b[3])};
  return __builtin_bit_cast(bf16x8, w);
}
__device__ __forceinline__ float sigmoidf_(float v) { return 1.0f / (1.0f + __expf(-v)); }
__device__ __forceinline__ float siluf_(float v) { return v / (1.0f + __expf(-v)); }
__device__ __forceinline__ float wave_sum(float v) {
#pragma unroll
  for (int o = 1; o < 64; o <<= 1) v += __shfl_xor(v, o);
  return v;
}

#define LAS __attribute__((address_space(3)))
#define XB_TMO      128
#define XB_XCNT(j)  (256  + 64 * (j))
#define XB_XSUB(j)  (1280 + 64 * (j))
#define XB_XGEN(j)  (2304 + 64 * (j))
#define XB_TOP      3328
#define XB_TOPGEN   3392
#define XCD_BAR_WORDS 3456
#define XB_SPIN_CAP (1u << 18)

__device__ __forceinline__ unsigned xb_ld(unsigned* p)              { return __hip_atomic_load(p, __ATOMIC_RELAXED, __HIP_MEMORY_SCOPE_AGENT); }
__device__ __forceinline__ unsigned xb_add(unsigned* p, unsigned v) { return __hip_atomic_fetch_add(p, v, __ATOMIC_RELAXED, __HIP_MEMORY_SCOPE_AGENT); }
__device__ __forceinline__ unsigned xb_xcc_id() { return (unsigned)__builtin_amdgcn_s_getreg((3 << 11) | 20) & 0xFu; }
#define XB_SPIN(cond, bar) do { unsigned _sp = 0; while (cond) { __builtin_amdgcn_s_sleep(1); \
    if ((++_sp & 255u) == 0u) { if (xb_ld(&(bar)[XB_TMO])) break; if (_sp > XB_SPIN_CAP) { atomicAdd(&(bar)[XB_TMO], 1u); break; } } } } while (0)

struct XcdBarrier {
    unsigned* bar; unsigned x;
    volatile LAS unsigned* st;
};

__device__ __forceinline__ XcdBarrier xcd_barrier_post(unsigned* bar, volatile LAS unsigned* st) {
    XcdBarrier b; b.bar = bar; b.x = xb_xcc_id(); b.st = st;
    if (threadIdx.x == 0) (void)xb_add(&bar[XB_XCNT(b.x)], 1u);
    return b;
}
__device__ __forceinline__ void xcd_barrier_complete(unsigned* bar, unsigned x, unsigned& nloc, unsigned& nx) {
    const unsigned G = gridDim.x * gridDim.y * gridDim.z;
    unsigned sum, cnt, mine, sp = 0u;
    for (;;) {
        sum = 0u; cnt = 0u; mine = 0u;
#pragma unroll
        for (unsigned j = 0; j < 16; ++j) { const unsigned c = xb_ld(&bar[XB_XCNT(j)]); sum += c; cnt += (c > 0u) ? 1u : 0u; mine = (j == x) ? c : mine; }
        if (sum == G) break;
        __builtin_amdgcn_s_sleep(1);
        if ((++sp & 255u) == 0u) { if (xb_ld(&bar[XB_TMO])) break; if (sp > XB_SPIN_CAP) { atomicAdd(&bar[XB_TMO], 1u); break; } }
    }
    nloc = mine > 0u ? mine : 1u; nx = cnt > 0u ? cnt : 1u;
}

__device__ __forceinline__ void xcd_barrier(const XcdBarrier& b) {
    asm volatile("s_waitcnt vmcnt(0)" ::: "memory");
    __syncthreads();
    if (threadIdx.x == 0) {
        unsigned* bar = b.bar;
        __builtin_amdgcn_s_waitcnt(0);
        unsigned nloc = b.st[0], nx = b.st[1];
        if (nloc == 0u) { xcd_barrier_complete(bar, b.x, nloc, nx); b.st[0] = nloc; b.st[1] = nx; }
        const unsigned old = xb_add(&bar[XB_XSUB(b.x)], 1u);
        const unsigned gen = old / nloc;
        if (old + 1u == (gen + 1u) * nloc) {
            __builtin_amdgcn_fence(__ATOMIC_RELEASE, "agent");
            asm volatile("s_waitcnt vmcnt(0)" ::: "memory");
            const unsigned og = xb_add(&bar[XB_TOP], 1u);
            const unsigned tg = og / nx;
            if (og + 1u == (tg + 1u) * nx) xb_add(&bar[XB_TOPGEN], 1u);
            else XB_SPIN(xb_ld(&bar[XB_TOPGEN]) == tg, bar);
            __builtin_amdgcn_fence(__ATOMIC_ACQUIRE, "agent");
            xb_add(&bar[XB_XGEN(b.x)], 1u);
            asm volatile("s_waitcnt vmcnt(0)" ::: "memory");
        } else {
            XB_SPIN(xb_ld(&bar[XB_XGEN(b.x)]) == gen, bar);
            __builtin_amdgcn_fence(__ATOMIC_ACQUIRE, "agent");
            asm volatile("s_waitcnt vmcnt(0)" ::: "memory");
        }
    }
    __syncthreads();
}


namespace pg8 {
#define PG8_LAS __attribute__((address_space(3)))
typedef unsigned short bf16_t;
typedef short bf16x8 __attribute__((ext_vector_type(8)));
typedef float f32x4 __attribute__((ext_vector_type(4)));
typedef unsigned u32x4 __attribute__((ext_vector_type(4)));
constexpr int BM = 256, BK = 64, HALF = 128, HTB = HALF * BK * 2  , STAGE_BYTES = 8 * HTB, NXCD = 8, WGM = 8;

__host__ __device__ __forceinline__ int lds_byte(int r, int c) { const int st = (r >> 4) * 2 + (c >> 5), rr = r & 15, cc = c & 31, ob = rr * 64 + cc * 2; return st * 1024 + (ob ^ (((ob >> 9) & 1) << 5)); }
__host__ __device__ __forceinline__ void stage_rc(int b, int& R, int& C) { const int st = b / 1024, sb = b % 1024, swz = sb ^ (((sb >> 9) & 1) << 5); R = (st >> 1) * 16 + swz / 64; C = (st & 1) * 32 + (swz % 64) / 2; }
__host__ __device__ __forceinline__ int perm32(int rho) { const int n = rho >> 4, i = rho & 15; return 8 * (i >> 2) + 4 * n + (i & 3); }

struct Unit { int pm, pn; };
struct Gemm { const bf16_t* A; const bf16_t* Bt; int M, N, K; };

struct StaticOrder {
    int nM, nN, nwg, G, c;
    __host__ __device__ void init(int M, int N, int G_, int c_) { nM = M / BM; nN = N / BM; nwg = nM * nN; G = G_; c = c_; }
    __host__ __device__ bool next(int i, Unit& u) const {
        const long L = (long)i * G + c; if (L >= nwg) return false;
        int wgid = (int)L; { const int q = nwg / NXCD, r = nwg % NXCD, xcd = wgid % NXCD, off = wgid / NXCD; wgid = (xcd < r ? xcd * (q + 1) : r * (q + 1) + (xcd - r) * q) + off; }
        const int nig = WGM * nN, gid = wgid / nig, fm = gid * WGM, gsz = (nM - fm) < WGM ? (nM - fm) : WGM;
        u.pm = fm + ((wgid % nig) % gsz); u.pn = (wgid % nig) / gsz; return true;
    }
    __device__ __forceinline__ void a_ready(const Unit&) const {}
    __device__ __forceinline__ void done(const Unit&) const {}
};
__device__ __forceinline__ unsigned cvt_pk_bf16(float lo, float hi) { unsigned r; asm volatile("v_cvt_pk_bf16_f32 %0, %1, %2" : "=v"(r) : "v"(lo), "v"(hi)); return r; }
template <class Epi, class Sched, bool ALIGN_EPI = false, bool SP2 = false>
__device__ __forceinline__ void gemm_phase(PG8_LAS unsigned char* lds, const Gemm g, const Sched& S, const Epi& E) {
    const int tid = tidx(), wid = __builtin_amdgcn_readfirstlane(tid >> 6), lane = tid & 63, wr = wid >> 2, wc = wid & 3, fr = lane & 15, fq = lane >> 4;
    const int K = g.K, nt = K / BK;
    unsigned voffA[2], voffB[2];
#pragma unroll
    for (int i = 0; i < 2; ++i) { int R, C; stage_rc(tid * 16 + i * 8192, R, C); const int Rb = Epi::PERM ? ((R & ~31) + perm32(R & 31)) : R;
        voffA[i] = (unsigned)(R * K + C) * 2u; voffB[i] = (unsigned)(Rb * K + C) * 2u; }
    const size_t kstep = (size_t)(BK * 2);
    const size_t hstep = (size_t)HALF * K * 2;
    const size_t tstep = 2 * hstep;
    const unsigned ldsw = (unsigned)wid * 1024u;
    const int aoff = lds_byte(wr * 64 + fr, fq * 8), boff = lds_byte(wc * 32 + fr, fq * 8);
#define PG8_SA(b, h) (((b) * 2 + (h)) * HTB)
#define PG8_SB(b, h) ((4 + (b) * 2 + (h)) * HTB)
#define PG8_STAGE(bufoff, gbase, voff) do { _Pragma("unroll") for (int _i = 0; _i < 2; ++_i) \
        __builtin_amdgcn_global_load_lds((const unsigned*)((const char*)(gbase) + (voff)[_i]), (PG8_LAS unsigned*)(lds + (bufoff) + ldsw + _i * 8192), 16, 0, 0); } while (0)
#define PG8_LDA(dst, b, h) do { _Pragma("unroll") for (int m = 0; m < 4; ++m) _Pragma("unroll") for (int k = 0; k < 2; ++k) dst[m][k] = *(const PG8_LAS bf16x8*)(lds + PG8_SA(b, h) + aoff + m * 2048 + k * 1024); } while (0)
#define PG8_LDB(dst, b, h) do { _Pragma("unroll") for (int n = 0; n < 2; ++n) _Pragma("unroll") for (int k = 0; k < 2; ++k) dst[n][k] = *(const PG8_LAS bf16x8*)(lds + PG8_SB(b, h) + boff + n * 2048 + k * 1024); } while (0)
#define PG8_MMA(ai, bj, At, Bt) do { __builtin_amdgcn_s_setprio(1); _Pragma("unroll") for (int m = 0; m < 4; ++m) _Pragma("unroll") for (int n = 0; n < 2; ++n) _Pragma("unroll") for (int k = 0; k < 2; ++k) \
        acc[ai][bj][m][n] = __builtin_amdgcn_mfma_f32_16x16x32_bf16(Bt[n][k], At[m][k], acc[ai][bj][m][n], 0, 0, 0); __builtin_amdgcn_s_setprio(0); } while (0)
#define PG8_WAIT_V(n) asm volatile("s_waitcnt vmcnt(" #n ")" ::: "memory")
#define PG8_WAIT_L(n) asm volatile("s_waitcnt lgkmcnt(" #n ")" ::: "memory")
#define PG8_BAR __builtin_amdgcn_s_barrier()
#define PG8_SCHED __builtin_amdgcn_sched_barrier(0)
    Unit cur, nxt; int ui = 0;
    if (!S.next(0, cur)) return;
    f32x4 acc[2][2][4][2];
#pragma unroll
    for (int a = 0; a < 2; ++a)
#pragma unroll
        for (int b = 0; b < 2; ++b)
#pragma unroll
            for (int m = 0; m < 4; ++m)
#pragma unroll
                for (int n = 0; n < 2; ++n) acc[a][b][m][n] = (f32x4){0.f, 0.f, 0.f, 0.f};
    bf16x8 At[4][2], B0[2][2], B1[2][2];
    const char* cA = (const char*)g.A + (size_t)cur.pm * tstep; const char* cB = (const char*)g.Bt + (size_t)cur.pn * tstep;
    S.a_ready(cur);
    if constexpr (SP2) {
        PG8_STAGE(PG8_SB(0, 0), cB, voffB); PG8_STAGE(PG8_SB(0, 1), cB + hstep, voffB); PG8_STAGE(PG8_SA(0, 0), cA, voffA); PG8_STAGE(PG8_SA(0, 1), cA + hstep, voffA);
        if (wr == 1) PG8_BAR;
        PG8_WAIT_V(2); PG8_BAR;
        PG8_STAGE(PG8_SB(1, 0), cB + kstep, voffB); PG8_STAGE(PG8_SA(1, 0), cA + kstep, voffA); PG8_STAGE(PG8_SB(1, 1), cB + hstep + kstep, voffB);
        PG8_WAIT_V(6); PG8_BAR;
    } else {
        PG8_STAGE(PG8_SB(0, 0), cB, voffB); PG8_STAGE(PG8_SA(0, 0), cA, voffA); PG8_STAGE(PG8_SB(0, 1), cB + hstep, voffB); PG8_STAGE(PG8_SA(0, 1), cA + hstep, voffA);
        if (wr == 1) PG8_BAR;
        PG8_WAIT_V(4); PG8_BAR;
        PG8_STAGE(PG8_SB(1, 0), cB + kstep, voffB); PG8_STAGE(PG8_SA(1, 0), cA + kstep, voffA); PG8_STAGE(PG8_SB(1, 1), cB + hstep + kstep, voffB);
        PG8_WAIT_V(6); PG8_BAR;
    }
    for (;;) {
        const bool has_next = S.next(ui + 1, nxt);
        const char* nA = has_next ? (const char*)g.A + (size_t)nxt.pm * tstep : cA; const char* nB = has_next ? (const char*)g.Bt + (size_t)nxt.pn * tstep : cB;
        for (int t = 0; t < nt; t += 2) {
            const bool last = (t == nt - 2);
            const char* a1 = cA + (size_t)(t + 1) * kstep;
            const char* a2 = last ? nA : cA + (size_t)(t + 2) * kstep; const char* b2 = last ? nB : cB + (size_t)(t + 2) * kstep;
            const char* a3 = a2 + kstep; const char* b3 = b2 + kstep;
            if (last && has_next) S.a_ready(nxt);
            if constexpr (SP2) {
            PG8_LDB(B0, 0, 0); PG8_LDB(B1, 0, 1); PG8_SCHED; PG8_LDA(At, 0, 0); PG8_STAGE(PG8_SA(1, 1), a1 + hstep, voffA);
            PG8_WAIT_V(8); PG8_WAIT_L(0); PG8_BAR; PG8_MMA(0, 0, At, B0); PG8_MMA(0, 1, At, B1); PG8_BAR; PG8_SCHED;
            PG8_LDA(At, 0, 1); PG8_STAGE(PG8_SB(0, 0), b2, voffB); PG8_STAGE(PG8_SB(0, 1), b2 + hstep, voffB); PG8_STAGE(PG8_SA(0, 0), a2, voffA);
            PG8_WAIT_V(8); PG8_WAIT_L(0); PG8_BAR; PG8_MMA(1, 0, At, B0); PG8_MMA(1, 1, At, B1); PG8_BAR; PG8_SCHED;
            PG8_LDB(B0, 1, 0); PG8_LDB(B1, 1, 1); PG8_SCHED; PG8_LDA(At, 1, 0); PG8_STAGE(PG8_SA(0, 1), a2 + hstep, voffA);
            PG8_WAIT_V(8); PG8_WAIT_L(0); PG8_BAR; PG8_MMA(0, 0, At, B0); PG8_MMA(0, 1, At, B1); PG8_BAR; PG8_SCHED;
            PG8_LDA(At, 1, 1); PG8_STAGE(PG8_SB(1, 0), b3, voffB); PG8_STAGE(PG8_SB(1, 1), b3 + hstep, voffB); PG8_STAGE(PG8_SA(1, 0), a3, voffA);
            PG8_WAIT_V(8); PG8_WAIT_L(0); PG8_BAR; PG8_MMA(1, 0, At, B0); PG8_MMA(1, 1, At, B1); PG8_BAR; PG8_SCHED;
            } else {
            PG8_LDB(B0, 0, 0); PG8_SCHED; PG8_LDA(At, 0, 0); PG8_STAGE(PG8_SA(1, 1), a1 + hstep, voffA);
            PG8_WAIT_L(8); PG8_BAR; PG8_WAIT_L(0); PG8_MMA(0, 0, At, B0); PG8_BAR; PG8_SCHED;
            PG8_LDB(B1, 0, 1); PG8_STAGE(PG8_SB(0, 0), b2, voffB);
            PG8_BAR; PG8_WAIT_L(0); PG8_MMA(0, 1, At, B1); PG8_BAR;
            PG8_LDA(At, 0, 1); PG8_STAGE(PG8_SA(0, 0), a2, voffA);
            PG8_BAR; PG8_WAIT_L(0); PG8_MMA(1, 0, At, B0); PG8_BAR; PG8_SCHED;
            PG8_STAGE(PG8_SB(0, 1), b2 + hstep, voffB);
            PG8_WAIT_V(6); PG8_BAR; PG8_MMA(1, 1, At, B1); PG8_BAR;
            PG8_LDB(B0, 1, 0); PG8_SCHED; PG8_LDA(At, 1, 0); PG8_STAGE(PG8_SA(0, 1), a2 + hstep, voffA);
            PG8_WAIT_L(8); PG8_BAR; PG8_WAIT_L(0); PG8_MMA(0, 0, At, B0); PG8_BAR; PG8_SCHED;
            PG8_LDB(B1, 1, 1); PG8_STAGE(PG8_SB(1, 0), b3, voffB);
            PG8_BAR; PG8_WAIT_L(0); PG8_MMA(0, 1, At, B1); PG8_BAR;
            PG8_LDA(At, 1, 1); PG8_STAGE(PG8_SA(1, 0), a3, voffA);
            PG8_BAR; PG8_WAIT_L(0); PG8_MMA(1, 0, At, B0); PG8_BAR; PG8_SCHED;
            PG8_STAGE(PG8_SB(1, 1), b3 + hstep, voffB);
            PG8_WAIT_V(6); PG8_BAR; PG8_MMA(1, 1, At, B1); PG8_BAR;
            }
        }
        if constexpr (ALIGN_EPI) { if (wr == 0) PG8_BAR; }
        if constexpr (!Epi::AFTER_DRAIN) { E(acc, cur, wr, wc, fr, fq); S.done(cur); }
        if (!has_next) break;
#pragma unroll
        for (int a = 0; a < 2; ++a)
#pragma unroll
            for (int b = 0; b < 2; ++b)
#pragma unroll
                for (int m = 0; m < 4; ++m)
#pragma unroll
                    for (int n = 0; n < 2; ++n) acc[a][b][m][n] = (f32x4){0.f, 0.f, 0.f, 0.f};
        cur = nxt; cA = nA; cB = nB; ++ui;
        if constexpr (ALIGN_EPI) { if (wr == 1) PG8_BAR; }
    }
    PG8_WAIT_V(0);
    if constexpr (!ALIGN_EPI) { if (wr == 0) PG8_BAR; }
    PG8_BAR;
    if constexpr (Epi::AFTER_DRAIN) { E.fused(acc, cur, wr, wc, fr, fq, lds, wid, lane); S.done(cur); }
#undef PG8_SA
#undef PG8_SB
#undef PG8_STAGE
#undef PG8_LDA
#undef PG8_LDB
#undef PG8_MMA
#undef PG8_WAIT_V
#undef PG8_WAIT_L
#undef PG8_BAR
#undef PG8_SCHED
}
}

struct EpiIn {
  static constexpr bool PERM = false, AFTER_DRAIN = false;
  const Params* pp; int l;
  __device__ __forceinline__ void operator()(f32x4 (&acc)[2][2][4][2], const pg8::Unit& u, int wr, int wc, int fr, int fq) const {
    const Params& p = *pp;
    const int U = u.pn * 4 + wc;
    if (U >= 77) return;
    const int rowb = u.pm * 256 + wr * 64 + fr;
    const int bq = (u.pm * 256) / T, tb = rowb % T;
    bf16_t* dst = nullptr; int ld = 0, col0 = 0; const float* gain = nullptr; bool rope = false, silu = false;
    float post = 1.0f;
    bf16_t* vt = nullptr;
    if (U < 8) { dst = WSP(bf16_t, OFF_QN); ld = 512; col0 = U * 64; gain = p.nsa_q_norm + l * 64; rope = true; post = 0.125f * LOG2E; }
    else if (U < 10) { dst = WSP(bf16_t, OFF_KC); ld = 128; col0 = (U - 8) * 64; rope = true; }
    else if (U < 12) { dst = WSP(bf16_t, OFF_VC); ld = 128; col0 = (U - 10) * 64; }
    else if (U < 14) { dst = WSP(bf16_t, OFF_KS); ld = 128; col0 = (U - 12) * 64; gain = p.nsa_k_norm + (l * 3 + 1) * 64; rope = true; }
    else if (U < 16) { vt = WSP(bf16_t, OFF_VST) + (size_t)((bq * 2 + (U - 14)) * 64) * T; }
    else if (U < 18) { dst = WSP(bf16_t, OFF_KW); ld = 128; col0 = (U - 16) * 64; gain = p.nsa_k_norm + (l * 3 + 2) * 64; rope = true; }
    else if (U < 20) { vt = WSP(bf16_t, OFF_VWT) + (size_t)((bq * 2 + (U - 18)) * 64) * T; }
    else if (U < 28) { dst = WSP(bf16_t, OFF_OA); ld = 512; col0 = (U - 20) * 64; silu = true; }
    else if (U < 36) { dst = WSP(bf16_t, OFF_FQ); ld = 512; col0 = (U - 28) * 64; gain = p.fox_q_norm + l * 64; post = 0.125f * LOG2E; }
    else if (U < 44) { dst = WSP(bf16_t, OFF_FK); ld = 512; col0 = (U - 36) * 64; gain = p.fox_k_norm + l * 64; }
    else if (U < 52) { vt = WSP(bf16_t, OFF_FVT) + (size_t)((bq * 8 + (U - 44)) * 64) * T; }
    else if (U < 60) { dst = WSP(bf16_t, OFF_OB); ld = 512; col0 = (U - 52) * 64; silu = true; }
    else if (U < 68) { dst = WSP(bf16_t, OFF_MQ); ld = 512; col0 = (U - 60) * 64; }
    else if (U < 76) { dst = WSP(bf16_t, OFF_OM); ld = 512; col0 = (U - 68) * 64; silu = true; }
    if (U == 76) {
      float* gate = WSP(float, OFF_GATE);
      float* flog = WSP(float, OFF_FLOG);
#pragma unroll
      for (int ai = 0; ai < 2; ++ai)
#pragma unroll
        for (int m = 0; m < 4; ++m) {
          const size_t row = (size_t)rowb + 128 * ai + 16 * m;
#pragma unroll
          for (int n = 0; n < 2; ++n)
#pragma unroll
            for (int i = 0; i < 4; ++i) {
              const int e = 16 * n + 4 * fq + i;
              const float v = acc[ai][0][m][n][i];
              if (e < 24) gate[row * 24 + e] = sigmoidf_(v);
              else {
                const float xx = v + p.fox_f_bias[l * 8 + (e - 24)];
                flog[row * 8 + (e - 24)] = xx >= 0.f ? -log1pf(expf(-xx)) : xx - log1pf(expf(xx));
              }
            }
        }
      return;
    }
    if (vt) {
#pragma unroll
      for (int ai = 0; ai < 2; ++ai)
#pragma unroll
        for (int m = 0; m < 4; ++m) {
          const int t = tb + 128 * ai + 16 * m;
#pragma unroll
          for (int bj = 0; bj < 2; ++bj)
#pragma unroll
            for (int n = 0; n < 2; ++n) {
              const f32x4 v = acc[ai][bj][m][n];
              const unsigned w0 = cvtpk(v[0], v[1]), w1 = cvtpk(v[2], v[3]);
              const unsigned qo = (unsigned)((32 * bj + 16 * n + 4 * fq) * T + t);
              vt[qo] = (bf16_t)(w0 & 0xffffu); vt[qo + T] = (bf16_t)(w0 >> 16); vt[qo + 2 * T] = (bf16_t)(w1 & 0xffffu); vt[qo + 3 * T] = (bf16_t)(w1 >> 16);
            }
        }
      return;
    }
    const float* ropetab = WSP(float, OFF_ROPE);
    f32x4 gv[2][2];
    if (gain) {
#pragma unroll
      for (int bj = 0; bj < 2; ++bj)
#pragma unroll
        for (int n = 0; n < 2; ++n) gv[bj][n] = *(const f32x4*)(gain + 32 * bj + 16 * n + 4 * fq);
    }
#pragma unroll
    for (int ai = 0; ai < 2; ++ai)
#pragma unroll
      for (int m = 0; m < 4; ++m) {
        f32x4 v[2][2];
#pragma unroll
        for (int bj = 0; bj < 2; ++bj)
#pragma unroll
          for (int n = 0; n < 2; ++n) v[bj][n] = acc[ai][bj][m][n];
        const int row = rowb + 128 * ai + 16 * m;
        if (gain) {
          float ss = 0.f;
#pragma unroll
          for (int bj = 0; bj < 2; ++bj)
#pragma unroll
            for (int n = 0; n < 2; ++n)
#pragma unroll
              for (int i = 0; i < 4; ++i) ss += v[bj][n][i] * v[bj][n][i];
          ss += __shfl_xor(ss, 16);
          ss += __shfl_xor(ss, 32);
          const float rstd = rsqrtf(ss * (1.0f / 64.0f) + EPS);
#pragma unroll
          for (int bj = 0; bj < 2; ++bj)
#pragma unroll
            for (int n = 0; n < 2; ++n) v[bj][n] = v[bj][n] * rstd * gv[bj][n];
        }
        if (rope) {
          const int pos = row & (T - 1);
#pragma unroll
          for (int n = 0; n < 2; ++n) {
            const f32x4* tp = (const f32x4*)(ropetab + ((size_t)pos * 32 + 16 * n + 4 * fq) * 2);
            const f32x4 t0 = tp[0], t1 = tp[1];
            const float cs[4] = {t0[0], t0[2], t1[0], t1[2]}, sn[4] = {t0[1], t0[3], t1[1], t1[3]};
#pragma unroll
            for (int i = 0; i < 4; ++i) {
              const float y1 = v[0][n][i], y2 = v[1][n][i];
              v[0][n][i] = y1 * cs[i] - y2 * sn[i];
              v[1][n][i] = y2 * cs[i] + y1 * sn[i];
            }
          }
        }
#pragma unroll
        for (int bj = 0; bj < 2; ++bj)
#pragma unroll
          for (int n = 0; n < 2; ++n) {
            f32x4 y = v[bj][n] * post;
            if (silu) {
#pragma unroll
              for (int i = 0; i < 4; ++i) y[i] = siluf_(y[i]);
            }
            u32x2 w = {cvtpk(y[0], y[1]), cvtpk(y[2], y[3])};
            *(u32x2*)(dst + (size_t)row * ld + col0 + 32 * bj + 16 * n + 4 * fq) = w;
          }
      }
  }
};
struct EpiMemKV {
  static constexpr bool PERM = false, AFTER_DRAIN = false;
  const Params* pp;
  __device__ __forceinline__ void operator()(f32x4 (&acc)[2][2][4][2], const pg8::Unit& u, int wr, int wc, int fr, int fq) const {
    const Params& p = *pp;
    const int U = u.pn * 4 + wc;
    const int rowb = u.pm * 256 + wr * 64 + fr;
#pragma unroll
    for (int ai = 0; ai < 2; ++ai)
#pragma unroll
      for (int m = 0; m < 4; ++m) {
        const int row = rowb + 128 * ai + 16 * m;
#pragma unroll
        for (int bj = 0; bj < 2; ++bj)
#pragma unroll
          for (int n = 0; n < 2; ++n) {
            const f32x4 v = acc[ai][bj][m][n];
            const unsigned w0 = cvtpk(v[0], v[1]), w1 = cvtpk(v[2], v[3]);
            const int e = 32 * bj + 16 * n + 4 * fq;
            if (U < 8) {
              u32x2 w = {w0, w1};
              *(u32x2*)(WSP(bf16_t, OFF_MK) + (size_t)row * 512 + U * 64 + e) = w;
            } else {
              const int col = (U - 8) * 64 + e, h = col >> 7, d = col & 127, b = row >> 8, mm = row & 255;
              bf16_t* q = WSP(bf16_t, OFF_MVT) + (size_t)((b * 4 + h) * 128 + d) * 256 + mm;
              q[0] = (bf16_t)(w0 & 0xffffu); q[256] = (bf16_t)(w0 >> 16); q[512] = (bf16_t)(w1 & 0xffffu); q[768] = (bf16_t)(w1 >> 16);
            }
          }
      }
  }
};
struct EpiGate {
  static constexpr bool PERM = false, AFTER_DRAIN = false;
  bf16_t* G;
  __device__ __forceinline__ void operator()(f32x4 (&acc)[2][2][4][2], const pg8::Unit& u, int wr, int wc, int fr, int fq) const {
    const int br = u.pn >> 2, colt = (u.pn & 3) * 256 + wc * 32 + 4 * fq;
    bf16_t* base = G + (size_t)br * M * 1024;
    const int rowb = u.pm * 256 + wr * 64 + fr;
#pragma unroll
    for (int ai = 0; ai < 2; ++ai)
#pragma unroll
      for (int m = 0; m < 4; ++m) {
        bf16_t* rp = base + (size_t)(rowb + 128 * ai + 16 * m) * 1024 + colt;
#pragma unroll
        for (int bj = 0; bj < 2; ++bj)
#pragma unroll
          for (int n = 0; n < 2; ++n) {
            const f32x4 v = acc[ai][bj][m][n];
            u32x2 w = {cvtpk(sigmoidf_(v[0]), sigmoidf_(v[1])), cvtpk(sigmoidf_(v[2]), sigmoidf_(v[3]))};
            *(u32x2*)(rp + 128 * bj + 16 * n) = w;
          }
      }
  }
};
struct EpiBranch {
  static constexpr bool PERM = false, AFTER_DRAIN = false;
  const bf16_t* G; bf16_t* Uo; int first;
  __device__ __forceinline__ void operator()(f32x4 (&acc)[2][2][4][2], const pg8::Unit& u, int wr, int wc, int fr, int fq) const {
    const int colt = u.pn * 256 + wc * 32 + 4 * fq;
    const int rowb = u.pm * 256 + wr * 64 + fr;
#pragma unroll
    for (int ai = 0; ai < 2; ++ai)
#pragma unroll
      for (int m = 0; m < 4; ++m) {
        const size_t ro = (size_t)(rowb + 128 * ai + 16 * m) * 1024 + colt;
#pragma unroll
        for (int bj = 0; bj < 2; ++bj)
#pragma unroll
          for (int n = 0; n < 2; ++n) {
            const f32x4 v = acc[ai][bj][m][n];
            const size_t off = ro + 128 * bj + 16 * n;
            const u32x2 gw = *(const u32x2*)(G + off);
            float y0 = v[0] * bflo(gw[0]), y1 = v[1] * bfhi(gw[0]), y2 = v[2] * bflo(gw[1]), y3 = v[3] * bfhi(gw[1]);
            if (!first) {
              const u32x2 uw = *(const u32x2*)(Uo + off);
              y0 += bflo(uw[0]); y1 += bfhi(uw[0]); y2 += bflo(uw[1]); y3 += bfhi(uw[1]);
            }
            u32x2 w = {cvtpk(y0, y1), cvtpk(y2, y3)};
            *(u32x2*)(Uo + off) = w;
          }
      }
  }
};
struct EpiOut {
  static constexpr bool PERM = false, AFTER_DRAIN = false;
  const float* xin; float* xout;
  __device__ __forceinline__ void operator()(f32x4 (&acc)[2][2][4][2], const pg8::Unit& u, int wr, int wc, int fr, int fq) const {
    const int colt = u.pn * 256 + wc * 32 + 4 * fq;
    const int rowb = u.pm * 256 + wr * 64 + fr;
#pragma unroll
    for (int ai = 0; ai < 2; ++ai)
#pragma unroll
      for (int m = 0; m < 4; ++m) {
        const size_t ro = (size_t)(rowb + 128 * ai + 16 * m) * 1024 + colt;
#pragma unroll
        for (int bj = 0; bj < 2; ++bj)
#pragma unroll
          for (int n = 0; n < 2; ++n) {
            const size_t off = ro + 128 * bj + 16 * n;
            const f32x4 xv = *(const f32x4*)(xin + off);
            *(f32x4*)(xout + off) = xv + acc[ai][bj][m][n];
          }
      }
  }
};
template <class Epi>
__device__ __forceinline__ void run_gemm(PG8_LAS unsigned char* lds, const bf16_t* A, const bf16_t* Bt, int Mr, int Nc, int K, const Epi& E) {
  pg8::Gemm g{A, Bt, Mr, Nc, K};
  pg8::StaticOrder S;
  S.init(Mr, Nc, gdim(), bidx());
  pg8::gemm_phase<Epi, pg8::StaticOrder, true, true>(lds, g, S, E);
}

__device__ __forceinline__ int map_in(int n) {
  const int i = n >> 6, c = n & 63;
  if (i < 20) return n;
  if (i < 28) return 1304 + (n - 1280);
  if (i < 52) return 1816 + (n - 1792);
  if (i < 60) return 3360 + (n - 3328);
  if (i < 68) return 3872 + (n - 3840);
  if (i < 76) return 4384 + (n - 4352);
  if (i == 76) return c < 24 ? 1280 + c : (c < 32 ? 3352 + (c - 24) : -1);
  return -1;
}
__device__ void transpose_tile(const float* __restrict__ src, int ld_src, int k0, int n0, bf16_t* __restrict__ dst,
                               int Kdim, int maptype, int srccol0, float* tile) {
  const int tid = tidx();
  for (int e = tid; e < 4096; e += NTHREADS) {
    const int kk = e >> 6, nn = e & 63;
    int nlog = n0 + nn;
    if (maptype) { const int w = nlog & 255; nlog = (nlog & ~255) + (((w & 127) >> 5) << 6) + (((w >> 7) << 5) | (w & 31)); }
    const int sc = (maptype == 1) ? map_in(nlog) : srccol0 + nlog;
    tile[kk * 65 + nn] = sc >= 0 ? src[(size_t)(k0 + kk) * ld_src + sc] : 0.f;
  }
  __syncthreads();
  for (int e = tid; e < 2048; e += NTHREADS) {
    const int nn = e >> 5, kp = e & 31;
    const float a = tile[(2 * kp) * 65 + nn], b = tile[(2 * kp + 1) * 65 + nn];
    *(unsigned*)(dst + (size_t)(n0 + nn) * Kdim + k0 + 2 * kp) = cvtpk(a, b);
  }
  __syncthreads();
}
__device__ void rmsnorm_rows(const float* __restrict__ x, const float* __restrict__ gain, bf16_t* __restrict__ dst,
                             int row_begin, int nrows) {
  const int wave = tidx() >> 6, lane = tidx() & 63;
  for (int rr = wave; rr < nrows; rr += NWAVES) {
    const size_t row = (size_t)row_begin + rr;
    const float* xp = x + row * 1024;
    f32x4 v[4];
    float ss = 0.f;
#pragma unroll
    for (int i = 0; i < 4; ++i) {
      v[i] = *(const f32x4*)(xp + lane * 4 + 256 * i);
      ss += v[i][0] * v[i][0] + v[i][1] * v[i][1] + v[i][2] * v[i][2] + v[i][3] * v[i][3];
    }
    ss = wave_sum(ss);
    const float rstd = rsqrtf(ss * (1.0f / 1024.0f) + EPS);
#pragma unroll
    for (int i = 0; i < 4; ++i) {
      const f32x4 gv = *(const f32x4*)(gain + lane * 4 + 256 * i);
      const f32x4 y = v[i] * rstd * gv;
      u32x2 w = {cvtpk(y[0], y[1]), cvtpk(y[2], y[3])};
      *(u32x2*)(dst + row * 1024 + lane * 4 + 256 * i) = w;
    }
  }
}
__device__ void phase_prep(const Params& p, int l, float* smem) {
  const int tid = tidx();
  constexpr int NT_TR = 3076, NT_H = 512, NT_MEMN = 16, NT_C1 = 2, NT_ROPE = 512;
  const int total = NT_TR + NT_H + NT_MEMN + NT_C1 + (l == 0 ? NT_ROPE : 0);
  if (l == 0 && bidx() == 0 && tid < 64) WSP(unsigned, OFF_CTL)[tid] = 0u;
  const float* xin = (l == 0) ? p.x : p.out;
  const int pmult = PROBE_PM2 ? (p.ws != nullptr ? 2 : 1) : 1;
  for (int u0 = bidx(); u0 < total * pmult; u0 += gdim()) {
    int u = u0 % total;
    if (u < NT_TR) {
      const float* src; int ld, kt, nt, Kd, mt = 0, c0 = 0; bf16_t* dst;
      if (u < 1280) { kt = u / 80; nt = u % 80; src = p.w_in + (size_t)l * 1024 * 7968; ld = 7968; Kd = 1024; dst = WSP(bf16_t, OFF_W_IN); mt = 1; }
      else if ((u -= 1280) < 768) { kt = u / 48; nt = u % 48; src = p.w_in + (size_t)l * 1024 * 7968; ld = 7968; Kd = 1024; dst = WSP(bf16_t, OFF_W_G); c0 = 4896; }
      else if ((u -= 768) < 256) { kt = u / 16; nt = u % 16; src = p.w_mem_kv + (size_t)l * 1024 * 1024; ld = 1024; Kd = 1024; dst = WSP(bf16_t, OFF_W_MKV); mt = 2; }
      else if ((u -= 256) < 384) { const int br = u / 128, uu = u % 128; kt = uu / 16; nt = uu % 16;
        src = (br == 0 ? p.w_branch_a : br == 1 ? p.w_branch_b : p.w_branch_m) + (size_t)l * 512 * 1024; ld = 1024; Kd = 512; dst = WSP(bf16_t, OFF_W_BR + (size_t)br * MiB); }
      else if ((u -= 384) < 256) { kt = u / 16; nt = u % 16; src = p.w_out + (size_t)l * 1024 * 1024; ld = 1024; Kd = 1024; dst = WSP(bf16_t, OFF_W_OUT); }
      else if ((u -= 256) < 128) { const int kv = u / 64, uu = u % 64; kt = uu / 2; nt = uu % 2;
        src = (kv ? p.cmp_w1_v : p.cmp_w1_k) + (size_t)l * 2048 * 128; ld = 128; Kd = 2048; dst = WSP(bf16_t, OFF_W1 + (size_t)kv * 512 * 1024); }
      else { u -= 128; const int kv = u / 2; kt = u % 2; nt = 0;
        src = (kv ? p.cmp_w2_v : p.cmp_w2_k) + (size_t)l * 128 * 64; ld = 64; Kd = 128; dst = WSP(bf16_t, OFF_W2 + (size_t)kv * 64 * 1024); }
      transpose_tile(src, ld, kt * 64, nt * 64, dst, Kd, mt, c0, smem);
    } else if ((u -= NT_TR) < NT_H) {
      rmsnorm_rows(xin, p.norm_g + l * 1024, WSP(bf16_t, OFF_H), u * 64, 64);
    } else if ((u -= NT_H) < NT_MEMN) {
      rmsnorm_rows(p.mem, p.mem_norm_g + l * 1024, WSP(bf16_t, OFF_MEMN), u * 64, 64);
    } else if ((u -= NT_MEMN) < NT_C1) {
      const float* pe = (u ? p.cmp_pe_v : p.cmp_pe_k) + (size_t)l * 2048;
      const float* w1 = (u ? p.cmp_w1_v : p.cmp_w1_k) + (size_t)l * 2048 * 128;
      constexpr int NPART = NTHREADS / 128, KPER = 2048 / NPART;
      const int n = tid & 127, part = tid >> 7;
      float s = 0.f;
      for (int kk = part * KPER; kk < part * KPER + KPER; ++kk) s += pe[kk] * w1[(size_t)kk * 128 + n];
      smem[part * 128 + n] = s;
      __syncthreads();
      if (tid < 128) { float tot = 0.f; for (int q = 0; q < NPART; ++q) tot += smem[q * 128 + tid]; WSP(float, OFF_C1)[u * 128 + tid] = tot; }
      __syncthreads();
    } else {
      u -= NT_C1;
      for (int e = tid; e < 512; e += NTHREADS) {
        const int idx = u * 512 + e, pos = idx >> 5, f = idx & 31;
        const float ang = (float)pos * c_inv_freq[f];
        const double a = (double)ang;
        const double k = rint(a * 0.15915494309189535);
        const float rr = (float)(a - k * 6.283185307179586);
        float2 cs; cs.x = __cosf(rr); cs.y = __sinf(rr);
        WSP(float2, OFF_ROPE)[idx] = cs;
      }
    }
  }
}

__device__ void compress_unit(const Params& p, int l, int u) {
  const int lane = tidx() & 63, r = lane & 15, g4 = lane >> 4;
  const int kv = u >> 7, rem = u & 127, b = rem >> 5, grp = (rem >> 4) & 1, it = rem & 15, i0 = it * 32;
  const bf16_t* src = WSP(bf16_t, kv ? OFF_VC : OFF_KC);
  const bf16_t* w1t = WSP(bf16_t, OFF_W1 + (size_t)kv * 512 * 1024);
  const bf16_t* w2t = WSP(bf16_t, OFF_W2 + (size_t)kv * 64 * 1024);
  const float* c1 = WSP(float, OFF_C1) + kv * 128;
  const bf16_t* arow[2];
#pragma unroll
  for (int mt = 0; mt < 2; ++mt) {
    int i = i0 + 16 * mt + r;
    if (i > 510) i = 510;
    arow[mt] = src + ((size_t)b * T + 16 * i) * 128 + grp * 64 + g4 * 8;
  }
  f32x4 acc[2][8];
#pragma unroll
  for (int a = 0; a < 2; ++a)
#pragma unroll
    for (int c = 0; c < 8; ++c) acc[a][c] = (f32x4){0.f, 0.f, 0.f, 0.f};
  const bf16_t* bp = w1t + (size_t)r * 2048 + g4 * 8;
  for (int k0 = 0; k0 < 2048; k0 += 32) {
    const int pp = k0 >> 6, d = k0 & 63;
    bf16x8 af[2], bf[8];
#pragma unroll
    for (int mt = 0; mt < 2; ++mt) af[mt] = *(const bf16x8*)(arow[mt] + (size_t)pp * 128 + d);
#pragma unroll
    for (int nt = 0; nt < 8; ++nt) bf[nt] = *(const bf16x8*)(bp + (size_t)nt * 16 * 2048 + k0);
#pragma unroll
    for (int mt = 0; mt < 2; ++mt)
#pragma unroll
      for (int nt = 0; nt < 8; ++nt) acc[mt][nt] = mfma16(bf[nt], af[mt], acc[mt][nt]);
  }
#pragma unroll
  for (int nt = 0; nt < 8; ++nt) {
    const f32x4 cv = *(const f32x4*)(c1 + 16 * nt + 4 * g4);
#pragma unroll
    for (int mt = 0; mt < 2; ++mt)
#pragma unroll
      for (int i = 0; i < 4; ++i) acc[mt][nt][i] = siluf_(acc[mt][nt][i] + cv[i]);
  }
  bf16x8 wf[4][4];
#pragma unroll
  for (int ks = 0; ks < 4; ++ks)
#pragma unroll
    for (int et = 0; et < 4; ++et) {
      const bf16_t* wp = w2t + (size_t)(16 * et + r) * 128 + 32 * ks + 4 * g4;
      const u32x2 lo = *(const u32x2*)wp, hi = *(const u32x2*)(wp + 16);
      u32x4 w = {lo[0], lo[1], hi[0], hi[1]};
      wf[ks][et] = __builtin_bit_cast(bf16x8, w);
    }
  if (kv == 0) {
    const float* gain = p.nsa_k_norm + (size_t)(l * 3 + 0) * 64;
    bf16_t* dst = WSP(bf16_t, OFF_KCMP) + (size_t)((b * 2 + grp) * 512) * 64;
    f32x4 gv[4];
#pragma unroll
    for (int et = 0; et < 4; ++et) gv[et] = *(const f32x4*)(gain + 16 * et + 4 * g4);
#pragma unroll
    for (int mt = 0; mt < 2; ++mt) {
      f32x4 o[4];
#pragma unroll
      for (int et = 0; et < 4; ++et) o[et] = (f32x4){0.f, 0.f, 0.f, 0.f};
#pragma unroll
      for (int ks = 0; ks < 4; ++ks) {
        const bf16x8 xf = pack8(acc[mt][2 * ks], acc[mt][2 * ks + 1]);
#pragma unroll
        for (int et = 0; et < 4; ++et) o[et] = mfma16(wf[ks][et], xf, o[et]);
      }
      float ss = 0.f;
#pragma unroll
      for (int et = 0; et < 4; ++et)
#pragma unroll
        for (int i = 0; i < 4; ++i) ss += o[et][i] * o[et][i];
      ss += __shfl_xor(ss, 16);
      ss += __shfl_xor(ss, 32);
      const float rstd = rsqrtf(ss * (1.0f / 64.0f) + EPS);
      const int i = i0 + 16 * mt + r;
#pragma unroll
      for (int et = 0; et < 4; ++et) {
        f32x4 y = o[et] * rstd * gv[et];
        if (i > 510) y = (f32x4){0.f, 0.f, 0.f, 0.f};
        u32x2 w = {cvtpk(y[0], y[1]), cvtpk(y[2], y[3])};
        *(u32x2*)(dst + (size_t)i * 64 + 16 * et + 4 * g4) = w;
      }
    }
  } else {
    bf16_t* dst = WSP(bf16_t, OFF_VCT) + (size_t)((b * 2 + grp) * 64) * 512;
#pragma unroll
    for (int mt = 0; mt < 2; ++mt) {
      f32x4 o[4];
#pragma unroll
      for (int et = 0; et < 4; ++et) o[et] = (f32x4){0.f, 0.f, 0.f, 0.f};
#pragma unroll
      for (int ks = 0; ks < 4; ++ks) {
        const bf16x8 xf = pack8(acc[mt][2 * ks], acc[mt][2 * ks + 1]);
#pragma unroll
        for (int et = 0; et < 4; ++et) o[et] = mfma16(xf, wf[ks][et], o[et]);
      }
#pragma unroll
      for (int et = 0; et < 4; ++et) {
        f32x4 y = o[et];
        const int ib = i0 + 16 * mt + 4 * g4;
#pragma unroll
        for (int i = 0; i < 4; ++i)
          if (ib + i > 510) y[i] = 0.f;
        u32x2 w = {cvtpk(y[0], y[1]), cvtpk(y[2], y[3])};
        *(u32x2*)(dst + (size_t)(16 * et + r) * 512 + ib) = w;
      }
    }
  }
}
__device__ void cumsum_unit(const Params& p, int u) {
  const int lane = tidx() & 63, b = u >> 3, h = u & 7;
  const float* fl = WSP(float, OFF_FLOG) + ((size_t)b * T) * 8 + h;
  float* fc = WSP(float, OFF_FC) + (size_t)(b * 8 + h) * T;
  const int tb = lane * 128;
  double s = 0.0;
  for (int i = 0; i < 128; ++i) s += (double)fl[(size_t)(tb + i) * 8];
  double incl = s;
#pragma unroll
  for (int o = 1; o < 64; o <<= 1) {
    const double y = __shfl_up(incl, o);
    if (lane >= o) incl += y;
  }
  double run = incl - s;
  for (int i = 0; i < 128; ++i) {
    run += (double)fl[(size_t)(tb + i) * 8];
    fc[tb + i] = (float)run;
  }
}
__device__ void memk_norm_unit(const Params& p, int l, int u) {
  const int lane = tidx() & 63;
  bf16_t* mk = WSP(bf16_t, OFF_MK);
  const float* gain = p.mem_k_norm + l * 128 + (lane & 15) * 8;
  for (int rr = 0; rr < 16; ++rr) {
    bf16_t* ptr = mk + (size_t)(u * 16 + rr) * 512 + lane * 8;
    const u32x4 w = *(const u32x4*)ptr;
    float v[8];
#pragma unroll
    for (int j = 0; j < 4; ++j) { v[2 * j] = bflo(w[j]); v[2 * j + 1] = bfhi(w[j]); }
    float ss = 0.f;
#pragma unroll
    for (int j = 0; j < 8; ++j) ss += v[j] * v[j];
#pragma unroll
    for (int o = 1; o < 16; o <<= 1) ss += __shfl_xor(ss, o);
    const float rstd = rsqrtf(ss * (1.0f / 128.0f) + EPS);
    u32x4 ow;
#pragma unroll
    for (int j = 0; j < 4; ++j) ow[j] = cvtpk(v[2 * j] * rstd * gain[2 * j], v[2 * j + 1] * rstd * gain[2 * j + 1]);
    *(u32x4*)ptr = ow;
  }
}
__device__ void phase_mid(const Params& p, int l) {
  const int wave = tidx() >> 6;
  const int gw = wave * gdim() + bidx(), nw = NWAVES * gdim();
  const int mult = PROBE_PM2 ? (p.ws != nullptr ? 2 : 1) : 1;
  for (int uu = gw; uu < (256 + 32 + 64) * mult; uu += nw) {
    const int u = uu % (256 + 32 + 64);
    if (u < 256) compress_unit(p, l, u);
    else if (u < 288) cumsum_unit(p, u - 256);
    else if (uu < 256 + 32 + 64) memk_norm_unit(p, l, u - 288);
  }
}

template <int NCT, int NDK, bool QL = false>
__device__ __forceinline__ void qk_scores(const bf16_t* __restrict__ kbase, int ldk, int key0,
                                          const bf16x8 (&qf)[NCT][NDK], f32x4 (&s)[2][NCT], int lane, const bf16x8* qlds = nullptr) {
  const int r = lane & 15, grp = lane >> 4;
#pragma unroll
  for (int kt = 0; kt < 2; ++kt) {
    const bf16_t* kp = kbase + (size_t)(key0 + 8 * (r >> 2) + 4 * kt + (r & 3)) * ldk + grp * 8;
    bf16x8 kf[NDK];
#pragma unroll
    for (int dk = 0; dk < NDK; ++dk) kf[dk] = *(const bf16x8*)(kp + dk * 32);
#pragma unroll
    for (int ct = 0; ct < NCT; ++ct) {
      f32x4 a = {0.f, 0.f, 0.f, 0.f};
#pragma unroll
      for (int dk = 0; dk < NDK; ++dk) a = mfma16(kf[dk], QL ? qlds[(ct * NDK + dk) * 64 + lane] : qf[ct][dk], a);
      s[kt][ct] = a;
    }
  }
}
template <int NCT, int NDT>
__device__ __forceinline__ void pv_accum(const bf16_t* __restrict__ vt, size_t ldv, int key0,
                                         const f32x4 (&s)[2][NCT], f32x4 (&o)[NDT][NCT], int lane) {
  const int r = lane & 15, grp = lane >> 4;
  bf16x8 pb[NCT];
#pragma unroll
  for (int ct = 0; ct < NCT; ++ct) pb[ct] = pack8(s[0][ct], s[1][ct]);
#pragma unroll
  for (int dt = 0; dt < NDT; ++dt) {
    const bf16x8 vf = *(const bf16x8*)(vt + (size_t)(16 * dt + r) * ldv + key0 + 8 * grp);
#pragma unroll
    for (int ct = 0; ct < NCT; ++ct) o[dt][ct] = mfma16(vf, pb[ct], o[dt][ct]);
  }
}
template <int NCT, int NDT, bool HAS_O>
__device__ __forceinline__ void softmax_update(f32x4 (&s)[2][NCT], float (&m)[NCT], float (&lsum)[NCT],
                                               f32x4 (&o)[NDT][NCT]) {
  float mnew[NCT];
  bool ch = false;
#pragma unroll
  for (int ct = 0; ct < NCT; ++ct) {
    float mx = fmaxf(fmaxf(fmaxf(s[0][ct][0], s[0][ct][1]), fmaxf(s[0][ct][2], s[0][ct][3])),
                     fmaxf(fmaxf(s[1][ct][0], s[1][ct][1]), fmaxf(s[1][ct][2], s[1][ct][3])));
    mx = fmaxf(mx, __shfl_xor(mx, 16));
    mx = fmaxf(mx, __shfl_xor(mx, 32));
    mnew[ct] = fmaxf(m[ct], mx);
    ch = ch || (mnew[ct] > m[ct]);
  }
  if (__any(ch)) {
#pragma unroll
    for (int ct = 0; ct < NCT; ++ct) {
      const float msafe = (mnew[ct] == NEG_INF) ? 0.f : mnew[ct];
      const float alpha = __builtin_amdgcn_exp2f(m[ct] - msafe);
      m[ct] = mnew[ct];
      lsum[ct] *= alpha;
      if (HAS_O) {
#pragma unroll
        for (int dt = 0; dt < NDT; ++dt) o[dt][ct] = o[dt][ct] * alpha;
      }
    }
  }
#pragma unroll
  for (int ct = 0; ct < NCT; ++ct) {
    const float msafe = (m[ct] == NEG_INF) ? 0.f : m[ct];
    float ps = 0.f;
#pragma unroll
    for (int kt = 0; kt < 2; ++kt)
#pragma unroll
      for (int i = 0; i < 4; ++i) {
        const float pv = __builtin_amdgcn_exp2f(s[kt][ct][i] - msafe);
        s[kt][ct][i] = pv;
        ps += pv;
      }
    lsum[ct] += ps;
  }
}
__device__ __forceinline__ float finish_l(float lsum) {
  lsum += __shfl_xor(lsum, 16);
  lsum += __shfl_xor(lsum, 32);
  return lsum > 0.f ? 1.0f / lsum : 0.f;
}

typedef __attribute__((address_space(3))) unsigned char lds_u8;
constexpr int TILE_ROWB = 144, TILE_HALF = 64 * TILE_ROWB, TILE_STAGE = 2 * TILE_HALF + 256;
struct TileRegs { u32x4 k, v; };
__device__ __forceinline__ void tile_gload(TileRegs& tr, const bf16_t* __restrict__ kbase, int ldk, const bf16_t* __restrict__ vtbase,
                                           size_t ldv, int key0, int tid) {
  const int row = tid >> 3, ch = tid & 7;
  tr.k = *(const u32x4*)(kbase + (size_t)(key0 + row) * ldk + ch * 8);
  tr.v = *(const u32x4*)(vtbase + (size_t)row * ldv + key0 + ch * 8);
}
__device__ __forceinline__ void tile_swrite(const TileRegs& tr, lds_u8* stage, int tid) {
  const int row = tid >> 3, ch = tid & 7;
  *(__attribute__((address_space(3))) u32x4*)(stage + row * TILE_ROWB + ch * 16) = tr.k;
  *(__attribute__((address_space(3))) u32x4*)(stage + TILE_HALF + row * TILE_ROWB + ch * 16) = tr.v;
}
template <int NCT, int NDK, bool QL>
__device__ __forceinline__ void qk_scores_lds(const lds_u8* stage, int hf, const bf16x8 (&qf)[NCT][NDK], f32x4 (&s)[2][NCT], int lane,
                                              const bf16x8* qlds, const f32x4 c0, const f32x4 c1) {
  const int r = lane & 15, grp = lane >> 4;
#pragma unroll
  for (int kt = 0; kt < 2; ++kt) {
    const lds_u8* kp = stage + (32 * hf + 8 * (r >> 2) + 4 * kt + (r & 3)) * TILE_ROWB + grp * 16;
    bf16x8 kf[NDK];
#pragma unroll
    for (int dk = 0; dk < NDK; ++dk) kf[dk] = *(const __attribute__((address_space(3))) bf16x8*)(kp + dk * 64);
#pragma unroll
    for (int ct = 0; ct < NCT; ++ct) {
      f32x4 a = kt ? c1 : c0;
#pragma unroll
      for (int dk = 0; dk < NDK; ++dk) a = mfma16(kf[dk], QL ? qlds[(ct * NDK + dk) * 64 + lane] : qf[ct][dk], a);
      s[kt][ct] = a;
    }
  }
}
template <int NCT, int NDT>
__device__ __forceinline__ void pv_accum_lds(const lds_u8* stage, int hf, const f32x4 (&s)[2][NCT], f32x4 (&o)[NDT][NCT], int lane) {
  const int r = lane & 15, grp = lane >> 4;
  bf16x8 pb[NCT];
#pragma unroll
  for (int ct = 0; ct < NCT; ++ct) pb[ct] = pack8(s[0][ct], s[1][ct]);
#pragma unroll
  for (int dt = 0; dt < NDT; ++dt) {
    const bf16x8 vf = *(const __attribute__((address_space(3))) bf16x8*)(stage + TILE_HALF + (16 * dt + r) * TILE_ROWB + (32 * hf + 8 * grp) * 2);
#pragma unroll
    for (int ct = 0; ct < NCT; ++ct) o[dt][ct] = mfma16(vf, pb[ct], o[dt][ct]);
  }
}
__device__ __forceinline__ int next_bit(unsigned long long lo, unsigned long long hi, int from) {
  if (from < 64) { const unsigned long long mm = lo & (~0ull << from); if (mm) return __ffsll(mm) - 1; from = 64; }
  if (from < 128) { const unsigned long long mm = hi & (~0ull << (from - 64)); if (mm) return 64 + __ffsll(mm) - 1; }
  return 128;
}

__device__ void nsa_wg_unit(const Params& p, int b, int g, int qi, float* imp, bf16x8* qlds, float* scr, lds_u8* tiles, unsigned* misc, bool st) {
  const int tid0 = tidx();
  const int wave = __builtin_amdgcn_readfirstlane(tid0 >> 6);
  const int lane0 = tid0 & 63;
  const int tq = qi * 8 + wave;
  const int t0 = tq * 16;
  const bf16x8 (&qf)[4][2] = *(const bf16x8 (*)[4][2])nullptr;
#define NSA_SECTION_VARS \
  int lane = lane0; asm volatile("" : "+v"(lane)); \
  const int r = lane & 15, grp = lane >> 4, t = t0 + r; \
  const size_t row = (size_t)b * T + t; \
  const float* gatep = WSP(float, OFF_GATE) + row * 24 + g * 12; (void)gatep; (void)grp; (void)t;
  {
    NSA_SECTION_VARS
#pragma unroll
    for (int ct = 0; ct < 4; ++ct)
#pragma unroll
      for (int dk = 0; dk < 2; ++dk)
        qlds[(ct * 2 + dk) * 64 + lane] = *(const bf16x8*)(WSP(bf16_t, OFF_QN) + row * 512 + (g * 4 + ct) * 64 + dk * 32 + grp * 8);
  }
  f32x4 o[4][4];
  float m[4], lsum[4];
  {
    NSA_SECTION_VARS
    const bf16_t* kc = WSP(bf16_t, OFF_KCMP) + (size_t)((b * 2 + g) * 512) * 64;
    const bf16_t* vct = WSP(bf16_t, OFF_VCT) + (size_t)((b * 2 + g) * 64) * 512;
    const int nblk = (tq + 31) >> 5;
#pragma unroll
    for (int ct = 0; ct < 4; ++ct) { m[ct] = NEG_INF; lsum[ct] = 0.f; }
#pragma unroll 1
    for (int blk = 0; blk < nblk; ++blk) {
      f32x4 s[2][4];
      qk_scores<4, 2, true>(kc, 64, blk * 32, qf, s, lane, qlds);
#pragma unroll
      for (int kt = 0; kt < 2; ++kt)
#pragma unroll
        for (int i = 0; i < 4; ++i) {
          const int n = blk * 32 + 8 * grp + 4 * kt + i;
          const bool ok = (16 * n + 31 <= t);
#pragma unroll
          for (int ct = 0; ct < 4; ++ct) s[kt][ct][i] = ok ? s[kt][ct][i] : NEG_INF;
        }
      softmax_update<4, 4, false>(s, m, lsum, o);
    }
    float invl[4], msafe[4];
#pragma unroll
    for (int ct = 0; ct < 4; ++ct) { invl[ct] = finish_l(lsum[ct]); msafe[ct] = (m[ct] == NEG_INF) ? 0.f : m[ct]; }
    for (int e = lane; e < 16 * 132; e += 64) imp[e] = 0.f;
    __builtin_amdgcn_fence(__ATOMIC_SEQ_CST, "workgroup");
    __builtin_amdgcn_wave_barrier();
#pragma unroll
    for (int dt = 0; dt < 4; ++dt)
#pragma unroll
      for (int ct = 0; ct < 4; ++ct) o[dt][ct] = (f32x4){0.f, 0.f, 0.f, 0.f};
#pragma unroll 1
    for (int blk = 0; blk < nblk; ++blk) {
      f32x4 s[2][4];
      qk_scores<4, 2, true>(kc, 64, blk * 32, qf, s, lane, qlds);
      float pq[2][4];
#pragma unroll
      for (int kt = 0; kt < 2; ++kt)
#pragma unroll
        for (int i = 0; i < 4; ++i) {
          const int n = blk * 32 + 8 * grp + 4 * kt + i;
          const bool ok = (16 * n + 31 <= t);
          float acc_p = 0.f;
#pragma unroll
          for (int ct = 0; ct < 4; ++ct) {
            const float pv = ok ? __builtin_amdgcn_exp2f(s[kt][ct][i] - msafe[ct]) * invl[ct] : 0.f;
            s[kt][ct][i] = pv;
            acc_p += pv;
          }
          pq[kt][i] = acc_p;
        }
      float* ir = imp + r * 132 + blk * 8 + 2 * grp;
      ir[0] += pq[0][0] + pq[0][1] + pq[0][2] + 0.5f * pq[0][3];
      __builtin_amdgcn_fence(__ATOMIC_SEQ_CST, "workgroup");
      __builtin_amdgcn_wave_barrier();
      ir[1] += pq[1][0] + pq[1][1] + pq[1][2] + 0.5f * pq[1][3] + 0.5f * pq[0][3];
      __builtin_amdgcn_fence(__ATOMIC_SEQ_CST, "workgroup");
      __builtin_amdgcn_wave_barrier();
      ir[2] += 0.5f * pq[1][3];
      __builtin_amdgcn_fence(__ATOMIC_SEQ_CST, "workgroup");
      __builtin_amdgcn_wave_barrier();
      pv_accum<4, 4>(vct, 512, blk * 32, s, o, lane);
    }
    f32x4 gt[4];
#pragma unroll
    for (int ct = 0; ct < 4; ++ct) gt[ct][0] = gatep[ct * 3 + 0];
#pragma unroll
    for (int dt = 0; dt < 4; ++dt) {
#pragma unroll
      for (int ct = 0; ct < 4; ++ct)
#pragma unroll
        for (int i = 0; i < 4; ++i) scr[((dt * 4 + ct) * 4 + i) * 64 + lane] = o[dt][ct][i] * gt[ct][0];
      asm volatile("" ::: "memory");
    }
  }
  const int cur = t0 >> 6;
  unsigned long long sel_lo = 0ull, sel_hi = 0ull;
  {
  NSA_SECTION_VARS
  if (cur <= 15) {
    sel_lo = (1ull << (cur + 1)) - 1ull;
  } else {
    __builtin_amdgcn_fence(__ATOMIC_SEQ_CST, "workgroup");
    __builtin_amdgcn_wave_barrier();
    float v[32];
#pragma unroll
    for (int k = 0; k < 32; ++k) {
      const int j = grp + 4 * k;
      const float x = imp[r * 132 + j];
      v[k] = (j >= 1 && j <= cur - 2) ? x : NEG_INF;
    }
#pragma unroll 1
    for (int round = 0; round < 13; ++round) {
      float best = NEG_INF;
      int bj = 1 << 20;
#pragma unroll
      for (int k = 0; k < 32; ++k) {
        const bool tk = v[k] > best;
        best = tk ? v[k] : best;
        bj = tk ? (grp + 4 * k) : bj;
      }
#pragma unroll
      for (int off = 16; off <= 32; off <<= 1) {
        const float ob = __shfl_xor(best, off);
        const int oj = __shfl_xor(bj, off);
        const bool tk = (ob > best) || (ob == best && oj < bj);
        best = tk ? ob : best;
        bj = tk ? oj : bj;
      }
      if (bj < 64) sel_lo |= 1ull << bj; else if (bj < 128) sel_hi |= 1ull << (bj - 64);
#pragma unroll
      for (int k = 0; k < 32; ++k) v[k] = (bj == grp + 4 * k) ? NEG_INF : v[k];
    }
    sel_lo |= 1ull;
    if (cur < 64) sel_lo |= 1ull << cur; else sel_hi |= 1ull << (cur - 64);
    if (cur - 1 < 64) sel_lo |= 1ull << (cur - 1); else sel_hi |= 1ull << (cur - 1 - 64);
  }
  }
  asm volatile("" : "+v"(sel_lo), "+v"(sel_hi));
  atomicOr(&misc[4], (unsigned)sel_lo); atomicOr(&misc[5], (unsigned)(sel_lo >> 32));
  atomicOr(&misc[6], (unsigned)sel_hi); atomicOr(&misc[7], (unsigned)(sel_hi >> 32));
  __syncthreads();
  unsigned long long ulo, uhi;
  {
    const unsigned u0 = __builtin_amdgcn_readfirstlane(misc[4]), u1 = __builtin_amdgcn_readfirstlane(misc[5]);
    const unsigned u2 = __builtin_amdgcn_readfirstlane(misc[6]), u3 = __builtin_amdgcn_readfirstlane(misc[7]);
    ulo = ((unsigned long long)u1 << 32) | u0; uhi = ((unsigned long long)u3 << 32) | u2;
  }
  {
    NSA_SECTION_VARS
    const int tid = (wave << 6) | lane;
    const bf16_t* ks = WSP(bf16_t, OFF_KS) + ((size_t)b * T) * 128 + g * 64;
    const bf16_t* vst = WSP(bf16_t, OFF_VST) + (size_t)((b * 2 + g) * 64) * T;
#pragma unroll
    for (int ct = 0; ct < 4; ++ct) { m[ct] = NEG_INF; lsum[ct] = 0.f; }
#pragma unroll
    for (int dt = 0; dt < 4; ++dt)
#pragma unroll
      for (int ct = 0; ct < 4; ++ct) o[dt][ct] = (f32x4){0.f, 0.f, 0.f, 0.f};
    TileRegs tr;
    int j = next_bit(ulo, uhi, 0), it = 0;
    tile_gload(tr, ks, 128, vst, T, 64 * j, tid);
    tile_swrite(tr, tiles, tid);
    __syncthreads();
#pragma unroll 1
    while (j < 128) {
      const int jn = next_bit(ulo, uhi, j + 1);
      if (jn < 128) tile_gload(tr, ks, 128, vst, T, 64 * jn, tid);
      const lds_u8* stage = tiles + (it & 1) * TILE_STAGE;
      const bool mine = ((j < 64 ? (sel_lo >> j) : (sel_hi >> (j - 64))) & 1ull) != 0ull;
      if (__any(mine)) {
#pragma unroll 1
        for (int hf = 0; hf < 2; ++hf) {
          const int key0 = j * 64 + hf * 32;
          f32x4 s[2][4];
          const float mv = mine ? 0.f : NEG_INF;
          const f32x4 cm = {mv, mv, mv, mv};
          qk_scores_lds<4, 2, true>(stage, hf, qf, s, lane, qlds, cm, cm);
          if (j == cur) {
#pragma unroll
            for (int kt = 0; kt < 2; ++kt)
#pragma unroll
              for (int i = 0; i < 4; ++i) {
                const int key = key0 + 8 * grp + 4 * kt + i;
                const bool ok = (key <= t);
#pragma unroll
                for (int ct = 0; ct < 4; ++ct) s[kt][ct][i] = ok ? s[kt][ct][i] : NEG_INF;
              }
          }
          softmax_update<4, 4, true>(s, m, lsum, o);
          pv_accum_lds<4, 4>(stage, hf, s, o, lane);
        }
      }
      if (jn < 128) tile_swrite(tr, tiles + ((it + 1) & 1) * TILE_STAGE, tid);
      __syncthreads();
      j = jn; ++it;
    }
    float sc2[4];
#pragma unroll
    for (int ct = 0; ct < 4; ++ct) sc2[ct] = finish_l(lsum[ct]) * gatep[ct * 3 + 1];
#pragma unroll
    for (int dt = 0; dt < 4; ++dt) {
#pragma unroll
      for (int ct = 0; ct < 4; ++ct)
#pragma unroll
        for (int i = 0; i < 4; ++i) scr[((dt * 4 + ct) * 4 + i) * 64 + lane] += o[dt][ct][i] * sc2[ct];
      asm volatile("" ::: "memory");
    }
  }
  {
    NSA_SECTION_VARS
    const int tid = (wave << 6) | lane;
    const bf16_t* kw = WSP(bf16_t, OFF_KW) + ((size_t)b * T) * 128 + g * 64;
    const bf16_t* vwt = WSP(bf16_t, OFF_VWT) + (size_t)((b * 2 + g) * 64) * T;
#pragma unroll
    for (int ct = 0; ct < 4; ++ct) { m[ct] = NEG_INF; lsum[ct] = 0.f; }
#pragma unroll
    for (int dt = 0; dt < 4; ++dt)
#pragma unroll
      for (int ct = 0; ct < 4; ++ct) o[dt][ct] = (f32x4){0.f, 0.f, 0.f, 0.f};
    int kstart = qi * 128 - 512;
    if (kstart < 0) kstart = 0;
    const int kend = qi * 128 + 64;
    TileRegs tr;
    int it = 0;
    tile_gload(tr, kw, 128, vwt, T, kstart, tid);
    tile_swrite(tr, tiles, tid);
    __syncthreads();
#pragma unroll 1
    for (int k0 = kstart; k0 <= kend; k0 += 64, ++it) {
      if (k0 + 64 <= kend) tile_gload(tr, kw, 128, vwt, T, k0 + 64, tid);
      const lds_u8* stage = tiles + (it & 1) * TILE_STAGE;
      if (k0 <= t0 + 15 && k0 + 63 + 512 > t0) {
#pragma unroll 1
        for (int hf = 0; hf < 2; ++hf) {
          const int key0 = k0 + hf * 32;
          f32x4 s[2][4];
          const f32x4 cz = {0.f, 0.f, 0.f, 0.f};
          qk_scores_lds<4, 2, true>(stage, hf, qf, s, lane, qlds, cz, cz);
          if (!(k0 + 63 <= t0 && k0 + 512 > t0 + 15)) {
#pragma unroll
            for (int kt = 0; kt < 2; ++kt)
#pragma unroll
              for (int i = 0; i < 4; ++i) {
                const int key = key0 + 8 * grp + 4 * kt + i;
                const bool ok = (key <= t) && (key + 512 > t);
#pragma unroll
                for (int ct = 0; ct < 4; ++ct) s[kt][ct][i] = ok ? s[kt][ct][i] : NEG_INF;
              }
          }
          softmax_update<4, 4, true>(s, m, lsum, o);
          pv_accum_lds<4, 4>(stage, hf, s, o, lane);
        }
      }
      if (k0 + 64 <= kend) tile_swrite(tr, tiles + ((it + 1) & 1) * TILE_STAGE, tid);
      __syncthreads();
    }
    float sc2[4];
#pragma unroll
    for (int ct = 0; ct < 4; ++ct) sc2[ct] = finish_l(lsum[ct]) * gatep[ct * 3 + 2];
    bf16_t* oa = WSP(bf16_t, OFF_OA) + row * 512 + g * 256;
#pragma unroll
    for (int dt = 0; dt < 4; ++dt)
#pragma unroll
      for (int ct = 0; ct < 4; ++ct) {
        bf16_t* ptr = oa + ct * 64 + 16 * dt + 4 * grp;
        const u32x2 sw = *(const u32x2*)ptr;
        float val[4];
#pragma unroll
        for (int i = 0; i < 4; ++i) val[i] = scr[((dt * 4 + ct) * 4 + i) * 64 + lane] + o[dt][ct][i] * sc2[ct];
        u32x2 w = {cvtpk(val[0] * bflo(sw[0]), val[1] * bfhi(sw[0])), cvtpk(val[2] * bflo(sw[1]), val[3] * bfhi(sw[1]))};
        if (st) *(u32x2*)ptr = w;
        asm volatile("" ::: "memory");
      }
  }
#undef NSA_SECTION_VARS
}

__device__ void fox_wg_unit(const Params& p, int b, int h, int qb, lds_u8* tiles, bool st) {
  const int tid = tidx();
  const int wave = __builtin_amdgcn_readfirstlane(tid >> 6);
  const int lane = tid & 63, r = lane & 15, grp = lane >> 4;
  const int t0 = qb * 512 + wave * 64;
  bf16x8 qf[4][2];
  const float* fc = WSP(float, OFF_FC) + (size_t)(b * 8 + h) * T;
#pragma unroll
  for (int ct = 0; ct < 4; ++ct) {
    const size_t row = (size_t)b * T + t0 + 16 * ct + r;
#pragma unroll
    for (int dk = 0; dk < 2; ++dk)
      qf[ct][dk] = *(const bf16x8*)(WSP(bf16_t, OFF_FQ) + row * 512 + h * 64 + dk * 32 + grp * 8);
  }
  const bf16_t* kb = WSP(bf16_t, OFF_FK) + ((size_t)b * T) * 512 + h * 64;
  const bf16_t* vt = WSP(bf16_t, OFF_FVT) + (size_t)((b * 8 + h) * 64) * T;
  f32x4 o[4][4];
  float m[4], lsum[4];
#pragma unroll
  for (int ct = 0; ct < 4; ++ct) { m[ct] = NEG_INF; lsum[ct] = 0.f; }
#pragma unroll
  for (int dt = 0; dt < 4; ++dt)
#pragma unroll
    for (int ct = 0; ct < 4; ++ct) o[dt][ct] = (f32x4){0.f, 0.f, 0.f, 0.f};
  const int ntiles = (qb + 1) * 8;
  TileRegs tr;
  float ckr = 0.f;
  tile_gload(tr, kb, 512, vt, T, 0, tid);
  if (tid < 64) ckr = fc[tid] * (-LOG2E);
  tile_swrite(tr, tiles, tid);
  if (tid < 64) *(__attribute__((address_space(3))) float*)(tiles + 2 * TILE_HALF + tid * 4) = ckr;
  __syncthreads();
#pragma unroll 1
  for (int it = 0; it < ntiles; ++it) {
    const int k0 = it * 64;
    if (it + 1 < ntiles) { tile_gload(tr, kb, 512, vt, T, k0 + 64, tid); if (tid < 64) ckr = fc[k0 + 64 + tid] * (-LOG2E); }
    const lds_u8* stage = tiles + (it & 1) * TILE_STAGE;
    if (k0 <= t0 + 63) {
      const bool diag = (k0 + 63 > t0);
#pragma unroll
      for (int hf = 0; hf < 2; ++hf) {
        const int key0 = k0 + hf * 32;
        f32x4 s[2][4];
        const f32x4 ck0 = *(const __attribute__((address_space(3))) f32x4*)(stage + 2 * TILE_HALF + (32 * hf + 8 * grp) * 4);
        const f32x4 ck1 = *(const __attribute__((address_space(3))) f32x4*)(stage + 2 * TILE_HALF + (32 * hf + 8 * grp + 4) * 4);
        qk_scores_lds<4, 2, false>(stage, hf, qf, s, lane, nullptr, ck0, ck1);
        if (diag) {
#pragma unroll
          for (int kt = 0; kt < 2; ++kt)
#pragma unroll
            for (int i = 0; i < 4; ++i) {
              const int key = key0 + 8 * grp + 4 * kt + i;
#pragma unroll
              for (int ct = 0; ct < 4; ++ct) s[kt][ct][i] = (key <= t0 + 16 * ct + r) ? s[kt][ct][i] : NEG_INF;
            }
        }
        softmax_update<4, 4, true>(s, m, lsum, o);
        pv_accum_lds<4, 4>(stage, hf, s, o, lane);
      }
    }
    if (it + 1 < ntiles) {
      tile_swrite(tr, tiles + ((it + 1) & 1) * TILE_STAGE, tid);
      if (tid < 64) *(__attribute__((address_space(3))) float*)(tiles + ((it + 1) & 1) * TILE_STAGE + 2 * TILE_HALF + tid * 4) = ckr;
    }
    __syncthreads();
  }
  float invl[4];
#pragma unroll
  for (int ct = 0; ct < 4; ++ct) invl[ct] = finish_l(lsum[ct]);
#pragma unroll
  for (int ct = 0; ct < 4; ++ct) {
    bf16_t* ob = WSP(bf16_t, OFF_OB) + ((size_t)b * T + t0 + 16 * ct + r) * 512 + h * 64;
#pragma unroll
    for (int dt = 0; dt < 4; ++dt) {
      bf16_t* ptr = ob + 16 * dt + 4 * grp;
      const u32x2 sw = *(const u32x2*)ptr;
      const f32x4 v = o[dt][ct] * invl[ct];
      u32x2 w = {cvtpk(v[0] * bflo(sw[0]), v[1] * bfhi(sw[0])), cvtpk(v[2] * bflo(sw[1]), v[3] * bfhi(sw[1]))};
      if (st) *(u32x2*)ptr = w;
    }
  }
}

__device__ void mem_unit(const Params& p, int l, int b, int h, int t0, bool st) {
  const int lane = tidx() & 63, r = lane & 15, grp = lane >> 4;
  const float SC = 0.08838834764831845f * LOG2E;
  bf16x8 qf[2][4];
  const float* gq = p.mem_q_norm + l * 128;
#pragma unroll
  for (int ct = 0; ct < 2; ++ct) {
    const size_t row = (size_t)b * T + t0 + 16 * ct + r;
    float v[4][8];
    float ss = 0.f;
#pragma unroll
    for (int dk = 0; dk < 4; ++dk) {
      const u32x4 w = *(const u32x4*)(WSP(bf16_t, OFF_MQ) + row * 512 + h * 128 + dk * 32 + grp * 8);
#pragma unroll
      for (int j = 0; j < 4; ++j) { v[dk][2 * j] = bflo(w[j]); v[dk][2 * j + 1] = bfhi(w[j]); }
#pragma unroll
      for (int j = 0; j < 8; ++j) ss += v[dk][j] * v[dk][j];
    }
    ss += __shfl_xor(ss, 16);
    ss += __shfl_xor(ss, 32);
    const float rstd = rsqrtf(ss * (1.0f / 128.0f) + EPS);
#pragma unroll
    for (int dk = 0; dk < 4; ++dk) {
      const f32x4 g0 = *(const f32x4*)(gq + dk * 32 + grp * 8), g1 = *(const f32x4*)(gq + dk * 32 + grp * 8 + 4);
      u32x4 w = {cvtpk(v[dk][0] * rstd * g0[0], v[dk][1] * rstd * g0[1]), cvtpk(v[dk][2] * rstd * g0[2], v[dk][3] * rstd * g0[3]),
                 cvtpk(v[dk][4] * rstd * g1[0], v[dk][5] * rstd * g1[1]), cvtpk(v[dk][6] * rstd * g1[2], v[dk][7] * rstd * g1[3])};
      qf[ct][dk] = __builtin_bit_cast(bf16x8, w);
    }
  }
  const bf16_t* kb = WSP(bf16_t, OFF_MK) + ((size_t)b * 256) * 512 + h * 128;
  const bf16_t* vt = WSP(bf16_t, OFF_MVT) + (size_t)((b * 4 + h) * 128) * 256;
  f32x4 o[8][2];
  float m[2], lsum[2];
#pragma unroll
  for (int ct = 0; ct < 2; ++ct) { m[ct] = NEG_INF; lsum[ct] = 0.f; }
#pragma unroll
  for (int dt = 0; dt < 8; ++dt)
#pragma unroll
    for (int ct = 0; ct < 2; ++ct) o[dt][ct] = (f32x4){0.f, 0.f, 0.f, 0.f};
#pragma unroll 1
  for (int key0 = 0; key0 < 256; key0 += 32) {
    f32x4 s[2][2];
    qk_scores<2, 4>(kb, 512, key0, qf, s, lane);
#pragma unroll
    for (int kt = 0; kt < 2; ++kt)
#pragma unroll
      for (int ct = 0; ct < 2; ++ct) s[kt][ct] = s[kt][ct] * SC;
    softmax_update<2, 8, true>(s, m, lsum, o);
    pv_accum<2, 8>(vt, 256, key0, s, o, lane);
  }
#pragma unroll
  for (int ct = 0; ct < 2; ++ct) {
    const float invl = finish_l(lsum[ct]);
    bf16_t* om = WSP(bf16_t, OFF_OM) + ((size_t)b * T + t0 + 16 * ct + r) * 512 + h * 128;
#pragma unroll
    for (int dt = 0; dt < 8; ++dt) {
      bf16_t* ptr = om + 16 * dt + 4 * grp;
      const u32x2 sw = *(const u32x2*)ptr;
      const f32x4 v = o[dt][ct] * invl;
      u32x2 w = {cvtpk(v[0] * bflo(sw[0]), v[1] * bfhi(sw[0])), cvtpk(v[2] * bflo(sw[1]), v[3] * bfhi(sw[1]))};
      if (st) *(u32x2*)ptr = w;
    }
  }
}

__device__ void phase_attn(const Params& p, int l, unsigned char* ldsraw, bool st, int cidx) {
  const int tid = tidx();
  const int wave = __builtin_amdgcn_readfirstlane(tid >> 6);
  float* imp = (float*)ldsraw + wave * 2112;
  lds_u8* tiles = (lds_u8*)ldsraw;
  bf16x8* qlds = (bf16x8*)(ldsraw + 69632 + wave * 8192);
  unsigned* misc = (unsigned*)(ldsraw + 135168);
  float* scr = WSP(float, OFF_SCR) + (size_t)(bidx() * NWAVES + wave) * 4096;
  unsigned* ctr = WSP(unsigned, OFF_CTL) + cidx;
  constexpr int NUNITS = 1536;
  for (;;) {
    __syncthreads();
    if (tid == 0) misc[0] = atomicAdd(ctr, 1u);
    if (tid >= 4 && tid < 8) misc[tid] = 0u;
    __syncthreads();
    const int u = __builtin_amdgcn_readfirstlane((int)misc[0]);
    if (u >= NUNITS) break;
    if (u < 1024) {
      const int g4 = u >> 6, w = u & 63;
      if (w < 32) fox_wg_unit(p, w >> 3, w & 7, 15 - g4, tiles, st);
      else { const int w2 = w - 32, kk = w2 >> 3, bg = w2 & 7; nsa_wg_unit(p, bg >> 1, bg & 1, 63 - (4 * g4 + kk), imp, qlds, scr, tiles, misc, st); }
    } else {
      const int mu = u - 1024, bh = mu >> 5, qblk = mu & 31;
      mem_unit(p, l, bh >> 2, bh & 3, 256 * qblk + 32 * wave, st);
    }
  }
}

__global__ void __launch_bounds__(NTHREADS) hybrid_megakernel(Params p) {
  cg::grid_group grid = cg::this_grid();
  extern __shared__ __attribute__((aligned(16))) unsigned char dynlds[];
  float* smem = (float*)dynlds;
  PG8_LAS unsigned char* glds = (PG8_LAS unsigned char*)dynlds;
  volatile LAS unsigned* bst = (volatile LAS unsigned*)(glds + 135168 + 64);
  if (threadIdx.x < 2) bst[threadIdx.x] = 0u;
  __syncthreads();
  grid.sync();
  const XcdBarrier xbar = xcd_barrier_post(WSP(unsigned, OFF_BAR), bst);
#pragma unroll 1
  for (int ph = 0; ph < 28; ++ph) {
    const int l = ph / 7, k = ph - 7 * l;
    if (k == 0) {
      phase_prep(p, l, smem);
    } else if (k == 1) {
      EpiIn E{&p, l};
      for (int rp = 0; rp < (PROBE_GEMM2 ? (p.ws != nullptr ? 2 : 1) : 1); ++rp)
        run_gemm(glds, WSP(bf16_t, OFF_H), WSP(bf16_t, OFF_W_IN), M, 5120, 1024, E);
      EpiMemKV E2{&p};
      run_gemm(glds, WSP(bf16_t, OFF_MEMN), WSP(bf16_t, OFF_W_MKV), 1024, 1024, 1024, E2);
    } else if (k == 2) {
      phase_mid(p, l);
    } else if (k == 3) {
      const int nrep = PROBE_ATTN2 ? (p.ws != nullptr ? 2 : 1) : 1;
      for (int rp = 0; rp < nrep; ++rp) {
        const bool last = (rp == nrep - 1);
        if (rp) xcd_barrier(xbar);
        phase_attn(p, l, dynlds, last, last ? l : 8 + l);
      }
    } else if (k == 4) {
      EpiGate E{WSP(bf16_t, OFF_G)};
      for (int rp = 0; rp < (PROBE_GEMM2 ? (p.ws != nullptr ? 2 : 1) : 1); ++rp)
        run_gemm(glds, WSP(bf16_t, OFF_H), WSP(bf16_t, OFF_W_G), M, 3072, 1024, E);
    } else if (k == 5) {
      EpiBranch Ea{WSP(bf16_t, OFF_G), WSP(bf16_t, OFF_U), 1};
      run_gemm(glds, WSP(bf16_t, OFF_OA), WSP(bf16_t, OFF_W_BR), M, 1024, 512, Ea);
      EpiBranch Eb{WSP(bf16_t, OFF_G) + (size_t)M * 1024, WSP(bf16_t, OFF_U), 0};
      run_gemm(glds, WSP(bf16_t, OFF_OB), WSP(bf16_t, OFF_W_BR + MiB), M, 1024, 512, Eb);
      EpiBranch Ec{WSP(bf16_t, OFF_G) + (size_t)2 * M * 1024, WSP(bf16_t, OFF_U), 0};
      run_gemm(glds, WSP(bf16_t, OFF_OM), WSP(bf16_t, OFF_W_BR + 2 * MiB), M, 1024, 512, Ec);
    } else {
      EpiOut E{l == 0 ? p.x : p.out, p.out};
      run_gemm(glds, WSP(bf16_t, OFF_U), WSP(bf16_t, OFF_W_OUT), M, 1024, 1024, E);
    }
    xcd_barrier(xbar);
  }
}

extern "C" void kernel_launch(void* const* d_in, const int* in_sizes, int n_in, void* d_out, int out_size, void* d_ws,
                              size_t ws_size, hipStream_t stream) {
  static int grid_blocks = 0;
  if (!grid_blocks) {
    int dev = 0, cus = 0, per_cu = 0;
    (void)hipGetDevice(&dev);
    (void)hipDeviceGetAttribute(&cus, hipDeviceAttributeMultiprocessorCount, dev);
    if (hipFuncSetAttribute((const void*)hybrid_megakernel, hipFuncAttributeMaxDynamicSharedMemorySize, LDS_BYTES) != hipSuccess)
      fprintf(stderr, "hipFuncSetAttribute(dynamic LDS %d) failed\n", LDS_BYTES);
    (void)hipOccupancyMaxActiveBlocksPerMultiprocessor(&per_cu, hybrid_megakernel, NTHREADS, LDS_BYTES);
    (void)hipGetLastError();
    grid_blocks = cus;
    if (grid_blocks > 256) grid_blocks = 256;
    if (ws_size < OFF_SCR + (size_t)32 * MiB) fprintf(stderr, "workspace too small: %zu\n", ws_size);
  }
  Params p{};
  const float** pp = (const float**)&p;
  for (int i = 0; i < 23; ++i) pp[i] = (const float*)d_in[i];
  p.out = (float*)d_out;
  p.ws = (char*)d_ws;
  void* args[] = {&p};
  (void)hipMemsetAsync((char*)d_ws + OFF_BAR, 0, XCD_BAR_WORDS * sizeof(unsigned), stream);
  hipError_t e = hipLaunchCooperativeKernel((void*)hybrid_megakernel, dim3(grid_blocks), dim3(NTHREADS), args, LDS_BYTES, stream);
  if (e != hipSuccess) fprintf(stderr, "cooperative launch failed: %s (grid %d)\n", hipGetErrorString(e), grid_blocks);
}
```

```cpp
#include <hip/hip_runtime.h>
#include <hip/hip_cooperative_groups.h>
#include <stdint.h>
#include <cstdio>
namespace cg = cooperative_groups;
#ifndef PROBE_ATTN2
#define PROBE_ATTN2 0
#endif
#ifndef PROBE_PM2
#define PROBE_PM2 0
#endif
#ifndef PROBE_BR2
#define PROBE_BR2 0
#endif
#ifndef PROBE_GEMM2
#define PROBE_GEMM2 0
#endif


typedef unsigned short bf16_t;
typedef short bf16x8 __attribute__((ext_vector_type(8)));
typedef float f32x4 __attribute__((ext_vector_type(4)));
typedef unsigned u32x2 __attribute__((ext_vector_type(2)));
typedef unsigned u32x4 __attribute__((ext_vector_type(4)));
typedef float f32x2_t __attribute__((ext_vector_type(2)));
typedef __bf16 bf16x2_t __attribute__((ext_vector_type(2)));

constexpr int NB = 4, T = 8192, M = NB * T;
constexpr int NTHREADS = 512, NWAVES = NTHREADS / 64;
constexpr int LDS_BYTES = 147456;
constexpr float EPS = 1e-6f;
constexpr float LOG2E = 1.4426950408889634f;
#define NEG_INF (-__builtin_inff())

constexpr size_t MiB = 1u << 20;
constexpr size_t OFF_CTL = 0;
constexpr size_t OFF_BAR = 64 * 1024;
constexpr size_t OFF_ROPE = 1 * MiB;
constexpr size_t OFF_W_IN = 3 * MiB;
constexpr size_t OFF_W_G = 13 * MiB;
constexpr size_t OFF_W_MKV = 19 * MiB;
constexpr size_t OFF_W_BR = 21 * MiB;
constexpr size_t OFF_W_OUT = 24 * MiB;
constexpr size_t OFF_W1 = 26 * MiB;
constexpr size_t OFF_W2 = 27 * MiB;
constexpr size_t OFF_C1 = 27 * MiB + 256 * 1024;
constexpr size_t OFF_MEMN = 28 * MiB;
constexpr size_t OFF_MK = 30 * MiB;
constexpr size_t OFF_MVT = 31 * MiB;
constexpr size_t OFF_H = 32 * MiB;
constexpr size_t OFF_U = OFF_H;
constexpr size_t OFF_OA = 96 * MiB;
constexpr size_t OFF_OB = 128 * MiB;
constexpr size_t OFF_OM = 160 * MiB;
constexpr size_t OFF_QN = 192 * MiB;
constexpr size_t OFF_G = 192 * MiB;
constexpr size_t OFF_KC = 224 * MiB;
constexpr size_t OFF_VC = 232 * MiB;
constexpr size_t OFF_KS = 240 * MiB;
constexpr size_t OFF_VST = 248 * MiB;
constexpr size_t OFF_KW = 256 * MiB;
constexpr size_t OFF_VWT = 264 * MiB;
constexpr size_t OFF_FQ = 272 * MiB;
constexpr size_t OFF_FK = 304 * MiB;
constexpr size_t OFF_FVT = 336 * MiB;
constexpr size_t OFF_MQ = 368 * MiB;
constexpr size_t OFF_GATE = 400 * MiB;
constexpr size_t OFF_FLOG = 403 * MiB;
constexpr size_t OFF_FC = 404 * MiB;
constexpr size_t OFF_KCMP = 405 * MiB;
constexpr size_t OFF_VCT = 405 * MiB + 512 * 1024;
constexpr size_t OFF_SCR = 406 * MiB;

struct Params {
  const float *x, *mem, *norm_g, *mem_norm_g, *w_in, *nsa_q_norm, *nsa_k_norm, *cmp_pe_k, *cmp_w1_k, *cmp_w2_k,
      *cmp_pe_v, *cmp_w1_v, *cmp_w2_v, *fox_q_norm, *fox_k_norm, *fox_f_bias, *mem_q_norm, *mem_k_norm, *w_mem_kv,
      *w_branch_a, *w_branch_b, *w_branch_m, *w_out;
  float* out;
  char* ws;
};
__device__ __forceinline__ char* ws_base(char* w) {
  unsigned lo = __builtin_amdgcn_readfirstlane((unsigned)(uintptr_t)w), hi = __builtin_amdgcn_readfirstlane((unsigned)((uintptr_t)w >> 32));
  asm volatile("" : "+s"(lo), "+s"(hi));
  return (char*)(__attribute__((address_space(1))) char*)(((uintptr_t)hi << 32) | (uintptr_t)lo);
}
#define WSP(TYPE, off) ((TYPE*)(ws_base(p.ws) + (off)))

__constant__ float c_inv_freq[32] = {
    1.000000000e+00f, 7.498942018e-01f, 5.623413324e-01f, 4.216965139e-01f, 3.162277639e-01f, 2.371373773e-01f,
    1.778279394e-01f, 1.333521456e-01f, 1.000000015e-01f, 7.498942316e-02f, 5.623413250e-02f, 4.216964915e-02f,
    3.162277490e-02f, 2.371373773e-02f, 1.778279431e-02f, 1.333521400e-02f, 9.999999776e-03f, 7.498942316e-03f,
    5.623413250e-03f, 4.216964822e-03f, 3.162277630e-03f, 2.371373819e-03f, 1.778279431e-03f, 1.333521446e-03f,
    1.000000047e-03f, 7.498941850e-04f, 5.623413017e-04f, 4.216965172e-04f, 3.162277571e-04f, 2.371373703e-04f,
    1.778279402e-04f, 1.333521504e-04f};

__device__ __forceinline__ int bidx() { int b = blockIdx.x; asm volatile("" : "+s"(b)); return b; }
__device__ __forceinline__ int gdim() { int g = gridDim.x; asm volatile("" : "+s"(g)); return g; }
__device__ __forceinline__ int tidx() { int t = threadIdx.x; asm volatile("" : "+v"(t)); return t; }
__device__ __forceinline__ unsigned cvtpk(float lo, float hi) {
  f32x2_t v = {lo, hi};
  bf16x2_t b = __builtin_convertvector(v, bf16x2_t);
  return __builtin_bit_cast(unsigned, b);
}
__device__ __forceinline__ float bf2f(unsigned short v) { return __uint_as_float(((unsigned)v) << 16); }
__device__ __forceinline__ float bflo(unsigned w) { return __uint_as_float(w << 16); }
__device__ __forceinline__ float bfhi(unsigned w) { return __uint_as_float(w & 0xffff0000u); }
__device__ __forceinline__ f32x4 mfma16(bf16x8 a, bf16x8 b, f32x4 c) {
  return __builtin_amdgcn_mfma_f32_16x16x32_bf16(a, b, c, 0, 0, 0);
}
__device__ __forceinline__ bf16x8 pack8(f32x4 a, f32x4 b) {
  u32x4 w = {cvtpk(a[0], a[1]), cvtpk(a[2], a[3]), cvtpk(b[0], b[1]), cvtpk(b[2], b[3])};
  return __builtin_bit_cast(bf16x8, w);
}
__device__ __forceinline__ float sigmoidf_(float v) { return 1.0f / (1.0f + __expf(-v)); }
__device__ __forceinline__ float siluf_(float v) { return v / (1.0f + __expf(-v)); }
__device__ __forceinline__ float grp_max4(float v) {
  auto a = __builtin_amdgcn_permlane32_swap(__float_as_uint(v), __float_as_uint(v), false, false);
  v = fmaxf(__uint_as_float(a[0]), __uint_as_float(a[1]));
  auto b = __builtin_amdgcn_permlane16_swap(__float_as_uint(v), __float_as_uint(v), false, false);
  return fmaxf(__uint_as_float(b[0]), __uint_as_float(b[1]));
}
__device__ __forceinline__ float wave_sum(float v) {
#pragma unroll
  for (int o = 1; o < 64; o <<= 1) v += __shfl_xor(v, o);
  return v;
}

#define LAS __attribute__((address_space(3)))
#define XB_TMO      128
#define XB_XCNT(j)  (256  + 64 * (j))
#define XB_XSUB(j)  (1280 + 64 * (j))
#define XB_XGEN(j)  (2304 + 64 * (j))
#define XB_TOP      3328
#define XB_TOPGEN   3392
#define XCD_BAR_WORDS 3456
#define XB_SPIN_CAP (1u << 18)

__device__ __forceinline__ unsigned xb_ld(unsigned* p)              { return __hip_atomic_load(p, __ATOMIC_RELAXED, __HIP_MEMORY_SCOPE_AGENT); }
__device__ __forceinline__ unsigned xb_add(unsigned* p, unsigned v) { return __hip_atomic_fetch_add(p, v, __ATOMIC_RELAXED, __HIP_MEMORY_SCOPE_AGENT); }
__device__ __forceinline__ unsigned xb_xcc_id() { return (unsigned)__builtin_amdgcn_s_getreg((3 << 11) | 20) & 0xFu; }
#define XB_SPIN(cond, bar) do { unsigned _sp = 0; while (cond) { __builtin_amdgcn_s_sleep(1); \
    if ((++_sp & 255u) == 0u) { if (xb_ld(&(bar)[XB_TMO])) break; if (_sp > XB_SPIN_CAP) { atomicAdd(&(bar)[XB_TMO], 1u); break; } } } } while (0)

struct XcdBarrier {
    unsigned* bar; unsigned x;
    volatile LAS unsigned* st;
};

__device__ __forceinline__ XcdBarrier xcd_barrier_post(unsigned* bar, volatile LAS unsigned* st) {
    XcdBarrier b; b.bar = bar; b.x = xb_xcc_id(); b.st = st;
    if (threadIdx.x == 0) (void)xb_add(&bar[XB_XCNT(b.x)], 1u);
    return b;
}
__device__ __forceinline__ void xcd_barrier_complete(unsigned* bar, unsigned x, unsigned& nloc, unsigned& nx) {
    const unsigned G = gridDim.x * gridDim.y * gridDim.z;
    unsigned sum, cnt, mine, sp = 0u;
    for (;;) {
        sum = 0u; cnt = 0u; mine = 0u;
#pragma unroll
        for (unsigned j = 0; j < 16; ++j) { const unsigned c = xb_ld(&bar[XB_XCNT(j)]); sum += c; cnt += (c > 0u) ? 1u : 0u; mine = (j == x) ? c : mine; }
        if (sum == G) break;
        __builtin_amdgcn_s_sleep(1);
        if ((++sp & 255u) == 0u) { if (xb_ld(&bar[XB_TMO])) break; if (sp > XB_SPIN_CAP) { atomicAdd(&bar[XB_TMO], 1u); break; } }
    }
    nloc = mine > 0u ? mine : 1u; nx = cnt > 0u ? cnt : 1u;
}

__device__ __forceinline__ void xcd_barrier(const XcdBarrier& b) {
    asm volatile("s_waitcnt vmcnt(0)" ::: "memory");
    __syncthreads();
    if (threadIdx.x == 0) {
        unsigned* bar = b.bar;
        __builtin_amdgcn_s_waitcnt(0);
        unsigned nloc = b.st[0], nx = b.st[1];
        if (nloc == 0u) { xcd_barrier_complete(bar, b.x, nloc, nx); b.st[0] = nloc; b.st[1] = nx; }
        const unsigned old = xb_add(&bar[XB_XSUB(b.x)], 1u);
        const unsigned gen = old / nloc;
        if (old + 1u == (gen + 1u) * nloc) {
            __builtin_amdgcn_fence(__ATOMIC_RELEASE, "agent");
            asm volatile("s_waitcnt vmcnt(0)" ::: "memory");
            const unsigned og = xb_add(&bar[XB_TOP], 1u);
            const unsigned tg = og / nx;
            if (og + 1u == (tg + 1u) * nx) xb_add(&bar[XB_TOPGEN], 1u);
            else XB_SPIN(xb_ld(&bar[XB_TOPGEN]) == tg, bar);
            __builtin_amdgcn_fence(__ATOMIC_ACQUIRE, "agent");
            xb_add(&bar[XB_XGEN(b.x)], 1u);
            asm volatile("s_waitcnt vmcnt(0)" ::: "memory");
        } else {
            XB_SPIN(xb_ld(&bar[XB_XGEN(b.x)]) == gen, bar);
            __builtin_amdgcn_fence(__ATOMIC_ACQUIRE, "agent");
            asm volatile("s_waitcnt vmcnt(0)" ::: "memory");
        }
    }
    __syncthreads();
}


namespace pg8 {
#define PG8_LAS __attribute__((address_space(3)))
typedef unsigned short bf16_t;
typedef short bf16x8 __attribute__((ext_vector_type(8)));
typedef float f32x4 __attribute__((ext_vector_type(4)));
typedef unsigned u32x4 __attribute__((ext_vector_type(4)));
constexpr int BM = 256, BK = 64, HALF = 128, HTB = HALF * BK * 2  , STAGE_BYTES = 8 * HTB, NXCD = 8, WGM = 8;

__host__ __device__ __forceinline__ int lds_byte(int r, int c) { const int st = (r >> 4) * 2 + (c >> 5), rr = r & 15, cc = c & 31, ob = rr * 64 + cc * 2; return st * 1024 + (ob ^ (((ob >> 9) & 1) << 5)); }
__host__ __device__ __forceinline__ void stage_rc(int b, int& R, int& C) { const int st = b / 1024, sb = b % 1024, swz = sb ^ (((sb >> 9) & 1) << 5); R = (st >> 1) * 16 + swz / 64; C = (st & 1) * 32 + (swz % 64) / 2; }
__host__ __device__ __forceinline__ int perm32(int rho) { const int n = rho >> 4, i = rho & 15; return 8 * (i >> 2) + 4 * n + (i & 3); }

struct Unit { int pm, pn; };
struct Gemm { const bf16_t* A; const bf16_t* Bt; int M, N, K; };

struct StaticOrder {
    int nM, nN, nwg, G, c;
    __host__ __device__ void init(int M, int N, int G_, int c_) { nM = M / BM; nN = N / BM; nwg = nM * nN; G = G_; c = c_; }
    __host__ __device__ bool next(int i, Unit& u) const {
        const long L = (long)i * G + c; if (L >= nwg) return false;
        int wgid = (int)L; { const int q = nwg / NXCD, r = nwg % NXCD, xcd = wgid % NXCD, off = wgid / NXCD; wgid = (xcd < r ? xcd * (q + 1) : r * (q + 1) + (xcd - r) * q) + off; }
        const int nig = WGM * nN, gid = wgid / nig, fm = gid * WGM, gsz = (nM - fm) < WGM ? (nM - fm) : WGM;
        u.pm = fm + ((wgid % nig) % gsz); u.pn = (wgid % nig) / gsz; return true;
    }
    __device__ __forceinline__ void a_ready(const Unit&) const {}
    __device__ __forceinline__ void done(const Unit&) const {}
};
__device__ __forceinline__ unsigned cvt_pk_bf16(float lo, float hi) { unsigned r; asm volatile("v_cvt_pk_bf16_f32 %0, %1, %2" : "=v"(r) : "v"(lo), "v"(hi)); return r; }
template <class Epi, class Sched, bool ALIGN_EPI = false, bool SP2 = false>
__device__ __forceinline__ void gemm_phase(PG8_LAS unsigned char* lds, const Gemm g, const Sched& S, const Epi& E) {
    const int tid = tidx(), wid = __builtin_amdgcn_readfirstlane(tid >> 6), lane = tid & 63, wr = wid >> 2, wc = wid & 3, fr = lane & 15, fq = lane >> 4;
    const int K = g.K, nt = K / BK;
    unsigned voffA[2], voffB[2];
#pragma unroll
    for (int i = 0; i < 2; ++i) { int R, C; stage_rc(tid * 16 + i * 8192, R, C); const int Rb = Epi::PERM ? ((R & ~31) + perm32(R & 31)) : R;
        voffA[i] = (unsigned)(R * K + C) * 2u; voffB[i] = (unsigned)(Rb * K + C) * 2u; }
    const size_t kstep = (size_t)(BK * 2);
    const size_t hstep = (size_t)HALF * K * 2;
    const size_t tstep = 2 * hstep;
    const unsigned ldsw = (unsigned)wid * 1024u;
    const int aoff = lds_byte(wr * 64 + fr, fq * 8), boff = lds_byte(wc * 32 + fr, fq * 8);
#define PG8_SA(b, h) (((b) * 2 + (h)) * HTB)
#define PG8_SB(b, h) ((4 + (b) * 2 + (h)) * HTB)
#define PG8_STAGE(bufoff, gbase, voff) do { _Pragma("unroll") for (int _i = 0; _i < 2; ++_i) \
        __builtin_amdgcn_global_load_lds((const unsigned*)((const char*)(gbase) + (voff)[_i]), (PG8_LAS unsigned*)(lds + (bufoff) + ldsw + _i * 8192), 16, 0, 0); } while (0)
#define PG8_LDA(dst, b, h) do { _Pragma("unroll") for (int m = 0; m < 4; ++m) _Pragma("unroll") for (int k = 0; k < 2; ++k) dst[m][k] = *(const PG8_LAS bf16x8*)(lds + PG8_SA(b, h) + aoff + m * 2048 + k * 1024); } while (0)
#define PG8_LDB(dst, b, h) do { _Pragma("unroll") for (int n = 0; n < 2; ++n) _Pragma("unroll") for (int k = 0; k < 2; ++k) dst[n][k] = *(const PG8_LAS bf16x8*)(lds + PG8_SB(b, h) + boff + n * 2048 + k * 1024); } while (0)
#define PG8_MMA(ai, bj, At, Bt) do { __builtin_amdgcn_s_setprio(1); _Pragma("unroll") for (int m = 0; m < 4; ++m) _Pragma("unroll") for (int n = 0; n < 2; ++n) _Pragma("unroll") for (int k = 0; k < 2; ++k) \
        acc[ai][bj][m][n] = __builtin_amdgcn_mfma_f32_16x16x32_bf16(Bt[n][k], At[m][k], acc[ai][bj][m][n], 0, 0, 0); __builtin_amdgcn_s_setprio(0); } while (0)
#define PG8_WAIT_V(n) asm volatile("s_waitcnt vmcnt(" #n ")" ::: "memory")
#define PG8_WAIT_L(n) asm volatile("s_waitcnt lgkmcnt(" #n ")" ::: "memory")
#define PG8_BAR __builtin_amdgcn_s_barrier()
#define PG8_SCHED __builtin_amdgcn_sched_barrier(0)
    Unit cur, nxt; int ui = 0;
    if (!S.next(0, cur)) return;
    f32x4 acc[2][2][4][2];
#pragma unroll
    for (int a = 0; a < 2; ++a)
#pragma unroll
        for (int b = 0; b < 2; ++b)
#pragma unroll
            for (int m = 0; m < 4; ++m)
#pragma unroll
                for (int n = 0; n < 2; ++n) acc[a][b][m][n] = (f32x4){0.f, 0.f, 0.f, 0.f};
    bf16x8 At[4][2], B0[2][2], B1[2][2];
    const char* cA = (const char*)g.A + (size_t)cur.pm * tstep; const char* cB = (const char*)g.Bt + (size_t)cur.pn * tstep;
    S.a_ready(cur);
    if constexpr (SP2) {
        PG8_STAGE(PG8_SB(0, 0), cB, voffB); PG8_STAGE(PG8_SB(0, 1), cB + hstep, voffB); PG8_STAGE(PG8_SA(0, 0), cA, voffA); PG8_STAGE(PG8_SA(0, 1), cA + hstep, voffA);
        if (wr == 1) PG8_BAR;
        PG8_WAIT_V(2); PG8_BAR;
        PG8_STAGE(PG8_SB(1, 0), cB + kstep, voffB); PG8_STAGE(PG8_SA(1, 0), cA + kstep, voffA); PG8_STAGE(PG8_SB(1, 1), cB + hstep + kstep, voffB);
        PG8_WAIT_V(6); PG8_BAR;
    } else {
        PG8_STAGE(PG8_SB(0, 0), cB, voffB); PG8_STAGE(PG8_SA(0, 0), cA, voffA); PG8_STAGE(PG8_SB(0, 1), cB + hstep, voffB); PG8_STAGE(PG8_SA(0, 1), cA + hstep, voffA);
        if (wr == 1) PG8_BAR;
        PG8_WAIT_V(4); PG8_BAR;
        PG8_STAGE(PG8_SB(1, 0), cB + kstep, voffB); PG8_STAGE(PG8_SA(1, 0), cA + kstep, voffA); PG8_STAGE(PG8_SB(1, 1), cB + hstep + kstep, voffB);
        PG8_WAIT_V(6); PG8_BAR;
    }
    for (;;) {
        const bool has_next = S.next(ui + 1, nxt);
        const char* nA = has_next ? (const char*)g.A + (size_t)nxt.pm * tstep : cA; const char* nB = has_next ? (const char*)g.Bt + (size_t)nxt.pn * tstep : cB;
        for (int t = 0; t < nt; t += 2) {
            const bool last = (t == nt - 2);
            const char* a1 = cA + (size_t)(t + 1) * kstep;
            const char* a2 = last ? nA : cA + (size_t)(t + 2) * kstep; const char* b2 = last ? nB : cB + (size_t)(t + 2) * kstep;
            const char* a3 = a2 + kstep; const char* b3 = b2 + kstep;
            if (last && has_next) S.a_ready(nxt);
            if constexpr (SP2) {
            PG8_LDB(B0, 0, 0); PG8_LDB(B1, 0, 1); PG8_SCHED; PG8_LDA(At, 0, 0); PG8_STAGE(PG8_SA(1, 1), a1 + hstep, voffA);
            PG8_WAIT_V(8); PG8_WAIT_L(0); PG8_BAR; PG8_MMA(0, 0, At, B0); PG8_MMA(0, 1, At, B1); PG8_BAR; PG8_SCHED;
            PG8_LDA(At, 0, 1); PG8_STAGE(PG8_SB(0, 0), b2, voffB); PG8_STAGE(PG8_SB(0, 1), b2 + hstep, voffB); PG8_STAGE(PG8_SA(0, 0), a2, voffA);
            PG8_WAIT_V(8); PG8_WAIT_L(0); PG8_BAR; PG8_MMA(1, 0, At, B0); PG8_MMA(1, 1, At, B1); PG8_BAR; PG8_SCHED;
            PG8_LDB(B0, 1, 0); PG8_LDB(B1, 1, 1); PG8_SCHED; PG8_LDA(At, 1, 0); PG8_STAGE(PG8_SA(0, 1), a2 + hstep, voffA);
            PG8_WAIT_V(8); PG8_WAIT_L(0); PG8_BAR; PG8_MMA(0, 0, At, B0); PG8_MMA(0, 1, At, B1); PG8_BAR; PG8_SCHED;
            PG8_LDA(At, 1, 1); PG8_STAGE(PG8_SB(1, 0), b3, voffB); PG8_STAGE(PG8_SB(1, 1), b3 + hstep, voffB); PG8_STAGE(PG8_SA(1, 0), a3, voffA);
            PG8_WAIT_V(8); PG8_WAIT_L(0); PG8_BAR; PG8_MMA(1, 0, At, B0); PG8_MMA(1, 1, At, B1); PG8_BAR; PG8_SCHED;
            } else {
            PG8_LDB(B0, 0, 0); PG8_SCHED; PG8_LDA(At, 0, 0); PG8_STAGE(PG8_SA(1, 1), a1 + hstep, voffA);
            PG8_WAIT_L(8); PG8_BAR; PG8_WAIT_L(0); PG8_MMA(0, 0, At, B0); PG8_BAR; PG8_SCHED;
            PG8_LDB(B1, 0, 1); PG8_STAGE(PG8_SB(0, 0), b2, voffB);
            PG8_BAR; PG8_WAIT_L(0); PG8_MMA(0, 1, At, B1); PG8_BAR;
            PG8_LDA(At, 0, 1); PG8_STAGE(PG8_SA(0, 0), a2, voffA);
            PG8_BAR; PG8_WAIT_L(0); PG8_MMA(1, 0, At, B0); PG8_BAR; PG8_SCHED;
            PG8_STAGE(PG8_SB(0, 1), b2 + hstep, voffB);
            PG8_WAIT_V(6); PG8_BAR; PG8_MMA(1, 1, At, B1); PG8_BAR;
            PG8_LDB(B0, 1, 0); PG8_SCHED; PG8_LDA(At, 1, 0); PG8_STAGE(PG8_SA(0, 1), a2 + hstep, voffA);
            PG8_WAIT_L(8); PG8_BAR; PG8_WAIT_L(0); PG8_MMA(0, 0, At, B0); PG8_BAR; PG8_SCHED;
            PG8_LDB(B1, 1, 1); PG8_STAGE(PG8_SB(1, 0), b3, voffB);
            PG8_BAR; PG8_WAIT_L(0); PG8_MMA(0, 1, At, B1); PG8_BAR;
            PG8_LDA(At, 1, 1); PG8_STAGE(PG8_SA(1, 0), a3, voffA);
            PG8_BAR; PG8_WAIT_L(0); PG8_MMA(1, 0, At, B0); PG8_BAR; PG8_SCHED;
            PG8_STAGE(PG8_SB(1, 1), b3 + hstep, voffB);
            PG8_WAIT_V(6); PG8_BAR; PG8_MMA(1, 1, At, B1); PG8_BAR;
            }
        }
        if constexpr (ALIGN_EPI) { if (wr == 0) PG8_BAR; }
        if constexpr (!Epi::AFTER_DRAIN) { E(acc, cur, wr, wc, fr, fq); S.done(cur); }
        if (!has_next) break;
#pragma unroll
        for (int a = 0; a < 2; ++a)
#pragma unroll
            for (int b = 0; b < 2; ++b)
#pragma unroll
                for (int m = 0; m < 4; ++m)
#pragma unroll
                    for (int n = 0; n < 2; ++n) acc[a][b][m][n] = (f32x4){0.f, 0.f, 0.f, 0.f};
        cur = nxt; cA = nA; cB = nB; ++ui;
        if constexpr (ALIGN_EPI) { if (wr == 1) PG8_BAR; }
    }
    PG8_WAIT_V(0);
    if constexpr (!ALIGN_EPI) { if (wr == 0) PG8_BAR; }
    PG8_BAR;
    if constexpr (Epi::AFTER_DRAIN) { E.fused(acc, cur, wr, wc, fr, fq, lds, wid, lane); S.done(cur); }
#undef PG8_SA
#undef PG8_SB
#undef PG8_STAGE
#undef PG8_LDA
#undef PG8_LDB
#undef PG8_MMA
#undef PG8_WAIT_V
#undef PG8_WAIT_L
#undef PG8_BAR
#undef PG8_SCHED
}
}

struct EpiIn {
  static constexpr bool PERM = false, AFTER_DRAIN = false;
  const Params* pp; int l;
  __device__ __forceinline__ void operator()(f32x4 (&acc)[2][2][4][2], const pg8::Unit& u, int wr, int wc, int fr, int fq) const {
    const Params& p = *pp;
    const int U = u.pn * 4 + wc;
    if (U >= 77) return;
    const int rowb = u.pm * 256 + wr * 64 + fr;
    const int bq = (u.pm * 256) / T, tb = rowb % T;
    bf16_t* dst = nullptr; int ld = 0, col0 = 0; const float* gain = nullptr; bool rope = false, silu = false;
    float post = 1.0f;
    bf16_t* vt = nullptr;
    if (U < 8) { dst = WSP(bf16_t, OFF_QN); ld = 512; col0 = U * 64; gain = p.nsa_q_norm + l * 64; rope = true; post = 0.125f * LOG2E; }
    else if (U < 10) { dst = WSP(bf16_t, OFF_KC); ld = 128; col0 = (U - 8) * 64; rope = true; }
    else if (U < 12) { dst = WSP(bf16_t, OFF_VC); ld = 128; col0 = (U - 10) * 64; }
    else if (U < 14) { dst = WSP(bf16_t, OFF_KS); ld = 128; col0 = (U - 12) * 64; gain = p.nsa_k_norm + (l * 3 + 1) * 64; rope = true; }
    else if (U < 16) { vt = WSP(bf16_t, OFF_VST) + (size_t)((bq * 2 + (U - 14)) * 64) * T; }
    else if (U < 18) { dst = WSP(bf16_t, OFF_KW); ld = 128; col0 = (U - 16) * 64; gain = p.nsa_k_norm + (l * 3 + 2) * 64; rope = true; }
    else if (U < 20) { vt = WSP(bf16_t, OFF_VWT) + (size_t)((bq * 2 + (U - 18)) * 64) * T; }
    else if (U < 28) { dst = WSP(bf16_t, OFF_OA); ld = 512; col0 = (U - 20) * 64; silu = true; }
    else if (U < 36) { dst = WSP(bf16_t, OFF_FQ); ld = 512; col0 = (U - 28) * 64; gain = p.fox_q_norm + l * 64; post = 0.125f * LOG2E; }
    else if (U < 44) { dst = WSP(bf16_t, OFF_FK); ld = 512; col0 = (U - 36) * 64; gain = p.fox_k_norm + l * 64; }
    else if (U < 52) { vt = WSP(bf16_t, OFF_FVT) + (size_t)((bq * 8 + (U - 44)) * 64) * T; }
    else if (U < 60) { dst = WSP(bf16_t, OFF_OB); ld = 512; col0 = (U - 52) * 64; silu = true; }
    else if (U < 68) { dst = WSP(bf16_t, OFF_MQ); ld = 512; col0 = (U - 60) * 64; }
    else if (U < 76) { dst = WSP(bf16_t, OFF_OM); ld = 512; col0 = (U - 68) * 64; silu = true; }
    if (U == 76) {
      float* gate = WSP(float, OFF_GATE);
      float* flog = WSP(float, OFF_FLOG);
#pragma unroll
      for (int ai = 0; ai < 2; ++ai)
#pragma unroll
        for (int m = 0; m < 4; ++m) {
          const size_t row = (size_t)rowb + 128 * ai + 16 * m;
#pragma unroll
          for (int n = 0; n < 2; ++n)
#pragma unroll
            for (int i = 0; i < 4; ++i) {
              const int e = 16 * n + 4 * fq + i;
              const float v = acc[ai][0][m][n][i];
              if (e < 24) gate[row * 24 + e] = sigmoidf_(v);
              else {
                const float xx = v + p.fox_f_bias[l * 8 + (e - 24)];
                flog[row * 8 + (e - 24)] = xx >= 0.f ? -log1pf(expf(-xx)) : xx - log1pf(expf(xx));
              }
            }
        }
      return;
    }
    if (vt) {
#pragma unroll
      for (int ai = 0; ai < 2; ++ai)
#pragma unroll
        for (int m = 0; m < 4; ++m) {
          const int t = tb + 128 * ai + 16 * m;
#pragma unroll
          for (int bj = 0; bj < 2; ++bj)
#pragma unroll
            for (int n = 0; n < 2; ++n) {
              const f32x4 v = acc[ai][bj][m][n];
              const unsigned w0 = cvtpk(v[0], v[1]), w1 = cvtpk(v[2], v[3]);
              const unsigned qo = (unsigned)((32 * bj + 16 * n + 4 * fq) * T + t);
              vt[qo] = (bf16_t)(w0 & 0xffffu); vt[qo + T] = (bf16_t)(w0 >> 16); vt[qo + 2 * T] = (bf16_t)(w1 & 0xffffu); vt[qo + 3 * T] = (bf16_t)(w1 >> 16);
            }
        }
      return;
    }
    const float* ropetab = WSP(float, OFF_ROPE);
    f32x4 gv[2][2];
    if (gain) {
#pragma unroll
      for (int bj = 0; bj < 2; ++bj)
#pragma unroll
        for (int n = 0; n < 2; ++n) gv[bj][n] = *(const f32x4*)(gain + 32 * bj + 16 * n + 4 * fq);
    }
#pragma unroll
    for (int ai = 0; ai < 2; ++ai)
#pragma unroll
      for (int m = 0; m < 4; ++m) {
        f32x4 v[2][2];
#pragma unroll
        for (int bj = 0; bj < 2; ++bj)
#pragma unroll
          for (int n = 0; n < 2; ++n) v[bj][n] = acc[ai][bj][m][n];
        const int row = rowb + 128 * ai + 16 * m;
        if (gain) {
          float ss = 0.f;
#pragma unroll
          for (int bj = 0; bj < 2; ++bj)
#pragma unroll
            for (int n = 0; n < 2; ++n)
#pragma unroll
              for (int i = 0; i < 4; ++i) ss += v[bj][n][i] * v[bj][n][i];
          ss += __shfl_xor(ss, 16);
          ss += __shfl_xor(ss, 32);
          const float rstd = rsqrtf(ss * (1.0f / 64.0f) + EPS);
#pragma unroll
          for (int bj = 0; bj < 2; ++bj)
#pragma unroll
            for (int n = 0; n < 2; ++n) v[bj][n] = v[bj][n] * rstd * gv[bj][n];
        }
        if (rope) {
          const int pos = row & (T - 1);
#pragma unroll
          for (int n = 0; n < 2; ++n) {
            const f32x4* tp = (const f32x4*)(ropetab + ((size_t)pos * 32 + 16 * n + 4 * fq) * 2);
            const f32x4 t0 = tp[0], t1 = tp[1];
            const float cs[4] = {t0[0], t0[2], t1[0], t1[2]}, sn[4] = {t0[1], t0[3], t1[1], t1[3]};
#pragma unroll
            for (int i = 0; i < 4; ++i) {
              const float y1 = v[0][n][i], y2 = v[1][n][i];
              v[0][n][i] = y1 * cs[i] - y2 * sn[i];
              v[1][n][i] = y2 * cs[i] + y1 * sn[i];
            }
          }
        }
#pragma unroll
        for (int bj = 0; bj < 2; ++bj)
#pragma unroll
          for (int n = 0; n < 2; ++n) {
            f32x4 y = v[bj][n] * post;
            if (silu) {
#pragma unroll
              for (int i = 0; i < 4; ++i) y[i] = siluf_(y[i]);
            }
            u32x2 w = {cvtpk(y[0], y[1]), cvtpk(y[2], y[3])};
            *(u32x2*)(dst + (size_t)row * ld + col0 + 32 * bj + 16 * n + 4 * fq) = w;
          }
      }
  }
};
struct EpiMemKV {
  static constexpr bool PERM = false, AFTER_DRAIN = false;
  const Params* pp;
  __device__ __forceinline__ void operator()(f32x4 (&acc)[2][2][4][2], const pg8::Unit& u, int wr, int wc, int fr, int fq) const {
    const Params& p = *pp;
    const int U = u.pn * 4 + wc;
    const int rowb = u.pm * 256 + wr * 64 + fr;
#pragma unroll
    for (int ai = 0; ai < 2; ++ai)
#pragma unroll
      for (int m = 0; m < 4; ++m) {
        const int row = rowb + 128 * ai + 16 * m;
#pragma unroll
        for (int bj = 0; bj < 2; ++bj)
#pragma unroll
          for (int n = 0; n < 2; ++n) {
            const f32x4 v = acc[ai][bj][m][n];
            const unsigned w0 = cvtpk(v[0], v[1]), w1 = cvtpk(v[2], v[3]);
            const int e = 32 * bj + 16 * n + 4 * fq;
            if (U < 8) {
              u32x2 w = {w0, w1};
              *(u32x2*)(WSP(bf16_t, OFF_MK) + (size_t)row * 512 + U * 64 + e) = w;
            } else {
              const int col = (U - 8) * 64 + e, h = col >> 7, d = col & 127, b = row >> 8, mm = row & 255;
              bf16_t* q = WSP(bf16_t, OFF_MVT) + (size_t)((b * 4 + h) * 128 + d) * 256 + mm;
              q[0] = (bf16_t)(w0 & 0xffffu); q[256] = (bf16_t)(w0 >> 16); q[512] = (bf16_t)(w1 & 0xffffu); q[768] = (bf16_t)(w1 >> 16);
            }
          }
      }
  }
};
struct EpiGate {
  static constexpr bool PERM = false, AFTER_DRAIN = false;
  bf16_t* G;
  __device__ __forceinline__ void operator()(f32x4 (&acc)[2][2][4][2], const pg8::Unit& u, int wr, int wc, int fr, int fq) const {
    const int br = u.pn >> 2, colt = (u.pn & 3) * 256 + wc * 32 + 4 * fq;
    bf16_t* base = G + (size_t)br * M * 1024;
    const int rowb = u.pm * 256 + wr * 64 + fr;
#pragma unroll
    for (int ai = 0; ai < 2; ++ai)
#pragma unroll
      for (int m = 0; m < 4; ++m) {
        bf16_t* rp = base + (size_t)(rowb + 128 * ai + 16 * m) * 1024 + colt;
#pragma unroll
        for (int bj = 0; bj < 2; ++bj)
#pragma unroll
          for (int n = 0; n < 2; ++n) {
            const f32x4 v = acc[ai][bj][m][n];
            u32x2 w = {cvtpk(sigmoidf_(v[0]), sigmoidf_(v[1])), cvtpk(sigmoidf_(v[2]), sigmoidf_(v[3]))};
            *(u32x2*)(rp + 128 * bj + 16 * n) = w;
          }
      }
  }
};
struct EpiBranch {
  static constexpr bool PERM = false, AFTER_DRAIN = false;
  const bf16_t* G; bf16_t* Uo; int first;
  __device__ __forceinline__ void operator()(f32x4 (&acc)[2][2][4][2], const pg8::Unit& u, int wr, int wc, int fr, int fq) const {
    const int colt = u.pn * 256 + wc * 32 + 4 * fq;
    const int rowb = u.pm * 256 + wr * 64 + fr;
#pragma unroll
    for (int ai = 0; ai < 2; ++ai)
#pragma unroll
      for (int m = 0; m < 4; ++m) {
        const size_t ro = (size_t)(rowb + 128 * ai + 16 * m) * 1024 + colt;
#pragma unroll
        for (int bj = 0; bj < 2; ++bj)
#pragma unroll
          for (int n = 0; n < 2; ++n) {
            const f32x4 v = acc[ai][bj][m][n];
            const size_t off = ro + 128 * bj + 16 * n;
            const u32x2 gw = *(const u32x2*)(G + off);
            float y0 = v[0] * bflo(gw[0]), y1 = v[1] * bfhi(gw[0]), y2 = v[2] * bflo(gw[1]), y3 = v[3] * bfhi(gw[1]);
            if (!first) {
              const u32x2 uw = *(const u32x2*)(Uo + off);
              y0 += bflo(uw[0]); y1 += bfhi(uw[0]); y2 += bflo(uw[1]); y3 += bfhi(uw[1]);
            }
            u32x2 w = {cvtpk(y0, y1), cvtpk(y2, y3)};
            *(u32x2*)(Uo + off) = w;
          }
      }
  }
};
struct EpiOut {
  static constexpr bool PERM = false, AFTER_DRAIN = false;
  const float* xin; float* xout;
  __device__ __forceinline__ void operator()(f32x4 (&acc)[2][2][4][2], const pg8::Unit& u, int wr, int wc, int fr, int fq) const {
    const int colt = u.pn * 256 + wc * 32 + 4 * fq;
    const int rowb = u.pm * 256 + wr * 64 + fr;
#pragma unroll
    for (int ai = 0; ai < 2; ++ai)
#pragma unroll
      for (int m = 0; m < 4; ++m) {
        const size_t ro = (size_t)(rowb + 128 * ai + 16 * m) * 1024 + colt;
#pragma unroll
        for (int bj = 0; bj < 2; ++bj)
#pragma unroll
          for (int n = 0; n < 2; ++n) {
            const size_t off = ro + 128 * bj + 16 * n;
            const f32x4 xv = *(const f32x4*)(xin + off);
            *(f32x4*)(xout + off) = xv + acc[ai][bj][m][n];
          }
      }
  }
};
template <class Epi>
__device__ __forceinline__ void run_gemm(PG8_LAS unsigned char* lds, const bf16_t* A, const bf16_t* Bt, int Mr, int Nc, int K, const Epi& E) {
  pg8::Gemm g{A, Bt, Mr, Nc, K};
  pg8::StaticOrder S;
  S.init(Mr, Nc, gdim(), bidx());
  pg8::gemm_phase<Epi, pg8::StaticOrder, true, true>(lds, g, S, E);
}

__device__ __forceinline__ int map_in(int n) {
  const int i = n >> 6, c = n & 63;
  if (i < 20) return n;
  if (i < 28) return 1304 + (n - 1280);
  if (i < 52) return 1816 + (n - 1792);
  if (i < 60) return 3360 + (n - 3328);
  if (i < 68) return 3872 + (n - 3840);
  if (i < 76) return 4384 + (n - 4352);
  if (i == 76) return c < 24 ? 1280 + c : (c < 32 ? 3352 + (c - 24) : -1);
  return -1;
}
__device__ void transpose_tile(const float* __restrict__ src, int ld_src, int k0, int n0, bf16_t* __restrict__ dst,
                               int Kdim, int maptype, int srccol0, float* tile) {
  const int tid = tidx();
  for (int e = tid; e < 4096; e += NTHREADS) {
    const int kk = e >> 6, nn = e & 63;
    int nlog = n0 + nn;
    if (maptype) { const int w = nlog & 255; nlog = (nlog & ~255) + (((w & 127) >> 5) << 6) + (((w >> 7) << 5) | (w & 31)); }
    const int sc = (maptype == 1) ? map_in(nlog) : srccol0 + nlog;
    tile[kk * 65 + nn] = sc >= 0 ? src[(size_t)(k0 + kk) * ld_src + sc] : 0.f;
  }
  __syncthreads();
  for (int e = tid; e < 2048; e += NTHREADS) {
    const int nn = e >> 5, kp = e & 31;
    const float a = tile[(2 * kp) * 65 + nn], b = tile[(2 * kp + 1) * 65 + nn];
    *(unsigned*)(dst + (size_t)(n0 + nn) * Kdim + k0 + 2 * kp) = cvtpk(a, b);
  }
  __syncthreads();
}
__device__ void rmsnorm_rows(const float* __restrict__ x, const float* __restrict__ gain, bf16_t* __restrict__ dst,
                             int row_begin, int nrows) {
  const int wave = tidx() >> 6, lane = tidx() & 63;
  for (int rr = wave; rr < nrows; rr += NWAVES) {
    const size_t row = (size_t)row_begin + rr;
    const float* xp = x + row * 1024;
    f32x4 v[4];
    float ss = 0.f;
#pragma unroll
    for (int i = 0; i < 4; ++i) {
      v[i] = *(const f32x4*)(xp + lane * 4 + 256 * i);
      ss += v[i][0] * v[i][0] + v[i][1] * v[i][1] + v[i][2] * v[i][2] + v[i][3] * v[i][3];
    }
    ss = wave_sum(ss);
    const float rstd = rsqrtf(ss * (1.0f / 1024.0f) + EPS);
#pragma unroll
    for (int i = 0; i < 4; ++i) {
      const f32x4 gv = *(const f32x4*)(gain + lane * 4 + 256 * i);
      const f32x4 y = v[i] * rstd * gv;
      u32x2 w = {cvtpk(y[0], y[1]), cvtpk(y[2], y[3])};
      *(u32x2*)(dst + row * 1024 + lane * 4 + 256 * i) = w;
    }
  }
}
__device__ void phase_prep(const Params& p, int l, float* smem) {
  const int tid = tidx();
  constexpr int NT_TR = 3076, NT_H = 512, NT_MEMN = 16, NT_C1 = 2, NT_ROPE = 512;
  const int total = NT_TR + NT_H + NT_MEMN + NT_C1 + (l == 0 ? NT_ROPE : 0);
  if (l == 0 && bidx() == 0 && tid < 64) WSP(unsigned, OFF_CTL)[tid] = 0u;
  const float* xin = (l == 0) ? p.x : p.out;
  const int pmult = PROBE_PM2 ? (p.ws != nullptr ? 2 : 1) : 1;
  for (int u0 = bidx(); u0 < total * pmult; u0 += gdim()) {
    int u = u0 % total;
    if (u < NT_TR) {
      const float* src; int ld, kt, nt, Kd, mt = 0, c0 = 0; bf16_t* dst;
      if (u < 1280) { kt = u / 80; nt = u % 80; src = p.w_in + (size_t)l * 1024 * 7968; ld = 7968; Kd = 1024; dst = WSP(bf16_t, OFF_W_IN); mt = 1; }
      else if ((u -= 1280) < 768) { kt = u / 48; nt = u % 48; src = p.w_in + (size_t)l * 1024 * 7968; ld = 7968; Kd = 1024; dst = WSP(bf16_t, OFF_W_G); c0 = 4896; }
      else if ((u -= 768) < 256) { kt = u / 16; nt = u % 16; src = p.w_mem_kv + (size_t)l * 1024 * 1024; ld = 1024; Kd = 1024; dst = WSP(bf16_t, OFF_W_MKV); mt = 2; }
      else if ((u -= 256) < 384) { const int br = u / 128, uu = u % 128; kt = uu / 16; nt = uu % 16;
        src = (br == 0 ? p.w_branch_a : br == 1 ? p.w_branch_b : p.w_branch_m) + (size_t)l * 512 * 1024; ld = 1024; Kd = 512; dst = WSP(bf16_t, OFF_W_BR + (size_t)br * MiB); }
      else if ((u -= 384) < 256) { kt = u / 16; nt = u % 16; src = p.w_out + (size_t)l * 1024 * 1024; ld = 1024; Kd = 1024; dst = WSP(bf16_t, OFF_W_OUT); }
      else if ((u -= 256) < 128) { const int kv = u / 64, uu = u % 64; kt = uu / 2; nt = uu % 2;
        src = (kv ? p.cmp_w1_v : p.cmp_w1_k) + (size_t)l * 2048 * 128; ld = 128; Kd = 2048; dst = WSP(bf16_t, OFF_W1 + (size_t)kv * 512 * 1024); }
      else { u -= 128; const int kv = u / 2; kt = u % 2; nt = 0;
        src = (kv ? p.cmp_w2_v : p.cmp_w2_k) + (size_t)l * 128 * 64; ld = 64; Kd = 128; dst = WSP(bf16_t, OFF_W2 + (size_t)kv * 64 * 1024); }
      transpose_tile(src, ld, kt * 64, nt * 64, dst, Kd, mt, c0, smem);
    } else if ((u -= NT_TR) < NT_H) {
      rmsnorm_rows(xin, p.norm_g + l * 1024, WSP(bf16_t, OFF_H), u * 64, 64);
    } else if ((u -= NT_H) < NT_MEMN) {
      rmsnorm_rows(p.mem, p.mem_norm_g + l * 1024, WSP(bf16_t, OFF_MEMN), u * 64, 64);
    } else if ((u -= NT_MEMN) < NT_C1) {
      const float* pe = (u ? p.cmp_pe_v : p.cmp_pe_k) + (size_t)l * 2048;
      const float* w1 = (u ? p.cmp_w1_v : p.cmp_w1_k) + (size_t)l * 2048 * 128;
      constexpr int NPART = NTHREADS / 128, KPER = 2048 / NPART;
      const int n = tid & 127, part = tid >> 7;
      float s = 0.f;
      for (int kk = part * KPER; kk < part * KPER + KPER; ++kk) s += pe[kk] * w1[(size_t)kk * 128 + n];
      smem[part * 128 + n] = s;
      __syncthreads();
      if (tid < 128) { float tot = 0.f; for (int q = 0; q < NPART; ++q) tot += smem[q * 128 + tid]; WSP(float, OFF_C1)[u * 128 + tid] = tot; }
      __syncthreads();
    } else {
      u -= NT_C1;
      for (int e = tid; e < 512; e += NTHREADS) {
        const int idx = u * 512 + e, pos = idx >> 5, f = idx & 31;
        const float ang = (float)pos * c_inv_freq[f];
        const double a = (double)ang;
        const double k = rint(a * 0.15915494309189535);
        const float rr = (float)(a - k * 6.283185307179586);
        float2 cs; cs.x = __cosf(rr); cs.y = __sinf(rr);
        WSP(float2, OFF_ROPE)[idx] = cs;
      }
    }
  }
}

__device__ void compress_unit(const Params& p, int l, int u) {
  const int lane = tidx() & 63, r = lane & 15, g4 = lane >> 4;
  const int kv = u >> 7, rem = u & 127, b = rem >> 5, grp = (rem >> 4) & 1, it = rem & 15, i0 = it * 32;
  const bf16_t* src = WSP(bf16_t, kv ? OFF_VC : OFF_KC);
  const bf16_t* w1t = WSP(bf16_t, OFF_W1 + (size_t)kv * 512 * 1024);
  const bf16_t* w2t = WSP(bf16_t, OFF_W2 + (size_t)kv * 64 * 1024);
  const float* c1 = WSP(float, OFF_C1) + kv * 128;
  const bf16_t* arow[2];
#pragma unroll
  for (int mt = 0; mt < 2; ++mt) {
    int i = i0 + 16 * mt + r;
    if (i > 510) i = 510;
    arow[mt] = src + ((size_t)b * T + 16 * i) * 128 + grp * 64 + g4 * 8;
  }
  f32x4 acc[2][8];
#pragma unroll
  for (int a = 0; a < 2; ++a)
#pragma unroll
    for (int c = 0; c < 8; ++c) acc[a][c] = (f32x4){0.f, 0.f, 0.f, 0.f};
  const bf16_t* bp = w1t + (size_t)r * 2048 + g4 * 8;
  for (int k0 = 0; k0 < 2048; k0 += 32) {
    const int pp = k0 >> 6, d = k0 & 63;
    bf16x8 af[2], bf[8];
#pragma unroll
    for (int mt = 0; mt < 2; ++mt) af[mt] = *(const bf16x8*)(arow[mt] + (size_t)pp * 128 + d);
#pragma unroll
    for (int nt = 0; nt < 8; ++nt) bf[nt] = *(const bf16x8*)(bp + (size_t)nt * 16 * 2048 + k0);
#pragma unroll
    for (int mt = 0; mt < 2; ++mt)
#pragma unroll
      for (int nt = 0; nt < 8; ++nt) acc[mt][nt] = mfma16(bf[nt], af[mt], acc[mt][nt]);
  }
#pragma unroll
  for (int nt = 0; nt < 8; ++nt) {
    const f32x4 cv = *(const f32x4*)(c1 + 16 * nt + 4 * g4);
#pragma unroll
    for (int mt = 0; mt < 2; ++mt)
#pragma unroll
      for (int i = 0; i < 4; ++i) acc[mt][nt][i] = siluf_(acc[mt][nt][i] + cv[i]);
  }
  bf16x8 wf[4][4];
#pragma unroll
  for (int ks = 0; ks < 4; ++ks)
#pragma unroll
    for (int et = 0; et < 4; ++et) {
      const bf16_t* wp = w2t + (size_t)(16 * et + r) * 128 + 32 * ks + 4 * g4;
      const u32x2 lo = *(const u32x2*)wp, hi = *(const u32x2*)(wp + 16);
      u32x4 w = {lo[0], lo[1], hi[0], hi[1]};
      wf[ks][et] = __builtin_bit_cast(bf16x8, w);
    }
  if (kv == 0) {
    const float* gain = p.nsa_k_norm + (size_t)(l * 3 + 0) * 64;
    bf16_t* dst = WSP(bf16_t, OFF_KCMP) + (size_t)((b * 2 + grp) * 512) * 64;
    f32x4 gv[4];
#pragma unroll
    for (int et = 0; et < 4; ++et) gv[et] = *(const f32x4*)(gain + 16 * et + 4 * g4);
#pragma unroll
    for (int mt = 0; mt < 2; ++mt) {
      f32x4 o[4];
#pragma unroll
      for (int et = 0; et < 4; ++et) o[et] = (f32x4){0.f, 0.f, 0.f, 0.f};
#pragma unroll
      for (int ks = 0; ks < 4; ++ks) {
        const bf16x8 xf = pack8(acc[mt][2 * ks], acc[mt][2 * ks + 1]);
#pragma unroll
        for (int et = 0; et < 4; ++et) o[et] = mfma16(wf[ks][et], xf, o[et]);
      }
      float ss = 0.f;
#pragma unroll
      for (int et = 0; et < 4; ++et)
#pragma unroll
        for (int i = 0; i < 4; ++i) ss += o[et][i] * o[et][i];
      ss += __shfl_xor(ss, 16);
      ss += __shfl_xor(ss, 32);
      const float rstd = rsqrtf(ss * (1.0f / 64.0f) + EPS);
      const int i = i0 + 16 * mt + r;
#pragma unroll
      for (int et = 0; et < 4; ++et) {
        f32x4 y = o[et] * rstd * gv[et];
        if (i > 510) y = (f32x4){0.f, 0.f, 0.f, 0.f};
        u32x2 w = {cvtpk(y[0], y[1]), cvtpk(y[2], y[3])};
        *(u32x2*)(dst + (size_t)i * 64 + 16 * et + 4 * g4) = w;
      }
    }
  } else {
    bf16_t* dst = WSP(bf16_t, OFF_VCT) + (size_t)((b * 2 + grp) * 64) * 512;
#pragma unroll
    for (int mt = 0; mt < 2; ++mt) {
      f32x4 o[4];
#pragma unroll
      for (int et = 0; et < 4; ++et) o[et] = (f32x4){0.f, 0.f, 0.f, 0.f};
#pragma unroll
      for (int ks = 0; ks < 4; ++ks) {
        const bf16x8 xf = pack8(acc[mt][2 * ks], acc[mt][2 * ks + 1]);
#pragma unroll
        for (int et = 0; et < 4; ++et) o[et] = mfma16(xf, wf[ks][et], o[et]);
      }
#pragma unroll
      for (int et = 0; et < 4; ++et) {
        f32x4 y = o[et];
        const int ib = i0 + 16 * mt + 4 * g4;
#pragma unroll
        for (int i = 0; i < 4; ++i)
          if (ib + i > 510) y[i] = 0.f;
        u32x2 w = {cvtpk(y[0], y[1]), cvtpk(y[2], y[3])};
        *(u32x2*)(dst + (size_t)(16 * et + r) * 512 + ib) = w;
      }
    }
  }
}
__device__ void cumsum_unit(const Params& p, int u) {
  const int lane = tidx() & 63, b = u >> 3, h = u & 7;
  const float* fl = WSP(float, OFF_FLOG) + ((size_t)b * T) * 8 + h;
  float* fc = WSP(float, OFF_FC) + (size_t)(b * 8 + h) * T;
  const int tb = lane * 128;
  double s = 0.0;
  for (int i = 0; i < 128; ++i) s += (double)fl[(size_t)(tb + i) * 8];
  double incl = s;
#pragma unroll
  for (int o = 1; o < 64; o <<= 1) {
    const double y = __shfl_up(incl, o);
    if (lane >= o) incl += y;
  }
  double run = incl - s;
  for (int i = 0; i < 128; ++i) {
    run += (double)fl[(size_t)(tb + i) * 8];
    fc[tb + i] = (float)run;
  }
}
__device__ void memk_norm_unit(const Params& p, int l, int u) {
  const int lane = tidx() & 63;
  bf16_t* mk = WSP(bf16_t, OFF_MK);
  const float* gain = p.mem_k_norm + l * 128 + (lane & 15) * 8;
  for (int rr = 0; rr < 16; ++rr) {
    bf16_t* ptr = mk + (size_t)(u * 16 + rr) * 512 + lane * 8;
    const u32x4 w = *(const u32x4*)ptr;
    float v[8];
#pragma unroll
    for (int j = 0; j < 4; ++j) { v[2 * j] = bflo(w[j]); v[2 * j + 1] = bfhi(w[j]); }
    float ss = 0.f;
#pragma unroll
    for (int j = 0; j < 8; ++j) ss += v[j] * v[j];
#pragma unroll
    for (int o = 1; o < 16; o <<= 1) ss += __shfl_xor(ss, o);
    const float rstd = rsqrtf(ss * (1.0f / 128.0f) + EPS);
    u32x4 ow;
#pragma unroll
    for (int j = 0; j < 4; ++j) ow[j] = cvtpk(v[2 * j] * rstd * gain[2 * j], v[2 * j + 1] * rstd * gain[2 * j + 1]);
    *(u32x4*)ptr = ow;
  }
}
__device__ void phase_mid(const Params& p, int l) {
  const int wave = tidx() >> 6;
  const int gw = wave * gdim() + bidx(), nw = NWAVES * gdim();
  const int mult = PROBE_PM2 ? (p.ws != nullptr ? 2 : 1) : 1;
  for (int uu = gw; uu < (256 + 32 + 64) * mult; uu += nw) {
    const int u = uu % (256 + 32 + 64);
    if (u < 256) compress_unit(p, l, u);
    else if (u < 288) cumsum_unit(p, u - 256);
    else if (uu < 256 + 32 + 64) memk_norm_unit(p, l, u - 288);
  }
}

template <int NCT, int NDK, bool QL = false>
__device__ __forceinline__ void qk_scores(const bf16_t* __restrict__ kbase, int ldk, int key0,
                                          const bf16x8 (&qf)[NCT][NDK], f32x4 (&s)[2][NCT], int lane, const bf16x8* qlds = nullptr) {
  const int r = lane & 15, grp = lane >> 4;
#pragma unroll
  for (int kt = 0; kt < 2; ++kt) {
    const bf16_t* kp = kbase + (size_t)(key0 + 8 * (r >> 2) + 4 * kt + (r & 3)) * ldk + grp * 8;
    bf16x8 kf[NDK];
#pragma unroll
    for (int dk = 0; dk < NDK; ++dk) kf[dk] = *(const bf16x8*)(kp + dk * 32);
#pragma unroll
    for (int ct = 0; ct < NCT; ++ct) {
      f32x4 a = {0.f, 0.f, 0.f, 0.f};
#pragma unroll
      for (int dk = 0; dk < NDK; ++dk) a = mfma16(kf[dk], QL ? qlds[(ct * NDK + dk) * 64 + lane] : qf[ct][dk], a);
      s[kt][ct] = a;
    }
  }
}
template <int NCT, int NDT>
__device__ __forceinline__ void pv_accum(const bf16_t* __restrict__ vt, size_t ldv, int key0,
                                         const f32x4 (&s)[2][NCT], f32x4 (&o)[NDT][NCT], int lane) {
  const int r = lane & 15, grp = lane >> 4;
  bf16x8 pb[NCT];
#pragma unroll
  for (int ct = 0; ct < NCT; ++ct) pb[ct] = pack8(s[0][ct], s[1][ct]);
#pragma unroll
  for (int dt = 0; dt < NDT; ++dt) {
    const bf16x8 vf = *(const bf16x8*)(vt + (size_t)(16 * dt + r) * ldv + key0 + 8 * grp);
#pragma unroll
    for (int ct = 0; ct < NCT; ++ct) o[dt][ct] = mfma16(vf, pb[ct], o[dt][ct]);
  }
}
template <int NCT, int NDT, bool HAS_O, bool SUMS = true>
__device__ __forceinline__ void softmax_update(f32x4 (&s)[2][NCT], float (&m)[NCT], float (&lsum)[NCT],
                                               f32x4 (&o)[NDT][NCT], f32x4 (*lacc)[NCT] = nullptr) {
  float mnew[NCT];
  bool ch = false;
#pragma unroll
  for (int ct = 0; ct < NCT; ++ct) {
    float mx = fmaxf(fmaxf(fmaxf(s[0][ct][0], s[0][ct][1]), fmaxf(s[0][ct][2], s[0][ct][3])),
                     fmaxf(fmaxf(s[1][ct][0], s[1][ct][1]), fmaxf(s[1][ct][2], s[1][ct][3])));
    mx = grp_max4(mx);
    mnew[ct] = fmaxf(m[ct], mx);
    ch = ch || (mnew[ct] > m[ct]);
  }
  if (__any(ch)) {
#pragma unroll
    for (int ct = 0; ct < NCT; ++ct) {
      const float msafe = (mnew[ct] == NEG_INF) ? 0.f : mnew[ct];
      const float alpha = __builtin_amdgcn_exp2f(m[ct] - msafe);
      m[ct] = mnew[ct];
      if (SUMS) lsum[ct] *= alpha; else (*lacc)[ct] = (*lacc)[ct] * alpha;
      if (HAS_O) {
#pragma unroll
        for (int dt = 0; dt < NDT; ++dt) o[dt][ct] = o[dt][ct] * alpha;
      }
    }
  }
#pragma unroll
  for (int ct = 0; ct < NCT; ++ct) {
    const float msafe = (m[ct] == NEG_INF) ? 0.f : m[ct];
#pragma unroll
    for (int kt = 0; kt < 2; ++kt) {
      const f32x4 d = s[kt][ct] - msafe;
      f32x4 pv;
#pragma unroll
      for (int i = 0; i < 4; ++i) pv[i] = __builtin_amdgcn_exp2f(d[i]);
      s[kt][ct] = pv;
    }
    if (SUMS) {
      const f32x4 t4 = s[0][ct] + s[1][ct];
      lsum[ct] += (t4[0] + t4[1]) + (t4[2] + t4[3]);
    }
  }
}
__device__ __forceinline__ float finish_l(float lsum) {
  lsum += __shfl_xor(lsum, 16);
  lsum += __shfl_xor(lsum, 32);
  return lsum > 0.f ? 1.0f / lsum : 0.f;
}

typedef __attribute__((address_space(3))) unsigned char lds_u8;
constexpr int TILE_ROWB = 144, TILE_HALF = 64 * TILE_ROWB, TILE_STAGE = 2 * TILE_HALF + 256;
struct TileRegs { u32x4 k, v; };
__device__ __forceinline__ void tile_gload(TileRegs& tr, const bf16_t* __restrict__ kbase, int ldk, const bf16_t* __restrict__ vtbase,
                                           size_t ldv, int key0, int tid) {
  const int row = tid >> 3, ch = tid & 7;
  tr.k = *(const u32x4*)(kbase + (size_t)(key0 + row) * ldk + ch * 8);
  tr.v = *(const u32x4*)(vtbase + (size_t)row * ldv + key0 + ch * 8);
}
__device__ __forceinline__ void tile_swrite(const TileRegs& tr, lds_u8* stage, int tid) {
  const int row = tid >> 3, ch = tid & 7;
  *(__attribute__((address_space(3))) u32x4*)(stage + row * TILE_ROWB + ch * 16) = tr.k;
  *(__attribute__((address_space(3))) u32x4*)(stage + TILE_HALF + row * TILE_ROWB + ch * 16) = tr.v;
}
template <int NCT, int NDK, bool QL>
__device__ __forceinline__ void qk_scores_lds(const lds_u8* stage, int hf, const bf16x8 (&qf)[NCT][NDK], f32x4 (&s)[2][NCT], int lane,
                                              const bf16x8* qlds, const f32x4 c0, const f32x4 c1) {
  const int r = lane & 15, grp = lane >> 4;
#pragma unroll
  for (int kt = 0; kt < 2; ++kt) {
    const lds_u8* kp = stage + (32 * hf + 8 * (r >> 2) + 4 * kt + (r & 3)) * TILE_ROWB + grp * 16;
    bf16x8 kf[NDK];
#pragma unroll
    for (int dk = 0; dk < NDK; ++dk) kf[dk] = *(const __attribute__((address_space(3))) bf16x8*)(kp + dk * 64);
#pragma unroll
    for (int ct = 0; ct < NCT; ++ct) {
      f32x4 a = kt ? c1 : c0;
#pragma unroll
      for (int dk = 0; dk < NDK; ++dk) a = mfma16(kf[dk], QL ? qlds[(ct * NDK + dk) * 64 + lane] : qf[ct][dk], a);
      s[kt][ct] = a;
    }
  }
}
template <int NDT>
__device__ __forceinline__ void v_frags_lds(const lds_u8* stage, int hf, bf16x8 (&vf)[NDT], int lane) {
  const int r = lane & 15, grp = lane >> 4;
#pragma unroll
  for (int dt = 0; dt < NDT; ++dt)
    vf[dt] = *(const __attribute__((address_space(3))) bf16x8*)(stage + TILE_HALF + (16 * dt + r) * TILE_ROWB + (32 * hf + 8 * grp) * 2);
}
template <int NCT, int NDT>
__device__ __forceinline__ void pv_accum_lds(const bf16x8 (&vfp)[NDT], const f32x4 (&s)[2][NCT], f32x4 (&o)[NDT][NCT], int lane, f32x4 (&lacc)[NCT]) {
  const int r = lane & 15, grp = lane >> 4; (void)r; (void)grp;
  bf16x8 pb[NCT];
#pragma unroll
  for (int ct = 0; ct < NCT; ++ct) pb[ct] = pack8(s[0][ct], s[1][ct]);
  {
    const short one = (short)0x3F80;
    const bf16x8 ones = {one, one, one, one, one, one, one, one};
#pragma unroll
    for (int ct = 0; ct < NCT; ++ct) lacc[ct] = mfma16(ones, pb[ct], lacc[ct]);
  }
#pragma unroll
  for (int dt = 0; dt < NDT; ++dt) {
    const bf16x8 vf = vfp[dt];
#pragma unroll
    for (int ct = 0; ct < NCT; ++ct) o[dt][ct] = mfma16(vf, pb[ct], o[dt][ct]);
  }
}
__device__ __forceinline__ int next_bit(unsigned long long lo, unsigned long long hi, int from) {
  if (from < 64) { const unsigned long long mm = lo & (~0ull << from); if (mm) return __ffsll(mm) - 1; from = 64; }
  if (from < 128) { const unsigned long long mm = hi & (~0ull << (from - 64)); if (mm) return 64 + __ffsll(mm) - 1; }
  return 128;
}

__device__ void nsa_wg_unit(const Params& p, int b, int g, int qi, float* imp, bf16x8* qlds, float* scr, lds_u8* tiles, unsigned* misc, bool st) {
  const int tid0 = tidx();
  const int wave = __builtin_amdgcn_readfirstlane(tid0 >> 6);
  const int lane0 = tid0 & 63;
  const int tq = qi * 8 + wave;
  const int t0 = tq * 16;
  const bf16x8 (&qf)[4][2] = *(const bf16x8 (*)[4][2])nullptr;
#define NSA_SECTION_VARS \
  int lane = lane0; asm volatile("" : "+v"(lane)); \
  const int r = lane & 15, grp = lane >> 4, t = t0 + r; \
  const size_t row = (size_t)b * T + t; \
  const float* gatep = WSP(float, OFF_GATE) + row * 24 + g * 12; (void)gatep; (void)grp; (void)t;
  {
    NSA_SECTION_VARS
#pragma unroll
    for (int ct = 0; ct < 4; ++ct)
#pragma unroll
      for (int dk = 0; dk < 2; ++dk)
        qlds[(ct * 2 + dk) * 64 + lane] = *(const bf16x8*)(WSP(bf16_t, OFF_QN) + row * 512 + (g * 4 + ct) * 64 + dk * 32 + grp * 8);
  }
  f32x4 o[4][4];
  float m[4], lsum[4];
  f32x4 lacc[4];
  {
    NSA_SECTION_VARS
    const bf16_t* kc = WSP(bf16_t, OFF_KCMP) + (size_t)((b * 2 + g) * 512) * 64;
    const bf16_t* vct = WSP(bf16_t, OFF_VCT) + (size_t)((b * 2 + g) * 64) * 512;
    const int nblk = (tq + 31) >> 5;
#pragma unroll
    for (int ct = 0; ct < 4; ++ct) { m[ct] = NEG_INF; lsum[ct] = 0.f; }
#pragma unroll 1
    for (int blk = 0; blk < nblk; ++blk) {
      f32x4 s[2][4];
      qk_scores<4, 2, true>(kc, 64, blk * 32, qf, s, lane, qlds);
#pragma unroll
      for (int kt = 0; kt < 2; ++kt)
#pragma unroll
        for (int i = 0; i < 4; ++i) {
          const int n = blk * 32 + 8 * grp + 4 * kt + i;
          const bool ok = (16 * n + 31 <= t);
#pragma unroll
          for (int ct = 0; ct < 4; ++ct) s[kt][ct][i] = ok ? s[kt][ct][i] : NEG_INF;
        }
      softmax_update<4, 4, false>(s, m, lsum, o);
    }
    float invl[4], msafe[4];
#pragma unroll
    for (int ct = 0; ct < 4; ++ct) { invl[ct] = finish_l(lsum[ct]); msafe[ct] = (m[ct] == NEG_INF) ? 0.f : m[ct]; }
    for (int e = lane; e < 16 * 132; e += 64) imp[e] = 0.f;
    __builtin_amdgcn_fence(__ATOMIC_SEQ_CST, "workgroup");
    __builtin_amdgcn_wave_barrier();
#pragma unroll
    for (int dt = 0; dt < 4; ++dt)
#pragma unroll
      for (int ct = 0; ct < 4; ++ct) o[dt][ct] = (f32x4){0.f, 0.f, 0.f, 0.f};
#pragma unroll 1
    for (int blk = 0; blk < nblk; ++blk) {
      f32x4 s[2][4];
      qk_scores<4, 2, true>(kc, 64, blk * 32, qf, s, lane, qlds);
      float pq[2][4];
#pragma unroll
      for (int kt = 0; kt < 2; ++kt)
#pragma unroll
        for (int i = 0; i < 4; ++i) {
          const int n = blk * 32 + 8 * grp + 4 * kt + i;
          const bool ok = (16 * n + 31 <= t);
          float acc_p = 0.f;
#pragma unroll
          for (int ct = 0; ct < 4; ++ct) {
            const float pv = ok ? __builtin_amdgcn_exp2f(s[kt][ct][i] - msafe[ct]) * invl[ct] : 0.f;
            s[kt][ct][i] = pv;
            acc_p += pv;
          }
          pq[kt][i] = acc_p;
        }
      float* ir = imp + r * 132 + blk * 8 + 2 * grp;
      ir[0] += pq[0][0] + pq[0][1] + pq[0][2] + 0.5f * pq[0][3];
      __builtin_amdgcn_fence(__ATOMIC_SEQ_CST, "workgroup");
      __builtin_amdgcn_wave_barrier();
      ir[1] += pq[1][0] + pq[1][1] + pq[1][2] + 0.5f * pq[1][3] + 0.5f * pq[0][3];
      __builtin_amdgcn_fence(__ATOMIC_SEQ_CST, "workgroup");
      __builtin_amdgcn_wave_barrier();
      ir[2] += 0.5f * pq[1][3];
      __builtin_amdgcn_fence(__ATOMIC_SEQ_CST, "workgroup");
      __builtin_amdgcn_wave_barrier();
      pv_accum<4, 4>(vct, 512, blk * 32, s, o, lane);
    }
    f32x4 gt[4];
#pragma unroll
    for (int ct = 0; ct < 4; ++ct) gt[ct][0] = gatep[ct * 3 + 0];
#pragma unroll
    for (int dt = 0; dt < 4; ++dt) {
#pragma unroll
      for (int ct = 0; ct < 4; ++ct)
#pragma unroll
        for (int i = 0; i < 4; ++i) scr[((dt * 4 + ct) * 4 + i) * 64 + lane] = o[dt][ct][i] * gt[ct][0];
      asm volatile("" ::: "memory");
    }
  }
  const int cur = t0 >> 6;
  unsigned long long sel_lo = 0ull, sel_hi = 0ull;
  {
  NSA_SECTION_VARS
  if (cur <= 15) {
    sel_lo = (1ull << (cur + 1)) - 1ull;
  } else {
    __builtin_amdgcn_fence(__ATOMIC_SEQ_CST, "workgroup");
    __builtin_amdgcn_wave_barrier();
    float v[32];
#pragma unroll
    for (int k = 0; k < 32; ++k) {
      const int j = grp + 4 * k;
      const float x = imp[r * 132 + j];
      v[k] = (j >= 1 && j <= cur - 2) ? x : NEG_INF;
    }
#pragma unroll 1
    for (int round = 0; round < 13; ++round) {
      float best = NEG_INF;
      int bj = 1 << 20;
#pragma unroll
      for (int k = 0; k < 32; ++k) {
        const bool tk = v[k] > best;
        best = tk ? v[k] : best;
        bj = tk ? (grp + 4 * k) : bj;
      }
#pragma unroll
      for (int off = 16; off <= 32; off <<= 1) {
        const float ob = __shfl_xor(best, off);
        const int oj = __shfl_xor(bj, off);
        const bool tk = (ob > best) || (ob == best && oj < bj);
        best = tk ? ob : best;
        bj = tk ? oj : bj;
      }
      if (bj < 64) sel_lo |= 1ull << bj; else if (bj < 128) sel_hi |= 1ull << (bj - 64);
#pragma unroll
      for (int k = 0; k < 32; ++k) v[k] = (bj == grp + 4 * k) ? NEG_INF : v[k];
    }
    sel_lo |= 1ull;
    if (cur < 64) sel_lo |= 1ull << cur; else sel_hi |= 1ull << (cur - 64);
    if (cur - 1 < 64) sel_lo |= 1ull << (cur - 1); else sel_hi |= 1ull << (cur - 1 - 64);
  }
  }
  asm volatile("" : "+v"(sel_lo), "+v"(sel_hi));
  atomicOr(&misc[4], (unsigned)sel_lo); atomicOr(&misc[5], (unsigned)(sel_lo >> 32));
  atomicOr(&misc[6], (unsigned)sel_hi); atomicOr(&misc[7], (unsigned)(sel_hi >> 32));
  __syncthreads();
  unsigned long long ulo, uhi;
  {
    const unsigned u0 = __builtin_amdgcn_readfirstlane(misc[4]), u1 = __builtin_amdgcn_readfirstlane(misc[5]);
    const unsigned u2 = __builtin_amdgcn_readfirstlane(misc[6]), u3 = __builtin_amdgcn_readfirstlane(misc[7]);
    ulo = ((unsigned long long)u1 << 32) | u0; uhi = ((unsigned long long)u3 << 32) | u2;
  }
  {
    NSA_SECTION_VARS
    const int tid = (wave << 6) | lane;
    const bf16_t* ks = WSP(bf16_t, OFF_KS) + ((size_t)b * T) * 128 + g * 64;
    const bf16_t* vst = WSP(bf16_t, OFF_VST) + (size_t)((b * 2 + g) * 64) * T;
#pragma unroll
    for (int ct = 0; ct < 4; ++ct) { m[ct] = NEG_INF; lsum[ct] = 0.f; lacc[ct] = (f32x4){0.f, 0.f, 0.f, 0.f}; }
#pragma unroll
    for (int dt = 0; dt < 4; ++dt)
#pragma unroll
      for (int ct = 0; ct < 4; ++ct) o[dt][ct] = (f32x4){0.f, 0.f, 0.f, 0.f};
    TileRegs tr;
    int j = next_bit(ulo, uhi, 0), it = 0;
    tile_gload(tr, ks, 128, vst, T, 64 * j, tid);
    tile_swrite(tr, tiles, tid);
    __syncthreads();
#pragma unroll 1
    while (j < 128) {
      const int jn = next_bit(ulo, uhi, j + 1);
      if (jn < 128) tile_gload(tr, ks, 128, vst, T, 64 * jn, tid);
      const lds_u8* stage = tiles + (it & 1) * TILE_STAGE;
      const bool mine = ((j < 64 ? (sel_lo >> j) : (sel_hi >> (j - 64))) & 1ull) != 0ull;
      if (__any(mine)) {
#pragma unroll 1
        for (int hf = 0; hf < 2; ++hf) {
          const int key0 = j * 64 + hf * 32;
          f32x4 s[2][4];
          const float mv = mine ? 0.f : NEG_INF;
          const f32x4 cm = {mv, mv, mv, mv};
          qk_scores_lds<4, 2, true>(stage, hf, qf, s, lane, qlds, cm, cm);
          if (j == cur) {
#pragma unroll
            for (int kt = 0; kt < 2; ++kt)
#pragma unroll
              for (int i = 0; i < 4; ++i) {
                const int key = key0 + 8 * grp + 4 * kt + i;
                const bool ok = (key <= t);
#pragma unroll
                for (int ct = 0; ct < 4; ++ct) s[kt][ct][i] = ok ? s[kt][ct][i] : NEG_INF;
              }
          }
          bf16x8 vfr[4];
          v_frags_lds<4>(stage, hf, vfr, lane);
          softmax_update<4, 4, true, false>(s, m, lsum, o, &lacc);
          pv_accum_lds<4, 4>(vfr, s, o, lane, lacc);
        }
      }
      if (jn < 128) tile_swrite(tr, tiles + ((it + 1) & 1) * TILE_STAGE, tid);
      __syncthreads();
      j = jn; ++it;
    }
    float sc2[4];
#pragma unroll
    for (int ct = 0; ct < 4; ++ct) sc2[ct] = (lacc[ct][0] > 0.f ? 1.0f / lacc[ct][0] : 0.f) * gatep[ct * 3 + 1];
#pragma unroll
    for (int dt = 0; dt < 4; ++dt) {
#pragma unroll
      for (int ct = 0; ct < 4; ++ct)
#pragma unroll
        for (int i = 0; i < 4; ++i) scr[((dt * 4 + ct) * 4 + i) * 64 + lane] += o[dt][ct][i] * sc2[ct];
      asm volatile("" ::: "memory");
    }
  }
  {
    NSA_SECTION_VARS
    const int tid = (wave << 6) | lane;
    const bf16_t* kw = WSP(bf16_t, OFF_KW) + ((size_t)b * T) * 128 + g * 64;
    const bf16_t* vwt = WSP(bf16_t, OFF_VWT) + (size_t)((b * 2 + g) * 64) * T;
#pragma unroll
    for (int ct = 0; ct < 4; ++ct) { m[ct] = NEG_INF; lsum[ct] = 0.f; lacc[ct] = (f32x4){0.f, 0.f, 0.f, 0.f}; }
#pragma unroll
    for (int dt = 0; dt < 4; ++dt)
#pragma unroll
      for (int ct = 0; ct < 4; ++ct) o[dt][ct] = (f32x4){0.f, 0.f, 0.f, 0.f};
    int kstart = qi * 128 - 512;
    if (kstart < 0) kstart = 0;
    const int kend = qi * 128 + 64;
    TileRegs tr;
    int it = 0;
    tile_gload(tr, kw, 128, vwt, T, kstart, tid);
    tile_swrite(tr, tiles, tid);
    __syncthreads();
#pragma unroll 1
    for (int k0 = kstart; k0 <= kend; k0 += 64, ++it) {
      if (k0 + 64 <= kend) tile_gload(tr, kw, 128, vwt, T, k0 + 64, tid);
      const lds_u8* stage = tiles + (it & 1) * TILE_STAGE;
      if (k0 <= t0 + 15 && k0 + 63 + 512 > t0) {
#pragma unroll 1
        for (int hf = 0; hf < 2; ++hf) {
          const int key0 = k0 + hf * 32;
          f32x4 s[2][4];
          const f32x4 cz = {0.f, 0.f, 0.f, 0.f};
          qk_scores_lds<4, 2, true>(stage, hf, qf, s, lane, qlds, cz, cz);
          if (!(k0 + 63 <= t0 && k0 + 512 > t0 + 15)) {
#pragma unroll
            for (int kt = 0; kt < 2; ++kt)
#pragma unroll
              for (int i = 0; i < 4; ++i) {
                const int key = key0 + 8 * grp + 4 * kt + i;
                const bool ok = (key <= t) && (key + 512 > t);
#pragma unroll
                for (int ct = 0; ct < 4; ++ct) s[kt][ct][i] = ok ? s[kt][ct][i] : NEG_INF;
              }
          }
          bf16x8 vfr[4];
          v_frags_lds<4>(stage, hf, vfr, lane);
          softmax_update<4, 4, true, false>(s, m, lsum, o, &lacc);
          pv_accum_lds<4, 4>(vfr, s, o, lane, lacc);
        }
      }
      if (k0 + 64 <= kend) tile_swrite(tr, tiles + ((it + 1) & 1) * TILE_STAGE, tid);
      __syncthreads();
    }
    float sc2[4];
#pragma unroll
    for (int ct = 0; ct < 4; ++ct) sc2[ct] = (lacc[ct][0] > 0.f ? 1.0f / lacc[ct][0] : 0.f) * gatep[ct * 3 + 2];
    bf16_t* oa = WSP(bf16_t, OFF_OA) + row * 512 + g * 256;
#pragma unroll
    for (int dt = 0; dt < 4; ++dt)
#pragma unroll
      for (int ct = 0; ct < 4; ++ct) {
        bf16_t* ptr = oa + ct * 64 + 16 * dt + 4 * grp;
        const u32x2 sw = *(const u32x2*)ptr;
        float val[4];
#pragma unroll
        for (int i = 0; i < 4; ++i) val[i] = scr[((dt * 4 + ct) * 4 + i) * 64 + lane] + o[dt][ct][i] * sc2[ct];
        u32x2 w = {cvtpk(val[0] * bflo(sw[0]), val[1] * bfhi(sw[0])), cvtpk(val[2] * bflo(sw[1]), val[3] * bfhi(sw[1]))};
        if (st) *(u32x2*)ptr = w;
        asm volatile("" ::: "memory");
      }
  }
#undef NSA_SECTION_VARS
}

__device__ void fox_wg_unit(const Params& p, int l, int b, int h, int qb, lds_u8* tiles, bool st) {
  const int tid = tidx();
  const int wave = __builtin_amdgcn_readfirstlane(tid >> 6);
  const int lane = tid & 63, r = lane & 15, grp = lane >> 4;
  const int t0 = qb * 512 + wave * 64;
  bf16x8 qf[4][2];
  const float* fc = WSP(float, OFF_FC) + (size_t)(b * 8 + h) * T;
#pragma unroll
  for (int ct = 0; ct < 4; ++ct) {
    const size_t row = (size_t)b * T + t0 + 16 * ct + r;
#pragma unroll
    for (int dk = 0; dk < 2; ++dk)
      qf[ct][dk] = *(const bf16x8*)(WSP(bf16_t, OFF_FQ) + row * 512 + h * 64 + dk * 32 + grp * 8);
  }
  const bf16_t* kb = WSP(bf16_t, OFF_FK) + ((size_t)b * T) * 512 + h * 64;
  const bf16_t* vt = WSP(bf16_t, OFF_FVT) + (size_t)((b * 8 + h) * 64) * T;
  f32x4 o[4][4];
  float m[4], lsum[4];
  f32x4 lacc[4];
#pragma unroll
  for (int ct = 0; ct < 4; ++ct) { m[ct] = NEG_INF; lsum[ct] = 0.f; lacc[ct] = (f32x4){0.f, 0.f, 0.f, 0.f}; }
#pragma unroll
  for (int dt = 0; dt < 4; ++dt)
#pragma unroll
    for (int ct = 0; ct < 4; ++ct) o[dt][ct] = (f32x4){0.f, 0.f, 0.f, 0.f};
  const int ntiles = (qb + 1) * 8;
  int it0, itw0;
  {
    float gq = fabsf(p.fox_q_norm[l * 64 + lane]), gk = fabsf(p.fox_k_norm[l * 64 + lane]);
#pragma unroll
    for (int o_ = 1; o_ < 64; o_ <<= 1) { gq = fmaxf(gq, __shfl_xor(gq, o_)); gk = fmaxf(gk, __shfl_xor(gk, o_)); }
    const float B2 = 16.0f * gq * gk * 1.02f + 104.0f;
    const float thr_wg = fc[qb * 512] + B2, thr_w = fc[t0] + B2;
    const float c0 = (lane < ntiles) ? fc[64 * lane + 63] : -3.0e38f;
    const float c1 = (lane + 64 < ntiles) ? fc[64 * (lane + 64) + 63] : -3.0e38f;
    it0 = __popcll(__ballot(c0 > thr_wg)) + __popcll(__ballot(c1 > thr_wg));
    itw0 = __popcll(__ballot(c0 > thr_w)) + __popcll(__ballot(c1 > thr_w));
    it0 = __builtin_amdgcn_readfirstlane(it0);
    itw0 = __builtin_amdgcn_readfirstlane(itw0);
  }
  TileRegs tr;
  float ckr = 0.f;
  tile_gload(tr, kb, 512, vt, T, it0 * 64, tid);
  if (tid < 64) ckr = fc[it0 * 64 + tid] * (-LOG2E);
  tile_swrite(tr, tiles, tid);
  if (tid < 64) *(__attribute__((address_space(3))) float*)(tiles + 2 * TILE_HALF + tid * 4) = ckr;
  __syncthreads();
#pragma unroll 1
  for (int it = it0; it < ntiles; ++it) {
    const int k0 = it * 64;
    if (it + 1 < ntiles) { tile_gload(tr, kb, 512, vt, T, k0 + 64, tid); if (tid < 64) ckr = fc[k0 + 64 + tid] * (-LOG2E); }
    const lds_u8* stage = tiles + ((it - it0) & 1) * TILE_STAGE;
    if (k0 <= t0 + 63 && it >= itw0) {
      const bool diag = (k0 + 63 > t0);
#pragma unroll
      for (int hf = 0; hf < 2; ++hf) {
        const int key0 = k0 + hf * 32;
        f32x4 s[2][4];
        const f32x4 ck0 = *(const __attribute__((address_space(3))) f32x4*)(stage + 2 * TILE_HALF + (32 * hf + 8 * grp) * 4);
        const f32x4 ck1 = *(const __attribute__((address_space(3))) f32x4*)(stage + 2 * TILE_HALF + (32 * hf + 8 * grp + 4) * 4);
        qk_scores_lds<4, 2, false>(stage, hf, qf, s, lane, nullptr, ck0, ck1);
        if (diag) {
#pragma unroll
          for (int kt = 0; kt < 2; ++kt)
#pragma unroll
            for (int i = 0; i < 4; ++i) {
              const int key = key0 + 8 * grp + 4 * kt + i;
#pragma unroll
              for (int ct = 0; ct < 4; ++ct) s[kt][ct][i] = (key <= t0 + 16 * ct + r) ? s[kt][ct][i] : NEG_INF;
            }
        }
        bf16x8 vfr[4];
        v_frags_lds<4>(stage, hf, vfr, lane);
        softmax_update<4, 4, true, false>(s, m, lsum, o, &lacc);
        pv_accum_lds<4, 4>(vfr, s, o, lane, lacc);
      }
    }
    if (it + 1 < ntiles) {
      tile_swrite(tr, tiles + ((it - it0 + 1) & 1) * TILE_STAGE, tid);
      if (tid < 64) *(__attribute__((address_space(3))) float*)(tiles + ((it - it0 + 1) & 1) * TILE_STAGE + 2 * TILE_HALF + tid * 4) = ckr;
    }
    __syncthreads();
  }
  float invl[4];
#pragma unroll
  for (int ct = 0; ct < 4; ++ct) invl[ct] = lacc[ct][0] > 0.f ? 1.0f / lacc[ct][0] : 0.f;
#pragma unroll
  for (int ct = 0; ct < 4; ++ct) {
    bf16_t* ob = WSP(bf16_t, OFF_OB) + ((size_t)b * T + t0 + 16 * ct + r) * 512 + h * 64;
#pragma unroll
    for (int dt = 0; dt < 4; ++dt) {
      bf16_t* ptr = ob + 16 * dt + 4 * grp;
      const u32x2 sw = *(const u32x2*)ptr;
      const f32x4 v = o[dt][ct] * invl[ct];
      u32x2 w = {cvtpk(v[0] * bflo(sw[0]), v[1] * bfhi(sw[0])), cvtpk(v[2] * bflo(sw[1]), v[3] * bfhi(sw[1]))};
      if (st) *(u32x2*)ptr = w;
    }
  }
}

__device__ void mem_unit(const Params& p, int l, int b, int h, int t0, bool st) {
  const int lane = tidx() & 63, r = lane & 15, grp = lane >> 4;
  const float SC = 0.08838834764831845f * LOG2E;
  bf16x8 qf[2][4];
  const float* gq = p.mem_q_norm + l * 128;
#pragma unroll
  for (int ct = 0; ct < 2; ++ct) {
    const size_t row = (size_t)b * T + t0 + 16 * ct + r;
    float v[4][8];
    float ss = 0.f;
#pragma unroll
    for (int dk = 0; dk < 4; ++dk) {
      const u32x4 w = *(const u32x4*)(WSP(bf16_t, OFF_MQ) + row * 512 + h * 128 + dk * 32 + grp * 8);
#pragma unroll
      for (int j = 0; j < 4; ++j) { v[dk][2 * j] = bflo(w[j]); v[dk][2 * j + 1] = bfhi(w[j]); }
#pragma unroll
      for (int j = 0; j < 8; ++j) ss += v[dk][j] * v[dk][j];
    }
    ss += __shfl_xor(ss, 16);
    ss += __shfl_xor(ss, 32);
    const float rstd = rsqrtf(ss * (1.0f / 128.0f) + EPS);
#pragma unroll
    for (int dk = 0; dk < 4; ++dk) {
      const f32x4 g0 = *(const f32x4*)(gq + dk * 32 + grp * 8), g1 = *(const f32x4*)(gq + dk * 32 + grp * 8 + 4);
      u32x4 w = {cvtpk(v[dk][0] * rstd * g0[0], v[dk][1] * rstd * g0[1]), cvtpk(v[dk][2] * rstd * g0[2], v[dk][3] * rstd * g0[3]),
                 cvtpk(v[dk][4] * rstd * g1[0], v[dk][5] * rstd * g1[1]), cvtpk(v[dk][6] * rstd * g1[2], v[dk][7] * rstd * g1[3])};
      qf[ct][dk] = __builtin_bit_cast(bf16x8, w);
    }
  }
  const bf16_t* kb = WSP(bf16_t, OFF_MK) + ((size_t)b * 256) * 512 + h * 128;
  const bf16_t* vt = WSP(bf16_t, OFF_MVT) + (size_t)((b * 4 + h) * 128) * 256;
  f32x4 o[8][2];
  float m[2], lsum[2];
#pragma unroll
  for (int ct = 0; ct < 2; ++ct) { m[ct] = NEG_INF; lsum[ct] = 0.f; }
#pragma unroll
  for (int dt = 0; dt < 8; ++dt)
#pragma unroll
    for (int ct = 0; ct < 2; ++ct) o[dt][ct] = (f32x4){0.f, 0.f, 0.f, 0.f};
#pragma unroll 1
  for (int key0 = 0; key0 < 256; key0 += 32) {
    f32x4 s[2][2];
    qk_scores<2, 4>(kb, 512, key0, qf, s, lane);
#pragma unroll
    for (int kt = 0; kt < 2; ++kt)
#pragma unroll
      for (int ct = 0; ct < 2; ++ct) s[kt][ct] = s[kt][ct] * SC;
    softmax_update<2, 8, true>(s, m, lsum, o);
    pv_accum<2, 8>(vt, 256, key0, s, o, lane);
  }
#pragma unroll
  for (int ct = 0; ct < 2; ++ct) {
    const float invl = finish_l(lsum[ct]);
    bf16_t* om = WSP(bf16_t, OFF_OM) + ((size_t)b * T + t0 + 16 * ct + r) * 512 + h * 128;
#pragma unroll
    for (int dt = 0; dt < 8; ++dt) {
      bf16_t* ptr = om + 16 * dt + 4 * grp;
      const u32x2 sw = *(const u32x2*)ptr;
      const f32x4 v = o[dt][ct] * invl;
      u32x2 w = {cvtpk(v[0] * bflo(sw[0]), v[1] * bfhi(sw[0])), cvtpk(v[2] * bflo(sw[1]), v[3] * bfhi(sw[1]))};
      if (st) *(u32x2*)ptr = w;
    }
  }
}

__device__ void phase_attn(const Params& p, int l, unsigned char* ldsraw, bool st, int cidx) {
  const int tid = tidx();
  const int wave = __builtin_amdgcn_readfirstlane(tid >> 6);
  float* imp = (float*)ldsraw + wave * 2112;
  lds_u8* tiles = (lds_u8*)ldsraw;
  bf16x8* qlds = (bf16x8*)(ldsraw + 69632 + wave * 8192);
  unsigned* misc = (unsigned*)(ldsraw + 135168);
  float* scr = WSP(float, OFF_SCR) + (size_t)(bidx() * NWAVES + wave) * 4096;
  unsigned* ctr = WSP(unsigned, OFF_CTL) + cidx;
  constexpr int NUNITS = 1536;
  for (;;) {
    __syncthreads();
    if (tid == 0) misc[0] = atomicAdd(ctr, 1u);
    if (tid >= 4 && tid < 8) misc[tid] = 0u;
    __syncthreads();
    const int u = __builtin_amdgcn_readfirstlane((int)misc[0]);
    if (u >= NUNITS) break;
    if (u < 1024) {
      const int g4 = u >> 6, w = u & 63;
      if (w < 32) fox_wg_unit(p, l, w >> 3, w & 7, 15 - g4, tiles, st);
      else { const int w2 = w - 32, kk = w2 >> 3, bg = w2 & 7; nsa_wg_unit(p, bg >> 1, bg & 1, 63 - (4 * g4 + kk), imp, qlds, scr, tiles, misc, st); }
    } else {
      const int mu = u - 1024, bh = mu >> 5, qblk = mu & 31;
      mem_unit(p, l, bh >> 2, bh & 3, 256 * qblk + 32 * wave, st);
    }
  }
}

__global__ void __launch_bounds__(NTHREADS) hybrid_megakernel(Params p) {
  cg::grid_group grid = cg::this_grid();
  extern __shared__ __attribute__((aligned(16))) unsigned char dynlds[];
  float* smem = (float*)dynlds;
  PG8_LAS unsigned char* glds = (PG8_LAS unsigned char*)dynlds;
  volatile LAS unsigned* bst = (volatile LAS unsigned*)(glds + 135168 + 64);
  if (threadIdx.x < 2) bst[threadIdx.x] = 0u;
  __syncthreads();
  grid.sync();
  const XcdBarrier xbar = xcd_barrier_post(WSP(unsigned, OFF_BAR), bst);
#pragma unroll 1
  for (int ph = 0; ph < 28; ++ph) {
    const int l = ph / 7, k = ph - 7 * l;
    if (k == 0) {
      phase_prep(p, l, smem);
    } else if (k == 1) {
      EpiIn E{&p, l};
      for (int rp = 0; rp < (PROBE_GEMM2 ? (p.ws != nullptr ? 2 : 1) : 1); ++rp)
        run_gemm(glds, WSP(bf16_t, OFF_H), WSP(bf16_t, OFF_W_IN), M, 5120, 1024, E);
      EpiMemKV E2{&p};
      run_gemm(glds, WSP(bf16_t, OFF_MEMN), WSP(bf16_t, OFF_W_MKV), 1024, 1024, 1024, E2);
    } else if (k == 2) {
      phase_mid(p, l);
    } else if (k == 3) {
      const int nrep = PROBE_ATTN2 ? (p.ws != nullptr ? 2 : 1) : 1;
      for (int rp = 0; rp < nrep; ++rp) {
        const bool last = (rp == nrep - 1);
        if (rp) xcd_barrier(xbar);
        phase_attn(p, l, dynlds, last, last ? l : 8 + l);
      }
    } else if (k == 4) {
      EpiGate E{WSP(bf16_t, OFF_G)};
      for (int rp = 0; rp < (PROBE_GEMM2 ? (p.ws != nullptr ? 2 : 1) : 1); ++rp)
        run_gemm(glds, WSP(bf16_t, OFF_H), WSP(bf16_t, OFF_W_G), M, 3072, 1024, E);
    } else if (k == 5) {
      for (int rp = 0; rp < (PROBE_BR2 ? (p.ws != nullptr ? 2 : 1) : 1); ++rp) {
      EpiBranch Ea{WSP(bf16_t, OFF_G), WSP(bf16_t, OFF_U), 1};
      run_gemm(glds, WSP(bf16_t, OFF_OA), WSP(bf16_t, OFF_W_BR), M, 1024, 512, Ea);
      EpiBranch Eb{WSP(bf16_t, OFF_G) + (size_t)M * 1024, WSP(bf16_t, OFF_U), 0};
      run_gemm(glds, WSP(bf16_t, OFF_OB), WSP(bf16_t, OFF_W_BR + MiB), M, 1024, 512, Eb);
      EpiBranch Ec{WSP(bf16_t, OFF_G) + (size_t)2 * M * 1024, WSP(bf16_t, OFF_U), 0};
      run_gemm(glds, WSP(bf16_t, OFF_OM), WSP(bf16_t, OFF_W_BR + 2 * MiB), M, 1024, 512, Ec);
      }
    } else {
      EpiOut E{l == 0 ? p.x : p.out, p.out};
      run_gemm(glds, WSP(bf16_t, OFF_U), WSP(bf16_t, OFF_W_OUT), M, 1024, 1024, E);
    }
    xcd_barrier(xbar);
  }
}

extern "C" void kernel_launch(void* const* d_in, const int* in_sizes, int n_in, void* d_out, int out_size, void* d_ws,
                              size_t ws_size, hipStream_t stream) {
  static int grid_blocks = 0;
  if (!grid_blocks) {
    int dev = 0, cus = 0, per_cu = 0;
    (void)hipGetDevice(&dev);
    (void)hipDeviceGetAttribute(&cus, hipDeviceAttributeMultiprocessorCount, dev);
    if (hipFuncSetAttribute((const void*)hybrid_megakernel, hipFuncAttributeMaxDynamicSharedMemorySize, LDS_BYTES) != hipSuccess)
      fprintf(stderr, "hipFuncSetAttribute(dynamic LDS %d) failed\n", LDS_BYTES);
    (void)hipOccupancyMaxActiveBlocksPerMultiprocessor(&per_cu, hybrid_megakernel, NTHREADS, LDS_BYTES);
    (void)hipGetLastError();
    grid_blocks = cus;
    if (grid_blocks > 256) grid_blocks = 256;
    if (ws_size < OFF_SCR + (size_t)32 * MiB) fprintf(stderr, "workspace too small: %zu\n", ws_size);
  }
  Params p{};
  const float** pp = (const float**)&p;
  for (int i = 0; i < 23; ++i) pp[i] = (const float*)d_in[i];
  p.out = (float*)d_out;
  p.ws = (char*)d_ws;
  void* args[] = {&p};
  (void)hipMemsetAsync((char*)d_ws + OFF_BAR, 0, XCD_BAR_WORDS * sizeof(unsigned), stream);
  hipError_t e = hipLaunchCooperativeKernel((void*)hybrid_megakernel, dim3(grid_blocks), dim3(NTHREADS), args, LDS_BYTES, stream);
  if (e != hipSuccess) fprintf(stderr, "cooperative launch failed: %s (grid %d)\n", hipGetErrorString(e), grid_blocks);
}
```

```cpp
#include <hip/hip_runtime.h>
#include <hip/hip_cooperative_groups.h>
#include <stdint.h>
#include <cstdio>
namespace cg = cooperative_groups;
#ifndef PROBE_ATTN2
#define PROBE_ATTN2 0
#endif
#ifndef PROBE_PM2
#define PROBE_PM2 0
#endif
#ifndef PROBE_BR2
#define PROBE_BR2 0
#endif
#ifndef PROBE_GEMM2
#define PROBE_GEMM2 0
#endif


typedef unsigned short bf16_t;
typedef short bf16x8 __attribute__((ext_vector_type(8)));
typedef float f32x4 __attribute__((ext_vector_type(4)));
typedef unsigned u32x2 __attribute__((ext_vector_type(2)));
typedef unsigned u32x4 __attribute__((ext_vector_type(4)));
typedef float f32x2_t __attribute__((ext_vector_type(2)));
typedef __bf16 bf16x2_t __attribute__((ext_vector_type(2)));

constexpr int NB = 4, T = 8192, M = NB * T;
constexpr int NTHREADS = 512, NWAVES = NTHREADS / 64;
constexpr int LDS_BYTES = 147456;
constexpr float EPS = 1e-6f;
constexpr float LOG2E = 1.4426950408889634f;
#define NEG_INF (-__builtin_inff())

constexpr size_t MiB = 1u << 20;
constexpr size_t OFF_CTL = 0;
constexpr size_t OFF_BAR = 64 * 1024;
constexpr size_t OFF_ROPE = 1 * MiB;
constexpr size_t OFF_W_IN = 3 * MiB;
constexpr size_t OFF_W_G = 13 * MiB;
constexpr size_t OFF_W_MKV = 19 * MiB;
constexpr size_t OFF_W_BR = 21 * MiB;
constexpr size_t OFF_W_OUT = 24 * MiB;
constexpr size_t OFF_W1 = 26 * MiB;
constexpr size_t OFF_W2 = 27 * MiB;
constexpr size_t OFF_C1 = 27 * MiB + 256 * 1024;
constexpr size_t OFF_MEMN = 28 * MiB;
constexpr size_t OFF_MK = 30 * MiB;
constexpr size_t OFF_MVT = 31 * MiB;
constexpr size_t OFF_H = 32 * MiB;
constexpr size_t OFF_U = OFF_H;
constexpr size_t OFF_OA = 96 * MiB;
constexpr size_t OFF_OB = 128 * MiB;
constexpr size_t OFF_OM = 160 * MiB;
constexpr size_t OFF_QN = 192 * MiB;
constexpr size_t OFF_G = 192 * MiB;
constexpr size_t OFF_KC = 224 * MiB;
constexpr size_t OFF_VC = 232 * MiB;
constexpr size_t OFF_KS = 240 * MiB;
constexpr size_t OFF_VST = 248 * MiB;
constexpr size_t OFF_KW = 256 * MiB;
constexpr size_t OFF_VWT = 264 * MiB;
constexpr size_t OFF_FQ = 272 * MiB;
constexpr size_t OFF_FK = 304 * MiB;
constexpr size_t OFF_FVT = 336 * MiB;
constexpr size_t OFF_MQ = 368 * MiB;
constexpr size_t OFF_GATE = 400 * MiB;
constexpr size_t OFF_FLOG = 403 * MiB;
constexpr size_t OFF_FC = 404 * MiB;
constexpr size_t OFF_KCMP = 405 * MiB;
constexpr size_t OFF_VCT = 405 * MiB + 512 * 1024;
constexpr size_t OFF_SCR = 406 * MiB;

struct Params {
  const float *x, *mem, *norm_g, *mem_norm_g, *w_in, *nsa_q_norm, *nsa_k_norm, *cmp_pe_k, *cmp_w1_k, *cmp_w2_k,
      *cmp_pe_v, *cmp_w1_v, *cmp_w2_v, *fox_q_norm, *fox_k_norm, *fox_f_bias, *mem_q_norm, *mem_k_norm, *w_mem_kv,
      *w_branch_a, *w_branch_b, *w_branch_m, *w_out;
  float* out;
  char* ws;
};
__device__ __forceinline__ char* ws_base(char* w) {
  unsigned lo = __builtin_amdgcn_readfirstlane((unsigned)(uintptr_t)w), hi = __builtin_amdgcn_readfirstlane((unsigned)((uintptr_t)w >> 32));
  asm volatile("" : "+s"(lo), "+s"(hi));
  return (char*)(__attribute__((address_space(1))) char*)(((uintptr_t)hi << 32) | (uintptr_t)lo);
}
#define WSP(TYPE, off) ((TYPE*)(ws_base(p.ws) + (off)))

__constant__ float c_inv_freq[32] = {
    1.000000000e+00f, 7.498942018e-01f, 5.623413324e-01f, 4.216965139e-01f, 3.162277639e-01f, 2.371373773e-01f,
    1.778279394e-01f, 1.333521456e-01f, 1.000000015e-01f, 7.498942316e-02f, 5.623413250e-02f, 4.216964915e-02f,
    3.162277490e-02f, 2.371373773e-02f, 1.778279431e-02f, 1.333521400e-02f, 9.999999776e-03f, 7.498942316e-03f,
    5.623413250e-03f, 4.216964822e-03f, 3.162277630e-03f, 2.371373819e-03f, 1.778279431e-03f, 1.333521446e-03f,
    1.000000047e-03f, 7.498941850e-04f, 5.623413017e-04f, 4.216965172e-04f, 3.162277571e-04f, 2.371373703e-04f,
    1.778279402e-04f, 1.333521504e-04f};

__device__ __forceinline__ int bidx() { int b = blockIdx.x; asm volatile("" : "+s"(b)); return b; }
__device__ __forceinline__ int gdim() { int g = gridDim.x; asm volatile("" : "+s"(g)); return g; }
__device__ __forceinline__ int tidx() { int t = threadIdx.x; asm volatile("" : "+v"(t)); return t; }
__device__ __forceinline__ unsigned cvtpk(float lo, float hi) {
  f32x2_t v = {lo, hi};
  bf16x2_t b = __builtin_convertvector(v, bf16x2_t);
  return __builtin_bit_cast(unsigned, b);
}
__device__ __forceinline__ float bf2f(unsigned short v) { return __uint_as_float(((unsigned)v) << 16); }
__device__ __forceinline__ float bflo(unsigned w) { return __uint_as_float(w << 16); }
__device__ __forceinline__ float bfhi(unsigned w) { return __uint_as_float(w & 0xffff0000u); }
__device__ __forceinline__ f32x4 mfma16(bf16x8 a, bf16x8 b, f32x4 c) {
  return __builtin_amdgcn_mfma_f32_16x16x32_bf16(a, b, c, 0, 0, 0);
}
__device__ __forceinline__ bf16x8 pack8(f32x4 a, f32x4 b) {
  u32x4 w = {cvtpk(a[0], a[1]), cvtpk(a[2], a[3]), cvtpk(b[0], b[1]), cvtpk(b[2], b[3])};
  return __builtin_bit_cast(bf16x8, w);
}
__device__ __forceinline__ float sigmoidf_(float v) { return 1.0f / (1.0f + __expf(-v)); }
__device__ __forceinline__ float siluf_(float v) { return v / (1.0f + __expf(-v)); }
__device__ __forceinline__ float grp_max4(float v) {
  auto a = __builtin_amdgcn_permlane32_swap(__float_as_uint(v), __float_as_uint(v), false, false);
  v = fmaxf(__uint_as_float(a[0]), __uint_as_float(a[1]));
  auto b = __builtin_amdgcn_permlane16_swap(__float_as_uint(v), __float_as_uint(v), false, false);
  return fmaxf(__uint_as_float(b[0]), __uint_as_float(b[1]));
}
__device__ __forceinline__ float wave_sum(float v) {
#pragma unroll
  for (int o = 1; o < 64; o <<= 1) v += __shfl_xor(v, o);
  return v;
}

#define LAS __attribute__((address_space(3)))
#define XB_TMO      128
#define XB_XCNT(j)  (256  + 64 * (j))
#define XB_XSUB(j)  (1280 + 64 * (j))
#define XB_XGEN(j)  (2304 + 64 * (j))
#define XB_TOP      3328
#define XB_TOPGEN   3392
#define XCD_BAR_WORDS 3456
#define XB_SPIN_CAP (1u << 18)

__device__ __forceinline__ unsigned xb_ld(unsigned* p)              { return __hip_atomic_load(p, __ATOMIC_RELAXED, __HIP_MEMORY_SCOPE_AGENT); }
__device__ __forceinline__ unsigned xb_add(unsigned* p, unsigned v) { return __hip_atomic_fetch_add(p, v, __ATOMIC_RELAXED, __HIP_MEMORY_SCOPE_AGENT); }
__device__ __forceinline__ unsigned xb_xcc_id() { return (unsigned)__builtin_amdgcn_s_getreg((3 << 11) | 20) & 0xFu; }
#define XB_SPIN(cond, bar) do { unsigned _sp = 0; while (cond) { __builtin_amdgcn_s_sleep(1); \
    if ((++_sp & 255u) == 0u) { if (xb_ld(&(bar)[XB_TMO])) break; if (_sp > XB_SPIN_CAP) { atomicAdd(&(bar)[XB_TMO], 1u); break; } } } } while (0)

struct XcdBarrier {
    unsigned* bar; unsigned x;
    volatile LAS unsigned* st;
};

__device__ __forceinline__ XcdBarrier xcd_barrier_post(unsigned* bar, volatile LAS unsigned* st) {
    XcdBarrier b; b.bar = bar; b.x = xb_xcc_id(); b.st = st;
    if (threadIdx.x == 0) (void)xb_add(&bar[XB_XCNT(b.x)], 1u);
    return b;
}
__device__ __forceinline__ void xcd_barrier_complete(unsigned* bar, unsigned x, unsigned& nloc, unsigned& nx) {
    const unsigned G = gridDim.x * gridDim.y * gridDim.z;
    unsigned sum, cnt, mine, sp = 0u;
    for (;;) {
        sum = 0u; cnt = 0u; mine = 0u;
#pragma unroll
        for (unsigned j = 0; j < 16; ++j) { const unsigned c = xb_ld(&bar[XB_XCNT(j)]); sum += c; cnt += (c > 0u) ? 1u : 0u; mine = (j == x) ? c : mine; }
        if (sum == G) break;
        __builtin_amdgcn_s_sleep(1);
        if ((++sp & 255u) == 0u) { if (xb_ld(&bar[XB_TMO])) break; if (sp > XB_SPIN_CAP) { atomicAdd(&bar[XB_TMO], 1u); break; } }
    }
    nloc = mine > 0u ? mine : 1u; nx = cnt > 0u ? cnt : 1u;
}

__device__ __forceinline__ void xcd_barrier(const XcdBarrier& b) {
    asm volatile("s_waitcnt vmcnt(0)" ::: "memory");
    __syncthreads();
    if (threadIdx.x == 0) {
        unsigned* bar = b.bar;
        __builtin_amdgcn_s_waitcnt(0);
        unsigned nloc = b.st[0], nx = b.st[1];
        if (nloc == 0u) { xcd_barrier_complete(bar, b.x, nloc, nx); b.st[0] = nloc; b.st[1] = nx; }
        const unsigned old = xb_add(&bar[XB_XSUB(b.x)], 1u);
        const unsigned gen = old / nloc;
        if (old + 1u == (gen + 1u) * nloc) {
            __builtin_amdgcn_fence(__ATOMIC_RELEASE, "agent");
            asm volatile("s_waitcnt vmcnt(0)" ::: "memory");
            const unsigned og = xb_add(&bar[XB_TOP], 1u);
            const unsigned tg = og / nx;
            if (og + 1u == (tg + 1u) * nx) xb_add(&bar[XB_TOPGEN], 1u);
            else XB_SPIN(xb_ld(&bar[XB_TOPGEN]) == tg, bar);
            __builtin_amdgcn_fence(__ATOMIC_ACQUIRE, "agent");
            xb_add(&bar[XB_XGEN(b.x)], 1u);
            asm volatile("s_waitcnt vmcnt(0)" ::: "memory");
        } else {
            XB_SPIN(xb_ld(&bar[XB_XGEN(b.x)]) == gen, bar);
            __builtin_amdgcn_fence(__ATOMIC_ACQUIRE, "agent");
            asm volatile("s_waitcnt vmcnt(0)" ::: "memory");
        }
    }
    __syncthreads();
}


namespace pg8 {
#define PG8_LAS __attribute__((address_space(3)))
typedef unsigned short bf16_t;
typedef short bf16x8 __attribute__((ext_vector_type(8)));
typedef float f32x4 __attribute__((ext_vector_type(4)));
typedef unsigned u32x4 __attribute__((ext_vector_type(4)));
constexpr int BM = 256, BK = 64, HALF = 128, HTB = HALF * BK * 2  , STAGE_BYTES = 8 * HTB, NXCD = 8, WGM = 8;

__host__ __device__ __forceinline__ int lds_byte(int r, int c) { const int st = (r >> 4) * 2 + (c >> 5), rr = r & 15, cc = c & 31, ob = rr * 64 + cc * 2; return st * 1024 + (ob ^ (((ob >> 9) & 1) << 5)); }
__host__ __device__ __forceinline__ void stage_rc(int b, int& R, int& C) { const int st = b / 1024, sb = b % 1024, swz = sb ^ (((sb >> 9) & 1) << 5); R = (st >> 1) * 16 + swz / 64; C = (st & 1) * 32 + (swz % 64) / 2; }
__host__ __device__ __forceinline__ int perm32(int rho) { const int n = rho >> 4, i = rho & 15; return 8 * (i >> 2) + 4 * n + (i & 3); }

struct Unit { int pm, pn; };
struct Gemm { const bf16_t* A; const bf16_t* Bt; int M, N, K; };

struct StaticOrder {
    int nM, nN, nwg, G, c;
    __host__ __device__ void init(int M, int N, int G_, int c_) { nM = M / BM; nN = N / BM; nwg = nM * nN; G = G_; c = c_; }
    __host__ __device__ bool next(int i, Unit& u) const {
        const long L = (long)i * G + c; if (L >= nwg) return false;
        int wgid = (int)L; { const int q = nwg / NXCD, r = nwg % NXCD, xcd = wgid % NXCD, off = wgid / NXCD; wgid = (xcd < r ? xcd * (q + 1) : r * (q + 1) + (xcd - r) * q) + off; }
        const int nig = WGM * nN, gid = wgid / nig, fm = gid * WGM, gsz = (nM - fm) < WGM ? (nM - fm) : WGM;
        u.pm = fm + ((wgid % nig) % gsz); u.pn = (wgid % nig) / gsz; return true;
    }
    __device__ __forceinline__ void a_ready(const Unit&) const {}
    __device__ __forceinline__ void done(const Unit&) const {}
};
__device__ __forceinline__ unsigned cvt_pk_bf16(float lo, float hi) { unsigned r; asm volatile("v_cvt_pk_bf16_f32 %0, %1, %2" : "=v"(r) : "v"(lo), "v"(hi)); return r; }
template <class Epi, class Sched, bool ALIGN_EPI = false, bool SP2 = false>
__device__ __forceinline__ void gemm_phase(PG8_LAS unsigned char* lds, const Gemm g, const Sched& S, const Epi& E) {
    const int tid = tidx(), wid = __builtin_amdgcn_readfirstlane(tid >> 6), lane = tid & 63, wr = wid >> 2, wc = wid & 3, fr = lane & 15, fq = lane >> 4;
    const int K = g.K, nt = K / BK;
    unsigned voffA[2], voffB[2];
#pragma unroll
    for (int i = 0; i < 2; ++i) { int R, C; stage_rc(tid * 16 + i * 8192, R, C); const int Rb = Epi::PERM ? ((R & ~31) + perm32(R & 31)) : R;
        voffA[i] = (unsigned)(R * K + C) * 2u; voffB[i] = (unsigned)(Rb * K + C) * 2u; }
    const size_t kstep = (size_t)(BK * 2);
    const size_t hstep = (size_t)HALF * K * 2;
    const size_t tstep = 2 * hstep;
    const unsigned ldsw = (unsigned)wid * 1024u;
    const int aoff = lds_byte(wr * 64 + fr, fq * 8), boff = lds_byte(wc * 32 + fr, fq * 8);
#define PG8_SA(b, h) (((b) * 2 + (h)) * HTB)
#define PG8_SB(b, h) ((4 + (b) * 2 + (h)) * HTB)
#define PG8_STAGE(bufoff, gbase, voff) do { _Pragma("unroll") for (int _i = 0; _i < 2; ++_i) \
        __builtin_amdgcn_global_load_lds((const unsigned*)((const char*)(gbase) + (voff)[_i]), (PG8_LAS unsigned*)(lds + (bufoff) + ldsw + _i * 8192), 16, 0, 0); } while (0)
#define PG8_LDA(dst, b, h) do { _Pragma("unroll") for (int m = 0; m < 4; ++m) _Pragma("unroll") for (int k = 0; k < 2; ++k) dst[m][k] = *(const PG8_LAS bf16x8*)(lds + PG8_SA(b, h) + aoff + m * 2048 + k * 1024); } while (0)
#define PG8_LDB(dst, b, h) do { _Pragma("unroll") for (int n = 0; n < 2; ++n) _Pragma("unroll") for (int k = 0; k < 2; ++k) dst[n][k] = *(const PG8_LAS bf16x8*)(lds + PG8_SB(b, h) + boff + n * 2048 + k * 1024); } while (0)
#define PG8_MMA(ai, bj, At, Bt) do { __builtin_amdgcn_s_setprio(1); _Pragma("unroll") for (int m = 0; m < 4; ++m) _Pragma("unroll") for (int n = 0; n < 2; ++n) _Pragma("unroll") for (int k = 0; k < 2; ++k) \
        acc[ai][bj][m][n] = __builtin_amdgcn_mfma_f32_16x16x32_bf16(Bt[n][k], At[m][k], acc[ai][bj][m][n], 0, 0, 0); __builtin_amdgcn_s_setprio(0); } while (0)
#define PG8_WAIT_V(n) asm volatile("s_waitcnt vmcnt(" #n ")" ::: "memory")
#define PG8_WAIT_L(n) asm volatile("s_waitcnt lgkmcnt(" #n ")" ::: "memory")
#define PG8_BAR __builtin_amdgcn_s_barrier()
#define PG8_SCHED __builtin_amdgcn_sched_barrier(0)
    Unit cur, nxt; int ui = 0;
    if (!S.next(0, cur)) return;
    f32x4 acc[2][2][4][2];
#pragma unroll
    for (int a = 0; a < 2; ++a)
#pragma unroll
        for (int b = 0; b < 2; ++b)
#pragma unroll
            for (int m = 0; m < 4; ++m)
#pragma unroll
                for (int n = 0; n < 2; ++n) acc[a][b][m][n] = (f32x4){0.f, 0.f, 0.f, 0.f};
    bf16x8 At[4][2], B0[2][2], B1[2][2];
    const char* cA = (const char*)g.A + (size_t)cur.pm * tstep; const char* cB = (const char*)g.Bt + (size_t)cur.pn * tstep;
    S.a_ready(cur);
    if constexpr (SP2) {
        PG8_STAGE(PG8_SB(0, 0), cB, voffB); PG8_STAGE(PG8_SB(0, 1), cB + hstep, voffB); PG8_STAGE(PG8_SA(0, 0), cA, voffA); PG8_STAGE(PG8_SA(0, 1), cA + hstep, voffA);
        if (wr == 1) PG8_BAR;
        PG8_WAIT_V(2); PG8_BAR;
        PG8_STAGE(PG8_SB(1, 0), cB + kstep, voffB); PG8_STAGE(PG8_SA(1, 0), cA + kstep, voffA); PG8_STAGE(PG8_SB(1, 1), cB + hstep + kstep, voffB);
        PG8_WAIT_V(6); PG8_BAR;
    } else {
        PG8_STAGE(PG8_SB(0, 0), cB, voffB); PG8_STAGE(PG8_SA(0, 0), cA, voffA); PG8_STAGE(PG8_SB(0, 1), cB + hstep, voffB); PG8_STAGE(PG8_SA(0, 1), cA + hstep, voffA);
        if (wr == 1) PG8_BAR;
        PG8_WAIT_V(4); PG8_BAR;
        PG8_STAGE(PG8_SB(1, 0), cB + kstep, voffB); PG8_STAGE(PG8_SA(1, 0), cA + kstep, voffA); PG8_STAGE(PG8_SB(1, 1), cB + hstep + kstep, voffB);
        PG8_WAIT_V(6); PG8_BAR;
    }
    for (;;) {
        const bool has_next = S.next(ui + 1, nxt);
        const char* nA = has_next ? (const char*)g.A + (size_t)nxt.pm * tstep : cA; const char* nB = has_next ? (const char*)g.Bt + (size_t)nxt.pn * tstep : cB;
        for (int t = 0; t < nt; t += 2) {
            const bool last = (t == nt - 2);
            const char* a1 = cA + (size_t)(t + 1) * kstep;
            const char* a2 = last ? nA : cA + (size_t)(t + 2) * kstep; const char* b2 = last ? nB : cB + (size_t)(t + 2) * kstep;
            const char* a3 = a2 + kstep; const char* b3 = b2 + kstep;
            if (last && has_next) S.a_ready(nxt);
            if constexpr (SP2) {
            PG8_LDB(B0, 0, 0); PG8_LDB(B1, 0, 1); PG8_SCHED; PG8_LDA(At, 0, 0); PG8_STAGE(PG8_SA(1, 1), a1 + hstep, voffA);
            PG8_WAIT_V(8); PG8_WAIT_L(0); PG8_BAR; PG8_MMA(0, 0, At, B0); PG8_MMA(0, 1, At, B1); PG8_BAR; PG8_SCHED;
            PG8_LDA(At, 0, 1); PG8_STAGE(PG8_SB(0, 0), b2, voffB); PG8_STAGE(PG8_SB(0, 1), b2 + hstep, voffB); PG8_STAGE(PG8_SA(0, 0), a2, voffA);
            PG8_WAIT_V(8); PG8_WAIT_L(0); PG8_BAR; PG8_MMA(1, 0, At, B0); PG8_MMA(1, 1, At, B1); PG8_BAR; PG8_SCHED;
            PG8_LDB(B0, 1, 0); PG8_LDB(B1, 1, 1); PG8_SCHED; PG8_LDA(At, 1, 0); PG8_STAGE(PG8_SA(0, 1), a2 + hstep, voffA);
            PG8_WAIT_V(8); PG8_WAIT_L(0); PG8_BAR; PG8_MMA(0, 0, At, B0); PG8_MMA(0, 1, At, B1); PG8_BAR; PG8_SCHED;
            PG8_LDA(At, 1, 1); PG8_STAGE(PG8_SB(1, 0), b3, voffB); PG8_STAGE(PG8_SB(1, 1), b3 + hstep, voffB); PG8_STAGE(PG8_SA(1, 0), a3, voffA);
            PG8_WAIT_V(8); PG8_WAIT_L(0); PG8_BAR; PG8_MMA(1, 0, At, B0); PG8_MMA(1, 1, At, B1); PG8_BAR; PG8_SCHED;
            } else {
            PG8_LDB(B0, 0, 0); PG8_SCHED; PG8_LDA(At, 0, 0); PG8_STAGE(PG8_SA(1, 1), a1 + hstep, voffA);
            PG8_WAIT_L(8); PG8_BAR; PG8_WAIT_L(0); PG8_MMA(0, 0, At, B0); PG8_BAR; PG8_SCHED;
            PG8_LDB(B1, 0, 1); PG8_STAGE(PG8_SB(0, 0), b2, voffB);
            PG8_BAR; PG8_WAIT_L(0); PG8_MMA(0, 1, At, B1); PG8_BAR;
            PG8_LDA(At, 0, 1); PG8_STAGE(PG8_SA(0, 0), a2, voffA);
            PG8_BAR; PG8_WAIT_L(0); PG8_MMA(1, 0, At, B0); PG8_BAR; PG8_SCHED;
            PG8_STAGE(PG8_SB(0, 1), b2 + hstep, voffB);
            PG8_WAIT_V(6); PG8_BAR; PG8_MMA(1, 1, At, B1); PG8_BAR;
            PG8_LDB(B0, 1, 0); PG8_SCHED; PG8_LDA(At, 1, 0); PG8_STAGE(PG8_SA(0, 1), a2 + hstep, voffA);
            PG8_WAIT_L(8); PG8_BAR; PG8_WAIT_L(0); PG8_MMA(0, 0, At, B0); PG8_BAR; PG8_SCHED;
            PG8_LDB(B1, 1, 1); PG8_STAGE(PG8_SB(1, 0), b3, voffB);
            PG8_BAR; PG8_WAIT_L(0); PG8_MMA(0, 1, At, B1); PG8_BAR;
            PG8_LDA(At, 1, 1); PG8_STAGE(PG8_SA(1, 0), a3, voffA);
            PG8_BAR; PG8_WAIT_L(0); PG8_MMA(1, 0, At, B0); PG8_BAR; PG8_SCHED;
            PG8_STAGE(PG8_SB(1, 1), b3 + hstep, voffB);
            PG8_WAIT_V(6); PG8_BAR; PG8_MMA(1, 1, At, B1); PG8_BAR;
            }
        }
        if constexpr (ALIGN_EPI) { if (wr == 0) PG8_BAR; }
        if constexpr (!Epi::AFTER_DRAIN) { E(acc, cur, wr, wc, fr, fq); S.done(cur); }
        if (!has_next) break;
#pragma unroll
        for (int a = 0; a < 2; ++a)
#pragma unroll
            for (int b = 0; b < 2; ++b)
#pragma unroll
                for (int m = 0; m < 4; ++m)
#pragma unroll
                    for (int n = 0; n < 2; ++n) acc[a][b][m][n] = (f32x4){0.f, 0.f, 0.f, 0.f};
        cur = nxt; cA = nA; cB = nB; ++ui;
        if constexpr (ALIGN_EPI) { if (wr == 1) PG8_BAR; }
    }
    PG8_WAIT_V(0);
    if constexpr (!ALIGN_EPI) { if (wr == 0) PG8_BAR; }
    PG8_BAR;
    if constexpr (Epi::AFTER_DRAIN) { E.fused(acc, cur, wr, wc, fr, fq, lds, wid, lane); S.done(cur); }
#undef PG8_SA
#undef PG8_SB
#undef PG8_STAGE
#undef PG8_LDA
#undef PG8_LDB
#undef PG8_MMA
#undef PG8_WAIT_V
#undef PG8_WAIT_L
#undef PG8_BAR
#undef PG8_SCHED
}
}

struct EpiIn {
  static constexpr bool PERM = false, AFTER_DRAIN = false;
  const Params* pp; int l;
  __device__ __forceinline__ void operator()(f32x4 (&acc)[2][2][4][2], const pg8::Unit& u, int wr, int wc, int fr, int fq) const {
    const Params& p = *pp;
    const int U = u.pn * 4 + wc;
    if (U >= 77) return;
    const int rowb = u.pm * 256 + wr * 64 + fr;
    const int bq = (u.pm * 256) / T, tb = rowb % T;
    bf16_t* dst = nullptr; int ld = 0, col0 = 0; const float* gain = nullptr; bool rope = false, silu = false;
    float post = 1.0f;
    bf16_t* vt = nullptr;
    if (U < 8) { dst = WSP(bf16_t, OFF_QN); ld = 512; col0 = U * 64; gain = p.nsa_q_norm + l * 64; rope = true; post = 0.125f * LOG2E; }
    else if (U < 10) { dst = WSP(bf16_t, OFF_KC); ld = 128; col0 = (U - 8) * 64; rope = true; }
    else if (U < 12) { dst = WSP(bf16_t, OFF_VC); ld = 128; col0 = (U - 10) * 64; }
    else if (U < 14) { dst = WSP(bf16_t, OFF_KS); ld = 128; col0 = (U - 12) * 64; gain = p.nsa_k_norm + (l * 3 + 1) * 64; rope = true; }
    else if (U < 16) { vt = WSP(bf16_t, OFF_VST) + (size_t)((bq * 2 + (U - 14)) * 64) * T; }
    else if (U < 18) { dst = WSP(bf16_t, OFF_KW); ld = 128; col0 = (U - 16) * 64; gain = p.nsa_k_norm + (l * 3 + 2) * 64; rope = true; }
    else if (U < 20) { vt = WSP(bf16_t, OFF_VWT) + (size_t)((bq * 2 + (U - 18)) * 64) * T; }
    else if (U < 28) { dst = WSP(bf16_t, OFF_OA); ld = 512; col0 = (U - 20) * 64; silu = true; }
    else if (U < 36) { dst = WSP(bf16_t, OFF_FQ); ld = 512; col0 = (U - 28) * 64; gain = p.fox_q_norm + l * 64; post = 0.125f * LOG2E; }
    else if (U < 44) { dst = WSP(bf16_t, OFF_FK); ld = 512; col0 = (U - 36) * 64; gain = p.fox_k_norm + l * 64; }
    else if (U < 52) { vt = WSP(bf16_t, OFF_FVT) + (size_t)((bq * 8 + (U - 44)) * 64) * T; }
    else if (U < 60) { dst = WSP(bf16_t, OFF_OB); ld = 512; col0 = (U - 52) * 64; silu = true; }
    else if (U < 68) { dst = WSP(bf16_t, OFF_MQ); ld = 512; col0 = (U - 60) * 64; }
    else if (U < 76) { dst = WSP(bf16_t, OFF_OM); ld = 512; col0 = (U - 68) * 64; silu = true; }
    if (U == 76) {
      float* gate = WSP(float, OFF_GATE);
      float* flog = WSP(float, OFF_FLOG);
#pragma unroll
      for (int ai = 0; ai < 2; ++ai)
#pragma unroll
        for (int m = 0; m < 4; ++m) {
          const size_t row = (size_t)rowb + 128 * ai + 16 * m;
#pragma unroll
          for (int n = 0; n < 2; ++n)
#pragma unroll
            for (int i = 0; i < 4; ++i) {
              const int e = 16 * n + 4 * fq + i;
              const float v = acc[ai][0][m][n][i];
              if (e < 24) gate[row * 24 + e] = sigmoidf_(v);
              else {
                const float xx = v + p.fox_f_bias[l * 8 + (e - 24)];
                flog[row * 8 + (e - 24)] = xx >= 0.f ? -log1pf(expf(-xx)) : xx - log1pf(expf(xx));
              }
            }
        }
      return;
    }
    if (vt) {
#pragma unroll
      for (int ai = 0; ai < 2; ++ai)
#pragma unroll
        for (int m = 0; m < 4; ++m) {
          const int t = tb + 128 * ai + 16 * m;
#pragma unroll
          for (int bj = 0; bj < 2; ++bj)
#pragma unroll
            for (int n = 0; n < 2; ++n) {
              const f32x4 v = acc[ai][bj][m][n];
              const unsigned w0 = cvtpk(v[0], v[1]), w1 = cvtpk(v[2], v[3]);
              const unsigned qo = (unsigned)((32 * bj + 16 * n + 4 * fq) * T + t);
              vt[qo] = (bf16_t)(w0 & 0xffffu); vt[qo + T] = (bf16_t)(w0 >> 16); vt[qo + 2 * T] = (bf16_t)(w1 & 0xffffu); vt[qo + 3 * T] = (bf16_t)(w1 >> 16);
            }
        }
      return;
    }
    const float* ropetab = WSP(float, OFF_ROPE);
    f32x4 gv[2][2];
    if (gain) {
#pragma unroll
      for (int bj = 0; bj < 2; ++bj)
#pragma unroll
        for (int n = 0; n < 2; ++n) gv[bj][n] = *(const f32x4*)(gain + 32 * bj + 16 * n + 4 * fq);
    }
#pragma unroll
    for (int ai = 0; ai < 2; ++ai)
#pragma unroll
      for (int m = 0; m < 4; ++m) {
        f32x4 v[2][2];
#pragma unroll
        for (int bj = 0; bj < 2; ++bj)
#pragma unroll
          for (int n = 0; n < 2; ++n) v[bj][n] = acc[ai][bj][m][n];
        const int row = rowb + 128 * ai + 16 * m;
        if (gain) {
          float ss = 0.f;
#pragma unroll
          for (int bj = 0; bj < 2; ++bj)
#pragma unroll
            for (int n = 0; n < 2; ++n)
#pragma unroll
              for (int i = 0; i < 4; ++i) ss += v[bj][n][i] * v[bj][n][i];
          ss += __shfl_xor(ss, 16);
          ss += __shfl_xor(ss, 32);
          const float rstd = rsqrtf(ss * (1.0f / 64.0f) + EPS);
#pragma unroll
          for (int bj = 0; bj < 2; ++bj)
#pragma unroll
            for (int n = 0; n < 2; ++n) v[bj][n] = v[bj][n] * rstd * gv[bj][n];
        }
        if (rope) {
          const int pos = row & (T - 1);
#pragma unroll
          for (int n = 0; n < 2; ++n) {
            const f32x4* tp = (const f32x4*)(ropetab + ((size_t)pos * 32 + 16 * n + 4 * fq) * 2);
            const f32x4 t0 = tp[0], t1 = tp[1];
            const float cs[4] = {t0[0], t0[2], t1[0], t1[2]}, sn[4] = {t0[1], t0[3], t1[1], t1[3]};
#pragma unroll
            for (int i = 0; i < 4; ++i) {
              const float y1 = v[0][n][i], y2 = v[1][n][i];
              v[0][n][i] = y1 * cs[i] - y2 * sn[i];
              v[1][n][i] = y2 * cs[i] + y1 * sn[i];
            }
          }
        }
#pragma unroll
        for (int bj = 0; bj < 2; ++bj)
#pragma unroll
          for (int n = 0; n < 2; ++n) {
            f32x4 y = v[bj][n] * post;
            if (silu) {
#pragma unroll
              for (int i = 0; i < 4; ++i) y[i] = siluf_(y[i]);
            }
            u32x2 w = {cvtpk(y[0], y[1]), cvtpk(y[2], y[3])};
            *(u32x2*)(dst + (size_t)row * ld + col0 + 32 * bj + 16 * n + 4 * fq) = w;
          }
      }
  }
};
struct EpiMemKV {
  static constexpr bool PERM = false, AFTER_DRAIN = false;
  const Params* pp;
  __device__ __forceinline__ void operator()(f32x4 (&acc)[2][2][4][2], const pg8::Unit& u, int wr, int wc, int fr, int fq) const {
    const Params& p = *pp;
    const int U = u.pn * 4 + wc;
    const int rowb = u.pm * 256 + wr * 64 + fr;
#pragma unroll
    for (int ai = 0; ai < 2; ++ai)
#pragma unroll
      for (int m = 0; m < 4; ++m) {
        const int row = rowb + 128 * ai + 16 * m;
#pragma unroll
        for (int bj = 0; bj < 2; ++bj)
#pragma unroll
          for (int n = 0; n < 2; ++n) {
            const f32x4 v = acc[ai][bj][m][n];
            const unsigned w0 = cvtpk(v[0], v[1]), w1 = cvtpk(v[2], v[3]);
            const int e = 32 * bj + 16 * n + 4 * fq;
            if (U < 8) {
              u32x2 w = {w0, w1};
              *(u32x2*)(WSP(bf16_t, OFF_MK) + (size_t)row * 512 + U * 64 + e) = w;
            } else {
              const int col = (U - 8) * 64 + e, h = col >> 7, d = col & 127, b = row >> 8, mm = row & 255;
              bf16_t* q = WSP(bf16_t, OFF_MVT) + (size_t)((b * 4 + h) * 128 + d) * 256 + mm;
              q[0] = (bf16_t)(w0 & 0xffffu); q[256] = (bf16_t)(w0 >> 16); q[512] = (bf16_t)(w1 & 0xffffu); q[768] = (bf16_t)(w1 >> 16);
            }
          }
      }
  }
};
struct EpiGate {
  static constexpr bool PERM = false, AFTER_DRAIN = false;
  bf16_t* G;
  __device__ __forceinline__ void operator()(f32x4 (&acc)[2][2][4][2], const pg8::Unit& u, int wr, int wc, int fr, int fq) const {
    const int br = u.pn >> 2, colt = (u.pn & 3) * 256 + wc * 32 + 4 * fq;
    bf16_t* base = G + (size_t)br * M * 1024;
    const int rowb = u.pm * 256 + wr * 64 + fr;
#pragma unroll
    for (int ai = 0; ai < 2; ++ai)
#pragma unroll
      for (int m = 0; m < 4; ++m) {
        bf16_t* rp = base + (size_t)(rowb + 128 * ai + 16 * m) * 1024 + colt;
#pragma unroll
        for (int bj = 0; bj < 2; ++bj)
#pragma unroll
          for (int n = 0; n < 2; ++n) {
            const f32x4 v = acc[ai][bj][m][n];
            u32x2 w = {cvtpk(sigmoidf_(v[0]), sigmoidf_(v[1])), cvtpk(sigmoidf_(v[2]), sigmoidf_(v[3]))};
            *(u32x2*)(rp + 128 * bj + 16 * n) = w;
          }
      }
  }
};
struct EpiBranch {
  static constexpr bool PERM = false, AFTER_DRAIN = false;
  const bf16_t* G; bf16_t* Uo; int first;
  __device__ __forceinline__ void operator()(f32x4 (&acc)[2][2][4][2], const pg8::Unit& u, int wr, int wc, int fr, int fq) const {
    const int colt = u.pn * 256 + wc * 32 + 4 * fq;
    const int rowb = u.pm * 256 + wr * 64 + fr;
#pragma unroll
    for (int ai = 0; ai < 2; ++ai)
#pragma unroll
      for (int m = 0; m < 4; ++m) {
        const size_t ro = (size_t)(rowb + 128 * ai + 16 * m) * 1024 + colt;
#pragma unroll
        for (int bj = 0; bj < 2; ++bj)
#pragma unroll
          for (int n = 0; n < 2; ++n) {
            const f32x4 v = acc[ai][bj][m][n];
            const size_t off = ro + 128 * bj + 16 * n;
            const u32x2 gw = *(const u32x2*)(G + off);
            float y0 = v[0] * bflo(gw[0]), y1 = v[1] * bfhi(gw[0]), y2 = v[2] * bflo(gw[1]), y3 = v[3] * bfhi(gw[1]);
            if (!first) {
              const u32x2 uw = *(const u32x2*)(Uo + off);
              y0 += bflo(uw[0]); y1 += bfhi(uw[0]); y2 += bflo(uw[1]); y3 += bfhi(uw[1]);
            }
            u32x2 w = {cvtpk(y0, y1), cvtpk(y2, y3)};
            *(u32x2*)(Uo + off) = w;
          }
      }
  }
};
struct EpiOut {
  static constexpr bool PERM = false, AFTER_DRAIN = false;
  const float* xin; float* xout;
  __device__ __forceinline__ void operator()(f32x4 (&acc)[2][2][4][2], const pg8::Unit& u, int wr, int wc, int fr, int fq) const {
    const int colt = u.pn * 256 + wc * 32 + 4 * fq;
    const int rowb = u.pm * 256 + wr * 64 + fr;
#pragma unroll
    for (int ai = 0; ai < 2; ++ai)
#pragma unroll
      for (int m = 0; m < 4; ++m) {
        const size_t ro = (size_t)(rowb + 128 * ai + 16 * m) * 1024 + colt;
#pragma unroll
        for (int bj = 0; bj < 2; ++bj)
#pragma unroll
          for (int n = 0; n < 2; ++n) {
            const size_t off = ro + 128 * bj + 16 * n;
            const f32x4 xv = *(const f32x4*)(xin + off);
            *(f32x4*)(xout + off) = xv + acc[ai][bj][m][n];
          }
      }
  }
};
template <class Epi>
__device__ __forceinline__ void run_gemm(PG8_LAS unsigned char* lds, const bf16_t* A, const bf16_t* Bt, int Mr, int Nc, int K, const Epi& E) {
  pg8::Gemm g{A, Bt, Mr, Nc, K};
  pg8::StaticOrder S;
  S.init(Mr, Nc, gdim(), bidx());
  pg8::gemm_phase<Epi, pg8::StaticOrder, true, true>(lds, g, S, E);
}

__device__ __forceinline__ int map_in(int n) {
  const int i = n >> 6, c = n & 63;
  if (i < 20) return n;
  if (i < 28) return 1304 + (n - 1280);
  if (i < 52) return 1816 + (n - 1792);
  if (i < 60) return 3360 + (n - 3328);
  if (i < 68) return 3872 + (n - 3840);
  if (i < 76) return 4384 + (n - 4352);
  if (i == 76) return c < 24 ? 1280 + c : (c < 32 ? 3352 + (c - 24) : -1);
  return -1;
}
__device__ void transpose_tile(const float* __restrict__ src, int ld_src, int k0, int n0, bf16_t* __restrict__ dst,
                               int Kdim, int maptype, int srccol0, float* tile) {
  const int tid = tidx();
  for (int e = tid; e < 4096; e += NTHREADS) {
    const int kk = e >> 6, nn = e & 63;
    int nlog = n0 + nn;
    if (maptype) { const int w = nlog & 255; nlog = (nlog & ~255) + (((w & 127) >> 5) << 6) + (((w >> 7) << 5) | (w & 31)); }
    const int sc = (maptype == 1) ? map_in(nlog) : srccol0 + nlog;
    tile[kk * 65 + nn] = sc >= 0 ? src[(size_t)(k0 + kk) * ld_src + sc] : 0.f;
  }
  __syncthreads();
  for (int e = tid; e < 2048; e += NTHREADS) {
    const int nn = e >> 5, kp = e & 31;
    const float a = tile[(2 * kp) * 65 + nn], b = tile[(2 * kp + 1) * 65 + nn];
    *(unsigned*)(dst + (size_t)(n0 + nn) * Kdim + k0 + 2 * kp) = cvtpk(a, b);
  }
  __syncthreads();
}
__device__ void rmsnorm_rows(const float* __restrict__ x, const float* __restrict__ gain, bf16_t* __restrict__ dst,
                             int row_begin, int nrows) {
  const int wave = tidx() >> 6, lane = tidx() & 63;
  for (int rr = wave; rr < nrows; rr += NWAVES) {
    const size_t row = (size_t)row_begin + rr;
    const float* xp = x + row * 1024;
    f32x4 v[4];
    float ss = 0.f;
#pragma unroll
    for (int i = 0; i < 4; ++i) {
      v[i] = *(const f32x4*)(xp + lane * 4 + 256 * i);
      ss += v[i][0] * v[i][0] + v[i][1] * v[i][1] + v[i][2] * v[i][2] + v[i][3] * v[i][3];
    }
    ss = wave_sum(ss);
    const float rstd = rsqrtf(ss * (1.0f / 1024.0f) + EPS);
#pragma unroll
    for (int i = 0; i < 4; ++i) {
      const f32x4 gv = *(const f32x4*)(gain + lane * 4 + 256 * i);
      const f32x4 y = v[i] * rstd * gv;
      u32x2 w = {cvtpk(y[0], y[1]), cvtpk(y[2], y[3])};
      *(u32x2*)(dst + row * 1024 + lane * 4 + 256 * i) = w;
    }
  }
}
__device__ void phase_prep(const Params& p, int l, float* smem) {
  const int tid = tidx();
  constexpr int NT_TR = 3076, NT_H = 512, NT_MEMN = 16, NT_C1 = 2, NT_ROPE = 512;
  const int total = NT_TR + NT_H + NT_MEMN + NT_C1 + (l == 0 ? NT_ROPE : 0);
  if (l == 0 && bidx() == 0 && tid < 64) WSP(unsigned, OFF_CTL)[tid] = 0u;
  const float* xin = (l == 0) ? p.x : p.out;
  const int pmult = PROBE_PM2 ? (p.ws != nullptr ? 2 : 1) : 1;
  for (int u0 = bidx(); u0 < total * pmult; u0 += gdim()) {
    int u = u0 % total;
    if (u < NT_TR) {
      const float* src; int ld, kt, nt, Kd, mt = 0, c0 = 0; bf16_t* dst;
      if (u < 1280) { kt = u / 80; nt = u % 80; src = p.w_in + (size_t)l * 1024 * 7968; ld = 7968; Kd = 1024; dst = WSP(bf16_t, OFF_W_IN); mt = 1; }
      else if ((u -= 1280) < 768) { kt = u / 48; nt = u % 48; src = p.w_in + (size_t)l * 1024 * 7968; ld = 7968; Kd = 1024; dst = WSP(bf16_t, OFF_W_G); c0 = 4896; }
      else if ((u -= 768) < 256) { kt = u / 16; nt = u % 16; src = p.w_mem_kv + (size_t)l * 1024 * 1024; ld = 1024; Kd = 1024; dst = WSP(bf16_t, OFF_W_MKV); mt = 2; }
      else if ((u -= 256) < 384) { const int br = u / 128, uu = u % 128; kt = uu / 16; nt = uu % 16;
        src = (br == 0 ? p.w_branch_a : br == 1 ? p.w_branch_b : p.w_branch_m) + (size_t)l * 512 * 1024; ld = 1024; Kd = 512; dst = WSP(bf16_t, OFF_W_BR + (size_t)br * MiB); }
      else if ((u -= 384) < 256) { kt = u / 16; nt = u % 16; src = p.w_out + (size_t)l * 1024 * 1024; ld = 1024; Kd = 1024; dst = WSP(bf16_t, OFF_W_OUT); }
      else if ((u -= 256) < 128) { const int kv = u / 64, uu = u % 64; kt = uu / 2; nt = uu % 2;
        src = (kv ? p.cmp_w1_v : p.cmp_w1_k) + (size_t)l * 2048 * 128; ld = 128; Kd = 2048; dst = WSP(bf16_t, OFF_W1 + (size_t)kv * 512 * 1024); }
      else { u -= 128; const int kv = u / 2; kt = u % 2; nt = 0;
        src = (kv ? p.cmp_w2_v : p.cmp_w2_k) + (size_t)l * 128 * 64; ld = 64; Kd = 128; dst = WSP(bf16_t, OFF_W2 + (size_t)kv * 64 * 1024); }
      transpose_tile(src, ld, kt * 64, nt * 64, dst, Kd, mt, c0, smem);
    } else if ((u -= NT_TR) < NT_H) {
      rmsnorm_rows(xin, p.norm_g + l * 1024, WSP(bf16_t, OFF_H), u * 64, 64);
    } else if ((u -= NT_H) < NT_MEMN) {
      rmsnorm_rows(p.mem, p.mem_norm_g + l * 1024, WSP(bf16_t, OFF_MEMN), u * 64, 64);
    } else if ((u -= NT_MEMN) < NT_C1) {
      const float* pe = (u ? p.cmp_pe_v : p.cmp_pe_k) + (size_t)l * 2048;
      const float* w1 = (u ? p.cmp_w1_v : p.cmp_w1_k) + (size_t)l * 2048 * 128;
      constexpr int NPART = NTHREADS / 128, KPER = 2048 / NPART;
      const int n = tid & 127, part = tid >> 7;
      float s = 0.f;
      for (int kk = part * KPER; kk < part * KPER + KPER; ++kk) s += pe[kk] * w1[(size_t)kk * 128 + n];
      smem[part * 128 + n] = s;
      __syncthreads();
      if (tid < 128) { float tot = 0.f; for (int q = 0; q < NPART; ++q) tot += smem[q * 128 + tid]; WSP(float, OFF_C1)[u * 128 + tid] = tot; }
      __syncthreads();
    } else {
      u -= NT_C1;
      for (int e = tid; e < 512; e += NTHREADS) {
        const int idx = u * 512 + e, pos = idx >> 5, f = idx & 31;
        const float ang = (float)pos * c_inv_freq[f];
        const double a = (double)ang;
        const double k = rint(a * 0.15915494309189535);
        const float rr = (float)(a - k * 6.283185307179586);
        float2 cs; cs.x = __cosf(rr); cs.y = __sinf(rr);
        WSP(float2, OFF_ROPE)[idx] = cs;
      }
    }
  }
}

__device__ void compress_unit(const Params& p, int l, int u) {
  const int lane = tidx() & 63, r = lane & 15, g4 = lane >> 4;
  const int kv = u >> 7, rem = u & 127, b = rem >> 5, grp = (rem >> 4) & 1, it = rem & 15, i0 = it * 32;
  const bf16_t* src = WSP(bf16_t, kv ? OFF_VC : OFF_KC);
  const bf16_t* w1t = WSP(bf16_t, OFF_W1 + (size_t)kv * 512 * 1024);
  const bf16_t* w2t = WSP(bf16_t, OFF_W2 + (size_t)kv * 64 * 1024);
  const float* c1 = WSP(float, OFF_C1) + kv * 128;
  const bf16_t* arow[2];
#pragma unroll
  for (int mt = 0; mt < 2; ++mt) {
    int i = i0 + 16 * mt + r;
    if (i > 510) i = 510;
    arow[mt] = src + ((size_t)b * T + 16 * i) * 128 + grp * 64 + g4 * 8;
  }
  f32x4 acc[2][8];
#pragma unroll
  for (int a = 0; a < 2; ++a)
#pragma unroll
    for (int c = 0; c < 8; ++c) acc[a][c] = (f32x4){0.f, 0.f, 0.f, 0.f};
  const bf16_t* bp = w1t + (size_t)r * 2048 + g4 * 8;
  for (int k0 = 0; k0 < 2048; k0 += 32) {
    const int pp = k0 >> 6, d = k0 & 63;
    bf16x8 af[2], bf[8];
#pragma unroll
    for (int mt = 0; mt < 2; ++mt) af[mt] = *(const bf16x8*)(arow[mt] + (size_t)pp * 128 + d);
#pragma unroll
    for (int nt = 0; nt < 8; ++nt) bf[nt] = *(const bf16x8*)(bp + (size_t)nt * 16 * 2048 + k0);
#pragma unroll
    for (int mt = 0; mt < 2; ++mt)
#pragma unroll
      for (int nt = 0; nt < 8; ++nt) acc[mt][nt] = mfma16(bf[nt], af[mt], acc[mt][nt]);
  }
#pragma unroll
  for (int nt = 0; nt < 8; ++nt) {
    const f32x4 cv = *(const f32x4*)(c1 + 16 * nt + 4 * g4);
#pragma unroll
    for (int mt = 0; mt < 2; ++mt)
#pragma unroll
      for (int i = 0; i < 4; ++i) acc[mt][nt][i] = siluf_(acc[mt][nt][i] + cv[i]);
  }
  bf16x8 wf[4][4];
#pragma unroll
  for (int ks = 0; ks < 4; ++ks)
#pragma unroll
    for (int et = 0; et < 4; ++et) {
      const bf16_t* wp = w2t + (size_t)(16 * et + r) * 128 + 32 * ks + 4 * g4;
      const u32x2 lo = *(const u32x2*)wp, hi = *(const u32x2*)(wp + 16);
      u32x4 w = {lo[0], lo[1], hi[0], hi[1]};
      wf[ks][et] = __builtin_bit_cast(bf16x8, w);
    }
  if (kv == 0) {
    const float* gain = p.nsa_k_norm + (size_t)(l * 3 + 0) * 64;
    bf16_t* dst = WSP(bf16_t, OFF_KCMP) + (size_t)((b * 2 + grp) * 512) * 64;
    f32x4 gv[4];
#pragma unroll
    for (int et = 0; et < 4; ++et) gv[et] = *(const f32x4*)(gain + 16 * et + 4 * g4);
#pragma unroll
    for (int mt = 0; mt < 2; ++mt) {
      f32x4 o[4];
#pragma unroll
      for (int et = 0; et < 4; ++et) o[et] = (f32x4){0.f, 0.f, 0.f, 0.f};
#pragma unroll
      for (int ks = 0; ks < 4; ++ks) {
        const bf16x8 xf = pack8(acc[mt][2 * ks], acc[mt][2 * ks + 1]);
#pragma unroll
        for (int et = 0; et < 4; ++et) o[et] = mfma16(wf[ks][et], xf, o[et]);
      }
      float ss = 0.f;
#pragma unroll
      for (int et = 0; et < 4; ++et)
#pragma unroll
        for (int i = 0; i < 4; ++i) ss += o[et][i] * o[et][i];
      ss += __shfl_xor(ss, 16);
      ss += __shfl_xor(ss, 32);
      const float rstd = rsqrtf(ss * (1.0f / 64.0f) + EPS);
      const int i = i0 + 16 * mt + r;
#pragma unroll
      for (int et = 0; et < 4; ++et) {
        f32x4 y = o[et] * rstd * gv[et];
        if (i > 510) y = (f32x4){0.f, 0.f, 0.f, 0.f};
        u32x2 w = {cvtpk(y[0], y[1]), cvtpk(y[2], y[3])};
        *(u32x2*)(dst + (size_t)i * 64 + 16 * et + 4 * g4) = w;
      }
    }
  } else {
    bf16_t* dst = WSP(bf16_t, OFF_VCT) + (size_t)((b * 2 + grp) * 64) * 512;
#pragma unroll
    for (int mt = 0; mt < 2; ++mt) {
      f32x4 o[4];
#pragma unroll
      for (int et = 0; et < 4; ++et) o[et] = (f32x4){0.f, 0.f, 0.f, 0.f};
#pragma unroll
      for (int ks = 0; ks < 4; ++ks) {
        const bf16x8 xf = pack8(acc[mt][2 * ks], acc[mt][2 * ks + 1]);
#pragma unroll
        for (int et = 0; et < 4; ++et) o[et] = mfma16(xf, wf[ks][et], o[et]);
      }
#pragma unroll
      for (int et = 0; et < 4; ++et) {
        f32x4 y = o[et];
        const int ib = i0 + 16 * mt + 4 * g4;
#pragma unroll
        for (int i = 0; i < 4; ++i)
          if (ib + i > 510) y[i] = 0.f;
        u32x2 w = {cvtpk(y[0], y[1]), cvtpk(y[2], y[3])};
        *(u32x2*)(dst + (size_t)(16 * et + r) * 512 + ib) = w;
      }
    }
  }
}
__device__ void cumsum_unit(const Params& p, int u) {
  const int lane = tidx() & 63, b = u >> 3, h = u & 7;
  const float* fl = WSP(float, OFF_FLOG) + ((size_t)b * T) * 8 + h;
  float* fc = WSP(float, OFF_FC) + (size_t)(b * 8 + h) * T;
  const int tb = lane * 128;
  double s = 0.0;
  for (int i = 0; i < 128; ++i) s += (double)fl[(size_t)(tb + i) * 8];
  double incl = s;
#pragma unroll
  for (int o = 1; o < 64; o <<= 1) {
    const double y = __shfl_up(incl, o);
    if (lane >= o) incl += y;
  }
  double run = incl - s;
  for (int i = 0; i < 128; ++i) {
    run += (double)fl[(size_t)(tb + i) * 8];
    fc[tb + i] = (float)run;
  }
}
__device__ void memk_norm_unit(const Params& p, int l, int u) {
  const int lane = tidx() & 63;
  bf16_t* mk = WSP(bf16_t, OFF_MK);
  const float* gain = p.mem_k_norm + l * 128 + (lane & 15) * 8;
  for (int rr = 0; rr < 16; ++rr) {
    bf16_t* ptr = mk + (size_t)(u * 16 + rr) * 512 + lane * 8;
    const u32x4 w = *(const u32x4*)ptr;
    float v[8];
#pragma unroll
    for (int j = 0; j < 4; ++j) { v[2 * j] = bflo(w[j]); v[2 * j + 1] = bfhi(w[j]); }
    float ss = 0.f;
#pragma unroll
    for (int j = 0; j < 8; ++j) ss += v[j] * v[j];
#pragma unroll
    for (int o = 1; o < 16; o <<= 1) ss += __shfl_xor(ss, o);
    const float rstd = rsqrtf(ss * (1.0f / 128.0f) + EPS);
    u32x4 ow;
#pragma unroll
    for (int j = 0; j < 4; ++j) ow[j] = cvtpk(v[2 * j] * rstd * gain[2 * j], v[2 * j + 1] * rstd * gain[2 * j + 1]);
    *(u32x4*)ptr = ow;
  }
}
__device__ void phase_mid(const Params& p, int l) {
  const int wave = tidx() >> 6;
  const int gw = wave * gdim() + bidx(), nw = NWAVES * gdim();
  const int mult = PROBE_PM2 ? (p.ws != nullptr ? 2 : 1) : 1;
  for (int uu = gw; uu < (256 + 32 + 64) * mult; uu += nw) {
    const int u = uu % (256 + 32 + 64);
    if (u < 256) compress_unit(p, l, u);
    else if (u < 288) cumsum_unit(p, u - 256);
    else if (uu < 256 + 32 + 64) memk_norm_unit(p, l, u - 288);
  }
}

template <int NCT, int NDK, bool QL = false>
__device__ __forceinline__ void qk_scores(const bf16_t* __restrict__ kbase, int ldk, int key0,
                                          const bf16x8 (&qf)[NCT][NDK], f32x4 (&s)[2][NCT], int lane, const bf16x8* qlds = nullptr) {
  const int r = lane & 15, grp = lane >> 4;
#pragma unroll
  for (int kt = 0; kt < 2; ++kt) {
    const bf16_t* kp = kbase + (size_t)(key0 + 8 * (r >> 2) + 4 * kt + (r & 3)) * ldk + grp * 8;
    bf16x8 kf[NDK];
#pragma unroll
    for (int dk = 0; dk < NDK; ++dk) kf[dk] = *(const bf16x8*)(kp + dk * 32);
#pragma unroll
    for (int ct = 0; ct < NCT; ++ct) {
      f32x4 a = {0.f, 0.f, 0.f, 0.f};
#pragma unroll
      for (int dk = 0; dk < NDK; ++dk) a = mfma16(kf[dk], QL ? qlds[(ct * NDK + dk) * 64 + lane] : qf[ct][dk], a);
      s[kt][ct] = a;
    }
  }
}
template <int NCT, int NDT>
__device__ __forceinline__ void pv_accum(const bf16_t* __restrict__ vt, size_t ldv, int key0,
                                         const f32x4 (&s)[2][NCT], f32x4 (&o)[NDT][NCT], int lane) {
  const int r = lane & 15, grp = lane >> 4;
  bf16x8 pb[NCT];
#pragma unroll
  for (int ct = 0; ct < NCT; ++ct) pb[ct] = pack8(s[0][ct], s[1][ct]);
#pragma unroll
  for (int dt = 0; dt < NDT; ++dt) {
    const bf16x8 vf = *(const bf16x8*)(vt + (size_t)(16 * dt + r) * ldv + key0 + 8 * grp);
#pragma unroll
    for (int ct = 0; ct < NCT; ++ct) o[dt][ct] = mfma16(vf, pb[ct], o[dt][ct]);
  }
}
template <int NCT, int NDT, bool HAS_O, bool SUMS = true>
__device__ __forceinline__ void softmax_update(f32x4 (&s)[2][NCT], float (&m)[NCT], float (&lsum)[NCT],
                                               f32x4 (&o)[NDT][NCT], f32x4 (*lacc)[NCT] = nullptr) {
  float mnew[NCT];
  bool ch = false;
#pragma unroll
  for (int ct = 0; ct < NCT; ++ct) {
    float mx = fmaxf(fmaxf(fmaxf(s[0][ct][0], s[0][ct][1]), fmaxf(s[0][ct][2], s[0][ct][3])),
                     fmaxf(fmaxf(s[1][ct][0], s[1][ct][1]), fmaxf(s[1][ct][2], s[1][ct][3])));
    mx = grp_max4(mx);
    mnew[ct] = fmaxf(m[ct], mx);
    ch = ch || (mnew[ct] > m[ct]);
  }
  if (__any(ch)) {
#pragma unroll
    for (int ct = 0; ct < NCT; ++ct) {
      const float msafe = (mnew[ct] == NEG_INF) ? 0.f : mnew[ct];
      const float alpha = __builtin_amdgcn_exp2f(m[ct] - msafe);
      m[ct] = mnew[ct];
      if (SUMS) lsum[ct] *= alpha; else (*lacc)[ct] = (*lacc)[ct] * alpha;
      if (HAS_O) {
#pragma unroll
        for (int dt = 0; dt < NDT; ++dt) o[dt][ct] = o[dt][ct] * alpha;
      }
    }
  }
#pragma unroll
  for (int ct = 0; ct < NCT; ++ct) {
    const float msafe = (m[ct] == NEG_INF) ? 0.f : m[ct];
#pragma unroll
    for (int kt = 0; kt < 2; ++kt) {
      const f32x4 d = s[kt][ct] - msafe;
      f32x4 pv;
#pragma unroll
      for (int i = 0; i < 4; ++i) pv[i] = __builtin_amdgcn_exp2f(d[i]);
      s[kt][ct] = pv;
    }
    if (SUMS) {
      const f32x4 t4 = s[0][ct] + s[1][ct];
      lsum[ct] += (t4[0] + t4[1]) + (t4[2] + t4[3]);
    }
  }
}
__device__ __forceinline__ float finish_l(float lsum) {
  lsum += __shfl_xor(lsum, 16);
  lsum += __shfl_xor(lsum, 32);
  return lsum > 0.f ? 1.0f / lsum : 0.f;
}

typedef __attribute__((address_space(3))) unsigned char lds_u8;
constexpr int TILE_ROWB = 144, TILE_HALF = 64 * TILE_ROWB, TILE_STAGE = 2 * TILE_HALF + 256;
struct TileRegs { u32x4 k, v; };
__device__ __forceinline__ void tile_gload(TileRegs& tr, const bf16_t* __restrict__ kbase, int ldk, const bf16_t* __restrict__ vtbase,
                                           size_t ldv, int key0, int tid) {
  const int row = tid >> 3, ch = tid & 7;
  tr.k = *(const u32x4*)(kbase + (size_t)(key0 + row) * ldk + ch * 8);
  tr.v = *(const u32x4*)(vtbase + (size_t)row * ldv + key0 + ch * 8);
}
__device__ __forceinline__ void tile_swrite(const TileRegs& tr, lds_u8* stage, int tid) {
  const int row = tid >> 3, ch = tid & 7;
  *(__attribute__((address_space(3))) u32x4*)(stage + row * TILE_ROWB + ch * 16) = tr.k;
  *(__attribute__((address_space(3))) u32x4*)(stage + TILE_HALF + row * TILE_ROWB + ch * 16) = tr.v;
}
template <int NCT, int NDK, bool QL>
__device__ __forceinline__ void qk_scores_lds(const lds_u8* stage, int hf, const bf16x8 (&qf)[NCT][NDK], f32x4 (&s)[2][NCT], int lane,
                                              const bf16x8* qlds, const f32x4 c0, const f32x4 c1) {
  const int r = lane & 15, grp = lane >> 4;
#pragma unroll
  for (int kt = 0; kt < 2; ++kt) {
    const lds_u8* kp = stage + (32 * hf + 8 * (r >> 2) + 4 * kt + (r & 3)) * TILE_ROWB + grp * 16;
    bf16x8 kf[NDK];
#pragma unroll
    for (int dk = 0; dk < NDK; ++dk) kf[dk] = *(const __attribute__((address_space(3))) bf16x8*)(kp + dk * 64);
#pragma unroll
    for (int ct = 0; ct < NCT; ++ct) {
      f32x4 a = kt ? c1 : c0;
#pragma unroll
      for (int dk = 0; dk < NDK; ++dk) a = mfma16(kf[dk], QL ? qlds[(ct * NDK + dk) * 64 + lane] : qf[ct][dk], a);
      s[kt][ct] = a;
    }
  }
}
template <int NDT>
__device__ __forceinline__ void v_frags_lds(const lds_u8* stage, int hf, bf16x8 (&vf)[NDT], int lane) {
  const int r = lane & 15, grp = lane >> 4;
#pragma unroll
  for (int dt = 0; dt < NDT; ++dt)
    vf[dt] = *(const __attribute__((address_space(3))) bf16x8*)(stage + TILE_HALF + (16 * dt + r) * TILE_ROWB + (32 * hf + 8 * grp) * 2);
}
template <int NCT, int NDT>
__device__ __forceinline__ void pv_accum_lds(const bf16x8 (&vfp)[NDT], const f32x4 (&s)[2][NCT], f32x4 (&o)[NDT][NCT], int lane, f32x4 (&lacc)[NCT]) {
  const int r = lane & 15, grp = lane >> 4; (void)r; (void)grp;
  bf16x8 pb[NCT];
#pragma unroll
  for (int ct = 0; ct < NCT; ++ct) pb[ct] = pack8(s[0][ct], s[1][ct]);
  {
    const short one = (short)0x3F80;
    const bf16x8 ones = {one, one, one, one, one, one, one, one};
#pragma unroll
    for (int ct = 0; ct < NCT; ++ct) lacc[ct] = mfma16(ones, pb[ct], lacc[ct]);
  }
#pragma unroll
  for (int dt = 0; dt < NDT; ++dt) {
    const bf16x8 vf = vfp[dt];
#pragma unroll
    for (int ct = 0; ct < NCT; ++ct) o[dt][ct] = mfma16(vf, pb[ct], o[dt][ct]);
  }
}
__device__ __forceinline__ int next_bit(unsigned long long lo, unsigned long long hi, int from) {
  if (from < 64) { const unsigned long long mm = lo & (~0ull << from); if (mm) return __ffsll(mm) - 1; from = 64; }
  if (from < 128) { const unsigned long long mm = hi & (~0ull << (from - 64)); if (mm) return 64 + __ffsll(mm) - 1; }
  return 128;
}

__device__ void nsa_wg_unit(const Params& p, int b, int g, int qi, float* imp, bf16x8* qlds, float* scr, lds_u8* tiles, unsigned* misc, bool st) {
  const int tid0 = tidx();
  const int wave = __builtin_amdgcn_readfirstlane(tid0 >> 6);
  const int lane0 = tid0 & 63;
  const int tq = qi * 8 + wave;
  const int t0 = tq * 16;
  const bf16x8 (&qf)[4][2] = *(const bf16x8 (*)[4][2])nullptr;
#define NSA_SECTION_VARS \
  int lane = lane0; asm volatile("" : "+v"(lane)); \
  const int r = lane & 15, grp = lane >> 4, t = t0 + r; \
  const size_t row = (size_t)b * T + t; \
  const float* gatep = WSP(float, OFF_GATE) + row * 24 + g * 12; (void)gatep; (void)grp; (void)t;
  {
    NSA_SECTION_VARS
#pragma unroll
    for (int ct = 0; ct < 4; ++ct)
#pragma unroll
      for (int dk = 0; dk < 2; ++dk)
        qlds[(ct * 2 + dk) * 64 + lane] = *(const bf16x8*)(WSP(bf16_t, OFF_QN) + row * 512 + (g * 4 + ct) * 64 + dk * 32 + grp * 8);
  }
  f32x4 o[4][4];
  float m[4], lsum[4];
  f32x4 lacc[4];
  {
    NSA_SECTION_VARS
    const bf16_t* kc = WSP(bf16_t, OFF_KCMP) + (size_t)((b * 2 + g) * 512) * 64;
    const bf16_t* vct = WSP(bf16_t, OFF_VCT) + (size_t)((b * 2 + g) * 64) * 512;
    const int nblk = (tq + 31) >> 5;
#pragma unroll
    for (int ct = 0; ct < 4; ++ct) { m[ct] = NEG_INF; lsum[ct] = 0.f; }
#pragma unroll 1
    for (int blk = 0; blk < nblk; ++blk) {
      f32x4 s[2][4];
      qk_scores<4, 2, true>(kc, 64, blk * 32, qf, s, lane, qlds);
#pragma unroll
      for (int kt = 0; kt < 2; ++kt)
#pragma unroll
        for (int i = 0; i < 4; ++i) {
          const int n = blk * 32 + 8 * grp + 4 * kt + i;
          const bool ok = (16 * n + 31 <= t);
#pragma unroll
          for (int ct = 0; ct < 4; ++ct) s[kt][ct][i] = ok ? s[kt][ct][i] : NEG_INF;
        }
      softmax_update<4, 4, false>(s, m, lsum, o);
    }
    float invl[4], msafe[4];
#pragma unroll
    for (int ct = 0; ct < 4; ++ct) { invl[ct] = finish_l(lsum[ct]); msafe[ct] = (m[ct] == NEG_INF) ? 0.f : m[ct]; }
    for (int e = lane; e < 16 * 132; e += 64) imp[e] = 0.f;
    __builtin_amdgcn_fence(__ATOMIC_SEQ_CST, "workgroup");
    __builtin_amdgcn_wave_barrier();
#pragma unroll
    for (int dt = 0; dt < 4; ++dt)
#pragma unroll
      for (int ct = 0; ct < 4; ++ct) o[dt][ct] = (f32x4){0.f, 0.f, 0.f, 0.f};
#pragma unroll 1
    for (int blk = 0; blk < nblk; ++blk) {
      f32x4 s[2][4];
      qk_scores<4, 2, true>(kc, 64, blk * 32, qf, s, lane, qlds);
      float pq[2][4];
#pragma unroll
      for (int kt = 0; kt < 2; ++kt)
#pragma unroll
        for (int i = 0; i < 4; ++i) {
          const int n = blk * 32 + 8 * grp + 4 * kt + i;
          const bool ok = (16 * n + 31 <= t);
          float acc_p = 0.f;
#pragma unroll
          for (int ct = 0; ct < 4; ++ct) {
            const float pv = ok ? __builtin_amdgcn_exp2f(s[kt][ct][i] - msafe[ct]) * invl[ct] : 0.f;
            s[kt][ct][i] = pv;
            acc_p += pv;
          }
          pq[kt][i] = acc_p;
        }
      float* ir = imp + r * 132 + blk * 8 + 2 * grp;
      ir[0] += pq[0][0] + pq[0][1] + pq[0][2] + 0.5f * pq[0][3];
      __builtin_amdgcn_fence(__ATOMIC_SEQ_CST, "workgroup");
      __builtin_amdgcn_wave_barrier();
      ir[1] += pq[1][0] + pq[1][1] + pq[1][2] + 0.5f * pq[1][3] + 0.5f * pq[0][3];
      __builtin_amdgcn_fence(__ATOMIC_SEQ_CST, "workgroup");
      __builtin_amdgcn_wave_barrier();
      ir[2] += 0.5f * pq[1][3];
      __builtin_amdgcn_fence(__ATOMIC_SEQ_CST, "workgroup");
      __builtin_amdgcn_wave_barrier();
      pv_accum<4, 4>(vct, 512, blk * 32, s, o, lane);
    }
    f32x4 gt[4];
#pragma unroll
    for (int ct = 0; ct < 4; ++ct) gt[ct][0] = gatep[ct * 3 + 0];
#pragma unroll
    for (int dt = 0; dt < 4; ++dt) {
#pragma unroll
      for (int ct = 0; ct < 4; ++ct)
#pragma unroll
        for (int i = 0; i < 4; ++i) scr[((dt * 4 + ct) * 4 + i) * 64 + lane] = o[dt][ct][i] * gt[ct][0];
      asm volatile("" ::: "memory");
    }
  }
  const int cur = t0 >> 6;
  unsigned long long sel_lo = 0ull, sel_hi = 0ull;
  {
  NSA_SECTION_VARS
  if (cur <= 15) {
    sel_lo = (1ull << (cur + 1)) - 1ull;
  } else {
    __builtin_amdgcn_fence(__ATOMIC_SEQ_CST, "workgroup");
    __builtin_amdgcn_wave_barrier();
    float v[32];
#pragma unroll
    for (int k = 0; k < 32; ++k) {
      const int j = grp + 4 * k;
      const float x = imp[r * 132 + j];
      v[k] = (j >= 1 && j <= cur - 2) ? x : NEG_INF;
    }
#pragma unroll 1
    for (int round = 0; round < 13; ++round) {
      float best = NEG_INF;
      int bj = 1 << 20;
#pragma unroll
      for (int k = 0; k < 32; ++k) {
        const bool tk = v[k] > best;
        best = tk ? v[k] : best;
        bj = tk ? (grp + 4 * k) : bj;
      }
#pragma unroll
      for (int off = 16; off <= 32; off <<= 1) {
        const float ob = __shfl_xor(best, off);
        const int oj = __shfl_xor(bj, off);
        const bool tk = (ob > best) || (ob == best && oj < bj);
        best = tk ? ob : best;
        bj = tk ? oj : bj;
      }
      if (bj < 64) sel_lo |= 1ull << bj; else if (bj < 128) sel_hi |= 1ull << (bj - 64);
#pragma unroll
      for (int k = 0; k < 32; ++k) v[k] = (bj == grp + 4 * k) ? NEG_INF : v[k];
    }
    sel_lo |= 1ull;
    if (cur < 64) sel_lo |= 1ull << cur; else sel_hi |= 1ull << (cur - 64);
    if (cur - 1 < 64) sel_lo |= 1ull << (cur - 1); else sel_hi |= 1ull << (cur - 1 - 64);
  }
  }
  asm volatile("" : "+v"(sel_lo), "+v"(sel_hi));
  atomicOr(&misc[4], (unsigned)sel_lo); atomicOr(&misc[5], (unsigned)(sel_lo >> 32));
  atomicOr(&misc[6], (unsigned)sel_hi); atomicOr(&misc[7], (unsigned)(sel_hi >> 32));
  __syncthreads();
  unsigned long long ulo, uhi;
  {
    const unsigned u0 = __builtin_amdgcn_readfirstlane(misc[4]), u1 = __builtin_amdgcn_readfirstlane(misc[5]);
    const unsigned u2 = __builtin_amdgcn_readfirstlane(misc[6]), u3 = __builtin_amdgcn_readfirstlane(misc[7]);
    ulo = ((unsigned long long)u1 << 32) | u0; uhi = ((unsigned long long)u3 << 32) | u2;
  }
  {
    NSA_SECTION_VARS
    const int tid = (wave << 6) | lane;
    const int hq = r >> 2, qq = r & 3;
    const bf16_t* ks = WSP(bf16_t, OFF_KS) + ((size_t)b * T) * 128 + g * 64;
    const bf16_t* vst = WSP(bf16_t, OFF_VST) + (size_t)((b * 2 + g) * 64) * T;
    bf16x8 qr[4][2];
    unsigned long long mlo[4], mhi[4];
#pragma unroll
    for (int ct = 0; ct < 4; ++ct) {
      const size_t rowq = (size_t)b * T + t0 + 4 * ct + qq;
#pragma unroll
      for (int dk = 0; dk < 2; ++dk)
        qr[ct][dk] = *(const bf16x8*)(WSP(bf16_t, OFF_QN) + rowq * 512 + (g * 4 + hq) * 64 + dk * 32 + grp * 8);
      const int srcl = (lane & 48) | (4 * ct + qq);
      mlo[ct] = __shfl(sel_lo, srcl);
      mhi[ct] = __shfl(sel_hi, srcl);
      m[ct] = NEG_INF; lacc[ct] = (f32x4){0.f, 0.f, 0.f, 0.f};
    }
#pragma unroll
    for (int dt = 0; dt < 4; ++dt)
#pragma unroll
      for (int ct = 0; ct < 4; ++ct) o[dt][ct] = (f32x4){0.f, 0.f, 0.f, 0.f};
    const short one_ = (short)0x3F80;
    const bf16x8 ones = {one_, one_, one_, one_, one_, one_, one_, one_};
    TileRegs tr;
    int j = next_bit(ulo, uhi, 0), it = 0;
    tile_gload(tr, ks, 128, vst, T, 64 * j, tid);
    tile_swrite(tr, tiles, tid);
    __syncthreads();
#pragma unroll 1
    while (j < 128) {
      const int jn = next_bit(ulo, uhi, j + 1);
      if (jn < 128) tile_gload(tr, ks, 128, vst, T, 64 * jn, tid);
      const lds_u8* stage = tiles + (it & 1) * TILE_STAGE;
      bool mine[4], need[4], anyneed = false;
#pragma unroll
      for (int ct = 0; ct < 4; ++ct) {
        mine[ct] = ((j < 64 ? (mlo[ct] >> j) : (mhi[ct] >> (j - 64))) & 1ull) != 0ull;
        need[ct] = __any(mine[ct]) != 0;
        anyneed = anyneed || need[ct];
      }
      if (anyneed) {
#pragma unroll 1
        for (int hf = 0; hf < 2; ++hf) {
          const int key0 = j * 64 + hf * 32;
          bf16x8 kf[2][2];
#pragma unroll
          for (int kt = 0; kt < 2; ++kt) {
            const lds_u8* kp = stage + (32 * hf + 8 * (r >> 2) + 4 * kt + (r & 3)) * TILE_ROWB + grp * 16;
#pragma unroll
            for (int dk = 0; dk < 2; ++dk) kf[kt][dk] = *(const __attribute__((address_space(3))) bf16x8*)(kp + dk * 64);
          }
          bf16x8 vfr[4];
          v_frags_lds<4>(stage, hf, vfr, lane);
#pragma unroll
          for (int ct = 0; ct < 4; ++ct) {
            if (need[ct]) {
              const float mv = mine[ct] ? 0.f : NEG_INF;
              f32x4 s0 = {mv, mv, mv, mv}, s1 = {mv, mv, mv, mv};
              s0 = mfma16(kf[0][0], qr[ct][0], s0);
              s1 = mfma16(kf[1][0], qr[ct][0], s1);
              s0 = mfma16(kf[0][1], qr[ct][1], s0);
              s1 = mfma16(kf[1][1], qr[ct][1], s1);
              if (j == cur) {
                const int tct = t0 + 4 * ct + qq;
#pragma unroll
                for (int i = 0; i < 4; ++i) {
                  s0[i] = (key0 + 8 * grp + i <= tct) ? s0[i] : NEG_INF;
                  s1[i] = (key0 + 8 * grp + 4 + i <= tct) ? s1[i] : NEG_INF;
                }
              }
              float mx = fmaxf(fmaxf(fmaxf(s0[0], s0[1]), fmaxf(s0[2], s0[3])), fmaxf(fmaxf(s1[0], s1[1]), fmaxf(s1[2], s1[3])));
              mx = grp_max4(mx);
              const float mnew = fmaxf(m[ct], mx);
              if (__any(mnew > m[ct])) {
                const float ms = (mnew == NEG_INF) ? 0.f : mnew;
                const float alpha = __builtin_amdgcn_exp2f(m[ct] - ms);
                m[ct] = mnew;
                lacc[ct] = lacc[ct] * alpha;
#pragma unroll
                for (int dt = 0; dt < 4; ++dt) o[dt][ct] = o[dt][ct] * alpha;
              }
              const float msafe = (m[ct] == NEG_INF) ? 0.f : m[ct];
              const f32x4 d0 = s0 - msafe, d1 = s1 - msafe;
              f32x4 p0, p1;
#pragma unroll
              for (int i = 0; i < 4; ++i) { p0[i] = __builtin_amdgcn_exp2f(d0[i]); p1[i] = __builtin_amdgcn_exp2f(d1[i]); }
              const bf16x8 pb = pack8(p0, p1);
              lacc[ct] = mfma16(ones, pb, lacc[ct]);
#pragma unroll
              for (int dt = 0; dt < 4; ++dt) o[dt][ct] = mfma16(vfr[dt], pb, o[dt][ct]);
            }
          }
        }
      }
      if (jn < 128) tile_swrite(tr, tiles + ((it + 1) & 1) * TILE_STAGE, tid);
      __syncthreads();
      j = jn; ++it;
    }
    float* scr2 = scr + (size_t)2048 * 4096;
#pragma unroll
    for (int ct = 0; ct < 4; ++ct) {
      const size_t rowq = (size_t)b * T + t0 + 4 * ct + qq;
      const float sc = (lacc[ct][0] > 0.f ? 1.0f / lacc[ct][0] : 0.f) * WSP(float, OFF_GATE)[rowq * 24 + (g * 4 + hq) * 3 + 1];
#pragma unroll
      for (int dt = 0; dt < 4; ++dt)
        *(f32x4*)(scr2 + (hq * 16 + 4 * ct + qq) * 64 + 16 * dt + 4 * grp) = o[dt][ct] * sc;
    }
    asm volatile("s_waitcnt vmcnt(0)" ::: "memory");
    __builtin_amdgcn_fence(__ATOMIC_SEQ_CST, "workgroup");
  }
  {
    NSA_SECTION_VARS
    const int tid = (wave << 6) | lane;
    const bf16_t* kw = WSP(bf16_t, OFF_KW) + ((size_t)b * T) * 128 + g * 64;
    const bf16_t* vwt = WSP(bf16_t, OFF_VWT) + (size_t)((b * 2 + g) * 64) * T;
#pragma unroll
    for (int ct = 0; ct < 4; ++ct) { m[ct] = NEG_INF; lsum[ct] = 0.f; lacc[ct] = (f32x4){0.f, 0.f, 0.f, 0.f}; }
#pragma unroll
    for (int dt = 0; dt < 4; ++dt)
#pragma unroll
      for (int ct = 0; ct < 4; ++ct) o[dt][ct] = (f32x4){0.f, 0.f, 0.f, 0.f};
    int kstart = qi * 128 - 512;
    if (kstart < 0) kstart = 0;
    const int kend = qi * 128 + 64;
    bf16x8 qr[4][2];
#pragma unroll
    for (int ct = 0; ct < 4; ++ct)
#pragma unroll
      for (int dk = 0; dk < 2; ++dk) qr[ct][dk] = qlds[(ct * 2 + dk) * 64 + lane];
    TileRegs tr;
    int it = 0;
    tile_gload(tr, kw, 128, vwt, T, kstart, tid);
    tile_swrite(tr, tiles, tid);
    __syncthreads();
#pragma unroll 1
    for (int k0 = kstart; k0 <= kend; k0 += 64, ++it) {
      if (k0 + 64 <= kend) tile_gload(tr, kw, 128, vwt, T, k0 + 64, tid);
      const lds_u8* stage = tiles + (it & 1) * TILE_STAGE;
      if (k0 <= t0 + 15 && k0 + 63 + 512 > t0) {
#pragma unroll 1
        for (int hf = 0; hf < 2; ++hf) {
          const int key0 = k0 + hf * 32;
          f32x4 s[2][4];
          const f32x4 cz = {0.f, 0.f, 0.f, 0.f};
          qk_scores_lds<4, 2, false>(stage, hf, qr, s, lane, nullptr, cz, cz);
          if (!(k0 + 63 <= t0 && k0 + 512 > t0 + 15)) {
#pragma unroll
            for (int kt = 0; kt < 2; ++kt)
#pragma unroll
              for (int i = 0; i < 4; ++i) {
                const int key = key0 + 8 * grp + 4 * kt + i;
                const bool ok = (key <= t) && (key + 512 > t);
#pragma unroll
                for (int ct = 0; ct < 4; ++ct) s[kt][ct][i] = ok ? s[kt][ct][i] : NEG_INF;
              }
          }
          bf16x8 vfr[4];
          v_frags_lds<4>(stage, hf, vfr, lane);
          softmax_update<4, 4, true, false>(s, m, lsum, o, &lacc);
          pv_accum_lds<4, 4>(vfr, s, o, lane, lacc);
        }
      }
      if (k0 + 64 <= kend) tile_swrite(tr, tiles + ((it + 1) & 1) * TILE_STAGE, tid);
      __syncthreads();
    }
    float sc2[4];
#pragma unroll
    for (int ct = 0; ct < 4; ++ct) sc2[ct] = (lacc[ct][0] > 0.f ? 1.0f / lacc[ct][0] : 0.f) * gatep[ct * 3 + 2];
    bf16_t* oa = WSP(bf16_t, OFF_OA) + row * 512 + g * 256;
#pragma unroll
    for (int dt = 0; dt < 4; ++dt)
#pragma unroll
      for (int ct = 0; ct < 4; ++ct) {
        bf16_t* ptr = oa + ct * 64 + 16 * dt + 4 * grp;
        const u32x2 sw = *(const u32x2*)ptr;
        float val[4];
        const f32x4 sv = *(const f32x4*)(scr + (size_t)2048 * 4096 + (ct * 16 + r) * 64 + 16 * dt + 4 * grp);
#pragma unroll
        for (int i = 0; i < 4; ++i) val[i] = scr[((dt * 4 + ct) * 4 + i) * 64 + lane] + sv[i] + o[dt][ct][i] * sc2[ct];
        u32x2 w = {cvtpk(val[0] * bflo(sw[0]), val[1] * bfhi(sw[0])), cvtpk(val[2] * bflo(sw[1]), val[3] * bfhi(sw[1]))};
        if (st) *(u32x2*)ptr = w;
        asm volatile("" ::: "memory");
      }
  }
#undef NSA_SECTION_VARS
}

__device__ void fox_wg_unit(const Params& p, int l, int b, int h, int qb, lds_u8* tiles, bool st) {
  const int tid = tidx();
  const int wave = __builtin_amdgcn_readfirstlane(tid >> 6);
  const int lane = tid & 63, r = lane & 15, grp = lane >> 4;
  const int t0 = qb * 512 + wave * 64;
  bf16x8 qf[4][2];
  const float* fc = WSP(float, OFF_FC) + (size_t)(b * 8 + h) * T;
#pragma unroll
  for (int ct = 0; ct < 4; ++ct) {
    const size_t row = (size_t)b * T + t0 + 16 * ct + r;
#pragma unroll
    for (int dk = 0; dk < 2; ++dk)
      qf[ct][dk] = *(const bf16x8*)(WSP(bf16_t, OFF_FQ) + row * 512 + h * 64 + dk * 32 + grp * 8);
  }
  const bf16_t* kb = WSP(bf16_t, OFF_FK) + ((size_t)b * T) * 512 + h * 64;
  const bf16_t* vt = WSP(bf16_t, OFF_FVT) + (size_t)((b * 8 + h) * 64) * T;
  f32x4 o[4][4];
  float m[4], lsum[4];
  f32x4 lacc[4];
#pragma unroll
  for (int ct = 0; ct < 4; ++ct) { m[ct] = NEG_INF; lsum[ct] = 0.f; lacc[ct] = (f32x4){0.f, 0.f, 0.f, 0.f}; }
#pragma unroll
  for (int dt = 0; dt < 4; ++dt)
#pragma unroll
    for (int ct = 0; ct < 4; ++ct) o[dt][ct] = (f32x4){0.f, 0.f, 0.f, 0.f};
  const int ntiles = (qb + 1) * 8;
  int it0, itw0;
  {
    float gq = fabsf(p.fox_q_norm[l * 64 + lane]), gk = fabsf(p.fox_k_norm[l * 64 + lane]);
#pragma unroll
    for (int o_ = 1; o_ < 64; o_ <<= 1) { gq = fmaxf(gq, __shfl_xor(gq, o_)); gk = fmaxf(gk, __shfl_xor(gk, o_)); }
    const float B2 = 16.0f * gq * gk * 1.02f + 104.0f;
    const float thr_wg = fc[qb * 512] + B2, thr_w = fc[t0] + B2;
    const float c0 = (lane < ntiles) ? fc[64 * lane + 63] : -3.0e38f;
    const float c1 = (lane + 64 < ntiles) ? fc[64 * (lane + 64) + 63] : -3.0e38f;
    it0 = __popcll(__ballot(c0 > thr_wg)) + __popcll(__ballot(c1 > thr_wg));
    itw0 = __popcll(__ballot(c0 > thr_w)) + __popcll(__ballot(c1 > thr_w));
    it0 = __builtin_amdgcn_readfirstlane(it0);
    itw0 = __builtin_amdgcn_readfirstlane(itw0);
  }
  TileRegs tr;
  float ckr = 0.f;
  tile_gload(tr, kb, 512, vt, T, it0 * 64, tid);
  if (tid < 64) ckr = fc[it0 * 64 + tid] * (-LOG2E);
  tile_swrite(tr, tiles, tid);
  if (tid < 64) *(__attribute__((address_space(3))) float*)(tiles + 2 * TILE_HALF + tid * 4) = ckr;
  __syncthreads();
#pragma unroll 1
  for (int it = it0; it < ntiles; ++it) {
    const int k0 = it * 64;
    if (it + 1 < ntiles) { tile_gload(tr, kb, 512, vt, T, k0 + 64, tid); if (tid < 64) ckr = fc[k0 + 64 + tid] * (-LOG2E); }
    const lds_u8* stage = tiles + ((it - it0) & 1) * TILE_STAGE;
    if (k0 <= t0 + 63 && it >= itw0) {
      const bool diag = (k0 + 63 > t0);
#pragma unroll
      for (int hf = 0; hf < 2; ++hf) {
        const int key0 = k0 + hf * 32;
        f32x4 s[2][4];
        const f32x4 ck0 = *(const __attribute__((address_space(3))) f32x4*)(stage + 2 * TILE_HALF + (32 * hf + 8 * grp) * 4);
        const f32x4 ck1 = *(const __attribute__((address_space(3))) f32x4*)(stage + 2 * TILE_HALF + (32 * hf + 8 * grp + 4) * 4);
        qk_scores_lds<4, 2, false>(stage, hf, qf, s, lane, nullptr, ck0, ck1);
        if (diag) {
#pragma unroll
          for (int kt = 0; kt < 2; ++kt)
#pragma unroll
            for (int i = 0; i < 4; ++i) {
              const int key = key0 + 8 * grp + 4 * kt + i;
#pragma unroll
              for (int ct = 0; ct < 4; ++ct) s[kt][ct][i] = (key <= t0 + 16 * ct + r) ? s[kt][ct][i] : NEG_INF;
            }
        }
        bf16x8 vfr[4];
        v_frags_lds<4>(stage, hf, vfr, lane);
        softmax_update<4, 4, true, false>(s, m, lsum, o, &lacc);
        pv_accum_lds<4, 4>(vfr, s, o, lane, lacc);
      }
    }
    if (it + 1 < ntiles) {
      tile_swrite(tr, tiles + ((it - it0 + 1) & 1) * TILE_STAGE, tid);
      if (tid < 64) *(__attribute__((address_space(3))) float*)(tiles + ((it - it0 + 1) & 1) * TILE_STAGE + 2 * TILE_HALF + tid * 4) = ckr;
    }
    __syncthreads();
  }
  float invl[4];
#pragma unroll
  for (int ct = 0; ct < 4; ++ct) invl[ct] = lacc[ct][0] > 0.f ? 1.0f / lacc[ct][0] : 0.f;
#pragma unroll
  for (int ct = 0; ct < 4; ++ct) {
    bf16_t* ob = WSP(bf16_t, OFF_OB) + ((size_t)b * T + t0 + 16 * ct + r) * 512 + h * 64;
#pragma unroll
    for (int dt = 0; dt < 4; ++dt) {
      bf16_t* ptr = ob + 16 * dt + 4 * grp;
      const u32x2 sw = *(const u32x2*)ptr;
      const f32x4 v = o[dt][ct] * invl[ct];
      u32x2 w = {cvtpk(v[0] * bflo(sw[0]), v[1] * bfhi(sw[0])), cvtpk(v[2] * bflo(sw[1]), v[3] * bfhi(sw[1]))};
      if (st) *(u32x2*)ptr = w;
    }
  }
}

__device__ void mem_unit(const Params& p, int l, int b, int h, int t0, bool st) {
  const int lane = tidx() & 63, r = lane & 15, grp = lane >> 4;
  const float SC = 0.08838834764831845f * LOG2E;
  bf16x8 qf[2][4];
  const float* gq = p.mem_q_norm + l * 128;
#pragma unroll
  for (int ct = 0; ct < 2; ++ct) {
    const size_t row = (size_t)b * T + t0 + 16 * ct + r;
    float v[4][8];
    float ss = 0.f;
#pragma unroll
    for (int dk = 0; dk < 4; ++dk) {
      const u32x4 w = *(const u32x4*)(WSP(bf16_t, OFF_MQ) + row * 512 + h * 128 + dk * 32 + grp * 8);
#pragma unroll
      for (int j = 0; j < 4; ++j) { v[dk][2 * j] = bflo(w[j]); v[dk][2 * j + 1] = bfhi(w[j]); }
#pragma unroll
      for (int j = 0; j < 8; ++j) ss += v[dk][j] * v[dk][j];
    }
    ss += __shfl_xor(ss, 16);
    ss += __shfl_xor(ss, 32);
    const float rstd = rsqrtf(ss * (1.0f / 128.0f) + EPS);
#pragma unroll
    for (int dk = 0; dk < 4; ++dk) {
      const f32x4 g0 = *(const f32x4*)(gq + dk * 32 + grp * 8), g1 = *(const f32x4*)(gq + dk * 32 + grp * 8 + 4);
      u32x4 w = {cvtpk(v[dk][0] * rstd * g0[0], v[dk][1] * rstd * g0[1]), cvtpk(v[dk][2] * rstd * g0[2], v[dk][3] * rstd * g0[3]),
                 cvtpk(v[dk][4] * rstd * g1[0], v[dk][5] * rstd * g1[1]), cvtpk(v[dk][6] * rstd * g1[2], v[dk][7] * rstd * g1[3])};
      qf[ct][dk] = __builtin_bit_cast(bf16x8, w);
    }
  }
  const bf16_t* kb = WSP(bf16_t, OFF_MK) + ((size_t)b * 256) * 512 + h * 128;
  const bf16_t* vt = WSP(bf16_t, OFF_MVT) + (size_t)((b * 4 + h) * 128) * 256;
  f32x4 o[8][2];
  float m[2], lsum[2];
#pragma unroll
  for (int ct = 0; ct < 2; ++ct) { m[ct] = NEG_INF; lsum[ct] = 0.f; }
#pragma unroll
  for (int dt = 0; dt < 8; ++dt)
#pragma unroll
    for (int ct = 0; ct < 2; ++ct) o[dt][ct] = (f32x4){0.f, 0.f, 0.f, 0.f};
#pragma unroll 1
  for (int key0 = 0; key0 < 256; key0 += 32) {
    f32x4 s[2][2];
    qk_scores<2, 4>(kb, 512, key0, qf, s, lane);
#pragma unroll
    for (int kt = 0; kt < 2; ++kt)
#pragma unroll
      for (int ct = 0; ct < 2; ++ct) s[kt][ct] = s[kt][ct] * SC;
    softmax_update<2, 8, true>(s, m, lsum, o);
    pv_accum<2, 8>(vt, 256, key0, s, o, lane);
  }
#pragma unroll
  for (int ct = 0; ct < 2; ++ct) {
    const float invl = finish_l(lsum[ct]);
    bf16_t* om = WSP(bf16_t, OFF_OM) + ((size_t)b * T + t0 + 16 * ct + r) * 512 + h * 128;
#pragma unroll
    for (int dt = 0; dt < 8; ++dt) {
      bf16_t* ptr = om + 16 * dt + 4 * grp;
      const u32x2 sw = *(const u32x2*)ptr;
      const f32x4 v = o[dt][ct] * invl;
      u32x2 w = {cvtpk(v[0] * bflo(sw[0]), v[1] * bfhi(sw[0])), cvtpk(v[2] * bflo(sw[1]), v[3] * bfhi(sw[1]))};
      if (st) *(u32x2*)ptr = w;
    }
  }
}

__device__ void phase_attn(const Params& p, int l, unsigned char* ldsraw, bool st, int cidx) {
  const int tid = tidx();
  const int wave = __builtin_amdgcn_readfirstlane(tid >> 6);
  float* imp = (float*)ldsraw + wave * 2112;
  lds_u8* tiles = (lds_u8*)ldsraw;
  bf16x8* qlds = (bf16x8*)(ldsraw + 69632 + wave * 8192);
  unsigned* misc = (unsigned*)(ldsraw + 135168);
  float* scr = WSP(float, OFF_SCR) + (size_t)(bidx() * NWAVES + wave) * 4096;
  const int myx = (int)(xb_xcc_id() & 7u);
  constexpr int QUNITS = 192;
  for (int qq = 0; qq < 8; ++qq) {
    const int x = (myx + qq) & 7;
    unsigned* ctr = WSP(unsigned, OFF_CTL) + cidx * 8 + x;
    for (;;) {
      __syncthreads();
      if (tid == 0) misc[0] = atomicAdd(ctr, 1u);
      if (tid >= 4 && tid < 8) misc[tid] = 0u;
      __syncthreads();
      const int u = __builtin_amdgcn_readfirstlane((int)misc[0]);
      if (u >= QUNITS) break;
      if (u < 128) {
        const int g4 = u >> 3, w = u & 7;
        if (w < 4) { const int bh = 4 * x + w; fox_wg_unit(p, l, bh >> 3, bh & 7, 15 - g4, tiles, st); }
        else nsa_wg_unit(p, x >> 1, x & 1, 63 - (4 * g4 + (w - 4)), imp, qlds, scr, tiles, misc, st);
      } else {
        const int mu = u - 128, bh = 2 * x + (mu >> 5), qblk = mu & 31;
        mem_unit(p, l, bh >> 2, bh & 3, 256 * qblk + 32 * wave, st);
      }
    }
  }
}

__global__ void __launch_bounds__(NTHREADS) hybrid_megakernel(Params p) {
  cg::grid_group grid = cg::this_grid();
  extern __shared__ __attribute__((aligned(16))) unsigned char dynlds[];
  float* smem = (float*)dynlds;
  PG8_LAS unsigned char* glds = (PG8_LAS unsigned char*)dynlds;
  volatile LAS unsigned* bst = (volatile LAS unsigned*)(glds + 135168 + 64);
  if (threadIdx.x < 2) bst[threadIdx.x] = 0u;
  __syncthreads();
  grid.sync();
  const XcdBarrier xbar = xcd_barrier_post(WSP(unsigned, OFF_BAR), bst);
#pragma unroll 1
  for (int ph = 0; ph < 28; ++ph) {
    const int l = ph / 7, k = ph - 7 * l;
    if (k == 0) {
      phase_prep(p, l, smem);
    } else if (k == 1) {
      EpiIn E{&p, l};
      for (int rp = 0; rp < (PROBE_GEMM2 ? (p.ws != nullptr ? 2 : 1) : 1); ++rp)
        run_gemm(glds, WSP(bf16_t, OFF_H), WSP(bf16_t, OFF_W_IN), M, 5120, 1024, E);
      EpiMemKV E2{&p};
      run_gemm(glds, WSP(bf16_t, OFF_MEMN), WSP(bf16_t, OFF_W_MKV), 1024, 1024, 1024, E2);
    } else if (k == 2) {
      phase_mid(p, l);
    } else if (k == 3) {
      const int nrep = PROBE_ATTN2 ? (p.ws != nullptr ? 2 : 1) : 1;
      for (int rp = 0; rp < nrep; ++rp) {
        const bool last = (rp == nrep - 1);
        if (rp) xcd_barrier(xbar);
        phase_attn(p, l, dynlds, last, last ? l : 4 + l);
      }
    } else if (k == 4) {
      EpiGate E{WSP(bf16_t, OFF_G)};
      for (int rp = 0; rp < (PROBE_GEMM2 ? (p.ws != nullptr ? 2 : 1) : 1); ++rp)
        run_gemm(glds, WSP(bf16_t, OFF_H), WSP(bf16_t, OFF_W_G), M, 3072, 1024, E);
    } else if (k == 5) {
      for (int rp = 0; rp < (PROBE_BR2 ? (p.ws != nullptr ? 2 : 1) : 1); ++rp) {
      EpiBranch Ea{WSP(bf16_t, OFF_G), WSP(bf16_t, OFF_U), 1};
      run_gemm(glds, WSP(bf16_t, OFF_OA), WSP(bf16_t, OFF_W_BR), M, 1024, 512, Ea);
      EpiBranch Eb{WSP(bf16_t, OFF_G) + (size_t)M * 1024, WSP(bf16_t, OFF_U), 0};
      run_gemm(glds, WSP(bf16_t, OFF_OB), WSP(bf16_t, OFF_W_BR + MiB), M, 1024, 512, Eb);
      EpiBranch Ec{WSP(bf16_t, OFF_G) + (size_t)2 * M * 1024, WSP(bf16_t, OFF_U), 0};
      run_gemm(glds, WSP(bf16_t, OFF_OM), WSP(bf16_t, OFF_W_BR + 2 * MiB), M, 1024, 512, Ec);
      }
    } else {
      EpiOut E{l == 0 ? p.x : p.out, p.out};
      run_gemm(glds, WSP(bf16_t, OFF_U), WSP(bf16_t, OFF_W_OUT), M, 1024, 1024, E);
    }
    xcd_barrier(xbar);
  }
}

extern "C" void kernel_launch(void* const* d_in, const int* in_sizes, int n_in, void* d_out, int out_size, void* d_ws,
                              size_t ws_size, hipStream_t stream) {
  static int grid_blocks = 0;
  if (!grid_blocks) {
    int dev = 0, cus = 0, per_cu = 0;
    (void)hipGetDevice(&dev);
    (void)hipDeviceGetAttribute(&cus, hipDeviceAttributeMultiprocessorCount, dev);
    if (hipFuncSetAttribute((const void*)hybrid_megakernel, hipFuncAttributeMaxDynamicSharedMemorySize, LDS_BYTES) != hipSuccess)
      fprintf(stderr, "hipFuncSetAttribute(dynamic LDS %d) failed\n", LDS_BYTES);
    (void)hipOccupancyMaxActiveBlocksPerMultiprocessor(&per_cu, hybrid_megakernel, NTHREADS, LDS_BYTES);
    (void)hipGetLastError();
    grid_blocks = cus;
    if (grid_blocks > 256) grid_blocks = 256;
    if (ws_size < OFF_SCR + (size_t)32 * MiB) fprintf(stderr, "workspace too small: %zu\n", ws_size);
  }
  Params p{};
  const float** pp = (const float**)&p;
  for (int i = 0; i < 23; ++i) pp[i] = (const float*)d_in[i];
  p.out = (float*)d_out;
  p.ws = (char*)d_ws;
  void* args[] = {&p};
  (void)hipMemsetAsync((char*)d_ws + OFF_BAR, 0, XCD_BAR_WORDS * sizeof(unsigned), stream);
  hipError_t e = hipLaunchCooperativeKernel((void*)hybrid_megakernel, dim3(grid_blocks), dim3(NTHREADS), args, LDS_BYTES, stream);
  if (e != hipSuccess) fprintf(stderr, "cooperative launch failed: %s (grid %d)\n", hipGetErrorString(e), grid_blocks);
}
```

```cpp
#include <hip/hip_runtime.h>
#include <hip/hip_cooperative_groups.h>
#include <stdint.h>
#include <cstdio>
namespace cg = cooperative_groups;
#ifndef PROBE_ATTN2
#define PROBE_ATTN2 0
#endif
#ifndef PROBE_PM2
#define PROBE_PM2 0
#endif
#ifndef PROBE_PHASE
#define PROBE_PHASE -1
#endif
#ifndef PROBE_BR2
#define PROBE_BR2 0
#endif
#ifndef PROBE_GEMM2
#define PROBE_GEMM2 0
#endif


typedef unsigned short bf16_t;
typedef short bf16x8 __attribute__((ext_vector_type(8)));
typedef float f32x4 __attribute__((ext_vector_type(4)));
typedef unsigned u32x2 __attribute__((ext_vector_type(2)));
typedef unsigned u32x4 __attribute__((ext_vector_type(4)));
typedef float f32x2_t __attribute__((ext_vector_type(2)));
typedef __bf16 bf16x2_t __attribute__((ext_vector_type(2)));

constexpr int NB = 4, T = 8192, M = NB * T;
constexpr int NTHREADS = 512, NWAVES = NTHREADS / 64;
constexpr int LDS_BYTES = 147456;
constexpr float EPS = 1e-6f;
constexpr float LOG2E = 1.4426950408889634f;
#define NEG_INF (-__builtin_inff())

constexpr size_t MiB = 1u << 20;
constexpr size_t OFF_CTL = 0;
constexpr size_t OFF_BAR = 64 * 1024;
constexpr size_t OFF_ROPE = 1 * MiB;
constexpr size_t OFF_W_IN = 3 * MiB;
constexpr size_t OFF_W_G = 13 * MiB;
constexpr size_t OFF_W_MKV = 19 * MiB;
constexpr size_t OFF_W_BR = 21 * MiB;
constexpr size_t OFF_W_OUT = 24 * MiB;
constexpr size_t OFF_W1 = 26 * MiB;
constexpr size_t OFF_W2 = 27 * MiB;
constexpr size_t OFF_C1 = 27 * MiB + 256 * 1024;
constexpr size_t OFF_MEMN = 28 * MiB;
constexpr size_t OFF_MK = 30 * MiB;
constexpr size_t OFF_MVT = 31 * MiB;
constexpr size_t OFF_H = 32 * MiB;
constexpr size_t OFF_U = OFF_H;
constexpr size_t OFF_OA = 96 * MiB;
constexpr size_t OFF_OB = 128 * MiB;
constexpr size_t OFF_OM = 160 * MiB;
constexpr size_t OFF_QN = 192 * MiB;
constexpr size_t OFF_G = 192 * MiB;
constexpr size_t OFF_KC = 224 * MiB;
constexpr size_t OFF_VC = 232 * MiB;
constexpr size_t OFF_KS = 240 * MiB;
constexpr size_t OFF_VST = 248 * MiB;
constexpr size_t OFF_KW = 256 * MiB;
constexpr size_t OFF_VWT = 264 * MiB;
constexpr size_t OFF_FQ = 272 * MiB;
constexpr size_t OFF_FK = 304 * MiB;
constexpr size_t OFF_FVT = 336 * MiB;
constexpr size_t OFF_MQ = 368 * MiB;
constexpr size_t OFF_GATE = 400 * MiB;
constexpr size_t OFF_FLOG = 403 * MiB;
constexpr size_t OFF_FC = 404 * MiB;
constexpr size_t OFF_KCMP = 405 * MiB;
constexpr size_t OFF_VCT = 405 * MiB + 512 * 1024;
constexpr size_t OFF_SCR = 406 * MiB;

struct Params {
  const float *x, *mem, *norm_g, *mem_norm_g, *w_in, *nsa_q_norm, *nsa_k_norm, *cmp_pe_k, *cmp_w1_k, *cmp_w2_k,
      *cmp_pe_v, *cmp_w1_v, *cmp_w2_v, *fox_q_norm, *fox_k_norm, *fox_f_bias, *mem_q_norm, *mem_k_norm, *w_mem_kv,
      *w_branch_a, *w_branch_b, *w_branch_m, *w_out;
  float* out;
  char* ws;
};
__device__ __forceinline__ char* ws_base(char* w) {
  unsigned lo = __builtin_amdgcn_readfirstlane((unsigned)(uintptr_t)w), hi = __builtin_amdgcn_readfirstlane((unsigned)((uintptr_t)w >> 32));
  asm volatile("" : "+s"(lo), "+s"(hi));
  return (char*)(__attribute__((address_space(1))) char*)(((uintptr_t)hi << 32) | (uintptr_t)lo);
}
#define WSP(TYPE, off) ((TYPE*)(ws_base(p.ws) + (off)))

__constant__ float c_inv_freq[32] = {
    1.000000000e+00f, 7.498942018e-01f, 5.623413324e-01f, 4.216965139e-01f, 3.162277639e-01f, 2.371373773e-01f,
    1.778279394e-01f, 1.333521456e-01f, 1.000000015e-01f, 7.498942316e-02f, 5.623413250e-02f, 4.216964915e-02f,
    3.162277490e-02f, 2.371373773e-02f, 1.778279431e-02f, 1.333521400e-02f, 9.999999776e-03f, 7.498942316e-03f,
    5.623413250e-03f, 4.216964822e-03f, 3.162277630e-03f, 2.371373819e-03f, 1.778279431e-03f, 1.333521446e-03f,
    1.000000047e-03f, 7.498941850e-04f, 5.623413017e-04f, 4.216965172e-04f, 3.162277571e-04f, 2.371373703e-04f,
    1.778279402e-04f, 1.333521504e-04f};

__device__ __forceinline__ int bidx() { int b = blockIdx.x; asm volatile("" : "+s"(b)); return b; }
__device__ __forceinline__ int gdim() { int g = gridDim.x; asm volatile("" : "+s"(g)); return g; }
__device__ __forceinline__ int tidx() { int t = threadIdx.x; asm volatile("" : "+v"(t)); return t; }
__device__ __forceinline__ unsigned cvtpk(float lo, float hi) {
  f32x2_t v = {lo, hi};
  bf16x2_t b = __builtin_convertvector(v, bf16x2_t);
  return __builtin_bit_cast(unsigned, b);
}
__device__ __forceinline__ float bf2f(unsigned short v) { return __uint_as_float(((unsigned)v) << 16); }
__device__ __forceinline__ float bflo(unsigned w) { return __uint_as_float(w << 16); }
__device__ __forceinline__ float bfhi(unsigned w) { return __uint_as_float(w & 0xffff0000u); }
__device__ __forceinline__ f32x4 mfma16(bf16x8 a, bf16x8 b, f32x4 c) {
  return __builtin_amdgcn_mfma_f32_16x16x32_bf16(a, b, c, 0, 0, 0);
}
__device__ __forceinline__ bf16x8 pack8(f32x4 a, f32x4 b) {
  u32x4 w = {cvtpk(a[0], a[1]), cvtpk(a[2], a[3]), cvtpk(b[0], b[1]), cvtpk(b[2], b[3])};
  return __builtin_bit_cast(bf16x8, w);
}
__device__ __forceinline__ float sigmoidf_(float v) { return 1.0f / (1.0f + __expf(-v)); }
__device__ __forceinline__ float siluf_(float v) { return v / (1.0f + __expf(-v)); }
__device__ __forceinline__ float grp_max4(float v) {
  auto a = __builtin_amdgcn_permlane32_swap(__float_as_uint(v), __float_as_uint(v), false, false);
  v = fmaxf(__uint_as_float(a[0]), __uint_as_float(a[1]));
  auto b = __builtin_amdgcn_permlane16_swap(__float_as_uint(v), __float_as_uint(v), false, false);
  return fmaxf(__uint_as_float(b[0]), __uint_as_float(b[1]));
}
__device__ __forceinline__ float wave_sum(float v) {
#pragma unroll
  for (int o = 1; o < 64; o <<= 1) v += __shfl_xor(v, o);
  return v;
}

#define LAS __attribute__((address_space(3)))
#define XB_TMO      128
#define XB_XCNT(j)  (256  + 64 * (j))
#define XB_XSUB(j)  (1280 + 64 * (j))
#define XB_XGEN(j)  (2304 + 64 * (j))
#define XB_TOP      3328
#define XB_TOPGEN   3392
#define XCD_BAR_WORDS 3456
#define XB_SPIN_CAP (1u << 18)

__device__ __forceinline__ unsigned xb_ld(unsigned* p)              { return __hip_atomic_load(p, __ATOMIC_RELAXED, __HIP_MEMORY_SCOPE_AGENT); }
__device__ __forceinline__ unsigned xb_add(unsigned* p, unsigned v) { return __hip_atomic_fetch_add(p, v, __ATOMIC_RELAXED, __HIP_MEMORY_SCOPE_AGENT); }
__device__ __forceinline__ unsigned xb_xcc_id() { return (unsigned)__builtin_amdgcn_s_getreg((3 << 11) | 20) & 0xFu; }
#define XB_SPIN(cond, bar) do { unsigned _sp = 0; while (cond) { __builtin_amdgcn_s_sleep(1); \
    if ((++_sp & 255u) == 0u) { if (xb_ld(&(bar)[XB_TMO])) break; if (_sp > XB_SPIN_CAP) { atomicAdd(&(bar)[XB_TMO], 1u); break; } } } } while (0)

struct XcdBarrier {
    unsigned* bar; unsigned x;
    volatile LAS unsigned* st;
};

__device__ __forceinline__ XcdBarrier xcd_barrier_post(unsigned* bar, volatile LAS unsigned* st) {
    XcdBarrier b; b.bar = bar; b.x = xb_xcc_id(); b.st = st;
    if (threadIdx.x == 0) (void)xb_add(&bar[XB_XCNT(b.x)], 1u);
    return b;
}
__device__ __forceinline__ void xcd_barrier_complete(unsigned* bar, unsigned x, unsigned& nloc, unsigned& nx) {
    const unsigned G = gridDim.x * gridDim.y * gridDim.z;
    unsigned sum, cnt, mine, sp = 0u;
    for (;;) {
        sum = 0u; cnt = 0u; mine = 0u;
#pragma unroll
        for (unsigned j = 0; j < 16; ++j) { const unsigned c = xb_ld(&bar[XB_XCNT(j)]); sum += c; cnt += (c > 0u) ? 1u : 0u; mine = (j == x) ? c : mine; }
        if (sum == G) break;
        __builtin_amdgcn_s_sleep(1);
        if ((++sp & 255u) == 0u) { if (xb_ld(&bar[XB_TMO])) break; if (sp > XB_SPIN_CAP) { atomicAdd(&bar[XB_TMO], 1u); break; } }
    }
    nloc = mine > 0u ? mine : 1u; nx = cnt > 0u ? cnt : 1u;
}

__device__ __forceinline__ void xcd_barrier(const XcdBarrier& b) {
    asm volatile("s_waitcnt vmcnt(0)" ::: "memory");
    __syncthreads();
    if (threadIdx.x == 0) {
        unsigned* bar = b.bar;
        __builtin_amdgcn_s_waitcnt(0);
        unsigned nloc = b.st[0], nx = b.st[1];
        if (nloc == 0u) { xcd_barrier_complete(bar, b.x, nloc, nx); b.st[0] = nloc; b.st[1] = nx; }
        const unsigned old = xb_add(&bar[XB_XSUB(b.x)], 1u);
        const unsigned gen = old / nloc;
        if (old + 1u == (gen + 1u) * nloc) {
            __builtin_amdgcn_fence(__ATOMIC_RELEASE, "agent");
            asm volatile("s_waitcnt vmcnt(0)" ::: "memory");
            const unsigned og = xb_add(&bar[XB_TOP], 1u);
            const unsigned tg = og / nx;
            if (og + 1u == (tg + 1u) * nx) xb_add(&bar[XB_TOPGEN], 1u);
            else XB_SPIN(xb_ld(&bar[XB_TOPGEN]) == tg, bar);
            __builtin_amdgcn_fence(__ATOMIC_ACQUIRE, "agent");
            xb_add(&bar[XB_XGEN(b.x)], 1u);
            asm volatile("s_waitcnt vmcnt(0)" ::: "memory");
        } else {
            XB_SPIN(xb_ld(&bar[XB_XGEN(b.x)]) == gen, bar);
            __builtin_amdgcn_fence(__ATOMIC_ACQUIRE, "agent");
            asm volatile("s_waitcnt vmcnt(0)" ::: "memory");
        }
    }
    __syncthreads();
}


namespace pg8 {
#define PG8_LAS __attribute__((address_space(3)))
typedef unsigned short bf16_t;
typedef short bf16x8 __attribute__((ext_vector_type(8)));
typedef float f32x4 __attribute__((ext_vector_type(4)));
typedef unsigned u32x4 __attribute__((ext_vector_type(4)));
constexpr int BM = 256, BK = 64, HALF = 128, HTB = HALF * BK * 2  , STAGE_BYTES = 8 * HTB, NXCD = 8, WGM = 8;

__host__ __device__ __forceinline__ int lds_byte(int r, int c) { const int st = (r >> 4) * 2 + (c >> 5), rr = r & 15, cc = c & 31, ob = rr * 64 + cc * 2; return st * 1024 + (ob ^ (((ob >> 9) & 1) << 5)); }
__host__ __device__ __forceinline__ void stage_rc(int b, int& R, int& C) { const int st = b / 1024, sb = b % 1024, swz = sb ^ (((sb >> 9) & 1) << 5); R = (st >> 1) * 16 + swz / 64; C = (st & 1) * 32 + (swz % 64) / 2; }
__host__ __device__ __forceinline__ int perm32(int rho) { const int n = rho >> 4, i = rho & 15; return 8 * (i >> 2) + 4 * n + (i & 3); }

struct Unit { int pm, pn; };
struct Gemm { const bf16_t* A; const bf16_t* Bt; int M, N, K; };

struct StaticOrder {
    int nM, nN, nwg, G, c;
    __host__ __device__ void init(int M, int N, int G_, int c_) { nM = M / BM; nN = N / BM; nwg = nM * nN; G = G_; c = c_; }
    __host__ __device__ bool next(int i, Unit& u) const {
        const long L = (long)i * G + c; if (L >= nwg) return false;
        int wgid = (int)L; { const int q = nwg / NXCD, r = nwg % NXCD, xcd = wgid % NXCD, off = wgid / NXCD; wgid = (xcd < r ? xcd * (q + 1) : r * (q + 1) + (xcd - r) * q) + off; }
        const int nig = WGM * nN, gid = wgid / nig, fm = gid * WGM, gsz = (nM - fm) < WGM ? (nM - fm) : WGM;
        u.pm = fm + ((wgid % nig) % gsz); u.pn = (wgid % nig) / gsz; return true;
    }
    __device__ __forceinline__ void a_ready(const Unit&) const {}
    __device__ __forceinline__ void done(const Unit&) const {}
};
__device__ __forceinline__ unsigned cvt_pk_bf16(float lo, float hi) { unsigned r; asm volatile("v_cvt_pk_bf16_f32 %0, %1, %2" : "=v"(r) : "v"(lo), "v"(hi)); return r; }
template <class Epi, class Sched, bool ALIGN_EPI = false, bool SP2 = false>
__device__ __forceinline__ void gemm_phase(PG8_LAS unsigned char* lds, const Gemm g, const Sched& S, const Epi& E) {
    const int tid = tidx(), wid = __builtin_amdgcn_readfirstlane(tid >> 6), lane = tid & 63, wr = wid >> 2, wc = wid & 3, fr = lane & 15, fq = lane >> 4;
    const int K = g.K, nt = K / BK;
    unsigned voffA[2], voffB[2];
#pragma unroll
    for (int i = 0; i < 2; ++i) { int R, C; stage_rc(tid * 16 + i * 8192, R, C); const int Rb = Epi::PERM ? ((R & ~31) + perm32(R & 31)) : R;
        voffA[i] = (unsigned)(R * K + C) * 2u; voffB[i] = (unsigned)(Rb * K + C) * 2u; }
    const size_t kstep = (size_t)(BK * 2);
    const size_t hstep = (size_t)HALF * K * 2;
    const size_t tstep = 2 * hstep;
    const unsigned ldsw = (unsigned)wid * 1024u;
    const int aoff = lds_byte(wr * 64 + fr, fq * 8), boff = lds_byte(wc * 32 + fr, fq * 8);
#define PG8_SA(b, h) (((b) * 2 + (h)) * HTB)
#define PG8_SB(b, h) ((4 + (b) * 2 + (h)) * HTB)
#define PG8_STAGE(bufoff, gbase, voff) do { _Pragma("unroll") for (int _i = 0; _i < 2; ++_i) \
        __builtin_amdgcn_global_load_lds((const unsigned*)((const char*)(gbase) + (voff)[_i]), (PG8_LAS unsigned*)(lds + (bufoff) + ldsw + _i * 8192), 16, 0, 0); } while (0)
#define PG8_LDA(dst, b, h) do { _Pragma("unroll") for (int m = 0; m < 4; ++m) _Pragma("unroll") for (int k = 0; k < 2; ++k) dst[m][k] = *(const PG8_LAS bf16x8*)(lds + PG8_SA(b, h) + aoff + m * 2048 + k * 1024); } while (0)
#define PG8_LDB(dst, b, h) do { _Pragma("unroll") for (int n = 0; n < 2; ++n) _Pragma("unroll") for (int k = 0; k < 2; ++k) dst[n][k] = *(const PG8_LAS bf16x8*)(lds + PG8_SB(b, h) + boff + n * 2048 + k * 1024); } while (0)
#define PG8_MMA(ai, bj, At, Bt) do { __builtin_amdgcn_s_setprio(1); _Pragma("unroll") for (int m = 0; m < 4; ++m) _Pragma("unroll") for (int n = 0; n < 2; ++n) _Pragma("unroll") for (int k = 0; k < 2; ++k) \
        acc[ai][bj][m][n] = __builtin_amdgcn_mfma_f32_16x16x32_bf16(Bt[n][k], At[m][k], acc[ai][bj][m][n], 0, 0, 0); __builtin_amdgcn_s_setprio(0); } while (0)
#define PG8_WAIT_V(n) asm volatile("s_waitcnt vmcnt(" #n ")" ::: "memory")
#define PG8_WAIT_L(n) asm volatile("s_waitcnt lgkmcnt(" #n ")" ::: "memory")
#define PG8_BAR __builtin_amdgcn_s_barrier()
#define PG8_SCHED __builtin_amdgcn_sched_barrier(0)
    Unit cur, nxt; int ui = 0;
    if (!S.next(0, cur)) return;
    f32x4 acc[2][2][4][2];
#pragma unroll
    for (int a = 0; a < 2; ++a)
#pragma unroll
        for (int b = 0; b < 2; ++b)
#pragma unroll
            for (int m = 0; m < 4; ++m)
#pragma unroll
                for (int n = 0; n < 2; ++n) acc[a][b][m][n] = (f32x4){0.f, 0.f, 0.f, 0.f};
    bf16x8 At[4][2], B0[2][2], B1[2][2];
    const char* cA = (const char*)g.A + (size_t)cur.pm * tstep; const char* cB = (const char*)g.Bt + (size_t)cur.pn * tstep;
    S.a_ready(cur);
    if constexpr (SP2) {
        PG8_STAGE(PG8_SB(0, 0), cB, voffB); PG8_STAGE(PG8_SB(0, 1), cB + hstep, voffB); PG8_STAGE(PG8_SA(0, 0), cA, voffA); PG8_STAGE(PG8_SA(0, 1), cA + hstep, voffA);
        if (wr == 1) PG8_BAR;
        PG8_WAIT_V(2); PG8_BAR;
        PG8_STAGE(PG8_SB(1, 0), cB + kstep, voffB); PG8_STAGE(PG8_SA(1, 0), cA + kstep, voffA); PG8_STAGE(PG8_SB(1, 1), cB + hstep + kstep, voffB);
        PG8_WAIT_V(6); PG8_BAR;
    } else {
        PG8_STAGE(PG8_SB(0, 0), cB, voffB); PG8_STAGE(PG8_SA(0, 0), cA, voffA); PG8_STAGE(PG8_SB(0, 1), cB + hstep, voffB); PG8_STAGE(PG8_SA(0, 1), cA + hstep, voffA);
        if (wr == 1) PG8_BAR;
        PG8_WAIT_V(4); PG8_BAR;
        PG8_STAGE(PG8_SB(1, 0), cB + kstep, voffB); PG8_STAGE(PG8_SA(1, 0), cA + kstep, voffA); PG8_STAGE(PG8_SB(1, 1), cB + hstep + kstep, voffB);
        PG8_WAIT_V(6); PG8_BAR;
    }
    for (;;) {
        const bool has_next = S.next(ui + 1, nxt);
        const char* nA = has_next ? (const char*)g.A + (size_t)nxt.pm * tstep : cA; const char* nB = has_next ? (const char*)g.Bt + (size_t)nxt.pn * tstep : cB;
        for (int t = 0; t < nt; t += 2) {
            const bool last = (t == nt - 2);
            const char* a1 = cA + (size_t)(t + 1) * kstep;
            const char* a2 = last ? nA : cA + (size_t)(t + 2) * kstep; const char* b2 = last ? nB : cB + (size_t)(t + 2) * kstep;
            const char* a3 = a2 + kstep; const char* b3 = b2 + kstep;
            if (last && has_next) S.a_ready(nxt);
            if constexpr (SP2) {
            PG8_LDB(B0, 0, 0); PG8_LDB(B1, 0, 1); PG8_SCHED; PG8_LDA(At, 0, 0); PG8_STAGE(PG8_SA(1, 1), a1 + hstep, voffA);
            PG8_WAIT_V(8); PG8_WAIT_L(0); PG8_BAR; PG8_MMA(0, 0, At, B0); PG8_MMA(0, 1, At, B1); PG8_BAR; PG8_SCHED;
            PG8_LDA(At, 0, 1); PG8_STAGE(PG8_SB(0, 0), b2, voffB); PG8_STAGE(PG8_SB(0, 1), b2 + hstep, voffB); PG8_STAGE(PG8_SA(0, 0), a2, voffA);
            PG8_WAIT_V(8); PG8_WAIT_L(0); PG8_BAR; PG8_MMA(1, 0, At, B0); PG8_MMA(1, 1, At, B1); PG8_BAR; PG8_SCHED;
            PG8_LDB(B0, 1, 0); PG8_LDB(B1, 1, 1); PG8_SCHED; PG8_LDA(At, 1, 0); PG8_STAGE(PG8_SA(0, 1), a2 + hstep, voffA);
            PG8_WAIT_V(8); PG8_WAIT_L(0); PG8_BAR; PG8_MMA(0, 0, At, B0); PG8_MMA(0, 1, At, B1); PG8_BAR; PG8_SCHED;
            PG8_LDA(At, 1, 1); PG8_STAGE(PG8_SB(1, 0), b3, voffB); PG8_STAGE(PG8_SB(1, 1), b3 + hstep, voffB); PG8_STAGE(PG8_SA(1, 0), a3, voffA);
            PG8_WAIT_V(8); PG8_WAIT_L(0); PG8_BAR; PG8_MMA(1, 0, At, B0); PG8_MMA(1, 1, At, B1); PG8_BAR; PG8_SCHED;
            } else {
            PG8_LDB(B0, 0, 0); PG8_SCHED; PG8_LDA(At, 0, 0); PG8_STAGE(PG8_SA(1, 1), a1 + hstep, voffA);
            PG8_WAIT_L(8); PG8_BAR; PG8_WAIT_L(0); PG8_MMA(0, 0, At, B0); PG8_BAR; PG8_SCHED;
            PG8_LDB(B1, 0, 1); PG8_STAGE(PG8_SB(0, 0), b2, voffB);
            PG8_BAR; PG8_WAIT_L(0); PG8_MMA(0, 1, At, B1); PG8_BAR;
            PG8_LDA(At, 0, 1); PG8_STAGE(PG8_SA(0, 0), a2, voffA);
            PG8_BAR; PG8_WAIT_L(0); PG8_MMA(1, 0, At, B0); PG8_BAR; PG8_SCHED;
            PG8_STAGE(PG8_SB(0, 1), b2 + hstep, voffB);
            PG8_WAIT_V(6); PG8_BAR; PG8_MMA(1, 1, At, B1); PG8_BAR;
            PG8_LDB(B0, 1, 0); PG8_SCHED; PG8_LDA(At, 1, 0); PG8_STAGE(PG8_SA(0, 1), a2 + hstep, voffA);
            PG8_WAIT_L(8); PG8_BAR; PG8_WAIT_L(0); PG8_MMA(0, 0, At, B0); PG8_BAR; PG8_SCHED;
            PG8_LDB(B1, 1, 1); PG8_STAGE(PG8_SB(1, 0), b3, voffB);
            PG8_BAR; PG8_WAIT_L(0); PG8_MMA(0, 1, At, B1); PG8_BAR;
            PG8_LDA(At, 1, 1); PG8_STAGE(PG8_SA(1, 0), a3, voffA);
            PG8_BAR; PG8_WAIT_L(0); PG8_MMA(1, 0, At, B0); PG8_BAR; PG8_SCHED;
            PG8_STAGE(PG8_SB(1, 1), b3 + hstep, voffB);
            PG8_WAIT_V(6); PG8_BAR; PG8_MMA(1, 1, At, B1); PG8_BAR;
            }
        }
        if constexpr (ALIGN_EPI) { if (wr == 0) PG8_BAR; }
        if constexpr (!Epi::AFTER_DRAIN) { E(acc, cur, wr, wc, fr, fq); S.done(cur); }
        if (!has_next) break;
#pragma unroll
        for (int a = 0; a < 2; ++a)
#pragma unroll
            for (int b = 0; b < 2; ++b)
#pragma unroll
                for (int m = 0; m < 4; ++m)
#pragma unroll
                    for (int n = 0; n < 2; ++n) acc[a][b][m][n] = (f32x4){0.f, 0.f, 0.f, 0.f};
        cur = nxt; cA = nA; cB = nB; ++ui;
        if constexpr (ALIGN_EPI) { if (wr == 1) PG8_BAR; }
    }
    PG8_WAIT_V(0);
    if constexpr (!ALIGN_EPI) { if (wr == 0) PG8_BAR; }
    PG8_BAR;
    if constexpr (Epi::AFTER_DRAIN) { E.fused(acc, cur, wr, wc, fr, fq, lds, wid, lane); S.done(cur); }
#undef PG8_SA
#undef PG8_SB
#undef PG8_STAGE
#undef PG8_LDA
#undef PG8_LDB
#undef PG8_MMA
#undef PG8_WAIT_V
#undef PG8_WAIT_L
#undef PG8_BAR
#undef PG8_SCHED
}
}

struct EpiIn {
  static constexpr bool PERM = false, AFTER_DRAIN = false;
  const Params* pp; int l;
  __device__ __forceinline__ void operator()(f32x4 (&acc)[2][2][4][2], const pg8::Unit& u, int wr, int wc, int fr, int fq) const {
    const Params& p = *pp;
    const int U = u.pn * 4 + wc;
    if (U >= 77) return;
    const int rowb = u.pm * 256 + wr * 64 + fr;
    const int bq = (u.pm * 256) / T, tb = rowb % T;
    bf16_t* dst = nullptr; int ld = 0, col0 = 0; const float* gain = nullptr; bool rope = false, silu = false;
    float post = 1.0f;
    bf16_t* vt = nullptr;
    if (U < 8) { dst = WSP(bf16_t, OFF_QN); ld = 512; col0 = U * 64; gain = p.nsa_q_norm + l * 64; rope = true; post = 0.125f * LOG2E; }
    else if (U < 10) { dst = WSP(bf16_t, OFF_KC); ld = 128; col0 = (U - 8) * 64; rope = true; }
    else if (U < 12) { dst = WSP(bf16_t, OFF_VC); ld = 128; col0 = (U - 10) * 64; }
    else if (U < 14) { dst = WSP(bf16_t, OFF_KS); ld = 128; col0 = (U - 12) * 64; gain = p.nsa_k_norm + (l * 3 + 1) * 64; rope = true; }
    else if (U < 16) { vt = WSP(bf16_t, OFF_VST) + (size_t)((bq * 2 + (U - 14)) * 64) * T; }
    else if (U < 18) { dst = WSP(bf16_t, OFF_KW); ld = 128; col0 = (U - 16) * 64; gain = p.nsa_k_norm + (l * 3 + 2) * 64; rope = true; }
    else if (U < 20) { vt = WSP(bf16_t, OFF_VWT) + (size_t)((bq * 2 + (U - 18)) * 64) * T; }
    else if (U < 28) { dst = WSP(bf16_t, OFF_OA); ld = 512; col0 = (U - 20) * 64; silu = true; }
    else if (U < 36) { dst = WSP(bf16_t, OFF_FQ); ld = 512; col0 = (U - 28) * 64; gain = p.fox_q_norm + l * 64; post = 0.125f * LOG2E; }
    else if (U < 44) { dst = WSP(bf16_t, OFF_FK); ld = 512; col0 = (U - 36) * 64; gain = p.fox_k_norm + l * 64; }
    else if (U < 52) { vt = WSP(bf16_t, OFF_FVT) + (size_t)((bq * 8 + (U - 44)) * 64) * T; }
    else if (U < 60) { dst = WSP(bf16_t, OFF_OB); ld = 512; col0 = (U - 52) * 64; silu = true; }
    else if (U < 68) { dst = WSP(bf16_t, OFF_MQ); ld = 512; col0 = (U - 60) * 64; }
    else if (U < 76) { dst = WSP(bf16_t, OFF_OM); ld = 512; col0 = (U - 68) * 64; silu = true; }
    if (U == 76) {
      float* gate = WSP(float, OFF_GATE);
      float* flog = WSP(float, OFF_FLOG);
#pragma unroll
      for (int ai = 0; ai < 2; ++ai)
#pragma unroll
        for (int m = 0; m < 4; ++m) {
          const size_t row = (size_t)rowb + 128 * ai + 16 * m;
#pragma unroll
          for (int n = 0; n < 2; ++n)
#pragma unroll
            for (int i = 0; i < 4; ++i) {
              const int e = 16 * n + 4 * fq + i;
              const float v = acc[ai][0][m][n][i];
              if (e < 24) gate[row * 24 + e] = sigmoidf_(v);
              else {
                const float xx = v + p.fox_f_bias[l * 8 + (e - 24)];
                flog[row * 8 + (e - 24)] = xx >= 0.f ? -log1pf(expf(-xx)) : xx - log1pf(expf(xx));
              }
            }
        }
      return;
    }
    if (vt) {
#pragma unroll
      for (int ai = 0; ai < 2; ++ai)
#pragma unroll
        for (int m = 0; m < 4; ++m) {
          const int t = tb + 128 * ai + 16 * m;
#pragma unroll
          for (int bj = 0; bj < 2; ++bj)
#pragma unroll
            for (int n = 0; n < 2; ++n) {
              const f32x4 v = acc[ai][bj][m][n];
              const unsigned w0 = cvtpk(v[0], v[1]), w1 = cvtpk(v[2], v[3]);
              const unsigned qo = (unsigned)((32 * bj + 16 * n + 4 * fq) * T + t);
              vt[qo] = (bf16_t)(w0 & 0xffffu); vt[qo + T] = (bf16_t)(w0 >> 16); vt[qo + 2 * T] = (bf16_t)(w1 & 0xffffu); vt[qo + 3 * T] = (bf16_t)(w1 >> 16);
            }
        }
      return;
    }
    const float* ropetab = WSP(float, OFF_ROPE);
    f32x4 gv[2][2];
    if (gain) {
#pragma unroll
      for (int bj = 0; bj < 2; ++bj)
#pragma unroll
        for (int n = 0; n < 2; ++n) gv[bj][n] = *(const f32x4*)(gain + 32 * bj + 16 * n + 4 * fq);
    }
#pragma unroll
    for (int ai = 0; ai < 2; ++ai)
#pragma unroll
      for (int m = 0; m < 4; ++m) {
        f32x4 v[2][2];
#pragma unroll
        for (int bj = 0; bj < 2; ++bj)
#pragma unroll
          for (int n = 0; n < 2; ++n) v[bj][n] = acc[ai][bj][m][n];
        const int row = rowb + 128 * ai + 16 * m;
        if (gain) {
          float ss = 0.f;
#pragma unroll
          for (int bj = 0; bj < 2; ++bj)
#pragma unroll
            for (int n = 0; n < 2; ++n)
#pragma unroll
              for (int i = 0; i < 4; ++i) ss += v[bj][n][i] * v[bj][n][i];
          ss += __shfl_xor(ss, 16);
          ss += __shfl_xor(ss, 32);
          const float rstd = rsqrtf(ss * (1.0f / 64.0f) + EPS);
#pragma unroll
          for (int bj = 0; bj < 2; ++bj)
#pragma unroll
            for (int n = 0; n < 2; ++n) v[bj][n] = v[bj][n] * rstd * gv[bj][n];
        }
        if (rope) {
          const int pos = row & (T - 1);
#pragma unroll
          for (int n = 0; n < 2; ++n) {
            const f32x4* tp = (const f32x4*)(ropetab + ((size_t)pos * 32 + 16 * n + 4 * fq) * 2);
            const f32x4 t0 = tp[0], t1 = tp[1];
            const float cs[4] = {t0[0], t0[2], t1[0], t1[2]}, sn[4] = {t0[1], t0[3], t1[1], t1[3]};
#pragma unroll
            for (int i = 0; i < 4; ++i) {
              const float y1 = v[0][n][i], y2 = v[1][n][i];
              v[0][n][i] = y1 * cs[i] - y2 * sn[i];
              v[1][n][i] = y2 * cs[i] + y1 * sn[i];
            }
          }
        }
#pragma unroll
        for (int bj = 0; bj < 2; ++bj)
#pragma unroll
          for (int n = 0; n < 2; ++n) {
            f32x4 y = v[bj][n] * post;
            if (silu) {
#pragma unroll
              for (int i = 0; i < 4; ++i) y[i] = siluf_(y[i]);
            }
            u32x2 w = {cvtpk(y[0], y[1]), cvtpk(y[2], y[3])};
            *(u32x2*)(dst + (size_t)row * ld + col0 + 32 * bj + 16 * n + 4 * fq) = w;
          }
      }
  }
};
struct EpiMemKV {
  static constexpr bool PERM = false, AFTER_DRAIN = false;
  const Params* pp;
  __device__ __forceinline__ void operator()(f32x4 (&acc)[2][2][4][2], const pg8::Unit& u, int wr, int wc, int fr, int fq) const {
    const Params& p = *pp;
    const int U = u.pn * 4 + wc;
    const int rowb = u.pm * 256 + wr * 64 + fr;
#pragma unroll
    for (int ai = 0; ai < 2; ++ai)
#pragma unroll
      for (int m = 0; m < 4; ++m) {
        const int row = rowb + 128 * ai + 16 * m;
#pragma unroll
        for (int bj = 0; bj < 2; ++bj)
#pragma unroll
          for (int n = 0; n < 2; ++n) {
            const f32x4 v = acc[ai][bj][m][n];
            const unsigned w0 = cvtpk(v[0], v[1]), w1 = cvtpk(v[2], v[3]);
            const int e = 32 * bj + 16 * n + 4 * fq;
            if (U < 8) {
              u32x2 w = {w0, w1};
              *(u32x2*)(WSP(bf16_t, OFF_MK) + (size_t)row * 512 + U * 64 + e) = w;
            } else {
              const int col = (U - 8) * 64 + e, h = col >> 7, d = col & 127, b = row >> 8, mm = row & 255;
              bf16_t* q = WSP(bf16_t, OFF_MVT) + (size_t)((b * 4 + h) * 128 + d) * 256 + mm;
              q[0] = (bf16_t)(w0 & 0xffffu); q[256] = (bf16_t)(w0 >> 16); q[512] = (bf16_t)(w1 & 0xffffu); q[768] = (bf16_t)(w1 >> 16);
            }
          }
      }
  }
};
struct EpiGate {
  static constexpr bool PERM = false, AFTER_DRAIN = false;
  bf16_t* G;
  __device__ __forceinline__ void operator()(f32x4 (&acc)[2][2][4][2], const pg8::Unit& u, int wr, int wc, int fr, int fq) const {
    const int br = u.pn >> 2, colt = (u.pn & 3) * 256 + wc * 32 + 4 * fq;
    bf16_t* base = G + (size_t)br * M * 1024;
    const int rowb = u.pm * 256 + wr * 64 + fr;
#pragma unroll
    for (int ai = 0; ai < 2; ++ai)
#pragma unroll
      for (int m = 0; m < 4; ++m) {
        bf16_t* rp = base + (size_t)(rowb + 128 * ai + 16 * m) * 1024 + colt;
#pragma unroll
        for (int bj = 0; bj < 2; ++bj)
#pragma unroll
          for (int n = 0; n < 2; ++n) {
            const f32x4 v = acc[ai][bj][m][n];
            u32x2 w = {cvtpk(sigmoidf_(v[0]), sigmoidf_(v[1])), cvtpk(sigmoidf_(v[2]), sigmoidf_(v[3]))};
            *(u32x2*)(rp + 128 * bj + 16 * n) = w;
          }
      }
  }
};
struct EpiBranch {
  static constexpr bool PERM = false, AFTER_DRAIN = false;
  const bf16_t* G; bf16_t* Uo; int first;
  __device__ __forceinline__ void operator()(f32x4 (&acc)[2][2][4][2], const pg8::Unit& u, int wr, int wc, int fr, int fq) const {
    const int colt = u.pn * 256 + wc * 32 + 4 * fq;
    const int rowb = u.pm * 256 + wr * 64 + fr;
#pragma unroll
    for (int ai = 0; ai < 2; ++ai)
#pragma unroll
      for (int m = 0; m < 4; ++m) {
        const size_t ro = (size_t)(rowb + 128 * ai + 16 * m) * 1024 + colt;
#pragma unroll
        for (int bj = 0; bj < 2; ++bj)
#pragma unroll
          for (int n = 0; n < 2; ++n) {
            const f32x4 v = acc[ai][bj][m][n];
            const size_t off = ro + 128 * bj + 16 * n;
            const u32x2 gw = *(const u32x2*)(G + off);
            float y0 = v[0] * bflo(gw[0]), y1 = v[1] * bfhi(gw[0]), y2 = v[2] * bflo(gw[1]), y3 = v[3] * bfhi(gw[1]);
            if (!first) {
              const u32x2 uw = *(const u32x2*)(Uo + off);
              y0 += bflo(uw[0]); y1 += bfhi(uw[0]); y2 += bflo(uw[1]); y3 += bfhi(uw[1]);
            }
            u32x2 w = {cvtpk(y0, y1), cvtpk(y2, y3)};
            *(u32x2*)(Uo + off) = w;
          }
      }
  }
};
struct EpiOut {
  static constexpr bool PERM = false, AFTER_DRAIN = false;
  const float* xin; float* xout;
  __device__ __forceinline__ void operator()(f32x4 (&acc)[2][2][4][2], const pg8::Unit& u, int wr, int wc, int fr, int fq) const {
    const int colt = u.pn * 256 + wc * 32 + 4 * fq;
    const int rowb = u.pm * 256 + wr * 64 + fr;
#pragma unroll
    for (int ai = 0; ai < 2; ++ai)
#pragma unroll
      for (int m = 0; m < 4; ++m) {
        const size_t ro = (size_t)(rowb + 128 * ai + 16 * m) * 1024 + colt;
#pragma unroll
        for (int bj = 0; bj < 2; ++bj)
#pragma unroll
          for (int n = 0; n < 2; ++n) {
            const size_t off = ro + 128 * bj + 16 * n;
            const f32x4 xv = *(const f32x4*)(xin + off);
            *(f32x4*)(xout + off) = xv + acc[ai][bj][m][n];
          }
      }
  }
};
template <class Epi>
__device__ __forceinline__ void run_gemm(PG8_LAS unsigned char* lds, const bf16_t* A, const bf16_t* Bt, int Mr, int Nc, int K, const Epi& E) {
  pg8::Gemm g{A, Bt, Mr, Nc, K};
  pg8::StaticOrder S;
  S.init(Mr, Nc, gdim(), bidx());
  pg8::gemm_phase<Epi, pg8::StaticOrder, true, true>(lds, g, S, E);
}

__device__ __forceinline__ int map_in(int n) {
  const int i = n >> 6, c = n & 63;
  if (i < 20) return n;
  if (i < 28) return 1304 + (n - 1280);
  if (i < 52) return 1816 + (n - 1792);
  if (i < 60) return 3360 + (n - 3328);
  if (i < 68) return 3872 + (n - 3840);
  if (i < 76) return 4384 + (n - 4352);
  if (i == 76) return c < 24 ? 1280 + c : (c < 32 ? 3352 + (c - 24) : -1);
  return -1;
}
__device__ __forceinline__ void wave_transpose_tile(const float* __restrict__ src, int ld_src, int k0, int n0, bf16_t* __restrict__ dst,
                                                    int Kdim, int maptype, int srccol0, float* tile, int lane) {
  int nlog = n0 + lane;
  if (maptype) { const int w = nlog & 255; nlog = (nlog & ~255) + (((w & 127) >> 5) << 6) + (((w >> 7) << 5) | (w & 31)); }
  const int sc = (maptype == 1) ? map_in(nlog) : srccol0 + nlog;
  const float* sp = src + (size_t)k0 * ld_src + (sc >= 0 ? sc : 0);
#pragma unroll 16
  for (int kk = 0; kk < 64; ++kk) {
    const float v = sp[(size_t)kk * ld_src];
    tile[kk * 65 + lane] = sc >= 0 ? v : 0.f;
  }
  __builtin_amdgcn_fence(__ATOMIC_SEQ_CST, "workgroup");
  __builtin_amdgcn_wave_barrier();
  const int rsub = lane >> 5, kp = lane & 31;
#pragma unroll 8
  for (int it = 0; it < 32; ++it) {
    const int row = 2 * it + rsub;
    const float a = tile[(2 * kp) * 65 + row], b = tile[(2 * kp + 1) * 65 + row];
    *(unsigned*)(dst + (size_t)(n0 + row) * Kdim + k0 + 2 * kp) = cvtpk(a, b);
  }
  __builtin_amdgcn_fence(__ATOMIC_SEQ_CST, "workgroup");
  __builtin_amdgcn_wave_barrier();
}
__device__ __forceinline__ void rmsnorm4(const float* __restrict__ x, const float* __restrict__ gain, bf16_t* __restrict__ dst, size_t row0, int lane) {
  f32x4 v[4][4];
  float ss[4];
#pragma unroll
  for (int rr = 0; rr < 4; ++rr)
#pragma unroll
    for (int i = 0; i < 4; ++i) v[rr][i] = *(const f32x4*)(x + (row0 + rr) * 1024 + lane * 4 + 256 * i);
  f32x4 gv[4];
#pragma unroll
  for (int i = 0; i < 4; ++i) gv[i] = *(const f32x4*)(gain + lane * 4 + 256 * i);
#pragma unroll
  for (int rr = 0; rr < 4; ++rr) {
    float s = 0.f;
#pragma unroll
    for (int i = 0; i < 4; ++i) s += v[rr][i][0] * v[rr][i][0] + v[rr][i][1] * v[rr][i][1] + v[rr][i][2] * v[rr][i][2] + v[rr][i][3] * v[rr][i][3];
    ss[rr] = s;
  }
#pragma unroll
  for (int o_ = 1; o_ < 64; o_ <<= 1) {
#pragma unroll
    for (int rr = 0; rr < 4; ++rr) ss[rr] += __shfl_xor(ss[rr], o_);
  }
#pragma unroll
  for (int rr = 0; rr < 4; ++rr) {
    const float rstd = rsqrtf(ss[rr] * (1.0f / 1024.0f) + EPS);
#pragma unroll
    for (int i = 0; i < 4; ++i) {
      const f32x4 y = v[rr][i] * rstd * gv[i];
      u32x2 w = {cvtpk(y[0], y[1]), cvtpk(y[2], y[3])};
      *(u32x2*)(dst + (row0 + rr) * 1024 + lane * 4 + 256 * i) = w;
    }
  }
}
__device__ __forceinline__ void phase_prep(const Params& p, int l, float* smem) {
  const int tid = tidx();
  const int wave = tid >> 6, lane = tid & 63;
  const int gw = wave * gdim() + bidx(), nw = NWAVES * gdim();
  if (l == 0 && bidx() == 0 && tid < 64) WSP(unsigned, OFF_CTL)[tid] = 0u;
  const float* xin = (l == 0) ? p.x : p.out;
  float* wtile = smem + wave * 4160;
  for (int u0 = gw; u0 < 3076; u0 += nw) {
    int u = u0;
    const float* src; int ld, kt, nt, Kd, mt = 0, c0 = 0; bf16_t* dst;
    if (u < 1280) { kt = u / 80; nt = u % 80; src = p.w_in + (size_t)l * 1024 * 7968; ld = 7968; Kd = 1024; dst = WSP(bf16_t, OFF_W_IN); mt = 1; }
    else if ((u -= 1280) < 768) { kt = u / 48; nt = u % 48; src = p.w_in + (size_t)l * 1024 * 7968; ld = 7968; Kd = 1024; dst = WSP(bf16_t, OFF_W_G); c0 = 4896; }
    else if ((u -= 768) < 256) { kt = u / 16; nt = u % 16; src = p.w_mem_kv + (size_t)l * 1024 * 1024; ld = 1024; Kd = 1024; dst = WSP(bf16_t, OFF_W_MKV); mt = 2; }
    else if ((u -= 256) < 384) { const int br = u / 128, uu = u % 128; kt = uu / 16; nt = uu % 16;
      src = (br == 0 ? p.w_branch_a : br == 1 ? p.w_branch_b : p.w_branch_m) + (size_t)l * 512 * 1024; ld = 1024; Kd = 512; dst = WSP(bf16_t, OFF_W_BR + (size_t)br * MiB); }
    else if ((u -= 384) < 256) { kt = u / 16; nt = u % 16; src = p.w_out + (size_t)l * 1024 * 1024; ld = 1024; Kd = 1024; dst = WSP(bf16_t, OFF_W_OUT); }
    else if ((u -= 256) < 128) { const int kv = u / 64, uu = u % 64; kt = uu / 2; nt = uu % 2;
      src = (kv ? p.cmp_w1_v : p.cmp_w1_k) + (size_t)l * 2048 * 128; ld = 128; Kd = 2048; dst = WSP(bf16_t, OFF_W1 + (size_t)kv * 512 * 1024); }
    else { u -= 128; const int kv = u / 2; kt = u % 2; nt = 0;
      src = (kv ? p.cmp_w2_v : p.cmp_w2_k) + (size_t)l * 128 * 64; ld = 64; Kd = 128; dst = WSP(bf16_t, OFF_W2 + (size_t)kv * 64 * 1024); }
    wave_transpose_tile(src, ld, kt * 64, nt * 64, dst, Kd, mt, c0, wtile, lane);
  }
  for (int grp = gw; grp < 8192 + 256; grp += nw) {
    if (grp < 8192) rmsnorm4(xin, p.norm_g + l * 1024, WSP(bf16_t, OFF_H), (size_t)grp * 4, lane);
    else rmsnorm4(p.mem, p.mem_norm_g + l * 1024, WSP(bf16_t, OFF_MEMN), (size_t)(grp - 8192) * 4, lane);
  }
  for (int u = gw; u < 32; u += nw) {
    const int kv = u >> 4, ch = u & 15;
    const float* pe = (kv ? p.cmp_pe_v : p.cmp_pe_k) + (size_t)l * 2048 + ch * 128;
    const float* w1 = (kv ? p.cmp_w1_v : p.cmp_w1_k) + (size_t)l * 2048 * 128 + (size_t)ch * 128 * 128;
    float s0 = 0.f, s1 = 0.f;
#pragma unroll 16
    for (int kk = 0; kk < 128; ++kk) {
      const float pv = pe[kk];
      s0 += pv * w1[(size_t)kk * 128 + lane];
      s1 += pv * w1[(size_t)kk * 128 + 64 + lane];
    }
    float* part = WSP(float, OFF_C1) + (size_t)(kv * 16 + ch) * 128;
    part[lane] = s0;
    part[64 + lane] = s1;
  }
  if (l == 0) {
    for (int u = bidx(); u < 512; u += gdim()) {
      for (int e = tid; e < 512; e += NTHREADS) {
        const int idx = u * 512 + e, pos = idx >> 5, f = idx & 31;
        const float ang = (float)pos * c_inv_freq[f];
        const double a = (double)ang;
        const double k = rint(a * 0.15915494309189535);
        const float rr = (float)(a - k * 6.283185307179586);
        float2 cs; cs.x = __cosf(rr); cs.y = __sinf(rr);
        WSP(float2, OFF_ROPE)[idx] = cs;
      }
    }
  }
}

__device__ __forceinline__ void compress_unit(const Params& p, int l, int u) {
  const int lane = tidx() & 63, r = lane & 15, g4 = lane >> 4;
  const int kv = u >> 7, rem = u & 127, b = rem >> 5, grp = (rem >> 4) & 1, it = rem & 15, i0 = it * 32;
  const bf16_t* src = WSP(bf16_t, kv ? OFF_VC : OFF_KC);
  const bf16_t* w1t = WSP(bf16_t, OFF_W1 + (size_t)kv * 512 * 1024);
  const bf16_t* w2t = WSP(bf16_t, OFF_W2 + (size_t)kv * 64 * 1024);
  const float* c1 = WSP(float, OFF_C1) + (size_t)kv * 16 * 128;
  const bf16_t* arow[2];
#pragma unroll
  for (int mt = 0; mt < 2; ++mt) {
    int i = i0 + 16 * mt + r;
    if (i > 510) i = 510;
    arow[mt] = src + ((size_t)b * T + 16 * i) * 128 + grp * 64 + g4 * 8;
  }
  f32x4 acc[2][8];
#pragma unroll
  for (int a = 0; a < 2; ++a)
#pragma unroll
    for (int c = 0; c < 8; ++c) acc[a][c] = (f32x4){0.f, 0.f, 0.f, 0.f};
  const bf16_t* bp = w1t + (size_t)r * 2048 + g4 * 8;
  for (int k0 = 0; k0 < 2048; k0 += 32) {
    const int pp = k0 >> 6, d = k0 & 63;
    bf16x8 af[2], bf[8];
#pragma unroll
    for (int mt = 0; mt < 2; ++mt) af[mt] = *(const bf16x8*)(arow[mt] + (size_t)pp * 128 + d);
#pragma unroll
    for (int nt = 0; nt < 8; ++nt) bf[nt] = *(const bf16x8*)(bp + (size_t)nt * 16 * 2048 + k0);
#pragma unroll
    for (int mt = 0; mt < 2; ++mt)
#pragma unroll
      for (int nt = 0; nt < 8; ++nt) acc[mt][nt] = mfma16(bf[nt], af[mt], acc[mt][nt]);
  }
#pragma unroll
  for (int nt = 0; nt < 8; ++nt) {
    f32x4 cv = {0.f, 0.f, 0.f, 0.f};
#pragma unroll
    for (int ch = 0; ch < 16; ++ch) cv = cv + *(const f32x4*)(c1 + ch * 128 + 16 * nt + 4 * g4);
#pragma unroll
    for (int mt = 0; mt < 2; ++mt)
#pragma unroll
      for (int i = 0; i < 4; ++i) acc[mt][nt][i] = siluf_(acc[mt][nt][i] + cv[i]);
  }
  bf16x8 wf[4][4];
#pragma unroll
  for (int ks = 0; ks < 4; ++ks)
#pragma unroll
    for (int et = 0; et < 4; ++et) {
      const bf16_t* wp = w2t + (size_t)(16 * et + r) * 128 + 32 * ks + 4 * g4;
      const u32x2 lo = *(const u32x2*)wp, hi = *(const u32x2*)(wp + 16);
      u32x4 w = {lo[0], lo[1], hi[0], hi[1]};
      wf[ks][et] = __builtin_bit_cast(bf16x8, w);
    }
  if (kv == 0) {
    const float* gain = p.nsa_k_norm + (size_t)(l * 3 + 0) * 64;
    bf16_t* dst = WSP(bf16_t, OFF_KCMP) + (size_t)((b * 2 + grp) * 512) * 64;
    f32x4 gv[4];
#pragma unroll
    for (int et = 0; et < 4; ++et) gv[et] = *(const f32x4*)(gain + 16 * et + 4 * g4);
#pragma unroll
    for (int mt = 0; mt < 2; ++mt) {
      f32x4 o[4];
#pragma unroll
      for (int et = 0; et < 4; ++et) o[et] = (f32x4){0.f, 0.f, 0.f, 0.f};
#pragma unroll
      for (int ks = 0; ks < 4; ++ks) {
        const bf16x8 xf = pack8(acc[mt][2 * ks], acc[mt][2 * ks + 1]);
#pragma unroll
        for (int et = 0; et < 4; ++et) o[et] = mfma16(wf[ks][et], xf, o[et]);
      }
      float ss = 0.f;
#pragma unroll
      for (int et = 0; et < 4; ++et)
#pragma unroll
        for (int i = 0; i < 4; ++i) ss += o[et][i] * o[et][i];
      ss += __shfl_xor(ss, 16);
      ss += __shfl_xor(ss, 32);
      const float rstd = rsqrtf(ss * (1.0f / 64.0f) + EPS);
      const int i = i0 + 16 * mt + r;
#pragma unroll
      for (int et = 0; et < 4; ++et) {
        f32x4 y = o[et] * rstd * gv[et];
        if (i > 510) y = (f32x4){0.f, 0.f, 0.f, 0.f};
        u32x2 w = {cvtpk(y[0], y[1]), cvtpk(y[2], y[3])};
        *(u32x2*)(dst + (size_t)i * 64 + 16 * et + 4 * g4) = w;
      }
    }
  } else {
    bf16_t* dst = WSP(bf16_t, OFF_VCT) + (size_t)((b * 2 + grp) * 64) * 512;
#pragma unroll
    for (int mt = 0; mt < 2; ++mt) {
      f32x4 o[4];
#pragma unroll
      for (int et = 0; et < 4; ++et) o[et] = (f32x4){0.f, 0.f, 0.f, 0.f};
#pragma unroll
      for (int ks = 0; ks < 4; ++ks) {
        const bf16x8 xf = pack8(acc[mt][2 * ks], acc[mt][2 * ks + 1]);
#pragma unroll
        for (int et = 0; et < 4; ++et) o[et] = mfma16(xf, wf[ks][et], o[et]);
      }
#pragma unroll
      for (int et = 0; et < 4; ++et) {
        f32x4 y = o[et];
        const int ib = i0 + 16 * mt + 4 * g4;
#pragma unroll
        for (int i = 0; i < 4; ++i)
          if (ib + i > 510) y[i] = 0.f;
        u32x2 w = {cvtpk(y[0], y[1]), cvtpk(y[2], y[3])};
        *(u32x2*)(dst + (size_t)(16 * et + r) * 512 + ib) = w;
      }
    }
  }
}
__device__ __forceinline__ void cumsum_unit(const Params& p, int u) {
  const int lane = tidx() & 63, b = u >> 3, h = u & 7;
  const float* fl = WSP(float, OFF_FLOG) + ((size_t)b * T) * 8 + h;
  float* fc = WSP(float, OFF_FC) + (size_t)(b * 8 + h) * T;
  const int tb = lane * 128;
  double s = 0.0;
  for (int i = 0; i < 128; ++i) s += (double)fl[(size_t)(tb + i) * 8];
  double incl = s;
#pragma unroll
  for (int o = 1; o < 64; o <<= 1) {
    const double y = __shfl_up(incl, o);
    if (lane >= o) incl += y;
  }
  double run = incl - s;
  for (int i = 0; i < 128; ++i) {
    run += (double)fl[(size_t)(tb + i) * 8];
    fc[tb + i] = (float)run;
  }
}
__device__ __forceinline__ void memk_norm_unit(const Params& p, int l, int u) {
  const int lane = tidx() & 63;
  bf16_t* mk = WSP(bf16_t, OFF_MK);
  const float* gain = p.mem_k_norm + l * 128 + (lane & 15) * 8;
  for (int rr = 0; rr < 16; ++rr) {
    bf16_t* ptr = mk + (size_t)(u * 16 + rr) * 512 + lane * 8;
    const u32x4 w = *(const u32x4*)ptr;
    float v[8];
#pragma unroll
    for (int j = 0; j < 4; ++j) { v[2 * j] = bflo(w[j]); v[2 * j + 1] = bfhi(w[j]); }
    float ss = 0.f;
#pragma unroll
    for (int j = 0; j < 8; ++j) ss += v[j] * v[j];
#pragma unroll
    for (int o = 1; o < 16; o <<= 1) ss += __shfl_xor(ss, o);
    const float rstd = rsqrtf(ss * (1.0f / 128.0f) + EPS);
    u32x4 ow;
#pragma unroll
    for (int j = 0; j < 4; ++j) ow[j] = cvtpk(v[2 * j] * rstd * gain[2 * j], v[2 * j + 1] * rstd * gain[2 * j + 1]);
    *(u32x4*)ptr = ow;
  }
}
__device__ __forceinline__ void phase_mid(const Params& p, int l) {
  const int wave = tidx() >> 6;
  const int gw = wave * gdim() + bidx(), nw = NWAVES * gdim();
  const int mult = PROBE_PM2 ? (p.ws != nullptr ? 2 : 1) : 1;
  for (int uu = gw; uu < (256 + 32 + 64) * mult; uu += nw) {
    const int u = uu % (256 + 32 + 64);
    if (u < 256) compress_unit(p, l, u);
    else if (u < 288) cumsum_unit(p, u - 256);
    else if (uu < 256 + 32 + 64) memk_norm_unit(p, l, u - 288);
  }
}

template <int NCT, int NDK, bool QL = false>
__device__ __forceinline__ void qk_scores(const bf16_t* __restrict__ kbase, int ldk, int key0,
                                          const bf16x8 (&qf)[NCT][NDK], f32x4 (&s)[2][NCT], int lane, const bf16x8* qlds = nullptr) {
  const int r = lane & 15, grp = lane >> 4;
#pragma unroll
  for (int kt = 0; kt < 2; ++kt) {
    const bf16_t* kp = kbase + (size_t)(key0 + 8 * (r >> 2) + 4 * kt + (r & 3)) * ldk + grp * 8;
    bf16x8 kf[NDK];
#pragma unroll
    for (int dk = 0; dk < NDK; ++dk) kf[dk] = *(const bf16x8*)(kp + dk * 32);
#pragma unroll
    for (int ct = 0; ct < NCT; ++ct) {
      f32x4 a = {0.f, 0.f, 0.f, 0.f};
#pragma unroll
      for (int dk = 0; dk < NDK; ++dk) a = mfma16(kf[dk], QL ? qlds[(ct * NDK + dk) * 64 + lane] : qf[ct][dk], a);
      s[kt][ct] = a;
    }
  }
}
template <int NCT, int NDT>
__device__ __forceinline__ void pv_accum(const bf16_t* __restrict__ vt, size_t ldv, int key0,
                                         const f32x4 (&s)[2][NCT], f32x4 (&o)[NDT][NCT], int lane) {
  const int r = lane & 15, grp = lane >> 4;
  bf16x8 pb[NCT];
#pragma unroll
  for (int ct = 0; ct < NCT; ++ct) pb[ct] = pack8(s[0][ct], s[1][ct]);
#pragma unroll
  for (int dt = 0; dt < NDT; ++dt) {
    const bf16x8 vf = *(const bf16x8*)(vt + (size_t)(16 * dt + r) * ldv + key0 + 8 * grp);
#pragma unroll
    for (int ct = 0; ct < NCT; ++ct) o[dt][ct] = mfma16(vf, pb[ct], o[dt][ct]);
  }
}
template <int NCT, int NDT, bool HAS_O, bool SUMS = true>
__device__ __forceinline__ void softmax_update(f32x4 (&s)[2][NCT], float (&m)[NCT], float (&lsum)[NCT],
                                               f32x4 (&o)[NDT][NCT], f32x4 (*lacc)[NCT] = nullptr) {
  float mnew[NCT];
  bool ch = false;
#pragma unroll
  for (int ct = 0; ct < NCT; ++ct) {
    float mx = fmaxf(fmaxf(fmaxf(s[0][ct][0], s[0][ct][1]), fmaxf(s[0][ct][2], s[0][ct][3])),
                     fmaxf(fmaxf(s[1][ct][0], s[1][ct][1]), fmaxf(s[1][ct][2], s[1][ct][3])));
    mx = grp_max4(mx);
    mnew[ct] = fmaxf(m[ct], mx);
    ch = ch || (mnew[ct] > m[ct]);
  }
  if (__any(ch)) {
#pragma unroll
    for (int ct = 0; ct < NCT; ++ct) {
      const float msafe = (mnew[ct] == NEG_INF) ? 0.f : mnew[ct];
      const float alpha = __builtin_amdgcn_exp2f(m[ct] - msafe);
      m[ct] = mnew[ct];
      if (SUMS) lsum[ct] *= alpha; else (*lacc)[ct] = (*lacc)[ct] * alpha;
      if (HAS_O) {
#pragma unroll
        for (int dt = 0; dt < NDT; ++dt) o[dt][ct] = o[dt][ct] * alpha;
      }
    }
  }
#pragma unroll
  for (int ct = 0; ct < NCT; ++ct) {
    const float msafe = (m[ct] == NEG_INF) ? 0.f : m[ct];
#pragma unroll
    for (int kt = 0; kt < 2; ++kt) {
      const f32x4 d = s[kt][ct] - msafe;
      f32x4 pv;
#pragma unroll
      for (int i = 0; i < 4; ++i) pv[i] = __builtin_amdgcn_exp2f(d[i]);
      s[kt][ct] = pv;
    }
    if (SUMS) {
      const f32x4 t4 = s[0][ct] + s[1][ct];
      lsum[ct] += (t4[0] + t4[1]) + (t4[2] + t4[3]);
    }
  }
}
__device__ __forceinline__ float finish_l(float lsum) {
  lsum += __shfl_xor(lsum, 16);
  lsum += __shfl_xor(lsum, 32);
  return lsum > 0.f ? 1.0f / lsum : 0.f;
}

typedef __attribute__((address_space(3))) unsigned char lds_u8;
constexpr int TILE_ROWB = 144, TILE_HALF = 64 * TILE_ROWB, TILE_STAGE = 2 * TILE_HALF + 256;
struct TileRegs { u32x4 k, v; };
__device__ __forceinline__ void tile_gload(TileRegs& tr, const bf16_t* __restrict__ kbase, int ldk, const bf16_t* __restrict__ vtbase,
                                           size_t ldv, int key0, int tid) {
  const int row = tid >> 3, ch = tid & 7;
  tr.k = *(const u32x4*)(kbase + (size_t)(key0 + row) * ldk + ch * 8);
  tr.v = *(const u32x4*)(vtbase + (size_t)row * ldv + key0 + ch * 8);
}
__device__ __forceinline__ void tile_swrite(const TileRegs& tr, lds_u8* stage, int tid) {
  const int row = tid >> 3, ch = tid & 7;
  *(__attribute__((address_space(3))) u32x4*)(stage + row * TILE_ROWB + ch * 16) = tr.k;
  *(__attribute__((address_space(3))) u32x4*)(stage + TILE_HALF + row * TILE_ROWB + ch * 16) = tr.v;
}
template <int NCT, int NDK, bool QL>
__device__ __forceinline__ void qk_scores_lds(const lds_u8* stage, int hf, const bf16x8 (&qf)[NCT][NDK], f32x4 (&s)[2][NCT], int lane,
                                              const bf16x8* qlds, const f32x4 c0, const f32x4 c1) {
  const int r = lane & 15, grp = lane >> 4;
#pragma unroll
  for (int kt = 0; kt < 2; ++kt) {
    const lds_u8* kp = stage + (32 * hf + 8 * (r >> 2) + 4 * kt + (r & 3)) * TILE_ROWB + grp * 16;
    bf16x8 kf[NDK];
#pragma unroll
    for (int dk = 0; dk < NDK; ++dk) kf[dk] = *(const __attribute__((address_space(3))) bf16x8*)(kp + dk * 64);
#pragma unroll
    for (int ct = 0; ct < NCT; ++ct) {
      f32x4 a = kt ? c1 : c0;
#pragma unroll
      for (int dk = 0; dk < NDK; ++dk) a = mfma16(kf[dk], QL ? qlds[(ct * NDK + dk) * 64 + lane] : qf[ct][dk], a);
      s[kt][ct] = a;
    }
  }
}
template <int NDT>
__device__ __forceinline__ void v_frags_lds(const lds_u8* stage, int hf, bf16x8 (&vf)[NDT], int lane) {
  const int r = lane & 15, grp = lane >> 4;
#pragma unroll
  for (int dt = 0; dt < NDT; ++dt)
    vf[dt] = *(const __attribute__((address_space(3))) bf16x8*)(stage + TILE_HALF + (16 * dt + r) * TILE_ROWB + (32 * hf + 8 * grp) * 2);
}
template <int NCT, int NDT>
__device__ __forceinline__ void pv_accum_lds(const bf16x8 (&vfp)[NDT], const f32x4 (&s)[2][NCT], f32x4 (&o)[NDT][NCT], int lane, f32x4 (&lacc)[NCT]) {
  const int r = lane & 15, grp = lane >> 4; (void)r; (void)grp;
  bf16x8 pb[NCT];
#pragma unroll
  for (int ct = 0; ct < NCT; ++ct) pb[ct] = pack8(s[0][ct], s[1][ct]);
  {
    const short one = (short)0x3F80;
    const bf16x8 ones = {one, one, one, one, one, one, one, one};
#pragma unroll
    for (int ct = 0; ct < NCT; ++ct) lacc[ct] = mfma16(ones, pb[ct], lacc[ct]);
  }
#pragma unroll
  for (int dt = 0; dt < NDT; ++dt) {
    const bf16x8 vf = vfp[dt];
#pragma unroll
    for (int ct = 0; ct < NCT; ++ct) o[dt][ct] = mfma16(vf, pb[ct], o[dt][ct]);
  }
}
__device__ __forceinline__ int next_bit(unsigned long long lo, unsigned long long hi, int from) {
  if (from < 64) { const unsigned long long mm = lo & (~0ull << from); if (mm) return __ffsll(mm) - 1; from = 64; }
  if (from < 128) { const unsigned long long mm = hi & (~0ull << (from - 64)); if (mm) return 64 + __ffsll(mm) - 1; }
  return 128;
}

__device__ __forceinline__ void nsa_wg_unit(const Params& p, int b, int g, int qi, float* imp, bf16x8* qlds, float* scr, lds_u8* tiles, unsigned* misc, bool st) {
  const int tid0 = tidx();
  const int wave = __builtin_amdgcn_readfirstlane(tid0 >> 6);
  const int lane0 = tid0 & 63;
  const int tq = qi * 8 + wave;
  const int t0 = tq * 16;
  const bf16x8 (&qf)[4][2] = *(const bf16x8 (*)[4][2])nullptr;
#define NSA_SECTION_VARS \
  int lane = lane0; asm volatile("" : "+v"(lane)); \
  const int r = lane & 15, grp = lane >> 4, t = t0 + r; \
  const size_t row = (size_t)b * T + t; \
  const float* gatep = WSP(float, OFF_GATE) + row * 24 + g * 12; (void)gatep; (void)grp; (void)t;
  {
    NSA_SECTION_VARS
#pragma unroll
    for (int ct = 0; ct < 4; ++ct)
#pragma unroll
      for (int dk = 0; dk < 2; ++dk)
        qlds[(ct * 2 + dk) * 64 + lane] = *(const bf16x8*)(WSP(bf16_t, OFF_QN) + row * 512 + (g * 4 + ct) * 64 + dk * 32 + grp * 8);
  }
  f32x4 o[4][4];
  float m[4], lsum[4];
  f32x4 lacc[4];
  {
    NSA_SECTION_VARS
    const bf16_t* kc = WSP(bf16_t, OFF_KCMP) + (size_t)((b * 2 + g) * 512) * 64;
    const bf16_t* vct = WSP(bf16_t, OFF_VCT) + (size_t)((b * 2 + g) * 64) * 512;
    const int nblk = (tq + 31) >> 5;
#pragma unroll
    for (int ct = 0; ct < 4; ++ct) { m[ct] = NEG_INF; lsum[ct] = 0.f; }
#pragma unroll 1
    for (int blk = 0; blk < nblk; ++blk) {
      f32x4 s[2][4];
      qk_scores<4, 2, true>(kc, 64, blk * 32, qf, s, lane, qlds);
#pragma unroll
      for (int kt = 0; kt < 2; ++kt)
#pragma unroll
        for (int i = 0; i < 4; ++i) {
          const int n = blk * 32 + 8 * grp + 4 * kt + i;
          const bool ok = (16 * n + 31 <= t);
#pragma unroll
          for (int ct = 0; ct < 4; ++ct) s[kt][ct][i] = ok ? s[kt][ct][i] : NEG_INF;
        }
      softmax_update<4, 4, false>(s, m, lsum, o);
    }
    float invl[4], msafe[4];
#pragma unroll
    for (int ct = 0; ct < 4; ++ct) { invl[ct] = finish_l(lsum[ct]); msafe[ct] = (m[ct] == NEG_INF) ? 0.f : m[ct]; }
    for (int e = lane; e < 16 * 132; e += 64) imp[e] = 0.f;
    __builtin_amdgcn_fence(__ATOMIC_SEQ_CST, "workgroup");
    __builtin_amdgcn_wave_barrier();
#pragma unroll
    for (int dt = 0; dt < 4; ++dt)
#pragma unroll
      for (int ct = 0; ct < 4; ++ct) o[dt][ct] = (f32x4){0.f, 0.f, 0.f, 0.f};
#pragma unroll 1
    for (int blk = 0; blk < nblk; ++blk) {
      f32x4 s[2][4];
      qk_scores<4, 2, true>(kc, 64, blk * 32, qf, s, lane, qlds);
      float pq[2][4];
#pragma unroll
      for (int kt = 0; kt < 2; ++kt)
#pragma unroll
        for (int i = 0; i < 4; ++i) {
          const int n = blk * 32 + 8 * grp + 4 * kt + i;
          const bool ok = (16 * n + 31 <= t);
          float acc_p = 0.f;
#pragma unroll
          for (int ct = 0; ct < 4; ++ct) {
            const float pv = ok ? __builtin_amdgcn_exp2f(s[kt][ct][i] - msafe[ct]) * invl[ct] : 0.f;
            s[kt][ct][i] = pv;
            acc_p += pv;
          }
          pq[kt][i] = acc_p;
        }
      float* ir = imp + r * 132 + blk * 8 + 2 * grp;
      ir[0] += pq[0][0] + pq[0][1] + pq[0][2] + 0.5f * pq[0][3];
      __builtin_amdgcn_fence(__ATOMIC_SEQ_CST, "workgroup");
      __builtin_amdgcn_wave_barrier();
      ir[1] += pq[1][0] + pq[1][1] + pq[1][2] + 0.5f * pq[1][3] + 0.5f * pq[0][3];
      __builtin_amdgcn_fence(__ATOMIC_SEQ_CST, "workgroup");
      __builtin_amdgcn_wave_barrier();
      ir[2] += 0.5f * pq[1][3];
      __builtin_amdgcn_fence(__ATOMIC_SEQ_CST, "workgroup");
      __builtin_amdgcn_wave_barrier();
      pv_accum<4, 4>(vct, 512, blk * 32, s, o, lane);
    }
    f32x4 gt[4];
#pragma unroll
    for (int ct = 0; ct < 4; ++ct) gt[ct][0] = gatep[ct * 3 + 0];
#pragma unroll
    for (int dt = 0; dt < 4; ++dt) {
#pragma unroll
      for (int ct = 0; ct < 4; ++ct)
#pragma unroll
        for (int i = 0; i < 4; ++i) scr[((dt * 4 + ct) * 4 + i) * 64 + lane] = o[dt][ct][i] * gt[ct][0];
      asm volatile("" ::: "memory");
    }
  }
  const int cur = t0 >> 6;
  unsigned long long sel_lo = 0ull, sel_hi = 0ull;
  {
  NSA_SECTION_VARS
  if (cur <= 15) {
    sel_lo = (1ull << (cur + 1)) - 1ull;
  } else {
    __builtin_amdgcn_fence(__ATOMIC_SEQ_CST, "workgroup");
    __builtin_amdgcn_wave_barrier();
    float v[32];
#pragma unroll
    for (int k = 0; k < 32; ++k) {
      const int j = grp + 4 * k;
      const float x = imp[r * 132 + j];
      v[k] = (j >= 1 && j <= cur - 2) ? x : NEG_INF;
    }
#pragma unroll 1
    for (int round = 0; round < 13; ++round) {
      float best = NEG_INF;
      int bj = 1 << 20;
#pragma unroll
      for (int k = 0; k < 32; ++k) {
        const bool tk = v[k] > best;
        best = tk ? v[k] : best;
        bj = tk ? (grp + 4 * k) : bj;
      }
#pragma unroll
      for (int off = 16; off <= 32; off <<= 1) {
        const float ob = __shfl_xor(best, off);
        const int oj = __shfl_xor(bj, off);
        const bool tk = (ob > best) || (ob == best && oj < bj);
        best = tk ? ob : best;
        bj = tk ? oj : bj;
      }
      if (bj < 64) sel_lo |= 1ull << bj; else if (bj < 128) sel_hi |= 1ull << (bj - 64);
#pragma unroll
      for (int k = 0; k < 32; ++k) v[k] = (bj == grp + 4 * k) ? NEG_INF : v[k];
    }
    sel_lo |= 1ull;
    if (cur < 64) sel_lo |= 1ull << cur; else sel_hi |= 1ull << (cur - 64);
    if (cur - 1 < 64) sel_lo |= 1ull << (cur - 1); else sel_hi |= 1ull << (cur - 1 - 64);
  }
  }
  asm volatile("" : "+v"(sel_lo), "+v"(sel_hi));
  atomicOr(&misc[4], (unsigned)sel_lo); atomicOr(&misc[5], (unsigned)(sel_lo >> 32));
  atomicOr(&misc[6], (unsigned)sel_hi); atomicOr(&misc[7], (unsigned)(sel_hi >> 32));
  __syncthreads();
  unsigned long long ulo, uhi;
  {
    const unsigned u0 = __builtin_amdgcn_readfirstlane(misc[4]), u1 = __builtin_amdgcn_readfirstlane(misc[5]);
    const unsigned u2 = __builtin_amdgcn_readfirstlane(misc[6]), u3 = __builtin_amdgcn_readfirstlane(misc[7]);
    ulo = ((unsigned long long)u1 << 32) | u0; uhi = ((unsigned long long)u3 << 32) | u2;
  }
  {
    NSA_SECTION_VARS
    const int tid = (wave << 6) | lane;
    const int hq = r >> 2, qq = r & 3;
    const bf16_t* ks = WSP(bf16_t, OFF_KS) + ((size_t)b * T) * 128 + g * 64;
    const bf16_t* vst = WSP(bf16_t, OFF_VST) + (size_t)((b * 2 + g) * 64) * T;
    bf16x8 qr[4][2];
    unsigned long long mlo[4], mhi[4];
#pragma unroll
    for (int ct = 0; ct < 4; ++ct) {
      const size_t rowq = (size_t)b * T + t0 + 4 * ct + qq;
#pragma unroll
      for (int dk = 0; dk < 2; ++dk)
        qr[ct][dk] = *(const bf16x8*)(WSP(bf16_t, OFF_QN) + rowq * 512 + (g * 4 + hq) * 64 + dk * 32 + grp * 8);
      const int srcl = (lane & 48) | (4 * ct + qq);
      mlo[ct] = __shfl(sel_lo, srcl);
      mhi[ct] = __shfl(sel_hi, srcl);
      m[ct] = NEG_INF; lacc[ct] = (f32x4){0.f, 0.f, 0.f, 0.f};
    }
#pragma unroll
    for (int dt = 0; dt < 4; ++dt)
#pragma unroll
      for (int ct = 0; ct < 4; ++ct) o[dt][ct] = (f32x4){0.f, 0.f, 0.f, 0.f};
    const short one_ = (short)0x3F80;
    const bf16x8 ones = {one_, one_, one_, one_, one_, one_, one_, one_};
    TileRegs tr;
    int j = next_bit(ulo, uhi, 0), it = 0;
    tile_gload(tr, ks, 128, vst, T, 64 * j, tid);
    tile_swrite(tr, tiles, tid);
    __syncthreads();
#pragma unroll 1
    while (j < 128) {
      const int jn = next_bit(ulo, uhi, j + 1);
      if (jn < 128) tile_gload(tr, ks, 128, vst, T, 64 * jn, tid);
      const lds_u8* stage = tiles + (it & 1) * TILE_STAGE;
      bool mine[4], need[4], anyneed = false;
#pragma unroll
      for (int ct = 0; ct < 4; ++ct) {
        mine[ct] = ((j < 64 ? (mlo[ct] >> j) : (mhi[ct] >> (j - 64))) & 1ull) != 0ull;
        need[ct] = __any(mine[ct]) != 0;
        anyneed = anyneed || need[ct];
      }
      if (anyneed) {
#pragma unroll
        for (int hf = 0; hf < 2; ++hf) {
          const int key0 = j * 64 + hf * 32;
          bf16x8 kf[2][2];
#pragma unroll
          for (int kt = 0; kt < 2; ++kt) {
            const lds_u8* kp = stage + (32 * hf + 8 * (r >> 2) + 4 * kt + (r & 3)) * TILE_ROWB + grp * 16;
#pragma unroll
            for (int dk = 0; dk < 2; ++dk) kf[kt][dk] = *(const __attribute__((address_space(3))) bf16x8*)(kp + dk * 64);
          }
          bf16x8 vfr[4];
          v_frags_lds<4>(stage, hf, vfr, lane);
#pragma unroll
          for (int ct = 0; ct < 4; ++ct) {
            if (need[ct]) {
              const float mv = mine[ct] ? 0.f : NEG_INF;
              f32x4 s0 = {mv, mv, mv, mv}, s1 = {mv, mv, mv, mv};
              s0 = mfma16(kf[0][0], qr[ct][0], s0);
              s1 = mfma16(kf[1][0], qr[ct][0], s1);
              s0 = mfma16(kf[0][1], qr[ct][1], s0);
              s1 = mfma16(kf[1][1], qr[ct][1], s1);
              if (j == cur) {
                const int tct = t0 + 4 * ct + qq;
#pragma unroll
                for (int i = 0; i < 4; ++i) {
                  s0[i] = (key0 + 8 * grp + i <= tct) ? s0[i] : NEG_INF;
                  s1[i] = (key0 + 8 * grp + 4 + i <= tct) ? s1[i] : NEG_INF;
                }
              }
              float mx = fmaxf(fmaxf(fmaxf(s0[0], s0[1]), fmaxf(s0[2], s0[3])), fmaxf(fmaxf(s1[0], s1[1]), fmaxf(s1[2], s1[3])));
              mx = grp_max4(mx);
              const float mnew = fmaxf(m[ct], mx);
              if (__any(mnew > m[ct])) {
                const float ms = (mnew == NEG_INF) ? 0.f : mnew;
                const float alpha = __builtin_amdgcn_exp2f(m[ct] - ms);
                m[ct] = mnew;
                lacc[ct] = lacc[ct] * alpha;
#pragma unroll
                for (int dt = 0; dt < 4; ++dt) o[dt][ct] = o[dt][ct] * alpha;
              }
              const float msafe = (m[ct] == NEG_INF) ? 0.f : m[ct];
              const f32x4 d0 = s0 - msafe, d1 = s1 - msafe;
              f32x4 p0, p1;
#pragma unroll
              for (int i = 0; i < 4; ++i) { p0[i] = __builtin_amdgcn_exp2f(d0[i]); p1[i] = __builtin_amdgcn_exp2f(d1[i]); }
              const bf16x8 pb = pack8(p0, p1);
              lacc[ct] = mfma16(ones, pb, lacc[ct]);
#pragma unroll
              for (int dt = 0; dt < 4; ++dt) o[dt][ct] = mfma16(vfr[dt], pb, o[dt][ct]);
            }
          }
        }
      }
      if (jn < 128) tile_swrite(tr, tiles + ((it + 1) & 1) * TILE_STAGE, tid);
      __syncthreads();
      j = jn; ++it;
    }
    float* scr2 = scr + (size_t)2048 * 4096;
#pragma unroll
    for (int ct = 0; ct < 4; ++ct) {
      const size_t rowq = (size_t)b * T + t0 + 4 * ct + qq;
      const float sc = (lacc[ct][0] > 0.f ? 1.0f / lacc[ct][0] : 0.f) * WSP(float, OFF_GATE)[rowq * 24 + (g * 4 + hq) * 3 + 1];
#pragma unroll
      for (int dt = 0; dt < 4; ++dt)
        *(f32x4*)(scr2 + (hq * 16 + 4 * ct + qq) * 64 + 16 * dt + 4 * grp) = o[dt][ct] * sc;
    }
    asm volatile("s_waitcnt vmcnt(0)" ::: "memory");
    __builtin_amdgcn_fence(__ATOMIC_SEQ_CST, "workgroup");
  }
  {
    NSA_SECTION_VARS
    const int tid = (wave << 6) | lane;
    const bf16_t* kw = WSP(bf16_t, OFF_KW) + ((size_t)b * T) * 128 + g * 64;
    const bf16_t* vwt = WSP(bf16_t, OFF_VWT) + (size_t)((b * 2 + g) * 64) * T;
#pragma unroll
    for (int ct = 0; ct < 4; ++ct) { m[ct] = NEG_INF; lsum[ct] = 0.f; lacc[ct] = (f32x4){0.f, 0.f, 0.f, 0.f}; }
#pragma unroll
    for (int dt = 0; dt < 4; ++dt)
#pragma unroll
      for (int ct = 0; ct < 4; ++ct) o[dt][ct] = (f32x4){0.f, 0.f, 0.f, 0.f};
    int kstart = qi * 128 - 512;
    if (kstart < 0) kstart = 0;
    const int kend = qi * 128 + 64;
    bf16x8 qr[4][2];
#pragma unroll
    for (int ct = 0; ct < 4; ++ct)
#pragma unroll
      for (int dk = 0; dk < 2; ++dk) qr[ct][dk] = qlds[(ct * 2 + dk) * 64 + lane];
    TileRegs tr;
    int it = 0;
    tile_gload(tr, kw, 128, vwt, T, kstart, tid);
    tile_swrite(tr, tiles, tid);
    __syncthreads();
#pragma unroll 1
    for (int k0 = kstart; k0 <= kend; k0 += 64, ++it) {
      if (k0 + 64 <= kend) tile_gload(tr, kw, 128, vwt, T, k0 + 64, tid);
      const lds_u8* stage = tiles + (it & 1) * TILE_STAGE;
      if (k0 <= t0 + 15 && k0 + 63 + 512 > t0) {
#pragma unroll
        for (int hf = 0; hf < 2; ++hf) {
          const int key0 = k0 + hf * 32;
          f32x4 s[2][4];
          const f32x4 cz = {0.f, 0.f, 0.f, 0.f};
          qk_scores_lds<4, 2, false>(stage, hf, qr, s, lane, nullptr, cz, cz);
          if (!(k0 + 63 <= t0 && k0 + 512 > t0 + 15)) {
#pragma unroll
            for (int kt = 0; kt < 2; ++kt)
#pragma unroll
              for (int i = 0; i < 4; ++i) {
                const int key = key0 + 8 * grp + 4 * kt + i;
                const bool ok = (key <= t) && (key + 512 > t);
#pragma unroll
                for (int ct = 0; ct < 4; ++ct) s[kt][ct][i] = ok ? s[kt][ct][i] : NEG_INF;
              }
          }
          bf16x8 vfr[4];
          v_frags_lds<4>(stage, hf, vfr, lane);
          softmax_update<4, 4, true, false>(s, m, lsum, o, &lacc);
          pv_accum_lds<4, 4>(vfr, s, o, lane, lacc);
        }
      }
      if (k0 + 64 <= kend) tile_swrite(tr, tiles + ((it + 1) & 1) * TILE_STAGE, tid);
      __syncthreads();
    }
    float sc2[4];
#pragma unroll
    for (int ct = 0; ct < 4; ++ct) sc2[ct] = (lacc[ct][0] > 0.f ? 1.0f / lacc[ct][0] : 0.f) * gatep[ct * 3 + 2];
    bf16_t* oa = WSP(bf16_t, OFF_OA) + row * 512 + g * 256;
#pragma unroll
    for (int dt = 0; dt < 4; ++dt)
#pragma unroll
      for (int ct = 0; ct < 4; ++ct) {
        bf16_t* ptr = oa + ct * 64 + 16 * dt + 4 * grp;
        const u32x2 sw = *(const u32x2*)ptr;
        float val[4];
        const f32x4 sv = *(const f32x4*)(scr + (size_t)2048 * 4096 + (ct * 16 + r) * 64 + 16 * dt + 4 * grp);
#pragma unroll
        for (int i = 0; i < 4; ++i) val[i] = scr[((dt * 4 + ct) * 4 + i) * 64 + lane] + sv[i] + o[dt][ct][i] * sc2[ct];
        u32x2 w = {cvtpk(val[0] * bflo(sw[0]), val[1] * bfhi(sw[0])), cvtpk(val[2] * bflo(sw[1]), val[3] * bfhi(sw[1]))};
        if (st) *(u32x2*)ptr = w;
        asm volatile("" ::: "memory");
      }
  }
#undef NSA_SECTION_VARS
}

__device__ __forceinline__ void fox_wg_unit(const Params& p, int l, int b, int h, int qb, lds_u8* tiles, bool st) {
  const int tid = tidx();
  const int wave = __builtin_amdgcn_readfirstlane(tid >> 6);
  const int lane = tid & 63, r = lane & 15, grp = lane >> 4;
  const int t0 = qb * 512 + wave * 64;
  bf16x8 qf[4][2];
  const float* fc = WSP(float, OFF_FC) + (size_t)(b * 8 + h) * T;
#pragma unroll
  for (int ct = 0; ct < 4; ++ct) {
    const size_t row = (size_t)b * T + t0 + 16 * ct + r;
#pragma unroll
    for (int dk = 0; dk < 2; ++dk)
      qf[ct][dk] = *(const bf16x8*)(WSP(bf16_t, OFF_FQ) + row * 512 + h * 64 + dk * 32 + grp * 8);
  }
  const bf16_t* kb = WSP(bf16_t, OFF_FK) + ((size_t)b * T) * 512 + h * 64;
  const bf16_t* vt = WSP(bf16_t, OFF_FVT) + (size_t)((b * 8 + h) * 64) * T;
  f32x4 o[4][4];
  float m[4], lsum[4];
  f32x4 lacc[4];
#pragma unroll
  for (int ct = 0; ct < 4; ++ct) { m[ct] = NEG_INF; lsum[ct] = 0.f; lacc[ct] = (f32x4){0.f, 0.f, 0.f, 0.f}; }
#pragma unroll
  for (int dt = 0; dt < 4; ++dt)
#pragma unroll
    for (int ct = 0; ct < 4; ++ct) o[dt][ct] = (f32x4){0.f, 0.f, 0.f, 0.f};
  const int ntiles = (qb + 1) * 8;
  int it0, itw0;
  {
    float gq = fabsf(p.fox_q_norm[l * 64 + lane]), gk = fabsf(p.fox_k_norm[l * 64 + lane]);
#pragma unroll
    for (int o_ = 1; o_ < 64; o_ <<= 1) { gq = fmaxf(gq, __shfl_xor(gq, o_)); gk = fmaxf(gk, __shfl_xor(gk, o_)); }
    const float B2 = 16.0f * gq * gk * 1.02f + 104.0f;
    const float thr_wg = fc[qb * 512] + B2, thr_w = fc[t0] + B2;
    const float c0 = (lane < ntiles) ? fc[64 * lane + 63] : -3.0e38f;
    const float c1 = (lane + 64 < ntiles) ? fc[64 * (lane + 64) + 63] : -3.0e38f;
    it0 = __popcll(__ballot(c0 > thr_wg)) + __popcll(__ballot(c1 > thr_wg));
    itw0 = __popcll(__ballot(c0 > thr_w)) + __popcll(__ballot(c1 > thr_w));
    it0 = __builtin_amdgcn_readfirstlane(it0);
    itw0 = __builtin_amdgcn_readfirstlane(itw0);
  }
  TileRegs tr;
  float ckr = 0.f;
  tile_gload(tr, kb, 512, vt, T, it0 * 64, tid);
  if (tid < 64) ckr = fc[it0 * 64 + tid] * (-LOG2E);
  tile_swrite(tr, tiles, tid);
  if (tid < 64) *(__attribute__((address_space(3))) float*)(tiles + 2 * TILE_HALF + tid * 4) = ckr;
  __syncthreads();
#pragma unroll 1
  for (int it = it0; it < ntiles; ++it) {
    const int k0 = it * 64;
    if (it + 1 < ntiles) { tile_gload(tr, kb, 512, vt, T, k0 + 64, tid); if (tid < 64) ckr = fc[k0 + 64 + tid] * (-LOG2E); }
    const lds_u8* stage = tiles + ((it - it0) & 1) * TILE_STAGE;
    if (k0 <= t0 + 63 && it >= itw0) {
      const bool diag = (k0 + 63 > t0);
#pragma unroll
      for (int hf = 0; hf < 2; ++hf) {
        const int key0 = k0 + hf * 32;
        f32x4 s[2][4];
        const f32x4 ck0 = *(const __attribute__((address_space(3))) f32x4*)(stage + 2 * TILE_HALF + (32 * hf + 8 * grp) * 4);
        const f32x4 ck1 = *(const __attribute__((address_space(3))) f32x4*)(stage + 2 * TILE_HALF + (32 * hf + 8 * grp + 4) * 4);
        qk_scores_lds<4, 2, false>(stage, hf, qf, s, lane, nullptr, ck0, ck1);
        if (diag) {
#pragma unroll
          for (int kt = 0; kt < 2; ++kt)
#pragma unroll
            for (int i = 0; i < 4; ++i) {
              const int key = key0 + 8 * grp + 4 * kt + i;
#pragma unroll
              for (int ct = 0; ct < 4; ++ct) s[kt][ct][i] = (key <= t0 + 16 * ct + r) ? s[kt][ct][i] : NEG_INF;
            }
        }
        bf16x8 vfr[4];
        v_frags_lds<4>(stage, hf, vfr, lane);
        softmax_update<4, 4, true, false>(s, m, lsum, o, &lacc);
        pv_accum_lds<4, 4>(vfr, s, o, lane, lacc);
      }
    }
    if (it + 1 < ntiles) {
      tile_swrite(tr, tiles + ((it - it0 + 1) & 1) * TILE_STAGE, tid);
      if (tid < 64) *(__attribute__((address_space(3))) float*)(tiles + ((it - it0 + 1) & 1) * TILE_STAGE + 2 * TILE_HALF + tid * 4) = ckr;
    }
    __syncthreads();
  }
  float invl[4];
#pragma unroll
  for (int ct = 0; ct < 4; ++ct) invl[ct] = lacc[ct][0] > 0.f ? 1.0f / lacc[ct][0] : 0.f;
#pragma unroll
  for (int ct = 0; ct < 4; ++ct) {
    bf16_t* ob = WSP(bf16_t, OFF_OB) + ((size_t)b * T + t0 + 16 * ct + r) * 512 + h * 64;
#pragma unroll
    for (int dt = 0; dt < 4; ++dt) {
      bf16_t* ptr = ob + 16 * dt + 4 * grp;
      const u32x2 sw = *(const u32x2*)ptr;
      const f32x4 v = o[dt][ct] * invl[ct];
      u32x2 w = {cvtpk(v[0] * bflo(sw[0]), v[1] * bfhi(sw[0])), cvtpk(v[2] * bflo(sw[1]), v[3] * bfhi(sw[1]))};
      if (st) *(u32x2*)ptr = w;
    }
  }
}

__device__ __forceinline__ void mem_unit(const Params& p, int l, int b, int h, int t0, bool st) {
  const int lane = tidx() & 63, r = lane & 15, grp = lane >> 4;
  const float SC = 0.08838834764831845f * LOG2E;
  bf16x8 qf[2][4];
  const float* gq = p.mem_q_norm + l * 128;
#pragma unroll
  for (int ct = 0; ct < 2; ++ct) {
    const size_t row = (size_t)b * T + t0 + 16 * ct + r;
    float v[4][8];
    float ss = 0.f;
#pragma unroll
    for (int dk = 0; dk < 4; ++dk) {
      const u32x4 w = *(const u32x4*)(WSP(bf16_t, OFF_MQ) + row * 512 + h * 128 + dk * 32 + grp * 8);
#pragma unroll
      for (int j = 0; j < 4; ++j) { v[dk][2 * j] = bflo(w[j]); v[dk][2 * j + 1] = bfhi(w[j]); }
#pragma unroll
      for (int j = 0; j < 8; ++j) ss += v[dk][j] * v[dk][j];
    }
    ss += __shfl_xor(ss, 16);
    ss += __shfl_xor(ss, 32);
    const float rstd = rsqrtf(ss * (1.0f / 128.0f) + EPS);
#pragma unroll
    for (int dk = 0; dk < 4; ++dk) {
      const f32x4 g0 = *(const f32x4*)(gq + dk * 32 + grp * 8), g1 = *(const f32x4*)(gq + dk * 32 + grp * 8 + 4);
      u32x4 w = {cvtpk(v[dk][0] * rstd * g0[0], v[dk][1] * rstd * g0[1]), cvtpk(v[dk][2] * rstd * g0[2], v[dk][3] * rstd * g0[3]),
                 cvtpk(v[dk][4] * rstd * g1[0], v[dk][5] * rstd * g1[1]), cvtpk(v[dk][6] * rstd * g1[2], v[dk][7] * rstd * g1[3])};
      qf[ct][dk] = __builtin_bit_cast(bf16x8, w);
    }
  }
  const bf16_t* kb = WSP(bf16_t, OFF_MK) + ((size_t)b * 256) * 512 + h * 128;
  const bf16_t* vt = WSP(bf16_t, OFF_MVT) + (size_t)((b * 4 + h) * 128) * 256;
  f32x4 o[8][2];
  float m[2], lsum[2];
#pragma unroll
  for (int ct = 0; ct < 2; ++ct) { m[ct] = NEG_INF; lsum[ct] = 0.f; }
#pragma unroll
  for (int dt = 0; dt < 8; ++dt)
#pragma unroll
    for (int ct = 0; ct < 2; ++ct) o[dt][ct] = (f32x4){0.f, 0.f, 0.f, 0.f};
#pragma unroll 1
  for (int key0 = 0; key0 < 256; key0 += 32) {
    f32x4 s[2][2];
    qk_scores<2, 4>(kb, 512, key0, qf, s, lane);
#pragma unroll
    for (int kt = 0; kt < 2; ++kt)
#pragma unroll
      for (int ct = 0; ct < 2; ++ct) s[kt][ct] = s[kt][ct] * SC;
    softmax_update<2, 8, true>(s, m, lsum, o);
    pv_accum<2, 8>(vt, 256, key0, s, o, lane);
  }
#pragma unroll
  for (int ct = 0; ct < 2; ++ct) {
    const float invl = finish_l(lsum[ct]);
    bf16_t* om = WSP(bf16_t, OFF_OM) + ((size_t)b * T + t0 + 16 * ct + r) * 512 + h * 128;
#pragma unroll
    for (int dt = 0; dt < 8; ++dt) {
      bf16_t* ptr = om + 16 * dt + 4 * grp;
      const u32x2 sw = *(const u32x2*)ptr;
      const f32x4 v = o[dt][ct] * invl;
      u32x2 w = {cvtpk(v[0] * bflo(sw[0]), v[1] * bfhi(sw[0])), cvtpk(v[2] * bflo(sw[1]), v[3] * bfhi(sw[1]))};
      if (st) *(u32x2*)ptr = w;
    }
  }
}

__device__ __forceinline__ void phase_attn(const Params& p, int l, unsigned char* ldsraw, bool st, int cidx) {
  const int tid = tidx();
  const int wave = __builtin_amdgcn_readfirstlane(tid >> 6);
  float* imp = (float*)ldsraw + wave * 2112;
  lds_u8* tiles = (lds_u8*)ldsraw;
  bf16x8* qlds = (bf16x8*)(ldsraw + 69632 + wave * 8192);
  unsigned* misc = (unsigned*)(ldsraw + 135168);
  float* scr = WSP(float, OFF_SCR) + (size_t)(bidx() * NWAVES + wave) * 4096;
  const int myx = (int)(xb_xcc_id() & 7u);
  constexpr int QUNITS = 192;
  for (int qq = 0; qq < 8; ++qq) {
    const int x = (myx + qq) & 7;
    unsigned* ctr = WSP(unsigned, OFF_CTL) + cidx * 8 + x;
    for (;;) {
      __syncthreads();
      if (tid == 0) misc[0] = atomicAdd(ctr, 1u);
      if (tid >= 4 && tid < 8) misc[tid] = 0u;
      __syncthreads();
      const int u = __builtin_amdgcn_readfirstlane((int)misc[0]);
      if (u >= QUNITS) break;
      if (u < 128) {
        const int g4 = u >> 3, w = u & 7;
        if (w < 4) { const int bh = 4 * x + w; fox_wg_unit(p, l, bh >> 3, bh & 7, 15 - g4, tiles, st); }
        else nsa_wg_unit(p, x >> 1, x & 1, 63 - (4 * g4 + (w - 4)), imp, qlds, scr, tiles, misc, st);
      } else {
        const int mu = u - 128, bh = 2 * x + (mu >> 5), qblk = mu & 31;
        mem_unit(p, l, bh >> 2, bh & 3, 256 * qblk + 32 * wave, st);
      }
    }
  }
}

__global__ void __launch_bounds__(NTHREADS) hybrid_megakernel(Params p) {
  cg::grid_group grid = cg::this_grid();
  extern __shared__ __attribute__((aligned(16))) unsigned char dynlds[];
  float* smem = (float*)dynlds;
  PG8_LAS unsigned char* glds = (PG8_LAS unsigned char*)dynlds;
  volatile LAS unsigned* bst = (volatile LAS unsigned*)(glds + 135168 + 64);
  if (threadIdx.x < 2) bst[threadIdx.x] = 0u;
  __syncthreads();
  grid.sync();
  const XcdBarrier xbar = xcd_barrier_post(WSP(unsigned, OFF_BAR), bst);
  unsigned long long pr_acc = 0ull, pr_t0 = 0ull;
#pragma unroll 1
  for (int ph = 0; ph < 28; ++ph) {
    const int l = ph / 7, k = ph - 7 * l;
    if (PROBE_PHASE >= 0 && k == PROBE_PHASE) pr_t0 = __builtin_amdgcn_s_memrealtime();
    if (k == 0) {
      phase_prep(p, l, smem);
    } else if (k == 1) {
      EpiIn E{&p, l};
      for (int rp = 0; rp < (PROBE_GEMM2 ? (p.ws != nullptr ? 2 : 1) : 1); ++rp)
        run_gemm(glds, WSP(bf16_t, OFF_H), WSP(bf16_t, OFF_W_IN), M, 5120, 1024, E);
      EpiMemKV E2{&p};
      run_gemm(glds, WSP(bf16_t, OFF_MEMN), WSP(bf16_t, OFF_W_MKV), 1024, 1024, 1024, E2);
    } else if (k == 2) {
      phase_mid(p, l);
    } else if (k == 3) {
      const int nrep = PROBE_ATTN2 ? (p.ws != nullptr ? 2 : 1) : 1;
      for (int rp = 0; rp < nrep; ++rp) {
        const bool last = (rp == nrep - 1);
        if (rp) xcd_barrier(xbar);
        phase_attn(p, l, dynlds, last, last ? l : 4 + l);
      }
    } else if (k == 4) {
      EpiGate E{WSP(bf16_t, OFF_G)};
      for (int rp = 0; rp < (PROBE_GEMM2 ? (p.ws != nullptr ? 2 : 1) : 1); ++rp)
        run_gemm(glds, WSP(bf16_t, OFF_H), WSP(bf16_t, OFF_W_G), M, 3072, 1024, E);
    } else if (k == 5) {
      for (int rp = 0; rp < (PROBE_BR2 ? (p.ws != nullptr ? 2 : 1) : 1); ++rp) {
      EpiBranch Ea{WSP(bf16_t, OFF_G), WSP(bf16_t, OFF_U), 1};
      run_gemm(glds, WSP(bf16_t, OFF_OA), WSP(bf16_t, OFF_W_BR), M, 1024, 512, Ea);
      EpiBranch Eb{WSP(bf16_t, OFF_G) + (size_t)M * 1024, WSP(bf16_t, OFF_U), 0};
      run_gemm(glds, WSP(bf16_t, OFF_OB), WSP(bf16_t, OFF_W_BR + MiB), M, 1024, 512, Eb);
      EpiBranch Ec{WSP(bf16_t, OFF_G) + (size_t)2 * M * 1024, WSP(bf16_t, OFF_U), 0};
      run_gemm(glds, WSP(bf16_t, OFF_OM), WSP(bf16_t, OFF_W_BR + 2 * MiB), M, 1024, 512, Ec);
      }
    } else {
      EpiOut E{l == 0 ? p.x : p.out, p.out};
      run_gemm(glds, WSP(bf16_t, OFF_U), WSP(bf16_t, OFF_W_OUT), M, 1024, 1024, E);
    }
    xcd_barrier(xbar);
    if (PROBE_PHASE >= 0 && k == PROBE_PHASE) pr_acc += __builtin_amdgcn_s_memrealtime() - pr_t0;
  }
  if (PROBE_PHASE >= 0 && blockIdx.x == 0) {
    const unsigned long long ts = __builtin_amdgcn_s_memrealtime();
    while (__builtin_amdgcn_s_memrealtime() - ts < pr_acc) __builtin_amdgcn_s_sleep(8);
  }
}

extern "C" void kernel_launch(void* const* d_in, const int* in_sizes, int n_in, void* d_out, int out_size, void* d_ws,
                              size_t ws_size, hipStream_t stream) {
  static int grid_blocks = 0;
  if (!grid_blocks) {
    int dev = 0, cus = 0, per_cu = 0;
    (void)hipGetDevice(&dev);
    (void)hipDeviceGetAttribute(&cus, hipDeviceAttributeMultiprocessorCount, dev);
    if (hipFuncSetAttribute((const void*)hybrid_megakernel, hipFuncAttributeMaxDynamicSharedMemorySize, LDS_BYTES) != hipSuccess)
      fprintf(stderr, "hipFuncSetAttribute(dynamic LDS %d) failed\n", LDS_BYTES);
    (void)hipOccupancyMaxActiveBlocksPerMultiprocessor(&per_cu, hybrid_megakernel, NTHREADS, LDS_BYTES);
    (void)hipGetLastError();
    grid_blocks = cus;
    if (grid_blocks > 256) grid_blocks = 256;
    if (ws_size < OFF_SCR + (size_t)32 * MiB) fprintf(stderr, "workspace too small: %zu\n", ws_size);
  }
  Params p{};
  const float** pp = (const float**)&p;
  for (int i = 0; i < 23; ++i) pp[i] = (const float*)d_in[i];
  p.out = (float*)d_out;
  p.ws = (char*)d_ws;
  void* args[] = {&p};
  (void)hipMemsetAsync((char*)d_ws + OFF_BAR, 0, XCD_BAR_WORDS * sizeof(unsigned), stream);
  hipError_t e = hipLaunchCooperativeKernel((void*)hybrid_megakernel, dim3(grid_blocks), dim3(NTHREADS), args, LDS_BYTES, stream);
  if (e != hipSuccess) fprintf(stderr, "cooperative launch failed: %s (grid %d)\n", hipGetErrorString(e), grid_blocks);
}
```

```cpp
#include <hip/hip_runtime.h>
#include <hip/hip_cooperative_groups.h>
#include <stdint.h>
#include <cstdio>
namespace cg = cooperative_groups;
#ifndef PROBE_ATTN2
#define PROBE_ATTN2 0
#endif
#ifndef PROBE_PM2
#define PROBE_PM2 0
#endif
#ifndef PROBE_PHASE
#define PROBE_PHASE -1
#endif
#ifndef PROBE_BR2
#define PROBE_BR2 0
#endif
#ifndef PROBE_GEMM2
#define PROBE_GEMM2 0
#endif


typedef unsigned short bf16_t;
typedef short bf16x8 __attribute__((ext_vector_type(8)));
typedef float f32x4 __attribute__((ext_vector_type(4)));
typedef unsigned u32x2 __attribute__((ext_vector_type(2)));
typedef unsigned u32x4 __attribute__((ext_vector_type(4)));
typedef float f32x2_t __attribute__((ext_vector_type(2)));
typedef __bf16 bf16x2_t __attribute__((ext_vector_type(2)));

constexpr int NB = 4, T = 8192, M = NB * T;
constexpr int NTHREADS = 512, NWAVES = NTHREADS / 64;
constexpr int LDS_BYTES = 147456;
constexpr float EPS = 1e-6f;
constexpr float LOG2E = 1.4426950408889634f;
#define NEG_INF (-__builtin_inff())

constexpr size_t MiB = 1u << 20;
constexpr size_t OFF_CTL = 0;
constexpr size_t OFF_BAR = 64 * 1024;
constexpr size_t OFF_ROPE = 1 * MiB;
constexpr size_t OFF_W_IN = 3 * MiB;
constexpr size_t OFF_W_G = 13 * MiB;
constexpr size_t OFF_W_MKV = 19 * MiB;
constexpr size_t OFF_W_BR = 21 * MiB;
constexpr size_t OFF_W_OUT = 24 * MiB;
constexpr size_t OFF_W1 = 26 * MiB;
constexpr size_t OFF_W2 = 27 * MiB;
constexpr size_t OFF_C1 = 27 * MiB + 256 * 1024;
constexpr size_t OFF_MEMN = 28 * MiB;
constexpr size_t OFF_MK = 30 * MiB;
constexpr size_t OFF_MVT = 31 * MiB;
constexpr size_t OFF_H = 32 * MiB;
constexpr size_t OFF_U = OFF_H;
constexpr size_t OFF_OA = 96 * MiB;
constexpr size_t OFF_OB = 128 * MiB;
constexpr size_t OFF_OM = 160 * MiB;
constexpr size_t OFF_QN = 192 * MiB;
constexpr size_t OFF_G = 192 * MiB;
constexpr size_t OFF_KC = 224 * MiB;
constexpr size_t OFF_VC = 232 * MiB;
constexpr size_t OFF_KS = 240 * MiB;
constexpr size_t OFF_VST = 248 * MiB;
constexpr size_t OFF_KW = 256 * MiB;
constexpr size_t OFF_VWT = 264 * MiB;
constexpr size_t OFF_FQ = 272 * MiB;
constexpr size_t OFF_FK = 304 * MiB;
constexpr size_t OFF_FVT = 336 * MiB;
constexpr size_t OFF_MQ = 368 * MiB;
constexpr size_t OFF_GATE = 400 * MiB;
constexpr size_t OFF_FLOG = 403 * MiB;
constexpr size_t OFF_FC = 404 * MiB;
constexpr size_t OFF_KCMP = 405 * MiB;
constexpr size_t OFF_VCT = 405 * MiB + 512 * 1024;
constexpr size_t OFF_SCR = 406 * MiB;

struct Params {
  const float *x, *mem, *norm_g, *mem_norm_g, *w_in, *nsa_q_norm, *nsa_k_norm, *cmp_pe_k, *cmp_w1_k, *cmp_w2_k,
      *cmp_pe_v, *cmp_w1_v, *cmp_w2_v, *fox_q_norm, *fox_k_norm, *fox_f_bias, *mem_q_norm, *mem_k_norm, *w_mem_kv,
      *w_branch_a, *w_branch_b, *w_branch_m, *w_out;
  float* out;
  char* ws;
};
__device__ __forceinline__ char* ws_base(char* w) {
  unsigned lo = __builtin_amdgcn_readfirstlane((unsigned)(uintptr_t)w), hi = __builtin_amdgcn_readfirstlane((unsigned)((uintptr_t)w >> 32));
  asm volatile("" : "+s"(lo), "+s"(hi));
  return (char*)(__attribute__((address_space(1))) char*)(((uintptr_t)hi << 32) | (uintptr_t)lo);
}
#define WSP(TYPE, off) ((TYPE*)(ws_base(p.ws) + (off)))

__constant__ float c_inv_freq[32] = {
    1.000000000e+00f, 7.498942018e-01f, 5.623413324e-01f, 4.216965139e-01f, 3.162277639e-01f, 2.371373773e-01f,
    1.778279394e-01f, 1.333521456e-01f, 1.000000015e-01f, 7.498942316e-02f, 5.623413250e-02f, 4.216964915e-02f,
    3.162277490e-02f, 2.371373773e-02f, 1.778279431e-02f, 1.333521400e-02f, 9.999999776e-03f, 7.498942316e-03f,
    5.623413250e-03f, 4.216964822e-03f, 3.162277630e-03f, 2.371373819e-03f, 1.778279431e-03f, 1.333521446e-03f,
    1.000000047e-03f, 7.498941850e-04f, 5.623413017e-04f, 4.216965172e-04f, 3.162277571e-04f, 2.371373703e-04f,
    1.778279402e-04f, 1.333521504e-04f};

__device__ __forceinline__ int bidx() { int b = blockIdx.x; asm volatile("" : "+s"(b)); return b; }
__device__ __forceinline__ int gdim() { int g = gridDim.x; asm volatile("" : "+s"(g)); return g; }
__device__ __forceinline__ int tidx() { int t = threadIdx.x; asm volatile("" : "+v"(t)); return t; }
__device__ __forceinline__ unsigned cvtpk(float lo, float hi) {
  f32x2_t v = {lo, hi};
  bf16x2_t b = __builtin_convertvector(v, bf16x2_t);
  return __builtin_bit_cast(unsigned, b);
}
__device__ __forceinline__ float bf2f(unsigned short v) { return __uint_as_float(((unsigned)v) << 16); }
__device__ __forceinline__ float bflo(unsigned w) { return __uint_as_float(w << 16); }
__device__ __forceinline__ float bfhi(unsigned w) { return __uint_as_float(w & 0xffff0000u); }
__device__ __forceinline__ f32x4 mfma16(bf16x8 a, bf16x8 b, f32x4 c) {
  return __builtin_amdgcn_mfma_f32_16x16x32_bf16(a, b, c, 0, 0, 0);
}
__device__ __forceinline__ bf16x8 pack8(f32x4 a, f32x4 b) {
  u32x4 w = {cvtpk(a[0], a[1]), cvtpk(a[2], a[3]), cvtpk(b[0], b[1]), cvtpk(b[2], b[3])};
  return __builtin_bit_cast(bf16x8, w);
}
__device__ __forceinline__ float sigmoidf_(float v) { return 1.0f / (1.0f + __expf(-v)); }
__device__ __forceinline__ float siluf_(float v) { return v / (1.0f + __expf(-v)); }
__device__ __forceinline__ float grp_max4(float v) {
  auto a = __builtin_amdgcn_permlane32_swap(__float_as_uint(v), __float_as_uint(v), false, false);
  v = fmaxf(__uint_as_float(a[0]), __uint_as_float(a[1]));
  auto b = __builtin_amdgcn_permlane16_swap(__float_as_uint(v), __float_as_uint(v), false, false);
  return fmaxf(__uint_as_float(b[0]), __uint_as_float(b[1]));
}
__device__ __forceinline__ float wave_sum(float v) {
#pragma unroll
  for (int o = 1; o < 64; o <<= 1) v += __shfl_xor(v, o);
  return v;
}

#define LAS __attribute__((address_space(3)))
#define XB_TMO      128
#define XB_XCNT(j)  (256  + 64 * (j))
#define XB_XSUB(j)  (1280 + 64 * (j))
#define XB_XGEN(j)  (2304 + 64 * (j))
#define XB_TOP      3328
#define XB_TOPGEN   3392
#define XCD_BAR_WORDS 3456
#define XB_SPIN_CAP (1u << 18)

__device__ __forceinline__ unsigned xb_ld(unsigned* p)              { return __hip_atomic_load(p, __ATOMIC_RELAXED, __HIP_MEMORY_SCOPE_AGENT); }
__device__ __forceinline__ unsigned xb_add(unsigned* p, unsigned v) { return __hip_atomic_fetch_add(p, v, __ATOMIC_RELAXED, __HIP_MEMORY_SCOPE_AGENT); }
__device__ __forceinline__ unsigned xb_xcc_id() { return (unsigned)__builtin_amdgcn_s_getreg((3 << 11) | 20) & 0xFu; }
#define XB_SPIN(cond, bar) do { unsigned _sp = 0; while (cond) { __builtin_amdgcn_s_sleep(1); \
    if ((++_sp & 255u) == 0u) { if (xb_ld(&(bar)[XB_TMO])) break; if (_sp > XB_SPIN_CAP) { atomicAdd(&(bar)[XB_TMO], 1u); break; } } } } while (0)

struct XcdBarrier {
    unsigned* bar; unsigned x;
    volatile LAS unsigned* st;
};

__device__ __forceinline__ XcdBarrier xcd_barrier_post(unsigned* bar, volatile LAS unsigned* st) {
    XcdBarrier b; b.bar = bar; b.x = xb_xcc_id(); b.st = st;
    if (threadIdx.x == 0) (void)xb_add(&bar[XB_XCNT(b.x)], 1u);
    return b;
}
__device__ __forceinline__ void xcd_barrier_complete(unsigned* bar, unsigned x, unsigned& nloc, unsigned& nx) {
    const unsigned G = gridDim.x * gridDim.y * gridDim.z;
    unsigned sum, cnt, mine, sp = 0u;
    for (;;) {
        sum = 0u; cnt = 0u; mine = 0u;
#pragma unroll
        for (unsigned j = 0; j < 16; ++j) { const unsigned c = xb_ld(&bar[XB_XCNT(j)]); sum += c; cnt += (c > 0u) ? 1u : 0u; mine = (j == x) ? c : mine; }
        if (sum == G) break;
        __builtin_amdgcn_s_sleep(1);
        if ((++sp & 255u) == 0u) { if (xb_ld(&bar[XB_TMO])) break; if (sp > XB_SPIN_CAP) { atomicAdd(&bar[XB_TMO], 1u); break; } }
    }
    nloc = mine > 0u ? mine : 1u; nx = cnt > 0u ? cnt : 1u;
}

__device__ __forceinline__ void xcd_barrier(const XcdBarrier& b) {
    asm volatile("s_waitcnt vmcnt(0)" ::: "memory");
    __syncthreads();
    if (threadIdx.x == 0) {
        unsigned* bar = b.bar;
        __builtin_amdgcn_s_waitcnt(0);
        unsigned nloc = b.st[0], nx = b.st[1];
        if (nloc == 0u) { xcd_barrier_complete(bar, b.x, nloc, nx); b.st[0] = nloc; b.st[1] = nx; }
        const unsigned old = xb_add(&bar[XB_XSUB(b.x)], 1u);
        const unsigned gen = old / nloc;
        if (old + 1u == (gen + 1u) * nloc) {
            __builtin_amdgcn_fence(__ATOMIC_RELEASE, "agent");
            asm volatile("s_waitcnt vmcnt(0)" ::: "memory");
            const unsigned og = xb_add(&bar[XB_TOP], 1u);
            const unsigned tg = og / nx;
            if (og + 1u == (tg + 1u) * nx) xb_add(&bar[XB_TOPGEN], 1u);
            else XB_SPIN(xb_ld(&bar[XB_TOPGEN]) == tg, bar);
            __builtin_amdgcn_fence(__ATOMIC_ACQUIRE, "agent");
            xb_add(&bar[XB_XGEN(b.x)], 1u);
            asm volatile("s_waitcnt vmcnt(0)" ::: "memory");
        } else {
            XB_SPIN(xb_ld(&bar[XB_XGEN(b.x)]) == gen, bar);
            __builtin_amdgcn_fence(__ATOMIC_ACQUIRE, "agent");
            asm volatile("s_waitcnt vmcnt(0)" ::: "memory");
        }
    }
    __syncthreads();
}


namespace pg8 {
#define PG8_LAS __attribute__((address_space(3)))
typedef unsigned short bf16_t;
typedef short bf16x8 __attribute__((ext_vector_type(8)));
typedef float f32x4 __attribute__((ext_vector_type(4)));
typedef unsigned u32x4 __attribute__((ext_vector_type(4)));
constexpr int BM = 256, BK = 64, HALF = 128, HTB = HALF * BK * 2  , STAGE_BYTES = 8 * HTB, NXCD = 8, WGM = 8;

__host__ __device__ __forceinline__ int lds_byte(int r, int c) { const int st = (r >> 4) * 2 + (c >> 5), rr = r & 15, cc = c & 31, ob = rr * 64 + cc * 2; return st * 1024 + (ob ^ (((ob >> 9) & 1) << 5)); }
__host__ __device__ __forceinline__ void stage_rc(int b, int& R, int& C) { const int st = b / 1024, sb = b % 1024, swz = sb ^ (((sb >> 9) & 1) << 5); R = (st >> 1) * 16 + swz / 64; C = (st & 1) * 32 + (swz % 64) / 2; }
__host__ __device__ __forceinline__ int perm32(int rho) { const int n = rho >> 4, i = rho & 15; return 8 * (i >> 2) + 4 * n + (i & 3); }

struct Unit { int pm, pn; };
struct Gemm { const bf16_t* A; const bf16_t* Bt; int M, N, K; };

struct StaticOrder {
    int nM, nN, nwg, G, c;
    __host__ __device__ void init(int M, int N, int G_, int c_) { nM = M / BM; nN = N / BM; nwg = nM * nN; G = G_; c = c_; }
    __host__ __device__ bool next(int i, Unit& u) const {
        const long L = (long)i * G + c; if (L >= nwg) return false;
        int wgid = (int)L; { const int q = nwg / NXCD, r = nwg % NXCD, xcd = wgid % NXCD, off = wgid / NXCD; wgid = (xcd < r ? xcd * (q + 1) : r * (q + 1) + (xcd - r) * q) + off; }
        const int nig = WGM * nN, gid = wgid / nig, fm = gid * WGM, gsz = (nM - fm) < WGM ? (nM - fm) : WGM;
        u.pm = fm + ((wgid % nig) % gsz); u.pn = (wgid % nig) / gsz; return true;
    }
    __device__ __forceinline__ void a_ready(const Unit&) const {}
    __device__ __forceinline__ void done(const Unit&) const {}
};
__device__ __forceinline__ unsigned cvt_pk_bf16(float lo, float hi) { unsigned r; asm volatile("v_cvt_pk_bf16_f32 %0, %1, %2" : "=v"(r) : "v"(lo), "v"(hi)); return r; }
template <class Epi, class Sched, bool ALIGN_EPI = false, bool SP2 = false>
__device__ __forceinline__ void gemm_phase(PG8_LAS unsigned char* lds, const Gemm g, const Sched& S, const Epi& E) {
    const int tid = tidx(), wid = __builtin_amdgcn_readfirstlane(tid >> 6), lane = tid & 63, wr = wid >> 2, wc = wid & 3, fr = lane & 15, fq = lane >> 4;
    const int K = g.K, nt = K / BK;
    unsigned voffA[2], voffB[2];
#pragma unroll
    for (int i = 0; i < 2; ++i) { int R, C; stage_rc(tid * 16 + i * 8192, R, C); const int Rb = Epi::PERM ? ((R & ~31) + perm32(R & 31)) : R;
        voffA[i] = (unsigned)(R * K + C) * 2u; voffB[i] = (unsigned)(Rb * K + C) * 2u; }
    const size_t kstep = (size_t)(BK * 2);
    const size_t hstep = (size_t)HALF * K * 2;
    const size_t tstep = 2 * hstep;
    const unsigned ldsw = (unsigned)wid * 1024u;
    const int aoff = lds_byte(wr * 64 + fr, fq * 8), boff = lds_byte(wc * 32 + fr, fq * 8);
#define PG8_SA(b, h) (((b) * 2 + (h)) * HTB)
#define PG8_SB(b, h) ((4 + (b) * 2 + (h)) * HTB)
#define PG8_STAGE(bufoff, gbase, voff) do { _Pragma("unroll") for (int _i = 0; _i < 2; ++_i) \
        __builtin_amdgcn_global_load_lds((const unsigned*)((const char*)(gbase) + (voff)[_i]), (PG8_LAS unsigned*)(lds + (bufoff) + ldsw + _i * 8192), 16, 0, 0); } while (0)
#define PG8_LDA(dst, b, h) do { _Pragma("unroll") for (int m = 0; m < 4; ++m) _Pragma("unroll") for (int k = 0; k < 2; ++k) dst[m][k] = *(const PG8_LAS bf16x8*)(lds + PG8_SA(b, h) + aoff + m * 2048 + k * 1024); } while (0)
#define PG8_LDB(dst, b, h) do { _Pragma("unroll") for (int n = 0; n < 2; ++n) _Pragma("unroll") for (int k = 0; k < 2; ++k) dst[n][k] = *(const PG8_LAS bf16x8*)(lds + PG8_SB(b, h) + boff + n * 2048 + k * 1024); } while (0)
#define PG8_MMA(ai, bj, At, Bt) do { __builtin_amdgcn_s_setprio(1); _Pragma("unroll") for (int m = 0; m < 4; ++m) _Pragma("unroll") for (int n = 0; n < 2; ++n) _Pragma("unroll") for (int k = 0; k < 2; ++k) \
        acc[ai][bj][m][n] = __builtin_amdgcn_mfma_f32_16x16x32_bf16(Bt[n][k], At[m][k], acc[ai][bj][m][n], 0, 0, 0); __builtin_amdgcn_s_setprio(0); } while (0)
#define PG8_WAIT_V(n) asm volatile("s_waitcnt vmcnt(" #n ")" ::: "memory")
#define PG8_WAIT_L(n) asm volatile("s_waitcnt lgkmcnt(" #n ")" ::: "memory")
#define PG8_BAR __builtin_amdgcn_s_barrier()
#define PG8_SCHED __builtin_amdgcn_sched_barrier(0)
    Unit cur, nxt; int ui = 0;
    if (!S.next(0, cur)) return;
    f32x4 acc[2][2][4][2];
#pragma unroll
    for (int a = 0; a < 2; ++a)
#pragma unroll
        for (int b = 0; b < 2; ++b)
#pragma unroll
            for (int m = 0; m < 4; ++m)
#pragma unroll
                for (int n = 0; n < 2; ++n) acc[a][b][m][n] = (f32x4){0.f, 0.f, 0.f, 0.f};
    bf16x8 At[4][2], B0[2][2], B1[2][2];
    const char* cA = (const char*)g.A + (size_t)cur.pm * tstep; const char* cB = (const char*)g.Bt + (size_t)cur.pn * tstep;
    S.a_ready(cur);
    if constexpr (SP2) {
        PG8_STAGE(PG8_SB(0, 0), cB, voffB); PG8_STAGE(PG8_SB(0, 1), cB + hstep, voffB); PG8_STAGE(PG8_SA(0, 0), cA, voffA); PG8_STAGE(PG8_SA(0, 1), cA + hstep, voffA);
        if (wr == 1) PG8_BAR;
        PG8_WAIT_V(2); PG8_BAR;
        PG8_STAGE(PG8_SB(1, 0), cB + kstep, voffB); PG8_STAGE(PG8_SA(1, 0), cA + kstep, voffA); PG8_STAGE(PG8_SB(1, 1), cB + hstep + kstep, voffB);
        PG8_WAIT_V(6); PG8_BAR;
    } else {
        PG8_STAGE(PG8_SB(0, 0), cB, voffB); PG8_STAGE(PG8_SA(0, 0), cA, voffA); PG8_STAGE(PG8_SB(0, 1), cB + hstep, voffB); PG8_STAGE(PG8_SA(0, 1), cA + hstep, voffA);
        if (wr == 1) PG8_BAR;
        PG8_WAIT_V(4); PG8_BAR;
        PG8_STAGE(PG8_SB(1, 0), cB + kstep, voffB); PG8_STAGE(PG8_SA(1, 0), cA + kstep, voffA); PG8_STAGE(PG8_SB(1, 1), cB + hstep + kstep, voffB);
        PG8_WAIT_V(6); PG8_BAR;
    }
    for (;;) {
        const bool has_next = S.next(ui + 1, nxt);
        const char* nA = has_next ? (const char*)g.A + (size_t)nxt.pm * tstep : cA; const char* nB = has_next ? (const char*)g.Bt + (size_t)nxt.pn * tstep : cB;
        for (int t = 0; t < nt; t += 2) {
            const bool last = (t == nt - 2);
            const char* a1 = cA + (size_t)(t + 1) * kstep;
            const char* a2 = last ? nA : cA + (size_t)(t + 2) * kstep; const char* b2 = last ? nB : cB + (size_t)(t + 2) * kstep;
            const char* a3 = a2 + kstep; const char* b3 = b2 + kstep;
            if (last && has_next) S.a_ready(nxt);
            if constexpr (SP2) {
            PG8_LDB(B0, 0, 0); PG8_LDB(B1, 0, 1); PG8_SCHED; PG8_LDA(At, 0, 0); PG8_STAGE(PG8_SA(1, 1), a1 + hstep, voffA);
            PG8_WAIT_V(8); PG8_WAIT_L(0); PG8_BAR; PG8_MMA(0, 0, At, B0); PG8_MMA(0, 1, At, B1); PG8_BAR; PG8_SCHED;
            PG8_LDA(At, 0, 1); PG8_STAGE(PG8_SB(0, 0), b2, voffB); PG8_STAGE(PG8_SB(0, 1), b2 + hstep, voffB); PG8_STAGE(PG8_SA(0, 0), a2, voffA);
            PG8_WAIT_V(8); PG8_WAIT_L(0); PG8_BAR; PG8_MMA(1, 0, At, B0); PG8_MMA(1, 1, At, B1); PG8_BAR; PG8_SCHED;
            PG8_LDB(B0, 1, 0); PG8_LDB(B1, 1, 1); PG8_SCHED; PG8_LDA(At, 1, 0); PG8_STAGE(PG8_SA(0, 1), a2 + hstep, voffA);
            PG8_WAIT_V(8); PG8_WAIT_L(0); PG8_BAR; PG8_MMA(0, 0, At, B0); PG8_MMA(0, 1, At, B1); PG8_BAR; PG8_SCHED;
            PG8_LDA(At, 1, 1); PG8_STAGE(PG8_SB(1, 0), b3, voffB); PG8_STAGE(PG8_SB(1, 1), b3 + hstep, voffB); PG8_STAGE(PG8_SA(1, 0), a3, voffA);
            PG8_WAIT_V(8); PG8_WAIT_L(0); PG8_BAR; PG8_MMA(1, 0, At, B0); PG8_MMA(1, 1, At, B1); PG8_BAR; PG8_SCHED;
            } else {
            PG8_LDB(B0, 0, 0); PG8_SCHED; PG8_LDA(At, 0, 0); PG8_STAGE(PG8_SA(1, 1), a1 + hstep, voffA);
            PG8_WAIT_L(8); PG8_BAR; PG8_WAIT_L(0); PG8_MMA(0, 0, At, B0); PG8_BAR; PG8_SCHED;
            PG8_LDB(B1, 0, 1); PG8_STAGE(PG8_SB(0, 0), b2, voffB);
            PG8_BAR; PG8_WAIT_L(0); PG8_MMA(0, 1, At, B1); PG8_BAR;
            PG8_LDA(At, 0, 1); PG8_STAGE(PG8_SA(0, 0), a2, voffA);
            PG8_BAR; PG8_WAIT_L(0); PG8_MMA(1, 0, At, B0); PG8_BAR; PG8_SCHED;
            PG8_STAGE(PG8_SB(0, 1), b2 + hstep, voffB);
            PG8_WAIT_V(6); PG8_BAR; PG8_MMA(1, 1, At, B1); PG8_BAR;
            PG8_LDB(B0, 1, 0); PG8_SCHED; PG8_LDA(At, 1, 0); PG8_STAGE(PG8_SA(0, 1), a2 + hstep, voffA);
            PG8_WAIT_L(8); PG8_BAR; PG8_WAIT_L(0); PG8_MMA(0, 0, At, B0); PG8_BAR; PG8_SCHED;
            PG8_LDB(B1, 1, 1); PG8_STAGE(PG8_SB(1, 0), b3, voffB);
            PG8_BAR; PG8_WAIT_L(0); PG8_MMA(0, 1, At, B1); PG8_BAR;
            PG8_LDA(At, 1, 1); PG8_STAGE(PG8_SA(1, 0), a3, voffA);
            PG8_BAR; PG8_WAIT_L(0); PG8_MMA(1, 0, At, B0); PG8_BAR; PG8_SCHED;
            PG8_STAGE(PG8_SB(1, 1), b3 + hstep, voffB);
            PG8_WAIT_V(6); PG8_BAR; PG8_MMA(1, 1, At, B1); PG8_BAR;
            }
        }
        if constexpr (ALIGN_EPI) { if (wr == 0) PG8_BAR; }
        if constexpr (!Epi::AFTER_DRAIN) { E(acc, cur, wr, wc, fr, fq); S.done(cur); }
        if (!has_next) break;
#pragma unroll
        for (int a = 0; a < 2; ++a)
#pragma unroll
            for (int b = 0; b < 2; ++b)
#pragma unroll
                for (int m = 0; m < 4; ++m)
#pragma unroll
                    for (int n = 0; n < 2; ++n) acc[a][b][m][n] = (f32x4){0.f, 0.f, 0.f, 0.f};
        cur = nxt; cA = nA; cB = nB; ++ui;
        if constexpr (ALIGN_EPI) { if (wr == 1) PG8_BAR; }
    }
    PG8_WAIT_V(0);
    if constexpr (!ALIGN_EPI) { if (wr == 0) PG8_BAR; }
    PG8_BAR;
    if constexpr (Epi::AFTER_DRAIN) { E.fused(acc, cur, wr, wc, fr, fq, lds, wid, lane); S.done(cur); }
#undef PG8_SA
#undef PG8_SB
#undef PG8_STAGE
#undef PG8_LDA
#undef PG8_LDB
#undef PG8_MMA
#undef PG8_WAIT_V
#undef PG8_WAIT_L
#undef PG8_BAR
#undef PG8_SCHED
}
}

struct EpiIn {
  static constexpr bool PERM = false, AFTER_DRAIN = false;
  const Params* pp; int l;
  __device__ __forceinline__ void operator()(f32x4 (&acc)[2][2][4][2], const pg8::Unit& u, int wr, int wc, int fr, int fq) const {
    const Params& p = *pp;
    const int U = u.pn * 4 + wc;
    if (U >= 77) return;
    const int rowb = u.pm * 256 + wr * 64 + fr;
    const int bq = (u.pm * 256) / T, tb = rowb % T;
    bf16_t* dst = nullptr; int ld = 0, col0 = 0; const float* gain = nullptr; bool rope = false, silu = false;
    float post = 1.0f;
    bf16_t* vt = nullptr;
    if (U < 8) { dst = WSP(bf16_t, OFF_QN); ld = 512; col0 = U * 64; gain = p.nsa_q_norm + l * 64; rope = true; post = 0.125f * LOG2E; }
    else if (U < 10) { dst = WSP(bf16_t, OFF_KC); ld = 128; col0 = (U - 8) * 64; rope = true; }
    else if (U < 12) { dst = WSP(bf16_t, OFF_VC); ld = 128; col0 = (U - 10) * 64; }
    else if (U < 14) { dst = WSP(bf16_t, OFF_KS); ld = 128; col0 = (U - 12) * 64; gain = p.nsa_k_norm + (l * 3 + 1) * 64; rope = true; }
    else if (U < 16) { vt = WSP(bf16_t, OFF_VST) + (size_t)((bq * 2 + (U - 14)) * 64) * T; }
    else if (U < 18) { dst = WSP(bf16_t, OFF_KW); ld = 128; col0 = (U - 16) * 64; gain = p.nsa_k_norm + (l * 3 + 2) * 64; rope = true; }
    else if (U < 20) { vt = WSP(bf16_t, OFF_VWT) + (size_t)((bq * 2 + (U - 18)) * 64) * T; }
    else if (U < 28) { dst = WSP(bf16_t, OFF_OA); ld = 512; col0 = (U - 20) * 64; silu = true; }
    else if (U < 36) { dst = WSP(bf16_t, OFF_FQ); ld = 512; col0 = (U - 28) * 64; gain = p.fox_q_norm + l * 64; post = 0.125f * LOG2E; }
    else if (U < 44) { dst = WSP(bf16_t, OFF_FK); ld = 512; col0 = (U - 36) * 64; gain = p.fox_k_norm + l * 64; }
    else if (U < 52) { vt = WSP(bf16_t, OFF_FVT) + (size_t)((bq * 8 + (U - 44)) * 64) * T; }
    else if (U < 60) { dst = WSP(bf16_t, OFF_OB); ld = 512; col0 = (U - 52) * 64; silu = true; }
    else if (U < 68) { dst = WSP(bf16_t, OFF_MQ); ld = 512; col0 = (U - 60) * 64; }
    else if (U < 76) { dst = WSP(bf16_t, OFF_OM); ld = 512; col0 = (U - 68) * 64; silu = true; }
    if (U == 76) {
      float* gate = WSP(float, OFF_GATE);
      float* flog = WSP(float, OFF_FLOG);
#pragma unroll
      for (int ai = 0; ai < 2; ++ai)
#pragma unroll
        for (int m = 0; m < 4; ++m) {
          const size_t row = (size_t)rowb + 128 * ai + 16 * m;
#pragma unroll
          for (int n = 0; n < 2; ++n)
#pragma unroll
            for (int i = 0; i < 4; ++i) {
              const int e = 16 * n + 4 * fq + i;
              const float v = acc[ai][0][m][n][i];
              if (e < 24) gate[row * 24 + e] = sigmoidf_(v);
              else {
                const float xx = v + p.fox_f_bias[l * 8 + (e - 24)];
                flog[row * 8 + (e - 24)] = xx >= 0.f ? -log1pf(expf(-xx)) : xx - log1pf(expf(xx));
              }
            }
        }
      return;
    }
    if (vt) {
#pragma unroll
      for (int ai = 0; ai < 2; ++ai)
#pragma unroll
        for (int m = 0; m < 4; ++m) {
          const int t = tb + 128 * ai + 16 * m;
#pragma unroll
          for (int bj = 0; bj < 2; ++bj)
#pragma unroll
            for (int n = 0; n < 2; ++n) {
              const f32x4 v = acc[ai][bj][m][n];
              const unsigned w0 = cvtpk(v[0], v[1]), w1 = cvtpk(v[2], v[3]);
              const unsigned qo = (unsigned)((32 * bj + 16 * n + 4 * fq) * T + t);
              vt[qo] = (bf16_t)(w0 & 0xffffu); vt[qo + T] = (bf16_t)(w0 >> 16); vt[qo + 2 * T] = (bf16_t)(w1 & 0xffffu); vt[qo + 3 * T] = (bf16_t)(w1 >> 16);
            }
        }
      return;
    }
    const float* ropetab = WSP(float, OFF_ROPE);
    f32x4 gv[2][2];
    if (gain) {
#pragma unroll
      for (int bj = 0; bj < 2; ++bj)
#pragma unroll
        for (int n = 0; n < 2; ++n) gv[bj][n] = *(const f32x4*)(gain + 32 * bj + 16 * n + 4 * fq);
    }
#pragma unroll
    for (int ai = 0; ai < 2; ++ai)
#pragma unroll
      for (int m = 0; m < 4; ++m) {
        f32x4 v[2][2];
#pragma unroll
        for (int bj = 0; bj < 2; ++bj)
#pragma unroll
          for (int n = 0; n < 2; ++n) v[bj][n] = acc[ai][bj][m][n];
        const int row = rowb + 128 * ai + 16 * m;
        if (gain) {
          float ss = 0.f;
#pragma unroll
          for (int bj = 0; bj < 2; ++bj)
#pragma unroll
            for (int n = 0; n < 2; ++n)
#pragma unroll
              for (int i = 0; i < 4; ++i) ss += v[bj][n][i] * v[bj][n][i];
          ss += __shfl_xor(ss, 16);
          ss += __shfl_xor(ss, 32);
          const float rstd = rsqrtf(ss * (1.0f / 64.0f) + EPS);
#pragma unroll
          for (int bj = 0; bj < 2; ++bj)
#pragma unroll
            for (int n = 0; n < 2; ++n) v[bj][n] = v[bj][n] * rstd * gv[bj][n];
        }
        if (rope) {
          const int pos = row & (T - 1);
#pragma unroll
          for (int n = 0; n < 2; ++n) {
            const f32x4* tp = (const f32x4*)(ropetab + ((size_t)pos * 32 + 16 * n + 4 * fq) * 2);
            const f32x4 t0 = tp[0], t1 = tp[1];
            const float cs[4] = {t0[0], t0[2], t1[0], t1[2]}, sn[4] = {t0[1], t0[3], t1[1], t1[3]};
#pragma unroll
            for (int i = 0; i < 4; ++i) {
              const float y1 = v[0][n][i], y2 = v[1][n][i];
              v[0][n][i] = y1 * cs[i] - y2 * sn[i];
              v[1][n][i] = y2 * cs[i] + y1 * sn[i];
            }
          }
        }
#pragma unroll
        for (int bj = 0; bj < 2; ++bj)
#pragma unroll
          for (int n = 0; n < 2; ++n) {
            f32x4 y = v[bj][n] * post;
            if (silu) {
#pragma unroll
              for (int i = 0; i < 4; ++i) y[i] = siluf_(y[i]);
            }
            u32x2 w = {cvtpk(y[0], y[1]), cvtpk(y[2], y[3])};
            *(u32x2*)(dst + (size_t)row * ld + col0 + 32 * bj + 16 * n + 4 * fq) = w;
          }
      }
  }
};
struct EpiMemKV {
  static constexpr bool PERM = false, AFTER_DRAIN = false;
  const Params* pp;
  __device__ __forceinline__ void operator()(f32x4 (&acc)[2][2][4][2], const pg8::Unit& u, int wr, int wc, int fr, int fq) const {
    const Params& p = *pp;
    const int U = u.pn * 4 + wc;
    const int rowb = u.pm * 256 + wr * 64 + fr;
#pragma unroll
    for (int ai = 0; ai < 2; ++ai)
#pragma unroll
      for (int m = 0; m < 4; ++m) {
        const int row = rowb + 128 * ai + 16 * m;
#pragma unroll
        for (int bj = 0; bj < 2; ++bj)
#pragma unroll
          for (int n = 0; n < 2; ++n) {
            const f32x4 v = acc[ai][bj][m][n];
            const unsigned w0 = cvtpk(v[0], v[1]), w1 = cvtpk(v[2], v[3]);
            const int e = 32 * bj + 16 * n + 4 * fq;
            if (U < 8) {
              u32x2 w = {w0, w1};
              *(u32x2*)(WSP(bf16_t, OFF_MK) + (size_t)row * 512 + U * 64 + e) = w;
            } else {
              const int col = (U - 8) * 64 + e, h = col >> 7, d = col & 127, b = row >> 8, mm = row & 255;
              bf16_t* q = WSP(bf16_t, OFF_MVT) + (size_t)((b * 4 + h) * 128 + d) * 256 + mm;
              q[0] = (bf16_t)(w0 & 0xffffu); q[256] = (bf16_t)(w0 >> 16); q[512] = (bf16_t)(w1 & 0xffffu); q[768] = (bf16_t)(w1 >> 16);
            }
          }
      }
  }
};
struct EpiGate {
  static constexpr bool PERM = true, AFTER_DRAIN = false;
  bf16_t* G;
  __device__ __forceinline__ void operator()(f32x4 (&acc)[2][2][4][2], const pg8::Unit& u, int wr, int wc, int fr, int fq) const {
    const int br = u.pn >> 2, colt = (u.pn & 3) * 256 + wc * 32 + 8 * fq;
    bf16_t* base = G + (size_t)br * M * 1024;
    const int rowb = u.pm * 256 + wr * 64 + fr;
#pragma unroll
    for (int ai = 0; ai < 2; ++ai)
#pragma unroll
      for (int m = 0; m < 4; ++m) {
        bf16_t* rp = base + (size_t)(rowb + 128 * ai + 16 * m) * 1024 + colt;
#pragma unroll
        for (int bj = 0; bj < 2; ++bj) {
          const f32x4 v0 = acc[ai][bj][m][0], v1 = acc[ai][bj][m][1];
          u32x4 w = {cvtpk(sigmoidf_(v0[0]), sigmoidf_(v0[1])), cvtpk(sigmoidf_(v0[2]), sigmoidf_(v0[3])),
                     cvtpk(sigmoidf_(v1[0]), sigmoidf_(v1[1])), cvtpk(sigmoidf_(v1[2]), sigmoidf_(v1[3]))};
          *(u32x4*)(rp + 128 * bj) = w;
        }
      }
  }
};
struct EpiBranch {
  static constexpr bool PERM = true, AFTER_DRAIN = false;
  const bf16_t* G; bf16_t* Uo; int first;
  __device__ __forceinline__ void operator()(f32x4 (&acc)[2][2][4][2], const pg8::Unit& u, int wr, int wc, int fr, int fq) const {
    const int colt = u.pn * 256 + wc * 32 + 8 * fq;
    const int rowb = u.pm * 256 + wr * 64 + fr;
#pragma unroll
    for (int ai = 0; ai < 2; ++ai)
#pragma unroll
      for (int m = 0; m < 4; ++m) {
        const size_t ro = (size_t)(rowb + 128 * ai + 16 * m) * 1024 + colt;
#pragma unroll
        for (int bj = 0; bj < 2; ++bj) {
          const size_t off = ro + 128 * bj;
          const u32x4 gw = *(const u32x4*)(G + off);
          float y[8];
#pragma unroll
          for (int q = 0; q < 4; ++q) {
            const f32x4 v = acc[ai][bj][m][q >> 1];
            y[2 * q] = v[(2 * q) & 3] * bflo(gw[q]);
            y[2 * q + 1] = v[(2 * q + 1) & 3] * bfhi(gw[q]);
          }
          if (!first) {
            const u32x4 uw = *(const u32x4*)(Uo + off);
#pragma unroll
            for (int q = 0; q < 4; ++q) { y[2 * q] += bflo(uw[q]); y[2 * q + 1] += bfhi(uw[q]); }
          }
          u32x4 w = {cvtpk(y[0], y[1]), cvtpk(y[2], y[3]), cvtpk(y[4], y[5]), cvtpk(y[6], y[7])};
          *(u32x4*)(Uo + off) = w;
        }
      }
  }
};
struct EpiOut {
  static constexpr bool PERM = true, AFTER_DRAIN = false;
  const float* xin; float* xout;
  __device__ __forceinline__ void operator()(f32x4 (&acc)[2][2][4][2], const pg8::Unit& u, int wr, int wc, int fr, int fq) const {
    const int colt = u.pn * 256 + wc * 32 + 8 * fq;
    const int rowb = u.pm * 256 + wr * 64 + fr;
#pragma unroll
    for (int ai = 0; ai < 2; ++ai)
#pragma unroll
      for (int m = 0; m < 4; ++m) {
        const size_t ro = (size_t)(rowb + 128 * ai + 16 * m) * 1024 + colt;
#pragma unroll
        for (int bj = 0; bj < 2; ++bj) {
          const size_t off = ro + 128 * bj;
          const f32x4 x0 = *(const f32x4*)(xin + off), x1 = *(const f32x4*)(xin + off + 4);
          *(f32x4*)(xout + off) = x0 + acc[ai][bj][m][0];
          *(f32x4*)(xout + off + 4) = x1 + acc[ai][bj][m][1];
        }
      }
  }
};
template <class Epi>
__device__ __forceinline__ void run_gemm(PG8_LAS unsigned char* lds, const bf16_t* A, const bf16_t* Bt, int Mr, int Nc, int K, const Epi& E) {
  pg8::Gemm g{A, Bt, Mr, Nc, K};
  pg8::StaticOrder S;
  S.init(Mr, Nc, gdim(), bidx());
  pg8::gemm_phase<Epi, pg8::StaticOrder, true, true>(lds, g, S, E);
}

__device__ __forceinline__ int map_in(int n) {
  const int i = n >> 6, c = n & 63;
  if (i < 20) return n;
  if (i < 28) return 1304 + (n - 1280);
  if (i < 52) return 1816 + (n - 1792);
  if (i < 60) return 3360 + (n - 3328);
  if (i < 68) return 3872 + (n - 3840);
  if (i < 76) return 4384 + (n - 4352);
  if (i == 76) return c < 24 ? 1280 + c : (c < 32 ? 3352 + (c - 24) : -1);
  return -1;
}
__device__ __forceinline__ void wave_transpose_tile(const float* __restrict__ src, int ld_src, int k0, int n0, bf16_t* __restrict__ dst,
                                                    int Kdim, int maptype, int srccol0, float* tile, int lane) {
  int nlog = n0 + lane;
  if (maptype) { const int w = nlog & 255; nlog = (nlog & ~255) + (((w & 127) >> 5) << 6) + (((w >> 7) << 5) | (w & 31)); }
  const int sc = (maptype == 1) ? map_in(nlog) : srccol0 + nlog;
  const float* sp = src + (size_t)k0 * ld_src + (sc >= 0 ? sc : 0);
#pragma unroll 16
  for (int kk = 0; kk < 64; ++kk) {
    const float v = sp[(size_t)kk * ld_src];
    tile[kk * 65 + lane] = sc >= 0 ? v : 0.f;
  }
  __builtin_amdgcn_fence(__ATOMIC_SEQ_CST, "workgroup");
  __builtin_amdgcn_wave_barrier();
  const int rsub = lane >> 5, kp = lane & 31;
#pragma unroll 8
  for (int it = 0; it < 32; ++it) {
    const int row = 2 * it + rsub;
    const float a = tile[(2 * kp) * 65 + row], b = tile[(2 * kp + 1) * 65 + row];
    *(unsigned*)(dst + (size_t)(n0 + row) * Kdim + k0 + 2 * kp) = cvtpk(a, b);
  }
  __builtin_amdgcn_fence(__ATOMIC_SEQ_CST, "workgroup");
  __builtin_amdgcn_wave_barrier();
}
__device__ __forceinline__ void rmsnorm4(const float* __restrict__ x, const float* __restrict__ gain, bf16_t* __restrict__ dst, size_t row0, int lane) {
  f32x4 v[4][4];
  float ss[4];
#pragma unroll
  for (int rr = 0; rr < 4; ++rr)
#pragma unroll
    for (int i = 0; i < 4; ++i) v[rr][i] = *(const f32x4*)(x + (row0 + rr) * 1024 + lane * 4 + 256 * i);
  f32x4 gv[4];
#pragma unroll
  for (int i = 0; i < 4; ++i) gv[i] = *(const f32x4*)(gain + lane * 4 + 256 * i);
#pragma unroll
  for (int rr = 0; rr < 4; ++rr) {
    float s = 0.f;
#pragma unroll
    for (int i = 0; i < 4; ++i) s += v[rr][i][0] * v[rr][i][0] + v[rr][i][1] * v[rr][i][1] + v[rr][i][2] * v[rr][i][2] + v[rr][i][3] * v[rr][i][3];
    ss[rr] = s;
  }
#pragma unroll
  for (int o_ = 1; o_ < 64; o_ <<= 1) {
#pragma unroll
    for (int rr = 0; rr < 4; ++rr) ss[rr] += __shfl_xor(ss[rr], o_);
  }
#pragma unroll
  for (int rr = 0; rr < 4; ++rr) {
    const float rstd = rsqrtf(ss[rr] * (1.0f / 1024.0f) + EPS);
#pragma unroll
    for (int i = 0; i < 4; ++i) {
      const f32x4 y = v[rr][i] * rstd * gv[i];
      u32x2 w = {cvtpk(y[0], y[1]), cvtpk(y[2], y[3])};
      *(u32x2*)(dst + (row0 + rr) * 1024 + lane * 4 + 256 * i) = w;
    }
  }
}
__device__ __forceinline__ void phase_prep(const Params& p, int l, float* smem) {
  const int tid = tidx();
  const int wave = tid >> 6, lane = tid & 63;
  const int gw = wave * gdim() + bidx(), nw = NWAVES * gdim();
  if (l == 0 && bidx() == 0 && tid < 64) WSP(unsigned, OFF_CTL)[tid] = 0u;
  const float* xin = (l == 0) ? p.x : p.out;
  float* wtile = smem + wave * 4160;
  for (int u0 = gw; u0 < 3076; u0 += nw) {
    int u = u0;
    const float* src; int ld, kt, nt, Kd, mt = 0, c0 = 0; bf16_t* dst;
    if (u < 1280) { kt = u / 80; nt = u % 80; src = p.w_in + (size_t)l * 1024 * 7968; ld = 7968; Kd = 1024; dst = WSP(bf16_t, OFF_W_IN); mt = 1; }
    else if ((u -= 1280) < 768) { kt = u / 48; nt = u % 48; src = p.w_in + (size_t)l * 1024 * 7968; ld = 7968; Kd = 1024; dst = WSP(bf16_t, OFF_W_G); c0 = 4896; }
    else if ((u -= 768) < 256) { kt = u / 16; nt = u % 16; src = p.w_mem_kv + (size_t)l * 1024 * 1024; ld = 1024; Kd = 1024; dst = WSP(bf16_t, OFF_W_MKV); mt = 2; }
    else if ((u -= 256) < 384) { const int br = u / 128, uu = u % 128; kt = uu / 16; nt = uu % 16;
      src = (br == 0 ? p.w_branch_a : br == 1 ? p.w_branch_b : p.w_branch_m) + (size_t)l * 512 * 1024; ld = 1024; Kd = 512; dst = WSP(bf16_t, OFF_W_BR + (size_t)br * MiB); }
    else if ((u -= 384) < 256) { kt = u / 16; nt = u % 16; src = p.w_out + (size_t)l * 1024 * 1024; ld = 1024; Kd = 1024; dst = WSP(bf16_t, OFF_W_OUT); }
    else if ((u -= 256) < 128) { const int kv = u / 64, uu = u % 64; kt = uu / 2; nt = uu % 2;
      src = (kv ? p.cmp_w1_v : p.cmp_w1_k) + (size_t)l * 2048 * 128; ld = 128; Kd = 2048; dst = WSP(bf16_t, OFF_W1 + (size_t)kv * 512 * 1024); }
    else { u -= 128; const int kv = u / 2; kt = u % 2; nt = 0;
      src = (kv ? p.cmp_w2_v : p.cmp_w2_k) + (size_t)l * 128 * 64; ld = 64; Kd = 128; dst = WSP(bf16_t, OFF_W2 + (size_t)kv * 64 * 1024); }
    wave_transpose_tile(src, ld, kt * 64, nt * 64, dst, Kd, mt, c0, wtile, lane);
  }
  for (int grp = gw; grp < 8192 + 256; grp += nw) {
    if (grp < 8192) rmsnorm4(xin, p.norm_g + l * 1024, WSP(bf16_t, OFF_H), (size_t)grp * 4, lane);
    else rmsnorm4(p.mem, p.mem_norm_g + l * 1024, WSP(bf16_t, OFF_MEMN), (size_t)(grp - 8192) * 4, lane);
  }
  for (int u = gw; u < 32; u += nw) {
    const int kv = u >> 4, ch = u & 15;
    const float* pe = (kv ? p.cmp_pe_v : p.cmp_pe_k) + (size_t)l * 2048 + ch * 128;
    const float* w1 = (kv ? p.cmp_w1_v : p.cmp_w1_k) + (size_t)l * 2048 * 128 + (size_t)ch * 128 * 128;
    float s0 = 0.f, s1 = 0.f;
#pragma unroll 16
    for (int kk = 0; kk < 128; ++kk) {
      const float pv = pe[kk];
      s0 += pv * w1[(size_t)kk * 128 + lane];
      s1 += pv * w1[(size_t)kk * 128 + 64 + lane];
    }
    float* part = WSP(float, OFF_C1) + (size_t)(kv * 16 + ch) * 128;
    part[lane] = s0;
    part[64 + lane] = s1;
  }
  if (l == 0) {
    for (int u = bidx(); u < 512; u += gdim()) {
      for (int e = tid; e < 512; e += NTHREADS) {
        const int idx = u * 512 + e, pos = idx >> 5, f = idx & 31;
        const float ang = (float)pos * c_inv_freq[f];
        const double a = (double)ang;
        const double k = rint(a * 0.15915494309189535);
        const float rr = (float)(a - k * 6.283185307179586);
        float2 cs; cs.x = __cosf(rr); cs.y = __sinf(rr);
        WSP(float2, OFF_ROPE)[idx] = cs;
      }
    }
  }
}

__device__ __forceinline__ void compress_unit(const Params& p, int l, int u) {
  const int lane = tidx() & 63, r = lane & 15, g4 = lane >> 4;
  const int kv = u >> 7, rem = u & 127, b = rem >> 5, grp = (rem >> 4) & 1, it = rem & 15, i0 = it * 32;
  const bf16_t* src = WSP(bf16_t, kv ? OFF_VC : OFF_KC);
  const bf16_t* w1t = WSP(bf16_t, OFF_W1 + (size_t)kv * 512 * 1024);
  const bf16_t* w2t = WSP(bf16_t, OFF_W2 + (size_t)kv * 64 * 1024);
  const float* c1 = WSP(float, OFF_C1) + (size_t)kv * 16 * 128;
  const bf16_t* arow[2];
#pragma unroll
  for (int mt = 0; mt < 2; ++mt) {
    int i = i0 + 16 * mt + r;
    if (i > 510) i = 510;
    arow[mt] = src + ((size_t)b * T + 16 * i) * 128 + grp * 64 + g4 * 8;
  }
  f32x4 acc[2][8];
#pragma unroll
  for (int a = 0; a < 2; ++a)
#pragma unroll
    for (int c = 0; c < 8; ++c) acc[a][c] = (f32x4){0.f, 0.f, 0.f, 0.f};
  const bf16_t* bp = w1t + (size_t)r * 2048 + g4 * 8;
  for (int k0 = 0; k0 < 2048; k0 += 32) {
    const int pp = k0 >> 6, d = k0 & 63;
    bf16x8 af[2], bf[8];
#pragma unroll
    for (int mt = 0; mt < 2; ++mt) af[mt] = *(const bf16x8*)(arow[mt] + (size_t)pp * 128 + d);
#pragma unroll
    for (int nt = 0; nt < 8; ++nt) bf[nt] = *(const bf16x8*)(bp + (size_t)nt * 16 * 2048 + k0);
#pragma unroll
    for (int mt = 0; mt < 2; ++mt)
#pragma unroll
      for (int nt = 0; nt < 8; ++nt) acc[mt][nt] = mfma16(bf[nt], af[mt], acc[mt][nt]);
  }
#pragma unroll
  for (int nt = 0; nt < 8; ++nt) {
    f32x4 cv = {0.f, 0.f, 0.f, 0.f};
#pragma unroll
    for (int ch = 0; ch < 16; ++ch) cv = cv + *(const f32x4*)(c1 + ch * 128 + 16 * nt + 4 * g4);
#pragma unroll
    for (int mt = 0; mt < 2; ++mt)
#pragma unroll
      for (int i = 0; i < 4; ++i) acc[mt][nt][i] = siluf_(acc[mt][nt][i] + cv[i]);
  }
  bf16x8 wf[4][4];
#pragma unroll
  for (int ks = 0; ks < 4; ++ks)
#pragma unroll
    for (int et = 0; et < 4; ++et) {
      const bf16_t* wp = w2t + (size_t)(16 * et + r) * 128 + 32 * ks + 4 * g4;
      const u32x2 lo = *(const u32x2*)wp, hi = *(const u32x2*)(wp + 16);
      u32x4 w = {lo[0], lo[1], hi[0], hi[1]};
      wf[ks][et] = __builtin_bit_cast(bf16x8, w);
    }
  if (kv == 0) {
    const float* gain = p.nsa_k_norm + (size_t)(l * 3 + 0) * 64;
    bf16_t* dst = WSP(bf16_t, OFF_KCMP) + (size_t)((b * 2 + grp) * 512) * 64;
    f32x4 gv[4];
#pragma unroll
    for (int et = 0; et < 4; ++et) gv[et] = *(const f32x4*)(gain + 16 * et + 4 * g4);
#pragma unroll
    for (int mt = 0; mt < 2; ++mt) {
      f32x4 o[4];
#pragma unroll
      for (int et = 0; et < 4; ++et) o[et] = (f32x4){0.f, 0.f, 0.f, 0.f};
#pragma unroll
      for (int ks = 0; ks < 4; ++ks) {
        const bf16x8 xf = pack8(acc[mt][2 * ks], acc[mt][2 * ks + 1]);
#pragma unroll
        for (int et = 0; et < 4; ++et) o[et] = mfma16(wf[ks][et], xf, o[et]);
      }
      float ss = 0.f;
#pragma unroll
      for (int et = 0; et < 4; ++et)
#pragma unroll
        for (int i = 0; i < 4; ++i) ss += o[et][i] * o[et][i];
      ss += __shfl_xor(ss, 16);
      ss += __shfl_xor(ss, 32);
      const float rstd = rsqrtf(ss * (1.0f / 64.0f) + EPS);
      const int i = i0 + 16 * mt + r;
#pragma unroll
      for (int et = 0; et < 4; ++et) {
        f32x4 y = o[et] * rstd * gv[et];
        if (i > 510) y = (f32x4){0.f, 0.f, 0.f, 0.f};
        u32x2 w = {cvtpk(y[0], y[1]), cvtpk(y[2], y[3])};
        *(u32x2*)(dst + (size_t)i * 64 + 16 * et + 4 * g4) = w;
      }
    }
  } else {
    bf16_t* dst = WSP(bf16_t, OFF_VCT) + (size_t)((b * 2 + grp) * 64) * 512;
#pragma unroll
    for (int mt = 0; mt < 2; ++mt) {
      f32x4 o[4];
#pragma unroll
      for (int et = 0; et < 4; ++et) o[et] = (f32x4){0.f, 0.f, 0.f, 0.f};
#pragma unroll
      for (int ks = 0; ks < 4; ++ks) {
        const bf16x8 xf = pack8(acc[mt][2 * ks], acc[mt][2 * ks + 1]);
#pragma unroll
        for (int et = 0; et < 4; ++et) o[et] = mfma16(xf, wf[ks][et], o[et]);
      }
#pragma unroll
      for (int et = 0; et < 4; ++et) {
        f32x4 y = o[et];
        const int ib = i0 + 16 * mt + 4 * g4;
#pragma unroll
        for (int i = 0; i < 4; ++i)
          if (ib + i > 510) y[i] = 0.f;
        u32x2 w = {cvtpk(y[0], y[1]), cvtpk(y[2], y[3])};
        *(u32x2*)(dst + (size_t)(16 * et + r) * 512 + ib) = w;
      }
    }
  }
}
__device__ __forceinline__ void cumsum_unit(const Params& p, int u) {
  const int lane = tidx() & 63, b = u >> 3, h = u & 7;
  const float* fl = WSP(float, OFF_FLOG) + ((size_t)b * T) * 8 + h;
  float* fc = WSP(float, OFF_FC) + (size_t)(b * 8 + h) * T;
  const int tb = lane * 128;
  double s = 0.0;
  for (int i = 0; i < 128; ++i) s += (double)fl[(size_t)(tb + i) * 8];
  double incl = s;
#pragma unroll
  for (int o = 1; o < 64; o <<= 1) {
    const double y = __shfl_up(incl, o);
    if (lane >= o) incl += y;
  }
  double run = incl - s;
  for (int i = 0; i < 128; ++i) {
    run += (double)fl[(size_t)(tb + i) * 8];
    fc[tb + i] = (float)run;
  }
}
__device__ __forceinline__ void memk_norm_unit(const Params& p, int l, int u) {
  const int lane = tidx() & 63;
  bf16_t* mk = WSP(bf16_t, OFF_MK);
  const float* gain = p.mem_k_norm + l * 128 + (lane & 15) * 8;
  for (int rr = 0; rr < 16; ++rr) {
    bf16_t* ptr = mk + (size_t)(u * 16 + rr) * 512 + lane * 8;
    const u32x4 w = *(const u32x4*)ptr;
    float v[8];
#pragma unroll
    for (int j = 0; j < 4; ++j) { v[2 * j] = bflo(w[j]); v[2 * j + 1] = bfhi(w[j]); }
    float ss = 0.f;
#pragma unroll
    for (int j = 0; j < 8; ++j) ss += v[j] * v[j];
#pragma unroll
    for (int o = 1; o < 16; o <<= 1) ss += __shfl_xor(ss, o);
    const float rstd = rsqrtf(ss * (1.0f / 128.0f) + EPS);
    u32x4 ow;
#pragma unroll
    for (int j = 0; j < 4; ++j) ow[j] = cvtpk(v[2 * j] * rstd * gain[2 * j], v[2 * j + 1] * rstd * gain[2 * j + 1]);
    *(u32x4*)ptr = ow;
  }
}
__device__ __forceinline__ void phase_mid(const Params& p, int l) {
  const int wave = tidx() >> 6;
  const int gw = wave * gdim() + bidx(), nw = NWAVES * gdim();
  const int mult = PROBE_PM2 ? (p.ws != nullptr ? 2 : 1) : 1;
  for (int uu = gw; uu < (256 + 32 + 64) * mult; uu += nw) {
    const int u = uu % (256 + 32 + 64);
    if (u < 256) compress_unit(p, l, u);
    else if (u < 288) cumsum_unit(p, u - 256);
    else if (uu < 256 + 32 + 64) memk_norm_unit(p, l, u - 288);
  }
}

template <int NCT, int NDK, bool QL = false>
__device__ __forceinline__ void qk_scores(const bf16_t* __restrict__ kbase, int ldk, int key0,
                                          const bf16x8 (&qf)[NCT][NDK], f32x4 (&s)[2][NCT], int lane, const bf16x8* qlds = nullptr) {
  const int r = lane & 15, grp = lane >> 4;
#pragma unroll
  for (int kt = 0; kt < 2; ++kt) {
    const bf16_t* kp = kbase + (size_t)(key0 + 8 * (r >> 2) + 4 * kt + (r & 3)) * ldk + grp * 8;
    bf16x8 kf[NDK];
#pragma unroll
    for (int dk = 0; dk < NDK; ++dk) kf[dk] = *(const bf16x8*)(kp + dk * 32);
#pragma unroll
    for (int ct = 0; ct < NCT; ++ct) {
      f32x4 a = {0.f, 0.f, 0.f, 0.f};
#pragma unroll
      for (int dk = 0; dk < NDK; ++dk) a = mfma16(kf[dk], QL ? qlds[(ct * NDK + dk) * 64 + lane] : qf[ct][dk], a);
      s[kt][ct] = a;
    }
  }
}
template <int NCT, int NDT>
__device__ __forceinline__ void pv_accum(const bf16_t* __restrict__ vt, size_t ldv, int key0,
                                         const f32x4 (&s)[2][NCT], f32x4 (&o)[NDT][NCT], int lane) {
  const int r = lane & 15, grp = lane >> 4;
  bf16x8 pb[NCT];
#pragma unroll
  for (int ct = 0; ct < NCT; ++ct) pb[ct] = pack8(s[0][ct], s[1][ct]);
#pragma unroll
  for (int dt = 0; dt < NDT; ++dt) {
    const bf16x8 vf = *(const bf16x8*)(vt + (size_t)(16 * dt + r) * ldv + key0 + 8 * grp);
#pragma unroll
    for (int ct = 0; ct < NCT; ++ct) o[dt][ct] = mfma16(vf, pb[ct], o[dt][ct]);
  }
}
template <int NCT, int NDT, bool HAS_O, bool SUMS = true>
__device__ __forceinline__ void softmax_update(f32x4 (&s)[2][NCT], float (&m)[NCT], float (&lsum)[NCT],
                                               f32x4 (&o)[NDT][NCT], f32x4 (*lacc)[NCT] = nullptr) {
  float mnew[NCT];
  bool ch = false;
#pragma unroll
  for (int ct = 0; ct < NCT; ++ct) {
    float mx = fmaxf(fmaxf(fmaxf(s[0][ct][0], s[0][ct][1]), fmaxf(s[0][ct][2], s[0][ct][3])),
                     fmaxf(fmaxf(s[1][ct][0], s[1][ct][1]), fmaxf(s[1][ct][2], s[1][ct][3])));
    mx = grp_max4(mx);
    mnew[ct] = fmaxf(m[ct], mx);
    ch = ch || (mnew[ct] > m[ct]);
  }
  if (__any(ch)) {
#pragma unroll
    for (int ct = 0; ct < NCT; ++ct) {
      const float msafe = (mnew[ct] == NEG_INF) ? 0.f : mnew[ct];
      const float alpha = __builtin_amdgcn_exp2f(m[ct] - msafe);
      m[ct] = mnew[ct];
      if (SUMS) lsum[ct] *= alpha; else (*lacc)[ct] = (*lacc)[ct] * alpha;
      if (HAS_O) {
#pragma unroll
        for (int dt = 0; dt < NDT; ++dt) o[dt][ct] = o[dt][ct] * alpha;
      }
    }
  }
#pragma unroll
  for (int ct = 0; ct < NCT; ++ct) {
    const float msafe = (m[ct] == NEG_INF) ? 0.f : m[ct];
#pragma unroll
    for (int kt = 0; kt < 2; ++kt) {
      const f32x4 d = s[kt][ct] - msafe;
      f32x4 pv;
#pragma unroll
      for (int i = 0; i < 4; ++i) pv[i] = __builtin_amdgcn_exp2f(d[i]);
      s[kt][ct] = pv;
    }
    if (SUMS) {
      const f32x4 t4 = s[0][ct] + s[1][ct];
      lsum[ct] += (t4[0] + t4[1]) + (t4[2] + t4[3]);
    }
  }
}
__device__ __forceinline__ float finish_l(float lsum) {
  lsum += __shfl_xor(lsum, 16);
  lsum += __shfl_xor(lsum, 32);
  return lsum > 0.f ? 1.0f / lsum : 0.f;
}

typedef __attribute__((address_space(3))) unsigned char lds_u8;
constexpr int TILE_ROWB = 144, TILE_HALF = 64 * TILE_ROWB, TILE_STAGE = 2 * TILE_HALF + 256;
struct TileRegs { u32x4 k, v; };
__device__ __forceinline__ void tile_gload(TileRegs& tr, const bf16_t* __restrict__ kbase, int ldk, const bf16_t* __restrict__ vtbase,
                                           size_t ldv, int key0, int tid) {
  const int row = tid >> 3, ch = tid & 7;
  tr.k = *(const u32x4*)(kbase + (size_t)(key0 + row) * ldk + ch * 8);
  tr.v = *(const u32x4*)(vtbase + (size_t)row * ldv + key0 + ch * 8);
}
__device__ __forceinline__ void tile_swrite(const TileRegs& tr, lds_u8* stage, int tid) {
  const int row = tid >> 3, ch = tid & 7;
  *(__attribute__((address_space(3))) u32x4*)(stage + row * TILE_ROWB + ch * 16) = tr.k;
  *(__attribute__((address_space(3))) u32x4*)(stage + TILE_HALF + row * TILE_ROWB + ch * 16) = tr.v;
}
template <int NCT, int NDK, bool QL>
__device__ __forceinline__ void qk_scores_lds(const lds_u8* stage, int hf, const bf16x8 (&qf)[NCT][NDK], f32x4 (&s)[2][NCT], int lane,
                                              const bf16x8* qlds, const f32x4 c0, const f32x4 c1) {
  const int r = lane & 15, grp = lane >> 4;
#pragma unroll
  for (int kt = 0; kt < 2; ++kt) {
    const lds_u8* kp = stage + (32 * hf + 8 * (r >> 2) + 4 * kt + (r & 3)) * TILE_ROWB + grp * 16;
    bf16x8 kf[NDK];
#pragma unroll
    for (int dk = 0; dk < NDK; ++dk) kf[dk] = *(const __attribute__((address_space(3))) bf16x8*)(kp + dk * 64);
#pragma unroll
    for (int ct = 0; ct < NCT; ++ct) {
      f32x4 a = kt ? c1 : c0;
#pragma unroll
      for (int dk = 0; dk < NDK; ++dk) a = mfma16(kf[dk], QL ? qlds[(ct * NDK + dk) * 64 + lane] : qf[ct][dk], a);
      s[kt][ct] = a;
    }
  }
}
template <int NDT>
__device__ __forceinline__ void v_frags_lds(const lds_u8* stage, int hf, bf16x8 (&vf)[NDT], int lane) {
  const int r = lane & 15, grp = lane >> 4;
#pragma unroll
  for (int dt = 0; dt < NDT; ++dt)
    vf[dt] = *(const __attribute__((address_space(3))) bf16x8*)(stage + TILE_HALF + (16 * dt + r) * TILE_ROWB + (32 * hf + 8 * grp) * 2);
}
template <int NCT, int NDT>
__device__ __forceinline__ void pv_accum_lds(const bf16x8 (&vfp)[NDT], const f32x4 (&s)[2][NCT], f32x4 (&o)[NDT][NCT], int lane, f32x4 (&lacc)[NCT]) {
  const int r = lane & 15, grp = lane >> 4; (void)r; (void)grp;
  bf16x8 pb[NCT];
#pragma unroll
  for (int ct = 0; ct < NCT; ++ct) pb[ct] = pack8(s[0][ct], s[1][ct]);
  {
    const short one = (short)0x3F80;
    const bf16x8 ones = {one, one, one, one, one, one, one, one};
#pragma unroll
    for (int ct = 0; ct < NCT; ++ct) lacc[ct] = mfma16(ones, pb[ct], lacc[ct]);
  }
#pragma unroll
  for (int dt = 0; dt < NDT; ++dt) {
    const bf16x8 vf = vfp[dt];
#pragma unroll
    for (int ct = 0; ct < NCT; ++ct) o[dt][ct] = mfma16(vf, pb[ct], o[dt][ct]);
  }
}
__device__ __forceinline__ int next_bit(unsigned long long lo, unsigned long long hi, int from) {
  if (from < 64) { const unsigned long long mm = lo & (~0ull << from); if (mm) return __ffsll(mm) - 1; from = 64; }
  if (from < 128) { const unsigned long long mm = hi & (~0ull << (from - 64)); if (mm) return 64 + __ffsll(mm) - 1; }
  return 128;
}

__device__ __forceinline__ void nsa_wg_unit(const Params& p, int b, int g, int qi, float* imp, bf16x8* qlds, float* scr, lds_u8* tiles, unsigned* misc, bool st) {
  const int tid0 = tidx();
  const int wave = __builtin_amdgcn_readfirstlane(tid0 >> 6);
  const int lane0 = tid0 & 63;
  const int tq = qi * 8 + wave;
  const int t0 = tq * 16;
  const bf16x8 (&qf)[4][2] = *(const bf16x8 (*)[4][2])nullptr;
#define NSA_SECTION_VARS \
  int lane = lane0; asm volatile("" : "+v"(lane)); \
  const int r = lane & 15, grp = lane >> 4, t = t0 + r; \
  const size_t row = (size_t)b * T + t; \
  const float* gatep = WSP(float, OFF_GATE) + row * 24 + g * 12; (void)gatep; (void)grp; (void)t;
  {
    NSA_SECTION_VARS
#pragma unroll
    for (int ct = 0; ct < 4; ++ct)
#pragma unroll
      for (int dk = 0; dk < 2; ++dk)
        qlds[(ct * 2 + dk) * 64 + lane] = *(const bf16x8*)(WSP(bf16_t, OFF_QN) + row * 512 + (g * 4 + ct) * 64 + dk * 32 + grp * 8);
  }
  f32x4 o[4][4];
  float m[4], lsum[4];
  f32x4 lacc[4];
  {
    NSA_SECTION_VARS
    const bf16_t* kc = WSP(bf16_t, OFF_KCMP) + (size_t)((b * 2 + g) * 512) * 64;
    const bf16_t* vct = WSP(bf16_t, OFF_VCT) + (size_t)((b * 2 + g) * 64) * 512;
    const int nblk = (tq + 31) >> 5;
#pragma unroll
    for (int ct = 0; ct < 4; ++ct) { m[ct] = NEG_INF; lsum[ct] = 0.f; }
#pragma unroll 1
    for (int blk = 0; blk < nblk; ++blk) {
      f32x4 s[2][4];
      qk_scores<4, 2, true>(kc, 64, blk * 32, qf, s, lane, qlds);
#pragma unroll
      for (int kt = 0; kt < 2; ++kt)
#pragma unroll
        for (int i = 0; i < 4; ++i) {
          const int n = blk * 32 + 8 * grp + 4 * kt + i;
          const bool ok = (16 * n + 31 <= t);
#pragma unroll
          for (int ct = 0; ct < 4; ++ct) s[kt][ct][i] = ok ? s[kt][ct][i] : NEG_INF;
        }
      softmax_update<4, 4, false>(s, m, lsum, o);
    }
    float invl[4], msafe[4];
#pragma unroll
    for (int ct = 0; ct < 4; ++ct) { invl[ct] = finish_l(lsum[ct]); msafe[ct] = (m[ct] == NEG_INF) ? 0.f : m[ct]; }
    for (int e = lane; e < 16 * 132; e += 64) imp[e] = 0.f;
    __builtin_amdgcn_fence(__ATOMIC_SEQ_CST, "workgroup");
    __builtin_amdgcn_wave_barrier();
#pragma unroll
    for (int dt = 0; dt < 4; ++dt)
#pragma unroll
      for (int ct = 0; ct < 4; ++ct) o[dt][ct] = (f32x4){0.f, 0.f, 0.f, 0.f};
#pragma unroll 1
    for (int blk = 0; blk < nblk; ++blk) {
      f32x4 s[2][4];
      qk_scores<4, 2, true>(kc, 64, blk * 32, qf, s, lane, qlds);
      float pq[2][4];
#pragma unroll
      for (int kt = 0; kt < 2; ++kt)
#pragma unroll
        for (int i = 0; i < 4; ++i) {
          const int n = blk * 32 + 8 * grp + 4 * kt + i;
          const bool ok = (16 * n + 31 <= t);
          float acc_p = 0.f;
#pragma unroll
          for (int ct = 0; ct < 4; ++ct) {
            const float pv = ok ? __builtin_amdgcn_exp2f(s[kt][ct][i] - msafe[ct]) * invl[ct] : 0.f;
            s[kt][ct][i] = pv;
            acc_p += pv;
          }
          pq[kt][i] = acc_p;
        }
      float* ir = imp + r * 132 + blk * 8 + 2 * grp;
      ir[0] += pq[0][0] + pq[0][1] + pq[0][2] + 0.5f * pq[0][3];
      __builtin_amdgcn_fence(__ATOMIC_SEQ_CST, "workgroup");
      __builtin_amdgcn_wave_barrier();
      ir[1] += pq[1][0] + pq[1][1] + pq[1][2] + 0.5f * pq[1][3] + 0.5f * pq[0][3];
      __builtin_amdgcn_fence(__ATOMIC_SEQ_CST, "workgroup");
      __builtin_amdgcn_wave_barrier();
      ir[2] += 0.5f * pq[1][3];
      __builtin_amdgcn_fence(__ATOMIC_SEQ_CST, "workgroup");
      __builtin_amdgcn_wave_barrier();
      pv_accum<4, 4>(vct, 512, blk * 32, s, o, lane);
    }
    f32x4 gt[4];
#pragma unroll
    for (int ct = 0; ct < 4; ++ct) gt[ct][0] = gatep[ct * 3 + 0];
#pragma unroll
    for (int dt = 0; dt < 4; ++dt) {
#pragma unroll
      for (int ct = 0; ct < 4; ++ct)
#pragma unroll
        for (int i = 0; i < 4; ++i) scr[((dt * 4 + ct) * 4 + i) * 64 + lane] = o[dt][ct][i] * gt[ct][0];
      asm volatile("" ::: "memory");
    }
  }
  const int cur = t0 >> 6;
  unsigned long long sel_lo = 0ull, sel_hi = 0ull;
  {
  NSA_SECTION_VARS
  if (cur <= 15) {
    sel_lo = (1ull << (cur + 1)) - 1ull;
  } else {
    __builtin_amdgcn_fence(__ATOMIC_SEQ_CST, "workgroup");
    __builtin_amdgcn_wave_barrier();
    float v[32];
#pragma unroll
    for (int k = 0; k < 32; ++k) {
      const int j = grp + 4 * k;
      const float x = imp[r * 132 + j];
      v[k] = (j >= 1 && j <= cur - 2) ? x : NEG_INF;
    }
#pragma unroll 1
    for (int round = 0; round < 13; ++round) {
      float best = NEG_INF;
      int bj = 1 << 20;
#pragma unroll
      for (int k = 0; k < 32; ++k) {
        const bool tk = v[k] > best;
        best = tk ? v[k] : best;
        bj = tk ? (grp + 4 * k) : bj;
      }
#pragma unroll
      for (int off = 16; off <= 32; off <<= 1) {
        const float ob = __shfl_xor(best, off);
        const int oj = __shfl_xor(bj, off);
        const bool tk = (ob > best) || (ob == best && oj < bj);
        best = tk ? ob : best;
        bj = tk ? oj : bj;
      }
      if (bj < 64) sel_lo |= 1ull << bj; else if (bj < 128) sel_hi |= 1ull << (bj - 64);
#pragma unroll
      for (int k = 0; k < 32; ++k) v[k] = (bj == grp + 4 * k) ? NEG_INF : v[k];
    }
    sel_lo |= 1ull;
    if (cur < 64) sel_lo |= 1ull << cur; else sel_hi |= 1ull << (cur - 64);
    if (cur - 1 < 64) sel_lo |= 1ull << (cur - 1); else sel_hi |= 1ull << (cur - 1 - 64);
  }
  }
  asm volatile("" : "+v"(sel_lo), "+v"(sel_hi));
  atomicOr(&misc[4], (unsigned)sel_lo); atomicOr(&misc[5], (unsigned)(sel_lo >> 32));
  atomicOr(&misc[6], (unsigned)sel_hi); atomicOr(&misc[7], (unsigned)(sel_hi >> 32));
  __syncthreads();
  unsigned long long ulo, uhi;
  {
    const unsigned u0 = __builtin_amdgcn_readfirstlane(misc[4]), u1 = __builtin_amdgcn_readfirstlane(misc[5]);
    const unsigned u2 = __builtin_amdgcn_readfirstlane(misc[6]), u3 = __builtin_amdgcn_readfirstlane(misc[7]);
    ulo = ((unsigned long long)u1 << 32) | u0; uhi = ((unsigned long long)u3 << 32) | u2;
  }
  {
    NSA_SECTION_VARS
    const int tid = (wave << 6) | lane;
    const int hq = r >> 2, qq = r & 3;
    const bf16_t* ks = WSP(bf16_t, OFF_KS) + ((size_t)b * T) * 128 + g * 64;
    const bf16_t* vst = WSP(bf16_t, OFF_VST) + (size_t)((b * 2 + g) * 64) * T;
    bf16x8 qr[4][2];
    unsigned long long mlo[4], mhi[4];
#pragma unroll
    for (int ct = 0; ct < 4; ++ct) {
      const size_t rowq = (size_t)b * T + t0 + 4 * ct + qq;
#pragma unroll
      for (int dk = 0; dk < 2; ++dk)
        qr[ct][dk] = *(const bf16x8*)(WSP(bf16_t, OFF_QN) + rowq * 512 + (g * 4 + hq) * 64 + dk * 32 + grp * 8);
      const int srcl = (lane & 48) | (4 * ct + qq);
      mlo[ct] = __shfl(sel_lo, srcl);
      mhi[ct] = __shfl(sel_hi, srcl);
      m[ct] = NEG_INF; lacc[ct] = (f32x4){0.f, 0.f, 0.f, 0.f};
    }
#pragma unroll
    for (int dt = 0; dt < 4; ++dt)
#pragma unroll
      for (int ct = 0; ct < 4; ++ct) o[dt][ct] = (f32x4){0.f, 0.f, 0.f, 0.f};
    const short one_ = (short)0x3F80;
    const bf16x8 ones = {one_, one_, one_, one_, one_, one_, one_, one_};
    TileRegs tr;
    int j = next_bit(ulo, uhi, 0), it = 0;
    tile_gload(tr, ks, 128, vst, T, 64 * j, tid);
    tile_swrite(tr, tiles, tid);
    __syncthreads();
#pragma unroll 1
    while (j < 128) {
      const int jn = next_bit(ulo, uhi, j + 1);
      if (jn < 128) tile_gload(tr, ks, 128, vst, T, 64 * jn, tid);
      const lds_u8* stage = tiles + (it & 1) * TILE_STAGE;
      bool mine[4], need[4], anyneed = false;
#pragma unroll
      for (int ct = 0; ct < 4; ++ct) {
        mine[ct] = ((j < 64 ? (mlo[ct] >> j) : (mhi[ct] >> (j - 64))) & 1ull) != 0ull;
        need[ct] = __any(mine[ct]) != 0;
        anyneed = anyneed || need[ct];
      }
      if (anyneed) {
#pragma unroll
        for (int hf = 0; hf < 2; ++hf) {
          const int key0 = j * 64 + hf * 32;
          bf16x8 kf[2][2];
#pragma unroll
          for (int kt = 0; kt < 2; ++kt) {
            const lds_u8* kp = stage + (32 * hf + 8 * (r >> 2) + 4 * kt + (r & 3)) * TILE_ROWB + grp * 16;
#pragma unroll
            for (int dk = 0; dk < 2; ++dk) kf[kt][dk] = *(const __attribute__((address_space(3))) bf16x8*)(kp + dk * 64);
          }
          bf16x8 vfr[4];
          v_frags_lds<4>(stage, hf, vfr, lane);
#pragma unroll
          for (int ct = 0; ct < 4; ++ct) {
            if (need[ct]) {
              const float mv = mine[ct] ? 0.f : NEG_INF;
              f32x4 s0 = {mv, mv, mv, mv}, s1 = {mv, mv, mv, mv};
              s0 = mfma16(kf[0][0], qr[ct][0], s0);
              s1 = mfma16(kf[1][0], qr[ct][0], s1);
              s0 = mfma16(kf[0][1], qr[ct][1], s0);
              s1 = mfma16(kf[1][1], qr[ct][1], s1);
              if (j == cur) {
                const int tct = t0 + 4 * ct + qq;
#pragma unroll
                for (int i = 0; i < 4; ++i) {
                  s0[i] = (key0 + 8 * grp + i <= tct) ? s0[i] : NEG_INF;
                  s1[i] = (key0 + 8 * grp + 4 + i <= tct) ? s1[i] : NEG_INF;
                }
              }
              float mx = fmaxf(fmaxf(fmaxf(s0[0], s0[1]), fmaxf(s0[2], s0[3])), fmaxf(fmaxf(s1[0], s1[1]), fmaxf(s1[2], s1[3])));
              mx = grp_max4(mx);
              const float mnew = fmaxf(m[ct], mx);
              if (__any(mnew > m[ct])) {
                const float ms = (mnew == NEG_INF) ? 0.f : mnew;
                const float alpha = __builtin_amdgcn_exp2f(m[ct] - ms);
                m[ct] = mnew;
                lacc[ct] = lacc[ct] * alpha;
#pragma unroll
                for (int dt = 0; dt < 4; ++dt) o[dt][ct] = o[dt][ct] * alpha;
              }
              const float msafe = (m[ct] == NEG_INF) ? 0.f : m[ct];
              const f32x4 d0 = s0 - msafe, d1 = s1 - msafe;
              f32x4 p0, p1;
#pragma unroll
              for (int i = 0; i < 4; ++i) { p0[i] = __builtin_amdgcn_exp2f(d0[i]); p1[i] = __builtin_amdgcn_exp2f(d1[i]); }
              const bf16x8 pb = pack8(p0, p1);
              lacc[ct] = mfma16(ones, pb, lacc[ct]);
#pragma unroll
              for (int dt = 0; dt < 4; ++dt) o[dt][ct] = mfma16(vfr[dt], pb, o[dt][ct]);
            }
          }
        }
      }
      if (jn < 128) tile_swrite(tr, tiles + ((it + 1) & 1) * TILE_STAGE, tid);
      __syncthreads();
      j = jn; ++it;
    }
    float* scr2 = scr + (size_t)2048 * 4096;
#pragma unroll
    for (int ct = 0; ct < 4; ++ct) {
      const size_t rowq = (size_t)b * T + t0 + 4 * ct + qq;
      const float sc = (lacc[ct][0] > 0.f ? 1.0f / lacc[ct][0] : 0.f) * WSP(float, OFF_GATE)[rowq * 24 + (g * 4 + hq) * 3 + 1];
#pragma unroll
      for (int dt = 0; dt < 4; ++dt)
        *(f32x4*)(scr2 + (hq * 16 + 4 * ct + qq) * 64 + 16 * dt + 4 * grp) = o[dt][ct] * sc;
    }
    asm volatile("s_waitcnt vmcnt(0)" ::: "memory");
    __builtin_amdgcn_fence(__ATOMIC_SEQ_CST, "workgroup");
  }
  {
    NSA_SECTION_VARS
    const int tid = (wave << 6) | lane;
    const bf16_t* kw = WSP(bf16_t, OFF_KW) + ((size_t)b * T) * 128 + g * 64;
    const bf16_t* vwt = WSP(bf16_t, OFF_VWT) + (size_t)((b * 2 + g) * 64) * T;
#pragma unroll
    for (int ct = 0; ct < 4; ++ct) { m[ct] = NEG_INF; lsum[ct] = 0.f; lacc[ct] = (f32x4){0.f, 0.f, 0.f, 0.f}; }
#pragma unroll
    for (int dt = 0; dt < 4; ++dt)
#pragma unroll
      for (int ct = 0; ct < 4; ++ct) o[dt][ct] = (f32x4){0.f, 0.f, 0.f, 0.f};
    int kstart = qi * 128 - 512;
    if (kstart < 0) kstart = 0;
    const int kend = qi * 128 + 64;
    bf16x8 qr[4][2];
#pragma unroll
    for (int ct = 0; ct < 4; ++ct)
#pragma unroll
      for (int dk = 0; dk < 2; ++dk) qr[ct][dk] = qlds[(ct * 2 + dk) * 64 + lane];
    TileRegs tr;
    int it = 0;
    tile_gload(tr, kw, 128, vwt, T, kstart, tid);
    tile_swrite(tr, tiles, tid);
    __syncthreads();
#pragma unroll 1
    for (int k0 = kstart; k0 <= kend; k0 += 64, ++it) {
      if (k0 + 64 <= kend) tile_gload(tr, kw, 128, vwt, T, k0 + 64, tid);
      const lds_u8* stage = tiles + (it & 1) * TILE_STAGE;
      if (k0 <= t0 + 15 && k0 + 63 + 512 > t0) {
#pragma unroll
        for (int hf = 0; hf < 2; ++hf) {
          const int key0 = k0 + hf * 32;
          f32x4 s[2][4];
          const f32x4 cz = {0.f, 0.f, 0.f, 0.f};
          qk_scores_lds<4, 2, false>(stage, hf, qr, s, lane, nullptr, cz, cz);
          if (!(k0 + 63 <= t0 && k0 + 512 > t0 + 15)) {
#pragma unroll
            for (int kt = 0; kt < 2; ++kt)
#pragma unroll
              for (int i = 0; i < 4; ++i) {
                const int key = key0 + 8 * grp + 4 * kt + i;
                const bool ok = (key <= t) && (key + 512 > t);
#pragma unroll
                for (int ct = 0; ct < 4; ++ct) s[kt][ct][i] = ok ? s[kt][ct][i] : NEG_INF;
              }
          }
          bf16x8 vfr[4];
          v_frags_lds<4>(stage, hf, vfr, lane);
          softmax_update<4, 4, true, false>(s, m, lsum, o, &lacc);
          pv_accum_lds<4, 4>(vfr, s, o, lane, lacc);
        }
      }
      if (k0 + 64 <= kend) tile_swrite(tr, tiles + ((it + 1) & 1) * TILE_STAGE, tid);
      __syncthreads();
    }
    float sc2[4];
#pragma unroll
    for (int ct = 0; ct < 4; ++ct) sc2[ct] = (lacc[ct][0] > 0.f ? 1.0f / lacc[ct][0] : 0.f) * gatep[ct * 3 + 2];
    bf16_t* oa = WSP(bf16_t, OFF_OA) + row * 512 + g * 256;
#pragma unroll
    for (int dt = 0; dt < 4; ++dt)
#pragma unroll
      for (int ct = 0; ct < 4; ++ct) {
        bf16_t* ptr = oa + ct * 64 + 16 * dt + 4 * grp;
        const u32x2 sw = *(const u32x2*)ptr;
        float val[4];
        const f32x4 sv = *(const f32x4*)(scr + (size_t)2048 * 4096 + (ct * 16 + r) * 64 + 16 * dt + 4 * grp);
#pragma unroll
        for (int i = 0; i < 4; ++i) val[i] = scr[((dt * 4 + ct) * 4 + i) * 64 + lane] + sv[i] + o[dt][ct][i] * sc2[ct];
        u32x2 w = {cvtpk(val[0] * bflo(sw[0]), val[1] * bfhi(sw[0])), cvtpk(val[2] * bflo(sw[1]), val[3] * bfhi(sw[1]))};
        if (st) *(u32x2*)ptr = w;
        asm volatile("" ::: "memory");
      }
  }
#undef NSA_SECTION_VARS
}

__device__ __forceinline__ void fox_wg_unit(const Params& p, int l, int b, int h, int qb, lds_u8* tiles, bool st) {
  const int tid = tidx();
  const int wave = __builtin_amdgcn_readfirstlane(tid >> 6);
  const int lane = tid & 63, r = lane & 15, grp = lane >> 4;
  const int t0 = qb * 512 + wave * 64;
  bf16x8 qf[4][2];
  const float* fc = WSP(float, OFF_FC) + (size_t)(b * 8 + h) * T;
#pragma unroll
  for (int ct = 0; ct < 4; ++ct) {
    const size_t row = (size_t)b * T + t0 + 16 * ct + r;
#pragma unroll
    for (int dk = 0; dk < 2; ++dk)
      qf[ct][dk] = *(const bf16x8*)(WSP(bf16_t, OFF_FQ) + row * 512 + h * 64 + dk * 32 + grp * 8);
  }
  const bf16_t* kb = WSP(bf16_t, OFF_FK) + ((size_t)b * T) * 512 + h * 64;
  const bf16_t* vt = WSP(bf16_t, OFF_FVT) + (size_t)((b * 8 + h) * 64) * T;
  f32x4 o[4][4];
  float m[4], lsum[4];
  f32x4 lacc[4];
#pragma unroll
  for (int ct = 0; ct < 4; ++ct) { m[ct] = NEG_INF; lsum[ct] = 0.f; lacc[ct] = (f32x4){0.f, 0.f, 0.f, 0.f}; }
#pragma unroll
  for (int dt = 0; dt < 4; ++dt)
#pragma unroll
    for (int ct = 0; ct < 4; ++ct) o[dt][ct] = (f32x4){0.f, 0.f, 0.f, 0.f};
  const int ntiles = (qb + 1) * 8;
  int it0, itw0;
  {
    float gq = fabsf(p.fox_q_norm[l * 64 + lane]), gk = fabsf(p.fox_k_norm[l * 64 + lane]);
#pragma unroll
    for (int o_ = 1; o_ < 64; o_ <<= 1) { gq = fmaxf(gq, __shfl_xor(gq, o_)); gk = fmaxf(gk, __shfl_xor(gk, o_)); }
    const float B2 = 16.0f * gq * gk * 1.02f + 104.0f;
    const float thr_wg = fc[qb * 512] + B2, thr_w = fc[t0] + B2;
    const float c0 = (lane < ntiles) ? fc[64 * lane + 63] : -3.0e38f;
    const float c1 = (lane + 64 < ntiles) ? fc[64 * (lane + 64) + 63] : -3.0e38f;
    it0 = __popcll(__ballot(c0 > thr_wg)) + __popcll(__ballot(c1 > thr_wg));
    itw0 = __popcll(__ballot(c0 > thr_w)) + __popcll(__ballot(c1 > thr_w));
    it0 = __builtin_amdgcn_readfirstlane(it0);
    itw0 = __builtin_amdgcn_readfirstlane(itw0);
  }
  TileRegs tr;
  float ckr = 0.f;
  tile_gload(tr, kb, 512, vt, T, it0 * 64, tid);
  if (tid < 64) ckr = fc[it0 * 64 + tid] * (-LOG2E);
  tile_swrite(tr, tiles, tid);
  if (tid < 64) *(__attribute__((address_space(3))) float*)(tiles + 2 * TILE_HALF + tid * 4) = ckr;
  __syncthreads();
#pragma unroll 1
  for (int it = it0; it < ntiles; ++it) {
    const int k0 = it * 64;
    if (it + 1 < ntiles) { tile_gload(tr, kb, 512, vt, T, k0 + 64, tid); if (tid < 64) ckr = fc[k0 + 64 + tid] * (-LOG2E); }
    const lds_u8* stage = tiles + ((it - it0) & 1) * TILE_STAGE;
    if (k0 <= t0 + 63 && it >= itw0) {
      const bool diag = (k0 + 63 > t0);
#pragma unroll
      for (int hf = 0; hf < 2; ++hf) {
        const int key0 = k0 + hf * 32;
        f32x4 s[2][4];
        const f32x4 ck0 = *(const __attribute__((address_space(3))) f32x4*)(stage + 2 * TILE_HALF + (32 * hf + 8 * grp) * 4);
        const f32x4 ck1 = *(const __attribute__((address_space(3))) f32x4*)(stage + 2 * TILE_HALF + (32 * hf + 8 * grp + 4) * 4);
        qk_scores_lds<4, 2, false>(stage, hf, qf, s, lane, nullptr, ck0, ck1);
        if (diag) {
#pragma unroll
          for (int kt = 0; kt < 2; ++kt)
#pragma unroll
            for (int i = 0; i < 4; ++i) {
              const int key = key0 + 8 * grp + 4 * kt + i;
#pragma unroll
              for (int ct = 0; ct < 4; ++ct) s[kt][ct][i] = (key <= t0 + 16 * ct + r) ? s[kt][ct][i] : NEG_INF;
            }
        }
        bf16x8 vfr[4];
        v_frags_lds<4>(stage, hf, vfr, lane);
        softmax_update<4, 4, true, false>(s, m, lsum, o, &lacc);
        pv_accum_lds<4, 4>(vfr, s, o, lane, lacc);
      }
    }
    if (it + 1 < ntiles) {
      tile_swrite(tr, tiles + ((it - it0 + 1) & 1) * TILE_STAGE, tid);
      if (tid < 64) *(__attribute__((address_space(3))) float*)(tiles + ((it - it0 + 1) & 1) * TILE_STAGE + 2 * TILE_HALF + tid * 4) = ckr;
    }
    __syncthreads();
  }
  float invl[4];
#pragma unroll
  for (int ct = 0; ct < 4; ++ct) invl[ct] = lacc[ct][0] > 0.f ? 1.0f / lacc[ct][0] : 0.f;
#pragma unroll
  for (int ct = 0; ct < 4; ++ct) {
    bf16_t* ob = WSP(bf16_t, OFF_OB) + ((size_t)b * T + t0 + 16 * ct + r) * 512 + h * 64;
#pragma unroll
    for (int dt = 0; dt < 4; ++dt) {
      bf16_t* ptr = ob + 16 * dt + 4 * grp;
      const u32x2 sw = *(const u32x2*)ptr;
      const f32x4 v = o[dt][ct] * invl[ct];
      u32x2 w = {cvtpk(v[0] * bflo(sw[0]), v[1] * bfhi(sw[0])), cvtpk(v[2] * bflo(sw[1]), v[3] * bfhi(sw[1]))};
      if (st) *(u32x2*)ptr = w;
    }
  }
}

__device__ __forceinline__ void mem_unit(const Params& p, int l, int b, int h, int t0, bool st) {
  const int lane = tidx() & 63, r = lane & 15, grp = lane >> 4;
  const float SC = 0.08838834764831845f * LOG2E;
  bf16x8 qf[2][4];
  const float* gq = p.mem_q_norm + l * 128;
#pragma unroll
  for (int ct = 0; ct < 2; ++ct) {
    const size_t row = (size_t)b * T + t0 + 16 * ct + r;
    float v[4][8];
    float ss = 0.f;
#pragma unroll
    for (int dk = 0; dk < 4; ++dk) {
      const u32x4 w = *(const u32x4*)(WSP(bf16_t, OFF_MQ) + row * 512 + h * 128 + dk * 32 + grp * 8);
#pragma unroll
      for (int j = 0; j < 4; ++j) { v[dk][2 * j] = bflo(w[j]); v[dk][2 * j + 1] = bfhi(w[j]); }
#pragma unroll
      for (int j = 0; j < 8; ++j) ss += v[dk][j] * v[dk][j];
    }
    ss += __shfl_xor(ss, 16);
    ss += __shfl_xor(ss, 32);
    const float rstd = rsqrtf(ss * (1.0f / 128.0f) + EPS);
#pragma unroll
    for (int dk = 0; dk < 4; ++dk) {
      const f32x4 g0 = *(const f32x4*)(gq + dk * 32 + grp * 8), g1 = *(const f32x4*)(gq + dk * 32 + grp * 8 + 4);
      u32x4 w = {cvtpk(v[dk][0] * rstd * g0[0], v[dk][1] * rstd * g0[1]), cvtpk(v[dk][2] * rstd * g0[2], v[dk][3] * rstd * g0[3]),
                 cvtpk(v[dk][4] * rstd * g1[0], v[dk][5] * rstd * g1[1]), cvtpk(v[dk][6] * rstd * g1[2], v[dk][7] * rstd * g1[3])};
      qf[ct][dk] = __builtin_bit_cast(bf16x8, w);
    }
  }
  const bf16_t* kb = WSP(bf16_t, OFF_MK) + ((size_t)b * 256) * 512 + h * 128;
  const bf16_t* vt = WSP(bf16_t, OFF_MVT) + (size_t)((b * 4 + h) * 128) * 256;
  f32x4 o[8][2];
  float m[2], lsum[2];
#pragma unroll
  for (int ct = 0; ct < 2; ++ct) { m[ct] = NEG_INF; lsum[ct] = 0.f; }
#pragma unroll
  for (int dt = 0; dt < 8; ++dt)
#pragma unroll
    for (int ct = 0; ct < 2; ++ct) o[dt][ct] = (f32x4){0.f, 0.f, 0.f, 0.f};
#pragma unroll 1
  for (int key0 = 0; key0 < 256; key0 += 32) {
    f32x4 s[2][2];
    qk_scores<2, 4>(kb, 512, key0, qf, s, lane);
#pragma unroll
    for (int kt = 0; kt < 2; ++kt)
#pragma unroll
      for (int ct = 0; ct < 2; ++ct) s[kt][ct] = s[kt][ct] * SC;
    softmax_update<2, 8, true>(s, m, lsum, o);
    pv_accum<2, 8>(vt, 256, key0, s, o, lane);
  }
#pragma unroll
  for (int ct = 0; ct < 2; ++ct) {
    const float invl = finish_l(lsum[ct]);
    bf16_t* om = WSP(bf16_t, OFF_OM) + ((size_t)b * T + t0 + 16 * ct + r) * 512 + h * 128;
#pragma unroll
    for (int dt = 0; dt < 8; ++dt) {
      bf16_t* ptr = om + 16 * dt + 4 * grp;
      const u32x2 sw = *(const u32x2*)ptr;
      const f32x4 v = o[dt][ct] * invl;
      u32x2 w = {cvtpk(v[0] * bflo(sw[0]), v[1] * bfhi(sw[0])), cvtpk(v[2] * bflo(sw[1]), v[3] * bfhi(sw[1]))};
      if (st) *(u32x2*)ptr = w;
    }
  }
}

__device__ __forceinline__ void phase_attn(const Params& p, int l, unsigned char* ldsraw, bool st, int cidx) {
  const int tid = tidx();
  const int wave = __builtin_amdgcn_readfirstlane(tid >> 6);
  float* imp = (float*)ldsraw + wave * 2112;
  lds_u8* tiles = (lds_u8*)ldsraw;
  bf16x8* qlds = (bf16x8*)(ldsraw + 69632 + wave * 8192);
  unsigned* misc = (unsigned*)(ldsraw + 135168);
  float* scr = WSP(float, OFF_SCR) + (size_t)(bidx() * NWAVES + wave) * 4096;
  const int myx = (int)(xb_xcc_id() & 7u);
  constexpr int QUNITS = 192;
  for (int qq = 0; qq < 8; ++qq) {
    const int x = (myx + qq) & 7;
    unsigned* ctr = WSP(unsigned, OFF_CTL) + cidx * 8 + x;
    for (;;) {
      __syncthreads();
      if (tid == 0) misc[0] = atomicAdd(ctr, 1u);
      if (tid >= 4 && tid < 8) misc[tid] = 0u;
      __syncthreads();
      const int u = __builtin_amdgcn_readfirstlane((int)misc[0]);
      if (u >= QUNITS) break;
      if (u < 128) {
        const int g4 = u >> 3, w = u & 7;
        if (w < 4) { const int bh = 4 * x + w; fox_wg_unit(p, l, bh >> 3, bh & 7, 15 - g4, tiles, st); }
        else nsa_wg_unit(p, x >> 1, x & 1, 63 - (4 * g4 + (w - 4)), imp, qlds, scr, tiles, misc, st);
      } else {
        const int mu = u - 128, bh = 2 * x + (mu >> 5), qblk = mu & 31;
        mem_unit(p, l, bh >> 2, bh & 3, 256 * qblk + 32 * wave, st);
      }
    }
  }
}

__global__ void __launch_bounds__(NTHREADS) hybrid_megakernel(Params p) {
  cg::grid_group grid = cg::this_grid();
  extern __shared__ __attribute__((aligned(16))) unsigned char dynlds[];
  float* smem = (float*)dynlds;
  PG8_LAS unsigned char* glds = (PG8_LAS unsigned char*)dynlds;
  volatile LAS unsigned* bst = (volatile LAS unsigned*)(glds + 135168 + 64);
  if (threadIdx.x < 2) bst[threadIdx.x] = 0u;
  __syncthreads();
  grid.sync();
  const XcdBarrier xbar = xcd_barrier_post(WSP(unsigned, OFF_BAR), bst);
  unsigned long long pr_acc = 0ull, pr_t0 = 0ull;
#pragma unroll 1
  for (int ph = 0; ph < 28; ++ph) {
    const int l = ph / 7, k = ph - 7 * l;
    if (PROBE_PHASE >= 0 && k == PROBE_PHASE) pr_t0 = __builtin_amdgcn_s_memrealtime();
    if (k == 0) {
      phase_prep(p, l, smem);
    } else if (k == 1) {
      EpiIn E{&p, l};
      for (int rp = 0; rp < (PROBE_GEMM2 ? (p.ws != nullptr ? 2 : 1) : 1); ++rp)
        run_gemm(glds, WSP(bf16_t, OFF_H), WSP(bf16_t, OFF_W_IN), M, 5120, 1024, E);
      EpiMemKV E2{&p};
      run_gemm(glds, WSP(bf16_t, OFF_MEMN), WSP(bf16_t, OFF_W_MKV), 1024, 1024, 1024, E2);
    } else if (k == 2) {
      phase_mid(p, l);
    } else if (k == 3) {
      const int nrep = PROBE_ATTN2 ? (p.ws != nullptr ? 2 : 1) : 1;
      for (int rp = 0; rp < nrep; ++rp) {
        const bool last = (rp == nrep - 1);
        if (rp) xcd_barrier(xbar);
        phase_attn(p, l, dynlds, last, last ? l : 4 + l);
      }
    } else if (k == 4) {
      EpiGate E{WSP(bf16_t, OFF_G)};
      for (int rp = 0; rp < (PROBE_GEMM2 ? (p.ws != nullptr ? 2 : 1) : 1); ++rp)
        run_gemm(glds, WSP(bf16_t, OFF_H), WSP(bf16_t, OFF_W_G), M, 3072, 1024, E);
    } else if (k == 5) {
      for (int rp = 0; rp < (PROBE_BR2 ? (p.ws != nullptr ? 2 : 1) : 1); ++rp) {
      EpiBranch Ea{WSP(bf16_t, OFF_G), WSP(bf16_t, OFF_U), 1};
      run_gemm(glds, WSP(bf16_t, OFF_OA), WSP(bf16_t, OFF_W_BR), M, 1024, 512, Ea);
      EpiBranch Eb{WSP(bf16_t, OFF_G) + (size_t)M * 1024, WSP(bf16_t, OFF_U), 0};
      run_gemm(glds, WSP(bf16_t, OFF_OB), WSP(bf16_t, OFF_W_BR + MiB), M, 1024, 512, Eb);
      EpiBranch Ec{WSP(bf16_t, OFF_G) + (size_t)2 * M * 1024, WSP(bf16_t, OFF_U), 0};
      run_gemm(glds, WSP(bf16_t, OFF_OM), WSP(bf16_t, OFF_W_BR + 2 * MiB), M, 1024, 512, Ec);
      }
    } else {
      EpiOut E{l == 0 ? p.x : p.out, p.out};
      run_gemm(glds, WSP(bf16_t, OFF_U), WSP(bf16_t, OFF_W_OUT), M, 1024, 1024, E);
    }
    xcd_barrier(xbar);
    if (PROBE_PHASE >= 0 && k == PROBE_PHASE) pr_acc += __builtin_amdgcn_s_memrealtime() - pr_t0;
  }
  if (PROBE_PHASE >= 0 && blockIdx.x == 0) {
    const unsigned long long ts = __builtin_amdgcn_s_memrealtime();
    while (__builtin_amdgcn_s_memrealtime() - ts < pr_acc) __builtin_amdgcn_s_sleep(8);
  }
}

extern "C" void kernel_launch(void* const* d_in, const int* in_sizes, int n_in, void* d_out, int out_size, void* d_ws,
                              size_t ws_size, hipStream_t stream) {
  static int grid_blocks = 0;
  if (!grid_blocks) {
    int dev = 0, cus = 0, per_cu = 0;
    (void)hipGetDevice(&dev);
    (void)hipDeviceGetAttribute(&cus, hipDeviceAttributeMultiprocessorCount, dev);
    if (hipFuncSetAttribute((const void*)hybrid_megakernel, hipFuncAttributeMaxDynamicSharedMemorySize, LDS_BYTES) != hipSuccess)
      fprintf(stderr, "hipFuncSetAttribute(dynamic LDS %d) failed\n", LDS_BYTES);
    (void)hipOccupancyMaxActiveBlocksPerMultiprocessor(&per_cu, hybrid_megakernel, NTHREADS, LDS_BYTES);
    (void)hipGetLastError();
    grid_blocks = cus;
    if (grid_blocks > 256) grid_blocks = 256;
    if (ws_size < OFF_SCR + (size_t)32 * MiB) fprintf(stderr, "workspace too small: %zu\n", ws_size);
  }
  Params p{};
  const float** pp = (const float**)&p;
  for (int i = 0; i < 23; ++i) pp[i] = (const float*)d_in[i];
  p.out = (float*)d_out;
  p.ws = (char*)d_ws;
  void* args[] = {&p};
  (void)hipMemsetAsync((char*)d_ws + OFF_BAR, 0, XCD_BAR_WORDS * sizeof(unsigned), stream);
  hipError_t e = hipLaunchCooperativeKernel((void*)hybrid_megakernel, dim3(grid_blocks), dim3(NTHREADS), args, LDS_BYTES, stream);
  if (e != hipSuccess) fprintf(stderr, "cooperative launch failed: %s (grid %d)\n", hipGetErrorString(e), grid_blocks);
}
```

```cpp
#include <hip/hip_runtime.h>
#include <hip/hip_cooperative_groups.h>
#include <stdint.h>
#include <cstdio>
namespace cg = cooperative_groups;
#ifndef PROBE_ATTN2
#define PROBE_ATTN2 0
#endif
#ifndef PROBE_PM2
#define PROBE_PM2 0
#endif
#ifndef PROBE_PHASE
#define PROBE_PHASE -1
#endif
#ifndef PROBE_BR2
#define PROBE_BR2 0
#endif
#ifndef PROBE_GEMM2
#define PROBE_GEMM2 0
#endif


typedef unsigned short bf16_t;
typedef short bf16x8 __attribute__((ext_vector_type(8)));
typedef float f32x4 __attribute__((ext_vector_type(4)));
typedef unsigned u32x2 __attribute__((ext_vector_type(2)));
typedef unsigned u32x4 __attribute__((ext_vector_type(4)));
typedef float f32x2_t __attribute__((ext_vector_type(2)));
typedef __bf16 bf16x2_t __attribute__((ext_vector_type(2)));

constexpr int NB = 4, T = 8192, M = NB * T;
constexpr int NTHREADS = 512, NWAVES = NTHREADS / 64;
constexpr int LDS_BYTES = 147456;
constexpr float EPS = 1e-6f;
constexpr float LOG2E = 1.4426950408889634f;
#define NEG_INF (-__builtin_inff())

constexpr size_t MiB = 1u << 20;
constexpr size_t OFF_CTL = 0;
constexpr size_t OFF_BAR = 64 * 1024;
constexpr size_t OFF_ROPE = 1 * MiB;
constexpr size_t OFF_W_IN = 3 * MiB;
constexpr size_t OFF_W_G = 13 * MiB;
constexpr size_t OFF_W_MKV = 19 * MiB;
constexpr size_t OFF_W_BR = 21 * MiB;
constexpr size_t OFF_W_OUT = 24 * MiB;
constexpr size_t OFF_W1 = 26 * MiB;
constexpr size_t OFF_W2 = 27 * MiB;
constexpr size_t OFF_C1 = 27 * MiB + 256 * 1024;
constexpr size_t OFF_MEMN = 28 * MiB;
constexpr size_t OFF_MK = 30 * MiB;
constexpr size_t OFF_MVT = 31 * MiB;
constexpr size_t OFF_H = 32 * MiB;
constexpr size_t OFF_U = OFF_H;
constexpr size_t OFF_OA = 96 * MiB;
constexpr size_t OFF_OB = 128 * MiB;
constexpr size_t OFF_OM = 160 * MiB;
constexpr size_t OFF_QN = 192 * MiB;
constexpr size_t OFF_G = 192 * MiB;
constexpr size_t OFF_KC = 224 * MiB;
constexpr size_t OFF_VC = 232 * MiB;
constexpr size_t OFF_KS = 240 * MiB;
constexpr size_t OFF_VST = 248 * MiB;
constexpr size_t OFF_KW = 256 * MiB;
constexpr size_t OFF_VWT = 264 * MiB;
constexpr size_t OFF_FQ = 272 * MiB;
constexpr size_t OFF_FK = 304 * MiB;
constexpr size_t OFF_FVT = 336 * MiB;
constexpr size_t OFF_MQ = 368 * MiB;
constexpr size_t OFF_GATE = 400 * MiB;
constexpr size_t OFF_FLOG = 403 * MiB;
constexpr size_t OFF_FC = 404 * MiB;
constexpr size_t OFF_KCMP = 405 * MiB;
constexpr size_t OFF_VCT = 405 * MiB + 512 * 1024;
constexpr size_t OFF_SCR = 406 * MiB;

struct Params {
  const float *x, *mem, *norm_g, *mem_norm_g, *w_in, *nsa_q_norm, *nsa_k_norm, *cmp_pe_k, *cmp_w1_k, *cmp_w2_k,
      *cmp_pe_v, *cmp_w1_v, *cmp_w2_v, *fox_q_norm, *fox_k_norm, *fox_f_bias, *mem_q_norm, *mem_k_norm, *w_mem_kv,
      *w_branch_a, *w_branch_b, *w_branch_m, *w_out;
  float* out;
  char* ws;
};
__device__ __forceinline__ char* ws_base(char* w) {
  unsigned lo = __builtin_amdgcn_readfirstlane((unsigned)(uintptr_t)w), hi = __builtin_amdgcn_readfirstlane((unsigned)((uintptr_t)w >> 32));
  asm volatile("" : "+s"(lo), "+s"(hi));
  return (char*)(__attribute__((address_space(1))) char*)(((uintptr_t)hi << 32) | (uintptr_t)lo);
}
typedef const __attribute__((address_space(4))) Params* kparams_t;
__device__ __forceinline__ kparams_t kparams() { kparams_t kp = (kparams_t)__builtin_amdgcn_kernarg_segment_ptr(); asm volatile("" : "+s"(kp)); return kp; }
#define WSP(TYPE, off) ((TYPE*)(ws_base(kp_->ws) + (off)))

__constant__ float c_inv_freq[32] = {
    1.000000000e+00f, 7.498942018e-01f, 5.623413324e-01f, 4.216965139e-01f, 3.162277639e-01f, 2.371373773e-01f,
    1.778279394e-01f, 1.333521456e-01f, 1.000000015e-01f, 7.498942316e-02f, 5.623413250e-02f, 4.216964915e-02f,
    3.162277490e-02f, 2.371373773e-02f, 1.778279431e-02f, 1.333521400e-02f, 9.999999776e-03f, 7.498942316e-03f,
    5.623413250e-03f, 4.216964822e-03f, 3.162277630e-03f, 2.371373819e-03f, 1.778279431e-03f, 1.333521446e-03f,
    1.000000047e-03f, 7.498941850e-04f, 5.623413017e-04f, 4.216965172e-04f, 3.162277571e-04f, 2.371373703e-04f,
    1.778279402e-04f, 1.333521504e-04f};

__device__ __forceinline__ int bidx() { int b = blockIdx.x; asm volatile("" : "+s"(b)); return b; }
__device__ __forceinline__ int gdim() { int g = gridDim.x; asm volatile("" : "+s"(g)); return g; }
__device__ __forceinline__ int tidx() { int t = threadIdx.x; asm volatile("" : "+v"(t)); return t; }
__device__ __forceinline__ unsigned cvtpk(float lo, float hi) {
  f32x2_t v = {lo, hi};
  bf16x2_t b = __builtin_convertvector(v, bf16x2_t);
  return __builtin_bit_cast(unsigned, b);
}
__device__ __forceinline__ float bf2f(unsigned short v) { return __uint_as_float(((unsigned)v) << 16); }
__device__ __forceinline__ float bflo(unsigned w) { return __uint_as_float(w << 16); }
__device__ __forceinline__ float bfhi(unsigned w) { return __uint_as_float(w & 0xffff0000u); }
__device__ __forceinline__ f32x4 mfma16(bf16x8 a, bf16x8 b, f32x4 c) {
  return __builtin_amdgcn_mfma_f32_16x16x32_bf16(a, b, c, 0, 0, 0);
}
__device__ __forceinline__ bf16x8 pack8(f32x4 a, f32x4 b) {
  u32x4 w = {cvtpk(a[0], a[1]), cvtpk(a[2], a[3]), cvtpk(b[0], b[1]), cvtpk(b[2], b[3])};
  return __builtin_bit_cast(bf16x8, w);
}
__device__ __forceinline__ float sigmoidf_(float v) { return 1.0f / (1.0f + __expf(-v)); }
__device__ __forceinline__ float siluf_(float v) { return v / (1.0f + __expf(-v)); }
__device__ __forceinline__ float grp_max4(float v) {
  auto a = __builtin_amdgcn_permlane32_swap(__float_as_uint(v), __float_as_uint(v), false, false);
  v = fmaxf(__uint_as_float(a[0]), __uint_as_float(a[1]));
  auto b = __builtin_amdgcn_permlane16_swap(__float_as_uint(v), __float_as_uint(v), false, false);
  return fmaxf(__uint_as_float(b[0]), __uint_as_float(b[1]));
}
__device__ __forceinline__ float wave_sum(float v) {
#pragma unroll
  for (int o = 1; o < 64; o <<= 1) v += __shfl_xor(v, o);
  return v;
}

#define LAS __attribute__((address_space(3)))
#define XB_TMO      128
#define XB_XCNT(j)  (256  + 64 * (j))
#define XB_XSUB(j)  (1280 + 64 * (j))
#define XB_XGEN(j)  (2304 + 64 * (j))
#define XB_TOP      3328
#define XB_TOPGEN   3392
#define XCD_BAR_WORDS 3456
#define XB_SPIN_CAP (1u << 18)

__device__ __forceinline__ unsigned xb_ld(unsigned* p)              { return __hip_atomic_load(p, __ATOMIC_RELAXED, __HIP_MEMORY_SCOPE_AGENT); }
__device__ __forceinline__ unsigned xb_add(unsigned* p, unsigned v) { return __hip_atomic_fetch_add(p, v, __ATOMIC_RELAXED, __HIP_MEMORY_SCOPE_AGENT); }
__device__ __forceinline__ unsigned xb_xcc_id() { return (unsigned)__builtin_amdgcn_s_getreg((3 << 11) | 20) & 0xFu; }
#define XB_SPIN(cond, bar) do { unsigned _sp = 0; while (cond) { __builtin_amdgcn_s_sleep(1); \
    if ((++_sp & 255u) == 0u) { if (xb_ld(&(bar)[XB_TMO])) break; if (_sp > XB_SPIN_CAP) { atomicAdd(&(bar)[XB_TMO], 1u); break; } } } } while (0)

struct XcdBarrier {
    unsigned* bar; unsigned x;
    volatile LAS unsigned* st;
};

__device__ __forceinline__ XcdBarrier xcd_barrier_post(unsigned* bar, volatile LAS unsigned* st) {
    XcdBarrier b; b.bar = bar; b.x = xb_xcc_id(); b.st = st;
    if (threadIdx.x == 0) (void)xb_add(&bar[XB_XCNT(b.x)], 1u);
    return b;
}
__device__ __forceinline__ void xcd_barrier_complete(unsigned* bar, unsigned x, unsigned& nloc, unsigned& nx) {
    const unsigned G = gridDim.x * gridDim.y * gridDim.z;
    unsigned sum, cnt, mine, sp = 0u;
    for (;;) {
        sum = 0u; cnt = 0u; mine = 0u;
#pragma unroll
        for (unsigned j = 0; j < 16; ++j) { const unsigned c = xb_ld(&bar[XB_XCNT(j)]); sum += c; cnt += (c > 0u) ? 1u : 0u; mine = (j == x) ? c : mine; }
        if (sum == G) break;
        __builtin_amdgcn_s_sleep(1);
        if ((++sp & 255u) == 0u) { if (xb_ld(&bar[XB_TMO])) break; if (sp > XB_SPIN_CAP) { atomicAdd(&bar[XB_TMO], 1u); break; } }
    }
    nloc = mine > 0u ? mine : 1u; nx = cnt > 0u ? cnt : 1u;
}

__device__ __forceinline__ void xcd_barrier(const XcdBarrier& b) {
    asm volatile("s_waitcnt vmcnt(0)" ::: "memory");
    __syncthreads();
    if (threadIdx.x == 0) {
        unsigned* bar = b.bar;
        __builtin_amdgcn_s_waitcnt(0);
        unsigned nloc = b.st[0], nx = b.st[1];
        if (nloc == 0u) { xcd_barrier_complete(bar, b.x, nloc, nx); b.st[0] = nloc; b.st[1] = nx; }
        const unsigned old = xb_add(&bar[XB_XSUB(b.x)], 1u);
        const unsigned gen = old / nloc;
        if (old + 1u == (gen + 1u) * nloc) {
            __builtin_amdgcn_fence(__ATOMIC_RELEASE, "agent");
            asm volatile("s_waitcnt vmcnt(0)" ::: "memory");
            const unsigned og = xb_add(&bar[XB_TOP], 1u);
            const unsigned tg = og / nx;
            if (og + 1u == (tg + 1u) * nx) xb_add(&bar[XB_TOPGEN], 1u);
            else XB_SPIN(xb_ld(&bar[XB_TOPGEN]) == tg, bar);
            __builtin_amdgcn_fence(__ATOMIC_ACQUIRE, "agent");
            xb_add(&bar[XB_XGEN(b.x)], 1u);
            asm volatile("s_waitcnt vmcnt(0)" ::: "memory");
        } else {
            XB_SPIN(xb_ld(&bar[XB_XGEN(b.x)]) == gen, bar);
            __builtin_amdgcn_fence(__ATOMIC_ACQUIRE, "agent");
            asm volatile("s_waitcnt vmcnt(0)" ::: "memory");
        }
    }
    __syncthreads();
}


namespace pg8 {
#define PG8_LAS __attribute__((address_space(3)))
typedef unsigned short bf16_t;
typedef short bf16x8 __attribute__((ext_vector_type(8)));
typedef float f32x4 __attribute__((ext_vector_type(4)));
typedef unsigned u32x4 __attribute__((ext_vector_type(4)));
constexpr int BM = 256, BK = 64, HALF = 128, HTB = HALF * BK * 2  , STAGE_BYTES = 8 * HTB, NXCD = 8, WGM = 8;

__host__ __device__ __forceinline__ int lds_byte(int r, int c) { const int st = (r >> 4) * 2 + (c >> 5), rr = r & 15, cc = c & 31, ob = rr * 64 + cc * 2; return st * 1024 + (ob ^ (((ob >> 9) & 1) << 5)); }
__host__ __device__ __forceinline__ void stage_rc(int b, int& R, int& C) { const int st = b / 1024, sb = b % 1024, swz = sb ^ (((sb >> 9) & 1) << 5); R = (st >> 1) * 16 + swz / 64; C = (st & 1) * 32 + (swz % 64) / 2; }
__host__ __device__ __forceinline__ int perm32(int rho) { const int n = rho >> 4, i = rho & 15; return 8 * (i >> 2) + 4 * n + (i & 3); }

struct Unit { int pm, pn; };
struct Gemm { const bf16_t* A; const bf16_t* Bt; int M, N, K; };

struct StaticOrder {
    int nM, nN, nwg, G, c;
    __host__ __device__ void init(int M, int N, int G_, int c_) { nM = M / BM; nN = N / BM; nwg = nM * nN; G = G_; c = c_; }
    __host__ __device__ bool next(int i, Unit& u) const {
        const long L = (long)i * G + c; if (L >= nwg) return false;
        int wgid = (int)L; { const int q = nwg / NXCD, r = nwg % NXCD, xcd = wgid % NXCD, off = wgid / NXCD; wgid = (xcd < r ? xcd * (q + 1) : r * (q + 1) + (xcd - r) * q) + off; }
        const int nig = WGM * nN, gid = wgid / nig, fm = gid * WGM, gsz = (nM - fm) < WGM ? (nM - fm) : WGM;
        u.pm = fm + ((wgid % nig) % gsz); u.pn = (wgid % nig) / gsz; return true;
    }
    __device__ __forceinline__ void a_ready(const Unit&) const {}
    __device__ __forceinline__ void done(const Unit&) const {}
};
__device__ __forceinline__ unsigned cvt_pk_bf16(float lo, float hi) { unsigned r; asm volatile("v_cvt_pk_bf16_f32 %0, %1, %2" : "=v"(r) : "v"(lo), "v"(hi)); return r; }
template <class Epi, class Sched, bool ALIGN_EPI = false, bool SP2 = false>
__device__ __forceinline__ void gemm_phase(PG8_LAS unsigned char* lds, const Gemm g, const Sched& S, const Epi& E) {
    const int tid = tidx(), wid = __builtin_amdgcn_readfirstlane(tid >> 6), lane = tid & 63, wr = wid >> 2, wc = wid & 3, fr = lane & 15, fq = lane >> 4;
    const int K = g.K, nt = K / BK;
    unsigned voffA[2], voffB[2];
#pragma unroll
    for (int i = 0; i < 2; ++i) { int R, C; stage_rc(tid * 16 + i * 8192, R, C); const int Rb = Epi::PERM ? ((R & ~31) + perm32(R & 31)) : R;
        voffA[i] = (unsigned)(R * K + C) * 2u; voffB[i] = (unsigned)(Rb * K + C) * 2u; }
    const size_t kstep = (size_t)(BK * 2);
    const size_t hstep = (size_t)HALF * K * 2;
    const size_t tstep = 2 * hstep;
    const unsigned ldsw = (unsigned)wid * 1024u;
    const int aoff = lds_byte(wr * 64 + fr, fq * 8), boff = lds_byte(wc * 32 + fr, fq * 8);
#define PG8_SA(b, h) (((b) * 2 + (h)) * HTB)
#define PG8_SB(b, h) ((4 + (b) * 2 + (h)) * HTB)
#define PG8_STAGE(bufoff, gbase, voff) do { _Pragma("unroll") for (int _i = 0; _i < 2; ++_i) \
        __builtin_amdgcn_global_load_lds((const unsigned*)((const char*)(gbase) + (voff)[_i]), (PG8_LAS unsigned*)(lds + (bufoff) + ldsw + _i * 8192), 16, 0, 0); } while (0)
#define PG8_LDA(dst, b, h) do { _Pragma("unroll") for (int m = 0; m < 4; ++m) _Pragma("unroll") for (int k = 0; k < 2; ++k) dst[m][k] = *(const PG8_LAS bf16x8*)(lds + PG8_SA(b, h) + aoff + m * 2048 + k * 1024); } while (0)
#define PG8_LDB(dst, b, h) do { _Pragma("unroll") for (int n = 0; n < 2; ++n) _Pragma("unroll") for (int k = 0; k < 2; ++k) dst[n][k] = *(const PG8_LAS bf16x8*)(lds + PG8_SB(b, h) + boff + n * 2048 + k * 1024); } while (0)
#define PG8_MMA(ai, bj, At, Bt) do { __builtin_amdgcn_s_setprio(1); _Pragma("unroll") for (int m = 0; m < 4; ++m) _Pragma("unroll") for (int n = 0; n < 2; ++n) _Pragma("unroll") for (int k = 0; k < 2; ++k) \
        acc[ai][bj][m][n] = __builtin_amdgcn_mfma_f32_16x16x32_bf16(Bt[n][k], At[m][k], acc[ai][bj][m][n], 0, 0, 0); __builtin_amdgcn_s_setprio(0); } while (0)
#define PG8_WAIT_V(n) asm volatile("s_waitcnt vmcnt(" #n ")" ::: "memory")
#define PG8_WAIT_L(n) asm volatile("s_waitcnt lgkmcnt(" #n ")" ::: "memory")
#define PG8_BAR __builtin_amdgcn_s_barrier()
#define PG8_SCHED __builtin_amdgcn_sched_barrier(0)
    Unit cur, nxt; int ui = 0;
    if (!S.next(0, cur)) return;
    f32x4 acc[2][2][4][2];
#pragma unroll
    for (int a = 0; a < 2; ++a)
#pragma unroll
        for (int b = 0; b < 2; ++b)
#pragma unroll
            for (int m = 0; m < 4; ++m)
#pragma unroll
                for (int n = 0; n < 2; ++n) acc[a][b][m][n] = (f32x4){0.f, 0.f, 0.f, 0.f};
    bf16x8 At[4][2], B0[2][2], B1[2][2];
    const char* cA = (const char*)g.A + (size_t)cur.pm * tstep; const char* cB = (const char*)g.Bt + (size_t)cur.pn * tstep;
    S.a_ready(cur);
    if constexpr (SP2) {
        PG8_STAGE(PG8_SB(0, 0), cB, voffB); PG8_STAGE(PG8_SB(0, 1), cB + hstep, voffB); PG8_STAGE(PG8_SA(0, 0), cA, voffA); PG8_STAGE(PG8_SA(0, 1), cA + hstep, voffA);
        if (wr == 1) PG8_BAR;
        PG8_WAIT_V(2); PG8_BAR;
        PG8_STAGE(PG8_SB(1, 0), cB + kstep, voffB); PG8_STAGE(PG8_SA(1, 0), cA + kstep, voffA); PG8_STAGE(PG8_SB(1, 1), cB + hstep + kstep, voffB);
        PG8_WAIT_V(6); PG8_BAR;
    } else {
        PG8_STAGE(PG8_SB(0, 0), cB, voffB); PG8_STAGE(PG8_SA(0, 0), cA, voffA); PG8_STAGE(PG8_SB(0, 1), cB + hstep, voffB); PG8_STAGE(PG8_SA(0, 1), cA + hstep, voffA);
        if (wr == 1) PG8_BAR;
        PG8_WAIT_V(4); PG8_BAR;
        PG8_STAGE(PG8_SB(1, 0), cB + kstep, voffB); PG8_STAGE(PG8_SA(1, 0), cA + kstep, voffA); PG8_STAGE(PG8_SB(1, 1), cB + hstep + kstep, voffB);
        PG8_WAIT_V(6); PG8_BAR;
    }
    for (;;) {
        const bool has_next = S.next(ui + 1, nxt);
        const char* nA = has_next ? (const char*)g.A + (size_t)nxt.pm * tstep : cA; const char* nB = has_next ? (const char*)g.Bt + (size_t)nxt.pn * tstep : cB;
        for (int t = 0; t < nt; t += 2) {
            const bool last = (t == nt - 2);
            const char* a1 = cA + (size_t)(t + 1) * kstep;
            const char* a2 = last ? nA : cA + (size_t)(t + 2) * kstep; const char* b2 = last ? nB : cB + (size_t)(t + 2) * kstep;
            const char* a3 = a2 + kstep; const char* b3 = b2 + kstep;
            if (last && has_next) S.a_ready(nxt);
            if constexpr (SP2) {
            PG8_LDB(B0, 0, 0); PG8_LDB(B1, 0, 1); PG8_SCHED; PG8_LDA(At, 0, 0); PG8_STAGE(PG8_SA(1, 1), a1 + hstep, voffA);
            PG8_WAIT_V(8); PG8_WAIT_L(0); PG8_BAR; PG8_MMA(0, 0, At, B0); PG8_MMA(0, 1, At, B1); PG8_BAR; PG8_SCHED;
            PG8_LDA(At, 0, 1); PG8_STAGE(PG8_SB(0, 0), b2, voffB); PG8_STAGE(PG8_SB(0, 1), b2 + hstep, voffB); PG8_STAGE(PG8_SA(0, 0), a2, voffA);
            PG8_WAIT_V(8); PG8_WAIT_L(0); PG8_BAR; PG8_MMA(1, 0, At, B0); PG8_MMA(1, 1, At, B1); PG8_BAR; PG8_SCHED;
            PG8_LDB(B0, 1, 0); PG8_LDB(B1, 1, 1); PG8_SCHED; PG8_LDA(At, 1, 0); PG8_STAGE(PG8_SA(0, 1), a2 + hstep, voffA);
            PG8_WAIT_V(8); PG8_WAIT_L(0); PG8_BAR; PG8_MMA(0, 0, At, B0); PG8_MMA(0, 1, At, B1); PG8_BAR; PG8_SCHED;
            PG8_LDA(At, 1, 1); PG8_STAGE(PG8_SB(1, 0), b3, voffB); PG8_STAGE(PG8_SB(1, 1), b3 + hstep, voffB); PG8_STAGE(PG8_SA(1, 0), a3, voffA);
            PG8_WAIT_V(8); PG8_WAIT_L(0); PG8_BAR; PG8_MMA(1, 0, At, B0); PG8_MMA(1, 1, At, B1); PG8_BAR; PG8_SCHED;
            } else {
            PG8_LDB(B0, 0, 0); PG8_SCHED; PG8_LDA(At, 0, 0); PG8_STAGE(PG8_SA(1, 1), a1 + hstep, voffA);
            PG8_WAIT_L(8); PG8_BAR; PG8_WAIT_L(0); PG8_MMA(0, 0, At, B0); PG8_BAR; PG8_SCHED;
            PG8_LDB(B1, 0, 1); PG8_STAGE(PG8_SB(0, 0), b2, voffB);
            PG8_BAR; PG8_WAIT_L(0); PG8_MMA(0, 1, At, B1); PG8_BAR;
            PG8_LDA(At, 0, 1); PG8_STAGE(PG8_SA(0, 0), a2, voffA);
            PG8_BAR; PG8_WAIT_L(0); PG8_MMA(1, 0, At, B0); PG8_BAR; PG8_SCHED;
            PG8_STAGE(PG8_SB(0, 1), b2 + hstep, voffB);
            PG8_WAIT_V(6); PG8_BAR; PG8_MMA(1, 1, At, B1); PG8_BAR;
            PG8_LDB(B0, 1, 0); PG8_SCHED; PG8_LDA(At, 1, 0); PG8_STAGE(PG8_SA(0, 1), a2 + hstep, voffA);
            PG8_WAIT_L(8); PG8_BAR; PG8_WAIT_L(0); PG8_MMA(0, 0, At, B0); PG8_BAR; PG8_SCHED;
            PG8_LDB(B1, 1, 1); PG8_STAGE(PG8_SB(1, 0), b3, voffB);
            PG8_BAR; PG8_WAIT_L(0); PG8_MMA(0, 1, At, B1); PG8_BAR;
            PG8_LDA(At, 1, 1); PG8_STAGE(PG8_SA(1, 0), a3, voffA);
            PG8_BAR; PG8_WAIT_L(0); PG8_MMA(1, 0, At, B0); PG8_BAR; PG8_SCHED;
            PG8_STAGE(PG8_SB(1, 1), b3 + hstep, voffB);
            PG8_WAIT_V(6); PG8_BAR; PG8_MMA(1, 1, At, B1); PG8_BAR;
            }
        }
        if constexpr (ALIGN_EPI) { if (wr == 0) PG8_BAR; }
        if constexpr (!Epi::AFTER_DRAIN) { E(acc, cur, wr, wc, fr, fq); S.done(cur); }
        if (!has_next) break;
#pragma unroll
        for (int a = 0; a < 2; ++a)
#pragma unroll
            for (int b = 0; b < 2; ++b)
#pragma unroll
                for (int m = 0; m < 4; ++m)
#pragma unroll
                    for (int n = 0; n < 2; ++n) acc[a][b][m][n] = (f32x4){0.f, 0.f, 0.f, 0.f};
        cur = nxt; cA = nA; cB = nB; ++ui;
        if constexpr (ALIGN_EPI) { if (wr == 1) PG8_BAR; }
    }
    PG8_WAIT_V(0);
    if constexpr (!ALIGN_EPI) { if (wr == 0) PG8_BAR; }
    PG8_BAR;
    if constexpr (Epi::AFTER_DRAIN) { E.fused(acc, cur, wr, wc, fr, fq, lds, wid, lane); S.done(cur); }
#undef PG8_SA
#undef PG8_SB
#undef PG8_STAGE
#undef PG8_LDA
#undef PG8_LDB
#undef PG8_MMA
#undef PG8_WAIT_V
#undef PG8_WAIT_L
#undef PG8_BAR
#undef PG8_SCHED
}
}

struct EpiIn {
  static constexpr bool PERM = false, AFTER_DRAIN = false;
  const Params* pp; int l;
  __device__ __forceinline__ void operator()(f32x4 (&acc)[2][2][4][2], const pg8::Unit& u, int wr, int wc, int fr, int fq) const {
    kparams_t kp_ = kparams(); (void)kp_;
    const int U = u.pn * 4 + wc;
    if (U >= 77) return;
    const int rowb = u.pm * 256 + wr * 64 + fr;
    const int bq = (u.pm * 256) / T, tb = rowb % T;
    bf16_t* dst = nullptr; int ld = 0, col0 = 0; const float* gain = nullptr; bool rope = false, silu = false;
    float post = 1.0f;
    bf16_t* vt = nullptr;
    if (U < 8) { dst = WSP(bf16_t, OFF_QN); ld = 512; col0 = U * 64; gain = kp_->nsa_q_norm + l * 64; rope = true; post = 0.125f * LOG2E; }
    else if (U < 10) { dst = WSP(bf16_t, OFF_KC); ld = 128; col0 = (U - 8) * 64; rope = true; }
    else if (U < 12) { dst = WSP(bf16_t, OFF_VC); ld = 128; col0 = (U - 10) * 64; }
    else if (U < 14) { dst = WSP(bf16_t, OFF_KS); ld = 128; col0 = (U - 12) * 64; gain = kp_->nsa_k_norm + (l * 3 + 1) * 64; rope = true; }
    else if (U < 16) { vt = WSP(bf16_t, OFF_VST) + (size_t)((bq * 2 + (U - 14)) * 64) * T; }
    else if (U < 18) { dst = WSP(bf16_t, OFF_KW); ld = 128; col0 = (U - 16) * 64; gain = kp_->nsa_k_norm + (l * 3 + 2) * 64; rope = true; }
    else if (U < 20) { vt = WSP(bf16_t, OFF_VWT) + (size_t)((bq * 2 + (U - 18)) * 64) * T; }
    else if (U < 28) { dst = WSP(bf16_t, OFF_OA); ld = 512; col0 = (U - 20) * 64; silu = true; }
    else if (U < 36) { dst = WSP(bf16_t, OFF_FQ); ld = 512; col0 = (U - 28) * 64; gain = kp_->fox_q_norm + l * 64; post = 0.125f * LOG2E; }
    else if (U < 44) { dst = WSP(bf16_t, OFF_FK); ld = 512; col0 = (U - 36) * 64; gain = kp_->fox_k_norm + l * 64; }
    else if (U < 52) { vt = WSP(bf16_t, OFF_FVT) + (size_t)((bq * 8 + (U - 44)) * 64) * T; }
    else if (U < 60) { dst = WSP(bf16_t, OFF_OB); ld = 512; col0 = (U - 52) * 64; silu = true; }
    else if (U < 68) { dst = WSP(bf16_t, OFF_MQ); ld = 512; col0 = (U - 60) * 64; }
    else if (U < 76) { dst = WSP(bf16_t, OFF_OM); ld = 512; col0 = (U - 68) * 64; silu = true; }
    if (U == 76) {
      float* gate = WSP(float, OFF_GATE);
      float* flog = WSP(float, OFF_FLOG);
#pragma unroll
      for (int ai = 0; ai < 2; ++ai)
#pragma unroll
        for (int m = 0; m < 4; ++m) {
          const size_t row = (size_t)rowb + 128 * ai + 16 * m;
#pragma unroll
          for (int n = 0; n < 2; ++n)
#pragma unroll
            for (int i = 0; i < 4; ++i) {
              const int e = 16 * n + 4 * fq + i;
              const float v = acc[ai][0][m][n][i];
              if (e < 24) gate[row * 24 + e] = sigmoidf_(v);
              else {
                const float xx = v + kp_->fox_f_bias[l * 8 + (e - 24)];
                flog[row * 8 + (e - 24)] = xx >= 0.f ? -log1pf(expf(-xx)) : xx - log1pf(expf(xx));
              }
            }
        }
      return;
    }
    if (vt) {
#pragma unroll
      for (int ai = 0; ai < 2; ++ai)
#pragma unroll
        for (int m = 0; m < 4; ++m) {
          const int t = tb + 128 * ai + 16 * m;
#pragma unroll
          for (int bj = 0; bj < 2; ++bj)
#pragma unroll
            for (int n = 0; n < 2; ++n) {
              const f32x4 v = acc[ai][bj][m][n];
              const unsigned w0 = cvtpk(v[0], v[1]), w1 = cvtpk(v[2], v[3]);
              const unsigned qo = (unsigned)((32 * bj + 16 * n + 4 * fq) * T + t);
              vt[qo] = (bf16_t)(w0 & 0xffffu); vt[qo + T] = (bf16_t)(w0 >> 16); vt[qo + 2 * T] = (bf16_t)(w1 & 0xffffu); vt[qo + 3 * T] = (bf16_t)(w1 >> 16);
            }
        }
      return;
    }
    const float* ropetab = WSP(float, OFF_ROPE);
    f32x4 gv[2][2];
    if (gain) {
#pragma unroll
      for (int bj = 0; bj < 2; ++bj)
#pragma unroll
        for (int n = 0; n < 2; ++n) gv[bj][n] = *(const f32x4*)(gain + 32 * bj + 16 * n + 4 * fq);
    }
#pragma unroll
    for (int ai = 0; ai < 2; ++ai)
#pragma unroll
      for (int m = 0; m < 4; ++m) {
        f32x4 v[2][2];
#pragma unroll
        for (int bj = 0; bj < 2; ++bj)
#pragma unroll
          for (int n = 0; n < 2; ++n) v[bj][n] = acc[ai][bj][m][n];
        const int row = rowb + 128 * ai + 16 * m;
        if (gain) {
          float ss = 0.f;
#pragma unroll
          for (int bj = 0; bj < 2; ++bj)
#pragma unroll
            for (int n = 0; n < 2; ++n)
#pragma unroll
              for (int i = 0; i < 4; ++i) ss += v[bj][n][i] * v[bj][n][i];
          ss += __shfl_xor(ss, 16);
          ss += __shfl_xor(ss, 32);
          const float rstd = rsqrtf(ss * (1.0f / 64.0f) + EPS);
#pragma unroll
          for (int bj = 0; bj < 2; ++bj)
#pragma unroll
            for (int n = 0; n < 2; ++n) v[bj][n] = v[bj][n] * rstd * gv[bj][n];
        }
        if (rope) {
          const int pos = row & (T - 1);
#pragma unroll
          for (int n = 0; n < 2; ++n) {
            const f32x4* tp = (const f32x4*)(ropetab + ((size_t)pos * 32 + 16 * n + 4 * fq) * 2);
            const f32x4 t0 = tp[0], t1 = tp[1];
            const float cs[4] = {t0[0], t0[2], t1[0], t1[2]}, sn[4] = {t0[1], t0[3], t1[1], t1[3]};
#pragma unroll
            for (int i = 0; i < 4; ++i) {
              const float y1 = v[0][n][i], y2 = v[1][n][i];
              v[0][n][i] = y1 * cs[i] - y2 * sn[i];
              v[1][n][i] = y2 * cs[i] + y1 * sn[i];
            }
          }
        }
#pragma unroll
        for (int bj = 0; bj < 2; ++bj)
#pragma unroll
          for (int n = 0; n < 2; ++n) {
            f32x4 y = v[bj][n] * post;
            if (silu) {
#pragma unroll
              for (int i = 0; i < 4; ++i) y[i] = siluf_(y[i]);
            }
            u32x2 w = {cvtpk(y[0], y[1]), cvtpk(y[2], y[3])};
            *(u32x2*)(dst + (size_t)row * ld + col0 + 32 * bj + 16 * n + 4 * fq) = w;
          }
      }
  }
};
struct EpiMemKV {
  static constexpr bool PERM = false, AFTER_DRAIN = false;
  const Params* pp;
  __device__ __forceinline__ void operator()(f32x4 (&acc)[2][2][4][2], const pg8::Unit& u, int wr, int wc, int fr, int fq) const {
    kparams_t kp_ = kparams(); (void)kp_;
    const int U = u.pn * 4 + wc;
    const int rowb = u.pm * 256 + wr * 64 + fr;
#pragma unroll
    for (int ai = 0; ai < 2; ++ai)
#pragma unroll
      for (int m = 0; m < 4; ++m) {
        const int row = rowb + 128 * ai + 16 * m;
#pragma unroll
        for (int bj = 0; bj < 2; ++bj)
#pragma unroll
          for (int n = 0; n < 2; ++n) {
            const f32x4 v = acc[ai][bj][m][n];
            const unsigned w0 = cvtpk(v[0], v[1]), w1 = cvtpk(v[2], v[3]);
            const int e = 32 * bj + 16 * n + 4 * fq;
            if (U < 8) {
              u32x2 w = {w0, w1};
              *(u32x2*)(WSP(bf16_t, OFF_MK) + (size_t)row * 512 + U * 64 + e) = w;
            } else {
              const int col = (U - 8) * 64 + e, h = col >> 7, d = col & 127, b = row >> 8, mm = row & 255;
              bf16_t* q = WSP(bf16_t, OFF_MVT) + (size_t)((b * 4 + h) * 128 + d) * 256 + mm;
              q[0] = (bf16_t)(w0 & 0xffffu); q[256] = (bf16_t)(w0 >> 16); q[512] = (bf16_t)(w1 & 0xffffu); q[768] = (bf16_t)(w1 >> 16);
            }
          }
      }
  }
};
struct EpiGate {
  static constexpr bool PERM = true, AFTER_DRAIN = false;
  bf16_t* G;
  __device__ __forceinline__ void operator()(f32x4 (&acc)[2][2][4][2], const pg8::Unit& u, int wr, int wc, int fr, int fq) const {
    const int br = u.pn >> 2, colt = (u.pn & 3) * 256 + wc * 32 + 8 * fq;
    bf16_t* base = G + (size_t)br * M * 1024;
    const int rowb = u.pm * 256 + wr * 64 + fr;
#pragma unroll
    for (int ai = 0; ai < 2; ++ai)
#pragma unroll
      for (int m = 0; m < 4; ++m) {
        bf16_t* rp = base + (size_t)(rowb + 128 * ai + 16 * m) * 1024 + colt;
#pragma unroll
        for (int bj = 0; bj < 2; ++bj) {
          const f32x4 v0 = acc[ai][bj][m][0], v1 = acc[ai][bj][m][1];
          u32x4 w = {cvtpk(sigmoidf_(v0[0]), sigmoidf_(v0[1])), cvtpk(sigmoidf_(v0[2]), sigmoidf_(v0[3])),
                     cvtpk(sigmoidf_(v1[0]), sigmoidf_(v1[1])), cvtpk(sigmoidf_(v1[2]), sigmoidf_(v1[3]))};
          *(u32x4*)(rp + 128 * bj) = w;
        }
      }
  }
};
struct EpiBranch {
  static constexpr bool PERM = true, AFTER_DRAIN = false;
  const bf16_t* G; bf16_t* Uo; int first;
  __device__ __forceinline__ void operator()(f32x4 (&acc)[2][2][4][2], const pg8::Unit& u, int wr, int wc, int fr, int fq) const {
    const int colt = u.pn * 256 + wc * 32 + 8 * fq;
    const int rowb = u.pm * 256 + wr * 64 + fr;
#pragma unroll
    for (int ai = 0; ai < 2; ++ai)
#pragma unroll
      for (int m = 0; m < 4; ++m) {
        const size_t ro = (size_t)(rowb + 128 * ai + 16 * m) * 1024 + colt;
#pragma unroll
        for (int bj = 0; bj < 2; ++bj) {
          const size_t off = ro + 128 * bj;
          const u32x4 gw = *(const u32x4*)(G + off);
          float y[8];
#pragma unroll
          for (int q = 0; q < 4; ++q) {
            const f32x4 v = acc[ai][bj][m][q >> 1];
            y[2 * q] = v[(2 * q) & 3] * bflo(gw[q]);
            y[2 * q + 1] = v[(2 * q + 1) & 3] * bfhi(gw[q]);
          }
          if (!first) {
            const u32x4 uw = *(const u32x4*)(Uo + off);
#pragma unroll
            for (int q = 0; q < 4; ++q) { y[2 * q] += bflo(uw[q]); y[2 * q + 1] += bfhi(uw[q]); }
          }
          u32x4 w = {cvtpk(y[0], y[1]), cvtpk(y[2], y[3]), cvtpk(y[4], y[5]), cvtpk(y[6], y[7])};
          *(u32x4*)(Uo + off) = w;
        }
      }
  }
};
struct EpiOut {
  static constexpr bool PERM = true, AFTER_DRAIN = false;
  const float* xin; float* xout;
  __device__ __forceinline__ void operator()(f32x4 (&acc)[2][2][4][2], const pg8::Unit& u, int wr, int wc, int fr, int fq) const {
    const int colt = u.pn * 256 + wc * 32 + 8 * fq;
    const int rowb = u.pm * 256 + wr * 64 + fr;
#pragma unroll
    for (int ai = 0; ai < 2; ++ai)
#pragma unroll
      for (int m = 0; m < 4; ++m) {
        const size_t ro = (size_t)(rowb + 128 * ai + 16 * m) * 1024 + colt;
#pragma unroll
        for (int bj = 0; bj < 2; ++bj) {
          const size_t off = ro + 128 * bj;
          const f32x4 x0 = *(const f32x4*)(xin + off), x1 = *(const f32x4*)(xin + off + 4);
          *(f32x4*)(xout + off) = x0 + acc[ai][bj][m][0];
          *(f32x4*)(xout + off + 4) = x1 + acc[ai][bj][m][1];
        }
      }
  }
};
template <class Epi>
__device__ __forceinline__ void run_gemm(PG8_LAS unsigned char* lds, const bf16_t* A, const bf16_t* Bt, int Mr, int Nc, int K, const Epi& E) {
  pg8::Gemm g{A, Bt, Mr, Nc, K};
  pg8::StaticOrder S;
  S.init(Mr, Nc, gdim(), bidx());
  pg8::gemm_phase<Epi, pg8::StaticOrder, true, true>(lds, g, S, E);
}

__device__ __forceinline__ int map_in(int n) {
  const int i = n >> 6, c = n & 63;
  if (i < 20) return n;
  if (i < 28) return 1304 + (n - 1280);
  if (i < 52) return 1816 + (n - 1792);
  if (i < 60) return 3360 + (n - 3328);
  if (i < 68) return 3872 + (n - 3840);
  if (i < 76) return 4384 + (n - 4352);
  if (i == 76) return c < 24 ? 1280 + c : (c < 32 ? 3352 + (c - 24) : -1);
  return -1;
}
__device__ __forceinline__ void wave_transpose_tile(const float* __restrict__ src, int ld_src, int k0, int n0, bf16_t* __restrict__ dst,
                                                    int Kdim, int maptype, int srccol0, float* tile, int lane) {
  int nlog = n0 + lane;
  if (maptype) { const int w = nlog & 255; nlog = (nlog & ~255) + (((w & 127) >> 5) << 6) + (((w >> 7) << 5) | (w & 31)); }
  const int sc = (maptype == 1) ? map_in(nlog) : srccol0 + nlog;
  const float* sp = src + (size_t)k0 * ld_src + (sc >= 0 ? sc : 0);
#pragma unroll 16
  for (int kk = 0; kk < 64; ++kk) {
    const float v = sp[(size_t)kk * ld_src];
    tile[kk * 65 + lane] = sc >= 0 ? v : 0.f;
  }
  __builtin_amdgcn_fence(__ATOMIC_SEQ_CST, "workgroup");
  __builtin_amdgcn_wave_barrier();
  const int rsub = lane >> 5, kp = lane & 31;
#pragma unroll 8
  for (int it = 0; it < 32; ++it) {
    const int row = 2 * it + rsub;
    const float a = tile[(2 * kp) * 65 + row], b = tile[(2 * kp + 1) * 65 + row];
    *(unsigned*)(dst + (size_t)(n0 + row) * Kdim + k0 + 2 * kp) = cvtpk(a, b);
  }
  __builtin_amdgcn_fence(__ATOMIC_SEQ_CST, "workgroup");
  __builtin_amdgcn_wave_barrier();
}
__device__ __forceinline__ void rmsnorm4(const float* __restrict__ x, const float* __restrict__ gain, bf16_t* __restrict__ dst, size_t row0, int lane) {
  f32x4 v[4][4];
  float ss[4];
#pragma unroll
  for (int rr = 0; rr < 4; ++rr)
#pragma unroll
    for (int i = 0; i < 4; ++i) v[rr][i] = *(const f32x4*)(x + (row0 + rr) * 1024 + lane * 4 + 256 * i);
  f32x4 gv[4];
#pragma unroll
  for (int i = 0; i < 4; ++i) gv[i] = *(const f32x4*)(gain + lane * 4 + 256 * i);
#pragma unroll
  for (int rr = 0; rr < 4; ++rr) {
    float s = 0.f;
#pragma unroll
    for (int i = 0; i < 4; ++i) s += v[rr][i][0] * v[rr][i][0] + v[rr][i][1] * v[rr][i][1] + v[rr][i][2] * v[rr][i][2] + v[rr][i][3] * v[rr][i][3];
    ss[rr] = s;
  }
#pragma unroll
  for (int o_ = 1; o_ < 64; o_ <<= 1) {
#pragma unroll
    for (int rr = 0; rr < 4; ++rr) ss[rr] += __shfl_xor(ss[rr], o_);
  }
#pragma unroll
  for (int rr = 0; rr < 4; ++rr) {
    const float rstd = rsqrtf(ss[rr] * (1.0f / 1024.0f) + EPS);
#pragma unroll
    for (int i = 0; i < 4; ++i) {
      const f32x4 y = v[rr][i] * rstd * gv[i];
      u32x2 w = {cvtpk(y[0], y[1]), cvtpk(y[2], y[3])};
      *(u32x2*)(dst + (row0 + rr) * 1024 + lane * 4 + 256 * i) = w;
    }
  }
}
__device__ __forceinline__ void phase_prep(const Params& p, int l, float* smem) {
  kparams_t kp_ = kparams(); (void)kp_;
  const int tid = tidx();
  const int wave = tid >> 6, lane = tid & 63;
  const int gw = wave * gdim() + bidx(), nw = NWAVES * gdim();
  if (l == 0 && bidx() == 0 && tid < 64) WSP(unsigned, OFF_CTL)[tid] = 0u;
  const float* xin = (l == 0) ? kp_->x : kp_->out;
  float* wtile = smem + wave * 4160;
  for (int u0 = gw; u0 < 3076; u0 += nw) {
    int u = u0;
    const float* src; int ld, kt, nt, Kd, mt = 0, c0 = 0; bf16_t* dst;
    if (u < 1280) { kt = u / 80; nt = u % 80; src = kp_->w_in + (size_t)l * 1024 * 7968; ld = 7968; Kd = 1024; dst = WSP(bf16_t, OFF_W_IN); mt = 1; }
    else if ((u -= 1280) < 768) { kt = u / 48; nt = u % 48; src = kp_->w_in + (size_t)l * 1024 * 7968; ld = 7968; Kd = 1024; dst = WSP(bf16_t, OFF_W_G); c0 = 4896; }
    else if ((u -= 768) < 256) { kt = u / 16; nt = u % 16; src = kp_->w_mem_kv + (size_t)l * 1024 * 1024; ld = 1024; Kd = 1024; dst = WSP(bf16_t, OFF_W_MKV); mt = 2; }
    else if ((u -= 256) < 384) { const int br = u / 128, uu = u % 128; kt = uu / 16; nt = uu % 16;
      src = (br == 0 ? kp_->w_branch_a : br == 1 ? kp_->w_branch_b : kp_->w_branch_m) + (size_t)l * 512 * 1024; ld = 1024; Kd = 512; dst = WSP(bf16_t, OFF_W_BR + (size_t)br * MiB); }
    else if ((u -= 384) < 256) { kt = u / 16; nt = u % 16; src = kp_->w_out + (size_t)l * 1024 * 1024; ld = 1024; Kd = 1024; dst = WSP(bf16_t, OFF_W_OUT); }
    else if ((u -= 256) < 128) { const int kv = u / 64, uu = u % 64; kt = uu / 2; nt = uu % 2;
      src = (kv ? kp_->cmp_w1_v : kp_->cmp_w1_k) + (size_t)l * 2048 * 128; ld = 128; Kd = 2048; dst = WSP(bf16_t, OFF_W1 + (size_t)kv * 512 * 1024); }
    else { u -= 128; const int kv = u / 2; kt = u % 2; nt = 0;
      src = (kv ? kp_->cmp_w2_v : kp_->cmp_w2_k) + (size_t)l * 128 * 64; ld = 64; Kd = 128; dst = WSP(bf16_t, OFF_W2 + (size_t)kv * 64 * 1024); }
    wave_transpose_tile(src, ld, kt * 64, nt * 64, dst, Kd, mt, c0, wtile, lane);
  }
  for (int grp = gw; grp < 8192 + 256; grp += nw) {
    if (grp < 8192) rmsnorm4(xin, kp_->norm_g + l * 1024, WSP(bf16_t, OFF_H), (size_t)grp * 4, lane);
    else rmsnorm4(kp_->mem, kp_->mem_norm_g + l * 1024, WSP(bf16_t, OFF_MEMN), (size_t)(grp - 8192) * 4, lane);
  }
  for (int u = gw; u < 32; u += nw) {
    const int kv = u >> 4, ch = u & 15;
    const float* pe = (kv ? kp_->cmp_pe_v : kp_->cmp_pe_k) + (size_t)l * 2048 + ch * 128;
    const float* w1 = (kv ? kp_->cmp_w1_v : kp_->cmp_w1_k) + (size_t)l * 2048 * 128 + (size_t)ch * 128 * 128;
    float s0 = 0.f, s1 = 0.f;
#pragma unroll 16
    for (int kk = 0; kk < 128; ++kk) {
      const float pv = pe[kk];
      s0 += pv * w1[(size_t)kk * 128 + lane];
      s1 += pv * w1[(size_t)kk * 128 + 64 + lane];
    }
    float* part = WSP(float, OFF_C1) + (size_t)(kv * 16 + ch) * 128;
    part[lane] = s0;
    part[64 + lane] = s1;
  }
  if (l == 0) {
    for (int u = bidx(); u < 512; u += gdim()) {
      for (int e = tid; e < 512; e += NTHREADS) {
        const int idx = u * 512 + e, pos = idx >> 5, f = idx & 31;
        const float ang = (float)pos * c_inv_freq[f];
        const double a = (double)ang;
        const double k = rint(a * 0.15915494309189535);
        const float rr = (float)(a - k * 6.283185307179586);
        float2 cs; cs.x = __cosf(rr); cs.y = __sinf(rr);
        WSP(float2, OFF_ROPE)[idx] = cs;
      }
    }
  }
}

__device__ __forceinline__ void compress_wg(const Params& p, int l, int up, float* smem) {
  kparams_t kp_ = kparams(); (void)kp_;
  const int wave_ = tidx() >> 6, kc = wave_ & 3, u = up * 2 + (wave_ >> 2);
  const int lane = tidx() & 63, r = lane & 15, g4 = lane >> 4;
  const int kv = u >> 7, rem = u & 127, b = rem >> 5, grp = (rem >> 4) & 1, it = rem & 15, i0 = it * 32;
  const bf16_t* src = WSP(bf16_t, kv ? OFF_VC : OFF_KC);
  const bf16_t* w1t = WSP(bf16_t, OFF_W1 + (size_t)kv * 512 * 1024);
  const bf16_t* w2t = WSP(bf16_t, OFF_W2 + (size_t)kv * 64 * 1024);
  const float* c1 = WSP(float, OFF_C1 + 16384) + kv * 128;
  const bf16_t* arow[2];
#pragma unroll
  for (int mt = 0; mt < 2; ++mt) {
    int i = i0 + 16 * mt + r;
    if (i > 510) i = 510;
    arow[mt] = src + ((size_t)b * T + 16 * i) * 128 + grp * 64 + g4 * 8;
  }
  f32x4 acc[2][8];
#pragma unroll
  for (int a = 0; a < 2; ++a)
#pragma unroll
    for (int c = 0; c < 8; ++c) acc[a][c] = (f32x4){0.f, 0.f, 0.f, 0.f};
  const bf16_t* bp = w1t + (size_t)r * 2048 + g4 * 8;
#pragma unroll 1
  for (int k0 = kc * 512; k0 < kc * 512 + 512; k0 += 32) {
    const int pp = k0 >> 6, d = k0 & 63;
    bf16x8 af[2], bf[8];
#pragma unroll
    for (int mt = 0; mt < 2; ++mt) af[mt] = *(const bf16x8*)(arow[mt] + (size_t)pp * 128 + d);
#pragma unroll
    for (int nt = 0; nt < 8; ++nt) bf[nt] = *(const bf16x8*)(bp + (size_t)nt * 16 * 2048 + k0);
#pragma unroll
    for (int mt = 0; mt < 2; ++mt)
#pragma unroll
      for (int nt = 0; nt < 8; ++nt) acc[mt][nt] = mfma16(bf[nt], af[mt], acc[mt][nt]);
  }
  {
    float* part = smem + wave_ * 4096;
#pragma unroll
    for (int a = 0; a < 2; ++a)
#pragma unroll
      for (int c = 0; c < 8; ++c)
#pragma unroll
        for (int i = 0; i < 4; ++i) part[((a * 8 + c) * 4 + i) * 64 + lane] = acc[a][c][i];
  }
  __syncthreads();
  if (kc != 0) return;
#pragma unroll 1
  for (int q = 1; q < 4; ++q) {
    const float* part = smem + (wave_ + q) * 4096;
#pragma unroll
    for (int a = 0; a < 2; ++a) {
#pragma unroll
      for (int c = 0; c < 8; ++c)
#pragma unroll
        for (int i = 0; i < 4; ++i) acc[a][c][i] += part[((a * 8 + c) * 4 + i) * 64 + lane];
      asm volatile("" ::: "memory");
    }
  }
#pragma unroll
  for (int nt = 0; nt < 8; ++nt) {
    const f32x4 cv = *(const f32x4*)(c1 + 16 * nt + 4 * g4);
#pragma unroll
    for (int mt = 0; mt < 2; ++mt)
#pragma unroll
      for (int i = 0; i < 4; ++i) acc[mt][nt][i] = siluf_(acc[mt][nt][i] + cv[i]);
  }
  bf16x8 wf[4][4];
#pragma unroll
  for (int ks = 0; ks < 4; ++ks)
#pragma unroll
    for (int et = 0; et < 4; ++et) {
      const bf16_t* wp = w2t + (size_t)(16 * et + r) * 128 + 32 * ks + 4 * g4;
      const u32x2 lo = *(const u32x2*)wp, hi = *(const u32x2*)(wp + 16);
      u32x4 w = {lo[0], lo[1], hi[0], hi[1]};
      wf[ks][et] = __builtin_bit_cast(bf16x8, w);
    }
  if (kv == 0) {
    const float* gain = kp_->nsa_k_norm + (size_t)(l * 3 + 0) * 64;
    bf16_t* dst = WSP(bf16_t, OFF_KCMP) + (size_t)((b * 2 + grp) * 512) * 64;
    f32x4 gv[4];
#pragma unroll
    for (int et = 0; et < 4; ++et) gv[et] = *(const f32x4*)(gain + 16 * et + 4 * g4);
#pragma unroll
    for (int mt = 0; mt < 2; ++mt) {
      f32x4 o[4];
#pragma unroll
      for (int et = 0; et < 4; ++et) o[et] = (f32x4){0.f, 0.f, 0.f, 0.f};
#pragma unroll
      for (int ks = 0; ks < 4; ++ks) {
        const bf16x8 xf = pack8(acc[mt][2 * ks], acc[mt][2 * ks + 1]);
#pragma unroll
        for (int et = 0; et < 4; ++et) o[et] = mfma16(wf[ks][et], xf, o[et]);
      }
      float ss = 0.f;
#pragma unroll
      for (int et = 0; et < 4; ++et)
#pragma unroll
        for (int i = 0; i < 4; ++i) ss += o[et][i] * o[et][i];
      ss += __shfl_xor(ss, 16);
      ss += __shfl_xor(ss, 32);
      const float rstd = rsqrtf(ss * (1.0f / 64.0f) + EPS);
      const int i = i0 + 16 * mt + r;
#pragma unroll
      for (int et = 0; et < 4; ++et) {
        f32x4 y = o[et] * rstd * gv[et];
        if (i > 510) y = (f32x4){0.f, 0.f, 0.f, 0.f};
        u32x2 w = {cvtpk(y[0], y[1]), cvtpk(y[2], y[3])};
        *(u32x2*)(dst + (size_t)i * 64 + 16 * et + 4 * g4) = w;
      }
    }
  } else {
    bf16_t* dst = WSP(bf16_t, OFF_VCT) + (size_t)((b * 2 + grp) * 64) * 512;
#pragma unroll
    for (int mt = 0; mt < 2; ++mt) {
      f32x4 o[4];
#pragma unroll
      for (int et = 0; et < 4; ++et) o[et] = (f32x4){0.f, 0.f, 0.f, 0.f};
#pragma unroll
      for (int ks = 0; ks < 4; ++ks) {
        const bf16x8 xf = pack8(acc[mt][2 * ks], acc[mt][2 * ks + 1]);
#pragma unroll
        for (int et = 0; et < 4; ++et) o[et] = mfma16(xf, wf[ks][et], o[et]);
      }
#pragma unroll
      for (int et = 0; et < 4; ++et) {
        f32x4 y = o[et];
        const int ib = i0 + 16 * mt + 4 * g4;
#pragma unroll
        for (int i = 0; i < 4; ++i)
          if (ib + i > 510) y[i] = 0.f;
        u32x2 w = {cvtpk(y[0], y[1]), cvtpk(y[2], y[3])};
        *(u32x2*)(dst + (size_t)(16 * et + r) * 512 + ib) = w;
      }
    }
  }
}
__device__ __forceinline__ void cumsum_wg(const Params& p, int u, float* smem) {
  kparams_t kp_ = kparams(); (void)kp_;
  const int tid = tidx(), lane = tid & 63, wave = tid >> 6, b = u >> 3, h = u & 7;
  const float* fl = WSP(float, OFF_FLOG) + ((size_t)b * T) * 8 + h;
  float* fc = WSP(float, OFF_FC) + (size_t)(b * 8 + h) * T;
  const int tb = tid * 16;
  float v[16];
#pragma unroll
  for (int i = 0; i < 16; ++i) v[i] = fl[(size_t)(tb + i) * 8];
  double s = 0.0;
#pragma unroll
  for (int i = 0; i < 16; ++i) s += (double)v[i];
  double incl = s;
#pragma unroll
  for (int o = 1; o < 64; o <<= 1) {
    const double y = __shfl_up(incl, o);
    if (lane >= o) incl += y;
  }
  double* wtot = (double*)smem;
  if (lane == 63) wtot[wave] = incl;
  __syncthreads();
  double base = 0.0;
  for (int w = 0; w < wave; ++w) base += wtot[w];
  double run = base + incl - s;
#pragma unroll
  for (int i = 0; i < 16; ++i) { run += (double)v[i]; v[i] = (float)run; }
#pragma unroll
  for (int i = 0; i < 4; ++i) *(f32x4*)(fc + tb + 4 * i) = (f32x4){v[4 * i], v[4 * i + 1], v[4 * i + 2], v[4 * i + 3]};
  __syncthreads();
}
__device__ __forceinline__ void memk_norm_unit(const Params& p, int l, int u) {
  kparams_t kp_ = kparams(); (void)kp_;
  const int lane = tidx() & 63;
  bf16_t* mk = WSP(bf16_t, OFF_MK);
  const float* gain = kp_->mem_k_norm + l * 128 + (lane & 15) * 8;
  for (int rr = 0; rr < 16; ++rr) {
    bf16_t* ptr = mk + (size_t)(u * 16 + rr) * 512 + lane * 8;
    const u32x4 w = *(const u32x4*)ptr;
    float v[8];
#pragma unroll
    for (int j = 0; j < 4; ++j) { v[2 * j] = bflo(w[j]); v[2 * j + 1] = bfhi(w[j]); }
    float ss = 0.f;
#pragma unroll
    for (int j = 0; j < 8; ++j) ss += v[j] * v[j];
#pragma unroll
    for (int o = 1; o < 16; o <<= 1) ss += __shfl_xor(ss, o);
    const float rstd = rsqrtf(ss * (1.0f / 128.0f) + EPS);
    u32x4 ow;
#pragma unroll
    for (int j = 0; j < 4; ++j) ow[j] = cvtpk(v[2 * j] * rstd * gain[2 * j], v[2 * j + 1] * rstd * gain[2 * j + 1]);
    *(u32x4*)ptr = ow;
  }
}
__device__ __forceinline__ void phase_mid(const Params& p, int l, float* smem) {
  const int wave = tidx() >> 6;
  for (int u = bidx(); u < 128 + 32 + 8; u += gdim()) {
    if (u < 128) { compress_wg(p, l, u, smem); __syncthreads(); }
    else if (u < 160) cumsum_wg(p, u - 128, smem);
    else memk_norm_unit(p, l, (u - 160) * 8 + wave);
  }
}

template <int NCT, int NDK, bool QL = false>
__device__ __forceinline__ void qk_scores(const bf16_t* __restrict__ kbase, int ldk, int key0,
                                          const bf16x8 (&qf)[NCT][NDK], f32x4 (&s)[2][NCT], int lane, const bf16x8* qlds = nullptr) {
  const int r = lane & 15, grp = lane >> 4;
#pragma unroll
  for (int kt = 0; kt < 2; ++kt) {
    const bf16_t* kp = kbase + (size_t)(key0 + 8 * (r >> 2) + 4 * kt + (r & 3)) * ldk + grp * 8;
    bf16x8 kf[NDK];
#pragma unroll
    for (int dk = 0; dk < NDK; ++dk) kf[dk] = *(const bf16x8*)(kp + dk * 32);
#pragma unroll
    for (int ct = 0; ct < NCT; ++ct) {
      f32x4 a = {0.f, 0.f, 0.f, 0.f};
#pragma unroll
      for (int dk = 0; dk < NDK; ++dk) a = mfma16(kf[dk], QL ? qlds[(ct * NDK + dk) * 64 + lane] : qf[ct][dk], a);
      s[kt][ct] = a;
    }
  }
}
template <int NCT, int NDT>
__device__ __forceinline__ void pv_accum(const bf16_t* __restrict__ vt, size_t ldv, int key0,
                                         const f32x4 (&s)[2][NCT], f32x4 (&o)[NDT][NCT], int lane) {
  const int r = lane & 15, grp = lane >> 4;
  bf16x8 pb[NCT];
#pragma unroll
  for (int ct = 0; ct < NCT; ++ct) pb[ct] = pack8(s[0][ct], s[1][ct]);
#pragma unroll
  for (int dt = 0; dt < NDT; ++dt) {
    const bf16x8 vf = *(const bf16x8*)(vt + (size_t)(16 * dt + r) * ldv + key0 + 8 * grp);
#pragma unroll
    for (int ct = 0; ct < NCT; ++ct) o[dt][ct] = mfma16(vf, pb[ct], o[dt][ct]);
  }
}
template <int NCT, int NDT, bool HAS_O, bool SUMS = true>
__device__ __forceinline__ void softmax_update(f32x4 (&s)[2][NCT], float (&m)[NCT], float (&lsum)[NCT],
                                               f32x4 (&o)[NDT][NCT], f32x4 (*lacc)[NCT] = nullptr) {
  float mnew[NCT];
  bool ch = false;
#pragma unroll
  for (int ct = 0; ct < NCT; ++ct) {
    float mx = fmaxf(fmaxf(fmaxf(s[0][ct][0], s[0][ct][1]), fmaxf(s[0][ct][2], s[0][ct][3])),
                     fmaxf(fmaxf(s[1][ct][0], s[1][ct][1]), fmaxf(s[1][ct][2], s[1][ct][3])));
    mx = grp_max4(mx);
    mnew[ct] = fmaxf(m[ct], mx);
    ch = ch || (mnew[ct] > m[ct]);
  }
  if (__any(ch)) {
#pragma unroll
    for (int ct = 0; ct < NCT; ++ct) {
      const float msafe = (mnew[ct] == NEG_INF) ? 0.f : mnew[ct];
      const float alpha = __builtin_amdgcn_exp2f(m[ct] - msafe);
      m[ct] = mnew[ct];
      if (SUMS) lsum[ct] *= alpha; else (*lacc)[ct] = (*lacc)[ct] * alpha;
      if (HAS_O) {
#pragma unroll
        for (int dt = 0; dt < NDT; ++dt) o[dt][ct] = o[dt][ct] * alpha;
      }
    }
  }
#pragma unroll
  for (int ct = 0; ct < NCT; ++ct) {
    const float msafe = (m[ct] == NEG_INF) ? 0.f : m[ct];
#pragma unroll
    for (int kt = 0; kt < 2; ++kt) {
      const f32x4 d = s[kt][ct] - msafe;
      f32x4 pv;
#pragma unroll
      for (int i = 0; i < 4; ++i) pv[i] = __builtin_amdgcn_exp2f(d[i]);
      s[kt][ct] = pv;
    }
    if (SUMS) {
      const f32x4 t4 = s[0][ct] + s[1][ct];
      lsum[ct] += (t4[0] + t4[1]) + (t4[2] + t4[3]);
    }
  }
}
__device__ __forceinline__ float finish_l(float lsum) {
  lsum += __shfl_xor(lsum, 16);
  lsum += __shfl_xor(lsum, 32);
  return lsum > 0.f ? 1.0f / lsum : 0.f;
}

typedef __attribute__((address_space(3))) unsigned char lds_u8;
constexpr int TILE_ROWB = 144, TILE_HALF = 64 * TILE_ROWB, TILE_STAGE = 2 * TILE_HALF + 256;
struct TileRegs { u32x4 k, v; };
__device__ __forceinline__ void tile_gload(TileRegs& tr, const bf16_t* __restrict__ kbase, int ldk, const bf16_t* __restrict__ vtbase,
                                           size_t ldv, int key0, int tid) {
  const int row = tid >> 3, ch = tid & 7;
  tr.k = *(const u32x4*)(kbase + (size_t)(key0 + row) * ldk + ch * 8);
  tr.v = *(const u32x4*)(vtbase + (size_t)row * ldv + key0 + ch * 8);
}
__device__ __forceinline__ void tile_swrite(const TileRegs& tr, lds_u8* stage, int tid) {
  const int row = tid >> 3, ch = tid & 7;
  *(__attribute__((address_space(3))) u32x4*)(stage + row * TILE_ROWB + ch * 16) = tr.k;
  *(__attribute__((address_space(3))) u32x4*)(stage + TILE_HALF + row * TILE_ROWB + ch * 16) = tr.v;
}
template <int NCT, int NDK, bool QL>
__device__ __forceinline__ void qk_scores_lds(const lds_u8* stage, int hf, const bf16x8 (&qf)[NCT][NDK], f32x4 (&s)[2][NCT], int lane,
                                              const bf16x8* qlds, const f32x4 c0, const f32x4 c1) {
  const int r = lane & 15, grp = lane >> 4;
#pragma unroll
  for (int kt = 0; kt < 2; ++kt) {
    const lds_u8* kp = stage + (32 * hf + 8 * (r >> 2) + 4 * kt + (r & 3)) * TILE_ROWB + grp * 16;
    bf16x8 kf[NDK];
#pragma unroll
    for (int dk = 0; dk < NDK; ++dk) kf[dk] = *(const __attribute__((address_space(3))) bf16x8*)(kp + dk * 64);
#pragma unroll
    for (int ct = 0; ct < NCT; ++ct) {
      f32x4 a = kt ? c1 : c0;
#pragma unroll
      for (int dk = 0; dk < NDK; ++dk) a = mfma16(kf[dk], QL ? qlds[(ct * NDK + dk) * 64 + lane] : qf[ct][dk], a);
      s[kt][ct] = a;
    }
  }
}
template <int NDT>
__device__ __forceinline__ void v_frags_lds(const lds_u8* stage, int hf, bf16x8 (&vf)[NDT], int lane) {
  const int r = lane & 15, grp = lane >> 4;
#pragma unroll
  for (int dt = 0; dt < NDT; ++dt)
    vf[dt] = *(const __attribute__((address_space(3))) bf16x8*)(stage + TILE_HALF + (16 * dt + r) * TILE_ROWB + (32 * hf + 8 * grp) * 2);
}
template <int NCT, int NDT>
__device__ __forceinline__ void pv_accum_lds(const bf16x8 (&vfp)[NDT], const f32x4 (&s)[2][NCT], f32x4 (&o)[NDT][NCT], int lane, f32x4 (&lacc)[NCT]) {
  const int r = lane & 15, grp = lane >> 4; (void)r; (void)grp;
  bf16x8 pb[NCT];
#pragma unroll
  for (int ct = 0; ct < NCT; ++ct) pb[ct] = pack8(s[0][ct], s[1][ct]);
  {
    const short one = (short)0x3F80;
    const bf16x8 ones = {one, one, one, one, one, one, one, one};
#pragma unroll
    for (int ct = 0; ct < NCT; ++ct) lacc[ct] = mfma16(ones, pb[ct], lacc[ct]);
  }
#pragma unroll
  for (int dt = 0; dt < NDT; ++dt) {
    const bf16x8 vf = vfp[dt];
#pragma unroll
    for (int ct = 0; ct < NCT; ++ct) o[dt][ct] = mfma16(vf, pb[ct], o[dt][ct]);
  }
}
__device__ __forceinline__ int next_bit(unsigned long long lo, unsigned long long hi, int from) {
  if (from < 64) { const unsigned long long mm = lo & (~0ull << from); if (mm) return __ffsll(mm) - 1; from = 64; }
  if (from < 128) { const unsigned long long mm = hi & (~0ull << (from - 64)); if (mm) return 64 + __ffsll(mm) - 1; }
  return 128;
}

__device__ __forceinline__ void nsa_wg_unit(const Params& p, int b, int g, int qi, float* imp, bf16x8* qlds, float* scr, lds_u8* tiles, unsigned* misc, bool st) {
  kparams_t kp_ = kparams(); (void)kp_;
  const int tid0 = tidx();
  const int wave = __builtin_amdgcn_readfirstlane(tid0 >> 6);
  const int lane0 = tid0 & 63;
  const int tq = qi * 8 + wave;
  const int t0 = tq * 16;
  const bf16x8 (&qf)[4][2] = *(const bf16x8 (*)[4][2])nullptr;
#define NSA_SECTION_VARS \
  int lane = lane0; asm volatile("" : "+v"(lane)); \
  const int r = lane & 15, grp = lane >> 4, t = t0 + r; \
  const size_t row = (size_t)b * T + t; \
  const float* gatep = WSP(float, OFF_GATE) + row * 24 + g * 12; (void)gatep; (void)grp; (void)t;
  {
    NSA_SECTION_VARS
#pragma unroll
    for (int ct = 0; ct < 4; ++ct)
#pragma unroll
      for (int dk = 0; dk < 2; ++dk)
        qlds[(ct * 2 + dk) * 64 + lane] = *(const bf16x8*)(WSP(bf16_t, OFF_QN) + row * 512 + (g * 4 + ct) * 64 + dk * 32 + grp * 8);
  }
  f32x4 o[4][4];
  float m[4], lsum[4];
  f32x4 lacc[4];
  {
    NSA_SECTION_VARS
    const bf16_t* kc = WSP(bf16_t, OFF_KCMP) + (size_t)((b * 2 + g) * 512) * 64;
    const bf16_t* vct = WSP(bf16_t, OFF_VCT) + (size_t)((b * 2 + g) * 64) * 512;
    const int nblk = (tq + 31) >> 5;
#pragma unroll
    for (int ct = 0; ct < 4; ++ct) { m[ct] = NEG_INF; lsum[ct] = 0.f; }
#pragma unroll 1
    for (int blk = 0; blk < nblk; ++blk) {
      f32x4 s[2][4];
      qk_scores<4, 2, true>(kc, 64, blk * 32, qf, s, lane, qlds);
#pragma unroll
      for (int kt = 0; kt < 2; ++kt)
#pragma unroll
        for (int i = 0; i < 4; ++i) {
          const int n = blk * 32 + 8 * grp + 4 * kt + i;
          const bool ok = (16 * n + 31 <= t);
#pragma unroll
          for (int ct = 0; ct < 4; ++ct) s[kt][ct][i] = ok ? s[kt][ct][i] : NEG_INF;
        }
      softmax_update<4, 4, false>(s, m, lsum, o);
    }
    float invl[4], msafe[4];
#pragma unroll
    for (int ct = 0; ct < 4; ++ct) { invl[ct] = finish_l(lsum[ct]); msafe[ct] = (m[ct] == NEG_INF) ? 0.f : m[ct]; }
    for (int e = lane; e < 16 * 132; e += 64) imp[e] = 0.f;
    __builtin_amdgcn_fence(__ATOMIC_SEQ_CST, "workgroup");
    __builtin_amdgcn_wave_barrier();
#pragma unroll
    for (int dt = 0; dt < 4; ++dt)
#pragma unroll
      for (int ct = 0; ct < 4; ++ct) o[dt][ct] = (f32x4){0.f, 0.f, 0.f, 0.f};
#pragma unroll 1
    for (int blk = 0; blk < nblk; ++blk) {
      f32x4 s[2][4];
      qk_scores<4, 2, true>(kc, 64, blk * 32, qf, s, lane, qlds);
      float pq[2][4];
#pragma unroll
      for (int kt = 0; kt < 2; ++kt)
#pragma unroll
        for (int i = 0; i < 4; ++i) {
          const int n = blk * 32 + 8 * grp + 4 * kt + i;
          const bool ok = (16 * n + 31 <= t);
          float acc_p = 0.f;
#pragma unroll
          for (int ct = 0; ct < 4; ++ct) {
            const float pv = ok ? __builtin_amdgcn_exp2f(s[kt][ct][i] - msafe[ct]) * invl[ct] : 0.f;
            s[kt][ct][i] = pv;
            acc_p += pv;
          }
          pq[kt][i] = acc_p;
        }
      float* ir = imp + r * 132 + blk * 8 + 2 * grp;
      ir[0] += pq[0][0] + pq[0][1] + pq[0][2] + 0.5f * pq[0][3];
      __builtin_amdgcn_fence(__ATOMIC_SEQ_CST, "workgroup");
      __builtin_amdgcn_wave_barrier();
      ir[1] += pq[1][0] + pq[1][1] + pq[1][2] + 0.5f * pq[1][3] + 0.5f * pq[0][3];
      __builtin_amdgcn_fence(__ATOMIC_SEQ_CST, "workgroup");
      __builtin_amdgcn_wave_barrier();
      ir[2] += 0.5f * pq[1][3];
      __builtin_amdgcn_fence(__ATOMIC_SEQ_CST, "workgroup");
      __builtin_amdgcn_wave_barrier();
      pv_accum<4, 4>(vct, 512, blk * 32, s, o, lane);
    }
    f32x4 gt[4];
#pragma unroll
    for (int ct = 0; ct < 4; ++ct) gt[ct][0] = gatep[ct * 3 + 0];
#pragma unroll
    for (int dt = 0; dt < 4; ++dt) {
#pragma unroll
      for (int ct = 0; ct < 4; ++ct)
#pragma unroll
        for (int i = 0; i < 4; ++i) scr[((dt * 4 + ct) * 4 + i) * 64 + lane] = o[dt][ct][i] * gt[ct][0];
      asm volatile("" ::: "memory");
    }
  }
  const int cur = t0 >> 6;
  unsigned long long sel_lo = 0ull, sel_hi = 0ull;
  {
  NSA_SECTION_VARS
  if (cur <= 15) {
    sel_lo = (1ull << (cur + 1)) - 1ull;
  } else {
    __builtin_amdgcn_fence(__ATOMIC_SEQ_CST, "workgroup");
    __builtin_amdgcn_wave_barrier();
    float v[32];
#pragma unroll
    for (int k = 0; k < 32; ++k) {
      const int j = grp + 4 * k;
      const float x = imp[r * 132 + j];
      v[k] = (j >= 1 && j <= cur - 2) ? x : NEG_INF;
    }
#pragma unroll 1
    for (int round = 0; round < 13; ++round) {
      float best = NEG_INF;
      int bj = 1 << 20;
#pragma unroll
      for (int k = 0; k < 32; ++k) {
        const bool tk = v[k] > best;
        best = tk ? v[k] : best;
        bj = tk ? (grp + 4 * k) : bj;
      }
#pragma unroll
      for (int off = 16; off <= 32; off <<= 1) {
        const float ob = __shfl_xor(best, off);
        const int oj = __shfl_xor(bj, off);
        const bool tk = (ob > best) || (ob == best && oj < bj);
        best = tk ? ob : best;
        bj = tk ? oj : bj;
      }
      if (bj < 64) sel_lo |= 1ull << bj; else if (bj < 128) sel_hi |= 1ull << (bj - 64);
#pragma unroll
      for (int k = 0; k < 32; ++k) v[k] = (bj == grp + 4 * k) ? NEG_INF : v[k];
    }
    sel_lo |= 1ull;
    if (cur < 64) sel_lo |= 1ull << cur; else sel_hi |= 1ull << (cur - 64);
    if (cur - 1 < 64) sel_lo |= 1ull << (cur - 1); else sel_hi |= 1ull << (cur - 1 - 64);
  }
  }
  asm volatile("" : "+v"(sel_lo), "+v"(sel_hi));
  atomicOr(&misc[4], (unsigned)sel_lo); atomicOr(&misc[5], (unsigned)(sel_lo >> 32));
  atomicOr(&misc[6], (unsigned)sel_hi); atomicOr(&misc[7], (unsigned)(sel_hi >> 32));
  __syncthreads();
  unsigned long long ulo, uhi;
  {
    const unsigned u0 = __builtin_amdgcn_readfirstlane(misc[4]), u1 = __builtin_amdgcn_readfirstlane(misc[5]);
    const unsigned u2 = __builtin_amdgcn_readfirstlane(misc[6]), u3 = __builtin_amdgcn_readfirstlane(misc[7]);
    ulo = ((unsigned long long)u1 << 32) | u0; uhi = ((unsigned long long)u3 << 32) | u2;
  }
  {
    NSA_SECTION_VARS
    const int tid = (wave << 6) | lane;
    const int hq = r >> 2, qq = r & 3;
    const bf16_t* ks = WSP(bf16_t, OFF_KS) + ((size_t)b * T) * 128 + g * 64;
    const bf16_t* vst = WSP(bf16_t, OFF_VST) + (size_t)((b * 2 + g) * 64) * T;
    bf16x8 qr[4][2];
    unsigned long long mlo[4], mhi[4];
#pragma unroll
    for (int ct = 0; ct < 4; ++ct) {
      const size_t rowq = (size_t)b * T + t0 + 4 * ct + qq;
#pragma unroll
      for (int dk = 0; dk < 2; ++dk)
        qr[ct][dk] = *(const bf16x8*)(WSP(bf16_t, OFF_QN) + rowq * 512 + (g * 4 + hq) * 64 + dk * 32 + grp * 8);
      const int srcl = (lane & 48) | (4 * ct + qq);
      mlo[ct] = __shfl(sel_lo, srcl);
      mhi[ct] = __shfl(sel_hi, srcl);
      m[ct] = NEG_INF; lacc[ct] = (f32x4){0.f, 0.f, 0.f, 0.f};
    }
#pragma unroll
    for (int dt = 0; dt < 4; ++dt)
#pragma unroll
      for (int ct = 0; ct < 4; ++ct) o[dt][ct] = (f32x4){0.f, 0.f, 0.f, 0.f};
    const short one_ = (short)0x3F80;
    const bf16x8 ones = {one_, one_, one_, one_, one_, one_, one_, one_};
    TileRegs tr, trb;
    int jA = next_bit(ulo, uhi, 0), it = 0;
    int jB = next_bit(ulo, uhi, jA + 1);
    tile_gload(tr, ks, 128, vst, T, 64 * jA, tid);
    if (jB < 128) tile_gload(trb, ks, 128, vst, T, 64 * jB, tid);
    tile_swrite(tr, tiles, tid);
    if (jB < 128) tile_swrite(trb, tiles + TILE_STAGE, tid);
    __syncthreads();
#pragma unroll 1
    while (jA < 128) {
      const int nA = (jB < 128) ? next_bit(ulo, uhi, jB + 1) : 128;
      const int nB = (nA < 128) ? next_bit(ulo, uhi, nA + 1) : 128;
      if (nA < 128) tile_gload(tr, ks, 128, vst, T, 64 * nA, tid);
      if (nB < 128) tile_gload(trb, ks, 128, vst, T, 64 * nB, tid);
#pragma unroll 1
      for (int sub = 0; sub < 2; ++sub) {
      const int j = sub ? jB : jA;
      if (j >= 128) break;
      const lds_u8* stage = tiles + (2 * (it & 1) + sub) * TILE_STAGE;
      bool mine[4], need[4], anyneed = false;
#pragma unroll
      for (int ct = 0; ct < 4; ++ct) {
        mine[ct] = ((j < 64 ? (mlo[ct] >> j) : (mhi[ct] >> (j - 64))) & 1ull) != 0ull;
        need[ct] = __any(mine[ct]) != 0;
        anyneed = anyneed || need[ct];
      }
      if (anyneed) {
#pragma unroll
        for (int hf = 0; hf < 2; ++hf) {
          const int key0 = j * 64 + hf * 32;
          bf16x8 kf[2][2];
#pragma unroll
          for (int kt = 0; kt < 2; ++kt) {
            const lds_u8* kp = stage + (32 * hf + 8 * (r >> 2) + 4 * kt + (r & 3)) * TILE_ROWB + grp * 16;
#pragma unroll
            for (int dk = 0; dk < 2; ++dk) kf[kt][dk] = *(const __attribute__((address_space(3))) bf16x8*)(kp + dk * 64);
          }
          bf16x8 vfr[4];
          v_frags_lds<4>(stage, hf, vfr, lane);
#pragma unroll
          for (int ct = 0; ct < 4; ++ct) {
            if (need[ct]) {
              const float mv = mine[ct] ? 0.f : NEG_INF;
              f32x4 s0 = {mv, mv, mv, mv}, s1 = {mv, mv, mv, mv};
              s0 = mfma16(kf[0][0], qr[ct][0], s0);
              s1 = mfma16(kf[1][0], qr[ct][0], s1);
              s0 = mfma16(kf[0][1], qr[ct][1], s0);
              s1 = mfma16(kf[1][1], qr[ct][1], s1);
              if (j == cur) {
                const int tct = t0 + 4 * ct + qq;
#pragma unroll
                for (int i = 0; i < 4; ++i) {
                  s0[i] = (key0 + 8 * grp + i <= tct) ? s0[i] : NEG_INF;
                  s1[i] = (key0 + 8 * grp + 4 + i <= tct) ? s1[i] : NEG_INF;
                }
              }
              float mx = fmaxf(fmaxf(fmaxf(s0[0], s0[1]), fmaxf(s0[2], s0[3])), fmaxf(fmaxf(s1[0], s1[1]), fmaxf(s1[2], s1[3])));
              mx = grp_max4(mx);
              const float mnew = fmaxf(m[ct], mx);
              if (__any(mnew > m[ct])) {
                const float ms = (mnew == NEG_INF) ? 0.f : mnew;
                const float alpha = __builtin_amdgcn_exp2f(m[ct] - ms);
                m[ct] = mnew;
                lacc[ct] = lacc[ct] * alpha;
#pragma unroll
                for (int dt = 0; dt < 4; ++dt) o[dt][ct] = o[dt][ct] * alpha;
              }
              const float msafe = (m[ct] == NEG_INF) ? 0.f : m[ct];
              const f32x4 d0 = s0 - msafe, d1 = s1 - msafe;
              f32x4 p0, p1;
#pragma unroll
              for (int i = 0; i < 4; ++i) { p0[i] = __builtin_amdgcn_exp2f(d0[i]); p1[i] = __builtin_amdgcn_exp2f(d1[i]); }
              const bf16x8 pb = pack8(p0, p1);
              lacc[ct] = mfma16(ones, pb, lacc[ct]);
#pragma unroll
              for (int dt = 0; dt < 4; ++dt) o[dt][ct] = mfma16(vfr[dt], pb, o[dt][ct]);
            }
          }
        }
      }
      }
      if (nA < 128) tile_swrite(tr, tiles + (2 * ((it + 1) & 1)) * TILE_STAGE, tid);
      if (nB < 128) tile_swrite(trb, tiles + (2 * ((it + 1) & 1) + 1) * TILE_STAGE, tid);
      __syncthreads();
      jA = nA; jB = nB; ++it;
    }
    float* scr2 = scr + (size_t)2048 * 4096;
#pragma unroll
    for (int ct = 0; ct < 4; ++ct) {
      const size_t rowq = (size_t)b * T + t0 + 4 * ct + qq;
      const float sc = (lacc[ct][0] > 0.f ? 1.0f / lacc[ct][0] : 0.f) * WSP(float, OFF_GATE)[rowq * 24 + (g * 4 + hq) * 3 + 1];
#pragma unroll
      for (int dt = 0; dt < 4; ++dt)
        *(f32x4*)(scr2 + (hq * 16 + 4 * ct + qq) * 64 + 16 * dt + 4 * grp) = o[dt][ct] * sc;
    }
    asm volatile("s_waitcnt vmcnt(0)" ::: "memory");
    __builtin_amdgcn_fence(__ATOMIC_SEQ_CST, "workgroup");
  }
  {
    NSA_SECTION_VARS
    const int tid = (wave << 6) | lane;
    const bf16_t* kw = WSP(bf16_t, OFF_KW) + ((size_t)b * T) * 128 + g * 64;
    const bf16_t* vwt = WSP(bf16_t, OFF_VWT) + (size_t)((b * 2 + g) * 64) * T;
#pragma unroll
    for (int ct = 0; ct < 4; ++ct) { m[ct] = NEG_INF; lsum[ct] = 0.f; lacc[ct] = (f32x4){0.f, 0.f, 0.f, 0.f}; }
#pragma unroll
    for (int dt = 0; dt < 4; ++dt)
#pragma unroll
      for (int ct = 0; ct < 4; ++ct) o[dt][ct] = (f32x4){0.f, 0.f, 0.f, 0.f};
    int kstart = qi * 128 - 512;
    if (kstart < 0) kstart = 0;
    const int kend = qi * 128 + 64;
    bf16x8 qr[4][2];
#pragma unroll
    for (int ct = 0; ct < 4; ++ct)
#pragma unroll
      for (int dk = 0; dk < 2; ++dk)
        qr[ct][dk] = *(const bf16x8*)(WSP(bf16_t, OFF_QN) + row * 512 + (g * 4 + ct) * 64 + dk * 32 + grp * 8);
    TileRegs tr;
    int it = 0;
    tile_gload(tr, kw, 128, vwt, T, kstart, tid);
    tile_swrite(tr, tiles, tid);
    __syncthreads();
#pragma unroll 1
    for (int k0 = kstart; k0 <= kend; k0 += 64, ++it) {
      if (k0 + 64 <= kend) tile_gload(tr, kw, 128, vwt, T, k0 + 64, tid);
      const lds_u8* stage = tiles + (it & 1) * TILE_STAGE;
      if (k0 <= t0 + 15 && k0 + 63 + 512 > t0) {
#pragma unroll
        for (int hf = 0; hf < 2; ++hf) {
          const int key0 = k0 + hf * 32;
          f32x4 s[2][4];
          const f32x4 cz = {0.f, 0.f, 0.f, 0.f};
          qk_scores_lds<4, 2, false>(stage, hf, qr, s, lane, nullptr, cz, cz);
          if (!(k0 + 63 <= t0 && k0 + 512 > t0 + 15)) {
#pragma unroll
            for (int kt = 0; kt < 2; ++kt)
#pragma unroll
              for (int i = 0; i < 4; ++i) {
                const int key = key0 + 8 * grp + 4 * kt + i;
                const bool ok = (key <= t) && (key + 512 > t);
#pragma unroll
                for (int ct = 0; ct < 4; ++ct) s[kt][ct][i] = ok ? s[kt][ct][i] : NEG_INF;
              }
          }
          bf16x8 vfr[4];
          v_frags_lds<4>(stage, hf, vfr, lane);
          softmax_update<4, 4, true, false>(s, m, lsum, o, &lacc);
          pv_accum_lds<4, 4>(vfr, s, o, lane, lacc);
        }
      }
      if (k0 + 64 <= kend) tile_swrite(tr, tiles + ((it + 1) & 1) * TILE_STAGE, tid);
      __syncthreads();
    }
    float sc2[4];
#pragma unroll
    for (int ct = 0; ct < 4; ++ct) sc2[ct] = (lacc[ct][0] > 0.f ? 1.0f / lacc[ct][0] : 0.f) * gatep[ct * 3 + 2];
    bf16_t* oa = WSP(bf16_t, OFF_OA) + row * 512 + g * 256;
#pragma unroll
    for (int dt = 0; dt < 4; ++dt)
#pragma unroll
      for (int ct = 0; ct < 4; ++ct) {
        bf16_t* ptr = oa + ct * 64 + 16 * dt + 4 * grp;
        const u32x2 sw = *(const u32x2*)ptr;
        float val[4];
        const f32x4 sv = *(const f32x4*)(scr + (size_t)2048 * 4096 + (ct * 16 + r) * 64 + 16 * dt + 4 * grp);
#pragma unroll
        for (int i = 0; i < 4; ++i) val[i] = scr[((dt * 4 + ct) * 4 + i) * 64 + lane] + sv[i] + o[dt][ct][i] * sc2[ct];
        u32x2 w = {cvtpk(val[0] * bflo(sw[0]), val[1] * bfhi(sw[0])), cvtpk(val[2] * bflo(sw[1]), val[3] * bfhi(sw[1]))};
        if (st) *(u32x2*)ptr = w;
        asm volatile("" ::: "memory");
      }
  }
#undef NSA_SECTION_VARS
}

__device__ __forceinline__ void fox_wg_unit(const Params& p, int l, int b, int h, int qb, lds_u8* tiles, bool st) {
  kparams_t kp_ = kparams(); (void)kp_;
  const int tid = tidx();
  const int wave = __builtin_amdgcn_readfirstlane(tid >> 6);
  const int lane = tid & 63, r = lane & 15, grp = lane >> 4;
  const int t0 = qb * 512 + wave * 64;
  bf16x8 qf[4][2];
  const float* fc = WSP(float, OFF_FC) + (size_t)(b * 8 + h) * T;
#pragma unroll
  for (int ct = 0; ct < 4; ++ct) {
    const size_t row = (size_t)b * T + t0 + 16 * ct + r;
#pragma unroll
    for (int dk = 0; dk < 2; ++dk)
      qf[ct][dk] = *(const bf16x8*)(WSP(bf16_t, OFF_FQ) + row * 512 + h * 64 + dk * 32 + grp * 8);
  }
  const bf16_t* kb = WSP(bf16_t, OFF_FK) + ((size_t)b * T) * 512 + h * 64;
  const bf16_t* vt = WSP(bf16_t, OFF_FVT) + (size_t)((b * 8 + h) * 64) * T;
  f32x4 o[4][4];
  float m[4], lsum[4];
  f32x4 lacc[4];
#pragma unroll
  for (int ct = 0; ct < 4; ++ct) { m[ct] = NEG_INF; lsum[ct] = 0.f; lacc[ct] = (f32x4){0.f, 0.f, 0.f, 0.f}; }
#pragma unroll
  for (int dt = 0; dt < 4; ++dt)
#pragma unroll
    for (int ct = 0; ct < 4; ++ct) o[dt][ct] = (f32x4){0.f, 0.f, 0.f, 0.f};
  const int ntiles = (qb + 1) * 8;
  int it0, itw0;
  {
    float gq = fabsf(kp_->fox_q_norm[l * 64 + lane]), gk = fabsf(kp_->fox_k_norm[l * 64 + lane]);
#pragma unroll
    for (int o_ = 1; o_ < 64; o_ <<= 1) { gq = fmaxf(gq, __shfl_xor(gq, o_)); gk = fmaxf(gk, __shfl_xor(gk, o_)); }
    const float B2 = 16.0f * gq * gk * 1.02f + 104.0f;
    const float thr_wg = fc[qb * 512] + B2, thr_w = fc[t0] + B2;
    const float c0 = (lane < ntiles) ? fc[64 * lane + 63] : -3.0e38f;
    const float c1 = (lane + 64 < ntiles) ? fc[64 * (lane + 64) + 63] : -3.0e38f;
    it0 = __popcll(__ballot(c0 > thr_wg)) + __popcll(__ballot(c1 > thr_wg));
    itw0 = __popcll(__ballot(c0 > thr_w)) + __popcll(__ballot(c1 > thr_w));
    it0 = __builtin_amdgcn_readfirstlane(it0);
    itw0 = __builtin_amdgcn_readfirstlane(itw0);
  }
  TileRegs tr;
  float ckr = 0.f;
  tile_gload(tr, kb, 512, vt, T, it0 * 64, tid);
  if (tid < 64) ckr = fc[it0 * 64 + tid] * (-LOG2E);
  tile_swrite(tr, tiles, tid);
  if (tid < 64) *(__attribute__((address_space(3))) float*)(tiles + 2 * TILE_HALF + tid * 4) = ckr;
  __syncthreads();
#pragma unroll 1
  for (int it = it0; it < ntiles; ++it) {
    const int k0 = it * 64;
    if (it + 1 < ntiles) { tile_gload(tr, kb, 512, vt, T, k0 + 64, tid); if (tid < 64) ckr = fc[k0 + 64 + tid] * (-LOG2E); }
    const lds_u8* stage = tiles + ((it - it0) & 1) * TILE_STAGE;
    if (k0 <= t0 + 63 && it >= itw0) {
      const bool diag = (k0 + 63 > t0);
#pragma unroll
      for (int hf = 0; hf < 2; ++hf) {
        const int key0 = k0 + hf * 32;
        f32x4 s[2][4];
        const f32x4 ck0 = *(const __attribute__((address_space(3))) f32x4*)(stage + 2 * TILE_HALF + (32 * hf + 8 * grp) * 4);
        const f32x4 ck1 = *(const __attribute__((address_space(3))) f32x4*)(stage + 2 * TILE_HALF + (32 * hf + 8 * grp + 4) * 4);
        qk_scores_lds<4, 2, false>(stage, hf, qf, s, lane, nullptr, ck0, ck1);
        if (diag) {
#pragma unroll
          for (int kt = 0; kt < 2; ++kt)
#pragma unroll
            for (int i = 0; i < 4; ++i) {
              const int key = key0 + 8 * grp + 4 * kt + i;
#pragma unroll
              for (int ct = 0; ct < 4; ++ct) s[kt][ct][i] = (key <= t0 + 16 * ct + r) ? s[kt][ct][i] : NEG_INF;
            }
        }
        bf16x8 vfr[4];
        v_frags_lds<4>(stage, hf, vfr, lane);
        softmax_update<4, 4, true, false>(s, m, lsum, o, &lacc);
        pv_accum_lds<4, 4>(vfr, s, o, lane, lacc);
      }
    }
    if (it + 1 < ntiles) {
      tile_swrite(tr, tiles + ((it - it0 + 1) & 1) * TILE_STAGE, tid);
      if (tid < 64) *(__attribute__((address_space(3))) float*)(tiles + ((it - it0 + 1) & 1) * TILE_STAGE + 2 * TILE_HALF + tid * 4) = ckr;
    }
    __syncthreads();
  }
  float invl[4];
#pragma unroll
  for (int ct = 0; ct < 4; ++ct) invl[ct] = lacc[ct][0] > 0.f ? 1.0f / lacc[ct][0] : 0.f;
#pragma unroll
  for (int ct = 0; ct < 4; ++ct) {
    bf16_t* ob = WSP(bf16_t, OFF_OB) + ((size_t)b * T + t0 + 16 * ct + r) * 512 + h * 64;
#pragma unroll
    for (int dt = 0; dt < 4; ++dt) {
      bf16_t* ptr = ob + 16 * dt + 4 * grp;
      const u32x2 sw = *(const u32x2*)ptr;
      const f32x4 v = o[dt][ct] * invl[ct];
      u32x2 w = {cvtpk(v[0] * bflo(sw[0]), v[1] * bfhi(sw[0])), cvtpk(v[2] * bflo(sw[1]), v[3] * bfhi(sw[1]))};
      if (st) *(u32x2*)ptr = w;
    }
  }
}

__device__ __forceinline__ void mem_unit(const Params& p, int l, int b, int h, int t0, bool st) {
  kparams_t kp_ = kparams(); (void)kp_;
  const int lane = tidx() & 63, r = lane & 15, grp = lane >> 4;
  const float SC = 0.08838834764831845f * LOG2E;
  bf16x8 qf[2][4];
  const float* gq = kp_->mem_q_norm + l * 128;
#pragma unroll
  for (int ct = 0; ct < 2; ++ct) {
    const size_t row = (size_t)b * T + t0 + 16 * ct + r;
    float v[4][8];
    float ss = 0.f;
#pragma unroll
    for (int dk = 0; dk < 4; ++dk) {
      const u32x4 w = *(const u32x4*)(WSP(bf16_t, OFF_MQ) + row * 512 + h * 128 + dk * 32 + grp * 8);
#pragma unroll
      for (int j = 0; j < 4; ++j) { v[dk][2 * j] = bflo(w[j]); v[dk][2 * j + 1] = bfhi(w[j]); }
#pragma unroll
      for (int j = 0; j < 8; ++j) ss += v[dk][j] * v[dk][j];
    }
    ss += __shfl_xor(ss, 16);
    ss += __shfl_xor(ss, 32);
    const float rstd = rsqrtf(ss * (1.0f / 128.0f) + EPS);
#pragma unroll
    for (int dk = 0; dk < 4; ++dk) {
      const f32x4 g0 = *(const f32x4*)(gq + dk * 32 + grp * 8), g1 = *(const f32x4*)(gq + dk * 32 + grp * 8 + 4);
      u32x4 w = {cvtpk(v[dk][0] * rstd * g0[0], v[dk][1] * rstd * g0[1]), cvtpk(v[dk][2] * rstd * g0[2], v[dk][3] * rstd * g0[3]),
                 cvtpk(v[dk][4] * rstd * g1[0], v[dk][5] * rstd * g1[1]), cvtpk(v[dk][6] * rstd * g1[2], v[dk][7] * rstd * g1[3])};
      qf[ct][dk] = __builtin_bit_cast(bf16x8, w);
    }
  }
  const bf16_t* kb = WSP(bf16_t, OFF_MK) + ((size_t)b * 256) * 512 + h * 128;
  const bf16_t* vt = WSP(bf16_t, OFF_MVT) + (size_t)((b * 4 + h) * 128) * 256;
  f32x4 o[8][2];
  float m[2], lsum[2];
#pragma unroll
  for (int ct = 0; ct < 2; ++ct) { m[ct] = NEG_INF; lsum[ct] = 0.f; }
#pragma unroll
  for (int dt = 0; dt < 8; ++dt)
#pragma unroll
    for (int ct = 0; ct < 2; ++ct) o[dt][ct] = (f32x4){0.f, 0.f, 0.f, 0.f};
#pragma unroll 1
  for (int key0 = 0; key0 < 256; key0 += 32) {
    f32x4 s[2][2];
    qk_scores<2, 4>(kb, 512, key0, qf, s, lane);
#pragma unroll
    for (int kt = 0; kt < 2; ++kt)
#pragma unroll
      for (int ct = 0; ct < 2; ++ct) s[kt][ct] = s[kt][ct] * SC;
    softmax_update<2, 8, true>(s, m, lsum, o);
    pv_accum<2, 8>(vt, 256, key0, s, o, lane);
  }
#pragma unroll
  for (int ct = 0; ct < 2; ++ct) {
    const float invl = finish_l(lsum[ct]);
    bf16_t* om = WSP(bf16_t, OFF_OM) + ((size_t)b * T + t0 + 16 * ct + r) * 512 + h * 128;
#pragma unroll
    for (int dt = 0; dt < 8; ++dt) {
      bf16_t* ptr = om + 16 * dt + 4 * grp;
      const u32x2 sw = *(const u32x2*)ptr;
      const f32x4 v = o[dt][ct] * invl;
      u32x2 w = {cvtpk(v[0] * bflo(sw[0]), v[1] * bfhi(sw[0])), cvtpk(v[2] * bflo(sw[1]), v[3] * bfhi(sw[1]))};
      if (st) *(u32x2*)ptr = w;
    }
  }
}

__device__ __forceinline__ void phase_attn(const Params& p, int l, unsigned char* ldsraw, bool st, int cidx) {
  kparams_t kp_ = kparams(); (void)kp_;
  const int tid = tidx();
  const int wave = __builtin_amdgcn_readfirstlane(tid >> 6);
  float* imp = (float*)ldsraw + wave * 2112;
  lds_u8* tiles = (lds_u8*)ldsraw;
  bf16x8* qlds = (bf16x8*)(ldsraw + 69632 + wave * 8192);
  unsigned* misc = (unsigned*)(ldsraw + 135168);
  float* scr = WSP(float, OFF_SCR) + (size_t)(bidx() * NWAVES + wave) * 4096;
  const int myx = (int)(xb_xcc_id() & 7u);
  constexpr int QUNITS = 192;
  for (int qq = 0; qq < 8; ++qq) {
    const int x = (myx + qq) & 7;
    unsigned* ctr = WSP(unsigned, OFF_CTL) + cidx * 8 + x;
    for (;;) {
      __syncthreads();
      if (tid == 0) misc[0] = atomicAdd(ctr, 1u);
      if (tid >= 4 && tid < 8) misc[tid] = 0u;
      __syncthreads();
      const int u = __builtin_amdgcn_readfirstlane((int)misc[0]);
      if (u >= QUNITS) break;
      if (u < 64) {
        nsa_wg_unit(p, x >> 1, x & 1, 63 - u, imp, qlds, scr, tiles, misc, st);
      } else if (u < 128) {
        const int v_ = u - 64, bh = 4 * x + (v_ >> 4);
        fox_wg_unit(p, l, bh >> 3, bh & 7, 15 - (v_ & 15), tiles, st);
      } else {
        const int mu = u - 128, bh = 2 * x + (mu >> 5), qblk = mu & 31;
        mem_unit(p, l, bh >> 2, bh & 3, 256 * qblk + 32 * wave, st);
      }
    }
  }
}

__global__ void __launch_bounds__(NTHREADS) hybrid_megakernel(Params p) {
  kparams_t kp_ = kparams();
  cg::grid_group grid = cg::this_grid();
  extern __shared__ __attribute__((aligned(16))) unsigned char dynlds[];
  float* smem = (float*)dynlds;
  PG8_LAS unsigned char* glds = (PG8_LAS unsigned char*)dynlds;
  volatile LAS unsigned* bst = (volatile LAS unsigned*)(glds + 135168 + 64);
  if (threadIdx.x < 2) bst[threadIdx.x] = 0u;
  __syncthreads();
  grid.sync();
  const XcdBarrier xbar = xcd_barrier_post(WSP(unsigned, OFF_BAR), bst);
  unsigned long long pr_acc = 0ull, pr_t0 = 0ull;
#pragma unroll 1
  for (int ph = 0; ph < 28; ++ph) {
    const int l = ph / 7, k = ph - 7 * l;
    if (PROBE_PHASE >= 0 && k == PROBE_PHASE) pr_t0 = __builtin_amdgcn_s_memrealtime();
    if (k == 0) {
      phase_prep(p, l, smem);
    } else if (k == 1) {
      if (bidx() == gdim() - 1 && tidx() < 256) {
        const int t_ = tidx();
        const float* part = WSP(float, OFF_C1) + (size_t)(t_ >> 7) * 16 * 128 + (t_ & 127);
        float s_ = 0.f;
        for (int ch = 0; ch < 16; ++ch) s_ += part[ch * 128];
        WSP(float, OFF_C1 + 16384)[t_] = s_;
      }
      EpiIn E{&p, l};
      for (int rp = 0; rp < (PROBE_GEMM2 ? (kp_->ws != nullptr ? 2 : 1) : 1); ++rp)
        run_gemm(glds, WSP(bf16_t, OFF_H), WSP(bf16_t, OFF_W_IN), M, 5120, 1024, E);
      EpiMemKV E2{&p};
      run_gemm(glds, WSP(bf16_t, OFF_MEMN), WSP(bf16_t, OFF_W_MKV), 1024, 1024, 1024, E2);
    } else if (k == 2) {
      phase_mid(p, l, smem);
    } else if (k == 3) {
      const int nrep = PROBE_ATTN2 ? (kp_->ws != nullptr ? 2 : 1) : 1;
      for (int rp = 0; rp < nrep; ++rp) {
        const bool last = (rp == nrep - 1);
        if (rp) xcd_barrier(xbar);
        phase_attn(p, l, dynlds, last, last ? l : 4 + l);
      }
    } else if (k == 4) {
      EpiGate E{WSP(bf16_t, OFF_G)};
      for (int rp = 0; rp < (PROBE_GEMM2 ? (kp_->ws != nullptr ? 2 : 1) : 1); ++rp)
        run_gemm(glds, WSP(bf16_t, OFF_H), WSP(bf16_t, OFF_W_G), M, 3072, 1024, E);
    } else if (k == 5) {
      for (int rp = 0; rp < (PROBE_BR2 ? (kp_->ws != nullptr ? 2 : 1) : 1); ++rp) {
      EpiBranch Ea{WSP(bf16_t, OFF_G), WSP(bf16_t, OFF_U), 1};
      run_gemm(glds, WSP(bf16_t, OFF_OA), WSP(bf16_t, OFF_W_BR), M, 1024, 512, Ea);
      EpiBranch Eb{WSP(bf16_t, OFF_G) + (size_t)M * 1024, WSP(bf16_t, OFF_U), 0};
      run_gemm(glds, WSP(bf16_t, OFF_OB), WSP(bf16_t, OFF_W_BR + MiB), M, 1024, 512, Eb);
      EpiBranch Ec{WSP(bf16_t, OFF_G) + (size_t)2 * M * 1024, WSP(bf16_t, OFF_U), 0};
      run_gemm(glds, WSP(bf16_t, OFF_OM), WSP(bf16_t, OFF_W_BR + 2 * MiB), M, 1024, 512, Ec);
      }
    } else {
      EpiOut E{l == 0 ? kp_->x : kp_->out, kp_->out};
      run_gemm(glds, WSP(bf16_t, OFF_U), WSP(bf16_t, OFF_W_OUT), M, 1024, 1024, E);
    }
    xcd_barrier(xbar);
    if (PROBE_PHASE >= 0 && k == PROBE_PHASE) pr_acc += __builtin_amdgcn_s_memrealtime() - pr_t0;
  }
  if (PROBE_PHASE >= 0 && blockIdx.x == 0) {
    const unsigned long long ts = __builtin_amdgcn_s_memrealtime();
    while (__builtin_amdgcn_s_memrealtime() - ts < pr_acc) __builtin_amdgcn_s_sleep(8);
  }
}

extern "C" void kernel_launch(void* const* d_in, const int* in_sizes, int n_in, void* d_out, int out_size, void* d_ws,
                              size_t ws_size, hipStream_t stream) {
  static int grid_blocks = 0;
  if (!grid_blocks) {
    int dev = 0, cus = 0, per_cu = 0;
    (void)hipGetDevice(&dev);
    (void)hipDeviceGetAttribute(&cus, hipDeviceAttributeMultiprocessorCount, dev);
    if (hipFuncSetAttribute((const void*)hybrid_megakernel, hipFuncAttributeMaxDynamicSharedMemorySize, LDS_BYTES) != hipSuccess)
      fprintf(stderr, "hipFuncSetAttribute(dynamic LDS %d) failed\n", LDS_BYTES);
    (void)hipOccupancyMaxActiveBlocksPerMultiprocessor(&per_cu, hybrid_megakernel, NTHREADS, LDS_BYTES);
    (void)hipGetLastError();
    grid_blocks = cus;
    if (grid_blocks > 256) grid_blocks = 256;
    if (ws_size < OFF_SCR + (size_t)64 * MiB) fprintf(stderr, "workspace too small: %zu\n", ws_size);
  }
  Params p{};
  const float** pp = (const float**)&p;
  for (int i = 0; i < 23; ++i) pp[i] = (const float*)d_in[i];
  p.out = (float*)d_out;
  p.ws = (char*)d_ws;
  void* args[] = {&p};
  (void)hipMemsetAsync((char*)d_ws + OFF_BAR, 0, XCD_BAR_WORDS * sizeof(unsigned), stream);
  hipError_t e = hipLaunchCooperativeKernel((void*)hybrid_megakernel, dim3(grid_blocks), dim3(NTHREADS), args, LDS_BYTES, stream);
  if (e != hipSuccess) fprintf(stderr, "cooperative launch failed: %s (grid %d)\n", hipGetErrorString(e), grid_blocks);
}
```

```cpp
#include <hip/hip_runtime.h>
#include <hip/hip_cooperative_groups.h>
#include <stdint.h>
#include <cstdio>
namespace cg = cooperative_groups;
#ifndef PROBE_ATTN2
#define PROBE_ATTN2 0
#endif
#ifndef PROBE_PM2
#define PROBE_PM2 0
#endif
#ifndef PROBE_PHASE
#define PROBE_PHASE -1
#endif
#ifndef PROBE_BR2
#define PROBE_BR2 0
#endif
#ifndef PROBE_GEMM2
#define PROBE_GEMM2 0
#endif


typedef unsigned short bf16_t;
typedef short bf16x8 __attribute__((ext_vector_type(8)));
typedef float f32x4 __attribute__((ext_vector_type(4)));
typedef unsigned u32x2 __attribute__((ext_vector_type(2)));
typedef unsigned u32x4 __attribute__((ext_vector_type(4)));
typedef float f32x2_t __attribute__((ext_vector_type(2)));
typedef __bf16 bf16x2_t __attribute__((ext_vector_type(2)));

constexpr int NB = 4, T = 8192, M = NB * T;
constexpr int NTHREADS = 512, NWAVES = NTHREADS / 64;
constexpr int LDS_BYTES = 147456;
constexpr float EPS = 1e-6f;
constexpr float LOG2E = 1.4426950408889634f;
#define NEG_INF (-__builtin_inff())

constexpr size_t MiB = 1u << 20;
constexpr size_t OFF_CTL = 0;
constexpr size_t OFF_BAR = 64 * 1024;
constexpr size_t OFF_ROPE = 1 * MiB;
constexpr size_t OFF_W_IN = 3 * MiB;
constexpr size_t OFF_W_G = 13 * MiB;
constexpr size_t OFF_W_MKV = 19 * MiB;
constexpr size_t OFF_W_BR = 21 * MiB;
constexpr size_t OFF_W_OUT = 24 * MiB;
constexpr size_t OFF_W1 = 26 * MiB;
constexpr size_t OFF_W2 = 27 * MiB;
constexpr size_t OFF_C1 = 27 * MiB + 256 * 1024;
constexpr size_t OFF_MEMN = 28 * MiB;
constexpr size_t OFF_MK = 30 * MiB;
constexpr size_t OFF_MVT = 31 * MiB;
constexpr size_t OFF_H = 32 * MiB;
constexpr size_t OFF_U = OFF_H;
constexpr size_t OFF_OA = 96 * MiB;
constexpr size_t OFF_OB = 128 * MiB;
constexpr size_t OFF_OM = 160 * MiB;
constexpr size_t OFF_QN = 192 * MiB;
constexpr size_t OFF_G = 192 * MiB;
constexpr size_t OFF_KC = 224 * MiB;
constexpr size_t OFF_VC = 232 * MiB;
constexpr size_t OFF_KS = 240 * MiB;
constexpr size_t OFF_VST = 248 * MiB;
constexpr size_t OFF_KW = 256 * MiB;
constexpr size_t OFF_VWT = 264 * MiB;
constexpr size_t OFF_FQ = 272 * MiB;
constexpr size_t OFF_FK = 304 * MiB;
constexpr size_t OFF_FVT = 336 * MiB;
constexpr size_t OFF_MQ = 368 * MiB;
constexpr size_t OFF_GATE = 400 * MiB;
constexpr size_t OFF_FLOG = 403 * MiB;
constexpr size_t OFF_FC = 404 * MiB;
constexpr size_t OFF_KCMP = 405 * MiB;
constexpr size_t OFF_VCT = 405 * MiB + 512 * 1024;
constexpr size_t OFF_SCR = 406 * MiB;

struct Params {
  const float *x, *mem, *norm_g, *mem_norm_g, *w_in, *nsa_q_norm, *nsa_k_norm, *cmp_pe_k, *cmp_w1_k, *cmp_w2_k,
      *cmp_pe_v, *cmp_w1_v, *cmp_w2_v, *fox_q_norm, *fox_k_norm, *fox_f_bias, *mem_q_norm, *mem_k_norm, *w_mem_kv,
      *w_branch_a, *w_branch_b, *w_branch_m, *w_out;
  float* out;
  char* ws;
};
__device__ __forceinline__ char* ws_base(char* w) {
  unsigned lo = __builtin_amdgcn_readfirstlane((unsigned)(uintptr_t)w), hi = __builtin_amdgcn_readfirstlane((unsigned)((uintptr_t)w >> 32));
  asm volatile("" : "+s"(lo), "+s"(hi));
  return (char*)(__attribute__((address_space(1))) char*)(((uintptr_t)hi << 32) | (uintptr_t)lo);
}
typedef const __attribute__((address_space(4))) Params* kparams_t;
__device__ __forceinline__ kparams_t kparams() { kparams_t kp = (kparams_t)__builtin_amdgcn_kernarg_segment_ptr(); asm volatile("" : "+s"(kp)); return kp; }
#define WSP(TYPE, off) ((TYPE*)(ws_base(kp_->ws) + (off)))

__constant__ float c_inv_freq[32] = {
    1.000000000e+00f, 7.498942018e-01f, 5.623413324e-01f, 4.216965139e-01f, 3.162277639e-01f, 2.371373773e-01f,
    1.778279394e-01f, 1.333521456e-01f, 1.000000015e-01f, 7.498942316e-02f, 5.623413250e-02f, 4.216964915e-02f,
    3.162277490e-02f, 2.371373773e-02f, 1.778279431e-02f, 1.333521400e-02f, 9.999999776e-03f, 7.498942316e-03f,
    5.623413250e-03f, 4.216964822e-03f, 3.162277630e-03f, 2.371373819e-03f, 1.778279431e-03f, 1.333521446e-03f,
    1.000000047e-03f, 7.498941850e-04f, 5.623413017e-04f, 4.216965172e-04f, 3.162277571e-04f, 2.371373703e-04f,
    1.778279402e-04f, 1.333521504e-04f};

__device__ __forceinline__ int bidx() { int b = blockIdx.x; asm volatile("" : "+s"(b)); return b; }
__device__ __forceinline__ int gdim() { int g = gridDim.x; asm volatile("" : "+s"(g)); return g; }
__device__ __forceinline__ int tidx() { int t = threadIdx.x; asm volatile("" : "+v"(t)); return t; }
__device__ __forceinline__ unsigned cvtpk(float lo, float hi) {
  f32x2_t v = {lo, hi};
  bf16x2_t b = __builtin_convertvector(v, bf16x2_t);
  return __builtin_bit_cast(unsigned, b);
}
__device__ __forceinline__ float bf2f(unsigned short v) { return __uint_as_float(((unsigned)v) << 16); }
__device__ __forceinline__ float bflo(unsigned w) { return __uint_as_float(w << 16); }
__device__ __forceinline__ float bfhi(unsigned w) { return __uint_as_float(w & 0xffff0000u); }
__device__ __forceinline__ f32x4 mfma16(bf16x8 a, bf16x8 b, f32x4 c) {
  return __builtin_amdgcn_mfma_f32_16x16x32_bf16(a, b, c, 0, 0, 0);
}
__device__ __forceinline__ bf16x8 pack8(f32x4 a, f32x4 b) {
  u32x4 w = {cvtpk(a[0], a[1]), cvtpk(a[2], a[3]), cvtpk(b[0], b[1]), cvtpk(b[2], b[3])};
  return __builtin_bit_cast(bf16x8, w);
}
__device__ __forceinline__ float sigmoidf_(float v) { return __builtin_amdgcn_rcpf(1.0f + __builtin_amdgcn_exp2f(-LOG2E * v)); }
__device__ __forceinline__ float siluf_(float v) { return v * __builtin_amdgcn_rcpf(1.0f + __builtin_amdgcn_exp2f(-LOG2E * v)); }
__device__ __forceinline__ float grp_max4(float v) {
  auto a = __builtin_amdgcn_permlane32_swap(__float_as_uint(v), __float_as_uint(v), false, false);
  v = fmaxf(__uint_as_float(a[0]), __uint_as_float(a[1]));
  auto b = __builtin_amdgcn_permlane16_swap(__float_as_uint(v), __float_as_uint(v), false, false);
  return fmaxf(__uint_as_float(b[0]), __uint_as_float(b[1]));
}
__device__ __forceinline__ float wave_sum(float v) {
#pragma unroll
  for (int o = 1; o < 64; o <<= 1) v += __shfl_xor(v, o);
  return v;
}

#define LAS __attribute__((address_space(3)))
#define XB_TMO      128
#define XB_XCNT(j)  (256  + 64 * (j))
#define XB_XSUB(j)  (1280 + 64 * (j))
#define XB_XGEN(j)  (2304 + 64 * (j))
#define XB_TOP      3328
#define XB_TOPGEN   3392
#define XCD_BAR_WORDS 3456
#define XB_SPIN_CAP (1u << 18)

__device__ __forceinline__ unsigned xb_ld(unsigned* p)              { return __hip_atomic_load(p, __ATOMIC_RELAXED, __HIP_MEMORY_SCOPE_AGENT); }
__device__ __forceinline__ unsigned xb_add(unsigned* p, unsigned v) { return __hip_atomic_fetch_add(p, v, __ATOMIC_RELAXED, __HIP_MEMORY_SCOPE_AGENT); }
__device__ __forceinline__ unsigned xb_xcc_id() { return (unsigned)__builtin_amdgcn_s_getreg((3 << 11) | 20) & 0xFu; }
#define XB_SPIN(cond, bar) do { unsigned _sp = 0; while (cond) { __builtin_amdgcn_s_sleep(1); \
    if ((++_sp & 255u) == 0u) { if (xb_ld(&(bar)[XB_TMO])) break; if (_sp > XB_SPIN_CAP) { atomicAdd(&(bar)[XB_TMO], 1u); break; } } } } while (0)

struct XcdBarrier {
    unsigned* bar; unsigned x;
    volatile LAS unsigned* st;
};

__device__ __forceinline__ XcdBarrier xcd_barrier_post(unsigned* bar, volatile LAS unsigned* st) {
    XcdBarrier b; b.bar = bar; b.x = xb_xcc_id(); b.st = st;
    if (threadIdx.x == 0) (void)xb_add(&bar[XB_XCNT(b.x)], 1u);
    return b;
}
__device__ __forceinline__ void xcd_barrier_complete(unsigned* bar, unsigned x, unsigned& nloc, unsigned& nx) {
    const unsigned G = gridDim.x * gridDim.y * gridDim.z;
    unsigned sum, cnt, mine, sp = 0u;
    for (;;) {
        sum = 0u; cnt = 0u; mine = 0u;
#pragma unroll
        for (unsigned j = 0; j < 16; ++j) { const unsigned c = xb_ld(&bar[XB_XCNT(j)]); sum += c; cnt += (c > 0u) ? 1u : 0u; mine = (j == x) ? c : mine; }
        if (sum == G) break;
        __builtin_amdgcn_s_sleep(1);
        if ((++sp & 255u) == 0u) { if (xb_ld(&bar[XB_TMO])) break; if (sp > XB_SPIN_CAP) { atomicAdd(&bar[XB_TMO], 1u); break; } }
    }
    nloc = mine > 0u ? mine : 1u; nx = cnt > 0u ? cnt : 1u;
}

__device__ __forceinline__ void xcd_barrier(const XcdBarrier& b) {
    asm volatile("s_waitcnt vmcnt(0)" ::: "memory");
    __syncthreads();
    if (threadIdx.x == 0) {
        unsigned* bar = b.bar;
        __builtin_amdgcn_s_waitcnt(0);
        unsigned nloc = b.st[0], nx = b.st[1];
        if (nloc == 0u) { xcd_barrier_complete(bar, b.x, nloc, nx); b.st[0] = nloc; b.st[1] = nx; }
        const unsigned old = xb_add(&bar[XB_XSUB(b.x)], 1u);
        const unsigned gen = old / nloc;
        if (old + 1u == (gen + 1u) * nloc) {
            __builtin_amdgcn_fence(__ATOMIC_RELEASE, "agent");
            asm volatile("s_waitcnt vmcnt(0)" ::: "memory");
            const unsigned og = xb_add(&bar[XB_TOP], 1u);
            const unsigned tg = og / nx;
            if (og + 1u == (tg + 1u) * nx) xb_add(&bar[XB_TOPGEN], 1u);
            else XB_SPIN(xb_ld(&bar[XB_TOPGEN]) == tg, bar);
            __builtin_amdgcn_fence(__ATOMIC_ACQUIRE, "agent");
            xb_add(&bar[XB_XGEN(b.x)], 1u);
            asm volatile("s_waitcnt vmcnt(0)" ::: "memory");
        } else {
            XB_SPIN(xb_ld(&bar[XB_XGEN(b.x)]) == gen, bar);
            __builtin_amdgcn_fence(__ATOMIC_ACQUIRE, "agent");
            asm volatile("s_waitcnt vmcnt(0)" ::: "memory");
        }
    }
    __syncthreads();
}


namespace pg8 {
#define PG8_LAS __attribute__((address_space(3)))
typedef unsigned short bf16_t;
typedef short bf16x8 __attribute__((ext_vector_type(8)));
typedef float f32x4 __attribute__((ext_vector_type(4)));
typedef unsigned u32x4 __attribute__((ext_vector_type(4)));
constexpr int BM = 256, BK = 64, HALF = 128, HTB = HALF * BK * 2  , STAGE_BYTES = 8 * HTB, NXCD = 8, WGM = 8;

__host__ __device__ __forceinline__ int lds_byte(int r, int c) { const int st = (r >> 4) * 2 + (c >> 5), rr = r & 15, cc = c & 31, ob = rr * 64 + cc * 2; return st * 1024 + (ob ^ (((ob >> 9) & 1) << 5)); }
__host__ __device__ __forceinline__ void stage_rc(int b, int& R, int& C) { const int st = b / 1024, sb = b % 1024, swz = sb ^ (((sb >> 9) & 1) << 5); R = (st >> 1) * 16 + swz / 64; C = (st & 1) * 32 + (swz % 64) / 2; }
__host__ __device__ __forceinline__ int perm32(int rho) { const int n = rho >> 4, i = rho & 15; return 8 * (i >> 2) + 4 * n + (i & 3); }

struct Unit { int pm, pn; };
struct Gemm { const bf16_t* A; const bf16_t* Bt; int M, N, K; };

struct StaticOrder {
    int nM, nN, nwg, G, c;
    __host__ __device__ void init(int M, int N, int G_, int c_) { nM = M / BM; nN = N / BM; nwg = nM * nN; G = G_; c = c_; }
    __host__ __device__ bool next(int i, Unit& u) const {
        const long L = (long)i * G + c; if (L >= nwg) return false;
        int wgid = (int)L; { const int q = nwg / NXCD, r = nwg % NXCD, xcd = wgid % NXCD, off = wgid / NXCD; wgid = (xcd < r ? xcd * (q + 1) : r * (q + 1) + (xcd - r) * q) + off; }
        const int nig = WGM * nN, gid = wgid / nig, fm = gid * WGM, gsz = (nM - fm) < WGM ? (nM - fm) : WGM;
        u.pm = fm + ((wgid % nig) % gsz); u.pn = (wgid % nig) / gsz; return true;
    }
    __device__ __forceinline__ void a_ready(const Unit&) const {}
    __device__ __forceinline__ void done(const Unit&) const {}
};
__device__ __forceinline__ unsigned cvt_pk_bf16(float lo, float hi) { unsigned r; asm volatile("v_cvt_pk_bf16_f32 %0, %1, %2" : "=v"(r) : "v"(lo), "v"(hi)); return r; }
template <class Epi, class Sched, bool ALIGN_EPI = false, bool SP2 = false>
__device__ __forceinline__ void gemm_phase(PG8_LAS unsigned char* lds, const Gemm g, const Sched& S, const Epi& E) {
    const int tid = tidx(), wid = __builtin_amdgcn_readfirstlane(tid >> 6), lane = tid & 63, wr = wid >> 2, wc = wid & 3, fr = lane & 15, fq = lane >> 4;
    const int K = g.K, nt = K / BK;
    unsigned voffA[2], voffB[2];
#pragma unroll
    for (int i = 0; i < 2; ++i) { int R, C; stage_rc(tid * 16 + i * 8192, R, C); const int Rb = Epi::PERM ? ((R & ~31) + perm32(R & 31)) : R;
        voffA[i] = (unsigned)(R * K + C) * 2u; voffB[i] = (unsigned)(Rb * K + C) * 2u; }
    const size_t kstep = (size_t)(BK * 2);
    const size_t hstep = (size_t)HALF * K * 2;
    const size_t tstep = 2 * hstep;
    const unsigned ldsw = (unsigned)wid * 1024u;
    const int aoff = lds_byte(wr * 64 + fr, fq * 8), boff = lds_byte(wc * 32 + fr, fq * 8);
#define PG8_SA(b, h) (((b) * 2 + (h)) * HTB)
#define PG8_SB(b, h) ((4 + (b) * 2 + (h)) * HTB)
#define PG8_STAGE(bufoff, gbase, voff) do { _Pragma("unroll") for (int _i = 0; _i < 2; ++_i) \
        __builtin_amdgcn_global_load_lds((const unsigned*)((const char*)(gbase) + (voff)[_i]), (PG8_LAS unsigned*)(lds + (bufoff) + ldsw + _i * 8192), 16, 0, 0); } while (0)
#define PG8_LDA(dst, b, h) do { _Pragma("unroll") for (int m = 0; m < 4; ++m) _Pragma("unroll") for (int k = 0; k < 2; ++k) dst[m][k] = *(const PG8_LAS bf16x8*)(lds + PG8_SA(b, h) + aoff + m * 2048 + k * 1024); } while (0)
#define PG8_LDB(dst, b, h) do { _Pragma("unroll") for (int n = 0; n < 2; ++n) _Pragma("unroll") for (int k = 0; k < 2; ++k) dst[n][k] = *(const PG8_LAS bf16x8*)(lds + PG8_SB(b, h) + boff + n * 2048 + k * 1024); } while (0)
#define PG8_MMA(ai, bj, At, Bt) do { __builtin_amdgcn_s_setprio(1); _Pragma("unroll") for (int m = 0; m < 4; ++m) _Pragma("unroll") for (int n = 0; n < 2; ++n) _Pragma("unroll") for (int k = 0; k < 2; ++k) \
        acc[ai][bj][m][n] = __builtin_amdgcn_mfma_f32_16x16x32_bf16(Bt[n][k], At[m][k], acc[ai][bj][m][n], 0, 0, 0); __builtin_amdgcn_s_setprio(0); } while (0)
#define PG8_WAIT_V(n) asm volatile("s_waitcnt vmcnt(" #n ")" ::: "memory")
#define PG8_WAIT_L(n) asm volatile("s_waitcnt lgkmcnt(" #n ")" ::: "memory")
#define PG8_BAR __builtin_amdgcn_s_barrier()
#define PG8_SCHED __builtin_amdgcn_sched_barrier(0)
    Unit cur, nxt; int ui = 0;
    if (!S.next(0, cur)) return;
    f32x4 acc[2][2][4][2];
#pragma unroll
    for (int a = 0; a < 2; ++a)
#pragma unroll
        for (int b = 0; b < 2; ++b)
#pragma unroll
            for (int m = 0; m < 4; ++m)
#pragma unroll
                for (int n = 0; n < 2; ++n) acc[a][b][m][n] = (f32x4){0.f, 0.f, 0.f, 0.f};
    bf16x8 At[4][2], B0[2][2], B1[2][2];
    const char* cA = (const char*)g.A + (size_t)cur.pm * tstep; const char* cB = (const char*)g.Bt + (size_t)cur.pn * tstep;
    S.a_ready(cur);
    if constexpr (SP2) {
        PG8_STAGE(PG8_SB(0, 0), cB, voffB); PG8_STAGE(PG8_SB(0, 1), cB + hstep, voffB); PG8_STAGE(PG8_SA(0, 0), cA, voffA); PG8_STAGE(PG8_SA(0, 1), cA + hstep, voffA);
        if (wr == 1) PG8_BAR;
        PG8_WAIT_V(2); PG8_BAR;
        PG8_STAGE(PG8_SB(1, 0), cB + kstep, voffB); PG8_STAGE(PG8_SA(1, 0), cA + kstep, voffA); PG8_STAGE(PG8_SB(1, 1), cB + hstep + kstep, voffB);
        PG8_WAIT_V(6); PG8_BAR;
    } else {
        PG8_STAGE(PG8_SB(0, 0), cB, voffB); PG8_STAGE(PG8_SA(0, 0), cA, voffA); PG8_STAGE(PG8_SB(0, 1), cB + hstep, voffB); PG8_STAGE(PG8_SA(0, 1), cA + hstep, voffA);
        if (wr == 1) PG8_BAR;
        PG8_WAIT_V(4); PG8_BAR;
        PG8_STAGE(PG8_SB(1, 0), cB + kstep, voffB); PG8_STAGE(PG8_SA(1, 0), cA + kstep, voffA); PG8_STAGE(PG8_SB(1, 1), cB + hstep + kstep, voffB);
        PG8_WAIT_V(6); PG8_BAR;
    }
    for (;;) {
        const bool has_next = S.next(ui + 1, nxt);
        const char* nA = has_next ? (const char*)g.A + (size_t)nxt.pm * tstep : cA; const char* nB = has_next ? (const char*)g.Bt + (size_t)nxt.pn * tstep : cB;
        for (int t = 0; t < nt; t += 2) {
            const bool last = (t == nt - 2);
            const char* a1 = cA + (size_t)(t + 1) * kstep;
            const char* a2 = last ? nA : cA + (size_t)(t + 2) * kstep; const char* b2 = last ? nB : cB + (size_t)(t + 2) * kstep;
            const char* a3 = a2 + kstep; const char* b3 = b2 + kstep;
            if (last && has_next) S.a_ready(nxt);
            if constexpr (SP2) {
            PG8_LDB(B0, 0, 0); PG8_LDB(B1, 0, 1); PG8_SCHED; PG8_LDA(At, 0, 0); PG8_STAGE(PG8_SA(1, 1), a1 + hstep, voffA);
            PG8_WAIT_V(8); PG8_WAIT_L(0); PG8_BAR; PG8_MMA(0, 0, At, B0); PG8_MMA(0, 1, At, B1); PG8_BAR; PG8_SCHED;
            PG8_LDA(At, 0, 1); PG8_STAGE(PG8_SB(0, 0), b2, voffB); PG8_STAGE(PG8_SB(0, 1), b2 + hstep, voffB); PG8_STAGE(PG8_SA(0, 0), a2, voffA);
            PG8_WAIT_V(8); PG8_WAIT_L(0); PG8_BAR; PG8_MMA(1, 0, At, B0); PG8_MMA(1, 1, At, B1); PG8_BAR; PG8_SCHED;
            PG8_LDB(B0, 1, 0); PG8_LDB(B1, 1, 1); PG8_SCHED; PG8_LDA(At, 1, 0); PG8_STAGE(PG8_SA(0, 1), a2 + hstep, voffA);
            PG8_WAIT_V(8); PG8_WAIT_L(0); PG8_BAR; PG8_MMA(0, 0, At, B0); PG8_MMA(0, 1, At, B1); PG8_BAR; PG8_SCHED;
            PG8_LDA(At, 1, 1); PG8_STAGE(PG8_SB(1, 0), b3, voffB); PG8_STAGE(PG8_SB(1, 1), b3 + hstep, voffB); PG8_STAGE(PG8_SA(1, 0), a3, voffA);
            PG8_WAIT_V(8); PG8_WAIT_L(0); PG8_BAR; PG8_MMA(1, 0, At, B0); PG8_MMA(1, 1, At, B1); PG8_BAR; PG8_SCHED;
            } else {
            PG8_LDB(B0, 0, 0); PG8_SCHED; PG8_LDA(At, 0, 0); PG8_STAGE(PG8_SA(1, 1), a1 + hstep, voffA);
            PG8_WAIT_L(8); PG8_BAR; PG8_WAIT_L(0); PG8_MMA(0, 0, At, B0); PG8_BAR; PG8_SCHED;
            PG8_LDB(B1, 0, 1); PG8_STAGE(PG8_SB(0, 0), b2, voffB);
            PG8_BAR; PG8_WAIT_L(0); PG8_MMA(0, 1, At, B1); PG8_BAR;
            PG8_LDA(At, 0, 1); PG8_STAGE(PG8_SA(0, 0), a2, voffA);
            PG8_BAR; PG8_WAIT_L(0); PG8_MMA(1, 0, At, B0); PG8_BAR; PG8_SCHED;
            PG8_STAGE(PG8_SB(0, 1), b2 + hstep, voffB);
            PG8_WAIT_V(6); PG8_BAR; PG8_MMA(1, 1, At, B1); PG8_BAR;
            PG8_LDB(B0, 1, 0); PG8_SCHED; PG8_LDA(At, 1, 0); PG8_STAGE(PG8_SA(0, 1), a2 + hstep, voffA);
            PG8_WAIT_L(8); PG8_BAR; PG8_WAIT_L(0); PG8_MMA(0, 0, At, B0); PG8_BAR; PG8_SCHED;
            PG8_LDB(B1, 1, 1); PG8_STAGE(PG8_SB(1, 0), b3, voffB);
            PG8_BAR; PG8_WAIT_L(0); PG8_MMA(0, 1, At, B1); PG8_BAR;
            PG8_LDA(At, 1, 1); PG8_STAGE(PG8_SA(1, 0), a3, voffA);
            PG8_BAR; PG8_WAIT_L(0); PG8_MMA(1, 0, At, B0); PG8_BAR; PG8_SCHED;
            PG8_STAGE(PG8_SB(1, 1), b3 + hstep, voffB);
            PG8_WAIT_V(6); PG8_BAR; PG8_MMA(1, 1, At, B1); PG8_BAR;
            }
        }
        if constexpr (ALIGN_EPI) { if (wr == 0) PG8_BAR; }
        if constexpr (!Epi::AFTER_DRAIN) { E(acc, cur, wr, wc, fr, fq); S.done(cur); }
        if (!has_next) break;
#pragma unroll
        for (int a = 0; a < 2; ++a)
#pragma unroll
            for (int b = 0; b < 2; ++b)
#pragma unroll
                for (int m = 0; m < 4; ++m)
#pragma unroll
                    for (int n = 0; n < 2; ++n) acc[a][b][m][n] = (f32x4){0.f, 0.f, 0.f, 0.f};
        cur = nxt; cA = nA; cB = nB; ++ui;
        if constexpr (ALIGN_EPI) { if (wr == 1) PG8_BAR; }
    }
    PG8_WAIT_V(0);
    if constexpr (!ALIGN_EPI) { if (wr == 0) PG8_BAR; }
    PG8_BAR;
    if constexpr (Epi::AFTER_DRAIN) { E.fused(acc, cur, wr, wc, fr, fq, lds, wid, lane); S.done(cur); }
#undef PG8_SA
#undef PG8_SB
#undef PG8_STAGE
#undef PG8_LDA
#undef PG8_LDB
#undef PG8_MMA
#undef PG8_WAIT_V
#undef PG8_WAIT_L
#undef PG8_BAR
#undef PG8_SCHED
}
}

struct EpiIn {
  static constexpr bool PERM = false, AFTER_DRAIN = false;
  const Params* pp; int l;
  __device__ __forceinline__ void operator()(f32x4 (&acc)[2][2][4][2], const pg8::Unit& u, int wr, int wc, int fr, int fq) const {
    kparams_t kp_ = kparams(); (void)kp_;
    const int U = u.pn * 4 + wc;
    if (U >= 77) return;
    const int rowb = u.pm * 256 + wr * 64 + fr;
    const int bq = (u.pm * 256) / T, tb = rowb % T;
    bf16_t* dst = nullptr; int ld = 0, col0 = 0; const float* gain = nullptr; bool rope = false, silu = false;
    float post = 1.0f;
    bf16_t* vt = nullptr;
    if (U < 8) { dst = WSP(bf16_t, OFF_QN); ld = 512; col0 = U * 64; gain = kp_->nsa_q_norm + l * 64; rope = true; post = 0.125f * LOG2E; }
    else if (U < 10) { dst = WSP(bf16_t, OFF_KC); ld = 128; col0 = (U - 8) * 64; rope = true; }
    else if (U < 12) { dst = WSP(bf16_t, OFF_VC); ld = 128; col0 = (U - 10) * 64; }
    else if (U < 14) { dst = WSP(bf16_t, OFF_KS); ld = 128; col0 = (U - 12) * 64; gain = kp_->nsa_k_norm + (l * 3 + 1) * 64; rope = true; }
    else if (U < 16) { vt = WSP(bf16_t, OFF_VST) + (size_t)((bq * 2 + (U - 14)) * 64) * T; }
    else if (U < 18) { dst = WSP(bf16_t, OFF_KW); ld = 128; col0 = (U - 16) * 64; gain = kp_->nsa_k_norm + (l * 3 + 2) * 64; rope = true; }
    else if (U < 20) { vt = WSP(bf16_t, OFF_VWT) + (size_t)((bq * 2 + (U - 18)) * 64) * T; }
    else if (U < 28) { dst = WSP(bf16_t, OFF_OA); ld = 512; col0 = (U - 20) * 64; silu = true; }
    else if (U < 36) { dst = WSP(bf16_t, OFF_FQ); ld = 512; col0 = (U - 28) * 64; gain = kp_->fox_q_norm + l * 64; post = 0.125f * LOG2E; }
    else if (U < 44) { dst = WSP(bf16_t, OFF_FK); ld = 512; col0 = (U - 36) * 64; gain = kp_->fox_k_norm + l * 64; }
    else if (U < 52) { vt = WSP(bf16_t, OFF_FVT) + (size_t)((bq * 8 + (U - 44)) * 64) * T; }
    else if (U < 60) { dst = WSP(bf16_t, OFF_OB); ld = 512; col0 = (U - 52) * 64; silu = true; }
    else if (U < 68) { dst = WSP(bf16_t, OFF_MQ); ld = 512; col0 = (U - 60) * 64; }
    else if (U < 76) { dst = WSP(bf16_t, OFF_OM); ld = 512; col0 = (U - 68) * 64; silu = true; }
    if (U == 76) {
      float* gate = WSP(float, OFF_GATE);
      float* flog = WSP(float, OFF_FLOG);
#pragma unroll
      for (int ai = 0; ai < 2; ++ai)
#pragma unroll
        for (int m = 0; m < 4; ++m) {
          const size_t row = (size_t)rowb + 128 * ai + 16 * m;
#pragma unroll
          for (int n = 0; n < 2; ++n)
#pragma unroll
            for (int i = 0; i < 4; ++i) {
              const int e = 16 * n + 4 * fq + i;
              const float v = acc[ai][0][m][n][i];
              if (e < 24) gate[row * 24 + e] = sigmoidf_(v);
              else {
                const float xx = v + kp_->fox_f_bias[l * 8 + (e - 24)];
                flog[row * 8 + (e - 24)] = xx >= 0.f ? -log1pf(expf(-xx)) : xx - log1pf(expf(xx));
              }
            }
        }
      return;
    }
    if (vt) {
#pragma unroll
      for (int ai = 0; ai < 2; ++ai)
#pragma unroll
        for (int m = 0; m < 4; ++m) {
          const int t = tb + 128 * ai + 16 * m;
#pragma unroll
          for (int bj = 0; bj < 2; ++bj)
#pragma unroll
            for (int n = 0; n < 2; ++n) {
              const f32x4 v = acc[ai][bj][m][n];
              const unsigned w0 = cvtpk(v[0], v[1]), w1 = cvtpk(v[2], v[3]);
              const unsigned qo = (unsigned)((32 * bj + 16 * n + 4 * fq) * T + t);
              vt[qo] = (bf16_t)(w0 & 0xffffu); vt[qo + T] = (bf16_t)(w0 >> 16); vt[qo + 2 * T] = (bf16_t)(w1 & 0xffffu); vt[qo + 3 * T] = (bf16_t)(w1 >> 16);
            }
        }
      return;
    }
    const float* ropetab = WSP(float, OFF_ROPE);
    f32x4 gv[2][2];
    if (gain) {
#pragma unroll
      for (int bj = 0; bj < 2; ++bj)
#pragma unroll
        for (int n = 0; n < 2; ++n) gv[bj][n] = *(const f32x4*)(gain + 32 * bj + 16 * n + 4 * fq);
    }
#pragma unroll
    for (int ai = 0; ai < 2; ++ai)
#pragma unroll
      for (int m = 0; m < 4; ++m) {
        f32x4 v[2][2];
#pragma unroll
        for (int bj = 0; bj < 2; ++bj)
#pragma unroll
          for (int n = 0; n < 2; ++n) v[bj][n] = acc[ai][bj][m][n];
        const int row = rowb + 128 * ai + 16 * m;
        if (gain) {
          float ss = 0.f;
#pragma unroll
          for (int bj = 0; bj < 2; ++bj)
#pragma unroll
            for (int n = 0; n < 2; ++n)
#pragma unroll
              for (int i = 0; i < 4; ++i) ss += v[bj][n][i] * v[bj][n][i];
          ss += __shfl_xor(ss, 16);
          ss += __shfl_xor(ss, 32);
          const float rstd = rsqrtf(ss * (1.0f / 64.0f) + EPS);
#pragma unroll
          for (int bj = 0; bj < 2; ++bj)
#pragma unroll
            for (int n = 0; n < 2; ++n) v[bj][n] = v[bj][n] * rstd * gv[bj][n];
        }
        if (rope) {
          const int pos = row & (T - 1);
#pragma unroll
          for (int n = 0; n < 2; ++n) {
            const f32x4* tp = (const f32x4*)(ropetab + ((size_t)pos * 32 + 16 * n + 4 * fq) * 2);
            const f32x4 t0 = tp[0], t1 = tp[1];
            const float cs[4] = {t0[0], t0[2], t1[0], t1[2]}, sn[4] = {t0[1], t0[3], t1[1], t1[3]};
#pragma unroll
            for (int i = 0; i < 4; ++i) {
              const float y1 = v[0][n][i], y2 = v[1][n][i];
              v[0][n][i] = y1 * cs[i] - y2 * sn[i];
              v[1][n][i] = y2 * cs[i] + y1 * sn[i];
            }
          }
        }
#pragma unroll
        for (int bj = 0; bj < 2; ++bj)
#pragma unroll
          for (int n = 0; n < 2; ++n) {
            f32x4 y = v[bj][n] * post;
            if (silu) {
#pragma unroll
              for (int i = 0; i < 4; ++i) y[i] = siluf_(y[i]);
            }
            u32x2 w = {cvtpk(y[0], y[1]), cvtpk(y[2], y[3])};
            *(u32x2*)(dst + (size_t)row * ld + col0 + 32 * bj + 16 * n + 4 * fq) = w;
          }
      }
  }
};
struct EpiMemKV {
  static constexpr bool PERM = false, AFTER_DRAIN = false;
  const Params* pp;
  __device__ __forceinline__ void operator()(f32x4 (&acc)[2][2][4][2], const pg8::Unit& u, int wr, int wc, int fr, int fq) const {
    kparams_t kp_ = kparams(); (void)kp_;
    const int U = u.pn * 4 + wc;
    const int rowb = u.pm * 256 + wr * 64 + fr;
#pragma unroll
    for (int ai = 0; ai < 2; ++ai)
#pragma unroll
      for (int m = 0; m < 4; ++m) {
        const int row = rowb + 128 * ai + 16 * m;
#pragma unroll
        for (int bj = 0; bj < 2; ++bj)
#pragma unroll
          for (int n = 0; n < 2; ++n) {
            const f32x4 v = acc[ai][bj][m][n];
            const unsigned w0 = cvtpk(v[0], v[1]), w1 = cvtpk(v[2], v[3]);
            const int e = 32 * bj + 16 * n + 4 * fq;
            if (U < 8) {
              u32x2 w = {w0, w1};
              *(u32x2*)(WSP(bf16_t, OFF_MK) + (size_t)row * 512 + U * 64 + e) = w;
            } else {
              const int col = (U - 8) * 64 + e, h = col >> 7, d = col & 127, b = row >> 8, mm = row & 255;
              bf16_t* q = WSP(bf16_t, OFF_MVT) + (size_t)((b * 4 + h) * 128 + d) * 256 + mm;
              q[0] = (bf16_t)(w0 & 0xffffu); q[256] = (bf16_t)(w0 >> 16); q[512] = (bf16_t)(w1 & 0xffffu); q[768] = (bf16_t)(w1 >> 16);
            }
          }
      }
  }
};
struct EpiGate {
  static constexpr bool PERM = true, AFTER_DRAIN = false;
  bf16_t* G;
  __device__ __forceinline__ void operator()(f32x4 (&acc)[2][2][4][2], const pg8::Unit& u, int wr, int wc, int fr, int fq) const {
    const int br = u.pn >> 2, colt = (u.pn & 3) * 256 + wc * 32 + 8 * fq;
    bf16_t* base = G + (size_t)br * M * 1024;
    const int rowb = u.pm * 256 + wr * 64 + fr;
#pragma unroll
    for (int ai = 0; ai < 2; ++ai)
#pragma unroll
      for (int m = 0; m < 4; ++m) {
        bf16_t* rp = base + (size_t)(rowb + 128 * ai + 16 * m) * 1024 + colt;
#pragma unroll
        for (int bj = 0; bj < 2; ++bj) {
          const f32x4 v0 = acc[ai][bj][m][0], v1 = acc[ai][bj][m][1];
          u32x4 w = {cvtpk(sigmoidf_(v0[0]), sigmoidf_(v0[1])), cvtpk(sigmoidf_(v0[2]), sigmoidf_(v0[3])),
                     cvtpk(sigmoidf_(v1[0]), sigmoidf_(v1[1])), cvtpk(sigmoidf_(v1[2]), sigmoidf_(v1[3]))};
          *(u32x4*)(rp + 128 * bj) = w;
        }
      }
  }
};
struct EpiBranch {
  static constexpr bool PERM = true, AFTER_DRAIN = false;
  const bf16_t* G; bf16_t* Uo; int first;
  __device__ __forceinline__ void operator()(f32x4 (&acc)[2][2][4][2], const pg8::Unit& u, int wr, int wc, int fr, int fq) const {
    const int colt = u.pn * 256 + wc * 32 + 8 * fq;
    const int rowb = u.pm * 256 + wr * 64 + fr;
#pragma unroll
    for (int ai = 0; ai < 2; ++ai)
#pragma unroll
      for (int m = 0; m < 4; ++m) {
        const size_t ro = (size_t)(rowb + 128 * ai + 16 * m) * 1024 + colt;
#pragma unroll
        for (int bj = 0; bj < 2; ++bj) {
          const size_t off = ro + 128 * bj;
          const u32x4 gw = *(const u32x4*)(G + off);
          float y[8];
#pragma unroll
          for (int q = 0; q < 4; ++q) {
            const f32x4 v = acc[ai][bj][m][q >> 1];
            y[2 * q] = v[(2 * q) & 3] * bflo(gw[q]);
            y[2 * q + 1] = v[(2 * q + 1) & 3] * bfhi(gw[q]);
          }
          if (!first) {
            const u32x4 uw = *(const u32x4*)(Uo + off);
#pragma unroll
            for (int q = 0; q < 4; ++q) { y[2 * q] += bflo(uw[q]); y[2 * q + 1] += bfhi(uw[q]); }
          }
          u32x4 w = {cvtpk(y[0], y[1]), cvtpk(y[2], y[3]), cvtpk(y[4], y[5]), cvtpk(y[6], y[7])};
          *(u32x4*)(Uo + off) = w;
        }
      }
  }
};
struct EpiOut {
  static constexpr bool PERM = true, AFTER_DRAIN = false;
  const float* xin; float* xout;
  __device__ __forceinline__ void operator()(f32x4 (&acc)[2][2][4][2], const pg8::Unit& u, int wr, int wc, int fr, int fq) const {
    const int colt = u.pn * 256 + wc * 32 + 8 * fq;
    const int rowb = u.pm * 256 + wr * 64 + fr;
#pragma unroll
    for (int ai = 0; ai < 2; ++ai)
#pragma unroll
      for (int m = 0; m < 4; ++m) {
        const size_t ro = (size_t)(rowb + 128 * ai + 16 * m) * 1024 + colt;
#pragma unroll
        for (int bj = 0; bj < 2; ++bj) {
          const size_t off = ro + 128 * bj;
          const f32x4 x0 = *(const f32x4*)(xin + off), x1 = *(const f32x4*)(xin + off + 4);
          *(f32x4*)(xout + off) = x0 + acc[ai][bj][m][0];
          *(f32x4*)(xout + off + 4) = x1 + acc[ai][bj][m][1];
        }
      }
  }
};
template <class Epi>
__device__ __forceinline__ void run_gemm(PG8_LAS unsigned char* lds, const bf16_t* A, const bf16_t* Bt, int Mr, int Nc, int K, const Epi& E) {
  pg8::Gemm g{A, Bt, Mr, Nc, K};
  pg8::StaticOrder S;
  S.init(Mr, Nc, gdim(), bidx());
  pg8::gemm_phase<Epi, pg8::StaticOrder, true, true>(lds, g, S, E);
}

__device__ __forceinline__ int map_in(int n) {
  const int i = n >> 6, c = n & 63;
  if (i < 20) return n;
  if (i < 28) return 1304 + (n - 1280);
  if (i < 52) return 1816 + (n - 1792);
  if (i < 60) return 3360 + (n - 3328);
  if (i < 68) return 3872 + (n - 3840);
  if (i < 76) return 4384 + (n - 4352);
  if (i == 76) return c < 24 ? 1280 + c : (c < 32 ? 3352 + (c - 24) : -1);
  return -1;
}
__device__ __forceinline__ void wave_transpose_tile(const float* __restrict__ src, int ld_src, int k0, int n0, bf16_t* __restrict__ dst,
                                                    int Kdim, int maptype, int srccol0, float* tile, int lane) {
  int nlog = n0 + lane;
  if (maptype) { const int w = nlog & 255; nlog = (nlog & ~255) + (((w & 127) >> 5) << 6) + (((w >> 7) << 5) | (w & 31)); }
  const int sc = (maptype == 1) ? map_in(nlog) : srccol0 + nlog;
  const float* sp = src + (size_t)k0 * ld_src + (sc >= 0 ? sc : 0);
#pragma unroll 16
  for (int kk = 0; kk < 64; ++kk) {
    const float v = sp[(size_t)kk * ld_src];
    tile[kk * 65 + lane] = sc >= 0 ? v : 0.f;
  }
  __builtin_amdgcn_fence(__ATOMIC_SEQ_CST, "workgroup");
  __builtin_amdgcn_wave_barrier();
  const int rsub = lane >> 5, kp = lane & 31;
#pragma unroll 8
  for (int it = 0; it < 32; ++it) {
    const int row = 2 * it + rsub;
    const float a = tile[(2 * kp) * 65 + row], b = tile[(2 * kp + 1) * 65 + row];
    *(unsigned*)(dst + (size_t)(n0 + row) * Kdim + k0 + 2 * kp) = cvtpk(a, b);
  }
  __builtin_amdgcn_fence(__ATOMIC_SEQ_CST, "workgroup");
  __builtin_amdgcn_wave_barrier();
}
__device__ __forceinline__ void rmsnorm4(const float* __restrict__ x, const float* __restrict__ gain, bf16_t* __restrict__ dst, size_t row0, int lane) {
  f32x4 v[4][4];
  float ss[4];
#pragma unroll
  for (int rr = 0; rr < 4; ++rr)
#pragma unroll
    for (int i = 0; i < 4; ++i) v[rr][i] = *(const f32x4*)(x + (row0 + rr) * 1024 + lane * 4 + 256 * i);
  f32x4 gv[4];
#pragma unroll
  for (int i = 0; i < 4; ++i) gv[i] = *(const f32x4*)(gain + lane * 4 + 256 * i);
#pragma unroll
  for (int rr = 0; rr < 4; ++rr) {
    float s = 0.f;
#pragma unroll
    for (int i = 0; i < 4; ++i) s += v[rr][i][0] * v[rr][i][0] + v[rr][i][1] * v[rr][i][1] + v[rr][i][2] * v[rr][i][2] + v[rr][i][3] * v[rr][i][3];
    ss[rr] = s;
  }
#pragma unroll
  for (int o_ = 1; o_ < 64; o_ <<= 1) {
#pragma unroll
    for (int rr = 0; rr < 4; ++rr) ss[rr] += __shfl_xor(ss[rr], o_);
  }
#pragma unroll
  for (int rr = 0; rr < 4; ++rr) {
    const float rstd = rsqrtf(ss[rr] * (1.0f / 1024.0f) + EPS);
#pragma unroll
    for (int i = 0; i < 4; ++i) {
      const f32x4 y = v[rr][i] * rstd * gv[i];
      u32x2 w = {cvtpk(y[0], y[1]), cvtpk(y[2], y[3])};
      *(u32x2*)(dst + (row0 + rr) * 1024 + lane * 4 + 256 * i) = w;
    }
  }
}
__device__ __forceinline__ void phase_prep(const Params& p, int l, float* smem) {
  kparams_t kp_ = kparams(); (void)kp_;
  const int tid = tidx();
  const int wave = tid >> 6, lane = tid & 63;
  const int gw = wave * gdim() + bidx(), nw = NWAVES * gdim();
  if (l == 0 && bidx() == 0 && tid < 64) WSP(unsigned, OFF_CTL)[tid] = 0u;
  const float* xin = (l == 0) ? kp_->x : kp_->out;
  float* wtile = smem + wave * 4160;
  for (int u0 = gw; u0 < 3076; u0 += nw) {
    int u = u0;
    const float* src; int ld, kt, nt, Kd, mt = 0, c0 = 0; bf16_t* dst;
    if (u < 1280) { kt = u / 80; nt = u % 80; src = kp_->w_in + (size_t)l * 1024 * 7968; ld = 7968; Kd = 1024; dst = WSP(bf16_t, OFF_W_IN); mt = 1; }
    else if ((u -= 1280) < 768) { kt = u / 48; nt = u % 48; src = kp_->w_in + (size_t)l * 1024 * 7968; ld = 7968; Kd = 1024; dst = WSP(bf16_t, OFF_W_G); c0 = 4896; }
    else if ((u -= 768) < 256) { kt = u / 16; nt = u % 16; src = kp_->w_mem_kv + (size_t)l * 1024 * 1024; ld = 1024; Kd = 1024; dst = WSP(bf16_t, OFF_W_MKV); mt = 2; }
    else if ((u -= 256) < 384) { const int br = u / 128, uu = u % 128; kt = uu / 16; nt = uu % 16;
      src = (br == 0 ? kp_->w_branch_a : br == 1 ? kp_->w_branch_b : kp_->w_branch_m) + (size_t)l * 512 * 1024; ld = 1024; Kd = 512; dst = WSP(bf16_t, OFF_W_BR + (size_t)br * MiB); }
    else if ((u -= 384) < 256) { kt = u / 16; nt = u % 16; src = kp_->w_out + (size_t)l * 1024 * 1024; ld = 1024; Kd = 1024; dst = WSP(bf16_t, OFF_W_OUT); }
    else if ((u -= 256) < 128) { const int kv = u / 64, uu = u % 64; kt = uu / 2; nt = uu % 2;
      src = (kv ? kp_->cmp_w1_v : kp_->cmp_w1_k) + (size_t)l * 2048 * 128; ld = 128; Kd = 2048; dst = WSP(bf16_t, OFF_W1 + (size_t)kv * 512 * 1024); }
    else { u -= 128; const int kv = u / 2; kt = u % 2; nt = 0;
      src = (kv ? kp_->cmp_w2_v : kp_->cmp_w2_k) + (size_t)l * 128 * 64; ld = 64; Kd = 128; dst = WSP(bf16_t, OFF_W2 + (size_t)kv * 64 * 1024); }
    wave_transpose_tile(src, ld, kt * 64, nt * 64, dst, Kd, mt, c0, wtile, lane);
  }
  for (int grp = gw; grp < 8192 + 256; grp += nw) {
    if (grp < 8192) rmsnorm4(xin, kp_->norm_g + l * 1024, WSP(bf16_t, OFF_H), (size_t)grp * 4, lane);
    else rmsnorm4(kp_->mem, kp_->mem_norm_g + l * 1024, WSP(bf16_t, OFF_MEMN), (size_t)(grp - 8192) * 4, lane);
  }
  for (int u = gw; u < 32; u += nw) {
    const int kv = u >> 4, ch = u & 15;
    const float* pe = (kv ? kp_->cmp_pe_v : kp_->cmp_pe_k) + (size_t)l * 2048 + ch * 128;
    const float* w1 = (kv ? kp_->cmp_w1_v : kp_->cmp_w1_k) + (size_t)l * 2048 * 128 + (size_t)ch * 128 * 128;
    float s0 = 0.f, s1 = 0.f;
#pragma unroll 16
    for (int kk = 0; kk < 128; ++kk) {
      const float pv = pe[kk];
      s0 += pv * w1[(size_t)kk * 128 + lane];
      s1 += pv * w1[(size_t)kk * 128 + 64 + lane];
    }
    float* part = WSP(float, OFF_C1) + (size_t)(kv * 16 + ch) * 128;
    part[lane] = s0;
    part[64 + lane] = s1;
  }
  if (l == 0) {
    for (int u = bidx(); u < 512; u += gdim()) {
      for (int e = tid; e < 512; e += NTHREADS) {
        const int idx = u * 512 + e, pos = idx >> 5, f = idx & 31;
        const float ang = (float)pos * c_inv_freq[f];
        const double a = (double)ang;
        const double k = rint(a * 0.15915494309189535);
        const float rr = (float)(a - k * 6.283185307179586);
        float2 cs; cs.x = __cosf(rr); cs.y = __sinf(rr);
        WSP(float2, OFF_ROPE)[idx] = cs;
      }
    }
  }
}

__device__ __forceinline__ void compress_wg(const Params& p, int l, int up, float* smem) {
  kparams_t kp_ = kparams(); (void)kp_;
  const int wave_ = tidx() >> 6, kc = wave_ & 3, u = up * 2 + (wave_ >> 2);
  const int lane = tidx() & 63, r = lane & 15, g4 = lane >> 4;
  const int kv = u >> 7, rem = u & 127, b = rem >> 5, grp = (rem >> 4) & 1, it = rem & 15, i0 = it * 32;
  const bf16_t* src = WSP(bf16_t, kv ? OFF_VC : OFF_KC);
  const bf16_t* w1t = WSP(bf16_t, OFF_W1 + (size_t)kv * 512 * 1024);
  const bf16_t* w2t = WSP(bf16_t, OFF_W2 + (size_t)kv * 64 * 1024);
  const float* c1 = WSP(float, OFF_C1 + 16384) + kv * 128;
  const bf16_t* arow[2];
#pragma unroll
  for (int mt = 0; mt < 2; ++mt) {
    int i = i0 + 16 * mt + r;
    if (i > 510) i = 510;
    arow[mt] = src + ((size_t)b * T + 16 * i) * 128 + grp * 64 + g4 * 8;
  }
  f32x4 acc[2][8];
#pragma unroll
  for (int a = 0; a < 2; ++a)
#pragma unroll
    for (int c = 0; c < 8; ++c) acc[a][c] = (f32x4){0.f, 0.f, 0.f, 0.f};
  const bf16_t* bp = w1t + (size_t)r * 2048 + g4 * 8;
#pragma unroll 1
  for (int k0 = kc * 512; k0 < kc * 512 + 512; k0 += 32) {
    const int pp = k0 >> 6, d = k0 & 63;
    bf16x8 af[2], bf[8];
#pragma unroll
    for (int mt = 0; mt < 2; ++mt) af[mt] = *(const bf16x8*)(arow[mt] + (size_t)pp * 128 + d);
#pragma unroll
    for (int nt = 0; nt < 8; ++nt) bf[nt] = *(const bf16x8*)(bp + (size_t)nt * 16 * 2048 + k0);
#pragma unroll
    for (int mt = 0; mt < 2; ++mt)
#pragma unroll
      for (int nt = 0; nt < 8; ++nt) acc[mt][nt] = mfma16(bf[nt], af[mt], acc[mt][nt]);
  }
  {
    float* part = smem + wave_ * 4096;
#pragma unroll
    for (int a = 0; a < 2; ++a)
#pragma unroll
      for (int c = 0; c < 8; ++c)
#pragma unroll
        for (int i = 0; i < 4; ++i) part[((a * 8 + c) * 4 + i) * 64 + lane] = acc[a][c][i];
  }
  __syncthreads();
  if (kc != 0) return;
#pragma unroll 1
  for (int q = 1; q < 4; ++q) {
    const float* part = smem + (wave_ + q) * 4096;
#pragma unroll
    for (int a = 0; a < 2; ++a) {
#pragma unroll
      for (int c = 0; c < 8; ++c)
#pragma unroll
        for (int i = 0; i < 4; ++i) acc[a][c][i] += part[((a * 8 + c) * 4 + i) * 64 + lane];
      asm volatile("" ::: "memory");
    }
  }
#pragma unroll
  for (int nt = 0; nt < 8; ++nt) {
    const f32x4 cv = *(const f32x4*)(c1 + 16 * nt + 4 * g4);
#pragma unroll
    for (int mt = 0; mt < 2; ++mt)
#pragma unroll
      for (int i = 0; i < 4; ++i) acc[mt][nt][i] = siluf_(acc[mt][nt][i] + cv[i]);
  }
  bf16x8 wf[4][4];
#pragma unroll
  for (int ks = 0; ks < 4; ++ks)
#pragma unroll
    for (int et = 0; et < 4; ++et) {
      const bf16_t* wp = w2t + (size_t)(16 * et + r) * 128 + 32 * ks + 4 * g4;
      const u32x2 lo = *(const u32x2*)wp, hi = *(const u32x2*)(wp + 16);
      u32x4 w = {lo[0], lo[1], hi[0], hi[1]};
      wf[ks][et] = __builtin_bit_cast(bf16x8, w);
    }
  if (kv == 0) {
    const float* gain = kp_->nsa_k_norm + (size_t)(l * 3 + 0) * 64;
    bf16_t* dst = WSP(bf16_t, OFF_KCMP) + (size_t)((b * 2 + grp) * 512) * 64;
    f32x4 gv[4];
#pragma unroll
    for (int et = 0; et < 4; ++et) gv[et] = *(const f32x4*)(gain + 16 * et + 4 * g4);
#pragma unroll
    for (int mt = 0; mt < 2; ++mt) {
      f32x4 o[4];
#pragma unroll
      for (int et = 0; et < 4; ++et) o[et] = (f32x4){0.f, 0.f, 0.f, 0.f};
#pragma unroll
      for (int ks = 0; ks < 4; ++ks) {
        const bf16x8 xf = pack8(acc[mt][2 * ks], acc[mt][2 * ks + 1]);
#pragma unroll
        for (int et = 0; et < 4; ++et) o[et] = mfma16(wf[ks][et], xf, o[et]);
      }
      float ss = 0.f;
#pragma unroll
      for (int et = 0; et < 4; ++et)
#pragma unroll
        for (int i = 0; i < 4; ++i) ss += o[et][i] * o[et][i];
      ss += __shfl_xor(ss, 16);
      ss += __shfl_xor(ss, 32);
      const float rstd = rsqrtf(ss * (1.0f / 64.0f) + EPS);
      const int i = i0 + 16 * mt + r;
#pragma unroll
      for (int et = 0; et < 4; ++et) {
        f32x4 y = o[et] * rstd * gv[et];
        if (i > 510) y = (f32x4){0.f, 0.f, 0.f, 0.f};
        u32x2 w = {cvtpk(y[0], y[1]), cvtpk(y[2], y[3])};
        *(u32x2*)(dst + (size_t)i * 64 + 16 * et + 4 * g4) = w;
      }
    }
  } else {
    bf16_t* dst = WSP(bf16_t, OFF_VCT) + (size_t)((b * 2 + grp) * 64) * 512;
#pragma unroll
    for (int mt = 0; mt < 2; ++mt) {
      f32x4 o[4];
#pragma unroll
      for (int et = 0; et < 4; ++et) o[et] = (f32x4){0.f, 0.f, 0.f, 0.f};
#pragma unroll
      for (int ks = 0; ks < 4; ++ks) {
        const bf16x8 xf = pack8(acc[mt][2 * ks], acc[mt][2 * ks + 1]);
#pragma unroll
        for (int et = 0; et < 4; ++et) o[et] = mfma16(xf, wf[ks][et], o[et]);
      }
#pragma unroll
      for (int et = 0; et < 4; ++et) {
        f32x4 y = o[et];
        const int ib = i0 + 16 * mt + 4 * g4;
#pragma unroll
        for (int i = 0; i < 4; ++i)
          if (ib + i > 510) y[i] = 0.f;
        u32x2 w = {cvtpk(y[0], y[1]), cvtpk(y[2], y[3])};
        *(u32x2*)(dst + (size_t)(16 * et + r) * 512 + ib) = w;
      }
    }
  }
}
__device__ __forceinline__ void cumsum_wg(const Params& p, int u, float* smem) {
  kparams_t kp_ = kparams(); (void)kp_;
  const int tid = tidx(), lane = tid & 63, wave = tid >> 6, b = u >> 3, h = u & 7;
  const float* fl = WSP(float, OFF_FLOG) + ((size_t)b * T) * 8 + h;
  float* fc = WSP(float, OFF_FC) + (size_t)(b * 8 + h) * T;
  const int tb = tid * 16;
  float v[16];
#pragma unroll
  for (int i = 0; i < 16; ++i) v[i] = fl[(size_t)(tb + i) * 8];
  double s = 0.0;
#pragma unroll
  for (int i = 0; i < 16; ++i) s += (double)v[i];
  double incl = s;
#pragma unroll
  for (int o = 1; o < 64; o <<= 1) {
    const double y = __shfl_up(incl, o);
    if (lane >= o) incl += y;
  }
  double* wtot = (double*)smem;
  if (lane == 63) wtot[wave] = incl;
  __syncthreads();
  double base = 0.0;
  for (int w = 0; w < wave; ++w) base += wtot[w];
  double run = base + incl - s;
#pragma unroll
  for (int i = 0; i < 16; ++i) { run += (double)v[i]; v[i] = (float)run; }
#pragma unroll
  for (int i = 0; i < 4; ++i) *(f32x4*)(fc + tb + 4 * i) = (f32x4){v[4 * i], v[4 * i + 1], v[4 * i + 2], v[4 * i + 3]};
  __syncthreads();
}
__device__ __forceinline__ void memk_norm_unit(const Params& p, int l, int u) {
  kparams_t kp_ = kparams(); (void)kp_;
  const int lane = tidx() & 63;
  bf16_t* mk = WSP(bf16_t, OFF_MK);
  const float* gain = kp_->mem_k_norm + l * 128 + (lane & 15) * 8;
  for (int rr = 0; rr < 16; ++rr) {
    bf16_t* ptr = mk + (size_t)(u * 16 + rr) * 512 + lane * 8;
    const u32x4 w = *(const u32x4*)ptr;
    float v[8];
#pragma unroll
    for (int j = 0; j < 4; ++j) { v[2 * j] = bflo(w[j]); v[2 * j + 1] = bfhi(w[j]); }
    float ss = 0.f;
#pragma unroll
    for (int j = 0; j < 8; ++j) ss += v[j] * v[j];
#pragma unroll
    for (int o = 1; o < 16; o <<= 1) ss += __shfl_xor(ss, o);
    const float rstd = rsqrtf(ss * (1.0f / 128.0f) + EPS);
    u32x4 ow;
#pragma unroll
    for (int j = 0; j < 4; ++j) ow[j] = cvtpk(v[2 * j] * rstd * gain[2 * j], v[2 * j + 1] * rstd * gain[2 * j + 1]);
    *(u32x4*)ptr = ow;
  }
}
__device__ __forceinline__ void phase_mid(const Params& p, int l, float* smem) {
  const int wave = tidx() >> 6;
  for (int u = bidx(); u < 128 + 32 + 8; u += gdim()) {
    if (u < 128) { compress_wg(p, l, u, smem); __syncthreads(); }
    else if (u < 160) cumsum_wg(p, u - 128, smem);
    else memk_norm_unit(p, l, (u - 160) * 8 + wave);
  }
}

template <int NCT, int NDK, bool QL = false>
__device__ __forceinline__ void qk_scores(const bf16_t* __restrict__ kbase, int ldk, int key0,
                                          const bf16x8 (&qf)[NCT][NDK], f32x4 (&s)[2][NCT], int lane, const bf16x8* qlds = nullptr) {
  const int r = lane & 15, grp = lane >> 4;
#pragma unroll
  for (int kt = 0; kt < 2; ++kt) {
    const bf16_t* kp = kbase + (size_t)(key0 + 8 * (r >> 2) + 4 * kt + (r & 3)) * ldk + grp * 8;
    bf16x8 kf[NDK];
#pragma unroll
    for (int dk = 0; dk < NDK; ++dk) kf[dk] = *(const bf16x8*)(kp + dk * 32);
#pragma unroll
    for (int ct = 0; ct < NCT; ++ct) {
      f32x4 a = {0.f, 0.f, 0.f, 0.f};
#pragma unroll
      for (int dk = 0; dk < NDK; ++dk) a = mfma16(kf[dk], QL ? qlds[(ct * NDK + dk) * 64 + lane] : qf[ct][dk], a);
      s[kt][ct] = a;
    }
  }
}
template <int NCT, int NDT>
__device__ __forceinline__ void pv_accum(const bf16_t* __restrict__ vt, size_t ldv, int key0,
                                         const f32x4 (&s)[2][NCT], f32x4 (&o)[NDT][NCT], int lane) {
  const int r = lane & 15, grp = lane >> 4;
  bf16x8 pb[NCT];
#pragma unroll
  for (int ct = 0; ct < NCT; ++ct) pb[ct] = pack8(s[0][ct], s[1][ct]);
#pragma unroll
  for (int dt = 0; dt < NDT; ++dt) {
    const bf16x8 vf = *(const bf16x8*)(vt + (size_t)(16 * dt + r) * ldv + key0 + 8 * grp);
#pragma unroll
    for (int ct = 0; ct < NCT; ++ct) o[dt][ct] = mfma16(vf, pb[ct], o[dt][ct]);
  }
}
template <int NCT, int NDT, bool HAS_O, bool SUMS = true>
__device__ __forceinline__ void softmax_update(f32x4 (&s)[2][NCT], float (&m)[NCT], float (&lsum)[NCT],
                                               f32x4 (&o)[NDT][NCT], f32x4 (*lacc)[NCT] = nullptr) {
  float mnew[NCT];
  bool ch = false;
#pragma unroll
  for (int ct = 0; ct < NCT; ++ct) {
    float mx = fmaxf(fmaxf(fmaxf(s[0][ct][0], s[0][ct][1]), fmaxf(s[0][ct][2], s[0][ct][3])),
                     fmaxf(fmaxf(s[1][ct][0], s[1][ct][1]), fmaxf(s[1][ct][2], s[1][ct][3])));
    mx = grp_max4(mx);
    mnew[ct] = fmaxf(m[ct], mx);
    ch = ch || (mnew[ct] > m[ct]);
  }
  if (__any(ch)) {
#pragma unroll
    for (int ct = 0; ct < NCT; ++ct) {
      const float msafe = (mnew[ct] == NEG_INF) ? 0.f : mnew[ct];
      const float alpha = __builtin_amdgcn_exp2f(m[ct] - msafe);
      m[ct] = mnew[ct];
      if (SUMS) lsum[ct] *= alpha; else (*lacc)[ct] = (*lacc)[ct] * alpha;
      if (HAS_O) {
#pragma unroll
        for (int dt = 0; dt < NDT; ++dt) o[dt][ct] = o[dt][ct] * alpha;
      }
    }
  }
#pragma unroll
  for (int ct = 0; ct < NCT; ++ct) {
    const float msafe = (m[ct] == NEG_INF) ? 0.f : m[ct];
#pragma unroll
    for (int kt = 0; kt < 2; ++kt) {
      const f32x4 d = s[kt][ct] - msafe;
      f32x4 pv;
#pragma unroll
      for (int i = 0; i < 4; ++i) pv[i] = __builtin_amdgcn_exp2f(d[i]);
      s[kt][ct] = pv;
    }
    if (SUMS) {
      const f32x4 t4 = s[0][ct] + s[1][ct];
      lsum[ct] += (t4[0] + t4[1]) + (t4[2] + t4[3]);
    }
  }
}
__device__ __forceinline__ float finish_l(float lsum) {
  lsum += __shfl_xor(lsum, 16);
  lsum += __shfl_xor(lsum, 32);
  return lsum > 0.f ? 1.0f / lsum : 0.f;
}

typedef __attribute__((address_space(3))) unsigned char lds_u8;
constexpr int TILE_ROWB = 144, TILE_HALF = 64 * TILE_ROWB, TILE_STAGE = 2 * TILE_HALF + 256;
struct TileRegs { u32x4 k, v; };
__device__ __forceinline__ void tile_gload(TileRegs& tr, const bf16_t* __restrict__ kbase, int ldk, const bf16_t* __restrict__ vtbase,
                                           size_t ldv, int key0, int tid) {
  const int row = tid >> 3, ch = tid & 7;
  tr.k = *(const u32x4*)(kbase + (size_t)(key0 + row) * ldk + ch * 8);
  tr.v = *(const u32x4*)(vtbase + (size_t)row * ldv + key0 + ch * 8);
}
__device__ __forceinline__ void tile_swrite(const TileRegs& tr, lds_u8* stage, int tid) {
  const int row = tid >> 3, ch = tid & 7;
  *(__attribute__((address_space(3))) u32x4*)(stage + row * TILE_ROWB + ch * 16) = tr.k;
  *(__attribute__((address_space(3))) u32x4*)(stage + TILE_HALF + row * TILE_ROWB + ch * 16) = tr.v;
}
template <int NCT, int NDK, bool QL>
__device__ __forceinline__ void qk_scores_lds(const lds_u8* stage, int hf, const bf16x8 (&qf)[NCT][NDK], f32x4 (&s)[2][NCT], int lane,
                                              const bf16x8* qlds, const f32x4 c0, const f32x4 c1) {
  const int r = lane & 15, grp = lane >> 4;
#pragma unroll
  for (int kt = 0; kt < 2; ++kt) {
    const lds_u8* kp = stage + (32 * hf + 8 * (r >> 2) + 4 * kt + (r & 3)) * TILE_ROWB + grp * 16;
    bf16x8 kf[NDK];
#pragma unroll
    for (int dk = 0; dk < NDK; ++dk) kf[dk] = *(const __attribute__((address_space(3))) bf16x8*)(kp + dk * 64);
#pragma unroll
    for (int ct = 0; ct < NCT; ++ct) {
      f32x4 a = kt ? c1 : c0;
#pragma unroll
      for (int dk = 0; dk < NDK; ++dk) a = mfma16(kf[dk], QL ? qlds[(ct * NDK + dk) * 64 + lane] : qf[ct][dk], a);
      s[kt][ct] = a;
    }
  }
}
template <int NDT>
__device__ __forceinline__ void v_frags_lds(const lds_u8* stage, int hf, bf16x8 (&vf)[NDT], int lane) {
  const int r = lane & 15, grp = lane >> 4;
#pragma unroll
  for (int dt = 0; dt < NDT; ++dt)
    vf[dt] = *(const __attribute__((address_space(3))) bf16x8*)(stage + TILE_HALF + (16 * dt + r) * TILE_ROWB + (32 * hf + 8 * grp) * 2);
}
template <int NCT, int NDT>
__device__ __forceinline__ void pv_accum_lds(const bf16x8 (&vfp)[NDT], const f32x4 (&s)[2][NCT], f32x4 (&o)[NDT][NCT], int lane, f32x4 (&lacc)[NCT]) {
  const int r = lane & 15, grp = lane >> 4; (void)r; (void)grp;
  bf16x8 pb[NCT];
#pragma unroll
  for (int ct = 0; ct < NCT; ++ct) pb[ct] = pack8(s[0][ct], s[1][ct]);
  {
    const short one = (short)0x3F80;
    const bf16x8 ones = {one, one, one, one, one, one, one, one};
#pragma unroll
    for (int ct = 0; ct < NCT; ++ct) lacc[ct] = mfma16(ones, pb[ct], lacc[ct]);
  }
#pragma unroll
  for (int dt = 0; dt < NDT; ++dt) {
    const bf16x8 vf = vfp[dt];
#pragma unroll
    for (int ct = 0; ct < NCT; ++ct) o[dt][ct] = mfma16(vf, pb[ct], o[dt][ct]);
  }
}
__device__ __forceinline__ int next_bit(unsigned long long lo, unsigned long long hi, int from) {
  if (from < 64) { const unsigned long long mm = lo & (~0ull << from); if (mm) return __ffsll(mm) - 1; from = 64; }
  if (from < 128) { const unsigned long long mm = hi & (~0ull << (from - 64)); if (mm) return 64 + __ffsll(mm) - 1; }
  return 128;
}

__device__ __forceinline__ void nsa_wg_unit(const Params& p, int b, int g, int qi, float* imp, bf16x8* qlds, float* scr, lds_u8* tiles, unsigned* misc, bool st) {
  kparams_t kp_ = kparams(); (void)kp_;
  const int tid0 = tidx();
  const int wave = __builtin_amdgcn_readfirstlane(tid0 >> 6);
  const int lane0 = tid0 & 63;
  const int tq = qi * 8 + wave;
  const int t0 = tq * 16;
  const bf16x8 (&qf)[4][2] = *(const bf16x8 (*)[4][2])nullptr;
#define NSA_SECTION_VARS \
  int lane = lane0; asm volatile("" : "+v"(lane)); \
  const int r = lane & 15, grp = lane >> 4, t = t0 + r; \
  const size_t row = (size_t)b * T + t; \
  const float* gatep = WSP(float, OFF_GATE) + row * 24 + g * 12; (void)gatep; (void)grp; (void)t;
  {
    NSA_SECTION_VARS
#pragma unroll
    for (int ct = 0; ct < 4; ++ct)
#pragma unroll
      for (int dk = 0; dk < 2; ++dk)
        qlds[(ct * 2 + dk) * 64 + lane] = *(const bf16x8*)(WSP(bf16_t, OFF_QN) + row * 512 + (g * 4 + ct) * 64 + dk * 32 + grp * 8);
  }
  f32x4 o[4][4];
  float m[4], lsum[4];
  f32x4 lacc[4];
  {
    NSA_SECTION_VARS
    const bf16_t* kc = WSP(bf16_t, OFF_KCMP) + (size_t)((b * 2 + g) * 512) * 64;
    const bf16_t* vct = WSP(bf16_t, OFF_VCT) + (size_t)((b * 2 + g) * 64) * 512;
    const int nblk = (tq + 31) >> 5;
#pragma unroll
    for (int ct = 0; ct < 4; ++ct) { m[ct] = NEG_INF; lsum[ct] = 0.f; }
#pragma unroll 1
    for (int blk = 0; blk < nblk; ++blk) {
      f32x4 s[2][4];
      qk_scores<4, 2, true>(kc, 64, blk * 32, qf, s, lane, qlds);
#pragma unroll
      for (int kt = 0; kt < 2; ++kt)
#pragma unroll
        for (int i = 0; i < 4; ++i) {
          const int n = blk * 32 + 8 * grp + 4 * kt + i;
          const bool ok = (16 * n + 31 <= t);
#pragma unroll
          for (int ct = 0; ct < 4; ++ct) s[kt][ct][i] = ok ? s[kt][ct][i] : NEG_INF;
        }
      softmax_update<4, 4, false>(s, m, lsum, o);
    }
    float invl[4], msafe[4];
#pragma unroll
    for (int ct = 0; ct < 4; ++ct) { invl[ct] = finish_l(lsum[ct]); msafe[ct] = (m[ct] == NEG_INF) ? 0.f : m[ct]; }
    for (int e = lane; e < 16 * 132; e += 64) imp[e] = 0.f;
    __builtin_amdgcn_fence(__ATOMIC_SEQ_CST, "workgroup");
    __builtin_amdgcn_wave_barrier();
#pragma unroll
    for (int dt = 0; dt < 4; ++dt)
#pragma unroll
      for (int ct = 0; ct < 4; ++ct) o[dt][ct] = (f32x4){0.f, 0.f, 0.f, 0.f};
#pragma unroll 1
    for (int blk = 0; blk < nblk; ++blk) {
      f32x4 s[2][4];
      qk_scores<4, 2, true>(kc, 64, blk * 32, qf, s, lane, qlds);
      float pq[2][4];
#pragma unroll
      for (int kt = 0; kt < 2; ++kt)
#pragma unroll
        for (int i = 0; i < 4; ++i) {
          const int n = blk * 32 + 8 * grp + 4 * kt + i;
          const bool ok = (16 * n + 31 <= t);
          float acc_p = 0.f;
#pragma unroll
          for (int ct = 0; ct < 4; ++ct) {
            const float pv = ok ? __builtin_amdgcn_exp2f(s[kt][ct][i] - msafe[ct]) * invl[ct] : 0.f;
            s[kt][ct][i] = pv;
            acc_p += pv;
          }
          pq[kt][i] = acc_p;
        }
      float* ir = imp + r * 132 + blk * 8 + 2 * grp;
      ir[0] += pq[0][0] + pq[0][1] + pq[0][2] + 0.5f * pq[0][3];
      __builtin_amdgcn_fence(__ATOMIC_SEQ_CST, "workgroup");
      __builtin_amdgcn_wave_barrier();
      ir[1] += pq[1][0] + pq[1][1] + pq[1][2] + 0.5f * pq[1][3] + 0.5f * pq[0][3];
      __builtin_amdgcn_fence(__ATOMIC_SEQ_CST, "workgroup");
      __builtin_amdgcn_wave_barrier();
      ir[2] += 0.5f * pq[1][3];
      __builtin_amdgcn_fence(__ATOMIC_SEQ_CST, "workgroup");
      __builtin_amdgcn_wave_barrier();
      pv_accum<4, 4>(vct, 512, blk * 32, s, o, lane);
    }
    f32x4 gt[4];
#pragma unroll
    for (int ct = 0; ct < 4; ++ct) gt[ct][0] = gatep[ct * 3 + 0];
#pragma unroll
    for (int dt = 0; dt < 4; ++dt) {
#pragma unroll
      for (int ct = 0; ct < 4; ++ct)
#pragma unroll
        for (int i = 0; i < 4; ++i) scr[((dt * 4 + ct) * 4 + i) * 64 + lane] = o[dt][ct][i] * gt[ct][0];
      asm volatile("" ::: "memory");
    }
  }
  const int cur = t0 >> 6;
  unsigned long long sel_lo = 0ull, sel_hi = 0ull;
  {
  NSA_SECTION_VARS
  if (cur <= 15) {
    sel_lo = (1ull << (cur + 1)) - 1ull;
  } else {
    __builtin_amdgcn_fence(__ATOMIC_SEQ_CST, "workgroup");
    __builtin_amdgcn_wave_barrier();
    float v[32];
#pragma unroll
    for (int k = 0; k < 32; ++k) {
      const int j = grp + 4 * k;
      const float x = imp[r * 132 + j];
      v[k] = (j >= 1 && j <= cur - 2) ? x : NEG_INF;
    }
#pragma unroll 1
    for (int round = 0; round < 13; ++round) {
      float best = NEG_INF;
      int bj = 1 << 20;
#pragma unroll
      for (int k = 0; k < 32; ++k) {
        const bool tk = v[k] > best;
        best = tk ? v[k] : best;
        bj = tk ? (grp + 4 * k) : bj;
      }
#pragma unroll
      for (int off = 16; off <= 32; off <<= 1) {
        const float ob = __shfl_xor(best, off);
        const int oj = __shfl_xor(bj, off);
        const bool tk = (ob > best) || (ob == best && oj < bj);
        best = tk ? ob : best;
        bj = tk ? oj : bj;
      }
      if (bj < 64) sel_lo |= 1ull << bj; else if (bj < 128) sel_hi |= 1ull << (bj - 64);
#pragma unroll
      for (int k = 0; k < 32; ++k) v[k] = (bj == grp + 4 * k) ? NEG_INF : v[k];
    }
    sel_lo |= 1ull;
    if (cur < 64) sel_lo |= 1ull << cur; else sel_hi |= 1ull << (cur - 64);
    if (cur - 1 < 64) sel_lo |= 1ull << (cur - 1); else sel_hi |= 1ull << (cur - 1 - 64);
  }
  }
  asm volatile("" : "+v"(sel_lo), "+v"(sel_hi));
  atomicOr(&misc[4], (unsigned)sel_lo); atomicOr(&misc[5], (unsigned)(sel_lo >> 32));
  atomicOr(&misc[6], (unsigned)sel_hi); atomicOr(&misc[7], (unsigned)(sel_hi >> 32));
  __syncthreads();
  unsigned long long ulo, uhi;
  {
    const unsigned u0 = __builtin_amdgcn_readfirstlane(misc[4]), u1 = __builtin_amdgcn_readfirstlane(misc[5]);
    const unsigned u2 = __builtin_amdgcn_readfirstlane(misc[6]), u3 = __builtin_amdgcn_readfirstlane(misc[7]);
    ulo = ((unsigned long long)u1 << 32) | u0; uhi = ((unsigned long long)u3 << 32) | u2;
  }
  {
    NSA_SECTION_VARS
    const int tid = (wave << 6) | lane;
    const int hq = r >> 2, qq = r & 3;
    const bf16_t* ks = WSP(bf16_t, OFF_KS) + ((size_t)b * T) * 128 + g * 64;
    const bf16_t* vst = WSP(bf16_t, OFF_VST) + (size_t)((b * 2 + g) * 64) * T;
    bf16x8 qr[4][2];
    unsigned long long mlo[4], mhi[4];
#pragma unroll
    for (int ct = 0; ct < 4; ++ct) {
      const size_t rowq = (size_t)b * T + t0 + 4 * ct + qq;
#pragma unroll
      for (int dk = 0; dk < 2; ++dk)
        qr[ct][dk] = *(const bf16x8*)(WSP(bf16_t, OFF_QN) + rowq * 512 + (g * 4 + hq) * 64 + dk * 32 + grp * 8);
      const int srcl = (lane & 48) | (4 * ct + qq);
      mlo[ct] = __shfl(sel_lo, srcl);
      mhi[ct] = __shfl(sel_hi, srcl);
      m[ct] = NEG_INF; lacc[ct] = (f32x4){0.f, 0.f, 0.f, 0.f};
    }
#pragma unroll
    for (int dt = 0; dt < 4; ++dt)
#pragma unroll
      for (int ct = 0; ct < 4; ++ct) o[dt][ct] = (f32x4){0.f, 0.f, 0.f, 0.f};
    const short one_ = (short)0x3F80;
    const bf16x8 ones = {one_, one_, one_, one_, one_, one_, one_, one_};
    TileRegs tr, trb;
    int jA = next_bit(ulo, uhi, 0), it = 0;
    int jB = next_bit(ulo, uhi, jA + 1);
    tile_gload(tr, ks, 128, vst, T, 64 * jA, tid);
    if (jB < 128) tile_gload(trb, ks, 128, vst, T, 64 * jB, tid);
    tile_swrite(tr, tiles, tid);
    if (jB < 128) tile_swrite(trb, tiles + TILE_STAGE, tid);
    __syncthreads();
#pragma unroll 1
    while (jA < 128) {
      const int nA = (jB < 128) ? next_bit(ulo, uhi, jB + 1) : 128;
      const int nB = (nA < 128) ? next_bit(ulo, uhi, nA + 1) : 128;
      if (nA < 128) tile_gload(tr, ks, 128, vst, T, 64 * nA, tid);
      if (nB < 128) tile_gload(trb, ks, 128, vst, T, 64 * nB, tid);
#pragma unroll 1
      for (int sub = 0; sub < 2; ++sub) {
      const int j = sub ? jB : jA;
      if (j >= 128) break;
      const lds_u8* stage = tiles + (2 * (it & 1) + sub) * TILE_STAGE;
      bool mine[4], need[4], anyneed = false;
#pragma unroll
      for (int ct = 0; ct < 4; ++ct) {
        mine[ct] = ((j < 64 ? (mlo[ct] >> j) : (mhi[ct] >> (j - 64))) & 1ull) != 0ull;
        need[ct] = __any(mine[ct]) != 0;
        anyneed = anyneed || need[ct];
      }
      if (anyneed) {
#pragma unroll
        for (int hf = 0; hf < 2; ++hf) {
          const int key0 = j * 64 + hf * 32;
          bf16x8 kf[2][2];
#pragma unroll
          for (int kt = 0; kt < 2; ++kt) {
            const lds_u8* kp = stage + (32 * hf + 8 * (r >> 2) + 4 * kt + (r & 3)) * TILE_ROWB + grp * 16;
#pragma unroll
            for (int dk = 0; dk < 2; ++dk) kf[kt][dk] = *(const __attribute__((address_space(3))) bf16x8*)(kp + dk * 64);
          }
          bf16x8 vfr[4];
          v_frags_lds<4>(stage, hf, vfr, lane);
#pragma unroll
          for (int ct = 0; ct < 4; ++ct) {
            if (need[ct]) {
              const float mv = mine[ct] ? 0.f : NEG_INF;
              f32x4 s0 = {mv, mv, mv, mv}, s1 = {mv, mv, mv, mv};
              s0 = mfma16(kf[0][0], qr[ct][0], s0);
              s1 = mfma16(kf[1][0], qr[ct][0], s1);
              s0 = mfma16(kf[0][1], qr[ct][1], s0);
              s1 = mfma16(kf[1][1], qr[ct][1], s1);
              if (j == cur) {
                const int tct = t0 + 4 * ct + qq;
#pragma unroll
                for (int i = 0; i < 4; ++i) {
                  s0[i] = (key0 + 8 * grp + i <= tct) ? s0[i] : NEG_INF;
                  s1[i] = (key0 + 8 * grp + 4 + i <= tct) ? s1[i] : NEG_INF;
                }
              }
              float mx = fmaxf(fmaxf(fmaxf(s0[0], s0[1]), fmaxf(s0[2], s0[3])), fmaxf(fmaxf(s1[0], s1[1]), fmaxf(s1[2], s1[3])));
              mx = grp_max4(mx);
              const float mnew = fmaxf(m[ct], mx);
              if (__any(mnew > m[ct])) {
                const float ms = (mnew == NEG_INF) ? 0.f : mnew;
                const float alpha = __builtin_amdgcn_exp2f(m[ct] - ms);
                m[ct] = mnew;
                lacc[ct] = lacc[ct] * alpha;
#pragma unroll
                for (int dt = 0; dt < 4; ++dt) o[dt][ct] = o[dt][ct] * alpha;
              }
              const float msafe = (m[ct] == NEG_INF) ? 0.f : m[ct];
              const f32x4 d0 = s0 - msafe, d1 = s1 - msafe;
              f32x4 p0, p1;
#pragma unroll
              for (int i = 0; i < 4; ++i) { p0[i] = __builtin_amdgcn_exp2f(d0[i]); p1[i] = __builtin_amdgcn_exp2f(d1[i]); }
              const bf16x8 pb = pack8(p0, p1);
              lacc[ct] = mfma16(ones, pb, lacc[ct]);
#pragma unroll
              for (int dt = 0; dt < 4; ++dt) o[dt][ct] = mfma16(vfr[dt], pb, o[dt][ct]);
            }
          }
        }
      }
      }
      if (nA < 128) tile_swrite(tr, tiles + (2 * ((it + 1) & 1)) * TILE_STAGE, tid);
      if (nB < 128) tile_swrite(trb, tiles + (2 * ((it + 1) & 1) + 1) * TILE_STAGE, tid);
      __syncthreads();
      jA = nA; jB = nB; ++it;
    }
    float* scr2 = scr + (size_t)2048 * 4096;
#pragma unroll
    for (int ct = 0; ct < 4; ++ct) {
      const size_t rowq = (size_t)b * T + t0 + 4 * ct + qq;
      const float sc = (lacc[ct][0] > 0.f ? 1.0f / lacc[ct][0] : 0.f) * WSP(float, OFF_GATE)[rowq * 24 + (g * 4 + hq) * 3 + 1];
#pragma unroll
      for (int dt = 0; dt < 4; ++dt)
        *(f32x4*)(scr2 + (hq * 16 + 4 * ct + qq) * 64 + 16 * dt + 4 * grp) = o[dt][ct] * sc;
    }
    asm volatile("s_waitcnt vmcnt(0)" ::: "memory");
    __builtin_amdgcn_fence(__ATOMIC_SEQ_CST, "workgroup");
  }
  {
    NSA_SECTION_VARS
    const int tid = (wave << 6) | lane;
    const bf16_t* kw = WSP(bf16_t, OFF_KW) + ((size_t)b * T) * 128 + g * 64;
    const bf16_t* vwt = WSP(bf16_t, OFF_VWT) + (size_t)((b * 2 + g) * 64) * T;
#pragma unroll
    for (int ct = 0; ct < 4; ++ct) { m[ct] = NEG_INF; lsum[ct] = 0.f; lacc[ct] = (f32x4){0.f, 0.f, 0.f, 0.f}; }
#pragma unroll
    for (int dt = 0; dt < 4; ++dt)
#pragma unroll
      for (int ct = 0; ct < 4; ++ct) o[dt][ct] = (f32x4){0.f, 0.f, 0.f, 0.f};
    int kstart = qi * 128 - 512;
    if (kstart < 0) kstart = 0;
    const int kend = qi * 128 + 64;
    bf16x8 qr[4][2];
#pragma unroll
    for (int ct = 0; ct < 4; ++ct)
#pragma unroll
      for (int dk = 0; dk < 2; ++dk)
        qr[ct][dk] = *(const bf16x8*)(WSP(bf16_t, OFF_QN) + row * 512 + (g * 4 + ct) * 64 + dk * 32 + grp * 8);
    TileRegs tr;
    int it = 0;
    tile_gload(tr, kw, 128, vwt, T, kstart, tid);
    tile_swrite(tr, tiles, tid);
    __syncthreads();
#pragma unroll 1
    for (int k0 = kstart; k0 <= kend; k0 += 64, ++it) {
      if (k0 + 64 <= kend) tile_gload(tr, kw, 128, vwt, T, k0 + 64, tid);
      const lds_u8* stage = tiles + (it & 1) * TILE_STAGE;
      if (k0 <= t0 + 15 && k0 + 63 + 512 > t0) {
#pragma unroll
        for (int hf = 0; hf < 2; ++hf) {
          const int key0 = k0 + hf * 32;
          f32x4 s[2][4];
          const f32x4 cz = {0.f, 0.f, 0.f, 0.f};
          qk_scores_lds<4, 2, false>(stage, hf, qr, s, lane, nullptr, cz, cz);
          if (!(k0 + 63 <= t0 && k0 + 512 > t0 + 15)) {
#pragma unroll
            for (int kt = 0; kt < 2; ++kt)
#pragma unroll
              for (int i = 0; i < 4; ++i) {
                const int key = key0 + 8 * grp + 4 * kt + i;
                const bool ok = (key <= t) && (key + 512 > t);
#pragma unroll
                for (int ct = 0; ct < 4; ++ct) s[kt][ct][i] = ok ? s[kt][ct][i] : NEG_INF;
              }
          }
          bf16x8 vfr[4];
          v_frags_lds<4>(stage, hf, vfr, lane);
          softmax_update<4, 4, true, false>(s, m, lsum, o, &lacc);
          pv_accum_lds<4, 4>(vfr, s, o, lane, lacc);
        }
      }
      if (k0 + 64 <= kend) tile_swrite(tr, tiles + ((it + 1) & 1) * TILE_STAGE, tid);
      __syncthreads();
    }
    float sc2[4];
#pragma unroll
    for (int ct = 0; ct < 4; ++ct) sc2[ct] = (lacc[ct][0] > 0.f ? 1.0f / lacc[ct][0] : 0.f) * gatep[ct * 3 + 2];
    bf16_t* oa = WSP(bf16_t, OFF_OA) + row * 512 + g * 256;
#pragma unroll
    for (int dt = 0; dt < 4; ++dt)
#pragma unroll
      for (int ct = 0; ct < 4; ++ct) {
        bf16_t* ptr = oa + ct * 64 + 16 * dt + 4 * grp;
        const u32x2 sw = *(const u32x2*)ptr;
        float val[4];
        const f32x4 sv = *(const f32x4*)(scr + (size_t)2048 * 4096 + (ct * 16 + r) * 64 + 16 * dt + 4 * grp);
#pragma unroll
        for (int i = 0; i < 4; ++i) val[i] = scr[((dt * 4 + ct) * 4 + i) * 64 + lane] + sv[i] + o[dt][ct][i] * sc2[ct];
        u32x2 w = {cvtpk(val[0] * bflo(sw[0]), val[1] * bfhi(sw[0])), cvtpk(val[2] * bflo(sw[1]), val[3] * bfhi(sw[1]))};
        if (st) *(u32x2*)ptr = w;
        asm volatile("" ::: "memory");
      }
  }
#undef NSA_SECTION_VARS
}

__device__ __forceinline__ void fox_wg_unit(const Params& p, int l, int b, int h, int qb, lds_u8* tiles, bool st) {
  kparams_t kp_ = kparams(); (void)kp_;
  const int tid = tidx();
  const int wave = __builtin_amdgcn_readfirstlane(tid >> 6);
  const int lane = tid & 63, r = lane & 15, grp = lane >> 4;
  const int t0 = qb * 512 + wave * 64;
  bf16x8 qf[4][2];
  const float* fc = WSP(float, OFF_FC) + (size_t)(b * 8 + h) * T;
#pragma unroll
  for (int ct = 0; ct < 4; ++ct) {
    const size_t row = (size_t)b * T + t0 + 16 * ct + r;
#pragma unroll
    for (int dk = 0; dk < 2; ++dk)
      qf[ct][dk] = *(const bf16x8*)(WSP(bf16_t, OFF_FQ) + row * 512 + h * 64 + dk * 32 + grp * 8);
  }
  const bf16_t* kb = WSP(bf16_t, OFF_FK) + ((size_t)b * T) * 512 + h * 64;
  const bf16_t* vt = WSP(bf16_t, OFF_FVT) + (size_t)((b * 8 + h) * 64) * T;
  f32x4 o[4][4];
  float m[4], lsum[4];
  f32x4 lacc[4];
#pragma unroll
  for (int ct = 0; ct < 4; ++ct) { m[ct] = NEG_INF; lsum[ct] = 0.f; lacc[ct] = (f32x4){0.f, 0.f, 0.f, 0.f}; }
#pragma unroll
  for (int dt = 0; dt < 4; ++dt)
#pragma unroll
    for (int ct = 0; ct < 4; ++ct) o[dt][ct] = (f32x4){0.f, 0.f, 0.f, 0.f};
  const int ntiles = (qb + 1) * 8;
  int it0, itw0;
  {
    float gq = fabsf(kp_->fox_q_norm[l * 64 + lane]), gk = fabsf(kp_->fox_k_norm[l * 64 + lane]);
#pragma unroll
    for (int o_ = 1; o_ < 64; o_ <<= 1) { gq = fmaxf(gq, __shfl_xor(gq, o_)); gk = fmaxf(gk, __shfl_xor(gk, o_)); }
    const float B2 = 16.0f * gq * gk * 1.02f + 104.0f;
    const float thr_wg = fc[qb * 512] + B2, thr_w = fc[t0] + B2;
    const float c0 = (lane < ntiles) ? fc[64 * lane + 63] : -3.0e38f;
    const float c1 = (lane + 64 < ntiles) ? fc[64 * (lane + 64) + 63] : -3.0e38f;
    it0 = __popcll(__ballot(c0 > thr_wg)) + __popcll(__ballot(c1 > thr_wg));
    itw0 = __popcll(__ballot(c0 > thr_w)) + __popcll(__ballot(c1 > thr_w));
    it0 = __builtin_amdgcn_readfirstlane(it0);
    itw0 = __builtin_amdgcn_readfirstlane(itw0);
  }
  TileRegs tr;
  float ckr = 0.f;
  tile_gload(tr, kb, 512, vt, T, it0 * 64, tid);
  if (tid < 64) ckr = fc[it0 * 64 + tid] * (-LOG2E);
  tile_swrite(tr, tiles, tid);
  if (tid < 64) *(__attribute__((address_space(3))) float*)(tiles + 2 * TILE_HALF + tid * 4) = ckr;
  __syncthreads();
#pragma unroll 1
  for (int it = it0; it < ntiles; ++it) {
    const int k0 = it * 64;
    if (it + 1 < ntiles) { tile_gload(tr, kb, 512, vt, T, k0 + 64, tid); if (tid < 64) ckr = fc[k0 + 64 + tid] * (-LOG2E); }
    const lds_u8* stage = tiles + ((it - it0) & 1) * TILE_STAGE;
    if (k0 <= t0 + 63 && it >= itw0) {
      const bool diag = (k0 + 63 > t0);
#pragma unroll
      for (int hf = 0; hf < 2; ++hf) {
        const int key0 = k0 + hf * 32;
        f32x4 s[2][4];
        const f32x4 ck0 = *(const __attribute__((address_space(3))) f32x4*)(stage + 2 * TILE_HALF + (32 * hf + 8 * grp) * 4);
        const f32x4 ck1 = *(const __attribute__((address_space(3))) f32x4*)(stage + 2 * TILE_HALF + (32 * hf + 8 * grp + 4) * 4);
        qk_scores_lds<4, 2, false>(stage, hf, qf, s, lane, nullptr, ck0, ck1);
        if (diag) {
#pragma unroll
          for (int kt = 0; kt < 2; ++kt)
#pragma unroll
            for (int i = 0; i < 4; ++i) {
              const int key = key0 + 8 * grp + 4 * kt + i;
#pragma unroll
              for (int ct = 0; ct < 4; ++ct) s[kt][ct][i] = (key <= t0 + 16 * ct + r) ? s[kt][ct][i] : NEG_INF;
            }
        }
        bf16x8 vfr[4];
        v_frags_lds<4>(stage, hf, vfr, lane);
        softmax_update<4, 4, true, false>(s, m, lsum, o, &lacc);
        pv_accum_lds<4, 4>(vfr, s, o, lane, lacc);
      }
    }
    if (it + 1 < ntiles) {
      tile_swrite(tr, tiles + ((it - it0 + 1) & 1) * TILE_STAGE, tid);
      if (tid < 64) *(__attribute__((address_space(3))) float*)(tiles + ((it - it0 + 1) & 1) * TILE_STAGE + 2 * TILE_HALF + tid * 4) = ckr;
    }
    __syncthreads();
  }
  float invl[4];
#pragma unroll
  for (int ct = 0; ct < 4; ++ct) invl[ct] = lacc[ct][0] > 0.f ? 1.0f / lacc[ct][0] : 0.f;
#pragma unroll
  for (int ct = 0; ct < 4; ++ct) {
    bf16_t* ob = WSP(bf16_t, OFF_OB) + ((size_t)b * T + t0 + 16 * ct + r) * 512 + h * 64;
#pragma unroll
    for (int dt = 0; dt < 4; ++dt) {
      bf16_t* ptr = ob + 16 * dt + 4 * grp;
      const u32x2 sw = *(const u32x2*)ptr;
      const f32x4 v = o[dt][ct] * invl[ct];
      u32x2 w = {cvtpk(v[0] * bflo(sw[0]), v[1] * bfhi(sw[0])), cvtpk(v[2] * bflo(sw[1]), v[3] * bfhi(sw[1]))};
      if (st) *(u32x2*)ptr = w;
    }
  }
}

__device__ __forceinline__ void mem_unit(const Params& p, int l, int b, int h, int t0, bool st) {
  kparams_t kp_ = kparams(); (void)kp_;
  const int lane = tidx() & 63, r = lane & 15, grp = lane >> 4;
  const float SC = 0.08838834764831845f * LOG2E;
  bf16x8 qf[2][4];
  const float* gq = kp_->mem_q_norm + l * 128;
#pragma unroll
  for (int ct = 0; ct < 2; ++ct) {
    const size_t row = (size_t)b * T + t0 + 16 * ct + r;
    float v[4][8];
    float ss = 0.f;
#pragma unroll
    for (int dk = 0; dk < 4; ++dk) {
      const u32x4 w = *(const u32x4*)(WSP(bf16_t, OFF_MQ) + row * 512 + h * 128 + dk * 32 + grp * 8);
#pragma unroll
      for (int j = 0; j < 4; ++j) { v[dk][2 * j] = bflo(w[j]); v[dk][2 * j + 1] = bfhi(w[j]); }
#pragma unroll
      for (int j = 0; j < 8; ++j) ss += v[dk][j] * v[dk][j];
    }
    ss += __shfl_xor(ss, 16);
    ss += __shfl_xor(ss, 32);
    const float rstd = rsqrtf(ss * (1.0f / 128.0f) + EPS);
#pragma unroll
    for (int dk = 0; dk < 4; ++dk) {
      const f32x4 g0 = *(const f32x4*)(gq + dk * 32 + grp * 8), g1 = *(const f32x4*)(gq + dk * 32 + grp * 8 + 4);
      u32x4 w = {cvtpk(v[dk][0] * rstd * g0[0], v[dk][1] * rstd * g0[1]), cvtpk(v[dk][2] * rstd * g0[2], v[dk][3] * rstd * g0[3]),
                 cvtpk(v[dk][4] * rstd * g1[0], v[dk][5] * rstd * g1[1]), cvtpk(v[dk][6] * rstd * g1[2], v[dk][7] * rstd * g1[3])};
      qf[ct][dk] = __builtin_bit_cast(bf16x8, w);
    }
  }
  const bf16_t* kb = WSP(bf16_t, OFF_MK) + ((size_t)b * 256) * 512 + h * 128;
  const bf16_t* vt = WSP(bf16_t, OFF_MVT) + (size_t)((b * 4 + h) * 128) * 256;
  f32x4 o[8][2];
  float m[2], lsum[2];
#pragma unroll
  for (int ct = 0; ct < 2; ++ct) { m[ct] = NEG_INF; lsum[ct] = 0.f; }
#pragma unroll
  for (int dt = 0; dt < 8; ++dt)
#pragma unroll
    for (int ct = 0; ct < 2; ++ct) o[dt][ct] = (f32x4){0.f, 0.f, 0.f, 0.f};
#pragma unroll 1
  for (int key0 = 0; key0 < 256; key0 += 32) {
    f32x4 s[2][2];
    qk_scores<2, 4>(kb, 512, key0, qf, s, lane);
#pragma unroll
    for (int kt = 0; kt < 2; ++kt)
#pragma unroll
      for (int ct = 0; ct < 2; ++ct) s[kt][ct] = s[kt][ct] * SC;
    softmax_update<2, 8, true>(s, m, lsum, o);
    pv_accum<2, 8>(vt, 256, key0, s, o, lane);
  }
#pragma unroll
  for (int ct = 0; ct < 2; ++ct) {
    const float invl = finish_l(lsum[ct]);
    bf16_t* om = WSP(bf16_t, OFF_OM) + ((size_t)b * T + t0 + 16 * ct + r) * 512 + h * 128;
#pragma unroll
    for (int dt = 0; dt < 8; ++dt) {
      bf16_t* ptr = om + 16 * dt + 4 * grp;
      const u32x2 sw = *(const u32x2*)ptr;
      const f32x4 v = o[dt][ct] * invl;
      u32x2 w = {cvtpk(v[0] * bflo(sw[0]), v[1] * bfhi(sw[0])), cvtpk(v[2] * bflo(sw[1]), v[3] * bfhi(sw[1]))};
      if (st) *(u32x2*)ptr = w;
    }
  }
}

__device__ __forceinline__ void phase_attn(const Params& p, int l, unsigned char* ldsraw, bool st, int cidx) {
  kparams_t kp_ = kparams(); (void)kp_;
  const int tid = tidx();
  const int wave = __builtin_amdgcn_readfirstlane(tid >> 6);
  float* imp = (float*)ldsraw + wave * 2112;
  lds_u8* tiles = (lds_u8*)ldsraw;
  bf16x8* qlds = (bf16x8*)(ldsraw + 69632 + wave * 8192);
  unsigned* misc = (unsigned*)(ldsraw + 135168);
  float* scr = WSP(float, OFF_SCR) + (size_t)(bidx() * NWAVES + wave) * 4096;
  const int myx = (int)(xb_xcc_id() & 7u);
  constexpr int QUNITS = 192;
  for (int qq = 0; qq < 8; ++qq) {
    const int x = (myx + qq) & 7;
    unsigned* ctr = WSP(unsigned, OFF_CTL) + cidx * 8 + x;
    for (;;) {
      __syncthreads();
      if (tid == 0) misc[0] = atomicAdd(ctr, 1u);
      if (tid >= 4 && tid < 8) misc[tid] = 0u;
      __syncthreads();
      const int u = __builtin_amdgcn_readfirstlane((int)misc[0]);
      if (u >= QUNITS) break;
      if (u < 64) {
        nsa_wg_unit(p, x >> 1, x & 1, 63 - u, imp, qlds, scr, tiles, misc, st);
      } else if (u < 128) {
        const int v_ = u - 64, bh = 4 * x + (v_ >> 4);
        fox_wg_unit(p, l, bh >> 3, bh & 7, 15 - (v_ & 15), tiles, st);
      } else {
        const int mu = u - 128, bh = 2 * x + (mu >> 5), qblk = mu & 31;
        mem_unit(p, l, bh >> 2, bh & 3, 256 * qblk + 32 * wave, st);
      }
    }
  }
}

__global__ void __launch_bounds__(NTHREADS) hybrid_megakernel(Params p) {
  kparams_t kp_ = kparams();
  cg::grid_group grid = cg::this_grid();
  extern __shared__ __attribute__((aligned(16))) unsigned char dynlds[];
  float* smem = (float*)dynlds;
  PG8_LAS unsigned char* glds = (PG8_LAS unsigned char*)dynlds;
  volatile LAS unsigned* bst = (volatile LAS unsigned*)(glds + 135168 + 64);
  if (threadIdx.x < 2) bst[threadIdx.x] = 0u;
  __syncthreads();
  grid.sync();
  const XcdBarrier xbar = xcd_barrier_post(WSP(unsigned, OFF_BAR), bst);
  unsigned long long pr_acc = 0ull, pr_t0 = 0ull;
#pragma unroll 1
  for (int ph = 0; ph < 28; ++ph) {
    const int l = ph / 7, k = ph - 7 * l;
    if (PROBE_PHASE >= 0 && k == PROBE_PHASE) pr_t0 = __builtin_amdgcn_s_memrealtime();
    if (k == 0) {
      phase_prep(p, l, smem);
    } else if (k == 1) {
      if (bidx() == gdim() - 1 && tidx() < 256) {
        const int t_ = tidx();
        const float* part = WSP(float, OFF_C1) + (size_t)(t_ >> 7) * 16 * 128 + (t_ & 127);
        float s_ = 0.f;
        for (int ch = 0; ch < 16; ++ch) s_ += part[ch * 128];
        WSP(float, OFF_C1 + 16384)[t_] = s_;
      }
      EpiIn E{&p, l};
      for (int rp = 0; rp < (PROBE_GEMM2 ? (kp_->ws != nullptr ? 2 : 1) : 1); ++rp)
        run_gemm(glds, WSP(bf16_t, OFF_H), WSP(bf16_t, OFF_W_IN), M, 5120, 1024, E);
      EpiMemKV E2{&p};
      run_gemm(glds, WSP(bf16_t, OFF_MEMN), WSP(bf16_t, OFF_W_MKV), 1024, 1024, 1024, E2);
    } else if (k == 2) {
      phase_mid(p, l, smem);
    } else if (k == 3) {
      const int nrep = PROBE_ATTN2 ? (kp_->ws != nullptr ? 2 : 1) : 1;
      for (int rp = 0; rp < nrep; ++rp) {
        const bool last = (rp == nrep - 1);
        if (rp) xcd_barrier(xbar);
        phase_attn(p, l, dynlds, last, last ? l : 4 + l);
      }
    } else if (k == 4) {
      EpiGate E{WSP(bf16_t, OFF_G)};
      for (int rp = 0; rp < (PROBE_GEMM2 ? (kp_->ws != nullptr ? 2 : 1) : 1); ++rp)
        run_gemm(glds, WSP(bf16_t, OFF_H), WSP(bf16_t, OFF_W_G), M, 3072, 1024, E);
    } else if (k == 5) {
      for (int rp = 0; rp < (PROBE_BR2 ? (kp_->ws != nullptr ? 2 : 1) : 1); ++rp) {
      EpiBranch Ea{WSP(bf16_t, OFF_G), WSP(bf16_t, OFF_U), 1};
      run_gemm(glds, WSP(bf16_t, OFF_OA), WSP(bf16_t, OFF_W_BR), M, 1024, 512, Ea);
      EpiBranch Eb{WSP(bf16_t, OFF_G) + (size_t)M * 1024, WSP(bf16_t, OFF_U), 0};
      run_gemm(glds, WSP(bf16_t, OFF_OB), WSP(bf16_t, OFF_W_BR + MiB), M, 1024, 512, Eb);
      EpiBranch Ec{WSP(bf16_t, OFF_G) + (size_t)2 * M * 1024, WSP(bf16_t, OFF_U), 0};
      run_gemm(glds, WSP(bf16_t, OFF_OM), WSP(bf16_t, OFF_W_BR + 2 * MiB), M, 1024, 512, Ec);
      }
    } else {
      EpiOut E{l == 0 ? kp_->x : kp_->out, kp_->out};
      run_gemm(glds, WSP(bf16_t, OFF_U), WSP(bf16_t, OFF_W_OUT), M, 1024, 1024, E);
    }
    xcd_barrier(xbar);
    if (PROBE_PHASE >= 0 && k == PROBE_PHASE) pr_acc += __builtin_amdgcn_s_memrealtime() - pr_t0;
  }
  if (PROBE_PHASE >= 0 && blockIdx.x == 0) {
    const unsigned long long ts = __builtin_amdgcn_s_memrealtime();
    while (__builtin_amdgcn_s_memrealtime() - ts < pr_acc) __builtin_amdgcn_s_sleep(8);
  }
}

extern "C" void kernel_launch(void* const* d_in, const int* in_sizes, int n_in, void* d_out, int out_size, void* d_ws,
                              size_t ws_size, hipStream_t stream) {
  static int grid_blocks = 0;
  if (!grid_blocks) {
    int dev = 0, cus = 0, per_cu = 0;
    (void)hipGetDevice(&dev);
    (void)hipDeviceGetAttribute(&cus, hipDeviceAttributeMultiprocessorCount, dev);
    if (hipFuncSetAttribute((const void*)hybrid_megakernel, hipFuncAttributeMaxDynamicSharedMemorySize, LDS_BYTES) != hipSuccess)
      fprintf(stderr, "hipFuncSetAttribute(dynamic LDS %d) failed\n", LDS_BYTES);
    (void)hipOccupancyMaxActiveBlocksPerMultiprocessor(&per_cu, hybrid_megakernel, NTHREADS, LDS_BYTES);
    (void)hipGetLastError();
    grid_blocks = cus;
    if (grid_blocks > 256) grid_blocks = 256;
    if (ws_size < OFF_SCR + (size_t)64 * MiB) fprintf(stderr, "workspace too small: %zu\n", ws_size);
  }
  Params p{};
  const float** pp = (const float**)&p;
  for (int i = 0; i < 23; ++i) pp[i] = (const float*)d_in[i];
  p.out = (float*)d_out;
  p.ws = (char*)d_ws;
  void* args[] = {&p};
  (void)hipMemsetAsync((char*)d_ws + OFF_BAR, 0, XCD_BAR_WORDS * sizeof(unsigned), stream);
  hipError_t e = hipLaunchCooperativeKernel((void*)hybrid_megakernel, dim3(grid_blocks), dim3(NTHREADS), args, LDS_BYTES, stream);
  if (e != hipSuccess) fprintf(stderr, "cooperative launch failed: %s (grid %d)\n", hipGetErrorString(e), grid_blocks);
}
```

```cpp
#include <hip/hip_runtime.h>
#include <hip/hip_cooperative_groups.h>
#include <stdint.h>
#include <cstdio>
namespace cg = cooperative_groups;
#ifndef PROBE_ATTN2
#define PROBE_ATTN2 0
#endif
#ifndef PROBE_PM2
#define PROBE_PM2 0
#endif
#ifndef PROBE_PHASE
#define PROBE_PHASE -1
#endif
#ifndef PROBE_BR2
#define PROBE_BR2 0
#endif
#ifndef PROBE_GEMM2
#define PROBE_GEMM2 0
#endif


typedef unsigned short bf16_t;
typedef short bf16x8 __attribute__((ext_vector_type(8)));
typedef float f32x4 __attribute__((ext_vector_type(4)));
typedef unsigned u32x2 __attribute__((ext_vector_type(2)));
typedef unsigned u32x4 __attribute__((ext_vector_type(4)));
typedef float f32x2_t __attribute__((ext_vector_type(2)));
typedef __bf16 bf16x2_t __attribute__((ext_vector_type(2)));

constexpr int NB = 4, T = 8192, M = NB * T;
constexpr int NTHREADS = 512, NWAVES = NTHREADS / 64;
constexpr int LDS_BYTES = 147456;
constexpr float EPS = 1e-6f;
constexpr float LOG2E = 1.4426950408889634f;
#define NEG_INF (-__builtin_inff())

constexpr size_t MiB = 1u << 20;
constexpr size_t OFF_CTL = 0;
constexpr size_t OFF_BAR = 64 * 1024;
constexpr size_t OFF_ROPE = 1 * MiB;
constexpr size_t OFF_W_IN = 3 * MiB;
constexpr size_t OFF_W_G = 13 * MiB;
constexpr size_t OFF_W_MKV = 19 * MiB;
constexpr size_t OFF_W_BR = 21 * MiB;
constexpr size_t OFF_W_OUT = 24 * MiB;
constexpr size_t OFF_W1 = 26 * MiB;
constexpr size_t OFF_W2 = 27 * MiB;
constexpr size_t OFF_C1 = 27 * MiB + 256 * 1024;
constexpr size_t OFF_MEMN = 28 * MiB;
constexpr size_t OFF_MK = 30 * MiB;
constexpr size_t OFF_MVT = 31 * MiB;
constexpr size_t OFF_H = 32 * MiB;
constexpr size_t OFF_U = OFF_H;
constexpr size_t OFF_OA = 96 * MiB;
constexpr size_t OFF_OB = 128 * MiB;
constexpr size_t OFF_OM = 160 * MiB;
constexpr size_t OFF_QN = 192 * MiB;
constexpr size_t OFF_G = 192 * MiB;
constexpr size_t OFF_KC = 224 * MiB;
constexpr size_t OFF_VC = 232 * MiB;
constexpr size_t OFF_KS = 240 * MiB;
constexpr size_t OFF_VST = 248 * MiB;
constexpr size_t OFF_KW = 256 * MiB;
constexpr size_t OFF_VWT = 264 * MiB;
constexpr size_t OFF_FQ = 272 * MiB;
constexpr size_t OFF_FK = 304 * MiB;
constexpr size_t OFF_FVT = 336 * MiB;
constexpr size_t OFF_MQ = 368 * MiB;
constexpr size_t OFF_GATE = 400 * MiB;
constexpr size_t OFF_FLOG = 403 * MiB;
constexpr size_t OFF_FC = 404 * MiB;
constexpr size_t OFF_KCMP = 405 * MiB;
constexpr size_t OFF_VCT = 405 * MiB + 512 * 1024;
constexpr size_t OFF_SCR = 406 * MiB;

struct Params {
  const float *x, *mem, *norm_g, *mem_norm_g, *w_in, *nsa_q_norm, *nsa_k_norm, *cmp_pe_k, *cmp_w1_k, *cmp_w2_k,
      *cmp_pe_v, *cmp_w1_v, *cmp_w2_v, *fox_q_norm, *fox_k_norm, *fox_f_bias, *mem_q_norm, *mem_k_norm, *w_mem_kv,
      *w_branch_a, *w_branch_b, *w_branch_m, *w_out;
  float* out;
  char* ws;
};
__device__ __forceinline__ char* ws_base(char* w) {
  unsigned lo = __builtin_amdgcn_readfirstlane((unsigned)(uintptr_t)w), hi = __builtin_amdgcn_readfirstlane((unsigned)((uintptr_t)w >> 32));
  asm volatile("" : "+s"(lo), "+s"(hi));
  return (char*)(__attribute__((address_space(1))) char*)(((uintptr_t)hi << 32) | (uintptr_t)lo);
}
typedef const __attribute__((address_space(4))) Params* kparams_t;
__device__ __forceinline__ kparams_t kparams() { kparams_t kp = (kparams_t)__builtin_amdgcn_kernarg_segment_ptr(); asm volatile("" : "+s"(kp)); return kp; }
#define WSP(TYPE, off) ((TYPE*)(ws_base(kp_->ws) + (off)))

__constant__ float c_inv_freq[32] = {
    1.000000000e+00f, 7.498942018e-01f, 5.623413324e-01f, 4.216965139e-01f, 3.162277639e-01f, 2.371373773e-01f,
    1.778279394e-01f, 1.333521456e-01f, 1.000000015e-01f, 7.498942316e-02f, 5.623413250e-02f, 4.216964915e-02f,
    3.162277490e-02f, 2.371373773e-02f, 1.778279431e-02f, 1.333521400e-02f, 9.999999776e-03f, 7.498942316e-03f,
    5.623413250e-03f, 4.216964822e-03f, 3.162277630e-03f, 2.371373819e-03f, 1.778279431e-03f, 1.333521446e-03f,
    1.000000047e-03f, 7.498941850e-04f, 5.623413017e-04f, 4.216965172e-04f, 3.162277571e-04f, 2.371373703e-04f,
    1.778279402e-04f, 1.333521504e-04f};

__device__ __forceinline__ int bidx() { int b = blockIdx.x; asm volatile("" : "+s"(b)); return b; }
__device__ __forceinline__ int gdim() { int g = gridDim.x; asm volatile("" : "+s"(g)); return g; }
__device__ __forceinline__ int tidx() { int t = threadIdx.x; asm volatile("" : "+v"(t)); return t; }
__device__ __forceinline__ unsigned cvtpk(float lo, float hi) {
  f32x2_t v = {lo, hi};
  bf16x2_t b = __builtin_convertvector(v, bf16x2_t);
  return __builtin_bit_cast(unsigned, b);
}
__device__ __forceinline__ float bf2f(unsigned short v) { return __uint_as_float(((unsigned)v) << 16); }
__device__ __forceinline__ float bflo(unsigned w) { return __uint_as_float(w << 16); }
__device__ __forceinline__ float bfhi(unsigned w) { return __uint_as_float(w & 0xffff0000u); }
__device__ __forceinline__ f32x4 mfma16(bf16x8 a, bf16x8 b, f32x4 c) {
  return __builtin_amdgcn_mfma_f32_16x16x32_bf16(a, b, c, 0, 0, 0);
}
__device__ __forceinline__ bf16x8 pack8(f32x4 a, f32x4 b) {
  u32x4 w = {cvtpk(a[0], a[1]), cvtpk(a[2], a[3]), cvtpk(b[0], b[1]), cvtpk(b[2], b[3])};
  return __builtin_bit_cast(bf16x8, w);
}
__device__ __forceinline__ float sigmoidf_(float v) { return __builtin_amdgcn_rcpf(1.0f + __builtin_amdgcn_exp2f(-LOG2E * v)); }
__device__ __forceinline__ float siluf_(float v) { return v * __builtin_amdgcn_rcpf(1.0f + __builtin_amdgcn_exp2f(-LOG2E * v)); }
__device__ __forceinline__ float grp_max4(float v) {
  auto a = __builtin_amdgcn_permlane32_swap(__float_as_uint(v), __float_as_uint(v), false, false);
  v = fmaxf(__uint_as_float(a[0]), __uint_as_float(a[1]));
  auto b = __builtin_amdgcn_permlane16_swap(__float_as_uint(v), __float_as_uint(v), false, false);
  return fmaxf(__uint_as_float(b[0]), __uint_as_float(b[1]));
}
__device__ __forceinline__ float wave_sum(float v) {
#pragma unroll
  for (int o = 1; o < 64; o <<= 1) v += __shfl_xor(v, o);
  return v;
}

#define LAS __attribute__((address_space(3)))
#define XB_TMO      128
#define XB_XCNT(j)  (256  + 64 * (j))
#define XB_XSUB(j)  (1280 + 64 * (j))
#define XB_XGEN(j)  (2304 + 64 * (j))
#define XB_TOP      3328
#define XB_TOPGEN   3392
#define XCD_BAR_WORDS 3456
#define XB_SPIN_CAP (1u << 18)

__device__ __forceinline__ unsigned xb_ld(unsigned* p)              { return __hip_atomic_load(p, __ATOMIC_RELAXED, __HIP_MEMORY_SCOPE_AGENT); }
__device__ __forceinline__ unsigned xb_add(unsigned* p, unsigned v) { return __hip_atomic_fetch_add(p, v, __ATOMIC_RELAXED, __HIP_MEMORY_SCOPE_AGENT); }
__device__ __forceinline__ unsigned xb_xcc_id() { return (unsigned)__builtin_amdgcn_s_getreg((3 << 11) | 20) & 0xFu; }
#define XB_SPIN(cond, bar) do { unsigned _sp = 0; while (cond) { __builtin_amdgcn_s_sleep(1); \
    if ((++_sp & 255u) == 0u) { if (xb_ld(&(bar)[XB_TMO])) break; if (_sp > XB_SPIN_CAP) { atomicAdd(&(bar)[XB_TMO], 1u); break; } } } } while (0)

struct XcdBarrier {
    unsigned* bar; unsigned x;
    volatile LAS unsigned* st;
};

__device__ __forceinline__ XcdBarrier xcd_barrier_post(unsigned* bar, volatile LAS unsigned* st) {
    XcdBarrier b; b.bar = bar; b.x = xb_xcc_id(); b.st = st;
    if (threadIdx.x == 0) (void)xb_add(&bar[XB_XCNT(b.x)], 1u);
    return b;
}
__device__ __forceinline__ void xcd_barrier_complete(unsigned* bar, unsigned x, unsigned& nloc, unsigned& nx) {
    const unsigned G = gridDim.x * gridDim.y * gridDim.z;
    unsigned sum, cnt, mine, sp = 0u;
    for (;;) {
        sum = 0u; cnt = 0u; mine = 0u;
#pragma unroll
        for (unsigned j = 0; j < 16; ++j) { const unsigned c = xb_ld(&bar[XB_XCNT(j)]); sum += c; cnt += (c > 0u) ? 1u : 0u; mine = (j == x) ? c : mine; }
        if (sum == G) break;
        __builtin_amdgcn_s_sleep(1);
        if ((++sp & 255u) == 0u) { if (xb_ld(&bar[XB_TMO])) break; if (sp > XB_SPIN_CAP) { atomicAdd(&bar[XB_TMO], 1u); break; } }
    }
    nloc = mine > 0u ? mine : 1u; nx = cnt > 0u ? cnt : 1u;
}

__device__ __forceinline__ void xcd_barrier(const XcdBarrier& b) {
    asm volatile("s_waitcnt vmcnt(0)" ::: "memory");
    __syncthreads();
    if (threadIdx.x == 0) {
        unsigned* bar = b.bar;
        __builtin_amdgcn_s_waitcnt(0);
        unsigned nloc = b.st[0], nx = b.st[1];
        if (nloc == 0u) { xcd_barrier_complete(bar, b.x, nloc, nx); b.st[0] = nloc; b.st[1] = nx; }
        const unsigned old = xb_add(&bar[XB_XSUB(b.x)], 1u);
        const unsigned gen = old / nloc;
        if (old + 1u == (gen + 1u) * nloc) {
            __builtin_amdgcn_fence(__ATOMIC_RELEASE, "agent");
            asm volatile("s_waitcnt vmcnt(0)" ::: "memory");
            const unsigned og = xb_add(&bar[XB_TOP], 1u);
            const unsigned tg = og / nx;
            if (og + 1u == (tg + 1u) * nx) xb_add(&bar[XB_TOPGEN], 1u);
            else XB_SPIN(xb_ld(&bar[XB_TOPGEN]) == tg, bar);
            __builtin_amdgcn_fence(__ATOMIC_ACQUIRE, "agent");
            xb_add(&bar[XB_XGEN(b.x)], 1u);
            asm volatile("s_waitcnt vmcnt(0)" ::: "memory");
        } else {
            XB_SPIN(xb_ld(&bar[XB_XGEN(b.x)]) == gen, bar);
            __builtin_amdgcn_fence(__ATOMIC_ACQUIRE, "agent");
            asm volatile("s_waitcnt vmcnt(0)" ::: "memory");
        }
    }
    __syncthreads();
}


namespace pg8 {
#define PG8_LAS __attribute__((address_space(3)))
typedef unsigned short bf16_t;
typedef short bf16x8 __attribute__((ext_vector_type(8)));
typedef float f32x4 __attribute__((ext_vector_type(4)));
typedef unsigned u32x4 __attribute__((ext_vector_type(4)));
constexpr int BM = 256, BK = 64, HALF = 128, HTB = HALF * BK * 2  , STAGE_BYTES = 8 * HTB, NXCD = 8, WGM = 8;

__host__ __device__ __forceinline__ int lds_byte(int r, int c) { const int st = (r >> 4) * 2 + (c >> 5), rr = r & 15, cc = c & 31, ob = rr * 64 + cc * 2; return st * 1024 + (ob ^ (((ob >> 9) & 1) << 5)); }
__host__ __device__ __forceinline__ void stage_rc(int b, int& R, int& C) { const int st = b / 1024, sb = b % 1024, swz = sb ^ (((sb >> 9) & 1) << 5); R = (st >> 1) * 16 + swz / 64; C = (st & 1) * 32 + (swz % 64) / 2; }
__host__ __device__ __forceinline__ int perm32(int rho) { const int n = rho >> 4, i = rho & 15; return 8 * (i >> 2) + 4 * n + (i & 3); }

struct Unit { int pm, pn; };
struct Gemm { const bf16_t* A; const bf16_t* Bt; int M, N, K; };

struct StaticOrder {
    int nM, nN, nwg, G, c;
    __host__ __device__ void init(int M, int N, int G_, int c_) { nM = M / BM; nN = N / BM; nwg = nM * nN; G = G_; c = c_; }
    __host__ __device__ bool next(int i, Unit& u) const {
        const long L = (long)i * G + c; if (L >= nwg) return false;
        int wgid = (int)L; { const int q = nwg / NXCD, r = nwg % NXCD, xcd = wgid % NXCD, off = wgid / NXCD; wgid = (xcd < r ? xcd * (q + 1) : r * (q + 1) + (xcd - r) * q) + off; }
        const int nig = WGM * nN, gid = wgid / nig, fm = gid * WGM, gsz = (nM - fm) < WGM ? (nM - fm) : WGM;
        u.pm = fm + ((wgid % nig) % gsz); u.pn = (wgid % nig) / gsz; return true;
    }
    __device__ __forceinline__ void a_ready(const Unit&) const {}
    __device__ __forceinline__ void done(const Unit&) const {}
};
__device__ __forceinline__ unsigned cvt_pk_bf16(float lo, float hi) { unsigned r; asm volatile("v_cvt_pk_bf16_f32 %0, %1, %2" : "=v"(r) : "v"(lo), "v"(hi)); return r; }
template <class Epi, class Sched, bool ALIGN_EPI = false, bool SP2 = false>
__device__ __forceinline__ void gemm_phase(PG8_LAS unsigned char* lds, const Gemm g, const Sched& S, const Epi& E) {
    const int tid = tidx(), wid = __builtin_amdgcn_readfirstlane(tid >> 6), lane = tid & 63, wr = wid >> 2, wc = wid & 3, fr = lane & 15, fq = lane >> 4;
    const int K = g.K, nt = K / BK;
    unsigned voffA[2], voffB[2];
#pragma unroll
    for (int i = 0; i < 2; ++i) { int R, C; stage_rc(tid * 16 + i * 8192, R, C); const int Rb = Epi::PERM ? ((R & ~31) + perm32(R & 31)) : R;
        voffA[i] = (unsigned)(R * K + C) * 2u; voffB[i] = (unsigned)(Rb * K + C) * 2u; }
    const size_t kstep = (size_t)(BK * 2);
    const size_t hstep = (size_t)HALF * K * 2;
    const size_t tstep = 2 * hstep;
    const unsigned ldsw = (unsigned)wid * 1024u;
    const int aoff = lds_byte(wr * 64 + fr, fq * 8), boff = lds_byte(wc * 32 + fr, fq * 8);
#define PG8_SA(b, h) (((b) * 2 + (h)) * HTB)
#define PG8_SB(b, h) ((4 + (b) * 2 + (h)) * HTB)
#define PG8_STAGE(bufoff, gbase, voff) do { _Pragma("unroll") for (int _i = 0; _i < 2; ++_i) \
        __builtin_amdgcn_global_load_lds((const unsigned*)((const char*)(gbase) + (voff)[_i]), (PG8_LAS unsigned*)(lds + (bufoff) + ldsw + _i * 8192), 16, 0, 0); } while (0)
#define PG8_LDA(dst, b, h) do { _Pragma("unroll") for (int m = 0; m < 4; ++m) _Pragma("unroll") for (int k = 0; k < 2; ++k) dst[m][k] = *(const PG8_LAS bf16x8*)(lds + PG8_SA(b, h) + aoff + m * 2048 + k * 1024); } while (0)
#define PG8_LDB(dst, b, h) do { _Pragma("unroll") for (int n = 0; n < 2; ++n) _Pragma("unroll") for (int k = 0; k < 2; ++k) dst[n][k] = *(const PG8_LAS bf16x8*)(lds + PG8_SB(b, h) + boff + n * 2048 + k * 1024); } while (0)
#define PG8_MMA(ai, bj, At, Bt) do { __builtin_amdgcn_s_setprio(1); _Pragma("unroll") for (int m = 0; m < 4; ++m) _Pragma("unroll") for (int n = 0; n < 2; ++n) _Pragma("unroll") for (int k = 0; k < 2; ++k) \
        acc[ai][bj][m][n] = __builtin_amdgcn_mfma_f32_16x16x32_bf16(Bt[n][k], At[m][k], acc[ai][bj][m][n], 0, 0, 0); __builtin_amdgcn_s_setprio(0); } while (0)
#define PG8_WAIT_V(n) asm volatile("s_waitcnt vmcnt(" #n ")" ::: "memory")
#define PG8_WAIT_L(n) asm volatile("s_waitcnt lgkmcnt(" #n ")" ::: "memory")
#define PG8_BAR __builtin_amdgcn_s_barrier()
#define PG8_SCHED __builtin_amdgcn_sched_barrier(0)
    Unit cur, nxt; int ui = 0;
    if (!S.next(0, cur)) return;
    f32x4 acc[2][2][4][2];
#pragma unroll
    for (int a = 0; a < 2; ++a)
#pragma unroll
        for (int b = 0; b < 2; ++b)
#pragma unroll
            for (int m = 0; m < 4; ++m)
#pragma unroll
                for (int n = 0; n < 2; ++n) acc[a][b][m][n] = (f32x4){0.f, 0.f, 0.f, 0.f};
    bf16x8 At[4][2], B0[2][2], B1[2][2];
    const char* cA = (const char*)g.A + (size_t)cur.pm * tstep; const char* cB = (const char*)g.Bt + (size_t)cur.pn * tstep;
    S.a_ready(cur);
    if constexpr (SP2) {
        PG8_STAGE(PG8_SB(0, 0), cB, voffB); PG8_STAGE(PG8_SB(0, 1), cB + hstep, voffB); PG8_STAGE(PG8_SA(0, 0), cA, voffA); PG8_STAGE(PG8_SA(0, 1), cA + hstep, voffA);
        if (wr == 1) PG8_BAR;
        PG8_WAIT_V(2); PG8_BAR;
        PG8_STAGE(PG8_SB(1, 0), cB + kstep, voffB); PG8_STAGE(PG8_SA(1, 0), cA + kstep, voffA); PG8_STAGE(PG8_SB(1, 1), cB + hstep + kstep, voffB);
        PG8_WAIT_V(6); PG8_BAR;
    } else {
        PG8_STAGE(PG8_SB(0, 0), cB, voffB); PG8_STAGE(PG8_SA(0, 0), cA, voffA); PG8_STAGE(PG8_SB(0, 1), cB + hstep, voffB); PG8_STAGE(PG8_SA(0, 1), cA + hstep, voffA);
        if (wr == 1) PG8_BAR;
        PG8_WAIT_V(4); PG8_BAR;
        PG8_STAGE(PG8_SB(1, 0), cB + kstep, voffB); PG8_STAGE(PG8_SA(1, 0), cA + kstep, voffA); PG8_STAGE(PG8_SB(1, 1), cB + hstep + kstep, voffB);
        PG8_WAIT_V(6); PG8_BAR;
    }
    for (;;) {
        const bool has_next = S.next(ui + 1, nxt);
        const char* nA = has_next ? (const char*)g.A + (size_t)nxt.pm * tstep : cA; const char* nB = has_next ? (const char*)g.Bt + (size_t)nxt.pn * tstep : cB;
        for (int t = 0; t < nt; t += 2) {
            const bool last = (t == nt - 2);
            const char* a1 = cA + (size_t)(t + 1) * kstep;
            const char* a2 = last ? nA : cA + (size_t)(t + 2) * kstep; const char* b2 = last ? nB : cB + (size_t)(t + 2) * kstep;
            const char* a3 = a2 + kstep; const char* b3 = b2 + kstep;
            if (last && has_next) S.a_ready(nxt);
            if constexpr (SP2) {
            PG8_LDB(B0, 0, 0); PG8_LDB(B1, 0, 1); PG8_SCHED; PG8_LDA(At, 0, 0); PG8_STAGE(PG8_SA(1, 1), a1 + hstep, voffA);
            PG8_WAIT_V(8); PG8_WAIT_L(0); PG8_BAR; PG8_MMA(0, 0, At, B0); PG8_MMA(0, 1, At, B1); PG8_BAR; PG8_SCHED;
            PG8_LDA(At, 0, 1); PG8_STAGE(PG8_SB(0, 0), b2, voffB); PG8_STAGE(PG8_SB(0, 1), b2 + hstep, voffB); PG8_STAGE(PG8_SA(0, 0), a2, voffA);
            PG8_WAIT_V(8); PG8_WAIT_L(0); PG8_BAR; PG8_MMA(1, 0, At, B0); PG8_MMA(1, 1, At, B1); PG8_BAR; PG8_SCHED;
            PG8_LDB(B0, 1, 0); PG8_LDB(B1, 1, 1); PG8_SCHED; PG8_LDA(At, 1, 0); PG8_STAGE(PG8_SA(0, 1), a2 + hstep, voffA);
            PG8_WAIT_V(8); PG8_WAIT_L(0); PG8_BAR; PG8_MMA(0, 0, At, B0); PG8_MMA(0, 1, At, B1); PG8_BAR; PG8_SCHED;
            PG8_LDA(At, 1, 1); PG8_STAGE(PG8_SB(1, 0), b3, voffB); PG8_STAGE(PG8_SB(1, 1), b3 + hstep, voffB); PG8_STAGE(PG8_SA(1, 0), a3, voffA);
            PG8_WAIT_V(8); PG8_WAIT_L(0); PG8_BAR; PG8_MMA(1, 0, At, B0); PG8_MMA(1, 1, At, B1); PG8_BAR; PG8_SCHED;
            } else {
            PG8_LDB(B0, 0, 0); PG8_SCHED; PG8_LDA(At, 0, 0); PG8_STAGE(PG8_SA(1, 1), a1 + hstep, voffA);
            PG8_WAIT_L(8); PG8_BAR; PG8_WAIT_L(0); PG8_MMA(0, 0, At, B0); PG8_BAR; PG8_SCHED;
            PG8_LDB(B1, 0, 1); PG8_STAGE(PG8_SB(0, 0), b2, voffB);
            PG8_BAR; PG8_WAIT_L(0); PG8_MMA(0, 1, At, B1); PG8_BAR;
            PG8_LDA(At, 0, 1); PG8_STAGE(PG8_SA(0, 0), a2, voffA);
            PG8_BAR; PG8_WAIT_L(0); PG8_MMA(1, 0, At, B0); PG8_BAR; PG8_SCHED;
            PG8_STAGE(PG8_SB(0, 1), b2 + hstep, voffB);
            PG8_WAIT_V(6); PG8_BAR; PG8_MMA(1, 1, At, B1); PG8_BAR;
            PG8_LDB(B0, 1, 0); PG8_SCHED; PG8_LDA(At, 1, 0); PG8_STAGE(PG8_SA(0, 1), a2 + hstep, voffA);
            PG8_WAIT_L(8); PG8_BAR; PG8_WAIT_L(0); PG8_MMA(0, 0, At, B0); PG8_BAR; PG8_SCHED;
            PG8_LDB(B1, 1, 1); PG8_STAGE(PG8_SB(1, 0), b3, voffB);
            PG8_BAR; PG8_WAIT_L(0); PG8_MMA(0, 1, At, B1); PG8_BAR;
            PG8_LDA(At, 1, 1); PG8_STAGE(PG8_SA(1, 0), a3, voffA);
            PG8_BAR; PG8_WAIT_L(0); PG8_MMA(1, 0, At, B0); PG8_BAR; PG8_SCHED;
            PG8_STAGE(PG8_SB(1, 1), b3 + hstep, voffB);
            PG8_WAIT_V(6); PG8_BAR; PG8_MMA(1, 1, At, B1); PG8_BAR;
            }
        }
        if constexpr (ALIGN_EPI) { if (wr == 0) PG8_BAR; }
        if constexpr (!Epi::AFTER_DRAIN) { E(acc, cur, wr, wc, fr, fq); S.done(cur); }
        if (!has_next) break;
#pragma unroll
        for (int a = 0; a < 2; ++a)
#pragma unroll
            for (int b = 0; b < 2; ++b)
#pragma unroll
                for (int m = 0; m < 4; ++m)
#pragma unroll
                    for (int n = 0; n < 2; ++n) acc[a][b][m][n] = (f32x4){0.f, 0.f, 0.f, 0.f};
        cur = nxt; cA = nA; cB = nB; ++ui;
        if constexpr (ALIGN_EPI) { if (wr == 1) PG8_BAR; }
    }
    PG8_WAIT_V(0);
    if constexpr (!ALIGN_EPI) { if (wr == 0) PG8_BAR; }
    PG8_BAR;
    if constexpr (Epi::AFTER_DRAIN) { E.fused(acc, cur, wr, wc, fr, fq, lds, wid, lane); S.done(cur); }
#undef PG8_SA
#undef PG8_SB
#undef PG8_STAGE
#undef PG8_LDA
#undef PG8_LDB
#undef PG8_MMA
#undef PG8_WAIT_V
#undef PG8_WAIT_L
#undef PG8_BAR
#undef PG8_SCHED
}
}

struct EpiIn {
  static constexpr bool PERM = false, AFTER_DRAIN = false;
  const Params* pp; int l;
  __device__ __forceinline__ void operator()(f32x4 (&acc)[2][2][4][2], const pg8::Unit& u, int wr, int wc, int fr, int fq) const {
    kparams_t kp_ = kparams(); (void)kp_;
    const int U = u.pn * 4 + wc;
    if (U >= 77) return;
    const int rowb = u.pm * 256 + wr * 64 + fr;
    const int bq = (u.pm * 256) / T, tb = rowb % T;
    bf16_t* dst = nullptr; int ld = 0, col0 = 0; const float* gain = nullptr; bool rope = false, silu = false;
    float post = 1.0f;
    bf16_t* vt = nullptr;
    if (U < 8) { dst = WSP(bf16_t, OFF_QN); ld = 512; col0 = U * 64; gain = kp_->nsa_q_norm + l * 64; rope = true; post = 0.125f * LOG2E; }
    else if (U < 10) { dst = WSP(bf16_t, OFF_KC); ld = 128; col0 = (U - 8) * 64; rope = true; }
    else if (U < 12) { dst = WSP(bf16_t, OFF_VC); ld = 128; col0 = (U - 10) * 64; }
    else if (U < 14) { dst = WSP(bf16_t, OFF_KS); ld = 128; col0 = (U - 12) * 64; gain = kp_->nsa_k_norm + (l * 3 + 1) * 64; rope = true; }
    else if (U < 16) { vt = WSP(bf16_t, OFF_VST) + (size_t)((bq * 2 + (U - 14)) * 64) * T; }
    else if (U < 18) { dst = WSP(bf16_t, OFF_KW); ld = 128; col0 = (U - 16) * 64; gain = kp_->nsa_k_norm + (l * 3 + 2) * 64; rope = true; }
    else if (U < 20) { vt = WSP(bf16_t, OFF_VWT) + (size_t)((bq * 2 + (U - 18)) * 64) * T; }
    else if (U < 28) { dst = WSP(bf16_t, OFF_OA); ld = 512; col0 = (U - 20) * 64; silu = true; }
    else if (U < 36) { dst = WSP(bf16_t, OFF_FQ); ld = 512; col0 = (U - 28) * 64; gain = kp_->fox_q_norm + l * 64; post = 0.125f * LOG2E; }
    else if (U < 44) { dst = WSP(bf16_t, OFF_FK); ld = 512; col0 = (U - 36) * 64; gain = kp_->fox_k_norm + l * 64; }
    else if (U < 52) { vt = WSP(bf16_t, OFF_FVT) + (size_t)((bq * 8 + (U - 44)) * 64) * T; }
    else if (U < 60) { dst = WSP(bf16_t, OFF_OB); ld = 512; col0 = (U - 52) * 64; silu = true; }
    else if (U < 68) { dst = WSP(bf16_t, OFF_MQ); ld = 512; col0 = (U - 60) * 64; }
    else if (U < 76) { dst = WSP(bf16_t, OFF_OM); ld = 512; col0 = (U - 68) * 64; silu = true; }
    if (U == 76) {
      float* gate = WSP(float, OFF_GATE);
      float* flog = WSP(float, OFF_FLOG);
#pragma unroll
      for (int ai = 0; ai < 2; ++ai)
#pragma unroll
        for (int m = 0; m < 4; ++m) {
          const size_t row = (size_t)rowb + 128 * ai + 16 * m;
#pragma unroll
          for (int n = 0; n < 2; ++n)
#pragma unroll
            for (int i = 0; i < 4; ++i) {
              const int e = 16 * n + 4 * fq + i;
              const float v = acc[ai][0][m][n][i];
              if (e < 24) gate[row * 24 + e] = sigmoidf_(v);
              else {
                const float xx = v + kp_->fox_f_bias[l * 8 + (e - 24)];
                flog[row * 8 + (e - 24)] = xx >= 0.f ? -log1pf(expf(-xx)) : xx - log1pf(expf(xx));
              }
            }
        }
      return;
    }
    if (vt) {
#pragma unroll
      for (int ai = 0; ai < 2; ++ai)
#pragma unroll
        for (int m = 0; m < 4; ++m) {
          const int t = tb + 128 * ai + 16 * m;
#pragma unroll
          for (int bj = 0; bj < 2; ++bj)
#pragma unroll
            for (int n = 0; n < 2; ++n) {
              const f32x4 v = acc[ai][bj][m][n];
              const unsigned w0 = cvtpk(v[0], v[1]), w1 = cvtpk(v[2], v[3]);
              const unsigned qo = (unsigned)((32 * bj + 16 * n + 4 * fq) * T + t);
              vt[qo] = (bf16_t)(w0 & 0xffffu); vt[qo + T] = (bf16_t)(w0 >> 16); vt[qo + 2 * T] = (bf16_t)(w1 & 0xffffu); vt[qo + 3 * T] = (bf16_t)(w1 >> 16);
            }
        }
      return;
    }
    const float* ropetab = WSP(float, OFF_ROPE);
    f32x4 gv[2][2];
    if (gain) {
#pragma unroll
      for (int bj = 0; bj < 2; ++bj)
#pragma unroll
        for (int n = 0; n < 2; ++n) gv[bj][n] = *(const f32x4*)(gain + 32 * bj + 16 * n + 4 * fq);
    }
#pragma unroll
    for (int ai = 0; ai < 2; ++ai)
#pragma unroll
      for (int m = 0; m < 4; ++m) {
        f32x4 v[2][2];
#pragma unroll
        for (int bj = 0; bj < 2; ++bj)
#pragma unroll
          for (int n = 0; n < 2; ++n) v[bj][n] = acc[ai][bj][m][n];
        const int row = rowb + 128 * ai + 16 * m;
        if (gain) {
          float ss = 0.f;
#pragma unroll
          for (int bj = 0; bj < 2; ++bj)
#pragma unroll
            for (int n = 0; n < 2; ++n)
#pragma unroll
              for (int i = 0; i < 4; ++i) ss += v[bj][n][i] * v[bj][n][i];
          ss += __shfl_xor(ss, 16);
          ss += __shfl_xor(ss, 32);
          const float rstd = rsqrtf(ss * (1.0f / 64.0f) + EPS);
#pragma unroll
          for (int bj = 0; bj < 2; ++bj)
#pragma unroll
            for (int n = 0; n < 2; ++n) v[bj][n] = v[bj][n] * rstd * gv[bj][n];
        }
        if (rope) {
          const int pos = row & (T - 1);
#pragma unroll
          for (int n = 0; n < 2; ++n) {
            const f32x4* tp = (const f32x4*)(ropetab + ((size_t)pos * 32 + 16 * n + 4 * fq) * 2);
            const f32x4 t0 = tp[0], t1 = tp[1];
            const float cs[4] = {t0[0], t0[2], t1[0], t1[2]}, sn[4] = {t0[1], t0[3], t1[1], t1[3]};
#pragma unroll
            for (int i = 0; i < 4; ++i) {
              const float y1 = v[0][n][i], y2 = v[1][n][i];
              v[0][n][i] = y1 * cs[i] - y2 * sn[i];
              v[1][n][i] = y2 * cs[i] + y1 * sn[i];
            }
          }
        }
#pragma unroll
        for (int bj = 0; bj < 2; ++bj)
#pragma unroll
          for (int n = 0; n < 2; ++n) {
            f32x4 y = v[bj][n] * post;
            if (silu) {
#pragma unroll
              for (int i = 0; i < 4; ++i) y[i] = siluf_(y[i]);
            }
            u32x2 w = {cvtpk(y[0], y[1]), cvtpk(y[2], y[3])};
            *(u32x2*)(dst + (size_t)row * ld + col0 + 32 * bj + 16 * n + 4 * fq) = w;
          }
      }
  }
};
struct EpiMemKV {
  static constexpr bool PERM = false, AFTER_DRAIN = false;
  const Params* pp;
  __device__ __forceinline__ void operator()(f32x4 (&acc)[2][2][4][2], const pg8::Unit& u, int wr, int wc, int fr, int fq) const {
    kparams_t kp_ = kparams(); (void)kp_;
    const int U = u.pn * 4 + wc;
    const int rowb = u.pm * 256 + wr * 64 + fr;
#pragma unroll
    for (int ai = 0; ai < 2; ++ai)
#pragma unroll
      for (int m = 0; m < 4; ++m) {
        const int row = rowb + 128 * ai + 16 * m;
#pragma unroll
        for (int bj = 0; bj < 2; ++bj)
#pragma unroll
          for (int n = 0; n < 2; ++n) {
            const f32x4 v = acc[ai][bj][m][n];
            const unsigned w0 = cvtpk(v[0], v[1]), w1 = cvtpk(v[2], v[3]);
            const int e = 32 * bj + 16 * n + 4 * fq;
            if (U < 8) {
              u32x2 w = {w0, w1};
              *(u32x2*)(WSP(bf16_t, OFF_MK) + (size_t)row * 512 + U * 64 + e) = w;
            } else {
              const int col = (U - 8) * 64 + e, h = col >> 7, d = col & 127, b = row >> 8, mm = row & 255;
              bf16_t* q = WSP(bf16_t, OFF_MVT) + (size_t)((b * 4 + h) * 128 + d) * 256 + mm;
              q[0] = (bf16_t)(w0 & 0xffffu); q[256] = (bf16_t)(w0 >> 16); q[512] = (bf16_t)(w1 & 0xffffu); q[768] = (bf16_t)(w1 >> 16);
            }
          }
      }
  }
};
struct EpiGate {
  static constexpr bool PERM = true, AFTER_DRAIN = false;
  bf16_t* G;
  __device__ __forceinline__ void operator()(f32x4 (&acc)[2][2][4][2], const pg8::Unit& u, int wr, int wc, int fr, int fq) const {
    const int br = u.pn >> 2, colt = (u.pn & 3) * 256 + wc * 32 + 8 * fq;
    bf16_t* base = G + (size_t)br * M * 1024;
    const int rowb = u.pm * 256 + wr * 64 + fr;
#pragma unroll
    for (int ai = 0; ai < 2; ++ai)
#pragma unroll
      for (int m = 0; m < 4; ++m) {
        bf16_t* rp = base + (size_t)(rowb + 128 * ai + 16 * m) * 1024 + colt;
#pragma unroll
        for (int bj = 0; bj < 2; ++bj) {
          const f32x4 v0 = acc[ai][bj][m][0], v1 = acc[ai][bj][m][1];
          u32x4 w = {cvtpk(sigmoidf_(v0[0]), sigmoidf_(v0[1])), cvtpk(sigmoidf_(v0[2]), sigmoidf_(v0[3])),
                     cvtpk(sigmoidf_(v1[0]), sigmoidf_(v1[1])), cvtpk(sigmoidf_(v1[2]), sigmoidf_(v1[3]))};
          *(u32x4*)(rp + 128 * bj) = w;
        }
      }
  }
};
struct EpiBranch {
  static constexpr bool PERM = true, AFTER_DRAIN = false;
  const bf16_t* G; bf16_t* Uo; int first;
  __device__ __forceinline__ void operator()(f32x4 (&acc)[2][2][4][2], const pg8::Unit& u, int wr, int wc, int fr, int fq) const {
    const int colt = u.pn * 256 + wc * 32 + 8 * fq;
    const int rowb = u.pm * 256 + wr * 64 + fr;
#pragma unroll
    for (int ai = 0; ai < 2; ++ai)
#pragma unroll
      for (int m = 0; m < 4; ++m) {
        const size_t ro = (size_t)(rowb + 128 * ai + 16 * m) * 1024 + colt;
#pragma unroll
        for (int bj = 0; bj < 2; ++bj) {
          const size_t off = ro + 128 * bj;
          const u32x4 gw = *(const u32x4*)(G + off);
          float y[8];
#pragma unroll
          for (int q = 0; q < 4; ++q) {
            const f32x4 v = acc[ai][bj][m][q >> 1];
            y[2 * q] = v[(2 * q) & 3] * bflo(gw[q]);
            y[2 * q + 1] = v[(2 * q + 1) & 3] * bfhi(gw[q]);
          }
          if (!first) {
            const u32x4 uw = *(const u32x4*)(Uo + off);
#pragma unroll
            for (int q = 0; q < 4; ++q) { y[2 * q] += bflo(uw[q]); y[2 * q + 1] += bfhi(uw[q]); }
          }
          u32x4 w = {cvtpk(y[0], y[1]), cvtpk(y[2], y[3]), cvtpk(y[4], y[5]), cvtpk(y[6], y[7])};
          *(u32x4*)(Uo + off) = w;
        }
      }
  }
};
struct EpiOut {
  static constexpr bool PERM = true, AFTER_DRAIN = false;
  const float* xin; float* xout;
  __device__ __forceinline__ void operator()(f32x4 (&acc)[2][2][4][2], const pg8::Unit& u, int wr, int wc, int fr, int fq) const {
    const int colt = u.pn * 256 + wc * 32 + 8 * fq;
    const int rowb = u.pm * 256 + wr * 64 + fr;
#pragma unroll
    for (int ai = 0; ai < 2; ++ai)
#pragma unroll
      for (int m = 0; m < 4; ++m) {
        const size_t ro = (size_t)(rowb + 128 * ai + 16 * m) * 1024 + colt;
#pragma unroll
        for (int bj = 0; bj < 2; ++bj) {
          const size_t off = ro + 128 * bj;
          const f32x4 x0 = *(const f32x4*)(xin + off), x1 = *(const f32x4*)(xin + off + 4);
          *(f32x4*)(xout + off) = x0 + acc[ai][bj][m][0];
          *(f32x4*)(xout + off + 4) = x1 + acc[ai][bj][m][1];
        }
      }
  }
};
template <class Epi>
__device__ __forceinline__ void run_gemm(PG8_LAS unsigned char* lds, const bf16_t* A, const bf16_t* Bt, int Mr, int Nc, int K, const Epi& E) {
  pg8::Gemm g{A, Bt, Mr, Nc, K};
  pg8::StaticOrder S;
  S.init(Mr, Nc, gdim(), bidx());
  pg8::gemm_phase<Epi, pg8::StaticOrder, true, true>(lds, g, S, E);
}

__device__ __forceinline__ int map_in(int n) {
  const int i = n >> 6, c = n & 63;
  if (i < 20) return n;
  if (i < 28) return 1304 + (n - 1280);
  if (i < 52) return 1816 + (n - 1792);
  if (i < 60) return 3360 + (n - 3328);
  if (i < 68) return 3872 + (n - 3840);
  if (i < 76) return 4384 + (n - 4352);
  if (i == 76) return c < 24 ? 1280 + c : (c < 32 ? 3352 + (c - 24) : -1);
  return -1;
}
__device__ __forceinline__ void wave_transpose_tile(const float* __restrict__ src, int ld_src, int k0, int n0, bf16_t* __restrict__ dst,
                                                    int Kdim, int maptype, int srccol0, float* tile, int lane) {
  int nlog = n0 + lane;
  if (maptype) { const int w = nlog & 255; nlog = (nlog & ~255) + (((w & 127) >> 5) << 6) + (((w >> 7) << 5) | (w & 31)); }
  const int sc = (maptype == 1) ? map_in(nlog) : srccol0 + nlog;
  const float* sp = src + (size_t)k0 * ld_src + (sc >= 0 ? sc : 0);
#pragma unroll 32
  for (int kk = 0; kk < 64; ++kk) {
    const float v = sp[(size_t)kk * ld_src];
    tile[kk * 65 + lane] = sc >= 0 ? v : 0.f;
  }
  __builtin_amdgcn_fence(__ATOMIC_SEQ_CST, "workgroup");
  __builtin_amdgcn_wave_barrier();
  const int rsub = lane >> 5, kp = lane & 31;
#pragma unroll 8
  for (int it = 0; it < 32; ++it) {
    const int row = 2 * it + rsub;
    const float a = tile[(2 * kp) * 65 + row], b = tile[(2 * kp + 1) * 65 + row];
    *(unsigned*)(dst + (size_t)(n0 + row) * Kdim + k0 + 2 * kp) = cvtpk(a, b);
  }
  __builtin_amdgcn_fence(__ATOMIC_SEQ_CST, "workgroup");
  __builtin_amdgcn_wave_barrier();
}
__device__ __forceinline__ void rmsnorm4(const float* __restrict__ x, const float* __restrict__ gain, bf16_t* __restrict__ dst, size_t row0, int lane) {
  f32x4 v[4][4];
  float ss[4];
#pragma unroll
  for (int rr = 0; rr < 4; ++rr)
#pragma unroll
    for (int i = 0; i < 4; ++i) v[rr][i] = *(const f32x4*)(x + (row0 + rr) * 1024 + lane * 4 + 256 * i);
  f32x4 gv[4];
#pragma unroll
  for (int i = 0; i < 4; ++i) gv[i] = *(const f32x4*)(gain + lane * 4 + 256 * i);
#pragma unroll
  for (int rr = 0; rr < 4; ++rr) {
    float s = 0.f;
#pragma unroll
    for (int i = 0; i < 4; ++i) s += v[rr][i][0] * v[rr][i][0] + v[rr][i][1] * v[rr][i][1] + v[rr][i][2] * v[rr][i][2] + v[rr][i][3] * v[rr][i][3];
    ss[rr] = s;
  }
#pragma unroll
  for (int o_ = 1; o_ < 64; o_ <<= 1) {
#pragma unroll
    for (int rr = 0; rr < 4; ++rr) ss[rr] += __shfl_xor(ss[rr], o_);
  }
#pragma unroll
  for (int rr = 0; rr < 4; ++rr) {
    const float rstd = rsqrtf(ss[rr] * (1.0f / 1024.0f) + EPS);
#pragma unroll
    for (int i = 0; i < 4; ++i) {
      const f32x4 y = v[rr][i] * rstd * gv[i];
      u32x2 w = {cvtpk(y[0], y[1]), cvtpk(y[2], y[3])};
      *(u32x2*)(dst + (row0 + rr) * 1024 + lane * 4 + 256 * i) = w;
    }
  }
}
__device__ __forceinline__ void phase_prep(const Params& p, int l, float* smem) {
  kparams_t kp_ = kparams(); (void)kp_;
  const int tid = tidx();
  const int wave = tid >> 6, lane = tid & 63;
  const int gw = wave * gdim() + bidx(), nw = NWAVES * gdim();
  if (l == 0 && bidx() == 0 && tid < 64) WSP(unsigned, OFF_CTL)[tid] = 0u;
  const float* xin = (l == 0) ? kp_->x : kp_->out;
  float* wtile = smem + wave * 4160;
  for (int u0 = gw; u0 < 3076; u0 += nw) {
    int u = u0;
    const float* src; int ld, kt, nt, Kd, mt = 0, c0 = 0; bf16_t* dst;
    if (u < 1280) { kt = u / 80; nt = u % 80; src = kp_->w_in + (size_t)l * 1024 * 7968; ld = 7968; Kd = 1024; dst = WSP(bf16_t, OFF_W_IN); mt = 1; }
    else if ((u -= 1280) < 768) { kt = u / 48; nt = u % 48; src = kp_->w_in + (size_t)l * 1024 * 7968; ld = 7968; Kd = 1024; dst = WSP(bf16_t, OFF_W_G); c0 = 4896; }
    else if ((u -= 768) < 256) { kt = u / 16; nt = u % 16; src = kp_->w_mem_kv + (size_t)l * 1024 * 1024; ld = 1024; Kd = 1024; dst = WSP(bf16_t, OFF_W_MKV); mt = 2; }
    else if ((u -= 256) < 384) { const int br = u / 128, uu = u % 128; kt = uu / 16; nt = uu % 16;
      src = (br == 0 ? kp_->w_branch_a : br == 1 ? kp_->w_branch_b : kp_->w_branch_m) + (size_t)l * 512 * 1024; ld = 1024; Kd = 512; dst = WSP(bf16_t, OFF_W_BR + (size_t)br * MiB); }
    else if ((u -= 384) < 256) { kt = u / 16; nt = u % 16; src = kp_->w_out + (size_t)l * 1024 * 1024; ld = 1024; Kd = 1024; dst = WSP(bf16_t, OFF_W_OUT); }
    else if ((u -= 256) < 128) { const int kv = u / 64, uu = u % 64; kt = uu / 2; nt = uu % 2;
      src = (kv ? kp_->cmp_w1_v : kp_->cmp_w1_k) + (size_t)l * 2048 * 128; ld = 128; Kd = 2048; dst = WSP(bf16_t, OFF_W1 + (size_t)kv * 512 * 1024); }
    else { u -= 128; const int kv = u / 2; kt = u % 2; nt = 0;
      src = (kv ? kp_->cmp_w2_v : kp_->cmp_w2_k) + (size_t)l * 128 * 64; ld = 64; Kd = 128; dst = WSP(bf16_t, OFF_W2 + (size_t)kv * 64 * 1024); }
    wave_transpose_tile(src, ld, kt * 64, nt * 64, dst, Kd, mt, c0, wtile, lane);
  }
  for (int grp = gw; grp < 8192 + 256; grp += nw) {
    if (grp < 8192) rmsnorm4(xin, kp_->norm_g + l * 1024, WSP(bf16_t, OFF_H), (size_t)grp * 4, lane);
    else rmsnorm4(kp_->mem, kp_->mem_norm_g + l * 1024, WSP(bf16_t, OFF_MEMN), (size_t)(grp - 8192) * 4, lane);
  }
  for (int u = gw; u < 32; u += nw) {
    const int kv = u >> 4, ch = u & 15;
    const float* pe = (kv ? kp_->cmp_pe_v : kp_->cmp_pe_k) + (size_t)l * 2048 + ch * 128;
    const float* w1 = (kv ? kp_->cmp_w1_v : kp_->cmp_w1_k) + (size_t)l * 2048 * 128 + (size_t)ch * 128 * 128;
    float s0 = 0.f, s1 = 0.f;
#pragma unroll 32
    for (int kk = 0; kk < 128; ++kk) {
      const float pv = pe[kk];
      s0 += pv * w1[(size_t)kk * 128 + lane];
      s1 += pv * w1[(size_t)kk * 128 + 64 + lane];
    }
    float* part = WSP(float, OFF_C1) + (size_t)(kv * 16 + ch) * 128;
    part[lane] = s0;
    part[64 + lane] = s1;
  }
  if (l == 0) {
    for (int u = bidx(); u < 512; u += gdim()) {
      for (int e = tid; e < 512; e += NTHREADS) {
        const int idx = u * 512 + e, pos = idx >> 5, f = idx & 31;
        const float ang = (float)pos * c_inv_freq[f];
        const double a = (double)ang;
        const double k = rint(a * 0.15915494309189535);
        const float rr = (float)(a - k * 6.283185307179586);
        float2 cs; cs.x = __cosf(rr); cs.y = __sinf(rr);
        WSP(float2, OFF_ROPE)[idx] = cs;
      }
    }
  }
}

__device__ __forceinline__ void compress_wg(const Params& p, int l, int up, float* smem) {
  kparams_t kp_ = kparams(); (void)kp_;
  const int wave_ = tidx() >> 6, kc = wave_ & 3, u = up * 2 + (wave_ >> 2);
  const int lane = tidx() & 63, r = lane & 15, g4 = lane >> 4;
  const int kv = u >> 7, rem = u & 127, b = rem >> 5, grp = (rem >> 4) & 1, it = rem & 15, i0 = it * 32;
  const bf16_t* src = WSP(bf16_t, kv ? OFF_VC : OFF_KC);
  const bf16_t* w1t = WSP(bf16_t, OFF_W1 + (size_t)kv * 512 * 1024);
  const bf16_t* w2t = WSP(bf16_t, OFF_W2 + (size_t)kv * 64 * 1024);
  const float* c1 = WSP(float, OFF_C1 + 16384) + kv * 128;
  const bf16_t* arow[2];
#pragma unroll
  for (int mt = 0; mt < 2; ++mt) {
    int i = i0 + 16 * mt + r;
    if (i > 510) i = 510;
    arow[mt] = src + ((size_t)b * T + 16 * i) * 128 + grp * 64 + g4 * 8;
  }
  f32x4 acc[2][8];
#pragma unroll
  for (int a = 0; a < 2; ++a)
#pragma unroll
    for (int c = 0; c < 8; ++c) acc[a][c] = (f32x4){0.f, 0.f, 0.f, 0.f};
  const bf16_t* bp = w1t + (size_t)r * 2048 + g4 * 8;
#pragma unroll 1
  for (int k0 = kc * 512; k0 < kc * 512 + 512; k0 += 32) {
    const int pp = k0 >> 6, d = k0 & 63;
    bf16x8 af[2], bf[8];
#pragma unroll
    for (int mt = 0; mt < 2; ++mt) af[mt] = *(const bf16x8*)(arow[mt] + (size_t)pp * 128 + d);
#pragma unroll
    for (int nt = 0; nt < 8; ++nt) bf[nt] = *(const bf16x8*)(bp + (size_t)nt * 16 * 2048 + k0);
#pragma unroll
    for (int mt = 0; mt < 2; ++mt)
#pragma unroll
      for (int nt = 0; nt < 8; ++nt) acc[mt][nt] = mfma16(bf[nt], af[mt], acc[mt][nt]);
  }
  {
    float* part = smem + wave_ * 4096;
#pragma unroll
    for (int a = 0; a < 2; ++a)
#pragma unroll
      for (int c = 0; c < 8; ++c)
#pragma unroll
        for (int i = 0; i < 4; ++i) part[((a * 8 + c) * 4 + i) * 64 + lane] = acc[a][c][i];
  }
  __syncthreads();
  if (kc != 0) return;
#pragma unroll 1
  for (int q = 1; q < 4; ++q) {
    const float* part = smem + (wave_ + q) * 4096;
#pragma unroll
    for (int a = 0; a < 2; ++a) {
#pragma unroll
      for (int c = 0; c < 8; ++c)
#pragma unroll
        for (int i = 0; i < 4; ++i) acc[a][c][i] += part[((a * 8 + c) * 4 + i) * 64 + lane];
      asm volatile("" ::: "memory");
    }
  }
#pragma unroll
  for (int nt = 0; nt < 8; ++nt) {
    const f32x4 cv = *(const f32x4*)(c1 + 16 * nt + 4 * g4);
#pragma unroll
    for (int mt = 0; mt < 2; ++mt)
#pragma unroll
      for (int i = 0; i < 4; ++i) acc[mt][nt][i] = siluf_(acc[mt][nt][i] + cv[i]);
  }
  bf16x8 wf[4][4];
#pragma unroll
  for (int ks = 0; ks < 4; ++ks)
#pragma unroll
    for (int et = 0; et < 4; ++et) {
      const bf16_t* wp = w2t + (size_t)(16 * et + r) * 128 + 32 * ks + 4 * g4;
      const u32x2 lo = *(const u32x2*)wp, hi = *(const u32x2*)(wp + 16);
      u32x4 w = {lo[0], lo[1], hi[0], hi[1]};
      wf[ks][et] = __builtin_bit_cast(bf16x8, w);
    }
  if (kv == 0) {
    const float* gain = kp_->nsa_k_norm + (size_t)(l * 3 + 0) * 64;
    bf16_t* dst = WSP(bf16_t, OFF_KCMP) + (size_t)((b * 2 + grp) * 512) * 64;
    f32x4 gv[4];
#pragma unroll
    for (int et = 0; et < 4; ++et) gv[et] = *(const f32x4*)(gain + 16 * et + 4 * g4);
#pragma unroll
    for (int mt = 0; mt < 2; ++mt) {
      f32x4 o[4];
#pragma unroll
      for (int et = 0; et < 4; ++et) o[et] = (f32x4){0.f, 0.f, 0.f, 0.f};
#pragma unroll
      for (int ks = 0; ks < 4; ++ks) {
        const bf16x8 xf = pack8(acc[mt][2 * ks], acc[mt][2 * ks + 1]);
#pragma unroll
        for (int et = 0; et < 4; ++et) o[et] = mfma16(wf[ks][et], xf, o[et]);
      }
      float ss = 0.f;
#pragma unroll
      for (int et = 0; et < 4; ++et)
#pragma unroll
        for (int i = 0; i < 4; ++i) ss += o[et][i] * o[et][i];
      ss += __shfl_xor(ss, 16);
      ss += __shfl_xor(ss, 32);
      const float rstd = rsqrtf(ss * (1.0f / 64.0f) + EPS);
      const int i = i0 + 16 * mt + r;
#pragma unroll
      for (int et = 0; et < 4; ++et) {
        f32x4 y = o[et] * rstd * gv[et];
        if (i > 510) y = (f32x4){0.f, 0.f, 0.f, 0.f};
        u32x2 w = {cvtpk(y[0], y[1]), cvtpk(y[2], y[3])};
        *(u32x2*)(dst + (size_t)i * 64 + 16 * et + 4 * g4) = w;
      }
    }
  } else {
    bf16_t* dst = WSP(bf16_t, OFF_VCT) + (size_t)((b * 2 + grp) * 64) * 512;
#pragma unroll
    for (int mt = 0; mt < 2; ++mt) {
      f32x4 o[4];
#pragma unroll
      for (int et = 0; et < 4; ++et) o[et] = (f32x4){0.f, 0.f, 0.f, 0.f};
#pragma unroll
      for (int ks = 0; ks < 4; ++ks) {
        const bf16x8 xf = pack8(acc[mt][2 * ks], acc[mt][2 * ks + 1]);
#pragma unroll
        for (int et = 0; et < 4; ++et) o[et] = mfma16(xf, wf[ks][et], o[et]);
      }
#pragma unroll
      for (int et = 0; et < 4; ++et) {
        f32x4 y = o[et];
        const int ib = i0 + 16 * mt + 4 * g4;
#pragma unroll
        for (int i = 0; i < 4; ++i)
          if (ib + i > 510) y[i] = 0.f;
        u32x2 w = {cvtpk(y[0], y[1]), cvtpk(y[2], y[3])};
        *(u32x2*)(dst + (size_t)(16 * et + r) * 512 + ib) = w;
      }
    }
  }
}
__device__ __forceinline__ void cumsum_wg(const Params& p, int u, float* smem) {
  kparams_t kp_ = kparams(); (void)kp_;
  const int tid = tidx(), lane = tid & 63, wave = tid >> 6, b = u >> 3, h = u & 7;
  const float* fl = WSP(float, OFF_FLOG) + ((size_t)b * T) * 8 + h;
  float* fc = WSP(float, OFF_FC) + (size_t)(b * 8 + h) * T;
  const int tb = tid * 16;
  float v[16];
#pragma unroll
  for (int i = 0; i < 16; ++i) v[i] = fl[(size_t)(tb + i) * 8];
  double s = 0.0;
#pragma unroll
  for (int i = 0; i < 16; ++i) s += (double)v[i];
  double incl = s;
#pragma unroll
  for (int o = 1; o < 64; o <<= 1) {
    const double y = __shfl_up(incl, o);
    if (lane >= o) incl += y;
  }
  double* wtot = (double*)smem;
  if (lane == 63) wtot[wave] = incl;
  __syncthreads();
  double base = 0.0;
  for (int w = 0; w < wave; ++w) base += wtot[w];
  double run = base + incl - s;
#pragma unroll
  for (int i = 0; i < 16; ++i) { run += (double)v[i]; v[i] = (float)run; }
#pragma unroll
  for (int i = 0; i < 4; ++i) *(f32x4*)(fc + tb + 4 * i) = (f32x4){v[4 * i], v[4 * i + 1], v[4 * i + 2], v[4 * i + 3]};
  __syncthreads();
}
__device__ __forceinline__ void memk_norm_unit(const Params& p, int l, int u) {
  kparams_t kp_ = kparams(); (void)kp_;
  const int lane = tidx() & 63;
  bf16_t* mk = WSP(bf16_t, OFF_MK);
  const float* gain = kp_->mem_k_norm + l * 128 + (lane & 15) * 8;
  for (int rr = 0; rr < 16; ++rr) {
    bf16_t* ptr = mk + (size_t)(u * 16 + rr) * 512 + lane * 8;
    const u32x4 w = *(const u32x4*)ptr;
    float v[8];
#pragma unroll
    for (int j = 0; j < 4; ++j) { v[2 * j] = bflo(w[j]); v[2 * j + 1] = bfhi(w[j]); }
    float ss = 0.f;
#pragma unroll
    for (int j = 0; j < 8; ++j) ss += v[j] * v[j];
#pragma unroll
    for (int o = 1; o < 16; o <<= 1) ss += __shfl_xor(ss, o);
    const float rstd = rsqrtf(ss * (1.0f / 128.0f) + EPS);
    u32x4 ow;
#pragma unroll
    for (int j = 0; j < 4; ++j) ow[j] = cvtpk(v[2 * j] * rstd * gain[2 * j], v[2 * j + 1] * rstd * gain[2 * j + 1]);
    *(u32x4*)ptr = ow;
  }
}
__device__ __forceinline__ void phase_mid(const Params& p, int l, float* smem) {
  const int wave = tidx() >> 6;
  for (int u = bidx(); u < 128 + 32 + 8; u += gdim()) {
    if (u < 128) { compress_wg(p, l, u, smem); __syncthreads(); }
    else if (u < 160) cumsum_wg(p, u - 128, smem);
    else memk_norm_unit(p, l, (u - 160) * 8 + wave);
  }
}

template <int NCT, int NDK, bool QL = false>
__device__ __forceinline__ void qk_scores(const bf16_t* __restrict__ kbase, int ldk, int key0,
                                          const bf16x8 (&qf)[NCT][NDK], f32x4 (&s)[2][NCT], int lane, const bf16x8* qlds = nullptr) {
  const int r = lane & 15, grp = lane >> 4;
#pragma unroll
  for (int kt = 0; kt < 2; ++kt) {
    const bf16_t* kp = kbase + (size_t)(key0 + 8 * (r >> 2) + 4 * kt + (r & 3)) * ldk + grp * 8;
    bf16x8 kf[NDK];
#pragma unroll
    for (int dk = 0; dk < NDK; ++dk) kf[dk] = *(const bf16x8*)(kp + dk * 32);
#pragma unroll
    for (int ct = 0; ct < NCT; ++ct) {
      f32x4 a = {0.f, 0.f, 0.f, 0.f};
#pragma unroll
      for (int dk = 0; dk < NDK; ++dk) a = mfma16(kf[dk], QL ? qlds[(ct * NDK + dk) * 64 + lane] : qf[ct][dk], a);
      s[kt][ct] = a;
    }
  }
}
template <int NCT, int NDT>
__device__ __forceinline__ void pv_accum(const bf16_t* __restrict__ vt, size_t ldv, int key0,
                                         const f32x4 (&s)[2][NCT], f32x4 (&o)[NDT][NCT], int lane) {
  const int r = lane & 15, grp = lane >> 4;
  bf16x8 pb[NCT];
#pragma unroll
  for (int ct = 0; ct < NCT; ++ct) pb[ct] = pack8(s[0][ct], s[1][ct]);
#pragma unroll
  for (int dt = 0; dt < NDT; ++dt) {
    const bf16x8 vf = *(const bf16x8*)(vt + (size_t)(16 * dt + r) * ldv + key0 + 8 * grp);
#pragma unroll
    for (int ct = 0; ct < NCT; ++ct) o[dt][ct] = mfma16(vf, pb[ct], o[dt][ct]);
  }
}
template <int NCT, int NDT, bool HAS_O, bool SUMS = true>
__device__ __forceinline__ void softmax_update(f32x4 (&s)[2][NCT], float (&m)[NCT], float (&lsum)[NCT],
                                               f32x4 (&o)[NDT][NCT], f32x4 (*lacc)[NCT] = nullptr) {
  float mnew[NCT];
  bool ch = false;
#pragma unroll
  for (int ct = 0; ct < NCT; ++ct) {
    float mx = fmaxf(fmaxf(fmaxf(s[0][ct][0], s[0][ct][1]), fmaxf(s[0][ct][2], s[0][ct][3])),
                     fmaxf(fmaxf(s[1][ct][0], s[1][ct][1]), fmaxf(s[1][ct][2], s[1][ct][3])));
    mx = grp_max4(mx);
    mnew[ct] = fmaxf(m[ct], mx);
    ch = ch || (mnew[ct] > m[ct]);
  }
  if (__any(ch)) {
#pragma unroll
    for (int ct = 0; ct < NCT; ++ct) {
      const float msafe = (mnew[ct] == NEG_INF) ? 0.f : mnew[ct];
      const float alpha = __builtin_amdgcn_exp2f(m[ct] - msafe);
      m[ct] = mnew[ct];
      if (SUMS) lsum[ct] *= alpha; else (*lacc)[ct] = (*lacc)[ct] * alpha;
      if (HAS_O) {
#pragma unroll
        for (int dt = 0; dt < NDT; ++dt) o[dt][ct] = o[dt][ct] * alpha;
      }
    }
  }
#pragma unroll
  for (int ct = 0; ct < NCT; ++ct) {
    const float msafe = (m[ct] == NEG_INF) ? 0.f : m[ct];
#pragma unroll
    for (int kt = 0; kt < 2; ++kt) {
      const f32x4 d = s[kt][ct] - msafe;
      f32x4 pv;
#pragma unroll
      for (int i = 0; i < 4; ++i) pv[i] = __builtin_amdgcn_exp2f(d[i]);
      s[kt][ct] = pv;
    }
    if (SUMS) {
      const f32x4 t4 = s[0][ct] + s[1][ct];
      lsum[ct] += (t4[0] + t4[1]) + (t4[2] + t4[3]);
    }
  }
}
__device__ __forceinline__ float finish_l(float lsum) {
  lsum += __shfl_xor(lsum, 16);
  lsum += __shfl_xor(lsum, 32);
  return lsum > 0.f ? 1.0f / lsum : 0.f;
}

typedef __attribute__((address_space(3))) unsigned char lds_u8;
constexpr int TILE_ROWB = 144, TILE_HALF = 64 * TILE_ROWB, TILE_STAGE = 2 * TILE_HALF + 256;
struct TileRegs { u32x4 k, v; };
__device__ __forceinline__ void tile_gload(TileRegs& tr, const bf16_t* __restrict__ kbase, int ldk, const bf16_t* __restrict__ vtbase,
                                           size_t ldv, int key0, int tid) {
  const int row = tid >> 3, ch = tid & 7;
  tr.k = *(const u32x4*)(kbase + (size_t)(key0 + row) * ldk + ch * 8);
  tr.v = *(const u32x4*)(vtbase + (size_t)row * ldv + key0 + ch * 8);
}
__device__ __forceinline__ void tile_swrite(const TileRegs& tr, lds_u8* stage, int tid) {
  const int row = tid >> 3, ch = tid & 7;
  *(__attribute__((address_space(3))) u32x4*)(stage + row * TILE_ROWB + ch * 16) = tr.k;
  *(__attribute__((address_space(3))) u32x4*)(stage + TILE_HALF + row * TILE_ROWB + ch * 16) = tr.v;
}
template <int NCT, int NDK, bool QL>
__device__ __forceinline__ void qk_scores_lds(const lds_u8* stage, int hf, const bf16x8 (&qf)[NCT][NDK], f32x4 (&s)[2][NCT], int lane,
                                              const bf16x8* qlds, const f32x4 c0, const f32x4 c1) {
  const int r = lane & 15, grp = lane >> 4;
#pragma unroll
  for (int kt = 0; kt < 2; ++kt) {
    const lds_u8* kp = stage + (32 * hf + 8 * (r >> 2) + 4 * kt + (r & 3)) * TILE_ROWB + grp * 16;
    bf16x8 kf[NDK];
#pragma unroll
    for (int dk = 0; dk < NDK; ++dk) kf[dk] = *(const __attribute__((address_space(3))) bf16x8*)(kp + dk * 64);
#pragma unroll
    for (int ct = 0; ct < NCT; ++ct) {
      f32x4 a = kt ? c1 : c0;
#pragma unroll
      for (int dk = 0; dk < NDK; ++dk) a = mfma16(kf[dk], QL ? qlds[(ct * NDK + dk) * 64 + lane] : qf[ct][dk], a);
      s[kt][ct] = a;
    }
  }
}
template <int NDT>
__device__ __forceinline__ void v_frags_lds(const lds_u8* stage, int hf, bf16x8 (&vf)[NDT], int lane) {
  const int r = lane & 15, grp = lane >> 4;
#pragma unroll
  for (int dt = 0; dt < NDT; ++dt)
    vf[dt] = *(const __attribute__((address_space(3))) bf16x8*)(stage + TILE_HALF + (16 * dt + r) * TILE_ROWB + (32 * hf + 8 * grp) * 2);
}
template <int NCT, int NDT>
__device__ __forceinline__ void pv_accum_lds(const bf16x8 (&vfp)[NDT], const f32x4 (&s)[2][NCT], f32x4 (&o)[NDT][NCT], int lane, f32x4 (&lacc)[NCT]) {
  const int r = lane & 15, grp = lane >> 4; (void)r; (void)grp;
  bf16x8 pb[NCT];
#pragma unroll
  for (int ct = 0; ct < NCT; ++ct) pb[ct] = pack8(s[0][ct], s[1][ct]);
  {
    const short one = (short)0x3F80;
    const bf16x8 ones = {one, one, one, one, one, one, one, one};
#pragma unroll
    for (int ct = 0; ct < NCT; ++ct) lacc[ct] = mfma16(ones, pb[ct], lacc[ct]);
  }
#pragma unroll
  for (int dt = 0; dt < NDT; ++dt) {
    const bf16x8 vf = vfp[dt];
#pragma unroll
    for (int ct = 0; ct < NCT; ++ct) o[dt][ct] = mfma16(vf, pb[ct], o[dt][ct]);
  }
}
__device__ __forceinline__ int next_bit(unsigned long long lo, unsigned long long hi, int from) {
  if (from < 64) { const unsigned long long mm = lo & (~0ull << from); if (mm) return __ffsll(mm) - 1; from = 64; }
  if (from < 128) { const unsigned long long mm = hi & (~0ull << (from - 64)); if (mm) return 64 + __ffsll(mm) - 1; }
  return 128;
}

__device__ __forceinline__ void nsa_wg_unit(const Params& p, int b, int g, int qi, float* imp, bf16x8* qlds, float* scr, lds_u8* tiles, unsigned* misc, bool st) {
  kparams_t kp_ = kparams(); (void)kp_;
  const int tid0 = tidx();
  const int wave = __builtin_amdgcn_readfirstlane(tid0 >> 6);
  const int lane0 = tid0 & 63;
  const int tq = qi * 8 + wave;
  const int t0 = tq * 16;
  const bf16x8 (&qf)[4][2] = *(const bf16x8 (*)[4][2])nullptr;
#define NSA_SECTION_VARS \
  int lane = lane0; asm volatile("" : "+v"(lane)); \
  const int r = lane & 15, grp = lane >> 4, t = t0 + r; \
  const size_t row = (size_t)b * T + t; \
  const float* gatep = WSP(float, OFF_GATE) + row * 24 + g * 12; (void)gatep; (void)grp; (void)t;
  {
    NSA_SECTION_VARS
#pragma unroll
    for (int ct = 0; ct < 4; ++ct)
#pragma unroll
      for (int dk = 0; dk < 2; ++dk)
        qlds[(ct * 2 + dk) * 64 + lane] = *(const bf16x8*)(WSP(bf16_t, OFF_QN) + row * 512 + (g * 4 + ct) * 64 + dk * 32 + grp * 8);
  }
  f32x4 o[4][4];
  float m[4], lsum[4];
  f32x4 lacc[4];
  {
    NSA_SECTION_VARS
    const bf16_t* kc = WSP(bf16_t, OFF_KCMP) + (size_t)((b * 2 + g) * 512) * 64;
    const bf16_t* vct = WSP(bf16_t, OFF_VCT) + (size_t)((b * 2 + g) * 64) * 512;
    const int nblk = (tq + 31) >> 5;
#pragma unroll
    for (int ct = 0; ct < 4; ++ct) { m[ct] = NEG_INF; lsum[ct] = 0.f; }
#pragma unroll 1
    for (int blk = 0; blk < nblk; ++blk) {
      f32x4 s[2][4];
      qk_scores<4, 2, true>(kc, 64, blk * 32, qf, s, lane, qlds);
#pragma unroll
      for (int kt = 0; kt < 2; ++kt)
#pragma unroll
        for (int i = 0; i < 4; ++i) {
          const int n = blk * 32 + 8 * grp + 4 * kt + i;
          const bool ok = (16 * n + 31 <= t);
#pragma unroll
          for (int ct = 0; ct < 4; ++ct) s[kt][ct][i] = ok ? s[kt][ct][i] : NEG_INF;
        }
      softmax_update<4, 4, false>(s, m, lsum, o);
    }
    float invl[4], msafe[4];
#pragma unroll
    for (int ct = 0; ct < 4; ++ct) { invl[ct] = finish_l(lsum[ct]); msafe[ct] = (m[ct] == NEG_INF) ? 0.f : m[ct]; }
    for (int e = lane; e < 16 * 132; e += 64) imp[e] = 0.f;
    __builtin_amdgcn_fence(__ATOMIC_SEQ_CST, "workgroup");
    __builtin_amdgcn_wave_barrier();
#pragma unroll
    for (int dt = 0; dt < 4; ++dt)
#pragma unroll
      for (int ct = 0; ct < 4; ++ct) o[dt][ct] = (f32x4){0.f, 0.f, 0.f, 0.f};
#pragma unroll 1
    for (int blk = 0; blk < nblk; ++blk) {
      f32x4 s[2][4];
      qk_scores<4, 2, true>(kc, 64, blk * 32, qf, s, lane, qlds);
      float pq[2][4];
#pragma unroll
      for (int kt = 0; kt < 2; ++kt)
#pragma unroll
        for (int i = 0; i < 4; ++i) {
          const int n = blk * 32 + 8 * grp + 4 * kt + i;
          const bool ok = (16 * n + 31 <= t);
          float acc_p = 0.f;
#pragma unroll
          for (int ct = 0; ct < 4; ++ct) {
            const float pv = ok ? __builtin_amdgcn_exp2f(s[kt][ct][i] - msafe[ct]) * invl[ct] : 0.f;
            s[kt][ct][i] = pv;
            acc_p += pv;
          }
          pq[kt][i] = acc_p;
        }
      float* ir = imp + r * 132 + blk * 8 + 2 * grp;
      ir[0] += pq[0][0] + pq[0][1] + pq[0][2] + 0.5f * pq[0][3];
      __builtin_amdgcn_fence(__ATOMIC_SEQ_CST, "workgroup");
      __builtin_amdgcn_wave_barrier();
      ir[1] += pq[1][0] + pq[1][1] + pq[1][2] + 0.5f * pq[1][3] + 0.5f * pq[0][3];
      __builtin_amdgcn_fence(__ATOMIC_SEQ_CST, "workgroup");
      __builtin_amdgcn_wave_barrier();
      ir[2] += 0.5f * pq[1][3];
      __builtin_amdgcn_fence(__ATOMIC_SEQ_CST, "workgroup");
      __builtin_amdgcn_wave_barrier();
      pv_accum<4, 4>(vct, 512, blk * 32, s, o, lane);
    }
    f32x4 gt[4];
#pragma unroll
    for (int ct = 0; ct < 4; ++ct) gt[ct][0] = gatep[ct * 3 + 0];
#pragma unroll
    for (int dt = 0; dt < 4; ++dt) {
#pragma unroll
      for (int ct = 0; ct < 4; ++ct)
#pragma unroll
        for (int i = 0; i < 4; ++i) scr[((dt * 4 + ct) * 4 + i) * 64 + lane] = o[dt][ct][i] * gt[ct][0];
      asm volatile("" ::: "memory");
    }
  }
  const int cur = t0 >> 6;
  unsigned long long sel_lo = 0ull, sel_hi = 0ull;
  {
  NSA_SECTION_VARS
  if (cur <= 15) {
    sel_lo = (1ull << (cur + 1)) - 1ull;
  } else {
    __builtin_amdgcn_fence(__ATOMIC_SEQ_CST, "workgroup");
    __builtin_amdgcn_wave_barrier();
    float v[32];
#pragma unroll
    for (int k = 0; k < 32; ++k) {
      const int j = grp + 4 * k;
      const float x = imp[r * 132 + j];
      v[k] = (j >= 1 && j <= cur - 2) ? x : NEG_INF;
    }
#pragma unroll 1
    for (int round = 0; round < 13; ++round) {
      float best = NEG_INF;
      int bj = 1 << 20;
#pragma unroll
      for (int k = 0; k < 32; ++k) {
        const bool tk = v[k] > best;
        best = tk ? v[k] : best;
        bj = tk ? (grp + 4 * k) : bj;
      }
#pragma unroll
      for (int off = 16; off <= 32; off <<= 1) {
        const float ob = __shfl_xor(best, off);
        const int oj = __shfl_xor(bj, off);
        const bool tk = (ob > best) || (ob == best && oj < bj);
        best = tk ? ob : best;
        bj = tk ? oj : bj;
      }
      if (bj < 64) sel_lo |= 1ull << bj; else if (bj < 128) sel_hi |= 1ull << (bj - 64);
#pragma unroll
      for (int k = 0; k < 32; ++k) v[k] = (bj == grp + 4 * k) ? NEG_INF : v[k];
    }
    sel_lo |= 1ull;
    if (cur < 64) sel_lo |= 1ull << cur; else sel_hi |= 1ull << (cur - 64);
    if (cur - 1 < 64) sel_lo |= 1ull << (cur - 1); else sel_hi |= 1ull << (cur - 1 - 64);
  }
  }
  asm volatile("" : "+v"(sel_lo), "+v"(sel_hi));
  atomicOr(&misc[4], (unsigned)sel_lo); atomicOr(&misc[5], (unsigned)(sel_lo >> 32));
  atomicOr(&misc[6], (unsigned)sel_hi); atomicOr(&misc[7], (unsigned)(sel_hi >> 32));
  __syncthreads();
  unsigned long long ulo, uhi;
  {
    const unsigned u0 = __builtin_amdgcn_readfirstlane(misc[4]), u1 = __builtin_amdgcn_readfirstlane(misc[5]);
    const unsigned u2 = __builtin_amdgcn_readfirstlane(misc[6]), u3 = __builtin_amdgcn_readfirstlane(misc[7]);
    ulo = ((unsigned long long)u1 << 32) | u0; uhi = ((unsigned long long)u3 << 32) | u2;
  }
  {
    NSA_SECTION_VARS
    const int tid = (wave << 6) | lane;
    const int hq = r >> 2, qq = r & 3;
    const bf16_t* ks = WSP(bf16_t, OFF_KS) + ((size_t)b * T) * 128 + g * 64;
    const bf16_t* vst = WSP(bf16_t, OFF_VST) + (size_t)((b * 2 + g) * 64) * T;
    bf16x8 qr[4][2];
    unsigned long long mlo[4], mhi[4];
#pragma unroll
    for (int ct = 0; ct < 4; ++ct) {
      const size_t rowq = (size_t)b * T + t0 + 4 * ct + qq;
#pragma unroll
      for (int dk = 0; dk < 2; ++dk)
        qr[ct][dk] = *(const bf16x8*)(WSP(bf16_t, OFF_QN) + rowq * 512 + (g * 4 + hq) * 64 + dk * 32 + grp * 8);
      const int srcl = (lane & 48) | (4 * ct + qq);
      mlo[ct] = __shfl(sel_lo, srcl);
      mhi[ct] = __shfl(sel_hi, srcl);
      m[ct] = NEG_INF; lacc[ct] = (f32x4){0.f, 0.f, 0.f, 0.f};
    }
#pragma unroll
    for (int dt = 0; dt < 4; ++dt)
#pragma unroll
      for (int ct = 0; ct < 4; ++ct) o[dt][ct] = (f32x4){0.f, 0.f, 0.f, 0.f};
    const short one_ = (short)0x3F80;
    const bf16x8 ones = {one_, one_, one_, one_, one_, one_, one_, one_};
    TileRegs tr, trb;
    int jA = next_bit(ulo, uhi, 0), it = 0;
    int jB = next_bit(ulo, uhi, jA + 1);
    tile_gload(tr, ks, 128, vst, T, 64 * jA, tid);
    if (jB < 128) tile_gload(trb, ks, 128, vst, T, 64 * jB, tid);
    tile_swrite(tr, tiles, tid);
    if (jB < 128) tile_swrite(trb, tiles + TILE_STAGE, tid);
    __syncthreads();
#pragma unroll 1
    while (jA < 128) {
      const int nA = (jB < 128) ? next_bit(ulo, uhi, jB + 1) : 128;
      const int nB = (nA < 128) ? next_bit(ulo, uhi, nA + 1) : 128;
      if (nA < 128) tile_gload(tr, ks, 128, vst, T, 64 * nA, tid);
      if (nB < 128) tile_gload(trb, ks, 128, vst, T, 64 * nB, tid);
#pragma unroll 1
      for (int sub = 0; sub < 2; ++sub) {
      const int j = sub ? jB : jA;
      if (j >= 128) break;
      const lds_u8* stage = tiles + (2 * (it & 1) + sub) * TILE_STAGE;
      bool mine[4], need[4], anyneed = false;
#pragma unroll
      for (int ct = 0; ct < 4; ++ct) {
        mine[ct] = ((j < 64 ? (mlo[ct] >> j) : (mhi[ct] >> (j - 64))) & 1ull) != 0ull;
        need[ct] = __any(mine[ct]) != 0;
        anyneed = anyneed || need[ct];
      }
      if (anyneed) {
#pragma unroll
        for (int hf = 0; hf < 2; ++hf) {
          const int key0 = j * 64 + hf * 32;
          bf16x8 kf[2][2];
#pragma unroll
          for (int kt = 0; kt < 2; ++kt) {
            const lds_u8* kp = stage + (32 * hf + 8 * (r >> 2) + 4 * kt + (r & 3)) * TILE_ROWB + grp * 16;
#pragma unroll
            for (int dk = 0; dk < 2; ++dk) kf[kt][dk] = *(const __attribute__((address_space(3))) bf16x8*)(kp + dk * 64);
          }
          bf16x8 vfr[4];
          v_frags_lds<4>(stage, hf, vfr, lane);
#pragma unroll
          for (int ct = 0; ct < 4; ++ct) {
            if (need[ct]) {
              const float mv = mine[ct] ? 0.f : NEG_INF;
              f32x4 s0 = {mv, mv, mv, mv}, s1 = {mv, mv, mv, mv};
              s0 = mfma16(kf[0][0], qr[ct][0], s0);
              s1 = mfma16(kf[1][0], qr[ct][0], s1);
              s0 = mfma16(kf[0][1], qr[ct][1], s0);
              s1 = mfma16(kf[1][1], qr[ct][1], s1);
              if (j == cur) {
                const int tct = t0 + 4 * ct + qq;
#pragma unroll
                for (int i = 0; i < 4; ++i) {
                  s0[i] = (key0 + 8 * grp + i <= tct) ? s0[i] : NEG_INF;
                  s1[i] = (key0 + 8 * grp + 4 + i <= tct) ? s1[i] : NEG_INF;
                }
              }
              float mx = fmaxf(fmaxf(fmaxf(s0[0], s0[1]), fmaxf(s0[2], s0[3])), fmaxf(fmaxf(s1[0], s1[1]), fmaxf(s1[2], s1[3])));
              mx = grp_max4(mx);
              const float mnew = fmaxf(m[ct], mx);
              if (__any(mnew > m[ct])) {
                const float ms = (mnew == NEG_INF) ? 0.f : mnew;
                const float alpha = __builtin_amdgcn_exp2f(m[ct] - ms);
                m[ct] = mnew;
                lacc[ct] = lacc[ct] * alpha;
#pragma unroll
                for (int dt = 0; dt < 4; ++dt) o[dt][ct] = o[dt][ct] * alpha;
              }
              const float msafe = (m[ct] == NEG_INF) ? 0.f : m[ct];
              const f32x4 d0 = s0 - msafe, d1 = s1 - msafe;
              f32x4 p0, p1;
#pragma unroll
              for (int i = 0; i < 4; ++i) { p0[i] = __builtin_amdgcn_exp2f(d0[i]); p1[i] = __builtin_amdgcn_exp2f(d1[i]); }
              const bf16x8 pb = pack8(p0, p1);
              lacc[ct] = mfma16(ones, pb, lacc[ct]);
#pragma unroll
              for (int dt = 0; dt < 4; ++dt) o[dt][ct] = mfma16(vfr[dt], pb, o[dt][ct]);
            }
          }
        }
      }
      }
      if (nA < 128) tile_swrite(tr, tiles + (2 * ((it + 1) & 1)) * TILE_STAGE, tid);
      if (nB < 128) tile_swrite(trb, tiles + (2 * ((it + 1) & 1) + 1) * TILE_STAGE, tid);
      __syncthreads();
      jA = nA; jB = nB; ++it;
    }
    float* scr2 = scr + (size_t)2048 * 4096;
#pragma unroll
    for (int ct = 0; ct < 4; ++ct) {
      const size_t rowq = (size_t)b * T + t0 + 4 * ct + qq;
      const float sc = (lacc[ct][0] > 0.f ? 1.0f / lacc[ct][0] : 0.f) * WSP(float, OFF_GATE)[rowq * 24 + (g * 4 + hq) * 3 + 1];
#pragma unroll
      for (int dt = 0; dt < 4; ++dt)
        *(f32x4*)(scr2 + (hq * 16 + 4 * ct + qq) * 64 + 16 * dt + 4 * grp) = o[dt][ct] * sc;
    }
    asm volatile("s_waitcnt vmcnt(0)" ::: "memory");
    __builtin_amdgcn_fence(__ATOMIC_SEQ_CST, "workgroup");
  }
  {
    NSA_SECTION_VARS
    const int tid = (wave << 6) | lane;
    const bf16_t* kw = WSP(bf16_t, OFF_KW) + ((size_t)b * T) * 128 + g * 64;
    const bf16_t* vwt = WSP(bf16_t, OFF_VWT) + (size_t)((b * 2 + g) * 64) * T;
#pragma unroll
    for (int ct = 0; ct < 4; ++ct) { m[ct] = NEG_INF; lsum[ct] = 0.f; lacc[ct] = (f32x4){0.f, 0.f, 0.f, 0.f}; }
#pragma unroll
    for (int dt = 0; dt < 4; ++dt)
#pragma unroll
      for (int ct = 0; ct < 4; ++ct) o[dt][ct] = (f32x4){0.f, 0.f, 0.f, 0.f};
    int kstart = qi * 128 - 512;
    if (kstart < 0) kstart = 0;
    const int kend = qi * 128 + 64;
    bf16x8 qr[4][2];
#pragma unroll
    for (int ct = 0; ct < 4; ++ct)
#pragma unroll
      for (int dk = 0; dk < 2; ++dk)
        qr[ct][dk] = *(const bf16x8*)(WSP(bf16_t, OFF_QN) + row * 512 + (g * 4 + ct) * 64 + dk * 32 + grp * 8);
    TileRegs tr;
    int it = 0;
    tile_gload(tr, kw, 128, vwt, T, kstart, tid);
    tile_swrite(tr, tiles, tid);
    __syncthreads();
#pragma unroll 1
    for (int k0 = kstart; k0 <= kend; k0 += 64, ++it) {
      if (k0 + 64 <= kend) tile_gload(tr, kw, 128, vwt, T, k0 + 64, tid);
      const lds_u8* stage = tiles + (it & 1) * TILE_STAGE;
      if (k0 <= t0 + 15 && k0 + 63 + 512 > t0) {
#pragma unroll
        for (int hf = 0; hf < 2; ++hf) {
          const int key0 = k0 + hf * 32;
          f32x4 s[2][4];
          const f32x4 cz = {0.f, 0.f, 0.f, 0.f};
          qk_scores_lds<4, 2, false>(stage, hf, qr, s, lane, nullptr, cz, cz);
          if (!(k0 + 63 <= t0 && k0 + 512 > t0 + 15)) {
#pragma unroll
            for (int kt = 0; kt < 2; ++kt)
#pragma unroll
              for (int i = 0; i < 4; ++i) {
                const int key = key0 + 8 * grp + 4 * kt + i;
                const bool ok = (key <= t) && (key + 512 > t);
#pragma unroll
                for (int ct = 0; ct < 4; ++ct) s[kt][ct][i] = ok ? s[kt][ct][i] : NEG_INF;
              }
          }
          bf16x8 vfr[4];
          v_frags_lds<4>(stage, hf, vfr, lane);
          softmax_update<4, 4, true, false>(s, m, lsum, o, &lacc);
          pv_accum_lds<4, 4>(vfr, s, o, lane, lacc);
        }
      }
      if (k0 + 64 <= kend) tile_swrite(tr, tiles + ((it + 1) & 1) * TILE_STAGE, tid);
      __syncthreads();
    }
    float sc2[4];
#pragma unroll
    for (int ct = 0; ct < 4; ++ct) sc2[ct] = (lacc[ct][0] > 0.f ? 1.0f / lacc[ct][0] : 0.f) * gatep[ct * 3 + 2];
    bf16_t* oa = WSP(bf16_t, OFF_OA) + row * 512 + g * 256;
#pragma unroll
    for (int dt = 0; dt < 4; ++dt)
#pragma unroll
      for (int ct = 0; ct < 4; ++ct) {
        bf16_t* ptr = oa + ct * 64 + 16 * dt + 4 * grp;
        const u32x2 sw = *(const u32x2*)ptr;
        float val[4];
        const f32x4 sv = *(const f32x4*)(scr + (size_t)2048 * 4096 + (ct * 16 + r) * 64 + 16 * dt + 4 * grp);
#pragma unroll
        for (int i = 0; i < 4; ++i) val[i] = scr[((dt * 4 + ct) * 4 + i) * 64 + lane] + sv[i] + o[dt][ct][i] * sc2[ct];
        u32x2 w = {cvtpk(val[0] * bflo(sw[0]), val[1] * bfhi(sw[0])), cvtpk(val[2] * bflo(sw[1]), val[3] * bfhi(sw[1]))};
        if (st) *(u32x2*)ptr = w;
        asm volatile("" ::: "memory");
      }
  }
#undef NSA_SECTION_VARS
}

__device__ __forceinline__ void fox_wg_unit(const Params& p, int l, int b, int h, int qb, lds_u8* tiles, bool st) {
  kparams_t kp_ = kparams(); (void)kp_;
  const int tid = tidx();
  const int wave = __builtin_amdgcn_readfirstlane(tid >> 6);
  const int lane = tid & 63, r = lane & 15, grp = lane >> 4;
  const int t0 = qb * 512 + wave * 64;
  bf16x8 qf[4][2];
  const float* fc = WSP(float, OFF_FC) + (size_t)(b * 8 + h) * T;
#pragma unroll
  for (int ct = 0; ct < 4; ++ct) {
    const size_t row = (size_t)b * T + t0 + 16 * ct + r;
#pragma unroll
    for (int dk = 0; dk < 2; ++dk)
      qf[ct][dk] = *(const bf16x8*)(WSP(bf16_t, OFF_FQ) + row * 512 + h * 64 + dk * 32 + grp * 8);
  }
  const bf16_t* kb = WSP(bf16_t, OFF_FK) + ((size_t)b * T) * 512 + h * 64;
  const bf16_t* vt = WSP(bf16_t, OFF_FVT) + (size_t)((b * 8 + h) * 64) * T;
  f32x4 o[4][4];
  float m[4], lsum[4];
  f32x4 lacc[4];
#pragma unroll
  for (int ct = 0; ct < 4; ++ct) { m[ct] = NEG_INF; lsum[ct] = 0.f; lacc[ct] = (f32x4){0.f, 0.f, 0.f, 0.f}; }
#pragma unroll
  for (int dt = 0; dt < 4; ++dt)
#pragma unroll
    for (int ct = 0; ct < 4; ++ct) o[dt][ct] = (f32x4){0.f, 0.f, 0.f, 0.f};
  const int ntiles = (qb + 1) * 8;
  int it0, itw0;
  {
    float gq = fabsf(kp_->fox_q_norm[l * 64 + lane]), gk = fabsf(kp_->fox_k_norm[l * 64 + lane]);
#pragma unroll
    for (int o_ = 1; o_ < 64; o_ <<= 1) { gq = fmaxf(gq, __shfl_xor(gq, o_)); gk = fmaxf(gk, __shfl_xor(gk, o_)); }
    const float B2 = 16.0f * gq * gk * 1.02f + 104.0f;
    const float thr_wg = fc[qb * 512] + B2, thr_w = fc[t0] + B2;
    const float c0 = (lane < ntiles) ? fc[64 * lane + 63] : -3.0e38f;
    const float c1 = (lane + 64 < ntiles) ? fc[64 * (lane + 64) + 63] : -3.0e38f;
    it0 = __popcll(__ballot(c0 > thr_wg)) + __popcll(__ballot(c1 > thr_wg));
    itw0 = __popcll(__ballot(c0 > thr_w)) + __popcll(__ballot(c1 > thr_w));
    it0 = __builtin_amdgcn_readfirstlane(it0);
    itw0 = __builtin_amdgcn_readfirstlane(itw0);
  }
  TileRegs tr;
  float ckr = 0.f;
  tile_gload(tr, kb, 512, vt, T, it0 * 64, tid);
  if (tid < 64) ckr = fc[it0 * 64 + tid] * (-LOG2E);
  tile_swrite(tr, tiles, tid);
  if (tid < 64) *(__attribute__((address_space(3))) float*)(tiles + 2 * TILE_HALF + tid * 4) = ckr;
  __syncthreads();
#pragma unroll 1
  for (int it = it0; it < ntiles; ++it) {
    const int k0 = it * 64;
    if (it + 1 < ntiles) { tile_gload(tr, kb, 512, vt, T, k0 + 64, tid); if (tid < 64) ckr = fc[k0 + 64 + tid] * (-LOG2E); }
    const lds_u8* stage = tiles + ((it - it0) & 1) * TILE_STAGE;
    if (k0 <= t0 + 63 && it >= itw0) {
      const bool diag = (k0 + 63 > t0);
#pragma unroll
      for (int hf = 0; hf < 2; ++hf) {
        const int key0 = k0 + hf * 32;
        f32x4 s[2][4];
        const f32x4 ck0 = *(const __attribute__((address_space(3))) f32x4*)(stage + 2 * TILE_HALF + (32 * hf + 8 * grp) * 4);
        const f32x4 ck1 = *(const __attribute__((address_space(3))) f32x4*)(stage + 2 * TILE_HALF + (32 * hf + 8 * grp + 4) * 4);
        qk_scores_lds<4, 2, false>(stage, hf, qf, s, lane, nullptr, ck0, ck1);
        if (diag) {
#pragma unroll
          for (int kt = 0; kt < 2; ++kt)
#pragma unroll
            for (int i = 0; i < 4; ++i) {
              const int key = key0 + 8 * grp + 4 * kt + i;
#pragma unroll
              for (int ct = 0; ct < 4; ++ct) s[kt][ct][i] = (key <= t0 + 16 * ct + r) ? s[kt][ct][i] : NEG_INF;
            }
        }
        bf16x8 vfr[4];
        v_frags_lds<4>(stage, hf, vfr, lane);
        softmax_update<4, 4, true, false>(s, m, lsum, o, &lacc);
        pv_accum_lds<4, 4>(vfr, s, o, lane, lacc);
      }
    }
    if (it + 1 < ntiles) {
      tile_swrite(tr, tiles + ((it - it0 + 1) & 1) * TILE_STAGE, tid);
      if (tid < 64) *(__attribute__((address_space(3))) float*)(tiles + ((it - it0 + 1) & 1) * TILE_STAGE + 2 * TILE_HALF + tid * 4) = ckr;
    }
    __syncthreads();
  }
  float invl[4];
#pragma unroll
  for (int ct = 0; ct < 4; ++ct) invl[ct] = lacc[ct][0] > 0.f ? 1.0f / lacc[ct][0] : 0.f;
#pragma unroll
  for (int ct = 0; ct < 4; ++ct) {
    bf16_t* ob = WSP(bf16_t, OFF_OB) + ((size_t)b * T + t0 + 16 * ct + r) * 512 + h * 64;
#pragma unroll
    for (int dt = 0; dt < 4; ++dt) {
      bf16_t* ptr = ob + 16 * dt + 4 * grp;
      const u32x2 sw = *(const u32x2*)ptr;
      const f32x4 v = o[dt][ct] * invl[ct];
      u32x2 w = {cvtpk(v[0] * bflo(sw[0]), v[1] * bfhi(sw[0])), cvtpk(v[2] * bflo(sw[1]), v[3] * bfhi(sw[1]))};
      if (st) *(u32x2*)ptr = w;
    }
  }
}

__device__ __forceinline__ void mem_unit(const Params& p, int l, int b, int h, int t0, bool st) {
  kparams_t kp_ = kparams(); (void)kp_;
  const int lane = tidx() & 63, r = lane & 15, grp = lane >> 4;
  const float SC = 0.08838834764831845f * LOG2E;
  bf16x8 qf[2][4];
  const float* gq = kp_->mem_q_norm + l * 128;
#pragma unroll
  for (int ct = 0; ct < 2; ++ct) {
    const size_t row = (size_t)b * T + t0 + 16 * ct + r;
    float v[4][8];
    float ss = 0.f;
#pragma unroll
    for (int dk = 0; dk < 4; ++dk) {
      const u32x4 w = *(const u32x4*)(WSP(bf16_t, OFF_MQ) + row * 512 + h * 128 + dk * 32 + grp * 8);
#pragma unroll
      for (int j = 0; j < 4; ++j) { v[dk][2 * j] = bflo(w[j]); v[dk][2 * j + 1] = bfhi(w[j]); }
#pragma unroll
      for (int j = 0; j < 8; ++j) ss += v[dk][j] * v[dk][j];
    }
    ss += __shfl_xor(ss, 16);
    ss += __shfl_xor(ss, 32);
    const float rstd = rsqrtf(ss * (1.0f / 128.0f) + EPS);
#pragma unroll
    for (int dk = 0; dk < 4; ++dk) {
      const f32x4 g0 = *(const f32x4*)(gq + dk * 32 + grp * 8), g1 = *(const f32x4*)(gq + dk * 32 + grp * 8 + 4);
      u32x4 w = {cvtpk(v[dk][0] * rstd * g0[0], v[dk][1] * rstd * g0[1]), cvtpk(v[dk][2] * rstd * g0[2], v[dk][3] * rstd * g0[3]),
                 cvtpk(v[dk][4] * rstd * g1[0], v[dk][5] * rstd * g1[1]), cvtpk(v[dk][6] * rstd * g1[2], v[dk][7] * rstd * g1[3])};
      qf[ct][dk] = __builtin_bit_cast(bf16x8, w);
    }
  }
  const bf16_t* kb = WSP(bf16_t, OFF_MK) + ((size_t)b * 256) * 512 + h * 128;
  const bf16_t* vt = WSP(bf16_t, OFF_MVT) + (size_t)((b * 4 + h) * 128) * 256;
  f32x4 o[8][2];
  float m[2], lsum[2];
#pragma unroll
  for (int ct = 0; ct < 2; ++ct) { m[ct] = NEG_INF; lsum[ct] = 0.f; }
#pragma unroll
  for (int dt = 0; dt < 8; ++dt)
#pragma unroll
    for (int ct = 0; ct < 2; ++ct) o[dt][ct] = (f32x4){0.f, 0.f, 0.f, 0.f};
#pragma unroll 1
  for (int key0 = 0; key0 < 256; key0 += 32) {
    f32x4 s[2][2];
    qk_scores<2, 4>(kb, 512, key0, qf, s, lane);
#pragma unroll
    for (int kt = 0; kt < 2; ++kt)
#pragma unroll
      for (int ct = 0; ct < 2; ++ct) s[kt][ct] = s[kt][ct] * SC;
    softmax_update<2, 8, true>(s, m, lsum, o);
    pv_accum<2, 8>(vt, 256, key0, s, o, lane);
  }
#pragma unroll
  for (int ct = 0; ct < 2; ++ct) {
    const float invl = finish_l(lsum[ct]);
    bf16_t* om = WSP(bf16_t, OFF_OM) + ((size_t)b * T + t0 + 16 * ct + r) * 512 + h * 128;
#pragma unroll
    for (int dt = 0; dt < 8; ++dt) {
      bf16_t* ptr = om + 16 * dt + 4 * grp;
      const u32x2 sw = *(const u32x2*)ptr;
      const f32x4 v = o[dt][ct] * invl;
      u32x2 w = {cvtpk(v[0] * bflo(sw[0]), v[1] * bfhi(sw[0])), cvtpk(v[2] * bflo(sw[1]), v[3] * bfhi(sw[1]))};
      if (st) *(u32x2*)ptr = w;
    }
  }
}

__device__ __forceinline__ void phase_attn(const Params& p, int l, unsigned char* ldsraw, bool st, int cidx) {
  kparams_t kp_ = kparams(); (void)kp_;
  const int tid = tidx();
  const int wave = __builtin_amdgcn_readfirstlane(tid >> 6);
  float* imp = (float*)ldsraw + wave * 2112;
  lds_u8* tiles = (lds_u8*)ldsraw;
  bf16x8* qlds = (bf16x8*)(ldsraw + 69632 + wave * 8192);
  unsigned* misc = (unsigned*)(ldsraw + 135168);
  float* scr = WSP(float, OFF_SCR) + (size_t)(bidx() * NWAVES + wave) * 4096;
  const int myx = (int)(xb_xcc_id() & 7u);
  constexpr int QUNITS = 192;
  for (int qq = 0; qq < 8; ++qq) {
    const int x = (myx + qq) & 7;
    unsigned* ctr = WSP(unsigned, OFF_CTL) + cidx * 8 + x;
    for (;;) {
      __syncthreads();
      if (tid == 0) misc[0] = atomicAdd(ctr, 1u);
      if (tid >= 4 && tid < 8) misc[tid] = 0u;
      __syncthreads();
      const int u = __builtin_amdgcn_readfirstlane((int)misc[0]);
      if (u >= QUNITS) break;
      if (u < 64) {
        nsa_wg_unit(p, x >> 1, x & 1, 63 - u, imp, qlds, scr, tiles, misc, st);
      } else if (u < 128) {
        const int v_ = u - 64, bh = 4 * x + (v_ >> 4);
        fox_wg_unit(p, l, bh >> 3, bh & 7, 15 - (v_ & 15), tiles, st);
      } else {
        const int mu = u - 128, bh = 2 * x + (mu >> 5), qblk = mu & 31;
        mem_unit(p, l, bh >> 2, bh & 3, 256 * qblk + 32 * wave, st);
      }
    }
  }
}

__global__ void __launch_bounds__(NTHREADS) hybrid_megakernel(Params p) {
  kparams_t kp_ = kparams();
  cg::grid_group grid = cg::this_grid();
  extern __shared__ __attribute__((aligned(16))) unsigned char dynlds[];
  float* smem = (float*)dynlds;
  PG8_LAS unsigned char* glds = (PG8_LAS unsigned char*)dynlds;
  volatile LAS unsigned* bst = (volatile LAS unsigned*)(glds + 135168 + 64);
  if (threadIdx.x < 2) bst[threadIdx.x] = 0u;
  __syncthreads();
  grid.sync();
  const XcdBarrier xbar = xcd_barrier_post(WSP(unsigned, OFF_BAR), bst);
  unsigned long long pr_acc = 0ull, pr_t0 = 0ull;
#pragma unroll 1
  for (int ph = 0; ph < 28; ++ph) {
    const int l = ph / 7, k = ph - 7 * l;
    if (PROBE_PHASE >= 0 && k == PROBE_PHASE) pr_t0 = __builtin_amdgcn_s_memrealtime();
    if (k == 0) {
      phase_prep(p, l, smem);
    } else if (k == 1) {
      if (bidx() == gdim() - 1 && tidx() < 256) {
        const int t_ = tidx();
        const float* part = WSP(float, OFF_C1) + (size_t)(t_ >> 7) * 16 * 128 + (t_ & 127);
        float pv_[16];
#pragma unroll
        for (int ch = 0; ch < 16; ++ch) pv_[ch] = part[ch * 128];
        float s_ = 0.f;
#pragma unroll
        for (int ch = 0; ch < 16; ++ch) s_ += pv_[ch];
        WSP(float, OFF_C1 + 16384)[t_] = s_;
      }
      EpiIn E{&p, l};
      for (int rp = 0; rp < (PROBE_GEMM2 ? (kp_->ws != nullptr ? 2 : 1) : 1); ++rp)
        run_gemm(glds, WSP(bf16_t, OFF_H), WSP(bf16_t, OFF_W_IN), M, 5120, 1024, E);
      EpiMemKV E2{&p};
      run_gemm(glds, WSP(bf16_t, OFF_MEMN), WSP(bf16_t, OFF_W_MKV), 1024, 1024, 1024, E2);
    } else if (k == 2) {
      phase_mid(p, l, smem);
    } else if (k == 3) {
      const int nrep = PROBE_ATTN2 ? (kp_->ws != nullptr ? 2 : 1) : 1;
      for (int rp = 0; rp < nrep; ++rp) {
        const bool last = (rp == nrep - 1);
        if (rp) xcd_barrier(xbar);
        phase_attn(p, l, dynlds, last, last ? l : 4 + l);
      }
    } else if (k == 4) {
      EpiGate E{WSP(bf16_t, OFF_G)};
      for (int rp = 0; rp < (PROBE_GEMM2 ? (kp_->ws != nullptr ? 2 : 1) : 1); ++rp)
        run_gemm(glds, WSP(bf16_t, OFF_H), WSP(bf16_t, OFF_W_G), M, 3072, 1024, E);
    } else if (k == 5) {
      for (int rp = 0; rp < (PROBE_BR2 ? (kp_->ws != nullptr ? 2 : 1) : 1); ++rp) {
      EpiBranch Ea{WSP(bf16_t, OFF_G), WSP(bf16_t, OFF_U), 1};
      run_gemm(glds, WSP(bf16_t, OFF_OA), WSP(bf16_t, OFF_W_BR), M, 1024, 512, Ea);
      EpiBranch Eb{WSP(bf16_t, OFF_G) + (size_t)M * 1024, WSP(bf16_t, OFF_U), 0};
      run_gemm(glds, WSP(bf16_t, OFF_OB), WSP(bf16_t, OFF_W_BR + MiB), M, 1024, 512, Eb);
      EpiBranch Ec{WSP(bf16_t, OFF_G) + (size_t)2 * M * 1024, WSP(bf16_t, OFF_U), 0};
      run_gemm(glds, WSP(bf16_t, OFF_OM), WSP(bf16_t, OFF_W_BR + 2 * MiB), M, 1024, 512, Ec);
      }
    } else {
      EpiOut E{l == 0 ? kp_->x : kp_->out, kp_->out};
      run_gemm(glds, WSP(bf16_t, OFF_U), WSP(bf16_t, OFF_W_OUT), M, 1024, 1024, E);
    }
    xcd_barrier(xbar);
    if (PROBE_PHASE >= 0 && k == PROBE_PHASE) pr_acc += __builtin_amdgcn_s_memrealtime() - pr_t0;
  }
  if (PROBE_PHASE >= 0 && blockIdx.x == 0) {
    const unsigned long long ts = __builtin_amdgcn_s_memrealtime();
    while (__builtin_amdgcn_s_memrealtime() - ts < pr_acc) __builtin_amdgcn_s_sleep(8);
  }
}

extern "C" void kernel_launch(void* const* d_in, const int* in_sizes, int n_in, void* d_out, int out_size, void* d_ws,
                              size_t ws_size, hipStream_t stream) {
  static int grid_blocks = 0;
  if (!grid_blocks) {
    int dev = 0, cus = 0, per_cu = 0;
    (void)hipGetDevice(&dev);
    (void)hipDeviceGetAttribute(&cus, hipDeviceAttributeMultiprocessorCount, dev);
    if (hipFuncSetAttribute((const void*)hybrid_megakernel, hipFuncAttributeMaxDynamicSharedMemorySize, LDS_BYTES) != hipSuccess)
      fprintf(stderr, "hipFuncSetAttribute(dynamic LDS %d) failed\n", LDS_BYTES);
    (void)hipOccupancyMaxActiveBlocksPerMultiprocessor(&per_cu, hybrid_megakernel, NTHREADS, LDS_BYTES);
    (void)hipGetLastError();
    grid_blocks = cus;
    if (grid_blocks > 256) grid_blocks = 256;
    if (ws_size < OFF_SCR + (size_t)64 * MiB) fprintf(stderr, "workspace too small: %zu\n", ws_size);
  }
  Params p{};
  const float** pp = (const float**)&p;
  for (int i = 0; i < 23; ++i) pp[i] = (const float*)d_in[i];
  p.out = (float*)d_out;
  p.ws = (char*)d_ws;
  void* args[] = {&p};
  (void)hipMemsetAsync((char*)d_ws + OFF_BAR, 0, XCD_BAR_WORDS * sizeof(unsigned), stream);
  hipError_t e = hipLaunchCooperativeKernel((void*)hybrid_megakernel, dim3(grid_blocks), dim3(NTHREADS), args, LDS_BYTES, stream);
  if (e != hipSuccess) fprintf(stderr, "cooperative launch failed: %s (grid %d)\n", hipGetErrorString(e), grid_blocks);
}
```

```cpp
#include <hip/hip_runtime.h>
#include <hip/hip_cooperative_groups.h>
#include <stdint.h>
#include <cstdio>
namespace cg = cooperative_groups;
#ifndef PROBE_ATTN2
#define PROBE_ATTN2 0
#endif
#ifndef PROBE_PM2
#define PROBE_PM2 0
#endif
#ifndef PROBE_PHASE
#define PROBE_PHASE -1
#endif
#ifndef PROBE_BR2
#define PROBE_BR2 0
#endif
#ifndef PROBE_GEMM2
#define PROBE_GEMM2 0
#endif


typedef unsigned short bf16_t;
typedef short bf16x8 __attribute__((ext_vector_type(8)));
typedef float f32x4 __attribute__((ext_vector_type(4)));
typedef unsigned u32x2 __attribute__((ext_vector_type(2)));
typedef unsigned u32x4 __attribute__((ext_vector_type(4)));
typedef float f32x2_t __attribute__((ext_vector_type(2)));
typedef __bf16 bf16x2_t __attribute__((ext_vector_type(2)));

constexpr int NB = 4, T = 8192, M = NB * T;
constexpr int NTHREADS = 512, NWAVES = NTHREADS / 64;
constexpr int LDS_BYTES = 147456;
constexpr float EPS = 1e-6f;
constexpr float LOG2E = 1.4426950408889634f;
#define NEG_INF (-__builtin_inff())

constexpr size_t MiB = 1u << 20;
constexpr size_t OFF_CTL = 0;
constexpr size_t OFF_BAR = 64 * 1024;
constexpr size_t OFF_ROPE = 1 * MiB;
constexpr size_t OFF_W_IN = 3 * MiB;
constexpr size_t OFF_W_G = 13 * MiB;
constexpr size_t OFF_W_MKV = 19 * MiB;
constexpr size_t OFF_W_BR = 21 * MiB;
constexpr size_t OFF_W_OUT = 24 * MiB;
constexpr size_t OFF_W1 = 26 * MiB;
constexpr size_t OFF_W2 = 27 * MiB;
constexpr size_t OFF_C1 = 27 * MiB + 256 * 1024;
constexpr size_t OFF_MEMN = 28 * MiB;
constexpr size_t OFF_MK = 30 * MiB;
constexpr size_t OFF_MVT = 31 * MiB;
constexpr size_t OFF_H = 32 * MiB;
constexpr size_t OFF_U = 406 * MiB;
constexpr size_t OFF_OA = 96 * MiB;
constexpr size_t OFF_OB = 128 * MiB;
constexpr size_t OFF_OM = 160 * MiB;
constexpr size_t OFF_QN = 192 * MiB;
constexpr size_t OFF_G = 192 * MiB;
constexpr size_t OFF_KC = 224 * MiB;
constexpr size_t OFF_VC = 232 * MiB;
constexpr size_t OFF_KS = 240 * MiB;
constexpr size_t OFF_VST = 248 * MiB;
constexpr size_t OFF_KW = 256 * MiB;
constexpr size_t OFF_VWT = 264 * MiB;
constexpr size_t OFF_FQ = 272 * MiB;
constexpr size_t OFF_FK = 304 * MiB;
constexpr size_t OFF_FVT = 336 * MiB;
constexpr size_t OFF_MQ = 368 * MiB;
constexpr size_t OFF_GATE = 400 * MiB;
constexpr size_t OFF_FLOG = 403 * MiB;
constexpr size_t OFF_FC = 404 * MiB;
constexpr size_t OFF_KCMP = 405 * MiB;
constexpr size_t OFF_VCT = 405 * MiB + 512 * 1024;
constexpr size_t OFF_SCR = 406 * MiB;

struct Params {
  const float *x, *mem, *norm_g, *mem_norm_g, *w_in, *nsa_q_norm, *nsa_k_norm, *cmp_pe_k, *cmp_w1_k, *cmp_w2_k,
      *cmp_pe_v, *cmp_w1_v, *cmp_w2_v, *fox_q_norm, *fox_k_norm, *fox_f_bias, *mem_q_norm, *mem_k_norm, *w_mem_kv,
      *w_branch_a, *w_branch_b, *w_branch_m, *w_out;
  float* out;
  char* ws;
};
__device__ __forceinline__ char* ws_base(char* w) {
  unsigned lo = __builtin_amdgcn_readfirstlane((unsigned)(uintptr_t)w), hi = __builtin_amdgcn_readfirstlane((unsigned)((uintptr_t)w >> 32));
  asm volatile("" : "+s"(lo), "+s"(hi));
  return (char*)(__attribute__((address_space(1))) char*)(((uintptr_t)hi << 32) | (uintptr_t)lo);
}
typedef const __attribute__((address_space(4))) Params* kparams_t;
__device__ __forceinline__ kparams_t kparams() { kparams_t kp = (kparams_t)__builtin_amdgcn_kernarg_segment_ptr(); asm volatile("" : "+s"(kp)); return kp; }
#define WSP(TYPE, off) ((TYPE*)(ws_base(kp_->ws) + (off)))

__constant__ float c_inv_freq[32] = {
    1.000000000e+00f, 7.498942018e-01f, 5.623413324e-01f, 4.216965139e-01f, 3.162277639e-01f, 2.371373773e-01f,
    1.778279394e-01f, 1.333521456e-01f, 1.000000015e-01f, 7.498942316e-02f, 5.623413250e-02f, 4.216964915e-02f,
    3.162277490e-02f, 2.371373773e-02f, 1.778279431e-02f, 1.333521400e-02f, 9.999999776e-03f, 7.498942316e-03f,
    5.623413250e-03f, 4.216964822e-03f, 3.162277630e-03f, 2.371373819e-03f, 1.778279431e-03f, 1.333521446e-03f,
    1.000000047e-03f, 7.498941850e-04f, 5.623413017e-04f, 4.216965172e-04f, 3.162277571e-04f, 2.371373703e-04f,
    1.778279402e-04f, 1.333521504e-04f};

__device__ __forceinline__ int bidx() { int b = blockIdx.x; asm volatile("" : "+s"(b)); return b; }
__device__ __forceinline__ int gdim() { int g = gridDim.x; asm volatile("" : "+s"(g)); return g; }
__device__ __forceinline__ int tidx() { int t = threadIdx.x; asm volatile("" : "+v"(t)); return t; }
__device__ __forceinline__ unsigned cvtpk(float lo, float hi) {
  f32x2_t v = {lo, hi};
  bf16x2_t b = __builtin_convertvector(v, bf16x2_t);
  return __builtin_bit_cast(unsigned, b);
}
__device__ __forceinline__ float bf2f(unsigned short v) { return __uint_as_float(((unsigned)v) << 16); }
__device__ __forceinline__ float bflo(unsigned w) { return __uint_as_float(w << 16); }
__device__ __forceinline__ float bfhi(unsigned w) { return __uint_as_float(w & 0xffff0000u); }
__device__ __forceinline__ f32x4 mfma16(bf16x8 a, bf16x8 b, f32x4 c) {
  return __builtin_amdgcn_mfma_f32_16x16x32_bf16(a, b, c, 0, 0, 0);
}
__device__ __forceinline__ bf16x8 pack8(f32x4 a, f32x4 b) {
  u32x4 w = {cvtpk(a[0], a[1]), cvtpk(a[2], a[3]), cvtpk(b[0], b[1]), cvtpk(b[2], b[3])};
  return __builtin_bit_cast(bf16x8, w);
}
__device__ __forceinline__ float sigmoidf_(float v) { return __builtin_amdgcn_rcpf(1.0f + __builtin_amdgcn_exp2f(-LOG2E * v)); }
__device__ __forceinline__ float siluf_(float v) { return v * __builtin_amdgcn_rcpf(1.0f + __builtin_amdgcn_exp2f(-LOG2E * v)); }
__device__ __forceinline__ float grp_max4(float v) {
  auto a = __builtin_amdgcn_permlane32_swap(__float_as_uint(v), __float_as_uint(v), false, false);
  v = fmaxf(__uint_as_float(a[0]), __uint_as_float(a[1]));
  auto b = __builtin_amdgcn_permlane16_swap(__float_as_uint(v), __float_as_uint(v), false, false);
  return fmaxf(__uint_as_float(b[0]), __uint_as_float(b[1]));
}
__device__ __forceinline__ float wave_sum(float v) {
#pragma unroll
  for (int o = 1; o < 64; o <<= 1) v += __shfl_xor(v, o);
  return v;
}

#define LAS __attribute__((address_space(3)))
#define XB_TMO      128
#define XB_XCNT(j)  (256  + 64 * (j))
#define XB_XSUB(j)  (1280 + 64 * (j))
#define XB_XGEN(j)  (2304 + 64 * (j))
#define XB_TOP      3328
#define XB_TOPGEN   3392
#define XCD_BAR_WORDS 3456
#define XB_SPIN_CAP (1u << 18)

__device__ __forceinline__ unsigned xb_ld(unsigned* p)              { return __hip_atomic_load(p, __ATOMIC_RELAXED, __HIP_MEMORY_SCOPE_AGENT); }
__device__ __forceinline__ unsigned xb_add(unsigned* p, unsigned v) { return __hip_atomic_fetch_add(p, v, __ATOMIC_RELAXED, __HIP_MEMORY_SCOPE_AGENT); }
__device__ __forceinline__ unsigned xb_xcc_id() { return (unsigned)__builtin_amdgcn_s_getreg((3 << 11) | 20) & 0xFu; }
#define XB_SPIN(cond, bar) do { unsigned _sp = 0; while (cond) { __builtin_amdgcn_s_sleep(1); \
    if ((++_sp & 255u) == 0u) { if (xb_ld(&(bar)[XB_TMO])) break; if (_sp > XB_SPIN_CAP) { atomicAdd(&(bar)[XB_TMO], 1u); break; } } } } while (0)

struct XcdBarrier {
    unsigned* bar; unsigned x;
    volatile LAS unsigned* st;
};

__device__ __forceinline__ XcdBarrier xcd_barrier_post(unsigned* bar, volatile LAS unsigned* st) {
    XcdBarrier b; b.bar = bar; b.x = xb_xcc_id(); b.st = st;
    if (threadIdx.x == 0) (void)xb_add(&bar[XB_XCNT(b.x)], 1u);
    return b;
}
__device__ __forceinline__ void xcd_barrier_complete(unsigned* bar, unsigned x, unsigned& nloc, unsigned& nx) {
    const unsigned G = gridDim.x * gridDim.y * gridDim.z;
    unsigned sum, cnt, mine, sp = 0u;
    for (;;) {
        sum = 0u; cnt = 0u; mine = 0u;
#pragma unroll
        for (unsigned j = 0; j < 16; ++j) { const unsigned c = xb_ld(&bar[XB_XCNT(j)]); sum += c; cnt += (c > 0u) ? 1u : 0u; mine = (j == x) ? c : mine; }
        if (sum == G) break;
        __builtin_amdgcn_s_sleep(1);
        if ((++sp & 255u) == 0u) { if (xb_ld(&bar[XB_TMO])) break; if (sp > XB_SPIN_CAP) { atomicAdd(&bar[XB_TMO], 1u); break; } }
    }
    nloc = mine > 0u ? mine : 1u; nx = cnt > 0u ? cnt : 1u;
}

__device__ __forceinline__ void xcd_barrier(const XcdBarrier& b) {
    asm volatile("s_waitcnt vmcnt(0)" ::: "memory");
    __syncthreads();
    if (threadIdx.x == 0) {
        unsigned* bar = b.bar;
        __builtin_amdgcn_s_waitcnt(0);
        unsigned nloc = b.st[0], nx = b.st[1];
        if (nloc == 0u) { xcd_barrier_complete(bar, b.x, nloc, nx); b.st[0] = nloc; b.st[1] = nx; }
        const unsigned old = xb_add(&bar[XB_XSUB(b.x)], 1u);
        const unsigned gen = old / nloc;
        if (old + 1u == (gen + 1u) * nloc) {
            __builtin_amdgcn_fence(__ATOMIC_RELEASE, "agent");
            asm volatile("s_waitcnt vmcnt(0)" ::: "memory");
            const unsigned og = xb_add(&bar[XB_TOP], 1u);
            const unsigned tg = og / nx;
            if (og + 1u == (tg + 1u) * nx) xb_add(&bar[XB_TOPGEN], 1u);
            else XB_SPIN(xb_ld(&bar[XB_TOPGEN]) == tg, bar);
            __builtin_amdgcn_fence(__ATOMIC_ACQUIRE, "agent");
            xb_add(&bar[XB_XGEN(b.x)], 1u);
            asm volatile("s_waitcnt vmcnt(0)" ::: "memory");
        } else {
            XB_SPIN(xb_ld(&bar[XB_XGEN(b.x)]) == gen, bar);
            __builtin_amdgcn_fence(__ATOMIC_ACQUIRE, "agent");
            asm volatile("s_waitcnt vmcnt(0)" ::: "memory");
        }
    }
    __syncthreads();
}


namespace pg8 {
#define PG8_LAS __attribute__((address_space(3)))
typedef unsigned short bf16_t;
typedef short bf16x8 __attribute__((ext_vector_type(8)));
typedef float f32x4 __attribute__((ext_vector_type(4)));
typedef unsigned u32x4 __attribute__((ext_vector_type(4)));
constexpr int BM = 256, BK = 64, HALF = 128, HTB = HALF * BK * 2  , STAGE_BYTES = 8 * HTB, NXCD = 8, WGM = 8;

__host__ __device__ __forceinline__ int lds_byte(int r, int c) { const int st = (r >> 4) * 2 + (c >> 5), rr = r & 15, cc = c & 31, ob = rr * 64 + cc * 2; return st * 1024 + (ob ^ (((ob >> 9) & 1) << 5)); }
__host__ __device__ __forceinline__ void stage_rc(int b, int& R, int& C) { const int st = b / 1024, sb = b % 1024, swz = sb ^ (((sb >> 9) & 1) << 5); R = (st >> 1) * 16 + swz / 64; C = (st & 1) * 32 + (swz % 64) / 2; }
__host__ __device__ __forceinline__ int perm32(int rho) { const int n = rho >> 4, i = rho & 15; return 8 * (i >> 2) + 4 * n + (i & 3); }

struct Unit { int pm, pn, z; };
struct Gemm { const bf16_t* A; const bf16_t* Bt; int M, N, K; size_t zA, zB; };

struct StaticOrder {
    int nM, nN, nwg, G, c;
    __host__ __device__ void init(int M, int N, int G_, int c_) { nM = M / BM; nN = N / BM; nwg = nM * nN; G = G_; c = c_; }
    __host__ __device__ bool next(int i, Unit& u) const {
        const long L = (long)i * G + c; if (L >= nwg) return false;
        int wgid = (int)L; { const int q = nwg / NXCD, r = nwg % NXCD, xcd = wgid % NXCD, off = wgid / NXCD; wgid = (xcd < r ? xcd * (q + 1) : r * (q + 1) + (xcd - r) * q) + off; }
        const int nig = WGM * nN, gid = wgid / nig, fm = gid * WGM, gsz = (nM - fm) < WGM ? (nM - fm) : WGM;
        u.pm = fm + ((wgid % nig) % gsz); u.pn = (wgid % nig) / gsz; u.z = 0; return true;
    }
    __device__ __forceinline__ void a_ready(const Unit&) const {}
    __device__ __forceinline__ void done(const Unit&) const {}
};
__device__ __forceinline__ unsigned cvt_pk_bf16(float lo, float hi) { unsigned r; asm volatile("v_cvt_pk_bf16_f32 %0, %1, %2" : "=v"(r) : "v"(lo), "v"(hi)); return r; }
template <class Epi, class Sched, bool ALIGN_EPI = false, bool SP2 = false>
__device__ __forceinline__ void gemm_phase(PG8_LAS unsigned char* lds, const Gemm g, const Sched& S, const Epi& E) {
    const int tid = tidx(), wid = __builtin_amdgcn_readfirstlane(tid >> 6), lane = tid & 63, wr = wid >> 2, wc = wid & 3, fr = lane & 15, fq = lane >> 4;
    const int K = g.K, nt = K / BK;
    unsigned voffA[2], voffB[2];
#pragma unroll
    for (int i = 0; i < 2; ++i) { int R, C; stage_rc(tid * 16 + i * 8192, R, C); const int Rb = Epi::PERM ? ((R & ~31) + perm32(R & 31)) : R;
        voffA[i] = (unsigned)(R * K + C) * 2u; voffB[i] = (unsigned)(Rb * K + C) * 2u; }
    const size_t kstep = (size_t)(BK * 2);
    const size_t hstep = (size_t)HALF * K * 2;
    const size_t tstep = 2 * hstep;
    const unsigned ldsw = (unsigned)wid * 1024u;
    const int aoff = lds_byte(wr * 64 + fr, fq * 8), boff = lds_byte(wc * 32 + fr, fq * 8);
#define PG8_SA(b, h) (((b) * 2 + (h)) * HTB)
#define PG8_SB(b, h) ((4 + (b) * 2 + (h)) * HTB)
#define PG8_STAGE(bufoff, gbase, voff) do { _Pragma("unroll") for (int _i = 0; _i < 2; ++_i) \
        __builtin_amdgcn_global_load_lds((const unsigned*)((const char*)(gbase) + (voff)[_i]), (PG8_LAS unsigned*)(lds + (bufoff) + ldsw + _i * 8192), 16, 0, 0); } while (0)
#define PG8_LDA(dst, b, h) do { _Pragma("unroll") for (int m = 0; m < 4; ++m) _Pragma("unroll") for (int k = 0; k < 2; ++k) dst[m][k] = *(const PG8_LAS bf16x8*)(lds + PG8_SA(b, h) + aoff + m * 2048 + k * 1024); } while (0)
#define PG8_LDB(dst, b, h) do { _Pragma("unroll") for (int n = 0; n < 2; ++n) _Pragma("unroll") for (int k = 0; k < 2; ++k) dst[n][k] = *(const PG8_LAS bf16x8*)(lds + PG8_SB(b, h) + boff + n * 2048 + k * 1024); } while (0)
#define PG8_MMA(ai, bj, At, Bt) do { __builtin_amdgcn_s_setprio(1); _Pragma("unroll") for (int m = 0; m < 4; ++m) _Pragma("unroll") for (int n = 0; n < 2; ++n) _Pragma("unroll") for (int k = 0; k < 2; ++k) \
        acc[ai][bj][m][n] = __builtin_amdgcn_mfma_f32_16x16x32_bf16(Bt[n][k], At[m][k], acc[ai][bj][m][n], 0, 0, 0); __builtin_amdgcn_s_setprio(0); } while (0)
#define PG8_WAIT_V(n) asm volatile("s_waitcnt vmcnt(" #n ")" ::: "memory")
#define PG8_WAIT_L(n) asm volatile("s_waitcnt lgkmcnt(" #n ")" ::: "memory")
#define PG8_BAR __builtin_amdgcn_s_barrier()
#define PG8_SCHED __builtin_amdgcn_sched_barrier(0)
    Unit cur, nxt; int ui = 0;
    if (!S.next(0, cur)) return;
    f32x4 acc[2][2][4][2];
#pragma unroll
    for (int a = 0; a < 2; ++a)
#pragma unroll
        for (int b = 0; b < 2; ++b)
#pragma unroll
            for (int m = 0; m < 4; ++m)
#pragma unroll
                for (int n = 0; n < 2; ++n) acc[a][b][m][n] = (f32x4){0.f, 0.f, 0.f, 0.f};
    bf16x8 At[4][2], B0[2][2], B1[2][2];
    const char* cA = (const char*)g.A + (size_t)cur.pm * tstep + (size_t)cur.z * g.zA; const char* cB = (const char*)g.Bt + (size_t)cur.pn * tstep + (size_t)cur.z * g.zB;
    S.a_ready(cur);
    if constexpr (SP2) {
        PG8_STAGE(PG8_SB(0, 0), cB, voffB); PG8_STAGE(PG8_SB(0, 1), cB + hstep, voffB); PG8_STAGE(PG8_SA(0, 0), cA, voffA); PG8_STAGE(PG8_SA(0, 1), cA + hstep, voffA);
        if (wr == 1) PG8_BAR;
        PG8_WAIT_V(2); PG8_BAR;
        PG8_STAGE(PG8_SB(1, 0), cB + kstep, voffB); PG8_STAGE(PG8_SA(1, 0), cA + kstep, voffA); PG8_STAGE(PG8_SB(1, 1), cB + hstep + kstep, voffB);
        PG8_WAIT_V(6); PG8_BAR;
    } else {
        PG8_STAGE(PG8_SB(0, 0), cB, voffB); PG8_STAGE(PG8_SA(0, 0), cA, voffA); PG8_STAGE(PG8_SB(0, 1), cB + hstep, voffB); PG8_STAGE(PG8_SA(0, 1), cA + hstep, voffA);
        if (wr == 1) PG8_BAR;
        PG8_WAIT_V(4); PG8_BAR;
        PG8_STAGE(PG8_SB(1, 0), cB + kstep, voffB); PG8_STAGE(PG8_SA(1, 0), cA + kstep, voffA); PG8_STAGE(PG8_SB(1, 1), cB + hstep + kstep, voffB);
        PG8_WAIT_V(6); PG8_BAR;
    }
    for (;;) {
        const bool has_next = S.next(ui + 1, nxt);
        const char* nA = has_next ? (const char*)g.A + (size_t)nxt.pm * tstep + (size_t)nxt.z * g.zA : cA; const char* nB = has_next ? (const char*)g.Bt + (size_t)nxt.pn * tstep + (size_t)nxt.z * g.zB : cB;
        for (int t = 0; t < nt; t += 2) {
            const bool last = (t == nt - 2);
            const char* a1 = cA + (size_t)(t + 1) * kstep;
            const char* a2 = last ? nA : cA + (size_t)(t + 2) * kstep; const char* b2 = last ? nB : cB + (size_t)(t + 2) * kstep;
            const char* a3 = a2 + kstep; const char* b3 = b2 + kstep;
            if (last && has_next) S.a_ready(nxt);
            if constexpr (SP2) {
            PG8_LDB(B0, 0, 0); PG8_LDB(B1, 0, 1); PG8_SCHED; PG8_LDA(At, 0, 0); PG8_STAGE(PG8_SA(1, 1), a1 + hstep, voffA);
            PG8_WAIT_V(8); PG8_WAIT_L(0); PG8_BAR; PG8_MMA(0, 0, At, B0); PG8_MMA(0, 1, At, B1); PG8_BAR; PG8_SCHED;
            PG8_LDA(At, 0, 1); PG8_STAGE(PG8_SB(0, 0), b2, voffB); PG8_STAGE(PG8_SB(0, 1), b2 + hstep, voffB); PG8_STAGE(PG8_SA(0, 0), a2, voffA);
            PG8_WAIT_V(8); PG8_WAIT_L(0); PG8_BAR; PG8_MMA(1, 0, At, B0); PG8_MMA(1, 1, At, B1); PG8_BAR; PG8_SCHED;
            PG8_LDB(B0, 1, 0); PG8_LDB(B1, 1, 1); PG8_SCHED; PG8_LDA(At, 1, 0); PG8_STAGE(PG8_SA(0, 1), a2 + hstep, voffA);
            PG8_WAIT_V(8); PG8_WAIT_L(0); PG8_BAR; PG8_MMA(0, 0, At, B0); PG8_MMA(0, 1, At, B1); PG8_BAR; PG8_SCHED;
            PG8_LDA(At, 1, 1); PG8_STAGE(PG8_SB(1, 0), b3, voffB); PG8_STAGE(PG8_SB(1, 1), b3 + hstep, voffB); PG8_STAGE(PG8_SA(1, 0), a3, voffA);
            PG8_WAIT_V(8); PG8_WAIT_L(0); PG8_BAR; PG8_MMA(1, 0, At, B0); PG8_MMA(1, 1, At, B1); PG8_BAR; PG8_SCHED;
            } else {
            PG8_LDB(B0, 0, 0); PG8_SCHED; PG8_LDA(At, 0, 0); PG8_STAGE(PG8_SA(1, 1), a1 + hstep, voffA);
            PG8_WAIT_L(8); PG8_BAR; PG8_WAIT_L(0); PG8_MMA(0, 0, At, B0); PG8_BAR; PG8_SCHED;
            PG8_LDB(B1, 0, 1); PG8_STAGE(PG8_SB(0, 0), b2, voffB);
            PG8_BAR; PG8_WAIT_L(0); PG8_MMA(0, 1, At, B1); PG8_BAR;
            PG8_LDA(At, 0, 1); PG8_STAGE(PG8_SA(0, 0), a2, voffA);
            PG8_BAR; PG8_WAIT_L(0); PG8_MMA(1, 0, At, B0); PG8_BAR; PG8_SCHED;
            PG8_STAGE(PG8_SB(0, 1), b2 + hstep, voffB);
            PG8_WAIT_V(6); PG8_BAR; PG8_MMA(1, 1, At, B1); PG8_BAR;
            PG8_LDB(B0, 1, 0); PG8_SCHED; PG8_LDA(At, 1, 0); PG8_STAGE(PG8_SA(0, 1), a2 + hstep, voffA);
            PG8_WAIT_L(8); PG8_BAR; PG8_WAIT_L(0); PG8_MMA(0, 0, At, B0); PG8_BAR; PG8_SCHED;
            PG8_LDB(B1, 1, 1); PG8_STAGE(PG8_SB(1, 0), b3, voffB);
            PG8_BAR; PG8_WAIT_L(0); PG8_MMA(0, 1, At, B1); PG8_BAR;
            PG8_LDA(At, 1, 1); PG8_STAGE(PG8_SA(1, 0), a3, voffA);
            PG8_BAR; PG8_WAIT_L(0); PG8_MMA(1, 0, At, B0); PG8_BAR; PG8_SCHED;
            PG8_STAGE(PG8_SB(1, 1), b3 + hstep, voffB);
            PG8_WAIT_V(6); PG8_BAR; PG8_MMA(1, 1, At, B1); PG8_BAR;
            }
        }
        if constexpr (ALIGN_EPI) { if (wr == 0) PG8_BAR; }
        if constexpr (!Epi::AFTER_DRAIN) { E(acc, cur, wr, wc, fr, fq); S.done(cur); }
        if (!has_next) break;
#pragma unroll
        for (int a = 0; a < 2; ++a)
#pragma unroll
            for (int b = 0; b < 2; ++b)
#pragma unroll
                for (int m = 0; m < 4; ++m)
#pragma unroll
                    for (int n = 0; n < 2; ++n) acc[a][b][m][n] = (f32x4){0.f, 0.f, 0.f, 0.f};
        cur = nxt; cA = nA; cB = nB; ++ui;
        if constexpr (ALIGN_EPI) { if (wr == 1) PG8_BAR; }
    }
    PG8_WAIT_V(0);
    if constexpr (!ALIGN_EPI) { if (wr == 0) PG8_BAR; }
    PG8_BAR;
    if constexpr (Epi::AFTER_DRAIN) { E.fused(acc, cur, wr, wc, fr, fq, lds, wid, lane); S.done(cur); }
#undef PG8_SA
#undef PG8_SB
#undef PG8_STAGE
#undef PG8_LDA
#undef PG8_LDB
#undef PG8_MMA
#undef PG8_WAIT_V
#undef PG8_WAIT_L
#undef PG8_BAR
#undef PG8_SCHED
}
}

struct EpiIn {
  static constexpr bool PERM = false, AFTER_DRAIN = false;
  const Params* pp; int l;
  __device__ __forceinline__ void operator()(f32x4 (&acc)[2][2][4][2], const pg8::Unit& u, int wr, int wc, int fr, int fq) const {
    kparams_t kp_ = kparams(); (void)kp_;
    const int U = u.pn * 4 + wc;
    if (U >= 77) return;
    const int rowb = u.pm * 256 + wr * 64 + fr;
    const int bq = (u.pm * 256) / T, tb = rowb % T;
    bf16_t* dst = nullptr; int ld = 0, col0 = 0; const float* gain = nullptr; bool rope = false, silu = false;
    float post = 1.0f;
    bf16_t* vt = nullptr;
    if (U < 8) { dst = WSP(bf16_t, OFF_QN); ld = 512; col0 = U * 64; gain = kp_->nsa_q_norm + l * 64; rope = true; post = 0.125f * LOG2E; }
    else if (U < 10) { dst = WSP(bf16_t, OFF_KC); ld = 128; col0 = (U - 8) * 64; rope = true; }
    else if (U < 12) { dst = WSP(bf16_t, OFF_VC); ld = 128; col0 = (U - 10) * 64; }
    else if (U < 14) { dst = WSP(bf16_t, OFF_KS); ld = 128; col0 = (U - 12) * 64; gain = kp_->nsa_k_norm + (l * 3 + 1) * 64; rope = true; }
    else if (U < 16) { vt = WSP(bf16_t, OFF_VST) + (size_t)((bq * 2 + (U - 14)) * 64) * T; }
    else if (U < 18) { dst = WSP(bf16_t, OFF_KW); ld = 128; col0 = (U - 16) * 64; gain = kp_->nsa_k_norm + (l * 3 + 2) * 64; rope = true; }
    else if (U < 20) { vt = WSP(bf16_t, OFF_VWT) + (size_t)((bq * 2 + (U - 18)) * 64) * T; }
    else if (U < 28) { dst = WSP(bf16_t, OFF_OA); ld = 512; col0 = (U - 20) * 64; silu = true; }
    else if (U < 36) { dst = WSP(bf16_t, OFF_FQ); ld = 512; col0 = (U - 28) * 64; gain = kp_->fox_q_norm + l * 64; post = 0.125f * LOG2E; }
    else if (U < 44) { dst = WSP(bf16_t, OFF_FK); ld = 512; col0 = (U - 36) * 64; gain = kp_->fox_k_norm + l * 64; }
    else if (U < 52) { vt = WSP(bf16_t, OFF_FVT) + (size_t)((bq * 8 + (U - 44)) * 64) * T; }
    else if (U < 60) { dst = WSP(bf16_t, OFF_OB); ld = 512; col0 = (U - 52) * 64; silu = true; }
    else if (U < 68) { dst = WSP(bf16_t, OFF_MQ); ld = 512; col0 = (U - 60) * 64; }
    else if (U < 76) { dst = WSP(bf16_t, OFF_OM); ld = 512; col0 = (U - 68) * 64; silu = true; }
    if (U == 76) {
      float* gate = WSP(float, OFF_GATE);
      float* flog = WSP(float, OFF_FLOG);
#pragma unroll
      for (int ai = 0; ai < 2; ++ai)
#pragma unroll
        for (int m = 0; m < 4; ++m) {
          const size_t row = (size_t)rowb + 128 * ai + 16 * m;
#pragma unroll
          for (int n = 0; n < 2; ++n)
#pragma unroll
            for (int i = 0; i < 4; ++i) {
              const int e = 16 * n + 4 * fq + i;
              const float v = acc[ai][0][m][n][i];
              if (e < 24) gate[row * 24 + e] = sigmoidf_(v);
              else {
                const float xx = v + kp_->fox_f_bias[l * 8 + (e - 24)];
                flog[row * 8 + (e - 24)] = xx >= 0.f ? -log1pf(expf(-xx)) : xx - log1pf(expf(xx));
              }
            }
        }
      return;
    }
    if (vt) {
#pragma unroll
      for (int ai = 0; ai < 2; ++ai)
#pragma unroll
        for (int m = 0; m < 4; ++m) {
          const int t = tb + 128 * ai + 16 * m;
#pragma unroll
          for (int bj = 0; bj < 2; ++bj)
#pragma unroll
            for (int n = 0; n < 2; ++n) {
              const f32x4 v = acc[ai][bj][m][n];
              const unsigned w0 = cvtpk(v[0], v[1]), w1 = cvtpk(v[2], v[3]);
              const unsigned qo = (unsigned)((32 * bj + 16 * n + 4 * fq) * T + t);
              vt[qo] = (bf16_t)(w0 & 0xffffu); vt[qo + T] = (bf16_t)(w0 >> 16); vt[qo + 2 * T] = (bf16_t)(w1 & 0xffffu); vt[qo + 3 * T] = (bf16_t)(w1 >> 16);
            }
        }
      return;
    }
    const float* ropetab = WSP(float, OFF_ROPE);
    f32x4 gv[2][2];
    if (gain) {
#pragma unroll
      for (int bj = 0; bj < 2; ++bj)
#pragma unroll
        for (int n = 0; n < 2; ++n) gv[bj][n] = *(const f32x4*)(gain + 32 * bj + 16 * n + 4 * fq);
    }
#pragma unroll
    for (int ai = 0; ai < 2; ++ai)
#pragma unroll
      for (int m = 0; m < 4; ++m) {
        f32x4 v[2][2];
#pragma unroll
        for (int bj = 0; bj < 2; ++bj)
#pragma unroll
          for (int n = 0; n < 2; ++n) v[bj][n] = acc[ai][bj][m][n];
        const int row = rowb + 128 * ai + 16 * m;
        if (gain) {
          float ss = 0.f;
#pragma unroll
          for (int bj = 0; bj < 2; ++bj)
#pragma unroll
            for (int n = 0; n < 2; ++n)
#pragma unroll
              for (int i = 0; i < 4; ++i) ss += v[bj][n][i] * v[bj][n][i];
          ss += __shfl_xor(ss, 16);
          ss += __shfl_xor(ss, 32);
          const float rstd = rsqrtf(ss * (1.0f / 64.0f) + EPS);
#pragma unroll
          for (int bj = 0; bj < 2; ++bj)
#pragma unroll
            for (int n = 0; n < 2; ++n) v[bj][n] = v[bj][n] * rstd * gv[bj][n];
        }
        if (rope) {
          const int pos = row & (T - 1);
#pragma unroll
          for (int n = 0; n < 2; ++n) {
            const f32x4* tp = (const f32x4*)(ropetab + ((size_t)pos * 32 + 16 * n + 4 * fq) * 2);
            const f32x4 t0 = tp[0], t1 = tp[1];
            const float cs[4] = {t0[0], t0[2], t1[0], t1[2]}, sn[4] = {t0[1], t0[3], t1[1], t1[3]};
#pragma unroll
            for (int i = 0; i < 4; ++i) {
              const float y1 = v[0][n][i], y2 = v[1][n][i];
              v[0][n][i] = y1 * cs[i] - y2 * sn[i];
              v[1][n][i] = y2 * cs[i] + y1 * sn[i];
            }
          }
        }
#pragma unroll
        for (int bj = 0; bj < 2; ++bj)
#pragma unroll
          for (int n = 0; n < 2; ++n) {
            f32x4 y = v[bj][n] * post;
            if (silu) {
#pragma unroll
              for (int i = 0; i < 4; ++i) y[i] = siluf_(y[i]);
            }
            u32x2 w = {cvtpk(y[0], y[1]), cvtpk(y[2], y[3])};
            *(u32x2*)(dst + (size_t)row * ld + col0 + 32 * bj + 16 * n + 4 * fq) = w;
          }
      }
  }
};
struct EpiMemKV {
  static constexpr bool PERM = false, AFTER_DRAIN = false;
  const Params* pp;
  __device__ __forceinline__ void operator()(f32x4 (&acc)[2][2][4][2], const pg8::Unit& u, int wr, int wc, int fr, int fq) const {
    kparams_t kp_ = kparams(); (void)kp_;
    const int U = u.pn * 4 + wc;
    const int rowb = u.pm * 256 + wr * 64 + fr;
#pragma unroll
    for (int ai = 0; ai < 2; ++ai)
#pragma unroll
      for (int m = 0; m < 4; ++m) {
        const int row = rowb + 128 * ai + 16 * m;
#pragma unroll
        for (int bj = 0; bj < 2; ++bj)
#pragma unroll
          for (int n = 0; n < 2; ++n) {
            const f32x4 v = acc[ai][bj][m][n];
            const unsigned w0 = cvtpk(v[0], v[1]), w1 = cvtpk(v[2], v[3]);
            const int e = 32 * bj + 16 * n + 4 * fq;
            if (U < 8) {
              u32x2 w = {w0, w1};
              *(u32x2*)(WSP(bf16_t, OFF_MK) + (size_t)row * 512 + U * 64 + e) = w;
            } else {
              const int col = (U - 8) * 64 + e, h = col >> 7, d = col & 127, b = row >> 8, mm = row & 255;
              bf16_t* q = WSP(bf16_t, OFF_MVT) + (size_t)((b * 4 + h) * 128 + d) * 256 + mm;
              q[0] = (bf16_t)(w0 & 0xffffu); q[256] = (bf16_t)(w0 >> 16); q[512] = (bf16_t)(w1 & 0xffffu); q[768] = (bf16_t)(w1 >> 16);
            }
          }
      }
  }
};
struct ZOrder3 {
  pg8::StaticOrder base;
  __device__ bool next(int i, pg8::Unit& u) const { if (!base.next(i / 3, u)) return false; u.z = i % 3; return true; }
  __device__ __forceinline__ void a_ready(const pg8::Unit&) const {}
  __device__ __forceinline__ void done(const pg8::Unit&) const {}
};
struct EpiGate {
  static constexpr bool PERM = true, AFTER_DRAIN = false;
  bf16_t* G;
  __device__ __forceinline__ void operator()(f32x4 (&acc)[2][2][4][2], const pg8::Unit& u, int wr, int wc, int fr, int fq) const {
    const int br = u.z, colt = u.pn * 256 + wc * 32 + 8 * fq;
    bf16_t* base = G + (size_t)br * M * 1024;
    const int rowb = u.pm * 256 + wr * 64 + fr;
#pragma unroll
    for (int ai = 0; ai < 2; ++ai)
#pragma unroll
      for (int m = 0; m < 4; ++m) {
        bf16_t* rp = base + (size_t)(rowb + 128 * ai + 16 * m) * 1024 + colt;
#pragma unroll
        for (int bj = 0; bj < 2; ++bj) {
          const f32x4 v0 = acc[ai][bj][m][0], v1 = acc[ai][bj][m][1];
          u32x4 w = {cvtpk(sigmoidf_(v0[0]), sigmoidf_(v0[1])), cvtpk(sigmoidf_(v0[2]), sigmoidf_(v0[3])),
                     cvtpk(sigmoidf_(v1[0]), sigmoidf_(v1[1])), cvtpk(sigmoidf_(v1[2]), sigmoidf_(v1[3]))};
          *(u32x4*)(rp + 128 * bj) = w;
        }
      }
  }
};
struct EpiBranch {
  static constexpr bool PERM = true, AFTER_DRAIN = false;
  const bf16_t* G; bf16_t* Uo; int first;
  __device__ __forceinline__ void operator()(f32x4 (&acc)[2][2][4][2], const pg8::Unit& u, int wr, int wc, int fr, int fq) const {
    const int colt = u.pn * 256 + wc * 32 + 8 * fq;
    const int rowb = u.pm * 256 + wr * 64 + fr;
#pragma unroll
    for (int ai = 0; ai < 2; ++ai)
#pragma unroll
      for (int m = 0; m < 4; ++m) {
        const size_t ro = (size_t)(rowb + 128 * ai + 16 * m) * 1024 + colt;
#pragma unroll
        for (int bj = 0; bj < 2; ++bj) {
          const size_t off = ro + 128 * bj;
          const u32x4 gw = *(const u32x4*)(G + off);
          float y[8];
#pragma unroll
          for (int q = 0; q < 4; ++q) {
            const f32x4 v = acc[ai][bj][m][q >> 1];
            y[2 * q] = v[(2 * q) & 3] * bflo(gw[q]);
            y[2 * q + 1] = v[(2 * q + 1) & 3] * bfhi(gw[q]);
          }
          if (!first) {
            const u32x4 uw = *(const u32x4*)(Uo + off);
#pragma unroll
            for (int q = 0; q < 4; ++q) { y[2 * q] += bflo(uw[q]); y[2 * q + 1] += bfhi(uw[q]); }
          }
          u32x4 w = {cvtpk(y[0], y[1]), cvtpk(y[2], y[3]), cvtpk(y[4], y[5]), cvtpk(y[6], y[7])};
          *(u32x4*)(Uo + off) = w;
        }
      }
  }
};
struct EpiOut {
  static constexpr bool PERM = true, AFTER_DRAIN = false;
  const float* xin; float* xout;
  __device__ __forceinline__ void operator()(f32x4 (&acc)[2][2][4][2], const pg8::Unit& u, int wr, int wc, int fr, int fq) const {
    const int colt = u.pn * 256 + wc * 32 + 8 * fq;
    const int rowb = u.pm * 256 + wr * 64 + fr;
#pragma unroll
    for (int ai = 0; ai < 2; ++ai)
#pragma unroll
      for (int m = 0; m < 4; ++m) {
        const size_t ro = (size_t)(rowb + 128 * ai + 16 * m) * 1024 + colt;
#pragma unroll
        for (int bj = 0; bj < 2; ++bj) {
          const size_t off = ro + 128 * bj;
          const f32x4 x0 = *(const f32x4*)(xin + off), x1 = *(const f32x4*)(xin + off + 4);
          *(f32x4*)(xout + off) = x0 + acc[ai][bj][m][0];
          *(f32x4*)(xout + off + 4) = x1 + acc[ai][bj][m][1];
        }
      }
  }
};
template <class Epi>
__device__ __forceinline__ void run_gemm(PG8_LAS unsigned char* lds, const bf16_t* A, const bf16_t* Bt, int Mr, int Nc, int K, const Epi& E) {
  pg8::Gemm g{A, Bt, Mr, Nc, K, 0, 0};
  pg8::StaticOrder S;
  S.init(Mr, Nc, gdim(), bidx());
  pg8::gemm_phase<Epi, pg8::StaticOrder, true, true>(lds, g, S, E);
}

__device__ __forceinline__ int map_in(int n) {
  const int i = n >> 6, c = n & 63;
  if (i < 20) return n;
  if (i < 28) return 1304 + (n - 1280);
  if (i < 52) return 1816 + (n - 1792);
  if (i < 60) return 3360 + (n - 3328);
  if (i < 68) return 3872 + (n - 3840);
  if (i < 76) return 4384 + (n - 4352);
  if (i == 76) return c < 24 ? 1280 + c : (c < 32 ? 3352 + (c - 24) : -1);
  return -1;
}
__device__ __forceinline__ void wave_transpose_tile(const float* __restrict__ src, int ld_src, int k0, int n0, bf16_t* __restrict__ dst,
                                                    int Kdim, int maptype, int srccol0, float* tile, int lane) {
  int nlog = n0 + lane;
  if (maptype) { const int w = nlog & 255; nlog = (nlog & ~255) + (((w & 127) >> 5) << 6) + (((w >> 7) << 5) | (w & 31)); }
  const int sc = (maptype == 1) ? map_in(nlog) : srccol0 + nlog;
  const float* sp = src + (size_t)k0 * ld_src + (sc >= 0 ? sc : 0);
#pragma unroll 32
  for (int kk = 0; kk < 64; ++kk) {
    const float v = sp[(size_t)kk * ld_src];
    tile[kk * 65 + lane] = sc >= 0 ? v : 0.f;
  }
  __builtin_amdgcn_fence(__ATOMIC_SEQ_CST, "workgroup");
  __builtin_amdgcn_wave_barrier();
  const int rsub = lane >> 5, kp = lane & 31;
#pragma unroll 8
  for (int it = 0; it < 32; ++it) {
    const int row = 2 * it + rsub;
    const float a = tile[(2 * kp) * 65 + row], b = tile[(2 * kp + 1) * 65 + row];
    *(unsigned*)(dst + (size_t)(n0 + row) * Kdim + k0 + 2 * kp) = cvtpk(a, b);
  }
  __builtin_amdgcn_fence(__ATOMIC_SEQ_CST, "workgroup");
  __builtin_amdgcn_wave_barrier();
}
__device__ __forceinline__ void rmsnorm4(const float* __restrict__ x, const float* __restrict__ gain, bf16_t* __restrict__ dst, size_t row0, int lane) {
  f32x4 v[4][4];
  float ss[4];
#pragma unroll
  for (int rr = 0; rr < 4; ++rr)
#pragma unroll
    for (int i = 0; i < 4; ++i) v[rr][i] = *(const f32x4*)(x + (row0 + rr) * 1024 + lane * 4 + 256 * i);
  f32x4 gv[4];
#pragma unroll
  for (int i = 0; i < 4; ++i) gv[i] = *(const f32x4*)(gain + lane * 4 + 256 * i);
#pragma unroll
  for (int rr = 0; rr < 4; ++rr) {
    float s = 0.f;
#pragma unroll
    for (int i = 0; i < 4; ++i) s += v[rr][i][0] * v[rr][i][0] + v[rr][i][1] * v[rr][i][1] + v[rr][i][2] * v[rr][i][2] + v[rr][i][3] * v[rr][i][3];
    ss[rr] = s;
  }
#pragma unroll
  for (int o_ = 1; o_ < 64; o_ <<= 1) {
#pragma unroll
    for (int rr = 0; rr < 4; ++rr) ss[rr] += __shfl_xor(ss[rr], o_);
  }
#pragma unroll
  for (int rr = 0; rr < 4; ++rr) {
    const float rstd = rsqrtf(ss[rr] * (1.0f / 1024.0f) + EPS);
#pragma unroll
    for (int i = 0; i < 4; ++i) {
      const f32x4 y = v[rr][i] * rstd * gv[i];
      u32x2 w = {cvtpk(y[0], y[1]), cvtpk(y[2], y[3])};
      *(u32x2*)(dst + (row0 + rr) * 1024 + lane * 4 + 256 * i) = w;
    }
  }
}
__device__ __forceinline__ void phase_prep(const Params& p, int l, float* smem) {
  kparams_t kp_ = kparams(); (void)kp_;
  const int tid = tidx();
  const int wave = tid >> 6, lane = tid & 63;
  const int gw = wave * gdim() + bidx(), nw = NWAVES * gdim();
  if (l == 0 && bidx() == 0 && tid < 64) WSP(unsigned, OFF_CTL)[tid] = 0u;
  const float* xin = (l == 0) ? kp_->x : kp_->out;
  float* wtile = smem + wave * 4160;
  for (int u0 = gw; u0 < 3076; u0 += nw) {
    int u = u0;
    const float* src; int ld, kt, nt, Kd, mt = 0, c0 = 0; bf16_t* dst;
    if (u < 1280) { kt = u / 80; nt = u % 80; src = kp_->w_in + (size_t)l * 1024 * 7968; ld = 7968; Kd = 1024; dst = WSP(bf16_t, OFF_W_IN); mt = 1; }
    else if ((u -= 1280) < 768) { kt = u / 48; nt = u % 48; src = kp_->w_in + (size_t)l * 1024 * 7968; ld = 7968; Kd = 1024; dst = WSP(bf16_t, OFF_W_G); c0 = 4896; }
    else if ((u -= 768) < 256) { kt = u / 16; nt = u % 16; src = kp_->w_mem_kv + (size_t)l * 1024 * 1024; ld = 1024; Kd = 1024; dst = WSP(bf16_t, OFF_W_MKV); mt = 2; }
    else if ((u -= 256) < 384) { const int br = u / 128, uu = u % 128; kt = uu / 16; nt = uu % 16;
      src = (br == 0 ? kp_->w_branch_a : br == 1 ? kp_->w_branch_b : kp_->w_branch_m) + (size_t)l * 512 * 1024; ld = 1024; Kd = 512; dst = WSP(bf16_t, OFF_W_BR + (size_t)br * MiB); }
    else if ((u -= 384) < 256) { kt = u / 16; nt = u % 16; src = kp_->w_out + (size_t)l * 1024 * 1024; ld = 1024; Kd = 1024; dst = WSP(bf16_t, OFF_W_OUT); }
    else if ((u -= 256) < 128) { const int kv = u / 64, uu = u % 64; kt = uu / 2; nt = uu % 2;
      src = (kv ? kp_->cmp_w1_v : kp_->cmp_w1_k) + (size_t)l * 2048 * 128; ld = 128; Kd = 2048; dst = WSP(bf16_t, OFF_W1 + (size_t)kv * 512 * 1024); }
    else { u -= 128; const int kv = u / 2; kt = u % 2; nt = 0;
      src = (kv ? kp_->cmp_w2_v : kp_->cmp_w2_k) + (size_t)l * 128 * 64; ld = 64; Kd = 128; dst = WSP(bf16_t, OFF_W2 + (size_t)kv * 64 * 1024); }
    wave_transpose_tile(src, ld, kt * 64, nt * 64, dst, Kd, mt, c0, wtile, lane);
  }
  for (int grp = gw; grp < 8192 + 256; grp += nw) {
    if (grp < 8192) rmsnorm4(xin, kp_->norm_g + l * 1024, WSP(bf16_t, OFF_H), (size_t)grp * 4, lane);
    else rmsnorm4(kp_->mem, kp_->mem_norm_g + l * 1024, WSP(bf16_t, OFF_MEMN), (size_t)(grp - 8192) * 4, lane);
  }
  for (int u = gw; u < 32; u += nw) {
    const int kv = u >> 4, ch = u & 15;
    const float* pe = (kv ? kp_->cmp_pe_v : kp_->cmp_pe_k) + (size_t)l * 2048 + ch * 128;
    const float* w1 = (kv ? kp_->cmp_w1_v : kp_->cmp_w1_k) + (size_t)l * 2048 * 128 + (size_t)ch * 128 * 128;
    float s0 = 0.f, s1 = 0.f;
#pragma unroll 32
    for (int kk = 0; kk < 128; ++kk) {
      const float pv = pe[kk];
      s0 += pv * w1[(size_t)kk * 128 + lane];
      s1 += pv * w1[(size_t)kk * 128 + 64 + lane];
    }
    float* part = WSP(float, OFF_C1) + (size_t)(kv * 16 + ch) * 128;
    part[lane] = s0;
    part[64 + lane] = s1;
  }
  if (l == 0) {
    for (int u = bidx(); u < 512; u += gdim()) {
      for (int e = tid; e < 512; e += NTHREADS) {
        const int idx = u * 512 + e, pos = idx >> 5, f = idx & 31;
        const float ang = (float)pos * c_inv_freq[f];
        const double a = (double)ang;
        const double k = rint(a * 0.15915494309189535);
        const float rr = (float)(a - k * 6.283185307179586);
        float2 cs; cs.x = __cosf(rr); cs.y = __sinf(rr);
        WSP(float2, OFF_ROPE)[idx] = cs;
      }
    }
  }
}

__device__ __forceinline__ void compress_wg(const Params& p, int l, int up, float* smem) {
  kparams_t kp_ = kparams(); (void)kp_;
  const int wave_ = tidx() >> 6, kc = wave_ & 3, u = up * 2 + (wave_ >> 2);
  const int lane = tidx() & 63, r = lane & 15, g4 = lane >> 4;
  const int kv = u >> 7, rem = u & 127, b = rem >> 5, grp = (rem >> 4) & 1, it = rem & 15, i0 = it * 32;
  const bf16_t* src = WSP(bf16_t, kv ? OFF_VC : OFF_KC);
  const bf16_t* w1t = WSP(bf16_t, OFF_W1 + (size_t)kv * 512 * 1024);
  const bf16_t* w2t = WSP(bf16_t, OFF_W2 + (size_t)kv * 64 * 1024);
  const float* c1 = WSP(float, OFF_C1 + 16384) + kv * 128;
  const bf16_t* arow[2];
#pragma unroll
  for (int mt = 0; mt < 2; ++mt) {
    int i = i0 + 16 * mt + r;
    if (i > 510) i = 510;
    arow[mt] = src + ((size_t)b * T + 16 * i) * 128 + grp * 64 + g4 * 8;
  }
  f32x4 acc[2][8];
#pragma unroll
  for (int a = 0; a < 2; ++a)
#pragma unroll
    for (int c = 0; c < 8; ++c) acc[a][c] = (f32x4){0.f, 0.f, 0.f, 0.f};
  const bf16_t* bp = w1t + (size_t)r * 2048 + g4 * 8;
#pragma unroll 1
  for (int k0 = kc * 512; k0 < kc * 512 + 512; k0 += 32) {
    const int pp = k0 >> 6, d = k0 & 63;
    bf16x8 af[2], bf[8];
#pragma unroll
    for (int mt = 0; mt < 2; ++mt) af[mt] = *(const bf16x8*)(arow[mt] + (size_t)pp * 128 + d);
#pragma unroll
    for (int nt = 0; nt < 8; ++nt) bf[nt] = *(const bf16x8*)(bp + (size_t)nt * 16 * 2048 + k0);
#pragma unroll
    for (int mt = 0; mt < 2; ++mt)
#pragma unroll
      for (int nt = 0; nt < 8; ++nt) acc[mt][nt] = mfma16(bf[nt], af[mt], acc[mt][nt]);
  }
  {
    float* part = smem + wave_ * 4096;
#pragma unroll
    for (int a = 0; a < 2; ++a)
#pragma unroll
      for (int c = 0; c < 8; ++c)
#pragma unroll
        for (int i = 0; i < 4; ++i) part[((a * 8 + c) * 4 + i) * 64 + lane] = acc[a][c][i];
  }
  __syncthreads();
  if (kc != 0) return;
#pragma unroll 1
  for (int q = 1; q < 4; ++q) {
    const float* part = smem + (wave_ + q) * 4096;
#pragma unroll
    for (int a = 0; a < 2; ++a) {
#pragma unroll
      for (int c = 0; c < 8; ++c)
#pragma unroll
        for (int i = 0; i < 4; ++i) acc[a][c][i] += part[((a * 8 + c) * 4 + i) * 64 + lane];
      asm volatile("" ::: "memory");
    }
  }
#pragma unroll
  for (int nt = 0; nt < 8; ++nt) {
    const f32x4 cv = *(const f32x4*)(c1 + 16 * nt + 4 * g4);
#pragma unroll
    for (int mt = 0; mt < 2; ++mt)
#pragma unroll
      for (int i = 0; i < 4; ++i) acc[mt][nt][i] = siluf_(acc[mt][nt][i] + cv[i]);
  }
  bf16x8 wf[4][4];
#pragma unroll
  for (int ks = 0; ks < 4; ++ks)
#pragma unroll
    for (int et = 0; et < 4; ++et) {
      const bf16_t* wp = w2t + (size_t)(16 * et + r) * 128 + 32 * ks + 4 * g4;
      const u32x2 lo = *(const u32x2*)wp, hi = *(const u32x2*)(wp + 16);
      u32x4 w = {lo[0], lo[1], hi[0], hi[1]};
      wf[ks][et] = __builtin_bit_cast(bf16x8, w);
    }
  if (kv == 0) {
    const float* gain = kp_->nsa_k_norm + (size_t)(l * 3 + 0) * 64;
    bf16_t* dst = WSP(bf16_t, OFF_KCMP) + (size_t)((b * 2 + grp) * 512) * 64;
    f32x4 gv[4];
#pragma unroll
    for (int et = 0; et < 4; ++et) gv[et] = *(const f32x4*)(gain + 16 * et + 4 * g4);
#pragma unroll
    for (int mt = 0; mt < 2; ++mt) {
      f32x4 o[4];
#pragma unroll
      for (int et = 0; et < 4; ++et) o[et] = (f32x4){0.f, 0.f, 0.f, 0.f};
#pragma unroll
      for (int ks = 0; ks < 4; ++ks) {
        const bf16x8 xf = pack8(acc[mt][2 * ks], acc[mt][2 * ks + 1]);
#pragma unroll
        for (int et = 0; et < 4; ++et) o[et] = mfma16(wf[ks][et], xf, o[et]);
      }
      float ss = 0.f;
#pragma unroll
      for (int et = 0; et < 4; ++et)
#pragma unroll
        for (int i = 0; i < 4; ++i) ss += o[et][i] * o[et][i];
      ss += __shfl_xor(ss, 16);
      ss += __shfl_xor(ss, 32);
      const float rstd = rsqrtf(ss * (1.0f / 64.0f) + EPS);
      const int i = i0 + 16 * mt + r;
#pragma unroll
      for (int et = 0; et < 4; ++et) {
        f32x4 y = o[et] * rstd * gv[et];
        if (i > 510) y = (f32x4){0.f, 0.f, 0.f, 0.f};
        u32x2 w = {cvtpk(y[0], y[1]), cvtpk(y[2], y[3])};
        *(u32x2*)(dst + (size_t)i * 64 + 16 * et + 4 * g4) = w;
      }
    }
  } else {
    bf16_t* dst = WSP(bf16_t, OFF_VCT) + (size_t)((b * 2 + grp) * 64) * 512;
#pragma unroll
    for (int mt = 0; mt < 2; ++mt) {
      f32x4 o[4];
#pragma unroll
      for (int et = 0; et < 4; ++et) o[et] = (f32x4){0.f, 0.f, 0.f, 0.f};
#pragma unroll
      for (int ks = 0; ks < 4; ++ks) {
        const bf16x8 xf = pack8(acc[mt][2 * ks], acc[mt][2 * ks + 1]);
#pragma unroll
        for (int et = 0; et < 4; ++et) o[et] = mfma16(xf, wf[ks][et], o[et]);
      }
#pragma unroll
      for (int et = 0; et < 4; ++et) {
        f32x4 y = o[et];
        const int ib = i0 + 16 * mt + 4 * g4;
#pragma unroll
        for (int i = 0; i < 4; ++i)
          if (ib + i > 510) y[i] = 0.f;
        u32x2 w = {cvtpk(y[0], y[1]), cvtpk(y[2], y[3])};
        *(u32x2*)(dst + (size_t)(16 * et + r) * 512 + ib) = w;
      }
    }
  }
}
__device__ __forceinline__ void cumsum_wg(const Params& p, int u, float* smem) {
  kparams_t kp_ = kparams(); (void)kp_;
  const int tid = tidx(), lane = tid & 63, wave = tid >> 6, b = u >> 3, h = u & 7;
  const float* fl = WSP(float, OFF_FLOG) + ((size_t)b * T) * 8 + h;
  float* fc = WSP(float, OFF_FC) + (size_t)(b * 8 + h) * T;
  const int tb = tid * 16;
  float v[16];
#pragma unroll
  for (int i = 0; i < 16; ++i) v[i] = fl[(size_t)(tb + i) * 8];
  double s = 0.0;
#pragma unroll
  for (int i = 0; i < 16; ++i) s += (double)v[i];
  double incl = s;
#pragma unroll
  for (int o = 1; o < 64; o <<= 1) {
    const double y = __shfl_up(incl, o);
    if (lane >= o) incl += y;
  }
  double* wtot = (double*)smem;
  if (lane == 63) wtot[wave] = incl;
  __syncthreads();
  double base = 0.0;
  for (int w = 0; w < wave; ++w) base += wtot[w];
  double run = base + incl - s;
#pragma unroll
  for (int i = 0; i < 16; ++i) { run += (double)v[i]; v[i] = (float)run; }
#pragma unroll
  for (int i = 0; i < 4; ++i) *(f32x4*)(fc + tb + 4 * i) = (f32x4){v[4 * i], v[4 * i + 1], v[4 * i + 2], v[4 * i + 3]};
  __syncthreads();
}
__device__ __forceinline__ void memk_norm_unit(const Params& p, int l, int u) {
  kparams_t kp_ = kparams(); (void)kp_;
  const int lane = tidx() & 63;
  bf16_t* mk = WSP(bf16_t, OFF_MK);
  const float* gain = kp_->mem_k_norm + l * 128 + (lane & 15) * 8;
  for (int rr = 0; rr < 16; ++rr) {
    bf16_t* ptr = mk + (size_t)(u * 16 + rr) * 512 + lane * 8;
    const u32x4 w = *(const u32x4*)ptr;
    float v[8];
#pragma unroll
    for (int j = 0; j < 4; ++j) { v[2 * j] = bflo(w[j]); v[2 * j + 1] = bfhi(w[j]); }
    float ss = 0.f;
#pragma unroll
    for (int j = 0; j < 8; ++j) ss += v[j] * v[j];
#pragma unroll
    for (int o = 1; o < 16; o <<= 1) ss += __shfl_xor(ss, o);
    const float rstd = rsqrtf(ss * (1.0f / 128.0f) + EPS);
    u32x4 ow;
#pragma unroll
    for (int j = 0; j < 4; ++j) ow[j] = cvtpk(v[2 * j] * rstd * gain[2 * j], v[2 * j + 1] * rstd * gain[2 * j + 1]);
    *(u32x4*)ptr = ow;
  }
}
__device__ __forceinline__ void phase_mid(const Params& p, int l, float* smem) {
  const int wave = tidx() >> 6;
  for (int u = bidx(); u < 128 + 32 + 8; u += gdim()) {
    if (u < 128) { compress_wg(p, l, u, smem); __syncthreads(); }
    else if (u < 160) cumsum_wg(p, u - 128, smem);
    else memk_norm_unit(p, l, (u - 160) * 8 + wave);
  }
}

template <int NCT, int NDK, bool QL = false>
__device__ __forceinline__ void qk_scores(const bf16_t* __restrict__ kbase, int ldk, int key0,
                                          const bf16x8 (&qf)[NCT][NDK], f32x4 (&s)[2][NCT], int lane, const bf16x8* qlds = nullptr) {
  const int r = lane & 15, grp = lane >> 4;
#pragma unroll
  for (int kt = 0; kt < 2; ++kt) {
    const bf16_t* kp = kbase + (size_t)(key0 + 8 * (r >> 2) + 4 * kt + (r & 3)) * ldk + grp * 8;
    bf16x8 kf[NDK];
#pragma unroll
    for (int dk = 0; dk < NDK; ++dk) kf[dk] = *(const bf16x8*)(kp + dk * 32);
#pragma unroll
    for (int ct = 0; ct < NCT; ++ct) {
      f32x4 a = {0.f, 0.f, 0.f, 0.f};
#pragma unroll
      for (int dk = 0; dk < NDK; ++dk) a = mfma16(kf[dk], QL ? qlds[(ct * NDK + dk) * 64 + lane] : qf[ct][dk], a);
      s[kt][ct] = a;
    }
  }
}
template <int NCT, int NDT>
__device__ __forceinline__ void pv_accum(const bf16_t* __restrict__ vt, size_t ldv, int key0,
                                         const f32x4 (&s)[2][NCT], f32x4 (&o)[NDT][NCT], int lane) {
  const int r = lane & 15, grp = lane >> 4;
  bf16x8 pb[NCT];
#pragma unroll
  for (int ct = 0; ct < NCT; ++ct) pb[ct] = pack8(s[0][ct], s[1][ct]);
#pragma unroll
  for (int dt = 0; dt < NDT; ++dt) {
    const bf16x8 vf = *(const bf16x8*)(vt + (size_t)(16 * dt + r) * ldv + key0 + 8 * grp);
#pragma unroll
    for (int ct = 0; ct < NCT; ++ct) o[dt][ct] = mfma16(vf, pb[ct], o[dt][ct]);
  }
}
template <int NCT, int NDT, bool HAS_O, bool SUMS = true>
__device__ __forceinline__ void softmax_update(f32x4 (&s)[2][NCT], float (&m)[NCT], float (&lsum)[NCT],
                                               f32x4 (&o)[NDT][NCT], f32x4 (*lacc)[NCT] = nullptr) {
  float mnew[NCT];
  bool ch = false;
#pragma unroll
  for (int ct = 0; ct < NCT; ++ct) {
    float mx = fmaxf(fmaxf(fmaxf(s[0][ct][0], s[0][ct][1]), fmaxf(s[0][ct][2], s[0][ct][3])),
                     fmaxf(fmaxf(s[1][ct][0], s[1][ct][1]), fmaxf(s[1][ct][2], s[1][ct][3])));
    mx = grp_max4(mx);
    mnew[ct] = fmaxf(m[ct], mx);
    ch = ch || (mnew[ct] > m[ct]);
  }
  if (__any(ch)) {
#pragma unroll
    for (int ct = 0; ct < NCT; ++ct) {
      const float msafe = (mnew[ct] == NEG_INF) ? 0.f : mnew[ct];
      const float alpha = __builtin_amdgcn_exp2f(m[ct] - msafe);
      m[ct] = mnew[ct];
      if (SUMS) lsum[ct] *= alpha; else (*lacc)[ct] = (*lacc)[ct] * alpha;
      if (HAS_O) {
#pragma unroll
        for (int dt = 0; dt < NDT; ++dt) o[dt][ct] = o[dt][ct] * alpha;
      }
    }
  }
#pragma unroll
  for (int ct = 0; ct < NCT; ++ct) {
    const float msafe = (m[ct] == NEG_INF) ? 0.f : m[ct];
#pragma unroll
    for (int kt = 0; kt < 2; ++kt) {
      const f32x4 d = s[kt][ct] - msafe;
      f32x4 pv;
#pragma unroll
      for (int i = 0; i < 4; ++i) pv[i] = __builtin_amdgcn_exp2f(d[i]);
      s[kt][ct] = pv;
    }
    if (SUMS) {
      const f32x4 t4 = s[0][ct] + s[1][ct];
      lsum[ct] += (t4[0] + t4[1]) + (t4[2] + t4[3]);
    }
  }
}
__device__ __forceinline__ float finish_l(float lsum) {
  lsum += __shfl_xor(lsum, 16);
  lsum += __shfl_xor(lsum, 32);
  return lsum > 0.f ? 1.0f / lsum : 0.f;
}

typedef __attribute__((address_space(3))) unsigned char lds_u8;
constexpr int TILE_ROWB = 144, TILE_HALF = 64 * TILE_ROWB, TILE_STAGE = 2 * TILE_HALF + 256;
struct TileRegs { u32x4 k, v; };
__device__ __forceinline__ void tile_gload(TileRegs& tr, const bf16_t* __restrict__ kbase, int ldk, const bf16_t* __restrict__ vtbase,
                                           size_t ldv, int key0, int tid) {
  const int row = tid >> 3, ch = tid & 7;
  tr.k = *(const u32x4*)(kbase + (size_t)(key0 + row) * ldk + ch * 8);
  tr.v = *(const u32x4*)(vtbase + (size_t)row * ldv + key0 + ch * 8);
}
__device__ __forceinline__ void tile_swrite(const TileRegs& tr, lds_u8* stage, int tid) {
  const int row = tid >> 3, ch = tid & 7;
  *(__attribute__((address_space(3))) u32x4*)(stage + row * TILE_ROWB + ch * 16) = tr.k;
  *(__attribute__((address_space(3))) u32x4*)(stage + TILE_HALF + row * TILE_ROWB + ch * 16) = tr.v;
}
template <int NCT, int NDK, bool QL>
__device__ __forceinline__ void qk_scores_lds(const lds_u8* stage, int hf, const bf16x8 (&qf)[NCT][NDK], f32x4 (&s)[2][NCT], int lane,
                                              const bf16x8* qlds, const f32x4 c0, const f32x4 c1) {
  const int r = lane & 15, grp = lane >> 4;
#pragma unroll
  for (int kt = 0; kt < 2; ++kt) {
    const lds_u8* kp = stage + (32 * hf + 8 * (r >> 2) + 4 * kt + (r & 3)) * TILE_ROWB + grp * 16;
    bf16x8 kf[NDK];
#pragma unroll
    for (int dk = 0; dk < NDK; ++dk) kf[dk] = *(const __attribute__((address_space(3))) bf16x8*)(kp + dk * 64);
#pragma unroll
    for (int ct = 0; ct < NCT; ++ct) {
      f32x4 a = kt ? c1 : c0;
#pragma unroll
      for (int dk = 0; dk < NDK; ++dk) a = mfma16(kf[dk], QL ? qlds[(ct * NDK + dk) * 64 + lane] : qf[ct][dk], a);
      s[kt][ct] = a;
    }
  }
}
template <int NDT>
__device__ __forceinline__ void v_frags_lds(const lds_u8* stage, int hf, bf16x8 (&vf)[NDT], int lane) {
  const int r = lane & 15, grp = lane >> 4;
#pragma unroll
  for (int dt = 0; dt < NDT; ++dt)
    vf[dt] = *(const __attribute__((address_space(3))) bf16x8*)(stage + TILE_HALF + (16 * dt + r) * TILE_ROWB + (32 * hf + 8 * grp) * 2);
}
template <int NCT, int NDT>
__device__ __forceinline__ void pv_accum_lds(const bf16x8 (&vfp)[NDT], const f32x4 (&s)[2][NCT], f32x4 (&o)[NDT][NCT], int lane, f32x4 (&lacc)[NCT]) {
  const int r = lane & 15, grp = lane >> 4; (void)r; (void)grp;
  bf16x8 pb[NCT];
#pragma unroll
  for (int ct = 0; ct < NCT; ++ct) pb[ct] = pack8(s[0][ct], s[1][ct]);
  {
    const short one = (short)0x3F80;
    const bf16x8 ones = {one, one, one, one, one, one, one, one};
#pragma unroll
    for (int ct = 0; ct < NCT; ++ct) lacc[ct] = mfma16(ones, pb[ct], lacc[ct]);
  }
#pragma unroll
  for (int dt = 0; dt < NDT; ++dt) {
    const bf16x8 vf = vfp[dt];
#pragma unroll
    for (int ct = 0; ct < NCT; ++ct) o[dt][ct] = mfma16(vf, pb[ct], o[dt][ct]);
  }
}
__device__ __forceinline__ int next_bit(unsigned long long lo, unsigned long long hi, int from) {
  if (from < 64) { const unsigned long long mm = lo & (~0ull << from); if (mm) return __ffsll(mm) - 1; from = 64; }
  if (from < 128) { const unsigned long long mm = hi & (~0ull << (from - 64)); if (mm) return 64 + __ffsll(mm) - 1; }
  return 128;
}

__device__ __forceinline__ void nsa_wg_unit(const Params& p, int b, int g, int qi, float* imp, bf16x8* qlds, float* scr, lds_u8* tiles, unsigned* misc, bool st) {
  kparams_t kp_ = kparams(); (void)kp_;
  const int tid0 = tidx();
  const int wave = __builtin_amdgcn_readfirstlane(tid0 >> 6);
  const int lane0 = tid0 & 63;
  const int tq = qi * 8 + wave;
  const int t0 = tq * 16;
  const bf16x8 (&qf)[4][2] = *(const bf16x8 (*)[4][2])nullptr;
#define NSA_SECTION_VARS \
  int lane = lane0; asm volatile("" : "+v"(lane)); \
  const int r = lane & 15, grp = lane >> 4, t = t0 + r; \
  const size_t row = (size_t)b * T + t; \
  const float* gatep = WSP(float, OFF_GATE) + row * 24 + g * 12; (void)gatep; (void)grp; (void)t;
  {
    NSA_SECTION_VARS
#pragma unroll
    for (int ct = 0; ct < 4; ++ct)
#pragma unroll
      for (int dk = 0; dk < 2; ++dk)
        qlds[(ct * 2 + dk) * 64 + lane] = *(const bf16x8*)(WSP(bf16_t, OFF_QN) + row * 512 + (g * 4 + ct) * 64 + dk * 32 + grp * 8);
  }
  f32x4 o[4][4];
  float m[4], lsum[4];
  f32x4 lacc[4];
  {
    NSA_SECTION_VARS
    const bf16_t* kc = WSP(bf16_t, OFF_KCMP) + (size_t)((b * 2 + g) * 512) * 64;
    const bf16_t* vct = WSP(bf16_t, OFF_VCT) + (size_t)((b * 2 + g) * 64) * 512;
    const int nblk = (tq + 31) >> 5;
#pragma unroll
    for (int ct = 0; ct < 4; ++ct) { m[ct] = NEG_INF; lsum[ct] = 0.f; }
#pragma unroll 1
    for (int blk = 0; blk < nblk; ++blk) {
      f32x4 s[2][4];
      qk_scores<4, 2, true>(kc, 64, blk * 32, qf, s, lane, qlds);
#pragma unroll
      for (int kt = 0; kt < 2; ++kt)
#pragma unroll
        for (int i = 0; i < 4; ++i) {
          const int n = blk * 32 + 8 * grp + 4 * kt + i;
          const bool ok = (16 * n + 31 <= t);
#pragma unroll
          for (int ct = 0; ct < 4; ++ct) s[kt][ct][i] = ok ? s[kt][ct][i] : NEG_INF;
        }
      softmax_update<4, 4, false>(s, m, lsum, o);
    }
    float invl[4], msafe[4];
#pragma unroll
    for (int ct = 0; ct < 4; ++ct) { invl[ct] = finish_l(lsum[ct]); msafe[ct] = (m[ct] == NEG_INF) ? 0.f : m[ct]; }
    for (int e = lane; e < 16 * 132; e += 64) imp[e] = 0.f;
    __builtin_amdgcn_fence(__ATOMIC_SEQ_CST, "workgroup");
    __builtin_amdgcn_wave_barrier();
#pragma unroll
    for (int dt = 0; dt < 4; ++dt)
#pragma unroll
      for (int ct = 0; ct < 4; ++ct) o[dt][ct] = (f32x4){0.f, 0.f, 0.f, 0.f};
#pragma unroll 1
    for (int blk = 0; blk < nblk; ++blk) {
      f32x4 s[2][4];
      qk_scores<4, 2, true>(kc, 64, blk * 32, qf, s, lane, qlds);
      float pq[2][4];
#pragma unroll
      for (int kt = 0; kt < 2; ++kt)
#pragma unroll
        for (int i = 0; i < 4; ++i) {
          const int n = blk * 32 + 8 * grp + 4 * kt + i;
          const bool ok = (16 * n + 31 <= t);
          float acc_p = 0.f;
#pragma unroll
          for (int ct = 0; ct < 4; ++ct) {
            const float pv = ok ? __builtin_amdgcn_exp2f(s[kt][ct][i] - msafe[ct]) * invl[ct] : 0.f;
            s[kt][ct][i] = pv;
            acc_p += pv;
          }
          pq[kt][i] = acc_p;
        }
      float* ir = imp + r * 132 + blk * 8 + 2 * grp;
      ir[0] += pq[0][0] + pq[0][1] + pq[0][2] + 0.5f * pq[0][3];
      __builtin_amdgcn_fence(__ATOMIC_SEQ_CST, "workgroup");
      __builtin_amdgcn_wave_barrier();
      ir[1] += pq[1][0] + pq[1][1] + pq[1][2] + 0.5f * pq[1][3] + 0.5f * pq[0][3];
      __builtin_amdgcn_fence(__ATOMIC_SEQ_CST, "workgroup");
      __builtin_amdgcn_wave_barrier();
      ir[2] += 0.5f * pq[1][3];
      __builtin_amdgcn_fence(__ATOMIC_SEQ_CST, "workgroup");
      __builtin_amdgcn_wave_barrier();
      pv_accum<4, 4>(vct, 512, blk * 32, s, o, lane);
    }
    f32x4 gt[4];
#pragma unroll
    for (int ct = 0; ct < 4; ++ct) gt[ct][0] = gatep[ct * 3 + 0];
#pragma unroll
    for (int dt = 0; dt < 4; ++dt) {
#pragma unroll
      for (int ct = 0; ct < 4; ++ct)
#pragma unroll
        for (int i = 0; i < 4; ++i) scr[((dt * 4 + ct) * 4 + i) * 64 + lane] = o[dt][ct][i] * gt[ct][0];
      asm volatile("" ::: "memory");
    }
  }
  const int cur = t0 >> 6;
  unsigned long long sel_lo = 0ull, sel_hi = 0ull;
  {
  NSA_SECTION_VARS
  if (cur <= 15) {
    sel_lo = (1ull << (cur + 1)) - 1ull;
  } else {
    __builtin_amdgcn_fence(__ATOMIC_SEQ_CST, "workgroup");
    __builtin_amdgcn_wave_barrier();
    float v[32];
#pragma unroll
    for (int k = 0; k < 32; ++k) {
      const int j = grp + 4 * k;
      const float x = imp[r * 132 + j];
      v[k] = (j >= 1 && j <= cur - 2) ? x : NEG_INF;
    }
#pragma unroll 1
    for (int round = 0; round < 13; ++round) {
      float best = NEG_INF;
      int bj = 1 << 20;
#pragma unroll
      for (int k = 0; k < 32; ++k) {
        const bool tk = v[k] > best;
        best = tk ? v[k] : best;
        bj = tk ? (grp + 4 * k) : bj;
      }
#pragma unroll
      for (int off = 16; off <= 32; off <<= 1) {
        const float ob = __shfl_xor(best, off);
        const int oj = __shfl_xor(bj, off);
        const bool tk = (ob > best) || (ob == best && oj < bj);
        best = tk ? ob : best;
        bj = tk ? oj : bj;
      }
      if (bj < 64) sel_lo |= 1ull << bj; else if (bj < 128) sel_hi |= 1ull << (bj - 64);
#pragma unroll
      for (int k = 0; k < 32; ++k) v[k] = (bj == grp + 4 * k) ? NEG_INF : v[k];
    }
    sel_lo |= 1ull;
    if (cur < 64) sel_lo |= 1ull << cur; else sel_hi |= 1ull << (cur - 64);
    if (cur - 1 < 64) sel_lo |= 1ull << (cur - 1); else sel_hi |= 1ull << (cur - 1 - 64);
  }
  }
  asm volatile("" : "+v"(sel_lo), "+v"(sel_hi));
  atomicOr(&misc[4], (unsigned)sel_lo); atomicOr(&misc[5], (unsigned)(sel_lo >> 32));
  atomicOr(&misc[6], (unsigned)sel_hi); atomicOr(&misc[7], (unsigned)(sel_hi >> 32));
  __syncthreads();
  unsigned long long ulo, uhi;
  {
    const unsigned u0 = __builtin_amdgcn_readfirstlane(misc[4]), u1 = __builtin_amdgcn_readfirstlane(misc[5]);
    const unsigned u2 = __builtin_amdgcn_readfirstlane(misc[6]), u3 = __builtin_amdgcn_readfirstlane(misc[7]);
    ulo = ((unsigned long long)u1 << 32) | u0; uhi = ((unsigned long long)u3 << 32) | u2;
  }
  {
    NSA_SECTION_VARS
    const int tid = (wave << 6) | lane;
    const int hq = r >> 2, qq = r & 3;
    const bf16_t* ks = WSP(bf16_t, OFF_KS) + ((size_t)b * T) * 128 + g * 64;
    const bf16_t* vst = WSP(bf16_t, OFF_VST) + (size_t)((b * 2 + g) * 64) * T;
    bf16x8 qr[4][2];
    unsigned long long mlo[4], mhi[4];
#pragma unroll
    for (int ct = 0; ct < 4; ++ct) {
      const size_t rowq = (size_t)b * T + t0 + 4 * ct + qq;
#pragma unroll
      for (int dk = 0; dk < 2; ++dk)
        qr[ct][dk] = *(const bf16x8*)(WSP(bf16_t, OFF_QN) + rowq * 512 + (g * 4 + hq) * 64 + dk * 32 + grp * 8);
      const int srcl = (lane & 48) | (4 * ct + qq);
      mlo[ct] = __shfl(sel_lo, srcl);
      mhi[ct] = __shfl(sel_hi, srcl);
      m[ct] = NEG_INF; lacc[ct] = (f32x4){0.f, 0.f, 0.f, 0.f};
    }
#pragma unroll
    for (int dt = 0; dt < 4; ++dt)
#pragma unroll
      for (int ct = 0; ct < 4; ++ct) o[dt][ct] = (f32x4){0.f, 0.f, 0.f, 0.f};
    const short one_ = (short)0x3F80;
    const bf16x8 ones = {one_, one_, one_, one_, one_, one_, one_, one_};
    TileRegs tr, trb;
    int jA = next_bit(ulo, uhi, 0), it = 0;
    int jB = next_bit(ulo, uhi, jA + 1);
    tile_gload(tr, ks, 128, vst, T, 64 * jA, tid);
    if (jB < 128) tile_gload(trb, ks, 128, vst, T, 64 * jB, tid);
    tile_swrite(tr, tiles, tid);
    if (jB < 128) tile_swrite(trb, tiles + TILE_STAGE, tid);
    __syncthreads();
#pragma unroll 1
    while (jA < 128) {
      const int nA = (jB < 128) ? next_bit(ulo, uhi, jB + 1) : 128;
      const int nB = (nA < 128) ? next_bit(ulo, uhi, nA + 1) : 128;
      if (nA < 128) tile_gload(tr, ks, 128, vst, T, 64 * nA, tid);
      if (nB < 128) tile_gload(trb, ks, 128, vst, T, 64 * nB, tid);
#pragma unroll 1
      for (int sub = 0; sub < 2; ++sub) {
      const int j = sub ? jB : jA;
      if (j >= 128) break;
      const lds_u8* stage = tiles + (2 * (it & 1) + sub) * TILE_STAGE;
      bool mine[4], need[4], anyneed = false;
#pragma unroll
      for (int ct = 0; ct < 4; ++ct) {
        mine[ct] = ((j < 64 ? (mlo[ct] >> j) : (mhi[ct] >> (j - 64))) & 1ull) != 0ull;
        need[ct] = __any(mine[ct]) != 0;
        anyneed = anyneed || need[ct];
      }
      if (anyneed) {
#pragma unroll
        for (int hf = 0; hf < 2; ++hf) {
          const int key0 = j * 64 + hf * 32;
          bf16x8 kf[2][2];
#pragma unroll
          for (int kt = 0; kt < 2; ++kt) {
            const lds_u8* kp = stage + (32 * hf + 8 * (r >> 2) + 4 * kt + (r & 3)) * TILE_ROWB + grp * 16;
#pragma unroll
            for (int dk = 0; dk < 2; ++dk) kf[kt][dk] = *(const __attribute__((address_space(3))) bf16x8*)(kp + dk * 64);
          }
          bf16x8 vfr[4];
          v_frags_lds<4>(stage, hf, vfr, lane);
#pragma unroll
          for (int ct = 0; ct < 4; ++ct) {
            if (need[ct]) {
              const float mv = mine[ct] ? 0.f : NEG_INF;
              f32x4 s0 = {mv, mv, mv, mv}, s1 = {mv, mv, mv, mv};
              s0 = mfma16(kf[0][0], qr[ct][0], s0);
              s1 = mfma16(kf[1][0], qr[ct][0], s1);
              s0 = mfma16(kf[0][1], qr[ct][1], s0);
              s1 = mfma16(kf[1][1], qr[ct][1], s1);
              if (j == cur) {
                const int tct = t0 + 4 * ct + qq;
#pragma unroll
                for (int i = 0; i < 4; ++i) {
                  s0[i] = (key0 + 8 * grp + i <= tct) ? s0[i] : NEG_INF;
                  s1[i] = (key0 + 8 * grp + 4 + i <= tct) ? s1[i] : NEG_INF;
                }
              }
              float mx = fmaxf(fmaxf(fmaxf(s0[0], s0[1]), fmaxf(s0[2], s0[3])), fmaxf(fmaxf(s1[0], s1[1]), fmaxf(s1[2], s1[3])));
              mx = grp_max4(mx);
              const float mnew = fmaxf(m[ct], mx);
              if (__any(mnew > m[ct])) {
                const float ms = (mnew == NEG_INF) ? 0.f : mnew;
                const float alpha = __builtin_amdgcn_exp2f(m[ct] - ms);
                m[ct] = mnew;
                lacc[ct] = lacc[ct] * alpha;
#pragma unroll
                for (int dt = 0; dt < 4; ++dt) o[dt][ct] = o[dt][ct] * alpha;
              }
              const float msafe = (m[ct] == NEG_INF) ? 0.f : m[ct];
              const f32x4 d0 = s0 - msafe, d1 = s1 - msafe;
              f32x4 p0, p1;
#pragma unroll
              for (int i = 0; i < 4; ++i) { p0[i] = __builtin_amdgcn_exp2f(d0[i]); p1[i] = __builtin_amdgcn_exp2f(d1[i]); }
              const bf16x8 pb = pack8(p0, p1);
              lacc[ct] = mfma16(ones, pb, lacc[ct]);
#pragma unroll
              for (int dt = 0; dt < 4; ++dt) o[dt][ct] = mfma16(vfr[dt], pb, o[dt][ct]);
            }
          }
        }
      }
      }
      if (nA < 128) tile_swrite(tr, tiles + (2 * ((it + 1) & 1)) * TILE_STAGE, tid);
      if (nB < 128) tile_swrite(trb, tiles + (2 * ((it + 1) & 1) + 1) * TILE_STAGE, tid);
      __syncthreads();
      jA = nA; jB = nB; ++it;
    }
    float* scr2 = scr + (size_t)2048 * 4096;
#pragma unroll
    for (int ct = 0; ct < 4; ++ct) {
      const size_t rowq = (size_t)b * T + t0 + 4 * ct + qq;
      const float sc = (lacc[ct][0] > 0.f ? 1.0f / lacc[ct][0] : 0.f) * WSP(float, OFF_GATE)[rowq * 24 + (g * 4 + hq) * 3 + 1];
#pragma unroll
      for (int dt = 0; dt < 4; ++dt)
        *(f32x4*)(scr2 + (hq * 16 + 4 * ct + qq) * 64 + 16 * dt + 4 * grp) = o[dt][ct] * sc;
    }
    asm volatile("s_waitcnt vmcnt(0)" ::: "memory");
    __builtin_amdgcn_fence(__ATOMIC_SEQ_CST, "workgroup");
  }
  {
    NSA_SECTION_VARS
    const int tid = (wave << 6) | lane;
    const bf16_t* kw = WSP(bf16_t, OFF_KW) + ((size_t)b * T) * 128 + g * 64;
    const bf16_t* vwt = WSP(bf16_t, OFF_VWT) + (size_t)((b * 2 + g) * 64) * T;
#pragma unroll
    for (int ct = 0; ct < 4; ++ct) { m[ct] = NEG_INF; lsum[ct] = 0.f; lacc[ct] = (f32x4){0.f, 0.f, 0.f, 0.f}; }
#pragma unroll
    for (int dt = 0; dt < 4; ++dt)
#pragma unroll
      for (int ct = 0; ct < 4; ++ct) o[dt][ct] = (f32x4){0.f, 0.f, 0.f, 0.f};
    int kstart = qi * 128 - 512;
    if (kstart < 0) kstart = 0;
    const int kend = qi * 128 + 64;
    bf16x8 qr[4][2];
#pragma unroll
    for (int ct = 0; ct < 4; ++ct)
#pragma unroll
      for (int dk = 0; dk < 2; ++dk)
        qr[ct][dk] = *(const bf16x8*)(WSP(bf16_t, OFF_QN) + row * 512 + (g * 4 + ct) * 64 + dk * 32 + grp * 8);
    TileRegs tr;
    int it = 0;
    tile_gload(tr, kw, 128, vwt, T, kstart, tid);
    tile_swrite(tr, tiles, tid);
    __syncthreads();
#pragma unroll 1
    for (int k0 = kstart; k0 <= kend; k0 += 64, ++it) {
      if (k0 + 64 <= kend) tile_gload(tr, kw, 128, vwt, T, k0 + 64, tid);
      const lds_u8* stage = tiles + (it & 1) * TILE_STAGE;
      if (k0 <= t0 + 15 && k0 + 63 + 512 > t0) {
#pragma unroll
        for (int hf = 0; hf < 2; ++hf) {
          const int key0 = k0 + hf * 32;
          f32x4 s[2][4];
          const f32x4 cz = {0.f, 0.f, 0.f, 0.f};
          qk_scores_lds<4, 2, false>(stage, hf, qr, s, lane, nullptr, cz, cz);
          if (!(k0 + 63 <= t0 && k0 + 512 > t0 + 15)) {
#pragma unroll
            for (int kt = 0; kt < 2; ++kt)
#pragma unroll
              for (int i = 0; i < 4; ++i) {
                const int key = key0 + 8 * grp + 4 * kt + i;
                const bool ok = (key <= t) && (key + 512 > t);
#pragma unroll
                for (int ct = 0; ct < 4; ++ct) s[kt][ct][i] = ok ? s[kt][ct][i] : NEG_INF;
              }
          }
          bf16x8 vfr[4];
          v_frags_lds<4>(stage, hf, vfr, lane);
          softmax_update<4, 4, true, false>(s, m, lsum, o, &lacc);
          pv_accum_lds<4, 4>(vfr, s, o, lane, lacc);
        }
      }
      if (k0 + 64 <= kend) tile_swrite(tr, tiles + ((it + 1) & 1) * TILE_STAGE, tid);
      __syncthreads();
    }
    float sc2[4];
#pragma unroll
    for (int ct = 0; ct < 4; ++ct) sc2[ct] = (lacc[ct][0] > 0.f ? 1.0f / lacc[ct][0] : 0.f) * gatep[ct * 3 + 2];
    bf16_t* oa = WSP(bf16_t, OFF_OA) + row * 512 + g * 256;
#pragma unroll
    for (int dt = 0; dt < 4; ++dt)
#pragma unroll
      for (int ct = 0; ct < 4; ++ct) {
        bf16_t* ptr = oa + ct * 64 + 16 * dt + 4 * grp;
        const u32x2 sw = *(const u32x2*)ptr;
        float val[4];
        const f32x4 sv = *(const f32x4*)(scr + (size_t)2048 * 4096 + (ct * 16 + r) * 64 + 16 * dt + 4 * grp);
#pragma unroll
        for (int i = 0; i < 4; ++i) val[i] = scr[((dt * 4 + ct) * 4 + i) * 64 + lane] + sv[i] + o[dt][ct][i] * sc2[ct];
        u32x2 w = {cvtpk(val[0] * bflo(sw[0]), val[1] * bfhi(sw[0])), cvtpk(val[2] * bflo(sw[1]), val[3] * bfhi(sw[1]))};
        if (st) *(u32x2*)ptr = w;
        asm volatile("" ::: "memory");
      }
  }
#undef NSA_SECTION_VARS
}

__device__ __forceinline__ void fox_wg_unit(const Params& p, int l, int b, int h, int qb, lds_u8* tiles, bool st) {
  kparams_t kp_ = kparams(); (void)kp_;
  const int tid = tidx();
  const int wave = __builtin_amdgcn_readfirstlane(tid >> 6);
  const int lane = tid & 63, r = lane & 15, grp = lane >> 4;
  const int t0 = qb * 512 + wave * 64;
  bf16x8 qf[4][2];
  const float* fc = WSP(float, OFF_FC) + (size_t)(b * 8 + h) * T;
#pragma unroll
  for (int ct = 0; ct < 4; ++ct) {
    const size_t row = (size_t)b * T + t0 + 16 * ct + r;
#pragma unroll
    for (int dk = 0; dk < 2; ++dk)
      qf[ct][dk] = *(const bf16x8*)(WSP(bf16_t, OFF_FQ) + row * 512 + h * 64 + dk * 32 + grp * 8);
  }
  const bf16_t* kb = WSP(bf16_t, OFF_FK) + ((size_t)b * T) * 512 + h * 64;
  const bf16_t* vt = WSP(bf16_t, OFF_FVT) + (size_t)((b * 8 + h) * 64) * T;
  f32x4 o[4][4];
  float m[4], lsum[4];
  f32x4 lacc[4];
#pragma unroll
  for (int ct = 0; ct < 4; ++ct) { m[ct] = NEG_INF; lsum[ct] = 0.f; lacc[ct] = (f32x4){0.f, 0.f, 0.f, 0.f}; }
#pragma unroll
  for (int dt = 0; dt < 4; ++dt)
#pragma unroll
    for (int ct = 0; ct < 4; ++ct) o[dt][ct] = (f32x4){0.f, 0.f, 0.f, 0.f};
  const int ntiles = (qb + 1) * 8;
  int it0, itw0;
  {
    float gq = fabsf(kp_->fox_q_norm[l * 64 + lane]), gk = fabsf(kp_->fox_k_norm[l * 64 + lane]);
#pragma unroll
    for (int o_ = 1; o_ < 64; o_ <<= 1) { gq = fmaxf(gq, __shfl_xor(gq, o_)); gk = fmaxf(gk, __shfl_xor(gk, o_)); }
    const float B2 = 16.0f * gq * gk * 1.02f + 104.0f;
    const float thr_wg = fc[qb * 512] + B2, thr_w = fc[t0] + B2;
    const float c0 = (lane < ntiles) ? fc[64 * lane + 63] : -3.0e38f;
    const float c1 = (lane + 64 < ntiles) ? fc[64 * (lane + 64) + 63] : -3.0e38f;
    it0 = __popcll(__ballot(c0 > thr_wg)) + __popcll(__ballot(c1 > thr_wg));
    itw0 = __popcll(__ballot(c0 > thr_w)) + __popcll(__ballot(c1 > thr_w));
    it0 = __builtin_amdgcn_readfirstlane(it0);
    itw0 = __builtin_amdgcn_readfirstlane(itw0);
  }
  TileRegs tr;
  float ckr = 0.f;
  tile_gload(tr, kb, 512, vt, T, it0 * 64, tid);
  if (tid < 64) ckr = fc[it0 * 64 + tid] * (-LOG2E);
  tile_swrite(tr, tiles, tid);
  if (tid < 64) *(__attribute__((address_space(3))) float*)(tiles + 2 * TILE_HALF + tid * 4) = ckr;
  __syncthreads();
#pragma unroll 1
  for (int it = it0; it < ntiles; ++it) {
    const int k0 = it * 64;
    if (it + 1 < ntiles) { tile_gload(tr, kb, 512, vt, T, k0 + 64, tid); if (tid < 64) ckr = fc[k0 + 64 + tid] * (-LOG2E); }
    const lds_u8* stage = tiles + ((it - it0) & 1) * TILE_STAGE;
    if (k0 <= t0 + 63 && it >= itw0) {
      const bool diag = (k0 + 63 > t0);
#pragma unroll
      for (int hf = 0; hf < 2; ++hf) {
        const int key0 = k0 + hf * 32;
        f32x4 s[2][4];
        const f32x4 ck0 = *(const __attribute__((address_space(3))) f32x4*)(stage + 2 * TILE_HALF + (32 * hf + 8 * grp) * 4);
        const f32x4 ck1 = *(const __attribute__((address_space(3))) f32x4*)(stage + 2 * TILE_HALF + (32 * hf + 8 * grp + 4) * 4);
        qk_scores_lds<4, 2, false>(stage, hf, qf, s, lane, nullptr, ck0, ck1);
        if (diag) {
#pragma unroll
          for (int kt = 0; kt < 2; ++kt)
#pragma unroll
            for (int i = 0; i < 4; ++i) {
              const int key = key0 + 8 * grp + 4 * kt + i;
#pragma unroll
              for (int ct = 0; ct < 4; ++ct) s[kt][ct][i] = (key <= t0 + 16 * ct + r) ? s[kt][ct][i] : NEG_INF;
            }
        }
        bf16x8 vfr[4];
        v_frags_lds<4>(stage, hf, vfr, lane);
        softmax_update<4, 4, true, false>(s, m, lsum, o, &lacc);
        pv_accum_lds<4, 4>(vfr, s, o, lane, lacc);
      }
    }
    if (it + 1 < ntiles) {
      tile_swrite(tr, tiles + ((it - it0 + 1) & 1) * TILE_STAGE, tid);
      if (tid < 64) *(__attribute__((address_space(3))) float*)(tiles + ((it - it0 + 1) & 1) * TILE_STAGE + 2 * TILE_HALF + tid * 4) = ckr;
    }
    __syncthreads();
  }
  float invl[4];
#pragma unroll
  for (int ct = 0; ct < 4; ++ct) invl[ct] = lacc[ct][0] > 0.f ? 1.0f / lacc[ct][0] : 0.f;
#pragma unroll
  for (int ct = 0; ct < 4; ++ct) {
    bf16_t* ob = WSP(bf16_t, OFF_OB) + ((size_t)b * T + t0 + 16 * ct + r) * 512 + h * 64;
#pragma unroll
    for (int dt = 0; dt < 4; ++dt) {
      bf16_t* ptr = ob + 16 * dt + 4 * grp;
      const u32x2 sw = *(const u32x2*)ptr;
      const f32x4 v = o[dt][ct] * invl[ct];
      u32x2 w = {cvtpk(v[0] * bflo(sw[0]), v[1] * bfhi(sw[0])), cvtpk(v[2] * bflo(sw[1]), v[3] * bfhi(sw[1]))};
      if (st) *(u32x2*)ptr = w;
    }
  }
}

__device__ __forceinline__ void mem_unit(const Params& p, int l, int b, int h, int t0, bool st) {
  kparams_t kp_ = kparams(); (void)kp_;
  const int lane = tidx() & 63, r = lane & 15, grp = lane >> 4;
  const float SC = 0.08838834764831845f * LOG2E;
  bf16x8 qf[2][4];
  const float* gq = kp_->mem_q_norm + l * 128;
#pragma unroll
  for (int ct = 0; ct < 2; ++ct) {
    const size_t row = (size_t)b * T + t0 + 16 * ct + r;
    float v[4][8];
    float ss = 0.f;
#pragma unroll
    for (int dk = 0; dk < 4; ++dk) {
      const u32x4 w = *(const u32x4*)(WSP(bf16_t, OFF_MQ) + row * 512 + h * 128 + dk * 32 + grp * 8);
#pragma unroll
      for (int j = 0; j < 4; ++j) { v[dk][2 * j] = bflo(w[j]); v[dk][2 * j + 1] = bfhi(w[j]); }
#pragma unroll
      for (int j = 0; j < 8; ++j) ss += v[dk][j] * v[dk][j];
    }
    ss += __shfl_xor(ss, 16);
    ss += __shfl_xor(ss, 32);
    const float rstd = rsqrtf(ss * (1.0f / 128.0f) + EPS);
#pragma unroll
    for (int dk = 0; dk < 4; ++dk) {
      const f32x4 g0 = *(const f32x4*)(gq + dk * 32 + grp * 8), g1 = *(const f32x4*)(gq + dk * 32 + grp * 8 + 4);
      u32x4 w = {cvtpk(v[dk][0] * rstd * g0[0], v[dk][1] * rstd * g0[1]), cvtpk(v[dk][2] * rstd * g0[2], v[dk][3] * rstd * g0[3]),
                 cvtpk(v[dk][4] * rstd * g1[0], v[dk][5] * rstd * g1[1]), cvtpk(v[dk][6] * rstd * g1[2], v[dk][7] * rstd * g1[3])};
      qf[ct][dk] = __builtin_bit_cast(bf16x8, w);
    }
  }
  const bf16_t* kb = WSP(bf16_t, OFF_MK) + ((size_t)b * 256) * 512 + h * 128;
  const bf16_t* vt = WSP(bf16_t, OFF_MVT) + (size_t)((b * 4 + h) * 128) * 256;
  f32x4 o[8][2];
  float m[2], lsum[2];
#pragma unroll
  for (int ct = 0; ct < 2; ++ct) { m[ct] = NEG_INF; lsum[ct] = 0.f; }
#pragma unroll
  for (int dt = 0; dt < 8; ++dt)
#pragma unroll
    for (int ct = 0; ct < 2; ++ct) o[dt][ct] = (f32x4){0.f, 0.f, 0.f, 0.f};
#pragma unroll 1
  for (int key0 = 0; key0 < 256; key0 += 32) {
    f32x4 s[2][2];
    qk_scores<2, 4>(kb, 512, key0, qf, s, lane);
#pragma unroll
    for (int kt = 0; kt < 2; ++kt)
#pragma unroll
      for (int ct = 0; ct < 2; ++ct) s[kt][ct] = s[kt][ct] * SC;
    softmax_update<2, 8, true>(s, m, lsum, o);
    pv_accum<2, 8>(vt, 256, key0, s, o, lane);
  }
#pragma unroll
  for (int ct = 0; ct < 2; ++ct) {
    const float invl = finish_l(lsum[ct]);
    bf16_t* om = WSP(bf16_t, OFF_OM) + ((size_t)b * T + t0 + 16 * ct + r) * 512 + h * 128;
#pragma unroll
    for (int dt = 0; dt < 8; ++dt) {
      bf16_t* ptr = om + 16 * dt + 4 * grp;
      const u32x2 sw = *(const u32x2*)ptr;
      const f32x4 v = o[dt][ct] * invl;
      u32x2 w = {cvtpk(v[0] * bflo(sw[0]), v[1] * bfhi(sw[0])), cvtpk(v[2] * bflo(sw[1]), v[3] * bfhi(sw[1]))};
      if (st) *(u32x2*)ptr = w;
    }
  }
}

__device__ __forceinline__ void phase_attn(const Params& p, int l, unsigned char* ldsraw, bool st, int cidx) {
  kparams_t kp_ = kparams(); (void)kp_;
  const int tid = tidx();
  const int wave = __builtin_amdgcn_readfirstlane(tid >> 6);
  float* imp = (float*)ldsraw + wave * 2112;
  lds_u8* tiles = (lds_u8*)ldsraw;
  bf16x8* qlds = (bf16x8*)(ldsraw + 69632 + wave * 8192);
  unsigned* misc = (unsigned*)(ldsraw + 135168);
  float* scr = WSP(float, OFF_SCR) + (size_t)(bidx() * NWAVES + wave) * 4096;
  const int myx = (int)(xb_xcc_id() & 7u);
  constexpr int QUNITS = 192;
  for (int qq = 0; qq < 8; ++qq) {
    const int x = (myx + qq) & 7;
    unsigned* ctr = WSP(unsigned, OFF_CTL) + cidx * 8 + x;
    for (;;) {
      __syncthreads();
      if (tid == 0) misc[0] = atomicAdd(ctr, 1u);
      if (tid >= 4 && tid < 8) misc[tid] = 0u;
      __syncthreads();
      const int u = __builtin_amdgcn_readfirstlane((int)misc[0]);
      if (u >= QUNITS) break;
      if (u < 64) {
        nsa_wg_unit(p, x >> 1, x & 1, 63 - u, imp, qlds, scr, tiles, misc, st);
      } else if (u < 128) {
        const int v_ = u - 64, bh = 4 * x + (v_ >> 4);
        fox_wg_unit(p, l, bh >> 3, bh & 7, 15 - (v_ & 15), tiles, st);
      } else {
        const int mu = u - 128, bh = 2 * x + (mu >> 5), qblk = mu & 31;
        mem_unit(p, l, bh >> 2, bh & 3, 256 * qblk + 32 * wave, st);
      }
    }
  }
}

__global__ void __launch_bounds__(NTHREADS) hybrid_megakernel(Params p) {
  kparams_t kp_ = kparams();
  cg::grid_group grid = cg::this_grid();
  extern __shared__ __attribute__((aligned(16))) unsigned char dynlds[];
  float* smem = (float*)dynlds;
  PG8_LAS unsigned char* glds = (PG8_LAS unsigned char*)dynlds;
  volatile LAS unsigned* bst = (volatile LAS unsigned*)(glds + 135168 + 64);
  if (threadIdx.x < 2) bst[threadIdx.x] = 0u;
  __syncthreads();
  grid.sync();
  const XcdBarrier xbar = xcd_barrier_post(WSP(unsigned, OFF_BAR), bst);
  unsigned long long pr_acc = 0ull, pr_t0 = 0ull;
#pragma unroll 1
  for (int ph = 0; ph < 28; ++ph) {
    const int l = ph / 7, k = ph - 7 * l;
    if (PROBE_PHASE >= 0 && k == PROBE_PHASE) pr_t0 = __builtin_amdgcn_s_memrealtime();
    if (k == 0) {
      phase_prep(p, l, smem);
    } else if (k == 1) {
      if (bidx() == gdim() - 1 && tidx() < 256) {
        const int t_ = tidx();
        const float* part = WSP(float, OFF_C1) + (size_t)(t_ >> 7) * 16 * 128 + (t_ & 127);
        float pv_[16];
#pragma unroll
        for (int ch = 0; ch < 16; ++ch) pv_[ch] = part[ch * 128];
        float s_ = 0.f;
#pragma unroll
        for (int ch = 0; ch < 16; ++ch) s_ += pv_[ch];
        WSP(float, OFF_C1 + 16384)[t_] = s_;
      }
      EpiIn E{&p, l};
      for (int rp = 0; rp < (PROBE_GEMM2 ? (kp_->ws != nullptr ? 2 : 1) : 1); ++rp)
        run_gemm(glds, WSP(bf16_t, OFF_H), WSP(bf16_t, OFF_W_IN), M, 5120, 1024, E);
      EpiMemKV E2{&p};
      run_gemm(glds, WSP(bf16_t, OFF_MEMN), WSP(bf16_t, OFF_W_MKV), 1024, 1024, 1024, E2);
    } else if (k == 2) {
      phase_mid(p, l, smem);
    } else if (k == 3) {
      const int nrep = PROBE_ATTN2 ? (kp_->ws != nullptr ? 2 : 1) : 1;
      for (int rp = 0; rp < nrep; ++rp) {
        const bool last = (rp == nrep - 1);
        if (rp) xcd_barrier(xbar);
        phase_attn(p, l, dynlds, last, last ? l : 4 + l);
      }
    } else if (k == 4) {
      pg8::Gemm g{WSP(bf16_t, OFF_H), WSP(bf16_t, OFF_W_G), M, 1024, 1024, 0, (size_t)2 * MiB};
      ZOrder3 S;
      S.base.init(M, 1024, gdim(), bidx());
      EpiGate E{WSP(bf16_t, OFF_G)};
      pg8::gemm_phase<EpiGate, ZOrder3, true, true>(glds, g, S, E);
      continue;
    } else if (k == 5) {
      for (int rp = 0; rp < (PROBE_BR2 ? (kp_->ws != nullptr ? 2 : 1) : 1); ++rp) {
      EpiBranch Ea{WSP(bf16_t, OFF_G), WSP(bf16_t, OFF_U), 1};
      run_gemm(glds, WSP(bf16_t, OFF_OA), WSP(bf16_t, OFF_W_BR), M, 1024, 512, Ea);
      EpiBranch Eb{WSP(bf16_t, OFF_G) + (size_t)M * 1024, WSP(bf16_t, OFF_U), 0};
      run_gemm(glds, WSP(bf16_t, OFF_OB), WSP(bf16_t, OFF_W_BR + MiB), M, 1024, 512, Eb);
      EpiBranch Ec{WSP(bf16_t, OFF_G) + (size_t)2 * M * 1024, WSP(bf16_t, OFF_U), 0};
      run_gemm(glds, WSP(bf16_t, OFF_OM), WSP(bf16_t, OFF_W_BR + 2 * MiB), M, 1024, 512, Ec);
      }
    } else {
      EpiOut E{l == 0 ? kp_->x : kp_->out, kp_->out};
      run_gemm(glds, WSP(bf16_t, OFF_U), WSP(bf16_t, OFF_W_OUT), M, 1024, 1024, E);
    }
    xcd_barrier(xbar);
    if (PROBE_PHASE >= 0 && k == PROBE_PHASE) pr_acc += __builtin_amdgcn_s_memrealtime() - pr_t0;
  }
  if (PROBE_PHASE >= 0 && blockIdx.x == 0) {
    const unsigned long long ts = __builtin_amdgcn_s_memrealtime();
    while (__builtin_amdgcn_s_memrealtime() - ts < pr_acc) __builtin_amdgcn_s_sleep(8);
  }
}

extern "C" void kernel_launch(void* const* d_in, const int* in_sizes, int n_in, void* d_out, int out_size, void* d_ws,
                              size_t ws_size, hipStream_t stream) {
  static int grid_blocks = 0;
  if (!grid_blocks) {
    int dev = 0, cus = 0, per_cu = 0;
    (void)hipGetDevice(&dev);
    (void)hipDeviceGetAttribute(&cus, hipDeviceAttributeMultiprocessorCount, dev);
    if (hipFuncSetAttribute((const void*)hybrid_megakernel, hipFuncAttributeMaxDynamicSharedMemorySize, LDS_BYTES) != hipSuccess)
      fprintf(stderr, "hipFuncSetAttribute(dynamic LDS %d) failed\n", LDS_BYTES);
    (void)hipOccupancyMaxActiveBlocksPerMultiprocessor(&per_cu, hybrid_megakernel, NTHREADS, LDS_BYTES);
    (void)hipGetLastError();
    grid_blocks = cus;
    if (grid_blocks > 256) grid_blocks = 256;
    if (ws_size < OFF_SCR + (size_t)64 * MiB) fprintf(stderr, "workspace too small: %zu\n", ws_size);
  }
  Params p{};
  const float** pp = (const float**)&p;
  for (int i = 0; i < 23; ++i) pp[i] = (const float*)d_in[i];
  p.out = (float*)d_out;
  p.ws = (char*)d_ws;
  void* args[] = {&p};
  (void)hipMemsetAsync((char*)d_ws + OFF_BAR, 0, XCD_BAR_WORDS * sizeof(unsigned), stream);
  hipError_t e = hipLaunchCooperativeKernel((void*)hybrid_megakernel, dim3(grid_blocks), dim3(NTHREADS), args, LDS_BYTES, stream);
  if (e != hipSuccess) fprintf(stderr, "cooperative launch failed: %s (grid %d)\n", hipGetErrorString(e), grid_blocks);
}
```

```cpp
#include <hip/hip_runtime.h>
#include <hip/hip_cooperative_groups.h>
#include <stdint.h>
#include <cstdio>
namespace cg = cooperative_groups;
typedef unsigned short bf16_t;
typedef short bf16x8 __attribute__((ext_vector_type(8)));
typedef float f32x4 __attribute__((ext_vector_type(4)));
typedef unsigned u32x2 __attribute__((ext_vector_type(2)));
typedef unsigned u32x4 __attribute__((ext_vector_type(4)));
typedef float f32x2_t __attribute__((ext_vector_type(2)));
typedef __bf16 bf16x2_t __attribute__((ext_vector_type(2)));

constexpr int NB = 4, T = 8192, M = NB * T;
constexpr int NTHREADS = 512, NWAVES = NTHREADS / 64;
constexpr int LDS_BYTES = 147456;
constexpr float EPS = 1e-6f;
constexpr float LOG2E = 1.4426950408889634f;
#define NEG_INF (-__builtin_inff())

constexpr size_t MiB = 1u << 20;
constexpr size_t OFF_CTL = 0;
constexpr size_t OFF_BAR = 64 * 1024;
constexpr size_t OFF_ROPE = 1 * MiB;
constexpr size_t OFF_W_IN = 3 * MiB;
constexpr size_t OFF_W_G = 13 * MiB;
constexpr size_t OFF_W_MKV = 19 * MiB;
constexpr size_t OFF_W_BR = 21 * MiB;
constexpr size_t OFF_W_OUT = 24 * MiB;
constexpr size_t OFF_W1 = 26 * MiB;
constexpr size_t OFF_W2 = 27 * MiB;
constexpr size_t OFF_C1 = 27 * MiB + 256 * 1024;
constexpr size_t OFF_MEMN = 28 * MiB;
constexpr size_t OFF_MK = 30 * MiB;
constexpr size_t OFF_MVT = 31 * MiB;
constexpr size_t OFF_H = 32 * MiB;
constexpr size_t OFF_U = OFF_H;
constexpr size_t OFF_OA = 96 * MiB;
constexpr size_t OFF_OB = 128 * MiB;
constexpr size_t OFF_OM = 160 * MiB;
constexpr size_t OFF_QN = 192 * MiB;
constexpr size_t OFF_G = 192 * MiB;
constexpr size_t OFF_KC = 224 * MiB;
constexpr size_t OFF_VC = 232 * MiB;
constexpr size_t OFF_KS = 240 * MiB;
constexpr size_t OFF_VST = 248 * MiB;
constexpr size_t OFF_KW = 256 * MiB;
constexpr size_t OFF_VWT = 264 * MiB;
constexpr size_t OFF_FQ = 272 * MiB;
constexpr size_t OFF_FK = 304 * MiB;
constexpr size_t OFF_FVT = 336 * MiB;
constexpr size_t OFF_MQ = 368 * MiB;
constexpr size_t OFF_GATE = 400 * MiB;
constexpr size_t OFF_FLOG = 403 * MiB;
constexpr size_t OFF_FC = 404 * MiB;
constexpr size_t OFF_KCMP = 405 * MiB;
constexpr size_t OFF_VCT = 405 * MiB + 512 * 1024;
constexpr size_t OFF_SCR = 406 * MiB;

struct Params {
  const float *x, *mem, *norm_g, *mem_norm_g, *w_in, *nsa_q_norm, *nsa_k_norm, *cmp_pe_k, *cmp_w1_k, *cmp_w2_k,
      *cmp_pe_v, *cmp_w1_v, *cmp_w2_v, *fox_q_norm, *fox_k_norm, *fox_f_bias, *mem_q_norm, *mem_k_norm, *w_mem_kv,
      *w_branch_a, *w_branch_b, *w_branch_m, *w_out;
  float* out;
  char* ws;
};
__device__ __forceinline__ char* ws_base(char* w) {
  unsigned lo = __builtin_amdgcn_readfirstlane((unsigned)(uintptr_t)w), hi = __builtin_amdgcn_readfirstlane((unsigned)((uintptr_t)w >> 32));
  asm volatile("" : "+s"(lo), "+s"(hi));
  return (char*)(__attribute__((address_space(1))) char*)(((uintptr_t)hi << 32) | (uintptr_t)lo);
}
typedef const __attribute__((address_space(4))) Params* kparams_t;
__device__ __forceinline__ kparams_t kparams() { kparams_t kp = (kparams_t)__builtin_amdgcn_kernarg_segment_ptr(); asm volatile("" : "+s"(kp)); return kp; }
#define WSP(TYPE, off) ((TYPE*)(ws_base(kp_->ws) + (off)))

__constant__ float c_inv_freq[32] = {
    1.000000000e+00f, 7.498942018e-01f, 5.623413324e-01f, 4.216965139e-01f, 3.162277639e-01f, 2.371373773e-01f,
    1.778279394e-01f, 1.333521456e-01f, 1.000000015e-01f, 7.498942316e-02f, 5.623413250e-02f, 4.216964915e-02f,
    3.162277490e-02f, 2.371373773e-02f, 1.778279431e-02f, 1.333521400e-02f, 9.999999776e-03f, 7.498942316e-03f,
    5.623413250e-03f, 4.216964822e-03f, 3.162277630e-03f, 2.371373819e-03f, 1.778279431e-03f, 1.333521446e-03f,
    1.000000047e-03f, 7.498941850e-04f, 5.623413017e-04f, 4.216965172e-04f, 3.162277571e-04f, 2.371373703e-04f,
    1.778279402e-04f, 1.333521504e-04f};

__device__ __forceinline__ int bidx() { int b = blockIdx.x; asm volatile("" : "+s"(b)); return b; }
__device__ __forceinline__ int gdim() { int g = gridDim.x; asm volatile("" : "+s"(g)); return g; }
__device__ __forceinline__ int tidx() { int t = threadIdx.x; asm volatile("" : "+v"(t)); return t; }
__device__ __forceinline__ unsigned cvtpk(float lo, float hi) {
  f32x2_t v = {lo, hi};
  bf16x2_t b = __builtin_convertvector(v, bf16x2_t);
  return __builtin_bit_cast(unsigned, b);
}
__device__ __forceinline__ float bf2f(unsigned short v) { return __uint_as_float(((unsigned)v) << 16); }
__device__ __forceinline__ float bflo(unsigned w) { return __uint_as_float(w << 16); }
__device__ __forceinline__ float bfhi(unsigned w) { return __uint_as_float(w & 0xffff0000u); }
__device__ __forceinline__ f32x4 mfma16(bf16x8 a, bf16x8 b, f32x4 c) {
  return __builtin_amdgcn_mfma_f32_16x16x32_bf16(a, b, c, 0, 0, 0);
}
__device__ __forceinline__ bf16x8 pack8(f32x4 a, f32x4 b) {
  u32x4 w = {cvtpk(a[0], a[1]), cvtpk(a[2], a[3]), cvtpk(b[0], b[1]), cvtpk(b[2], b[3])};
  return __builtin_bit_cast(bf16x8, w);
}
__device__ __forceinline__ float sigmoidf_(float v) { return __builtin_amdgcn_rcpf(1.0f + __builtin_amdgcn_exp2f(-LOG2E * v)); }
__device__ __forceinline__ float siluf_(float v) { return v * __builtin_amdgcn_rcpf(1.0f + __builtin_amdgcn_exp2f(-LOG2E * v)); }
__device__ __forceinline__ float grp_max4(float v) {
  auto a = __builtin_amdgcn_permlane32_swap(__float_as_uint(v), __float_as_uint(v), false, false);
  v = fmaxf(__uint_as_float(a[0]), __uint_as_float(a[1]));
  auto b = __builtin_amdgcn_permlane16_swap(__float_as_uint(v), __float_as_uint(v), false, false);
  return fmaxf(__uint_as_float(b[0]), __uint_as_float(b[1]));
}
__device__ __forceinline__ float wave_sum(float v) {
#pragma unroll
  for (int o = 1; o < 64; o <<= 1) v += __shfl_xor(v, o);
  return v;
}

#define LAS __attribute__((address_space(3)))
#define XB_TMO      128
#define XB_XCNT(j)  (256  + 64 * (j))
#define XB_XSUB(j)  (1280 + 64 * (j))
#define XB_XGEN(j)  (2304 + 64 * (j))
#define XB_TOP      3328
#define XB_TOPGEN   3392
#define XCD_BAR_WORDS 3456
#define XB_SPIN_CAP (1u << 18)

__device__ __forceinline__ unsigned xb_ld(unsigned* p)              { return __hip_atomic_load(p, __ATOMIC_RELAXED, __HIP_MEMORY_SCOPE_AGENT); }
__device__ __forceinline__ unsigned xb_add(unsigned* p, unsigned v) { return __hip_atomic_fetch_add(p, v, __ATOMIC_RELAXED, __HIP_MEMORY_SCOPE_AGENT); }
__device__ __forceinline__ unsigned xb_xcc_id() { return (unsigned)__builtin_amdgcn_s_getreg((3 << 11) | 20) & 0xFu; }
#define XB_SPIN(cond, bar) do { unsigned _sp = 0; while (cond) { __builtin_amdgcn_s_sleep(1); \
    if ((++_sp & 255u) == 0u) { if (xb_ld(&(bar)[XB_TMO])) break; if (_sp > XB_SPIN_CAP) { atomicAdd(&(bar)[XB_TMO], 1u); break; } } } } while (0)

struct XcdBarrier {
    unsigned* bar; unsigned x;
    volatile LAS unsigned* st;
};

__device__ __forceinline__ XcdBarrier xcd_barrier_post(unsigned* bar, volatile LAS unsigned* st) {
    XcdBarrier b; b.bar = bar; b.x = xb_xcc_id(); b.st = st;
    if (threadIdx.x == 0) (void)xb_add(&bar[XB_XCNT(b.x)], 1u);
    return b;
}
__device__ __forceinline__ void xcd_barrier_complete(unsigned* bar, unsigned x, unsigned& nloc, unsigned& nx) {
    const unsigned G = gridDim.x * gridDim.y * gridDim.z;
    unsigned sum, cnt, mine, sp = 0u;
    for (;;) {
        sum = 0u; cnt = 0u; mine = 0u;
#pragma unroll
        for (unsigned j = 0; j < 16; ++j) { const unsigned c = xb_ld(&bar[XB_XCNT(j)]); sum += c; cnt += (c > 0u) ? 1u : 0u; mine = (j == x) ? c : mine; }
        if (sum == G) break;
        __builtin_amdgcn_s_sleep(1);
        if ((++sp & 255u) == 0u) { if (xb_ld(&bar[XB_TMO])) break; if (sp > XB_SPIN_CAP) { atomicAdd(&bar[XB_TMO], 1u); break; } }
    }
    nloc = mine > 0u ? mine : 1u; nx = cnt > 0u ? cnt : 1u;
}

__device__ __forceinline__ void xcd_barrier(const XcdBarrier& b) {
    asm volatile("s_waitcnt vmcnt(0)" ::: "memory");
    __syncthreads();
    if (threadIdx.x == 0) {
        unsigned* bar = b.bar;
        __builtin_amdgcn_s_waitcnt(0);
        unsigned nloc = b.st[0], nx = b.st[1];
        if (nloc == 0u) { xcd_barrier_complete(bar, b.x, nloc, nx); b.st[0] = nloc; b.st[1] = nx; }
        const unsigned old = xb_add(&bar[XB_XSUB(b.x)], 1u);
        const unsigned gen = old / nloc;
        if (old + 1u == (gen + 1u) * nloc) {
            __builtin_amdgcn_fence(__ATOMIC_RELEASE, "agent");
            asm volatile("s_waitcnt vmcnt(0)" ::: "memory");
            const unsigned og = xb_add(&bar[XB_TOP], 1u);
            const unsigned tg = og / nx;
            if (og + 1u == (tg + 1u) * nx) xb_add(&bar[XB_TOPGEN], 1u);
            else XB_SPIN(xb_ld(&bar[XB_TOPGEN]) == tg, bar);
            __builtin_amdgcn_fence(__ATOMIC_ACQUIRE, "agent");
            xb_add(&bar[XB_XGEN(b.x)], 1u);
            asm volatile("s_waitcnt vmcnt(0)" ::: "memory");
        } else {
            XB_SPIN(xb_ld(&bar[XB_XGEN(b.x)]) == gen, bar);
            __builtin_amdgcn_fence(__ATOMIC_ACQUIRE, "agent");
            asm volatile("s_waitcnt vmcnt(0)" ::: "memory");
        }
    }
    __syncthreads();
}


namespace pg8 {
#define PG8_LAS __attribute__((address_space(3)))
typedef unsigned short bf16_t;
typedef short bf16x8 __attribute__((ext_vector_type(8)));
typedef float f32x4 __attribute__((ext_vector_type(4)));
typedef unsigned u32x4 __attribute__((ext_vector_type(4)));
constexpr int BM = 256, BK = 64, HALF = 128, HTB = HALF * BK * 2  , STAGE_BYTES = 8 * HTB, NXCD = 8, WGM = 8;

__host__ __device__ __forceinline__ int lds_byte(int r, int c) { const int st = (r >> 4) * 2 + (c >> 5), rr = r & 15, cc = c & 31, ob = rr * 64 + cc * 2; return st * 1024 + (ob ^ (((ob >> 9) & 1) << 5)); }
__host__ __device__ __forceinline__ void stage_rc(int b, int& R, int& C) { const int st = b / 1024, sb = b % 1024, swz = sb ^ (((sb >> 9) & 1) << 5); R = (st >> 1) * 16 + swz / 64; C = (st & 1) * 32 + (swz % 64) / 2; }
__host__ __device__ __forceinline__ int perm32(int rho) { const int n = rho >> 4, i = rho & 15; return 8 * (i >> 2) + 4 * n + (i & 3); }

struct Unit { int pm, pn; };
struct Gemm { const bf16_t* A; const bf16_t* Bt; int M, N, K; };

struct StaticOrder {
    int nM, nN, nwg, G, c;
    __host__ __device__ void init(int M, int N, int G_, int c_) { nM = M / BM; nN = N / BM; nwg = nM * nN; G = G_; c = c_; }
    __host__ __device__ bool next(int i, Unit& u) const {
        const long L = (long)i * G + c; if (L >= nwg) return false;
        int wgid = (int)L; { const int q = nwg / NXCD, r = nwg % NXCD, xcd = wgid % NXCD, off = wgid / NXCD; wgid = (xcd < r ? xcd * (q + 1) : r * (q + 1) + (xcd - r) * q) + off; }
        const int nig = WGM * nN, gid = wgid / nig, fm = gid * WGM, gsz = (nM - fm) < WGM ? (nM - fm) : WGM;
        u.pm = fm + ((wgid % nig) % gsz); u.pn = (wgid % nig) / gsz; return true;
    }
    __device__ __forceinline__ void a_ready(const Unit&) const {}
    __device__ __forceinline__ void done(const Unit&) const {}
};
__device__ __forceinline__ unsigned cvt_pk_bf16(float lo, float hi) { unsigned r; asm volatile("v_cvt_pk_bf16_f32 %0, %1, %2" : "=v"(r) : "v"(lo), "v"(hi)); return r; }
template <class Epi, class Sched, bool ALIGN_EPI = false, bool SP2 = false>
__device__ __forceinline__ void gemm_phase(PG8_LAS unsigned char* lds, const Gemm g, const Sched& S, const Epi& E) {
    const int tid = tidx(), wid = __builtin_amdgcn_readfirstlane(tid >> 6), lane = tid & 63, wr = wid >> 2, wc = wid & 3, fr = lane & 15, fq = lane >> 4;
    const int K = g.K, nt = K / BK;
    unsigned voffA[2], voffB[2];
#pragma unroll
    for (int i = 0; i < 2; ++i) { int R, C; stage_rc(tid * 16 + i * 8192, R, C); const int Rb = Epi::PERM ? ((R & ~31) + perm32(R & 31)) : R;
        voffA[i] = (unsigned)(R * K + C) * 2u; voffB[i] = (unsigned)(Rb * K + C) * 2u; }
    const size_t kstep = (size_t)(BK * 2);
    const size_t hstep = (size_t)HALF * K * 2;
    const size_t tstep = 2 * hstep;
    const unsigned ldsw = (unsigned)wid * 1024u;
    const int aoff = lds_byte(wr * 64 + fr, fq * 8), boff = lds_byte(wc * 32 + fr, fq * 8);
#define PG8_SA(b, h) (((b) * 2 + (h)) * HTB)
#define PG8_SB(b, h) ((4 + (b) * 2 + (h)) * HTB)
#define PG8_STAGE(bufoff, gbase, voff) do { _Pragma("unroll") for (int _i = 0; _i < 2; ++_i) \
        __builtin_amdgcn_global_load_lds((const unsigned*)((const char*)(gbase) + (voff)[_i]), (PG8_LAS unsigned*)(lds + (bufoff) + ldsw + _i * 8192), 16, 0, 0); } while (0)
#define PG8_LDA(dst, b, h) do { _Pragma("unroll") for (int m = 0; m < 4; ++m) _Pragma("unroll") for (int k = 0; k < 2; ++k) dst[m][k] = *(const PG8_LAS bf16x8*)(lds + PG8_SA(b, h) + aoff + m * 2048 + k * 1024); } while (0)
#define PG8_LDB(dst, b, h) do { _Pragma("unroll") for (int n = 0; n < 2; ++n) _Pragma("unroll") for (int k = 0; k < 2; ++k) dst[n][k] = *(const PG8_LAS bf16x8*)(lds + PG8_SB(b, h) + boff + n * 2048 + k * 1024); } while (0)
#define PG8_MMA(ai, bj, At, Bt) do { __builtin_amdgcn_s_setprio(1); _Pragma("unroll") for (int m = 0; m < 4; ++m) _Pragma("unroll") for (int n = 0; n < 2; ++n) _Pragma("unroll") for (int k = 0; k < 2; ++k) \
        acc[ai][bj][m][n] = __builtin_amdgcn_mfma_f32_16x16x32_bf16(Bt[n][k], At[m][k], acc[ai][bj][m][n], 0, 0, 0); __builtin_amdgcn_s_setprio(0); } while (0)
#define PG8_WAIT_V(n) asm volatile("s_waitcnt vmcnt(" #n ")" ::: "memory")
#define PG8_WAIT_L(n) asm volatile("s_waitcnt lgkmcnt(" #n ")" ::: "memory")
#define PG8_BAR __builtin_amdgcn_s_barrier()
#define PG8_SCHED __builtin_amdgcn_sched_barrier(0)
    Unit cur, nxt; int ui = 0;
    if (!S.next(0, cur)) return;
    f32x4 acc[2][2][4][2];
#pragma unroll
    for (int a = 0; a < 2; ++a)
#pragma unroll
        for (int b = 0; b < 2; ++b)
#pragma unroll
            for (int m = 0; m < 4; ++m)
#pragma unroll
                for (int n = 0; n < 2; ++n) acc[a][b][m][n] = (f32x4){0.f, 0.f, 0.f, 0.f};
    bf16x8 At[4][2], B0[2][2], B1[2][2];
    const char* cA = (const char*)g.A + (size_t)cur.pm * tstep; const char* cB = (const char*)g.Bt + (size_t)cur.pn * tstep;
    S.a_ready(cur);
    if constexpr (SP2) {
        PG8_STAGE(PG8_SB(0, 0), cB, voffB); PG8_STAGE(PG8_SB(0, 1), cB + hstep, voffB); PG8_STAGE(PG8_SA(0, 0), cA, voffA); PG8_STAGE(PG8_SA(0, 1), cA + hstep, voffA);
        if (wr == 1) PG8_BAR;
        PG8_WAIT_V(2); PG8_BAR;
        PG8_STAGE(PG8_SB(1, 0), cB + kstep, voffB); PG8_STAGE(PG8_SA(1, 0), cA + kstep, voffA); PG8_STAGE(PG8_SB(1, 1), cB + hstep + kstep, voffB);
        PG8_WAIT_V(6); PG8_BAR;
    } else {
        PG8_STAGE(PG8_SB(0, 0), cB, voffB); PG8_STAGE(PG8_SA(0, 0), cA, voffA); PG8_STAGE(PG8_SB(0, 1), cB + hstep, voffB); PG8_STAGE(PG8_SA(0, 1), cA + hstep, voffA);
        if (wr == 1) PG8_BAR;
        PG8_WAIT_V(4); PG8_BAR;
        PG8_STAGE(PG8_SB(1, 0), cB + kstep, voffB); PG8_STAGE(PG8_SA(1, 0), cA + kstep, voffA); PG8_STAGE(PG8_SB(1, 1), cB + hstep + kstep, voffB);
        PG8_WAIT_V(6); PG8_BAR;
    }
    for (;;) {
        const bool has_next = S.next(ui + 1, nxt);
        const char* nA = has_next ? (const char*)g.A + (size_t)nxt.pm * tstep : cA; const char* nB = has_next ? (const char*)g.Bt + (size_t)nxt.pn * tstep : cB;
        for (int t = 0; t < nt; t += 2) {
            const bool last = (t == nt - 2);
            const char* a1 = cA + (size_t)(t + 1) * kstep;
            const char* a2 = last ? nA : cA + (size_t)(t + 2) * kstep; const char* b2 = last ? nB : cB + (size_t)(t + 2) * kstep;
            const char* a3 = a2 + kstep; const char* b3 = b2 + kstep;
            if (last && has_next) S.a_ready(nxt);
            if constexpr (SP2) {
            PG8_LDB(B0, 0, 0); PG8_LDB(B1, 0, 1); PG8_SCHED; PG8_LDA(At, 0, 0); PG8_STAGE(PG8_SA(1, 1), a1 + hstep, voffA);
            PG8_WAIT_V(8); PG8_WAIT_L(0); PG8_BAR; PG8_MMA(0, 0, At, B0); PG8_MMA(0, 1, At, B1); PG8_BAR; PG8_SCHED;
            PG8_LDA(At, 0, 1); PG8_STAGE(PG8_SB(0, 0), b2, voffB); PG8_STAGE(PG8_SB(0, 1), b2 + hstep, voffB); PG8_STAGE(PG8_SA(0, 0), a2, voffA);
            PG8_WAIT_V(8); PG8_WAIT_L(0); PG8_BAR; PG8_MMA(1, 0, At, B0); PG8_MMA(1, 1, At, B1); PG8_BAR; PG8_SCHED;
            PG8_LDB(B0, 1, 0); PG8_LDB(B1, 1, 1); PG8_SCHED; PG8_LDA(At, 1, 0); PG8_STAGE(PG8_SA(0, 1), a2 + hstep, voffA);
            PG8_WAIT_V(8); PG8_WAIT_L(0); PG8_BAR; PG8_MMA(0, 0, At, B0); PG8_MMA(0, 1, At, B1); PG8_BAR; PG8_SCHED;
            PG8_LDA(At, 1, 1); PG8_STAGE(PG8_SB(1, 0), b3, voffB); PG8_STAGE(PG8_SB(1, 1), b3 + hstep, voffB); PG8_STAGE(PG8_SA(1, 0), a3, voffA);
            PG8_WAIT_V(8); PG8_WAIT_L(0); PG8_BAR; PG8_MMA(1, 0, At, B0); PG8_MMA(1, 1, At, B1); PG8_BAR; PG8_SCHED;
            } else {
            PG8_LDB(B0, 0, 0); PG8_SCHED; PG8_LDA(At, 0, 0); PG8_STAGE(PG8_SA(1, 1), a1 + hstep, voffA);
            PG8_WAIT_L(8); PG8_BAR; PG8_WAIT_L(0); PG8_MMA(0, 0, At, B0); PG8_BAR; PG8_SCHED;
            PG8_LDB(B1, 0, 1); PG8_STAGE(PG8_SB(0, 0), b2, voffB);
            PG8_BAR; PG8_WAIT_L(0); PG8_MMA(0, 1, At, B1); PG8_BAR;
            PG8_LDA(At, 0, 1); PG8_STAGE(PG8_SA(0, 0), a2, voffA);
            PG8_BAR; PG8_WAIT_L(0); PG8_MMA(1, 0, At, B0); PG8_BAR; PG8_SCHED;
            PG8_STAGE(PG8_SB(0, 1), b2 + hstep, voffB);
            PG8_WAIT_V(6); PG8_BAR; PG8_MMA(1, 1, At, B1); PG8_BAR;
            PG8_LDB(B0, 1, 0); PG8_SCHED; PG8_LDA(At, 1, 0); PG8_STAGE(PG8_SA(0, 1), a2 + hstep, voffA);
            PG8_WAIT_L(8); PG8_BAR; PG8_WAIT_L(0); PG8_MMA(0, 0, At, B0); PG8_BAR; PG8_SCHED;
            PG8_LDB(B1, 1, 1); PG8_STAGE(PG8_SB(1, 0), b3, voffB);
            PG8_BAR; PG8_WAIT_L(0); PG8_MMA(0, 1, At, B1); PG8_BAR;
            PG8_LDA(At, 1, 1); PG8_STAGE(PG8_SA(1, 0), a3, voffA);
            PG8_BAR; PG8_WAIT_L(0); PG8_MMA(1, 0, At, B0); PG8_BAR; PG8_SCHED;
            PG8_STAGE(PG8_SB(1, 1), b3 + hstep, voffB);
            PG8_WAIT_V(6); PG8_BAR; PG8_MMA(1, 1, At, B1); PG8_BAR;
            }
        }
        if constexpr (ALIGN_EPI) { if (wr == 0) PG8_BAR; }
        if constexpr (!Epi::AFTER_DRAIN) { E(acc, cur, wr, wc, fr, fq); S.done(cur); }
        if (!has_next) break;
#pragma unroll
        for (int a = 0; a < 2; ++a)
#pragma unroll
            for (int b = 0; b < 2; ++b)
#pragma unroll
                for (int m = 0; m < 4; ++m)
#pragma unroll
                    for (int n = 0; n < 2; ++n) acc[a][b][m][n] = (f32x4){0.f, 0.f, 0.f, 0.f};
        cur = nxt; cA = nA; cB = nB; ++ui;
        if constexpr (ALIGN_EPI) { if (wr == 1) PG8_BAR; }
    }
    PG8_WAIT_V(0);
    if constexpr (!ALIGN_EPI) { if (wr == 0) PG8_BAR; }
    PG8_BAR;
    if constexpr (Epi::AFTER_DRAIN) { E.fused(acc, cur, wr, wc, fr, fq, lds, wid, lane); S.done(cur); }
#undef PG8_SA
#undef PG8_SB
#undef PG8_STAGE
#undef PG8_LDA
#undef PG8_LDB
#undef PG8_MMA
#undef PG8_WAIT_V
#undef PG8_WAIT_L
#undef PG8_BAR
#undef PG8_SCHED
}
}

struct EpiIn {
  static constexpr bool PERM = false, AFTER_DRAIN = false;
  const Params* pp; int l;
  __device__ __forceinline__ void operator()(f32x4 (&acc)[2][2][4][2], const pg8::Unit& u, int wr, int wc, int fr, int fq) const {
    kparams_t kp_ = kparams(); (void)kp_;
    const int U = u.pn * 4 + wc;
    if (U >= 77) return;
    const int rowb = u.pm * 256 + wr * 64 + fr;
    const int bq = (u.pm * 256) / T, tb = rowb % T;
    bf16_t* dst = nullptr; int ld = 0, col0 = 0; const float* gain = nullptr; bool rope = false, silu = false;
    float post = 1.0f;
    bf16_t* vt = nullptr;
    if (U < 8) { dst = WSP(bf16_t, OFF_QN); ld = 512; col0 = U * 64; gain = kp_->nsa_q_norm + l * 64; rope = true; post = 0.125f * LOG2E; }
    else if (U < 10) { dst = WSP(bf16_t, OFF_KC); ld = 128; col0 = (U - 8) * 64; rope = true; }
    else if (U < 12) { dst = WSP(bf16_t, OFF_VC); ld = 128; col0 = (U - 10) * 64; }
    else if (U < 14) { dst = WSP(bf16_t, OFF_KS); ld = 128; col0 = (U - 12) * 64; gain = kp_->nsa_k_norm + (l * 3 + 1) * 64; rope = true; }
    else if (U < 16) { vt = WSP(bf16_t, OFF_VST) + (size_t)((bq * 2 + (U - 14)) * 64) * T; }
    else if (U < 18) { dst = WSP(bf16_t, OFF_KW); ld = 128; col0 = (U - 16) * 64; gain = kp_->nsa_k_norm + (l * 3 + 2) * 64; rope = true; }
    else if (U < 20) { vt = WSP(bf16_t, OFF_VWT) + (size_t)((bq * 2 + (U - 18)) * 64) * T; }
    else if (U < 28) { dst = WSP(bf16_t, OFF_OA); ld = 512; col0 = (U - 20) * 64; silu = true; }
    else if (U < 36) { dst = WSP(bf16_t, OFF_FQ); ld = 512; col0 = (U - 28) * 64; gain = kp_->fox_q_norm + l * 64; post = 0.125f * LOG2E; }
    else if (U < 44) { dst = WSP(bf16_t, OFF_FK); ld = 512; col0 = (U - 36) * 64; gain = kp_->fox_k_norm + l * 64; }
    else if (U < 52) { vt = WSP(bf16_t, OFF_FVT) + (size_t)((bq * 8 + (U - 44)) * 64) * T; }
    else if (U < 60) { dst = WSP(bf16_t, OFF_OB); ld = 512; col0 = (U - 52) * 64; silu = true; }
    else if (U < 68) { dst = WSP(bf16_t, OFF_MQ); ld = 512; col0 = (U - 60) * 64; }
    else if (U < 76) { dst = WSP(bf16_t, OFF_OM); ld = 512; col0 = (U - 68) * 64; silu = true; }
    if (U == 76) {
      float* gate = WSP(float, OFF_GATE);
      float* flog = WSP(float, OFF_FLOG);
#pragma unroll
      for (int ai = 0; ai < 2; ++ai)
#pragma unroll
        for (int m = 0; m < 4; ++m) {
          const size_t row = (size_t)rowb + 128 * ai + 16 * m;
#pragma unroll
          for (int n = 0; n < 2; ++n)
#pragma unroll
            for (int i = 0; i < 4; ++i) {
              const int e = 16 * n + 4 * fq + i;
              const float v = acc[ai][0][m][n][i];
              if (e < 24) gate[row * 24 + e] = sigmoidf_(v);
              else {
                const float xx = v + kp_->fox_f_bias[l * 8 + (e - 24)];
                flog[row * 8 + (e - 24)] = xx >= 0.f ? -log1pf(expf(-xx)) : xx - log1pf(expf(xx));
              }
            }
        }
      return;
    }
    if (vt) {
#pragma unroll
      for (int ai = 0; ai < 2; ++ai)
#pragma unroll
        for (int m = 0; m < 4; ++m) {
          const int t = tb + 128 * ai + 16 * m;
#pragma unroll
          for (int bj = 0; bj < 2; ++bj)
#pragma unroll
            for (int n = 0; n < 2; ++n) {
              const f32x4 v = acc[ai][bj][m][n];
              const unsigned w0 = cvtpk(v[0], v[1]), w1 = cvtpk(v[2], v[3]);
              const unsigned qo = (unsigned)((32 * bj + 16 * n + 4 * fq) * T + t);
              vt[qo] = (bf16_t)(w0 & 0xffffu); vt[qo + T] = (bf16_t)(w0 >> 16); vt[qo + 2 * T] = (bf16_t)(w1 & 0xffffu); vt[qo + 3 * T] = (bf16_t)(w1 >> 16);
            }
        }
      return;
    }
    const float* ropetab = WSP(float, OFF_ROPE);
    f32x4 gv[2][2];
    if (gain) {
#pragma unroll
      for (int bj = 0; bj < 2; ++bj)
#pragma unroll
        for (int n = 0; n < 2; ++n) gv[bj][n] = *(const f32x4*)(gain + 32 * bj + 16 * n + 4 * fq);
    }
#pragma unroll
    for (int ai = 0; ai < 2; ++ai)
#pragma unroll
      for (int m = 0; m < 4; ++m) {
        f32x4 v[2][2];
#pragma unroll
        for (int bj = 0; bj < 2; ++bj)
#pragma unroll
          for (int n = 0; n < 2; ++n) v[bj][n] = acc[ai][bj][m][n];
        const int row = rowb + 128 * ai + 16 * m;
        if (gain) {
          float ss = 0.f;
#pragma unroll
          for (int bj = 0; bj < 2; ++bj)
#pragma unroll
            for (int n = 0; n < 2; ++n)
#pragma unroll
              for (int i = 0; i < 4; ++i) ss += v[bj][n][i] * v[bj][n][i];
          ss += __shfl_xor(ss, 16);
          ss += __shfl_xor(ss, 32);
          const float rstd = rsqrtf(ss * (1.0f / 64.0f) + EPS);
#pragma unroll
          for (int bj = 0; bj < 2; ++bj)
#pragma unroll
            for (int n = 0; n < 2; ++n) v[bj][n] = v[bj][n] * rstd * gv[bj][n];
        }
        if (rope) {
          const int pos = row & (T - 1);
#pragma unroll
          for (int n = 0; n < 2; ++n) {
            const f32x4* tp = (const f32x4*)(ropetab + ((size_t)pos * 32 + 16 * n + 4 * fq) * 2);
            const f32x4 t0 = tp[0], t1 = tp[1];
            const float cs[4] = {t0[0], t0[2], t1[0], t1[2]}, sn[4] = {t0[1], t0[3], t1[1], t1[3]};
#pragma unroll
            for (int i = 0; i < 4; ++i) {
              const float y1 = v[0][n][i], y2 = v[1][n][i];
              v[0][n][i] = y1 * cs[i] - y2 * sn[i];
              v[1][n][i] = y2 * cs[i] + y1 * sn[i];
            }
          }
        }
#pragma unroll
        for (int bj = 0; bj < 2; ++bj)
#pragma unroll
          for (int n = 0; n < 2; ++n) {
            f32x4 y = v[bj][n] * post;
            if (silu) {
#pragma unroll
              for (int i = 0; i < 4; ++i) y[i] = siluf_(y[i]);
            }
            u32x2 w = {cvtpk(y[0], y[1]), cvtpk(y[2], y[3])};
            *(u32x2*)(dst + (size_t)row * ld + col0 + 32 * bj + 16 * n + 4 * fq) = w;
          }
      }
  }
};
struct EpiMemKV {
  static constexpr bool PERM = false, AFTER_DRAIN = false;
  const Params* pp;
  __device__ __forceinline__ void operator()(f32x4 (&acc)[2][2][4][2], const pg8::Unit& u, int wr, int wc, int fr, int fq) const {
    kparams_t kp_ = kparams(); (void)kp_;
    const int U = u.pn * 4 + wc;
    const int rowb = u.pm * 256 + wr * 64 + fr;
#pragma unroll
    for (int ai = 0; ai < 2; ++ai)
#pragma unroll
      for (int m = 0; m < 4; ++m) {
        const int row = rowb + 128 * ai + 16 * m;
#pragma unroll
        for (int bj = 0; bj < 2; ++bj)
#pragma unroll
          for (int n = 0; n < 2; ++n) {
            const f32x4 v = acc[ai][bj][m][n];
            const unsigned w0 = cvtpk(v[0], v[1]), w1 = cvtpk(v[2], v[3]);
            const int e = 32 * bj + 16 * n + 4 * fq;
            if (U < 8) {
              u32x2 w = {w0, w1};
              *(u32x2*)(WSP(bf16_t, OFF_MK) + (size_t)row * 512 + U * 64 + e) = w;
            } else {
              const int col = (U - 8) * 64 + e, h = col >> 7, d = col & 127, b = row >> 8, mm = row & 255;
              bf16_t* q = WSP(bf16_t, OFF_MVT) + (size_t)((b * 4 + h) * 128 + d) * 256 + mm;
              q[0] = (bf16_t)(w0 & 0xffffu); q[256] = (bf16_t)(w0 >> 16); q[512] = (bf16_t)(w1 & 0xffffu); q[768] = (bf16_t)(w1 >> 16);
            }
          }
      }
  }
};
struct EpiGate {
  static constexpr bool PERM = true, AFTER_DRAIN = false;
  bf16_t* G;
  __device__ __forceinline__ void operator()(f32x4 (&acc)[2][2][4][2], const pg8::Unit& u, int wr, int wc, int fr, int fq) const {
    const int br = u.pn >> 2, colt = (u.pn & 3) * 256 + wc * 32 + 8 * fq;
    bf16_t* base = G + (size_t)br * M * 1024;
    const int rowb = u.pm * 256 + wr * 64 + fr;
#pragma unroll
    for (int ai = 0; ai < 2; ++ai)
#pragma unroll
      for (int m = 0; m < 4; ++m) {
        bf16_t* rp = base + (size_t)(rowb + 128 * ai + 16 * m) * 1024 + colt;
#pragma unroll
        for (int bj = 0; bj < 2; ++bj) {
          const f32x4 v0 = acc[ai][bj][m][0], v1 = acc[ai][bj][m][1];
          u32x4 w = {cvtpk(sigmoidf_(v0[0]), sigmoidf_(v0[1])), cvtpk(sigmoidf_(v0[2]), sigmoidf_(v0[3])),
                     cvtpk(sigmoidf_(v1[0]), sigmoidf_(v1[1])), cvtpk(sigmoidf_(v1[2]), sigmoidf_(v1[3]))};
          *(u32x4*)(rp + 128 * bj) = w;
        }
      }
  }
};
struct EpiBranch {
  static constexpr bool PERM = true, AFTER_DRAIN = false;
  const bf16_t* G; bf16_t* Uo; int first;
  __device__ __forceinline__ void operator()(f32x4 (&acc)[2][2][4][2], const pg8::Unit& u, int wr, int wc, int fr, int fq) const {
    const int colt = u.pn * 256 + wc * 32 + 8 * fq;
    const int rowb = u.pm * 256 + wr * 64 + fr;
#pragma unroll
    for (int ai = 0; ai < 2; ++ai)
#pragma unroll
      for (int m = 0; m < 4; ++m) {
        const size_t ro = (size_t)(rowb + 128 * ai + 16 * m) * 1024 + colt;
#pragma unroll
        for (int bj = 0; bj < 2; ++bj) {
          const size_t off = ro + 128 * bj;
          const u32x4 gw = *(const u32x4*)(G + off);
          float y[8];
#pragma unroll
          for (int q = 0; q < 4; ++q) {
            const f32x4 v = acc[ai][bj][m][q >> 1];
            y[2 * q] = v[(2 * q) & 3] * bflo(gw[q]);
            y[2 * q + 1] = v[(2 * q + 1) & 3] * bfhi(gw[q]);
          }
          if (!first) {
            const u32x4 uw = *(const u32x4*)(Uo + off);
#pragma unroll
            for (int q = 0; q < 4; ++q) { y[2 * q] += bflo(uw[q]); y[2 * q + 1] += bfhi(uw[q]); }
          }
          u32x4 w = {cvtpk(y[0], y[1]), cvtpk(y[2], y[3]), cvtpk(y[4], y[5]), cvtpk(y[6], y[7])};
          *(u32x4*)(Uo + off) = w;
        }
      }
  }
};
struct EpiOut {
  static constexpr bool PERM = true, AFTER_DRAIN = false;
  const float* xin; float* xout;
  __device__ __forceinline__ void operator()(f32x4 (&acc)[2][2][4][2], const pg8::Unit& u, int wr, int wc, int fr, int fq) const {
    const int colt = u.pn * 256 + wc * 32 + 8 * fq;
    const int rowb = u.pm * 256 + wr * 64 + fr;
#pragma unroll
    for (int ai = 0; ai < 2; ++ai)
#pragma unroll
      for (int m = 0; m < 4; ++m) {
        const size_t ro = (size_t)(rowb + 128 * ai + 16 * m) * 1024 + colt;
#pragma unroll
        for (int bj = 0; bj < 2; ++bj) {
          const size_t off = ro + 128 * bj;
          const f32x4 x0 = *(const f32x4*)(xin + off), x1 = *(const f32x4*)(xin + off + 4);
          *(f32x4*)(xout + off) = x0 + acc[ai][bj][m][0];
          *(f32x4*)(xout + off + 4) = x1 + acc[ai][bj][m][1];
        }
      }
  }
};
template <class Epi>
__device__ __forceinline__ void run_gemm(PG8_LAS unsigned char* lds, const bf16_t* A, const bf16_t* Bt, int Mr, int Nc, int K, const Epi& E) {
  pg8::Gemm g{A, Bt, Mr, Nc, K};
  pg8::StaticOrder S;
  S.init(Mr, Nc, gdim(), bidx());
  pg8::gemm_phase<Epi, pg8::StaticOrder, true, true>(lds, g, S, E);
}

__device__ __forceinline__ int map_in(int n) {
  const int i = n >> 6, c = n & 63;
  if (i < 20) return n;
  if (i < 28) return 1304 + (n - 1280);
  if (i < 52) return 1816 + (n - 1792);
  if (i < 60) return 3360 + (n - 3328);
  if (i < 68) return 3872 + (n - 3840);
  if (i < 76) return 4384 + (n - 4352);
  if (i == 76) return c < 24 ? 1280 + c : (c < 32 ? 3352 + (c - 24) : -1);
  return -1;
}
__device__ __forceinline__ void wave_transpose_tile(const float* __restrict__ src, int ld_src, int k0, int n0, bf16_t* __restrict__ dst,
                                                    int Kdim, int maptype, int srccol0, float* tile, int lane) {
  int nlog = n0 + lane;
  if (maptype) { const int w = nlog & 255; nlog = (nlog & ~255) + (((w & 127) >> 5) << 6) + (((w >> 7) << 5) | (w & 31)); }
  const int sc = (maptype == 1) ? map_in(nlog) : srccol0 + nlog;
  const float* sp = src + (size_t)k0 * ld_src + (sc >= 0 ? sc : 0);
#pragma unroll 32
  for (int kk = 0; kk < 64; ++kk) {
    const float v = sp[(size_t)kk * ld_src];
    tile[kk * 65 + lane] = sc >= 0 ? v : 0.f;
  }
  __builtin_amdgcn_fence(__ATOMIC_SEQ_CST, "workgroup");
  __builtin_amdgcn_wave_barrier();
  const int rsub = lane >> 5, kp = lane & 31;
#pragma unroll 8
  for (int it = 0; it < 32; ++it) {
    const int row = 2 * it + rsub;
    const float a = tile[(2 * kp) * 65 + row], b = tile[(2 * kp + 1) * 65 + row];
    *(unsigned*)(dst + (size_t)(n0 + row) * Kdim + k0 + 2 * kp) = cvtpk(a, b);
  }
  __builtin_amdgcn_fence(__ATOMIC_SEQ_CST, "workgroup");
  __builtin_amdgcn_wave_barrier();
}
__device__ __forceinline__ void rmsnorm4(const float* __restrict__ x, const float* __restrict__ gain, bf16_t* __restrict__ dst, size_t row0, int lane) {
  f32x4 v[4][4];
  float ss[4];
#pragma unroll
  for (int rr = 0; rr < 4; ++rr)
#pragma unroll
    for (int i = 0; i < 4; ++i) v[rr][i] = *(const f32x4*)(x + (row0 + rr) * 1024 + lane * 4 + 256 * i);
  f32x4 gv[4];
#pragma unroll
  for (int i = 0; i < 4; ++i) gv[i] = *(const f32x4*)(gain + lane * 4 + 256 * i);
#pragma unroll
  for (int rr = 0; rr < 4; ++rr) {
    float s = 0.f;
#pragma unroll
    for (int i = 0; i < 4; ++i) s += v[rr][i][0] * v[rr][i][0] + v[rr][i][1] * v[rr][i][1] + v[rr][i][2] * v[rr][i][2] + v[rr][i][3] * v[rr][i][3];
    ss[rr] = s;
  }
#pragma unroll
  for (int o_ = 1; o_ < 64; o_ <<= 1) {
#pragma unroll
    for (int rr = 0; rr < 4; ++rr) ss[rr] += __shfl_xor(ss[rr], o_);
  }
#pragma unroll
  for (int rr = 0; rr < 4; ++rr) {
    const float rstd = rsqrtf(ss[rr] * (1.0f / 1024.0f) + EPS);
#pragma unroll
    for (int i = 0; i < 4; ++i) {
      const f32x4 y = v[rr][i] * rstd * gv[i];
      u32x2 w = {cvtpk(y[0], y[1]), cvtpk(y[2], y[3])};
      *(u32x2*)(dst + (row0 + rr) * 1024 + lane * 4 + 256 * i) = w;
    }
  }
}
__device__ __forceinline__ void phase_prep(const Params& p, int l, float* smem) {
  kparams_t kp_ = kparams(); (void)kp_;
  const int tid = tidx();
  const int wave = tid >> 6, lane = tid & 63;
  const int gw = wave * gdim() + bidx(), nw = NWAVES * gdim();
  if (l == 0 && bidx() == 0 && tid < 64) WSP(unsigned, OFF_CTL)[tid] = 0u;
  const float* xin = (l == 0) ? kp_->x : kp_->out;
  float* wtile = smem + wave * 4160;
  for (int u0 = gw; u0 < 3076; u0 += nw) {
    int u = u0;
    const float* src; int ld, kt, nt, Kd, mt = 0, c0 = 0; bf16_t* dst;
    if (u < 1280) { kt = u / 80; nt = u % 80; src = kp_->w_in + (size_t)l * 1024 * 7968; ld = 7968; Kd = 1024; dst = WSP(bf16_t, OFF_W_IN); mt = 1; }
    else if ((u -= 1280) < 768) { kt = u / 48; nt = u % 48; src = kp_->w_in + (size_t)l * 1024 * 7968; ld = 7968; Kd = 1024; dst = WSP(bf16_t, OFF_W_G); c0 = 4896; }
    else if ((u -= 768) < 256) { kt = u / 16; nt = u % 16; src = kp_->w_mem_kv + (size_t)l * 1024 * 1024; ld = 1024; Kd = 1024; dst = WSP(bf16_t, OFF_W_MKV); mt = 2; }
    else if ((u -= 256) < 384) { const int br = u / 128, uu = u % 128; kt = uu / 16; nt = uu % 16;
      src = (br == 0 ? kp_->w_branch_a : br == 1 ? kp_->w_branch_b : kp_->w_branch_m) + (size_t)l * 512 * 1024; ld = 1024; Kd = 512; dst = WSP(bf16_t, OFF_W_BR + (size_t)br * MiB); }
    else if ((u -= 384) < 256) { kt = u / 16; nt = u % 16; src = kp_->w_out + (size_t)l * 1024 * 1024; ld = 1024; Kd = 1024; dst = WSP(bf16_t, OFF_W_OUT); }
    else if ((u -= 256) < 128) { const int kv = u / 64, uu = u % 64; kt = uu / 2; nt = uu % 2;
      src = (kv ? kp_->cmp_w1_v : kp_->cmp_w1_k) + (size_t)l * 2048 * 128; ld = 128; Kd = 2048; dst = WSP(bf16_t, OFF_W1 + (size_t)kv * 512 * 1024); }
    else { u -= 128; const int kv = u / 2; kt = u % 2; nt = 0;
      src = (kv ? kp_->cmp_w2_v : kp_->cmp_w2_k) + (size_t)l * 128 * 64; ld = 64; Kd = 128; dst = WSP(bf16_t, OFF_W2 + (size_t)kv * 64 * 1024); }
    wave_transpose_tile(src, ld, kt * 64, nt * 64, dst, Kd, mt, c0, wtile, lane);
  }
  for (int grp = gw; grp < 8192 + 256; grp += nw) {
    if (grp < 8192) rmsnorm4(xin, kp_->norm_g + l * 1024, WSP(bf16_t, OFF_H), (size_t)grp * 4, lane);
    else rmsnorm4(kp_->mem, kp_->mem_norm_g + l * 1024, WSP(bf16_t, OFF_MEMN), (size_t)(grp - 8192) * 4, lane);
  }
  for (int u = gw; u < 32; u += nw) {
    const int kv = u >> 4, ch = u & 15;
    const float* pe = (kv ? kp_->cmp_pe_v : kp_->cmp_pe_k) + (size_t)l * 2048 + ch * 128;
    const float* w1 = (kv ? kp_->cmp_w1_v : kp_->cmp_w1_k) + (size_t)l * 2048 * 128 + (size_t)ch * 128 * 128;
    float s0 = 0.f, s1 = 0.f;
#pragma unroll 32
    for (int kk = 0; kk < 128; ++kk) {
      const float pv = pe[kk];
      s0 += pv * w1[(size_t)kk * 128 + lane];
      s1 += pv * w1[(size_t)kk * 128 + 64 + lane];
    }
    float* part = WSP(float, OFF_C1) + (size_t)(kv * 16 + ch) * 128;
    part[lane] = s0;
    part[64 + lane] = s1;
  }
  if (l == 0) {
    for (int u = bidx(); u < 512; u += gdim()) {
      for (int e = tid; e < 512; e += NTHREADS) {
        const int idx = u * 512 + e, pos = idx >> 5, f = idx & 31;
        const float ang = (float)pos * c_inv_freq[f];
        const double a = (double)ang;
        const double k = rint(a * 0.15915494309189535);
        const float rr = (float)(a - k * 6.283185307179586);
        float2 cs; cs.x = __cosf(rr); cs.y = __sinf(rr);
        WSP(float2, OFF_ROPE)[idx] = cs;
      }
    }
  }
}

__device__ __forceinline__ void compress_wg(const Params& p, int l, int up, float* smem) {
  kparams_t kp_ = kparams(); (void)kp_;
  const int wave_ = tidx() >> 6, kc = wave_ & 3, u = up * 2 + (wave_ >> 2);
  const int lane = tidx() & 63, r = lane & 15, g4 = lane >> 4;
  const int kv = u >> 7, rem = u & 127, b = rem >> 5, grp = (rem >> 4) & 1, it = rem & 15, i0 = it * 32;
  const bf16_t* src = WSP(bf16_t, kv ? OFF_VC : OFF_KC);
  const bf16_t* w1t = WSP(bf16_t, OFF_W1 + (size_t)kv * 512 * 1024);
  const bf16_t* w2t = WSP(bf16_t, OFF_W2 + (size_t)kv * 64 * 1024);
  const float* c1 = WSP(float, OFF_C1 + 16384) + kv * 128;
  const bf16_t* arow[2];
#pragma unroll
  for (int mt = 0; mt < 2; ++mt) {
    int i = i0 + 16 * mt + r;
    if (i > 510) i = 510;
    arow[mt] = src + ((size_t)b * T + 16 * i) * 128 + grp * 64 + g4 * 8;
  }
  f32x4 acc[2][8];
#pragma unroll
  for (int a = 0; a < 2; ++a)
#pragma unroll
    for (int c = 0; c < 8; ++c) acc[a][c] = (f32x4){0.f, 0.f, 0.f, 0.f};
  const bf16_t* bp = w1t + (size_t)r * 2048 + g4 * 8;
#pragma unroll 1
  for (int k0 = kc * 512; k0 < kc * 512 + 512; k0 += 32) {
    const int pp = k0 >> 6, d = k0 & 63;
    bf16x8 af[2], bf[8];
#pragma unroll
    for (int mt = 0; mt < 2; ++mt) af[mt] = *(const bf16x8*)(arow[mt] + (size_t)pp * 128 + d);
#pragma unroll
    for (int nt = 0; nt < 8; ++nt) bf[nt] = *(const bf16x8*)(bp + (size_t)nt * 16 * 2048 + k0);
#pragma unroll
    for (int mt = 0; mt < 2; ++mt)
#pragma unroll
      for (int nt = 0; nt < 8; ++nt) acc[mt][nt] = mfma16(bf[nt], af[mt], acc[mt][nt]);
  }
  {
    float* part = smem + wave_ * 4096;
#pragma unroll
    for (int a = 0; a < 2; ++a)
#pragma unroll
      for (int c = 0; c < 8; ++c)
#pragma unroll
        for (int i = 0; i < 4; ++i) part[((a * 8 + c) * 4 + i) * 64 + lane] = acc[a][c][i];
  }
  __syncthreads();
  if (kc != 0) return;
#pragma unroll 1
  for (int q = 1; q < 4; ++q) {
    const float* part = smem + (wave_ + q) * 4096;
#pragma unroll
    for (int a = 0; a < 2; ++a) {
#pragma unroll
      for (int c = 0; c < 8; ++c)
#pragma unroll
        for (int i = 0; i < 4; ++i) acc[a][c][i] += part[((a * 8 + c) * 4 + i) * 64 + lane];
      asm volatile("" ::: "memory");
    }
  }
#pragma unroll
  for (int nt = 0; nt < 8; ++nt) {
    const f32x4 cv = *(const f32x4*)(c1 + 16 * nt + 4 * g4);
#pragma unroll
    for (int mt = 0; mt < 2; ++mt)
#pragma unroll
      for (int i = 0; i < 4; ++i) acc[mt][nt][i] = siluf_(acc[mt][nt][i] + cv[i]);
  }
  bf16x8 wf[4][4];
#pragma unroll
  for (int ks = 0; ks < 4; ++ks)
#pragma unroll
    for (int et = 0; et < 4; ++et) {
      const bf16_t* wp = w2t + (size_t)(16 * et + r) * 128 + 32 * ks + 4 * g4;
      const u32x2 lo = *(const u32x2*)wp, hi = *(const u32x2*)(wp + 16);
      u32x4 w = {lo[0], lo[1], hi[0], hi[1]};
      wf[ks][et] = __builtin_bit_cast(bf16x8, w);
    }
  if (kv == 0) {
    const float* gain = kp_->nsa_k_norm + (size_t)(l * 3 + 0) * 64;
    bf16_t* dst = WSP(bf16_t, OFF_KCMP) + (size_t)((b * 2 + grp) * 512) * 64;
    f32x4 gv[4];
#pragma unroll
    for (int et = 0; et < 4; ++et) gv[et] = *(const f32x4*)(gain + 16 * et + 4 * g4);
#pragma unroll
    for (int mt = 0; mt < 2; ++mt) {
      f32x4 o[4];
#pragma unroll
      for (int et = 0; et < 4; ++et) o[et] = (f32x4){0.f, 0.f, 0.f, 0.f};
#pragma unroll
      for (int ks = 0; ks < 4; ++ks) {
        const bf16x8 xf = pack8(acc[mt][2 * ks], acc[mt][2 * ks + 1]);
#pragma unroll
        for (int et = 0; et < 4; ++et) o[et] = mfma16(wf[ks][et], xf, o[et]);
      }
      float ss = 0.f;
#pragma unroll
      for (int et = 0; et < 4; ++et)
#pragma unroll
        for (int i = 0; i < 4; ++i) ss += o[et][i] * o[et][i];
      ss += __shfl_xor(ss, 16);
      ss += __shfl_xor(ss, 32);
      const float rstd = rsqrtf(ss * (1.0f / 64.0f) + EPS);
      const int i = i0 + 16 * mt + r;
#pragma unroll
      for (int et = 0; et < 4; ++et) {
        f32x4 y = o[et] * rstd * gv[et];
        if (i > 510) y = (f32x4){0.f, 0.f, 0.f, 0.f};
        u32x2 w = {cvtpk(y[0], y[1]), cvtpk(y[2], y[3])};
        *(u32x2*)(dst + (size_t)i * 64 + 16 * et + 4 * g4) = w;
      }
    }
  } else {
    bf16_t* dst = WSP(bf16_t, OFF_VCT) + (size_t)((b * 2 + grp) * 64) * 512;
#pragma unroll
    for (int mt = 0; mt < 2; ++mt) {
      f32x4 o[4];
#pragma unroll
      for (int et = 0; et < 4; ++et) o[et] = (f32x4){0.f, 0.f, 0.f, 0.f};
#pragma unroll
      for (int ks = 0; ks < 4; ++ks) {
        const bf16x8 xf = pack8(acc[mt][2 * ks], acc[mt][2 * ks + 1]);
#pragma unroll
        for (int et = 0; et < 4; ++et) o[et] = mfma16(xf, wf[ks][et], o[et]);
      }
#pragma unroll
      for (int et = 0; et < 4; ++et) {
        f32x4 y = o[et];
        const int ib = i0 + 16 * mt + 4 * g4;
#pragma unroll
        for (int i = 0; i < 4; ++i)
          if (ib + i > 510) y[i] = 0.f;
        u32x2 w = {cvtpk(y[0], y[1]), cvtpk(y[2], y[3])};
        *(u32x2*)(dst + (size_t)(16 * et + r) * 512 + ib) = w;
      }
    }
  }
}
__device__ __forceinline__ void cumsum_wg(const Params& p, int u, float* smem) {
  kparams_t kp_ = kparams(); (void)kp_;
  const int tid = tidx(), lane = tid & 63, wave = tid >> 6, b = u >> 3, h = u & 7;
  const float* fl = WSP(float, OFF_FLOG) + ((size_t)b * T) * 8 + h;
  float* fc = WSP(float, OFF_FC) + (size_t)(b * 8 + h) * T;
  const int tb = tid * 16;
  float v[16];
#pragma unroll
  for (int i = 0; i < 16; ++i) v[i] = fl[(size_t)(tb + i) * 8];
  double s = 0.0;
#pragma unroll
  for (int i = 0; i < 16; ++i) s += (double)v[i];
  double incl = s;
#pragma unroll
  for (int o = 1; o < 64; o <<= 1) {
    const double y = __shfl_up(incl, o);
    if (lane >= o) incl += y;
  }
  double* wtot = (double*)smem;
  if (lane == 63) wtot[wave] = incl;
  __syncthreads();
  double base = 0.0;
  for (int w = 0; w < wave; ++w) base += wtot[w];
  double run = base + incl - s;
#pragma unroll
  for (int i = 0; i < 16; ++i) { run += (double)v[i]; v[i] = (float)run; }
#pragma unroll
  for (int i = 0; i < 4; ++i) *(f32x4*)(fc + tb + 4 * i) = (f32x4){v[4 * i], v[4 * i + 1], v[4 * i + 2], v[4 * i + 3]};
  __syncthreads();
}
__device__ __forceinline__ void memk_norm_unit(const Params& p, int l, int u) {
  kparams_t kp_ = kparams(); (void)kp_;
  const int lane = tidx() & 63;
  bf16_t* mk = WSP(bf16_t, OFF_MK);
  const float* gain = kp_->mem_k_norm + l * 128 + (lane & 15) * 8;
  for (int rr = 0; rr < 16; ++rr) {
    bf16_t* ptr = mk + (size_t)(u * 16 + rr) * 512 + lane * 8;
    const u32x4 w = *(const u32x4*)ptr;
    float v[8];
#pragma unroll
    for (int j = 0; j < 4; ++j) { v[2 * j] = bflo(w[j]); v[2 * j + 1] = bfhi(w[j]); }
    float ss = 0.f;
#pragma unroll
    for (int j = 0; j < 8; ++j) ss += v[j] * v[j];
#pragma unroll
    for (int o = 1; o < 16; o <<= 1) ss += __shfl_xor(ss, o);
    const float rstd = rsqrtf(ss * (1.0f / 128.0f) + EPS);
    u32x4 ow;
#pragma unroll
    for (int j = 0; j < 4; ++j) ow[j] = cvtpk(v[2 * j] * rstd * gain[2 * j], v[2 * j + 1] * rstd * gain[2 * j + 1]);
    *(u32x4*)ptr = ow;
  }
}
__device__ __forceinline__ void phase_mid(const Params& p, int l, float* smem) {
  const int wave = tidx() >> 6;
  for (int u = bidx(); u < 128 + 32 + 8; u += gdim()) {
    if (u < 128) { compress_wg(p, l, u, smem); __syncthreads(); }
    else if (u < 160) cumsum_wg(p, u - 128, smem);
    else memk_norm_unit(p, l, (u - 160) * 8 + wave);
  }
}

template <int NCT, int NDK, bool QL = false>
__device__ __forceinline__ void qk_scores(const bf16_t* __restrict__ kbase, int ldk, int key0,
                                          const bf16x8 (&qf)[NCT][NDK], f32x4 (&s)[2][NCT], int lane, const bf16x8* qlds = nullptr) {
  const int r = lane & 15, grp = lane >> 4;
#pragma unroll
  for (int kt = 0; kt < 2; ++kt) {
    const bf16_t* kp = kbase + (size_t)(key0 + 8 * (r >> 2) + 4 * kt + (r & 3)) * ldk + grp * 8;
    bf16x8 kf[NDK];
#pragma unroll
    for (int dk = 0; dk < NDK; ++dk) kf[dk] = *(const bf16x8*)(kp + dk * 32);
#pragma unroll
    for (int ct = 0; ct < NCT; ++ct) {
      f32x4 a = {0.f, 0.f, 0.f, 0.f};
#pragma unroll
      for (int dk = 0; dk < NDK; ++dk) a = mfma16(kf[dk], QL ? qlds[(ct * NDK + dk) * 64 + lane] : qf[ct][dk], a);
      s[kt][ct] = a;
    }
  }
}
template <int NCT, int NDT>
__device__ __forceinline__ void pv_accum(const bf16_t* __restrict__ vt, size_t ldv, int key0,
                                         const f32x4 (&s)[2][NCT], f32x4 (&o)[NDT][NCT], int lane) {
  const int r = lane & 15, grp = lane >> 4;
  bf16x8 pb[NCT];
#pragma unroll
  for (int ct = 0; ct < NCT; ++ct) pb[ct] = pack8(s[0][ct], s[1][ct]);
#pragma unroll
  for (int dt = 0; dt < NDT; ++dt) {
    const bf16x8 vf = *(const bf16x8*)(vt + (size_t)(16 * dt + r) * ldv + key0 + 8 * grp);
#pragma unroll
    for (int ct = 0; ct < NCT; ++ct) o[dt][ct] = mfma16(vf, pb[ct], o[dt][ct]);
  }
}
template <int NCT, int NDT, bool HAS_O, bool SUMS = true>
__device__ __forceinline__ void softmax_update(f32x4 (&s)[2][NCT], float (&m)[NCT], float (&lsum)[NCT],
                                               f32x4 (&o)[NDT][NCT], f32x4 (*lacc)[NCT] = nullptr) {
  float mnew[NCT];
  bool ch = false;
#pragma unroll
  for (int ct = 0; ct < NCT; ++ct) {
    float mx = fmaxf(fmaxf(fmaxf(s[0][ct][0], s[0][ct][1]), fmaxf(s[0][ct][2], s[0][ct][3])),
                     fmaxf(fmaxf(s[1][ct][0], s[1][ct][1]), fmaxf(s[1][ct][2], s[1][ct][3])));
    mx = grp_max4(mx);
    mnew[ct] = fmaxf(m[ct], mx);
    ch = ch || (mnew[ct] > m[ct]);
  }
  if (__any(ch)) {
#pragma unroll
    for (int ct = 0; ct < NCT; ++ct) {
      const float msafe = (mnew[ct] == NEG_INF) ? 0.f : mnew[ct];
      const float alpha = __builtin_amdgcn_exp2f(m[ct] - msafe);
      m[ct] = mnew[ct];
      if (SUMS) lsum[ct] *= alpha; else (*lacc)[ct] = (*lacc)[ct] * alpha;
      if (HAS_O) {
#pragma unroll
        for (int dt = 0; dt < NDT; ++dt) o[dt][ct] = o[dt][ct] * alpha;
      }
    }
  }
#pragma unroll
  for (int ct = 0; ct < NCT; ++ct) {
    const float msafe = (m[ct] == NEG_INF) ? 0.f : m[ct];
#pragma unroll
    for (int kt = 0; kt < 2; ++kt) {
      const f32x4 d = s[kt][ct] - msafe;
      f32x4 pv;
#pragma unroll
      for (int i = 0; i < 4; ++i) pv[i] = __builtin_amdgcn_exp2f(d[i]);
      s[kt][ct] = pv;
    }
    if (SUMS) {
      const f32x4 t4 = s[0][ct] + s[1][ct];
      lsum[ct] += (t4[0] + t4[1]) + (t4[2] + t4[3]);
    }
  }
}
__device__ __forceinline__ float finish_l(float lsum) {
  lsum += __shfl_xor(lsum, 16);
  lsum += __shfl_xor(lsum, 32);
  return lsum > 0.f ? 1.0f / lsum : 0.f;
}

typedef __attribute__((address_space(3))) unsigned char lds_u8;
constexpr int TILE_ROWB = 144, TILE_HALF = 64 * TILE_ROWB, TILE_STAGE = 2 * TILE_HALF + 256;
struct TileRegs { u32x4 k, v; };
__device__ __forceinline__ void tile_gload(TileRegs& tr, const bf16_t* __restrict__ kbase, int ldk, const bf16_t* __restrict__ vtbase,
                                           size_t ldv, int key0, int tid) {
  const int row = tid >> 3, ch = tid & 7;
  tr.k = *(const u32x4*)(kbase + (size_t)(key0 + row) * ldk + ch * 8);
  tr.v = *(const u32x4*)(vtbase + (size_t)row * ldv + key0 + ch * 8);
}
__device__ __forceinline__ void tile_swrite(const TileRegs& tr, lds_u8* stage, int tid) {
  const int row = tid >> 3, ch = tid & 7;
  *(__attribute__((address_space(3))) u32x4*)(stage + row * TILE_ROWB + ch * 16) = tr.k;
  *(__attribute__((address_space(3))) u32x4*)(stage + TILE_HALF + row * TILE_ROWB + ch * 16) = tr.v;
}
template <int NCT, int NDK, bool QL>
__device__ __forceinline__ void qk_scores_lds(const lds_u8* stage, int hf, const bf16x8 (&qf)[NCT][NDK], f32x4 (&s)[2][NCT], int lane,
                                              const bf16x8* qlds, const f32x4 c0, const f32x4 c1) {
  const int r = lane & 15, grp = lane >> 4;
#pragma unroll
  for (int kt = 0; kt < 2; ++kt) {
    const lds_u8* kp = stage + (32 * hf + 8 * (r >> 2) + 4 * kt + (r & 3)) * TILE_ROWB + grp * 16;
    bf16x8 kf[NDK];
#pragma unroll
    for (int dk = 0; dk < NDK; ++dk) kf[dk] = *(const __attribute__((address_space(3))) bf16x8*)(kp + dk * 64);
#pragma unroll
    for (int ct = 0; ct < NCT; ++ct) {
      f32x4 a = kt ? c1 : c0;
#pragma unroll
      for (int dk = 0; dk < NDK; ++dk) a = mfma16(kf[dk], QL ? qlds[(ct * NDK + dk) * 64 + lane] : qf[ct][dk], a);
      s[kt][ct] = a;
    }
  }
}
template <int NDT>
__device__ __forceinline__ void v_frags_lds(const lds_u8* stage, int hf, bf16x8 (&vf)[NDT], int lane) {
  const int r = lane & 15, grp = lane >> 4;
#pragma unroll
  for (int dt = 0; dt < NDT; ++dt)
    vf[dt] = *(const __attribute__((address_space(3))) bf16x8*)(stage + TILE_HALF + (16 * dt + r) * TILE_ROWB + (32 * hf + 8 * grp) * 2);
}
template <int NCT, int NDT>
__device__ __forceinline__ void pv_accum_lds(const bf16x8 (&vfp)[NDT], const f32x4 (&s)[2][NCT], f32x4 (&o)[NDT][NCT], int lane, f32x4 (&lacc)[NCT]) {
  const int r = lane & 15, grp = lane >> 4; (void)r; (void)grp;
  bf16x8 pb[NCT];
#pragma unroll
  for (int ct = 0; ct < NCT; ++ct) pb[ct] = pack8(s[0][ct], s[1][ct]);
  {
    const short one = (short)0x3F80;
    const bf16x8 ones = {one, one, one, one, one, one, one, one};
#pragma unroll
    for (int ct = 0; ct < NCT; ++ct) lacc[ct] = mfma16(ones, pb[ct], lacc[ct]);
  }
#pragma unroll
  for (int dt = 0; dt < NDT; ++dt) {
    const bf16x8 vf = vfp[dt];
#pragma unroll
    for (int ct = 0; ct < NCT; ++ct) o[dt][ct] = mfma16(vf, pb[ct], o[dt][ct]);
  }
}
__device__ __forceinline__ int next_bit(unsigned long long lo, unsigned long long hi, int from) {
  if (from < 64) { const unsigned long long mm = lo & (~0ull << from); if (mm) return __ffsll(mm) - 1; from = 64; }
  if (from < 128) { const unsigned long long mm = hi & (~0ull << (from - 64)); if (mm) return 64 + __ffsll(mm) - 1; }
  return 128;
}

__device__ __forceinline__ void nsa_wg_unit(const Params& p, int b, int g, int qi, float* imp, bf16x8* qlds, float* scr, lds_u8* tiles, unsigned* misc, bool st) {
  kparams_t kp_ = kparams(); (void)kp_;
  const int tid0 = tidx();
  const int wave = __builtin_amdgcn_readfirstlane(tid0 >> 6);
  const int lane0 = tid0 & 63;
  const int tq = qi * 8 + wave;
  const int t0 = tq * 16;
  const bf16x8 (&qf)[4][2] = *(const bf16x8 (*)[4][2])nullptr;
#define NSA_SECTION_VARS \
  int lane = lane0; asm volatile("" : "+v"(lane)); \
  const int r = lane & 15, grp = lane >> 4, t = t0 + r; \
  const size_t row = (size_t)b * T + t; \
  const float* gatep = WSP(float, OFF_GATE) + row * 24 + g * 12; (void)gatep; (void)grp; (void)t;
  {
    NSA_SECTION_VARS
#pragma unroll
    for (int ct = 0; ct < 4; ++ct)
#pragma unroll
      for (int dk = 0; dk < 2; ++dk)
        qlds[(ct * 2 + dk) * 64 + lane] = *(const bf16x8*)(WSP(bf16_t, OFF_QN) + row * 512 + (g * 4 + ct) * 64 + dk * 32 + grp * 8);
  }
  f32x4 o[4][4];
  float m[4], lsum[4];
  f32x4 lacc[4];
  {
    NSA_SECTION_VARS
    const bf16_t* kc = WSP(bf16_t, OFF_KCMP) + (size_t)((b * 2 + g) * 512) * 64;
    const bf16_t* vct = WSP(bf16_t, OFF_VCT) + (size_t)((b * 2 + g) * 64) * 512;
    const int nblk = (tq + 31) >> 5;
#pragma unroll
    for (int ct = 0; ct < 4; ++ct) { m[ct] = NEG_INF; lsum[ct] = 0.f; }
#pragma unroll 1
    for (int blk = 0; blk < nblk; ++blk) {
      f32x4 s[2][4];
      qk_scores<4, 2, true>(kc, 64, blk * 32, qf, s, lane, qlds);
#pragma unroll
      for (int kt = 0; kt < 2; ++kt)
#pragma unroll
        for (int i = 0; i < 4; ++i) {
          const int n = blk * 32 + 8 * grp + 4 * kt + i;
          const bool ok = (16 * n + 31 <= t);
#pragma unroll
          for (int ct = 0; ct < 4; ++ct) s[kt][ct][i] = ok ? s[kt][ct][i] : NEG_INF;
        }
      softmax_update<4, 4, false>(s, m, lsum, o);
    }
    float invl[4], msafe[4];
#pragma unroll
    for (int ct = 0; ct < 4; ++ct) { invl[ct] = finish_l(lsum[ct]); msafe[ct] = (m[ct] == NEG_INF) ? 0.f : m[ct]; }
    for (int e = lane; e < 16 * 132; e += 64) imp[e] = 0.f;
    __builtin_amdgcn_fence(__ATOMIC_SEQ_CST, "workgroup");
    __builtin_amdgcn_wave_barrier();
#pragma unroll
    for (int dt = 0; dt < 4; ++dt)
#pragma unroll
      for (int ct = 0; ct < 4; ++ct) o[dt][ct] = (f32x4){0.f, 0.f, 0.f, 0.f};
#pragma unroll 1
    for (int blk = 0; blk < nblk; ++blk) {
      f32x4 s[2][4];
      qk_scores<4, 2, true>(kc, 64, blk * 32, qf, s, lane, qlds);
      float pq[2][4];
#pragma unroll
      for (int kt = 0; kt < 2; ++kt)
#pragma unroll
        for (int i = 0; i < 4; ++i) {
          const int n = blk * 32 + 8 * grp + 4 * kt + i;
          const bool ok = (16 * n + 31 <= t);
          float acc_p = 0.f;
#pragma unroll
          for (int ct = 0; ct < 4; ++ct) {
            const float pv = ok ? __builtin_amdgcn_exp2f(s[kt][ct][i] - msafe[ct]) * invl[ct] : 0.f;
            s[kt][ct][i] = pv;
            acc_p += pv;
          }
          pq[kt][i] = acc_p;
        }
      float* ir = imp + r * 132 + blk * 8 + 2 * grp;
      ir[0] += pq[0][0] + pq[0][1] + pq[0][2] + 0.5f * pq[0][3];
      __builtin_amdgcn_fence(__ATOMIC_SEQ_CST, "workgroup");
      __builtin_amdgcn_wave_barrier();
      ir[1] += pq[1][0] + pq[1][1] + pq[1][2] + 0.5f * pq[1][3] + 0.5f * pq[0][3];
      __builtin_amdgcn_fence(__ATOMIC_SEQ_CST, "workgroup");
      __builtin_amdgcn_wave_barrier();
      ir[2] += 0.5f * pq[1][3];
      __builtin_amdgcn_fence(__ATOMIC_SEQ_CST, "workgroup");
      __builtin_amdgcn_wave_barrier();
      pv_accum<4, 4>(vct, 512, blk * 32, s, o, lane);
    }
    f32x4 gt[4];
#pragma unroll
    for (int ct = 0; ct < 4; ++ct) gt[ct][0] = gatep[ct * 3 + 0];
#pragma unroll
    for (int dt = 0; dt < 4; ++dt) {
#pragma unroll
      for (int ct = 0; ct < 4; ++ct)
#pragma unroll
        for (int i = 0; i < 4; ++i) scr[((dt * 4 + ct) * 4 + i) * 64 + lane] = o[dt][ct][i] * gt[ct][0];
      asm volatile("" ::: "memory");
    }
  }
  const int cur = t0 >> 6;
  unsigned long long sel_lo = 0ull, sel_hi = 0ull;
  {
  NSA_SECTION_VARS
  if (cur <= 15) {
    sel_lo = (1ull << (cur + 1)) - 1ull;
  } else {
    __builtin_amdgcn_fence(__ATOMIC_SEQ_CST, "workgroup");
    __builtin_amdgcn_wave_barrier();
    float v[32];
#pragma unroll
    for (int k = 0; k < 32; ++k) {
      const int j = grp + 4 * k;
      const float x = imp[r * 132 + j];
      v[k] = (j >= 1 && j <= cur - 2) ? x : NEG_INF;
    }
#pragma unroll 1
    for (int round = 0; round < 13; ++round) {
      float best = NEG_INF;
      int bj = 1 << 20;
#pragma unroll
      for (int k = 0; k < 32; ++k) {
        const bool tk = v[k] > best;
        best = tk ? v[k] : best;
        bj = tk ? (grp + 4 * k) : bj;
      }
#pragma unroll
      for (int off = 16; off <= 32; off <<= 1) {
        const float ob = __shfl_xor(best, off);
        const int oj = __shfl_xor(bj, off);
        const bool tk = (ob > best) || (ob == best && oj < bj);
        best = tk ? ob : best;
        bj = tk ? oj : bj;
      }
      if (bj < 64) sel_lo |= 1ull << bj; else if (bj < 128) sel_hi |= 1ull << (bj - 64);
#pragma unroll
      for (int k = 0; k < 32; ++k) v[k] = (bj == grp + 4 * k) ? NEG_INF : v[k];
    }
    sel_lo |= 1ull;
    if (cur < 64) sel_lo |= 1ull << cur; else sel_hi |= 1ull << (cur - 64);
    if (cur - 1 < 64) sel_lo |= 1ull << (cur - 1); else sel_hi |= 1ull << (cur - 1 - 64);
  }
  }
  asm volatile("" : "+v"(sel_lo), "+v"(sel_hi));
  atomicOr(&misc[4], (unsigned)sel_lo); atomicOr(&misc[5], (unsigned)(sel_lo >> 32));
  atomicOr(&misc[6], (unsigned)sel_hi); atomicOr(&misc[7], (unsigned)(sel_hi >> 32));
  __syncthreads();
  unsigned long long ulo, uhi;
  {
    const unsigned u0 = __builtin_amdgcn_readfirstlane(misc[4]), u1 = __builtin_amdgcn_readfirstlane(misc[5]);
    const unsigned u2 = __builtin_amdgcn_readfirstlane(misc[6]), u3 = __builtin_amdgcn_readfirstlane(misc[7]);
    ulo = ((unsigned long long)u1 << 32) | u0; uhi = ((unsigned long long)u3 << 32) | u2;
  }
  {
    NSA_SECTION_VARS
    const int tid = (wave << 6) | lane;
    const int hq = r >> 2, qq = r & 3;
    const bf16_t* ks = WSP(bf16_t, OFF_KS) + ((size_t)b * T) * 128 + g * 64;
    const bf16_t* vst = WSP(bf16_t, OFF_VST) + (size_t)((b * 2 + g) * 64) * T;
    bf16x8 qr[4][2];
    unsigned long long mlo[4], mhi[4];
#pragma unroll
    for (int ct = 0; ct < 4; ++ct) {
      const size_t rowq = (size_t)b * T + t0 + 4 * ct + qq;
#pragma unroll
      for (int dk = 0; dk < 2; ++dk)
        qr[ct][dk] = *(const bf16x8*)(WSP(bf16_t, OFF_QN) + rowq * 512 + (g * 4 + hq) * 64 + dk * 32 + grp * 8);
      const int srcl = (lane & 48) | (4 * ct + qq);
      mlo[ct] = __shfl(sel_lo, srcl);
      mhi[ct] = __shfl(sel_hi, srcl);
      m[ct] = NEG_INF; lacc[ct] = (f32x4){0.f, 0.f, 0.f, 0.f};
    }
#pragma unroll
    for (int dt = 0; dt < 4; ++dt)
#pragma unroll
      for (int ct = 0; ct < 4; ++ct) o[dt][ct] = (f32x4){0.f, 0.f, 0.f, 0.f};
    const short one_ = (short)0x3F80;
    const bf16x8 ones = {one_, one_, one_, one_, one_, one_, one_, one_};
    TileRegs tr, trb;
    int jA = next_bit(ulo, uhi, 0), it = 0;
    int jB = next_bit(ulo, uhi, jA + 1);
    tile_gload(tr, ks, 128, vst, T, 64 * jA, tid);
    if (jB < 128) tile_gload(trb, ks, 128, vst, T, 64 * jB, tid);
    tile_swrite(tr, tiles, tid);
    if (jB < 128) tile_swrite(trb, tiles + TILE_STAGE, tid);
    __syncthreads();
#pragma unroll 1
    while (jA < 128) {
      const int nA = (jB < 128) ? next_bit(ulo, uhi, jB + 1) : 128;
      const int nB = (nA < 128) ? next_bit(ulo, uhi, nA + 1) : 128;
      if (nA < 128) tile_gload(tr, ks, 128, vst, T, 64 * nA, tid);
      if (nB < 128) tile_gload(trb, ks, 128, vst, T, 64 * nB, tid);
#pragma unroll 1
      for (int sub = 0; sub < 2; ++sub) {
      const int j = sub ? jB : jA;
      if (j >= 128) break;
      const lds_u8* stage = tiles + (2 * (it & 1) + sub) * TILE_STAGE;
      bool mine[4], need[4], anyneed = false;
#pragma unroll
      for (int ct = 0; ct < 4; ++ct) {
        mine[ct] = ((j < 64 ? (mlo[ct] >> j) : (mhi[ct] >> (j - 64))) & 1ull) != 0ull;
        need[ct] = __any(mine[ct]) != 0;
        anyneed = anyneed || need[ct];
      }
      if (anyneed) {
#pragma unroll
        for (int hf = 0; hf < 2; ++hf) {
          const int key0 = j * 64 + hf * 32;
          bf16x8 kf[2][2];
#pragma unroll
          for (int kt = 0; kt < 2; ++kt) {
            const lds_u8* kp = stage + (32 * hf + 8 * (r >> 2) + 4 * kt + (r & 3)) * TILE_ROWB + grp * 16;
#pragma unroll
            for (int dk = 0; dk < 2; ++dk) kf[kt][dk] = *(const __attribute__((address_space(3))) bf16x8*)(kp + dk * 64);
          }
          bf16x8 vfr[4];
          v_frags_lds<4>(stage, hf, vfr, lane);
#pragma unroll
          for (int ct = 0; ct < 4; ++ct) {
            if (need[ct]) {
              const float mv = mine[ct] ? 0.f : NEG_INF;
              f32x4 s0 = {mv, mv, mv, mv}, s1 = {mv, mv, mv, mv};
              s0 = mfma16(kf[0][0], qr[ct][0], s0);
              s1 = mfma16(kf[1][0], qr[ct][0], s1);
              s0 = mfma16(kf[0][1], qr[ct][1], s0);
              s1 = mfma16(kf[1][1], qr[ct][1], s1);
              if (j == cur) {
                const int tct = t0 + 4 * ct + qq;
#pragma unroll
                for (int i = 0; i < 4; ++i) {
                  s0[i] = (key0 + 8 * grp + i <= tct) ? s0[i] : NEG_INF;
                  s1[i] = (key0 + 8 * grp + 4 + i <= tct) ? s1[i] : NEG_INF;
                }
              }
              float mx = fmaxf(fmaxf(fmaxf(s0[0], s0[1]), fmaxf(s0[2], s0[3])), fmaxf(fmaxf(s1[0], s1[1]), fmaxf(s1[2], s1[3])));
              mx = grp_max4(mx);
              const float mnew = fmaxf(m[ct], mx);
              if (__any(mnew > m[ct])) {
                const float ms = (mnew == NEG_INF) ? 0.f : mnew;
                const float alpha = __builtin_amdgcn_exp2f(m[ct] - ms);
                m[ct] = mnew;
                lacc[ct] = lacc[ct] * alpha;
#pragma unroll
                for (int dt = 0; dt < 4; ++dt) o[dt][ct] = o[dt][ct] * alpha;
              }
              const float msafe = (m[ct] == NEG_INF) ? 0.f : m[ct];
              const f32x4 d0 = s0 - msafe, d1 = s1 - msafe;
              f32x4 p0, p1;
#pragma unroll
              for (int i = 0; i < 4; ++i) { p0[i] = __builtin_amdgcn_exp2f(d0[i]); p1[i] = __builtin_amdgcn_exp2f(d1[i]); }
              const bf16x8 pb = pack8(p0, p1);
              lacc[ct] = mfma16(ones, pb, lacc[ct]);
#pragma unroll
              for (int dt = 0; dt < 4; ++dt) o[dt][ct] = mfma16(vfr[dt], pb, o[dt][ct]);
            }
          }
        }
      }
      }
      if (nA < 128) tile_swrite(tr, tiles + (2 * ((it + 1) & 1)) * TILE_STAGE, tid);
      if (nB < 128) tile_swrite(trb, tiles + (2 * ((it + 1) & 1) + 1) * TILE_STAGE, tid);
      __syncthreads();
      jA = nA; jB = nB; ++it;
    }
    float* scr2 = scr + (size_t)2048 * 4096;
#pragma unroll
    for (int ct = 0; ct < 4; ++ct) {
      const size_t rowq = (size_t)b * T + t0 + 4 * ct + qq;
      const float sc = (lacc[ct][0] > 0.f ? 1.0f / lacc[ct][0] : 0.f) * WSP(float, OFF_GATE)[rowq * 24 + (g * 4 + hq) * 3 + 1];
#pragma unroll
      for (int dt = 0; dt < 4; ++dt)
        *(f32x4*)(scr2 + (hq * 16 + 4 * ct + qq) * 64 + 16 * dt + 4 * grp) = o[dt][ct] * sc;
    }
    asm volatile("s_waitcnt vmcnt(0)" ::: "memory");
    __builtin_amdgcn_fence(__ATOMIC_SEQ_CST, "workgroup");
  }
  {
    NSA_SECTION_VARS
    const int tid = (wave << 6) | lane;
    const bf16_t* kw = WSP(bf16_t, OFF_KW) + ((size_t)b * T) * 128 + g * 64;
    const bf16_t* vwt = WSP(bf16_t, OFF_VWT) + (size_t)((b * 2 + g) * 64) * T;
#pragma unroll
    for (int ct = 0; ct < 4; ++ct) { m[ct] = NEG_INF; lsum[ct] = 0.f; lacc[ct] = (f32x4){0.f, 0.f, 0.f, 0.f}; }
#pragma unroll
    for (int dt = 0; dt < 4; ++dt)
#pragma unroll
      for (int ct = 0; ct < 4; ++ct) o[dt][ct] = (f32x4){0.f, 0.f, 0.f, 0.f};
    int kstart = qi * 128 - 512;
    if (kstart < 0) kstart = 0;
    const int kend = qi * 128 + 64;
    bf16x8 qr[4][2];
#pragma unroll
    for (int ct = 0; ct < 4; ++ct)
#pragma unroll
      for (int dk = 0; dk < 2; ++dk)
        qr[ct][dk] = *(const bf16x8*)(WSP(bf16_t, OFF_QN) + row * 512 + (g * 4 + ct) * 64 + dk * 32 + grp * 8);
    TileRegs tr;
    int it = 0;
    tile_gload(tr, kw, 128, vwt, T, kstart, tid);
    tile_swrite(tr, tiles, tid);
    __syncthreads();
#pragma unroll 1
    for (int k0 = kstart; k0 <= kend; k0 += 64, ++it) {
      if (k0 + 64 <= kend) tile_gload(tr, kw, 128, vwt, T, k0 + 64, tid);
      const lds_u8* stage = tiles + (it & 1) * TILE_STAGE;
      if (k0 <= t0 + 15 && k0 + 63 + 512 > t0) {
#pragma unroll
        for (int hf = 0; hf < 2; ++hf) {
          const int key0 = k0 + hf * 32;
          f32x4 s[2][4];
          const f32x4 cz = {0.f, 0.f, 0.f, 0.f};
          qk_scores_lds<4, 2, false>(stage, hf, qr, s, lane, nullptr, cz, cz);
          if (!(k0 + 63 <= t0 && k0 + 512 > t0 + 15)) {
#pragma unroll
            for (int kt = 0; kt < 2; ++kt)
#pragma unroll
              for (int i = 0; i < 4; ++i) {
                const int key = key0 + 8 * grp + 4 * kt + i;
                const bool ok = (key <= t) && (key + 512 > t);
#pragma unroll
                for (int ct = 0; ct < 4; ++ct) s[kt][ct][i] = ok ? s[kt][ct][i] : NEG_INF;
              }
          }
          bf16x8 vfr[4];
          v_frags_lds<4>(stage, hf, vfr, lane);
          softmax_update<4, 4, true, false>(s, m, lsum, o, &lacc);
          pv_accum_lds<4, 4>(vfr, s, o, lane, lacc);
        }
      }
      if (k0 + 64 <= kend) tile_swrite(tr, tiles + ((it + 1) & 1) * TILE_STAGE, tid);
      __syncthreads();
    }
    float sc2[4];
#pragma unroll
    for (int ct = 0; ct < 4; ++ct) sc2[ct] = (lacc[ct][0] > 0.f ? 1.0f / lacc[ct][0] : 0.f) * gatep[ct * 3 + 2];
    bf16_t* oa = WSP(bf16_t, OFF_OA) + row * 512 + g * 256;
#pragma unroll
    for (int dt = 0; dt < 4; ++dt)
#pragma unroll
      for (int ct = 0; ct < 4; ++ct) {
        bf16_t* ptr = oa + ct * 64 + 16 * dt + 4 * grp;
        const u32x2 sw = *(const u32x2*)ptr;
        float val[4];
        const f32x4 sv = *(const f32x4*)(scr + (size_t)2048 * 4096 + (ct * 16 + r) * 64 + 16 * dt + 4 * grp);
#pragma unroll
        for (int i = 0; i < 4; ++i) val[i] = scr[((dt * 4 + ct) * 4 + i) * 64 + lane] + sv[i] + o[dt][ct][i] * sc2[ct];
        u32x2 w = {cvtpk(val[0] * bflo(sw[0]), val[1] * bfhi(sw[0])), cvtpk(val[2] * bflo(sw[1]), val[3] * bfhi(sw[1]))};
        if (st) *(u32x2*)ptr = w;
        asm volatile("" ::: "memory");
      }
  }
#undef NSA_SECTION_VARS
}

__device__ __forceinline__ void fox_wg_unit(const Params& p, int l, int b, int h, int qb, lds_u8* tiles, bool st) {
  kparams_t kp_ = kparams(); (void)kp_;
  const int tid = tidx();
  const int wave = __builtin_amdgcn_readfirstlane(tid >> 6);
  const int lane = tid & 63, r = lane & 15, grp = lane >> 4;
  const int t0 = qb * 512 + wave * 64;
  bf16x8 qf[4][2];
  const float* fc = WSP(float, OFF_FC) + (size_t)(b * 8 + h) * T;
#pragma unroll
  for (int ct = 0; ct < 4; ++ct) {
    const size_t row = (size_t)b * T + t0 + 16 * ct + r;
#pragma unroll
    for (int dk = 0; dk < 2; ++dk)
      qf[ct][dk] = *(const bf16x8*)(WSP(bf16_t, OFF_FQ) + row * 512 + h * 64 + dk * 32 + grp * 8);
  }
  const bf16_t* kb = WSP(bf16_t, OFF_FK) + ((size_t)b * T) * 512 + h * 64;
  const bf16_t* vt = WSP(bf16_t, OFF_FVT) + (size_t)((b * 8 + h) * 64) * T;
  f32x4 o[4][4];
  float m[4], lsum[4];
  f32x4 lacc[4];
#pragma unroll
  for (int ct = 0; ct < 4; ++ct) { m[ct] = NEG_INF; lsum[ct] = 0.f; lacc[ct] = (f32x4){0.f, 0.f, 0.f, 0.f}; }
#pragma unroll
  for (int dt = 0; dt < 4; ++dt)
#pragma unroll
    for (int ct = 0; ct < 4; ++ct) o[dt][ct] = (f32x4){0.f, 0.f, 0.f, 0.f};
  const int ntiles = (qb + 1) * 8;
  int it0, itw0;
  {
    float gq = fabsf(kp_->fox_q_norm[l * 64 + lane]), gk = fabsf(kp_->fox_k_norm[l * 64 + lane]);
#pragma unroll
    for (int o_ = 1; o_ < 64; o_ <<= 1) { gq = fmaxf(gq, __shfl_xor(gq, o_)); gk = fmaxf(gk, __shfl_xor(gk, o_)); }
    const float B2 = 16.0f * gq * gk * 1.02f + 104.0f;
    const float thr_wg = fc[qb * 512] + B2, thr_w = fc[t0] + B2;
    const float c0 = (lane < ntiles) ? fc[64 * lane + 63] : -3.0e38f;
    const float c1 = (lane + 64 < ntiles) ? fc[64 * (lane + 64) + 63] : -3.0e38f;
    it0 = __popcll(__ballot(c0 > thr_wg)) + __popcll(__ballot(c1 > thr_wg));
    itw0 = __popcll(__ballot(c0 > thr_w)) + __popcll(__ballot(c1 > thr_w));
    it0 = __builtin_amdgcn_readfirstlane(it0);
    itw0 = __builtin_amdgcn_readfirstlane(itw0);
  }
  TileRegs tr;
  float ckr = 0.f;
  tile_gload(tr, kb, 512, vt, T, it0 * 64, tid);
  if (tid < 64) ckr = fc[it0 * 64 + tid] * (-LOG2E);
  tile_swrite(tr, tiles, tid);
  if (tid < 64) *(__attribute__((address_space(3))) float*)(tiles + 2 * TILE_HALF + tid * 4) = ckr;
  __syncthreads();
#pragma unroll 1
  for (int it = it0; it < ntiles; ++it) {
    const int k0 = it * 64;
    if (it + 1 < ntiles) { tile_gload(tr, kb, 512, vt, T, k0 + 64, tid); if (tid < 64) ckr = fc[k0 + 64 + tid] * (-LOG2E); }
    const lds_u8* stage = tiles + ((it - it0) & 1) * TILE_STAGE;
    if (k0 <= t0 + 63 && it >= itw0) {
      const bool diag = (k0 + 63 > t0);
#pragma unroll
      for (int hf = 0; hf < 2; ++hf) {
        const int key0 = k0 + hf * 32;
        f32x4 s[2][4];
        const f32x4 ck0 = *(const __attribute__((address_space(3))) f32x4*)(stage + 2 * TILE_HALF + (32 * hf + 8 * grp) * 4);
        const f32x4 ck1 = *(const __attribute__((address_space(3))) f32x4*)(stage + 2 * TILE_HALF + (32 * hf + 8 * grp + 4) * 4);
        qk_scores_lds<4, 2, false>(stage, hf, qf, s, lane, nullptr, ck0, ck1);
        if (diag) {
#pragma unroll
          for (int kt = 0; kt < 2; ++kt)
#pragma unroll
            for (int i = 0; i < 4; ++i) {
              const int key = key0 + 8 * grp + 4 * kt + i;
#pragma unroll
              for (int ct = 0; ct < 4; ++ct) s[kt][ct][i] = (key <= t0 + 16 * ct + r) ? s[kt][ct][i] : NEG_INF;
            }
        }
        bf16x8 vfr[4];
        v_frags_lds<4>(stage, hf, vfr, lane);
        softmax_update<4, 4, true, false>(s, m, lsum, o, &lacc);
        pv_accum_lds<4, 4>(vfr, s, o, lane, lacc);
      }
    }
    if (it + 1 < ntiles) {
      tile_swrite(tr, tiles + ((it - it0 + 1) & 1) * TILE_STAGE, tid);
      if (tid < 64) *(__attribute__((address_space(3))) float*)(tiles + ((it - it0 + 1) & 1) * TILE_STAGE + 2 * TILE_HALF + tid * 4) = ckr;
    }
    __syncthreads();
  }
  float invl[4];
#pragma unroll
  for (int ct = 0; ct < 4; ++ct) invl[ct] = lacc[ct][0] > 0.f ? 1.0f / lacc[ct][0] : 0.f;
#pragma unroll
  for (int ct = 0; ct < 4; ++ct) {
    bf16_t* ob = WSP(bf16_t, OFF_OB) + ((size_t)b * T + t0 + 16 * ct + r) * 512 + h * 64;
#pragma unroll
    for (int dt = 0; dt < 4; ++dt) {
      bf16_t* ptr = ob + 16 * dt + 4 * grp;
      const u32x2 sw = *(const u32x2*)ptr;
      const f32x4 v = o[dt][ct] * invl[ct];
      u32x2 w = {cvtpk(v[0] * bflo(sw[0]), v[1] * bfhi(sw[0])), cvtpk(v[2] * bflo(sw[1]), v[3] * bfhi(sw[1]))};
      if (st) *(u32x2*)ptr = w;
    }
  }
}

__device__ __forceinline__ void mem_unit(const Params& p, int l, int b, int h, int t0, bool st) {
  kparams_t kp_ = kparams(); (void)kp_;
  const int lane = tidx() & 63, r = lane & 15, grp = lane >> 4;
  const float SC = 0.08838834764831845f * LOG2E;
  bf16x8 qf[2][4];
  const float* gq = kp_->mem_q_norm + l * 128;
#pragma unroll
  for (int ct = 0; ct < 2; ++ct) {
    const size_t row = (size_t)b * T + t0 + 16 * ct + r;
    float v[4][8];
    float ss = 0.f;
#pragma unroll
    for (int dk = 0; dk < 4; ++dk) {
      const u32x4 w = *(const u32x4*)(WSP(bf16_t, OFF_MQ) + row * 512 + h * 128 + dk * 32 + grp * 8);
#pragma unroll
      for (int j = 0; j < 4; ++j) { v[dk][2 * j] = bflo(w[j]); v[dk][2 * j + 1] = bfhi(w[j]); }
#pragma unroll
      for (int j = 0; j < 8; ++j) ss += v[dk][j] * v[dk][j];
    }
    ss += __shfl_xor(ss, 16);
    ss += __shfl_xor(ss, 32);
    const float rstd = rsqrtf(ss * (1.0f / 128.0f) + EPS);
#pragma unroll
    for (int dk = 0; dk < 4; ++dk) {
      const f32x4 g0 = *(const f32x4*)(gq + dk * 32 + grp * 8), g1 = *(const f32x4*)(gq + dk * 32 + grp * 8 + 4);
      u32x4 w = {cvtpk(v[dk][0] * rstd * g0[0], v[dk][1] * rstd * g0[1]), cvtpk(v[dk][2] * rstd * g0[2], v[dk][3] * rstd * g0[3]),
                 cvtpk(v[dk][4] * rstd * g1[0], v[dk][5] * rstd * g1[1]), cvtpk(v[dk][6] * rstd * g1[2], v[dk][7] * rstd * g1[3])};
      qf[ct][dk] = __builtin_bit_cast(bf16x8, w);
    }
  }
  const bf16_t* kb = WSP(bf16_t, OFF_MK) + ((size_t)b * 256) * 512 + h * 128;
  const bf16_t* vt = WSP(bf16_t, OFF_MVT) + (size_t)((b * 4 + h) * 128) * 256;
  f32x4 o[8][2];
  float m[2], lsum[2];
#pragma unroll
  for (int ct = 0; ct < 2; ++ct) { m[ct] = NEG_INF; lsum[ct] = 0.f; }
#pragma unroll
  for (int dt = 0; dt < 8; ++dt)
#pragma unroll
    for (int ct = 0; ct < 2; ++ct) o[dt][ct] = (f32x4){0.f, 0.f, 0.f, 0.f};
#pragma unroll 1
  for (int key0 = 0; key0 < 256; key0 += 32) {
    f32x4 s[2][2];
    qk_scores<2, 4>(kb, 512, key0, qf, s, lane);
#pragma unroll
    for (int kt = 0; kt < 2; ++kt)
#pragma unroll
      for (int ct = 0; ct < 2; ++ct) s[kt][ct] = s[kt][ct] * SC;
    softmax_update<2, 8, true>(s, m, lsum, o);
    pv_accum<2, 8>(vt, 256, key0, s, o, lane);
  }
#pragma unroll
  for (int ct = 0; ct < 2; ++ct) {
    const float invl = finish_l(lsum[ct]);
    bf16_t* om = WSP(bf16_t, OFF_OM) + ((size_t)b * T + t0 + 16 * ct + r) * 512 + h * 128;
#pragma unroll
    for (int dt = 0; dt < 8; ++dt) {
      bf16_t* ptr = om + 16 * dt + 4 * grp;
      const u32x2 sw = *(const u32x2*)ptr;
      const f32x4 v = o[dt][ct] * invl;
      u32x2 w = {cvtpk(v[0] * bflo(sw[0]), v[1] * bfhi(sw[0])), cvtpk(v[2] * bflo(sw[1]), v[3] * bfhi(sw[1]))};
      if (st) *(u32x2*)ptr = w;
    }
  }
}

__device__ __forceinline__ void phase_attn(const Params& p, int l, unsigned char* ldsraw, bool st, int cidx) {
  kparams_t kp_ = kparams(); (void)kp_;
  const int tid = tidx();
  const int wave = __builtin_amdgcn_readfirstlane(tid >> 6);
  float* imp = (float*)ldsraw + wave * 2112;
  lds_u8* tiles = (lds_u8*)ldsraw;
  bf16x8* qlds = (bf16x8*)(ldsraw + 69632 + wave * 8192);
  unsigned* misc = (unsigned*)(ldsraw + 135168);
  float* scr = WSP(float, OFF_SCR) + (size_t)(bidx() * NWAVES + wave) * 4096;
  const int myx = (int)(xb_xcc_id() & 7u);
  constexpr int QUNITS = 192;
  for (int qq = 0; qq < 8; ++qq) {
    const int x = (myx + qq) & 7;
    unsigned* ctr = WSP(unsigned, OFF_CTL) + cidx * 8 + x;
    for (;;) {
      __syncthreads();
      if (tid == 0) misc[0] = atomicAdd(ctr, 1u);
      if (tid >= 4 && tid < 8) misc[tid] = 0u;
      __syncthreads();
      const int u = __builtin_amdgcn_readfirstlane((int)misc[0]);
      if (u >= QUNITS) break;
      if (u < 64) {
        nsa_wg_unit(p, x >> 1, x & 1, 63 - u, imp, qlds, scr, tiles, misc, st);
      } else if (u < 128) {
        const int v_ = u - 64, bh = 4 * x + (v_ >> 4);
        fox_wg_unit(p, l, bh >> 3, bh & 7, 15 - (v_ & 15), tiles, st);
      } else {
        const int mu = u - 128, bh = 2 * x + (mu >> 5), qblk = mu & 31;
        mem_unit(p, l, bh >> 2, bh & 3, 256 * qblk + 32 * wave, st);
      }
    }
  }
}

__global__ void __launch_bounds__(NTHREADS) hybrid_megakernel(Params p) {
  kparams_t kp_ = kparams();
  cg::grid_group grid = cg::this_grid();
  extern __shared__ __attribute__((aligned(16))) unsigned char dynlds[];
  float* smem = (float*)dynlds;
  PG8_LAS unsigned char* glds = (PG8_LAS unsigned char*)dynlds;
  volatile LAS unsigned* bst = (volatile LAS unsigned*)(glds + 135168 + 64);
  if (threadIdx.x < 2) bst[threadIdx.x] = 0u;
  __syncthreads();
  grid.sync();
  const XcdBarrier xbar = xcd_barrier_post(WSP(unsigned, OFF_BAR), bst);
#pragma unroll 1
  for (int ph = 0; ph < 28; ++ph) {
    const int l = ph / 7, k = ph - 7 * l;
    if (k == 0) {
      phase_prep(p, l, smem);
    } else if (k == 1) {
      if (bidx() == gdim() - 1 && tidx() < 256) {
        const int t_ = tidx();
        const float* part = WSP(float, OFF_C1) + (size_t)(t_ >> 7) * 16 * 128 + (t_ & 127);
        float pv_[16];
#pragma unroll
        for (int ch = 0; ch < 16; ++ch) pv_[ch] = part[ch * 128];
        float s_ = 0.f;
#pragma unroll
        for (int ch = 0; ch < 16; ++ch) s_ += pv_[ch];
        WSP(float, OFF_C1 + 16384)[t_] = s_;
      }
      EpiIn E{&p, l};
      run_gemm(glds, WSP(bf16_t, OFF_H), WSP(bf16_t, OFF_W_IN), M, 5120, 1024, E);
      EpiMemKV E2{&p};
      run_gemm(glds, WSP(bf16_t, OFF_MEMN), WSP(bf16_t, OFF_W_MKV), 1024, 1024, 1024, E2);
    } else if (k == 2) {
      phase_mid(p, l, smem);
    } else if (k == 3) {
      phase_attn(p, l, dynlds, true, l);
    } else if (k == 4) {
      EpiGate E{WSP(bf16_t, OFF_G)};
      run_gemm(glds, WSP(bf16_t, OFF_H), WSP(bf16_t, OFF_W_G), M, 3072, 1024, E);
    } else if (k == 5) {
      EpiBranch Ea{WSP(bf16_t, OFF_G), WSP(bf16_t, OFF_U), 1};
      run_gemm(glds, WSP(bf16_t, OFF_OA), WSP(bf16_t, OFF_W_BR), M, 1024, 512, Ea);
      EpiBranch Eb{WSP(bf16_t, OFF_G) + (size_t)M * 1024, WSP(bf16_t, OFF_U), 0};
      run_gemm(glds, WSP(bf16_t, OFF_OB), WSP(bf16_t, OFF_W_BR + MiB), M, 1024, 512, Eb);
      EpiBranch Ec{WSP(bf16_t, OFF_G) + (size_t)2 * M * 1024, WSP(bf16_t, OFF_U), 0};
      run_gemm(glds, WSP(bf16_t, OFF_OM), WSP(bf16_t, OFF_W_BR + 2 * MiB), M, 1024, 512, Ec);
    } else {
      EpiOut E{l == 0 ? kp_->x : kp_->out, kp_->out};
      run_gemm(glds, WSP(bf16_t, OFF_U), WSP(bf16_t, OFF_W_OUT), M, 1024, 1024, E);
    }
    xcd_barrier(xbar);
  }
}

extern "C" void kernel_launch(void* const* d_in, const int* in_sizes, int n_in, void* d_out, int out_size, void* d_ws,
                              size_t ws_size, hipStream_t stream) {
  static int grid_blocks = 0;
  if (!grid_blocks) {
    int dev = 0, cus = 0, per_cu = 0;
    (void)hipGetDevice(&dev);
    (void)hipDeviceGetAttribute(&cus, hipDeviceAttributeMultiprocessorCount, dev);
    if (hipFuncSetAttribute((const void*)hybrid_megakernel, hipFuncAttributeMaxDynamicSharedMemorySize, LDS_BYTES) != hipSuccess)
      fprintf(stderr, "hipFuncSetAttribute(dynamic LDS %d) failed\n", LDS_BYTES);
    (void)hipOccupancyMaxActiveBlocksPerMultiprocessor(&per_cu, hybrid_megakernel, NTHREADS, LDS_BYTES);
    (void)hipGetLastError();
    grid_blocks = cus;
    if (grid_blocks > 256) grid_blocks = 256;
    if (ws_size < OFF_SCR + (size_t)64 * MiB) fprintf(stderr, "workspace too small: %zu\n", ws_size);
  }
  Params p{};
  const float** pp = (const float**)&p;
  for (int i = 0; i < 23; ++i) pp[i] = (const float*)d_in[i];
  p.out = (float*)d_out;
  p.ws = (char*)d_ws;
  void* args[] = {&p};
  (void)hipMemsetAsync((char*)d_ws + OFF_BAR, 0, XCD_BAR_WORDS * sizeof(unsigned), stream);
  hipError_t e = hipLaunchCooperativeKernel((void*)hybrid_megakernel, dim3(grid_blocks), dim3(NTHREADS), args, LDS_BYTES, stream);
  if (e != hipSuccess) fprintf(stderr, "cooperative launch failed: %s (grid %d)\n", hipGetErrorString(e), grid_blocks);
}
```

```cpp
#include <hip/hip_runtime.h>
#include <hip/hip_cooperative_groups.h>
#include <stdint.h>
#include <cstdio>
namespace cg = cooperative_groups;
typedef unsigned short bf16_t;
typedef short bf16x8 __attribute__((ext_vector_type(8)));
typedef float f32x4 __attribute__((ext_vector_type(4)));
typedef unsigned u32x2 __attribute__((ext_vector_type(2)));
typedef unsigned u32x4 __attribute__((ext_vector_type(4)));
typedef float f32x2_t __attribute__((ext_vector_type(2)));
typedef __bf16 bf16x2_t __attribute__((ext_vector_type(2)));

constexpr int NB = 4, T = 8192, M = NB * T;
constexpr int NTHREADS = 512, NWAVES = NTHREADS / 64;
constexpr int LDS_BYTES = 147456;
constexpr float EPS = 1e-6f;
constexpr float LOG2E = 1.4426950408889634f;
#define NEG_INF (-__builtin_inff())

constexpr size_t MiB = 1u << 20;
constexpr size_t OFF_CTL = 0;
constexpr size_t OFF_BAR = 64 * 1024;
constexpr size_t OFF_ROPE = 1 * MiB;
constexpr size_t OFF_W_IN = 3 * MiB;
constexpr size_t OFF_W_G = 13 * MiB;
constexpr size_t OFF_W_MKV = 19 * MiB;
constexpr size_t OFF_W_BR = 21 * MiB;
constexpr size_t OFF_W_OUT = 24 * MiB;
constexpr size_t OFF_W1 = 26 * MiB;
constexpr size_t OFF_W2 = 27 * MiB;
constexpr size_t OFF_C1 = 27 * MiB + 256 * 1024;
constexpr size_t OFF_MEMN = 28 * MiB;
constexpr size_t OFF_MK = 30 * MiB;
constexpr size_t OFF_MVT = 31 * MiB;
constexpr size_t OFF_H = 32 * MiB;
constexpr size_t OFF_U = OFF_H;
constexpr size_t OFF_OA = 96 * MiB;
constexpr size_t OFF_OB = 128 * MiB;
constexpr size_t OFF_OM = 160 * MiB;
constexpr size_t OFF_QN = 192 * MiB;
constexpr size_t OFF_G = 192 * MiB;
constexpr size_t OFF_KC = 224 * MiB;
constexpr size_t OFF_VC = 232 * MiB;
constexpr size_t OFF_KS = 240 * MiB;
constexpr size_t OFF_VST = 248 * MiB;
constexpr size_t OFF_KW = 256 * MiB;
constexpr size_t OFF_VWT = 264 * MiB;
constexpr size_t OFF_FQ = 272 * MiB;
constexpr size_t OFF_FK = 304 * MiB;
constexpr size_t OFF_FVT = 336 * MiB;
constexpr size_t OFF_MQ = 368 * MiB;
constexpr size_t OFF_GATE = 400 * MiB;
constexpr size_t OFF_FLOG = 403 * MiB;
constexpr size_t OFF_FC = 404 * MiB;
constexpr size_t OFF_KCMP = 405 * MiB;
constexpr size_t OFF_VCT = 405 * MiB + 512 * 1024;
constexpr size_t OFF_SCR = 406 * MiB;

struct Params {
  const float *x, *mem, *norm_g, *mem_norm_g, *w_in, *nsa_q_norm, *nsa_k_norm, *cmp_pe_k, *cmp_w1_k, *cmp_w2_k,
      *cmp_pe_v, *cmp_w1_v, *cmp_w2_v, *fox_q_norm, *fox_k_norm, *fox_f_bias, *mem_q_norm, *mem_k_norm, *w_mem_kv,
      *w_branch_a, *w_branch_b, *w_branch_m, *w_out;
  float* out;
  char* ws;
};
__device__ __forceinline__ char* ws_base(char* w) {
  unsigned lo = __builtin_amdgcn_readfirstlane((unsigned)(uintptr_t)w), hi = __builtin_amdgcn_readfirstlane((unsigned)((uintptr_t)w >> 32));
  asm volatile("" : "+s"(lo), "+s"(hi));
  return (char*)(__attribute__((address_space(1))) char*)(((uintptr_t)hi << 32) | (uintptr_t)lo);
}
typedef const __attribute__((address_space(4))) Params* kparams_t;
__device__ __forceinline__ kparams_t kparams() { kparams_t kp = (kparams_t)__builtin_amdgcn_kernarg_segment_ptr(); asm volatile("" : "+s"(kp)); return kp; }
#define WSP(TYPE, off) ((TYPE*)(ws_base(kp_->ws) + (off)))

__constant__ float c_inv_freq[32] = {
    1.000000000e+00f, 7.498942018e-01f, 5.623413324e-01f, 4.216965139e-01f, 3.162277639e-01f, 2.371373773e-01f,
    1.778279394e-01f, 1.333521456e-01f, 1.000000015e-01f, 7.498942316e-02f, 5.623413250e-02f, 4.216964915e-02f,
    3.162277490e-02f, 2.371373773e-02f, 1.778279431e-02f, 1.333521400e-02f, 9.999999776e-03f, 7.498942316e-03f,
    5.623413250e-03f, 4.216964822e-03f, 3.162277630e-03f, 2.371373819e-03f, 1.778279431e-03f, 1.333521446e-03f,
    1.000000047e-03f, 7.498941850e-04f, 5.623413017e-04f, 4.216965172e-04f, 3.162277571e-04f, 2.371373703e-04f,
    1.778279402e-04f, 1.333521504e-04f};

__device__ __forceinline__ int bidx() { int b = blockIdx.x; asm volatile("" : "+s"(b)); return b; }
__device__ __forceinline__ int gdim() { int g = gridDim.x; asm volatile("" : "+s"(g)); return g; }
__device__ __forceinline__ int tidx() { int t = threadIdx.x; asm volatile("" : "+v"(t)); return t; }
__device__ __forceinline__ unsigned cvtpk(float lo, float hi) {
  f32x2_t v = {lo, hi};
  bf16x2_t b = __builtin_convertvector(v, bf16x2_t);
  return __builtin_bit_cast(unsigned, b);
}
__device__ __forceinline__ float bf2f(unsigned short v) { return __uint_as_float(((unsigned)v) << 16); }
__device__ __forceinline__ float bflo(unsigned w) { return __uint_as_float(w << 16); }
__device__ __forceinline__ float bfhi(unsigned w) { return __uint_as_float(w & 0xffff0000u); }
__device__ __forceinline__ f32x4 mfma16(bf16x8 a, bf16x8 b, f32x4 c) {
  return __builtin_amdgcn_mfma_f32_16x16x32_bf16(a, b, c, 0, 0, 0);
}
__device__ __forceinline__ bf16x8 pack8(f32x4 a, f32x4 b) {
  u32x4 w = {cvtpk(a[0], a[1]), cvtpk(a[2], a[3]), cvtpk(b[0], b[1]), cvtpk(b[2], b[3])};
  return __builtin_bit_cast(bf16x8, w);
}
__device__ __forceinline__ float sigmoidf_(float v) { return __builtin_amdgcn_rcpf(1.0f + __builtin_amdgcn_exp2f(-LOG2E * v)); }
__device__ __forceinline__ float siluf_(float v) { return v * __builtin_amdgcn_rcpf(1.0f + __builtin_amdgcn_exp2f(-LOG2E * v)); }
__device__ __forceinline__ float grp_max4(float v) {
  auto a = __builtin_amdgcn_permlane32_swap(__float_as_uint(v), __float_as_uint(v), false, false);
  v = fmaxf(__uint_as_float(a[0]), __uint_as_float(a[1]));
  auto b = __builtin_amdgcn_permlane16_swap(__float_as_uint(v), __float_as_uint(v), false, false);
  return fmaxf(__uint_as_float(b[0]), __uint_as_float(b[1]));
}
__device__ __forceinline__ float wave_sum(float v) {
#pragma unroll
  for (int o = 1; o < 64; o <<= 1) v += __shfl_xor(v, o);
  return v;
}

#define LAS __attribute__((address_space(3)))
#define XB_TMO      128
#define XB_XCNT(j)  (256  + 64 * (j))
#define XB_XSUB(j)  (1280 + 64 * (j))
#define XB_XGEN(j)  (2304 + 64 * (j))
#define XB_TOP      3328
#define XB_TOPGEN   3392
#define XCD_BAR_WORDS 3456
#define XB_SPIN_CAP (1u << 18)

__device__ __forceinline__ unsigned xb_ld(unsigned* p)              { return __hip_atomic_load(p, __ATOMIC_RELAXED, __HIP_MEMORY_SCOPE_AGENT); }
__device__ __forceinline__ unsigned xb_add(unsigned* p, unsigned v) { return __hip_atomic_fetch_add(p, v, __ATOMIC_RELAXED, __HIP_MEMORY_SCOPE_AGENT); }
__device__ __forceinline__ unsigned xb_xcc_id() { return (unsigned)__builtin_amdgcn_s_getreg((3 << 11) | 20) & 0xFu; }
#define XB_SPIN(cond, bar) do { unsigned _sp = 0; while (cond) { __builtin_amdgcn_s_sleep(1); \
    if ((++_sp & 255u) == 0u) { if (xb_ld(&(bar)[XB_TMO])) break; if (_sp > XB_SPIN_CAP) { atomicAdd(&(bar)[XB_TMO], 1u); break; } } } } while (0)

struct XcdBarrier {
    unsigned* bar; unsigned x;
    volatile LAS unsigned* st;
};

__device__ __forceinline__ XcdBarrier xcd_barrier_post(unsigned* bar, volatile LAS unsigned* st) {
    XcdBarrier b; b.bar = bar; b.x = xb_xcc_id(); b.st = st;
    if (threadIdx.x == 0) (void)xb_add(&bar[XB_XCNT(b.x)], 1u);
    return b;
}
__device__ __forceinline__ void xcd_barrier_complete(unsigned* bar, unsigned x, unsigned& nloc, unsigned& nx) {
    const unsigned G = gridDim.x * gridDim.y * gridDim.z;
    unsigned sum, cnt, mine, sp = 0u;
    for (;;) {
        sum = 0u; cnt = 0u; mine = 0u;
#pragma unroll
        for (unsigned j = 0; j < 16; ++j) { const unsigned c = xb_ld(&bar[XB_XCNT(j)]); sum += c; cnt += (c > 0u) ? 1u : 0u; mine = (j == x) ? c : mine; }
        if (sum == G) break;
        __builtin_amdgcn_s_sleep(1);
        if ((++sp & 255u) == 0u) { if (xb_ld(&bar[XB_TMO])) break; if (sp > XB_SPIN_CAP) { atomicAdd(&bar[XB_TMO], 1u); break; } }
    }
    nloc = mine > 0u ? mine : 1u; nx = cnt > 0u ? cnt : 1u;
}

__device__ __forceinline__ void xcd_barrier(const XcdBarrier& b) {
    asm volatile("s_waitcnt vmcnt(0)" ::: "memory");
    __syncthreads();
    if (threadIdx.x == 0) {
        unsigned* bar = b.bar;
        __builtin_amdgcn_s_waitcnt(0);
        unsigned nloc = b.st[0], nx = b.st[1];
        if (nloc == 0u) { xcd_barrier_complete(bar, b.x, nloc, nx); b.st[0] = nloc; b.st[1] = nx; }
        const unsigned old = xb_add(&bar[XB_XSUB(b.x)], 1u);
        const unsigned gen = old / nloc;
        if (old + 1u == (gen + 1u) * nloc) {
            __builtin_amdgcn_fence(__ATOMIC_RELEASE, "agent");
            asm volatile("s_waitcnt vmcnt(0)" ::: "memory");
            const unsigned og = xb_add(&bar[XB_TOP], 1u);
            const unsigned tg = og / nx;
            if (og + 1u == (tg + 1u) * nx) xb_add(&bar[XB_TOPGEN], 1u);
            else XB_SPIN(xb_ld(&bar[XB_TOPGEN]) == tg, bar);
            __builtin_amdgcn_fence(__ATOMIC_ACQUIRE, "agent");
            xb_add(&bar[XB_XGEN(b.x)], 1u);
            asm volatile("s_waitcnt vmcnt(0)" ::: "memory");
        } else {
            XB_SPIN(xb_ld(&bar[XB_XGEN(b.x)]) == gen, bar);
            __builtin_amdgcn_fence(__ATOMIC_ACQUIRE, "agent");
            asm volatile("s_waitcnt vmcnt(0)" ::: "memory");
        }
    }
    __syncthreads();
}


namespace pg8 {
#define PG8_LAS __attribute__((address_space(3)))
typedef unsigned short bf16_t;
typedef short bf16x8 __attribute__((ext_vector_type(8)));
typedef float f32x4 __attribute__((ext_vector_type(4)));
typedef unsigned u32x4 __attribute__((ext_vector_type(4)));
constexpr int BM = 256, BK = 64, HALF = 128, HTB = HALF * BK * 2  , STAGE_BYTES = 8 * HTB, NXCD = 8, WGM = 8;

__host__ __device__ __forceinline__ int lds_byte(int r, int c) { const int st = (r >> 4) * 2 + (c >> 5), rr = r & 15, cc = c & 31, ob = rr * 64 + cc * 2; return st * 1024 + (ob ^ (((ob >> 9) & 1) << 5)); }
__host__ __device__ __forceinline__ void stage_rc(int b, int& R, int& C) { const int st = b / 1024, sb = b % 1024, swz = sb ^ (((sb >> 9) & 1) << 5); R = (st >> 1) * 16 + swz / 64; C = (st & 1) * 32 + (swz % 64) / 2; }
__host__ __device__ __forceinline__ int perm32(int rho) { const int n = rho >> 4, i = rho & 15; return 8 * (i >> 2) + 4 * n + (i & 3); }

struct Unit { int pm, pn; };
struct Gemm { const bf16_t* A; const bf16_t* Bt; int M, N, K; };

struct StaticOrder {
    int nM, nN, nwg, G, c;
    __host__ __device__ void init(int M, int N, int G_, int c_) { nM = M / BM; nN = N / BM; nwg = nM * nN; G = G_; c = c_; }
    __host__ __device__ bool next(int i, Unit& u) const {
        const long L = (long)i * G + c; if (L >= nwg) return false;
        int wgid = (int)L; { const int q = nwg / NXCD, r = nwg % NXCD, xcd = wgid % NXCD, off = wgid / NXCD; wgid = (xcd < r ? xcd * (q + 1) : r * (q + 1) + (xcd - r) * q) + off; }
        const int nig = WGM * nN, gid = wgid / nig, fm = gid * WGM, gsz = (nM - fm) < WGM ? (nM - fm) : WGM;
        u.pm = fm + ((wgid % nig) % gsz); u.pn = (wgid % nig) / gsz; return true;
    }
    __device__ __forceinline__ void a_ready(const Unit&) const {}
    __device__ __forceinline__ void done(const Unit&) const {}
};
__device__ __forceinline__ unsigned cvt_pk_bf16(float lo, float hi) { unsigned r; asm volatile("v_cvt_pk_bf16_f32 %0, %1, %2" : "=v"(r) : "v"(lo), "v"(hi)); return r; }
template <class Epi, class Sched, bool ALIGN_EPI = false, bool SP2 = false>
__device__ __forceinline__ void gemm_phase(PG8_LAS unsigned char* lds, const Gemm g, const Sched& S, const Epi& E) {
    const int tid = tidx(), wid = __builtin_amdgcn_readfirstlane(tid >> 6), lane = tid & 63, wr = wid >> 2, wc = wid & 3, fr = lane & 15, fq = lane >> 4;
    const int K = g.K, nt = K / BK;
    unsigned voffA[2], voffB[2];
#pragma unroll
    for (int i = 0; i < 2; ++i) { int R, C; stage_rc(tid * 16 + i * 8192, R, C); const int Rb = Epi::PERM ? ((R & ~31) + perm32(R & 31)) : R;
        voffA[i] = (unsigned)(R * K + C) * 2u; voffB[i] = (unsigned)(Rb * K + C) * 2u; }
    const size_t kstep = (size_t)(BK * 2);
    const size_t hstep = (size_t)HALF * K * 2;
    const size_t tstep = 2 * hstep;
    const unsigned ldsw = (unsigned)wid * 1024u;
    const int aoff = lds_byte(wr * 64 + fr, fq * 8), boff = lds_byte(wc * 32 + fr, fq * 8);
#define PG8_SA(b, h) (((b) * 2 + (h)) * HTB)
#define PG8_SB(b, h) ((4 + (b) * 2 + (h)) * HTB)
#define PG8_STAGE(bufoff, gbase, voff) do { _Pragma("unroll") for (int _i = 0; _i < 2; ++_i) \
        __builtin_amdgcn_global_load_lds((const unsigned*)((const char*)(gbase) + (voff)[_i]), (PG8_LAS unsigned*)(lds + (bufoff) + ldsw + _i * 8192), 16, 0, 0); } while (0)
#define PG8_LDA(dst, b, h) do { _Pragma("unroll") for (int m = 0; m < 4; ++m) _Pragma("unroll") for (int k = 0; k < 2; ++k) dst[m][k] = *(const PG8_LAS bf16x8*)(lds + PG8_SA(b, h) + aoff + m * 2048 + k * 1024); } while (0)
#define PG8_LDB(dst, b, h) do { _Pragma("unroll") for (int n = 0; n < 2; ++n) _Pragma("unroll") for (int k = 0; k < 2; ++k) dst[n][k] = *(const PG8_LAS bf16x8*)(lds + PG8_SB(b, h) + boff + n * 2048 + k * 1024); } while (0)
#define PG8_MMA(ai, bj, At, Bt) do { __builtin_amdgcn_s_setprio(1); _Pragma("unroll") for (int m = 0; m < 4; ++m) _Pragma("unroll") for (int n = 0; n < 2; ++n) _Pragma("unroll") for (int k = 0; k < 2; ++k) \
        acc[ai][bj][m][n] = __builtin_amdgcn_mfma_f32_16x16x32_bf16(Bt[n][k], At[m][k], acc[ai][bj][m][n], 0, 0, 0); __builtin_amdgcn_s_setprio(0); } while (0)
#define PG8_WAIT_V(n) asm volatile("s_waitcnt vmcnt(" #n ")" ::: "memory")
#define PG8_WAIT_L(n) asm volatile("s_waitcnt lgkmcnt(" #n ")" ::: "memory")
#define PG8_BAR __builtin_amdgcn_s_barrier()
#define PG8_SCHED __builtin_amdgcn_sched_barrier(0)
    Unit cur, nxt; int ui = 0;
    if (!S.next(0, cur)) return;
    f32x4 acc[2][2][4][2];
#pragma unroll
    for (int a = 0; a < 2; ++a)
#pragma unroll
        for (int b = 0; b < 2; ++b)
#pragma unroll
            for (int m = 0; m < 4; ++m)
#pragma unroll
                for (int n = 0; n < 2; ++n) acc[a][b][m][n] = (f32x4){0.f, 0.f, 0.f, 0.f};
    bf16x8 At[4][2], B0[2][2], B1[2][2];
    const char* cA = (const char*)g.A + (size_t)cur.pm * tstep; const char* cB = (const char*)g.Bt + (size_t)cur.pn * tstep;
    S.a_ready(cur);
    if constexpr (SP2) {
        PG8_STAGE(PG8_SB(0, 0), cB, voffB); PG8_STAGE(PG8_SB(0, 1), cB + hstep, voffB); PG8_STAGE(PG8_SA(0, 0), cA, voffA); PG8_STAGE(PG8_SA(0, 1), cA + hstep, voffA);
        if (wr == 1) PG8_BAR;
        PG8_WAIT_V(2); PG8_BAR;
        PG8_STAGE(PG8_SB(1, 0), cB + kstep, voffB); PG8_STAGE(PG8_SA(1, 0), cA + kstep, voffA); PG8_STAGE(PG8_SB(1, 1), cB + hstep + kstep, voffB);
        PG8_WAIT_V(6); PG8_BAR;
    } else {
        PG8_STAGE(PG8_SB(0, 0), cB, voffB); PG8_STAGE(PG8_SA(0, 0), cA, voffA); PG8_STAGE(PG8_SB(0, 1), cB + hstep, voffB); PG8_STAGE(PG8_SA(0, 1), cA + hstep, voffA);
        if (wr == 1) PG8_BAR;
        PG8_WAIT_V(4); PG8_BAR;
        PG8_STAGE(PG8_SB(1, 0), cB + kstep, voffB); PG8_STAGE(PG8_SA(1, 0), cA + kstep, voffA); PG8_STAGE(PG8_SB(1, 1), cB + hstep + kstep, voffB);
        PG8_WAIT_V(6); PG8_BAR;
    }
    for (;;) {
        const bool has_next = S.next(ui + 1, nxt);
        const char* nA = has_next ? (const char*)g.A + (size_t)nxt.pm * tstep : cA; const char* nB = has_next ? (const char*)g.Bt + (size_t)nxt.pn * tstep : cB;
        for (int t = 0; t < nt; t += 2) {
            const bool last = (t == nt - 2);
            const char* a1 = cA + (size_t)(t + 1) * kstep;
            const char* a2 = last ? nA : cA + (size_t)(t + 2) * kstep; const char* b2 = last ? nB : cB + (size_t)(t + 2) * kstep;
            const char* a3 = a2 + kstep; const char* b3 = b2 + kstep;
            if (last && has_next) S.a_ready(nxt);
            if constexpr (SP2) {
            PG8_LDB(B0, 0, 0); PG8_LDB(B1, 0, 1); PG8_SCHED; PG8_LDA(At, 0, 0); PG8_STAGE(PG8_SA(1, 1), a1 + hstep, voffA);
            PG8_WAIT_V(8); PG8_WAIT_L(0); PG8_BAR; PG8_MMA(0, 0, At, B0); PG8_MMA(0, 1, At, B1); PG8_BAR; PG8_SCHED;
            PG8_LDA(At, 0, 1); PG8_STAGE(PG8_SB(0, 0), b2, voffB); PG8_STAGE(PG8_SB(0, 1), b2 + hstep, voffB); PG8_STAGE(PG8_SA(0, 0), a2, voffA);
            PG8_WAIT_V(8); PG8_WAIT_L(0); PG8_BAR; PG8_MMA(1, 0, At, B0); PG8_MMA(1, 1, At, B1); PG8_BAR; PG8_SCHED;
            PG8_LDB(B0, 1, 0); PG8_LDB(B1, 1, 1); PG8_SCHED; PG8_LDA(At, 1, 0); PG8_STAGE(PG8_SA(0, 1), a2 + hstep, voffA);
            PG8_WAIT_V(8); PG8_WAIT_L(0); PG8_BAR; PG8_MMA(0, 0, At, B0); PG8_MMA(0, 1, At, B1); PG8_BAR; PG8_SCHED;
            PG8_LDA(At, 1, 1); PG8_STAGE(PG8_SB(1, 0), b3, voffB); PG8_STAGE(PG8_SB(1, 1), b3 + hstep, voffB); PG8_STAGE(PG8_SA(1, 0), a3, voffA);
            PG8_WAIT_V(8); PG8_WAIT_L(0); PG8_BAR; PG8_MMA(1, 0, At, B0); PG8_MMA(1, 1, At, B1); PG8_BAR; PG8_SCHED;
            } else {
            PG8_LDB(B0, 0, 0); PG8_SCHED; PG8_LDA(At, 0, 0); PG8_STAGE(PG8_SA(1, 1), a1 + hstep, voffA);
            PG8_WAIT_L(8); PG8_BAR; PG8_WAIT_L(0); PG8_MMA(0, 0, At, B0); PG8_BAR; PG8_SCHED;
            PG8_LDB(B1, 0, 1); PG8_STAGE(PG8_SB(0, 0), b2, voffB);
            PG8_BAR; PG8_WAIT_L(0); PG8_MMA(0, 1, At, B1); PG8_BAR;
            PG8_LDA(At, 0, 1); PG8_STAGE(PG8_SA(0, 0), a2, voffA);
            PG8_BAR; PG8_WAIT_L(0); PG8_MMA(1, 0, At, B0); PG8_BAR; PG8_SCHED;
            PG8_STAGE(PG8_SB(0, 1), b2 + hstep, voffB);
            PG8_WAIT_V(6); PG8_BAR; PG8_MMA(1, 1, At, B1); PG8_BAR;
            PG8_LDB(B0, 1, 0); PG8_SCHED; PG8_LDA(At, 1, 0); PG8_STAGE(PG8_SA(0, 1), a2 + hstep, voffA);
            PG8_WAIT_L(8); PG8_BAR; PG8_WAIT_L(0); PG8_MMA(0, 0, At, B0); PG8_BAR; PG8_SCHED;
            PG8_LDB(B1, 1, 1); PG8_STAGE(PG8_SB(1, 0), b3, voffB);
            PG8_BAR; PG8_WAIT_L(0); PG8_MMA(0, 1, At, B1); PG8_BAR;
            PG8_LDA(At, 1, 1); PG8_STAGE(PG8_SA(1, 0), a3, voffA);
            PG8_BAR; PG8_WAIT_L(0); PG8_MMA(1, 0, At, B0); PG8_BAR; PG8_SCHED;
            PG8_STAGE(PG8_SB(1, 1), b3 + hstep, voffB);
            PG8_WAIT_V(6); PG8_BAR; PG8_MMA(1, 1, At, B1); PG8_BAR;
            }
        }
        if constexpr (ALIGN_EPI) { if (wr == 0) PG8_BAR; }
        if constexpr (!Epi::AFTER_DRAIN) { E(acc, cur, wr, wc, fr, fq); S.done(cur); }
        if (!has_next) break;
#pragma unroll
        for (int a = 0; a < 2; ++a)
#pragma unroll
            for (int b = 0; b < 2; ++b)
#pragma unroll
                for (int m = 0; m < 4; ++m)
#pragma unroll
                    for (int n = 0; n < 2; ++n) acc[a][b][m][n] = (f32x4){0.f, 0.f, 0.f, 0.f};
        cur = nxt; cA = nA; cB = nB; ++ui;
        if constexpr (ALIGN_EPI) { if (wr == 1) PG8_BAR; }
    }
    PG8_WAIT_V(0);
    if constexpr (!ALIGN_EPI) { if (wr == 0) PG8_BAR; }
    PG8_BAR;
    if constexpr (Epi::AFTER_DRAIN) { E.fused(acc, cur, wr, wc, fr, fq, lds, wid, lane); S.done(cur); }
#undef PG8_SA
#undef PG8_SB
#undef PG8_STAGE
#undef PG8_LDA
#undef PG8_LDB
#undef PG8_MMA
#undef PG8_WAIT_V
#undef PG8_WAIT_L
#undef PG8_BAR
#undef PG8_SCHED
}
}

struct EpiIn {
  static constexpr bool PERM = false, AFTER_DRAIN = false;
  const Params* pp; int l;
  __device__ __forceinline__ void operator()(f32x4 (&acc)[2][2][4][2], const pg8::Unit& u, int wr, int wc, int fr, int fq) const {
    kparams_t kp_ = kparams(); (void)kp_;
    const int U = u.pn * 4 + wc;
    if (U >= 77) return;
    const int rowb = u.pm * 256 + wr * 64 + fr;
    const int bq = (u.pm * 256) / T, tb = rowb % T;
    bf16_t* dst = nullptr; int ld = 0, col0 = 0; const float* gain = nullptr; bool rope = false, silu = false;
    float post = 1.0f;
    bf16_t* vt = nullptr;
    if (U < 8) { dst = WSP(bf16_t, OFF_QN); ld = 512; col0 = U * 64; gain = kp_->nsa_q_norm + l * 64; rope = true; post = 0.125f * LOG2E; }
    else if (U < 10) { dst = WSP(bf16_t, OFF_KC); ld = 128; col0 = (U - 8) * 64; rope = true; }
    else if (U < 12) { dst = WSP(bf16_t, OFF_VC); ld = 128; col0 = (U - 10) * 64; }
    else if (U < 14) { dst = WSP(bf16_t, OFF_KS); ld = 128; col0 = (U - 12) * 64; gain = kp_->nsa_k_norm + (l * 3 + 1) * 64; rope = true; }
    else if (U < 16) { vt = WSP(bf16_t, OFF_VST) + (size_t)((bq * 2 + (U - 14)) * 64) * T; }
    else if (U < 18) { dst = WSP(bf16_t, OFF_KW); ld = 128; col0 = (U - 16) * 64; gain = kp_->nsa_k_norm + (l * 3 + 2) * 64; rope = true; }
    else if (U < 20) { vt = WSP(bf16_t, OFF_VWT) + (size_t)((bq * 2 + (U - 18)) * 64) * T; }
    else if (U < 28) { dst = WSP(bf16_t, OFF_OA); ld = 512; col0 = (U - 20) * 64; silu = true; }
    else if (U < 36) { dst = WSP(bf16_t, OFF_FQ); ld = 512; col0 = (U - 28) * 64; gain = kp_->fox_q_norm + l * 64; post = 0.125f * LOG2E; }
    else if (U < 44) { dst = WSP(bf16_t, OFF_FK); ld = 512; col0 = (U - 36) * 64; gain = kp_->fox_k_norm + l * 64; }
    else if (U < 52) { vt = WSP(bf16_t, OFF_FVT) + (size_t)((bq * 8 + (U - 44)) * 64) * T; }
    else if (U < 60) { dst = WSP(bf16_t, OFF_OB); ld = 512; col0 = (U - 52) * 64; silu = true; }
    else if (U < 68) { dst = WSP(bf16_t, OFF_MQ); ld = 512; col0 = (U - 60) * 64; }
    else if (U < 76) { dst = WSP(bf16_t, OFF_OM); ld = 512; col0 = (U - 68) * 64; silu = true; }
    if (U == 76) {
      float* gate = WSP(float, OFF_GATE);
      float* flog = WSP(float, OFF_FLOG);
#pragma unroll
      for (int ai = 0; ai < 2; ++ai)
#pragma unroll
        for (int m = 0; m < 4; ++m) {
          const size_t row = (size_t)rowb + 128 * ai + 16 * m;
#pragma unroll
          for (int n = 0; n < 2; ++n)
#pragma unroll
            for (int i = 0; i < 4; ++i) {
              const int e = 16 * n + 4 * fq + i;
              const float v = acc[ai][0][m][n][i];
              if (e < 24) gate[row * 24 + e] = sigmoidf_(v);
              else {
                const float xx = v + kp_->fox_f_bias[l * 8 + (e - 24)];
                flog[row * 8 + (e - 24)] = xx >= 0.f ? -log1pf(expf(-xx)) : xx - log1pf(expf(xx));
              }
            }
        }
      return;
    }
    if (vt) {
#pragma unroll
      for (int ai = 0; ai < 2; ++ai)
#pragma unroll
        for (int m = 0; m < 4; ++m) {
          const int t = tb + 128 * ai + 16 * m;
#pragma unroll
          for (int bj = 0; bj < 2; ++bj)
#pragma unroll
            for (int n = 0; n < 2; ++n) {
              const f32x4 v = acc[ai][bj][m][n];
              const unsigned w0 = cvtpk(v[0], v[1]), w1 = cvtpk(v[2], v[3]);
              const unsigned qo = (unsigned)((32 * bj + 16 * n + 4 * fq) * T + t);
              vt[qo] = (bf16_t)(w0 & 0xffffu); vt[qo + T] = (bf16_t)(w0 >> 16); vt[qo + 2 * T] = (bf16_t)(w1 & 0xffffu); vt[qo + 3 * T] = (bf16_t)(w1 >> 16);
            }
        }
      return;
    }
    const float* ropetab = WSP(float, OFF_ROPE);
    f32x4 gv[2][2];
    if (gain) {
#pragma unroll
      for (int bj = 0; bj < 2; ++bj)
#pragma unroll
        for (int n = 0; n < 2; ++n) gv[bj][n] = *(const f32x4*)(gain + 32 * bj + 16 * n + 4 * fq);
    }
#pragma unroll
    for (int ai = 0; ai < 2; ++ai)
#pragma unroll
      for (int m = 0; m < 4; ++m) {
        f32x4 v[2][2];
#pragma unroll
        for (int bj = 0; bj < 2; ++bj)
#pragma unroll
          for (int n = 0; n < 2; ++n) v[bj][n] = acc[ai][bj][m][n];
        const int row = rowb + 128 * ai + 16 * m;
        if (gain) {
          float ss = 0.f;
#pragma unroll
          for (int bj = 0; bj < 2; ++bj)
#pragma unroll
            for (int n = 0; n < 2; ++n)
#pragma unroll
              for (int i = 0; i < 4; ++i) ss += v[bj][n][i] * v[bj][n][i];
          ss += __shfl_xor(ss, 16);
          ss += __shfl_xor(ss, 32);
          const float rstd = rsqrtf(ss * (1.0f / 64.0f) + EPS);
#pragma unroll
          for (int bj = 0; bj < 2; ++bj)
#pragma unroll
            for (int n = 0; n < 2; ++n) v[bj][n] = v[bj][n] * rstd * gv[bj][n];
        }
        if (rope) {
          const int pos = row & (T - 1);
#pragma unroll
          for (int n = 0; n < 2; ++n) {
            const f32x4* tp = (const f32x4*)(ropetab + ((size_t)pos * 32 + 16 * n + 4 * fq) * 2);
            const f32x4 t0 = tp[0], t1 = tp[1];
            const float cs[4] = {t0[0], t0[2], t1[0], t1[2]}, sn[4] = {t0[1], t0[3], t1[1], t1[3]};
#pragma unroll
            for (int i = 0; i < 4; ++i) {
              const float y1 = v[0][n][i], y2 = v[1][n][i];
              v[0][n][i] = y1 * cs[i] - y2 * sn[i];
              v[1][n][i] = y2 * cs[i] + y1 * sn[i];
            }
          }
        }
#pragma unroll
        for (int bj = 0; bj < 2; ++bj)
#pragma unroll
          for (int n = 0; n < 2; ++n) {
            f32x4 y = v[bj][n] * post;
            if (silu) {
#pragma unroll
              for (int i = 0; i < 4; ++i) y[i] = siluf_(y[i]);
            }
            u32x2 w = {cvtpk(y[0], y[1]), cvtpk(y[2], y[3])};
            *(u32x2*)(dst + (size_t)row * ld + col0 + 32 * bj + 16 * n + 4 * fq) = w;
          }
      }
  }
};
struct EpiMemKV {
  static constexpr bool PERM = false, AFTER_DRAIN = false;
  const Params* pp;
  __device__ __forceinline__ void operator()(f32x4 (&acc)[2][2][4][2], const pg8::Unit& u, int wr, int wc, int fr, int fq) const {
    kparams_t kp_ = kparams(); (void)kp_;
    const int U = u.pn * 4 + wc;
    const int rowb = u.pm * 256 + wr * 64 + fr;
#pragma unroll
    for (int ai = 0; ai < 2; ++ai)
#pragma unroll
      for (int m = 0; m < 4; ++m) {
        const int row = rowb + 128 * ai + 16 * m;
#pragma unroll
        for (int bj = 0; bj < 2; ++bj)
#pragma unroll
          for (int n = 0; n < 2; ++n) {
            const f32x4 v = acc[ai][bj][m][n];
            const unsigned w0 = cvtpk(v[0], v[1]), w1 = cvtpk(v[2], v[3]);
            const int e = 32 * bj + 16 * n + 4 * fq;
            if (U < 8) {
              u32x2 w = {w0, w1};
              *(u32x2*)(WSP(bf16_t, OFF_MK) + (size_t)row * 512 + U * 64 + e) = w;
            } else {
              const int col = (U - 8) * 64 + e, h = col >> 7, d = col & 127, b = row >> 8, mm = row & 255;
              bf16_t* q = WSP(bf16_t, OFF_MVT) + (size_t)((b * 4 + h) * 128 + d) * 256 + mm;
              q[0] = (bf16_t)(w0 & 0xffffu); q[256] = (bf16_t)(w0 >> 16); q[512] = (bf16_t)(w1 & 0xffffu); q[768] = (bf16_t)(w1 >> 16);
            }
          }
      }
  }
};
struct EpiGate {
  static constexpr bool PERM = true, AFTER_DRAIN = false;
  bf16_t* G;
  __device__ __forceinline__ void operator()(f32x4 (&acc)[2][2][4][2], const pg8::Unit& u, int wr, int wc, int fr, int fq) const {
    const int br = u.pn >> 2, colt = (u.pn & 3) * 256 + wc * 32 + 8 * fq;
    bf16_t* base = G + (size_t)br * M * 1024;
    const int rowb = u.pm * 256 + wr * 64 + fr;
#pragma unroll
    for (int ai = 0; ai < 2; ++ai)
#pragma unroll
      for (int m = 0; m < 4; ++m) {
        bf16_t* rp = base + (size_t)(rowb + 128 * ai + 16 * m) * 1024 + colt;
#pragma unroll
        for (int bj = 0; bj < 2; ++bj) {
          const f32x4 v0 = acc[ai][bj][m][0], v1 = acc[ai][bj][m][1];
          u32x4 w = {cvtpk(sigmoidf_(v0[0]), sigmoidf_(v0[1])), cvtpk(sigmoidf_(v0[2]), sigmoidf_(v0[3])),
                     cvtpk(sigmoidf_(v1[0]), sigmoidf_(v1[1])), cvtpk(sigmoidf_(v1[2]), sigmoidf_(v1[3]))};
          *(u32x4*)(rp + 128 * bj) = w;
        }
      }
  }
};
struct EpiBranch {
  static constexpr bool PERM = true, AFTER_DRAIN = false;
  const bf16_t* G; bf16_t* Uo; int first;
  __device__ __forceinline__ void operator()(f32x4 (&acc)[2][2][4][2], const pg8::Unit& u, int wr, int wc, int fr, int fq) const {
    const int colt = u.pn * 256 + wc * 32 + 8 * fq;
    const int rowb = u.pm * 256 + wr * 64 + fr;
#pragma unroll
    for (int ai = 0; ai < 2; ++ai)
#pragma unroll
      for (int m = 0; m < 4; ++m) {
        const size_t ro = (size_t)(rowb + 128 * ai + 16 * m) * 1024 + colt;
#pragma unroll
        for (int bj = 0; bj < 2; ++bj) {
          const size_t off = ro + 128 * bj;
          const u32x4 gw = *(const u32x4*)(G + off);
          float y[8];
#pragma unroll
          for (int q = 0; q < 4; ++q) {
            const f32x4 v = acc[ai][bj][m][q >> 1];
            y[2 * q] = v[(2 * q) & 3] * bflo(gw[q]);
            y[2 * q + 1] = v[(2 * q + 1) & 3] * bfhi(gw[q]);
          }
          if (!first) {
            const u32x4 uw = *(const u32x4*)(Uo + off);
#pragma unroll
            for (int q = 0; q < 4; ++q) { y[2 * q] += bflo(uw[q]); y[2 * q + 1] += bfhi(uw[q]); }
          }
          u32x4 w = {cvtpk(y[0], y[1]), cvtpk(y[2], y[3]), cvtpk(y[4], y[5]), cvtpk(y[6], y[7])};
          *(u32x4*)(Uo + off) = w;
        }
      }
  }
};
struct EpiOut {
  static constexpr bool PERM = true, AFTER_DRAIN = false;
  const float* xin; float* xout;
  __device__ __forceinline__ void operator()(f32x4 (&acc)[2][2][4][2], const pg8::Unit& u, int wr, int wc, int fr, int fq) const {
    const int colt = u.pn * 256 + wc * 32 + 8 * fq;
    const int rowb = u.pm * 256 + wr * 64 + fr;
#pragma unroll
    for (int ai = 0; ai < 2; ++ai)
#pragma unroll
      for (int m = 0; m < 4; ++m) {
        const size_t ro = (size_t)(rowb + 128 * ai + 16 * m) * 1024 + colt;
#pragma unroll
        for (int bj = 0; bj < 2; ++bj) {
          const size_t off = ro + 128 * bj;
          const f32x4 x0 = *(const f32x4*)(xin + off), x1 = *(const f32x4*)(xin + off + 4);
          *(f32x4*)(xout + off) = x0 + acc[ai][bj][m][0];
          *(f32x4*)(xout + off + 4) = x1 + acc[ai][bj][m][1];
        }
      }
  }
};
template <class Epi>
__device__ __forceinline__ void run_gemm(PG8_LAS unsigned char* lds, const bf16_t* A, const bf16_t* Bt, int Mr, int Nc, int K, const Epi& E) {
  pg8::Gemm g{A, Bt, Mr, Nc, K};
  pg8::StaticOrder S;
  S.init(Mr, Nc, gdim(), bidx());
  pg8::gemm_phase<Epi, pg8::StaticOrder, true, true>(lds, g, S, E);
}

__device__ __forceinline__ int map_in(int n) {
  const int i = n >> 6, c = n & 63;
  if (i < 20) return n;
  if (i < 28) return 1304 + (n - 1280);
  if (i < 52) return 1816 + (n - 1792);
  if (i < 60) return 3360 + (n - 3328);
  if (i < 68) return 3872 + (n - 3840);
  if (i < 76) return 4384 + (n - 4352);
  if (i == 76) return c < 24 ? 1280 + c : (c < 32 ? 3352 + (c - 24) : -1);
  return -1;
}
__device__ __forceinline__ void wave_transpose_tile(const float* __restrict__ src, int ld_src, int k0, int n0, bf16_t* __restrict__ dst,
                                                    int Kdim, int maptype, int srccol0, float* tile, int lane) {
  int nlog = n0 + lane;
  if (maptype) { const int w = nlog & 255; nlog = (nlog & ~255) + (((w & 127) >> 5) << 6) + (((w >> 7) << 5) | (w & 31)); }
  const int sc = (maptype == 1) ? map_in(nlog) : srccol0 + nlog;
  const float* sp = src + (size_t)k0 * ld_src + (sc >= 0 ? sc : 0);
#pragma unroll 32
  for (int kk = 0; kk < 64; ++kk) {
    const float v = sp[(size_t)kk * ld_src];
    tile[kk * 65 + lane] = sc >= 0 ? v : 0.f;
  }
  __builtin_amdgcn_fence(__ATOMIC_SEQ_CST, "workgroup");
  __builtin_amdgcn_wave_barrier();
  const int rsub = lane >> 5, kp = lane & 31;
#pragma unroll 8
  for (int it = 0; it < 32; ++it) {
    const int row = 2 * it + rsub;
    const float a = tile[(2 * kp) * 65 + row], b = tile[(2 * kp + 1) * 65 + row];
    *(unsigned*)(dst + (size_t)(n0 + row) * Kdim + k0 + 2 * kp) = cvtpk(a, b);
  }
  __builtin_amdgcn_fence(__ATOMIC_SEQ_CST, "workgroup");
  __builtin_amdgcn_wave_barrier();
}
__device__ __forceinline__ void rmsnorm4(const float* __restrict__ x, const float* __restrict__ gain, bf16_t* __restrict__ dst, size_t row0, int lane) {
  f32x4 v[4][4];
  float ss[4];
#pragma unroll
  for (int rr = 0; rr < 4; ++rr)
#pragma unroll
    for (int i = 0; i < 4; ++i) v[rr][i] = *(const f32x4*)(x + (row0 + rr) * 1024 + lane * 4 + 256 * i);
  f32x4 gv[4];
#pragma unroll
  for (int i = 0; i < 4; ++i) gv[i] = *(const f32x4*)(gain + lane * 4 + 256 * i);
#pragma unroll
  for (int rr = 0; rr < 4; ++rr) {
    float s = 0.f;
#pragma unroll
    for (int i = 0; i < 4; ++i) s += v[rr][i][0] * v[rr][i][0] + v[rr][i][1] * v[rr][i][1] + v[rr][i][2] * v[rr][i][2] + v[rr][i][3] * v[rr][i][3];
    ss[rr] = s;
  }
#pragma unroll
  for (int o_ = 1; o_ < 64; o_ <<= 1) {
#pragma unroll
    for (int rr = 0; rr < 4; ++rr) ss[rr] += __shfl_xor(ss[rr], o_);
  }
#pragma unroll
  for (int rr = 0; rr < 4; ++rr) {
    const float rstd = rsqrtf(ss[rr] * (1.0f / 1024.0f) + EPS);
#pragma unroll
    for (int i = 0; i < 4; ++i) {
      const f32x4 y = v[rr][i] * rstd * gv[i];
      u32x2 w = {cvtpk(y[0], y[1]), cvtpk(y[2], y[3])};
      *(u32x2*)(dst + (row0 + rr) * 1024 + lane * 4 + 256 * i) = w;
    }
  }
}
__device__ __forceinline__ void phase_prep(const Params& p, int l, float* smem) {
  kparams_t kp_ = kparams(); (void)kp_;
  const int tid = tidx();
  const int wave = tid >> 6, lane = tid & 63;
  const int gw = wave * gdim() + bidx(), nw = NWAVES * gdim();
  if (l == 0 && bidx() == 0 && tid < 64) WSP(unsigned, OFF_CTL)[tid] = 0u;
  const float* xin = (l == 0) ? kp_->x : kp_->out;
  float* wtile = smem + wave * 4160;
  for (int u0 = gw; u0 < 3076; u0 += nw) {
    int u = u0;
    const float* src; int ld, kt, nt, Kd, mt = 0, c0 = 0; bf16_t* dst;
    if (u < 1280) { kt = u / 80; nt = u % 80; src = kp_->w_in + (size_t)l * 1024 * 7968; ld = 7968; Kd = 1024; dst = WSP(bf16_t, OFF_W_IN); mt = 1; }
    else if ((u -= 1280) < 768) { kt = u / 48; nt = u % 48; src = kp_->w_in + (size_t)l * 1024 * 7968; ld = 7968; Kd = 1024; dst = WSP(bf16_t, OFF_W_G); c0 = 4896; }
    else if ((u -= 768) < 256) { kt = u / 16; nt = u % 16; src = kp_->w_mem_kv + (size_t)l * 1024 * 1024; ld = 1024; Kd = 1024; dst = WSP(bf16_t, OFF_W_MKV); mt = 2; }
    else if ((u -= 256) < 384) { const int br = u / 128, uu = u % 128; kt = uu / 16; nt = uu % 16;
      src = (br == 0 ? kp_->w_branch_a : br == 1 ? kp_->w_branch_b : kp_->w_branch_m) + (size_t)l * 512 * 1024; ld = 1024; Kd = 512; dst = WSP(bf16_t, OFF_W_BR + (size_t)br * MiB); }
    else if ((u -= 384) < 256) { kt = u / 16; nt = u % 16; src = kp_->w_out + (size_t)l * 1024 * 1024; ld = 1024; Kd = 1024; dst = WSP(bf16_t, OFF_W_OUT); }
    else if ((u -= 256) < 128) { const int kv = u / 64, uu = u % 64; kt = uu / 2; nt = uu % 2;
      src = (kv ? kp_->cmp_w1_v : kp_->cmp_w1_k) + (size_t)l * 2048 * 128; ld = 128; Kd = 2048; dst = WSP(bf16_t, OFF_W1 + (size_t)kv * 512 * 1024); }
    else { u -= 128; const int kv = u / 2; kt = u % 2; nt = 0;
      src = (kv ? kp_->cmp_w2_v : kp_->cmp_w2_k) + (size_t)l * 128 * 64; ld = 64; Kd = 128; dst = WSP(bf16_t, OFF_W2 + (size_t)kv * 64 * 1024); }
    wave_transpose_tile(src, ld, kt * 64, nt * 64, dst, Kd, mt, c0, wtile, lane);
  }
  for (int grp = gw; grp < 8192 + 256; grp += nw) {
    if (grp < 8192) rmsnorm4(xin, kp_->norm_g + l * 1024, WSP(bf16_t, OFF_H), (size_t)grp * 4, lane);
    else rmsnorm4(kp_->mem, kp_->mem_norm_g + l * 1024, WSP(bf16_t, OFF_MEMN), (size_t)(grp - 8192) * 4, lane);
  }
  for (int u = gw; u < 32; u += nw) {
    const int kv = u >> 4, ch = u & 15;
    const float* pe = (kv ? kp_->cmp_pe_v : kp_->cmp_pe_k) + (size_t)l * 2048 + ch * 128;
    const float* w1 = (kv ? kp_->cmp_w1_v : kp_->cmp_w1_k) + (size_t)l * 2048 * 128 + (size_t)ch * 128 * 128;
    float s0 = 0.f, s1 = 0.f;
#pragma unroll 32
    for (int kk = 0; kk < 128; ++kk) {
      const float pv = pe[kk];
      s0 += pv * w1[(size_t)kk * 128 + lane];
      s1 += pv * w1[(size_t)kk * 128 + 64 + lane];
    }
    float* part = WSP(float, OFF_C1) + (size_t)(kv * 16 + ch) * 128;
    part[lane] = s0;
    part[64 + lane] = s1;
  }
  if (l == 0) {
    for (int u = bidx(); u < 512; u += gdim()) {
      for (int e = tid; e < 512; e += NTHREADS) {
        const int idx = u * 512 + e, pos = idx >> 5, f = idx & 31;
        const float ang = (float)pos * c_inv_freq[f];
        const double a = (double)ang;
        const double k = rint(a * 0.15915494309189535);
        const float rr = (float)(a - k * 6.283185307179586);
        float2 cs; cs.x = __cosf(rr); cs.y = __sinf(rr);
        WSP(float2, OFF_ROPE)[idx] = cs;
      }
    }
  }
}

__device__ __forceinline__ void compress_wg(const Params& p, int l, int up, float* smem) {
  kparams_t kp_ = kparams(); (void)kp_;
  const int wave_ = tidx() >> 6, kc = wave_ & 3, u = up * 2 + (wave_ >> 2);
  const int lane = tidx() & 63, r = lane & 15, g4 = lane >> 4;
  const int kv = u >> 7, rem = u & 127, b = rem >> 5, grp = (rem >> 4) & 1, it = rem & 15, i0 = it * 32;
  const bf16_t* src = WSP(bf16_t, kv ? OFF_VC : OFF_KC);
  const bf16_t* w1t = WSP(bf16_t, OFF_W1 + (size_t)kv * 512 * 1024);
  const bf16_t* w2t = WSP(bf16_t, OFF_W2 + (size_t)kv * 64 * 1024);
  const float* c1 = WSP(float, OFF_C1 + 16384) + kv * 128;
  const bf16_t* arow[2];
#pragma unroll
  for (int mt = 0; mt < 2; ++mt) {
    int i = i0 + 16 * mt + r;
    if (i > 510) i = 510;
    arow[mt] = src + ((size_t)b * T + 16 * i) * 128 + grp * 64 + g4 * 8;
  }
  f32x4 acc[2][8];
#pragma unroll
  for (int a = 0; a < 2; ++a)
#pragma unroll
    for (int c = 0; c < 8; ++c) acc[a][c] = (f32x4){0.f, 0.f, 0.f, 0.f};
  const bf16_t* bp = w1t + (size_t)r * 2048 + g4 * 8;
#pragma unroll 1
  for (int k0 = kc * 512; k0 < kc * 512 + 512; k0 += 32) {
    const int pp = k0 >> 6, d = k0 & 63;
    bf16x8 af[2], bf[8];
#pragma unroll
    for (int mt = 0; mt < 2; ++mt) af[mt] = *(const bf16x8*)(arow[mt] + (size_t)pp * 128 + d);
#pragma unroll
    for (int nt = 0; nt < 8; ++nt) bf[nt] = *(const bf16x8*)(bp + (size_t)nt * 16 * 2048 + k0);
#pragma unroll
    for (int mt = 0; mt < 2; ++mt)
#pragma unroll
      for (int nt = 0; nt < 8; ++nt) acc[mt][nt] = mfma16(bf[nt], af[mt], acc[mt][nt]);
  }
  {
    float* part = smem + wave_ * 4096;
#pragma unroll
    for (int a = 0; a < 2; ++a)
#pragma unroll
      for (int c = 0; c < 8; ++c)
#pragma unroll
        for (int i = 0; i < 4; ++i) part[((a * 8 + c) * 4 + i) * 64 + lane] = acc[a][c][i];
  }
  __syncthreads();
  if (kc != 0) return;
#pragma unroll 1
  for (int q = 1; q < 4; ++q) {
    const float* part = smem + (wave_ + q) * 4096;
#pragma unroll
    for (int a = 0; a < 2; ++a) {
#pragma unroll
      for (int c = 0; c < 8; ++c)
#pragma unroll
        for (int i = 0; i < 4; ++i) acc[a][c][i] += part[((a * 8 + c) * 4 + i) * 64 + lane];
      asm volatile("" ::: "memory");
    }
  }
#pragma unroll
  for (int nt = 0; nt < 8; ++nt) {
    const f32x4 cv = *(const f32x4*)(c1 + 16 * nt + 4 * g4);
#pragma unroll
    for (int mt = 0; mt < 2; ++mt)
#pragma unroll
      for (int i = 0; i < 4; ++i) acc[mt][nt][i] = siluf_(acc[mt][nt][i] + cv[i]);
  }
  bf16x8 wf[4][4];
#pragma unroll
  for (int ks = 0; ks < 4; ++ks)
#pragma unroll
    for (int et = 0; et < 4; ++et) {
      const bf16_t* wp = w2t + (size_t)(16 * et + r) * 128 + 32 * ks + 4 * g4;
      const u32x2 lo = *(const u32x2*)wp, hi = *(const u32x2*)(wp + 16);
      u32x4 w = {lo[0], lo[1], hi[0], hi[1]};
      wf[ks][et] = __builtin_bit_cast(bf16x8, w);
    }
  if (kv == 0) {
    const float* gain = kp_->nsa_k_norm + (size_t)(l * 3 + 0) * 64;
    bf16_t* dst = WSP(bf16_t, OFF_KCMP) + (size_t)((b * 2 + grp) * 512) * 64;
    f32x4 gv[4];
#pragma unroll
    for (int et = 0; et < 4; ++et) gv[et] = *(const f32x4*)(gain + 16 * et + 4 * g4);
#pragma unroll
    for (int mt = 0; mt < 2; ++mt) {
      f32x4 o[4];
#pragma unroll
      for (int et = 0; et < 4; ++et) o[et] = (f32x4){0.f, 0.f, 0.f, 0.f};
#pragma unroll
      for (int ks = 0; ks < 4; ++ks) {
        const bf16x8 xf = pack8(acc[mt][2 * ks], acc[mt][2 * ks + 1]);
#pragma unroll
        for (int et = 0; et < 4; ++et) o[et] = mfma16(wf[ks][et], xf, o[et]);
      }
      float ss = 0.f;
#pragma unroll
      for (int et = 0; et < 4; ++et)
#pragma unroll
        for (int i = 0; i < 4; ++i) ss += o[et][i] * o[et][i];
      ss += __shfl_xor(ss, 16);
      ss += __shfl_xor(ss, 32);
      const float rstd = rsqrtf(ss * (1.0f / 64.0f) + EPS);
      const int i = i0 + 16 * mt + r;
#pragma unroll
      for (int et = 0; et < 4; ++et) {
        f32x4 y = o[et] * rstd * gv[et];
        if (i > 510) y = (f32x4){0.f, 0.f, 0.f, 0.f};
        u32x2 w = {cvtpk(y[0], y[1]), cvtpk(y[2], y[3])};
        *(u32x2*)(dst + (size_t)i * 64 + 16 * et + 4 * g4) = w;
      }
    }
  } else {
    bf16_t* dst = WSP(bf16_t, OFF_VCT) + (size_t)((b * 2 + grp) * 64) * 512;
#pragma unroll
    for (int mt = 0; mt < 2; ++mt) {
      f32x4 o[4];
#pragma unroll
      for (int et = 0; et < 4; ++et) o[et] = (f32x4){0.f, 0.f, 0.f, 0.f};
#pragma unroll
      for (int ks = 0; ks < 4; ++ks) {
        const bf16x8 xf = pack8(acc[mt][2 * ks], acc[mt][2 * ks + 1]);
#pragma unroll
        for (int et = 0; et < 4; ++et) o[et] = mfma16(xf, wf[ks][et], o[et]);
      }
#pragma unroll
      for (int et = 0; et < 4; ++et) {
        f32x4 y = o[et];
        const int ib = i0 + 16 * mt + 4 * g4;
#pragma unroll
        for (int i = 0; i < 4; ++i)
          if (ib + i > 510) y[i] = 0.f;
        u32x2 w = {cvtpk(y[0], y[1]), cvtpk(y[2], y[3])};
        *(u32x2*)(dst + (size_t)(16 * et + r) * 512 + ib) = w;
      }
    }
  }
}
__device__ __forceinline__ void cumsum_wg(const Params& p, int u, float* smem) {
  kparams_t kp_ = kparams(); (void)kp_;
  const int tid = tidx(), lane = tid & 63, wave = tid >> 6, b = u >> 3, h = u & 7;
  const float* fl = WSP(float, OFF_FLOG) + ((size_t)b * T) * 8 + h;
  float* fc = WSP(float, OFF_FC) + (size_t)(b * 8 + h) * T;
  const int tb = tid * 16;
  float v[16];
#pragma unroll
  for (int i = 0; i < 16; ++i) v[i] = fl[(size_t)(tb + i) * 8];
  double s = 0.0;
#pragma unroll
  for (int i = 0; i < 16; ++i) s += (double)v[i];
  double incl = s;
#pragma unroll
  for (int o = 1; o < 64; o <<= 1) {
    const double y = __shfl_up(incl, o);
    if (lane >= o) incl += y;
  }
  double* wtot = (double*)smem;
  if (lane == 63) wtot[wave] = incl;
  __syncthreads();
  double base = 0.0;
  for (int w = 0; w < wave; ++w) base += wtot[w];
  double run = base + incl - s;
#pragma unroll
  for (int i = 0; i < 16; ++i) { run += (double)v[i]; v[i] = (float)run; }
#pragma unroll
  for (int i = 0; i < 4; ++i) *(f32x4*)(fc + tb + 4 * i) = (f32x4){v[4 * i], v[4 * i + 1], v[4 * i + 2], v[4 * i + 3]};
  __syncthreads();
}
__device__ __forceinline__ void memk_norm_unit(const Params& p, int l, int u) {
  kparams_t kp_ = kparams(); (void)kp_;
  const int lane = tidx() & 63;
  bf16_t* mk = WSP(bf16_t, OFF_MK);
  const float* gain = kp_->mem_k_norm + l * 128 + (lane & 15) * 8;
  for (int rr = 0; rr < 16; ++rr) {
    bf16_t* ptr = mk + (size_t)(u * 16 + rr) * 512 + lane * 8;
    const u32x4 w = *(const u32x4*)ptr;
    float v[8];
#pragma unroll
    for (int j = 0; j < 4; ++j) { v[2 * j] = bflo(w[j]); v[2 * j + 1] = bfhi(w[j]); }
    float ss = 0.f;
#pragma unroll
    for (int j = 0; j < 8; ++j) ss += v[j] * v[j];
#pragma unroll
    for (int o = 1; o < 16; o <<= 1) ss += __shfl_xor(ss, o);
    const float rstd = rsqrtf(ss * (1.0f / 128.0f) + EPS);
    u32x4 ow;
#pragma unroll
    for (int j = 0; j < 4; ++j) ow[j] = cvtpk(v[2 * j] * rstd * gain[2 * j], v[2 * j + 1] * rstd * gain[2 * j + 1]);
    *(u32x4*)ptr = ow;
  }
}
__device__ __forceinline__ void phase_mid(const Params& p, int l, float* smem) {
  const int wave = tidx() >> 6;
  for (int u = bidx(); u < 128 + 32 + 8; u += gdim()) {
    if (u < 128) { compress_wg(p, l, u, smem); __syncthreads(); }
    else if (u < 160) cumsum_wg(p, u - 128, smem);
    else memk_norm_unit(p, l, (u - 160) * 8 + wave);
  }
}

template <int NCT, int NDK, bool QL = false>
__device__ __forceinline__ void qk_scores(const bf16_t* __restrict__ kbase, int ldk, int key0,
                                          const bf16x8 (&qf)[NCT][NDK], f32x4 (&s)[2][NCT], int lane, const bf16x8* qlds = nullptr) {
  const int r = lane & 15, grp = lane >> 4;
#pragma unroll
  for (int kt = 0; kt < 2; ++kt) {
    const bf16_t* kp = kbase + (size_t)(key0 + 8 * (r >> 2) + 4 * kt + (r & 3)) * ldk + grp * 8;
    bf16x8 kf[NDK];
#pragma unroll
    for (int dk = 0; dk < NDK; ++dk) kf[dk] = *(const bf16x8*)(kp + dk * 32);
#pragma unroll
    for (int ct = 0; ct < NCT; ++ct) {
      f32x4 a = {0.f, 0.f, 0.f, 0.f};
#pragma unroll
      for (int dk = 0; dk < NDK; ++dk) a = mfma16(kf[dk], QL ? qlds[(ct * NDK + dk) * 64 + lane] : qf[ct][dk], a);
      s[kt][ct] = a;
    }
  }
}
template <int NCT, int NDT>
__device__ __forceinline__ void pv_accum(const bf16_t* __restrict__ vt, size_t ldv, int key0,
                                         const f32x4 (&s)[2][NCT], f32x4 (&o)[NDT][NCT], int lane) {
  const int r = lane & 15, grp = lane >> 4;
  bf16x8 pb[NCT];
#pragma unroll
  for (int ct = 0; ct < NCT; ++ct) pb[ct] = pack8(s[0][ct], s[1][ct]);
#pragma unroll
  for (int dt = 0; dt < NDT; ++dt) {
    const bf16x8 vf = *(const bf16x8*)(vt + (size_t)(16 * dt + r) * ldv + key0 + 8 * grp);
#pragma unroll
    for (int ct = 0; ct < NCT; ++ct) o[dt][ct] = mfma16(vf, pb[ct], o[dt][ct]);
  }
}
template <int NCT, int NDT, bool HAS_O, bool SUMS = true>
__device__ __forceinline__ void softmax_update(f32x4 (&s)[2][NCT], float (&m)[NCT], float (&lsum)[NCT],
                                               f32x4 (&o)[NDT][NCT], f32x4 (*lacc)[NCT] = nullptr) {
  float mnew[NCT];
  bool ch = false;
#pragma unroll
  for (int ct = 0; ct < NCT; ++ct) {
    float mx = fmaxf(fmaxf(fmaxf(s[0][ct][0], s[0][ct][1]), fmaxf(s[0][ct][2], s[0][ct][3])),
                     fmaxf(fmaxf(s[1][ct][0], s[1][ct][1]), fmaxf(s[1][ct][2], s[1][ct][3])));
    mx = grp_max4(mx);
    mnew[ct] = fmaxf(m[ct], mx);
    ch = ch || (mnew[ct] > m[ct]);
  }
  if (__any(ch)) {
#pragma unroll
    for (int ct = 0; ct < NCT; ++ct) {
      const float msafe = (mnew[ct] == NEG_INF) ? 0.f : mnew[ct];
      const float alpha = __builtin_amdgcn_exp2f(m[ct] - msafe);
      m[ct] = mnew[ct];
      if (SUMS) lsum[ct] *= alpha; else (*lacc)[ct] = (*lacc)[ct] * alpha;
      if (HAS_O) {
#pragma unroll
        for (int dt = 0; dt < NDT; ++dt) o[dt][ct] = o[dt][ct] * alpha;
      }
    }
  }
#pragma unroll
  for (int ct = 0; ct < NCT; ++ct) {
    const float msafe = (m[ct] == NEG_INF) ? 0.f : m[ct];
#pragma unroll
    for (int kt = 0; kt < 2; ++kt) {
      const f32x4 d = s[kt][ct] - msafe;
      f32x4 pv;
#pragma unroll
      for (int i = 0; i < 4; ++i) pv[i] = __builtin_amdgcn_exp2f(d[i]);
      s[kt][ct] = pv;
    }
    if (SUMS) {
      const f32x4 t4 = s[0][ct] + s[1][ct];
      lsum[ct] += (t4[0] + t4[1]) + (t4[2] + t4[3]);
    }
  }
}
__device__ __forceinline__ float finish_l(float lsum) {
  lsum += __shfl_xor(lsum, 16);
  lsum += __shfl_xor(lsum, 32);
  return lsum > 0.f ? 1.0f / lsum : 0.f;
}

typedef __attribute__((address_space(3))) unsigned char lds_u8;
constexpr int TILE_ROWB = 144, TILE_HALF = 64 * TILE_ROWB, TILE_STAGE = 2 * TILE_HALF + 256;
struct TileRegs { u32x4 k, v; };
__device__ __forceinline__ void tile_gload(TileRegs& tr, const bf16_t* __restrict__ kbase, int ldk, const bf16_t* __restrict__ vtbase,
                                           size_t ldv, int key0, int tid) {
  const int row = tid >> 3, ch = tid & 7;
  tr.k = *(const u32x4*)(kbase + (size_t)(key0 + row) * ldk + ch * 8);
  tr.v = *(const u32x4*)(vtbase + (size_t)row * ldv + key0 + ch * 8);
}
__device__ __forceinline__ void tile_swrite(const TileRegs& tr, lds_u8* stage, int tid) {
  const int row = tid >> 3, ch = tid & 7;
  *(__attribute__((address_space(3))) u32x4*)(stage + row * TILE_ROWB + ch * 16) = tr.k;
  *(__attribute__((address_space(3))) u32x4*)(stage + TILE_HALF + row * TILE_ROWB + ch * 16) = tr.v;
}
template <int NCT, int NDK, bool QL>
__device__ __forceinline__ void qk_scores_lds(const lds_u8* stage, int hf, const bf16x8 (&qf)[NCT][NDK], f32x4 (&s)[2][NCT], int lane,
                                              const bf16x8* qlds, const f32x4 c0, const f32x4 c1) {
  const int r = lane & 15, grp = lane >> 4;
#pragma unroll
  for (int kt = 0; kt < 2; ++kt) {
    const lds_u8* kp = stage + (32 * hf + 8 * (r >> 2) + 4 * kt + (r & 3)) * TILE_ROWB + grp * 16;
    bf16x8 kf[NDK];
#pragma unroll
    for (int dk = 0; dk < NDK; ++dk) kf[dk] = *(const __attribute__((address_space(3))) bf16x8*)(kp + dk * 64);
#pragma unroll
    for (int ct = 0; ct < NCT; ++ct) {
      f32x4 a = kt ? c1 : c0;
#pragma unroll
      for (int dk = 0; dk < NDK; ++dk) a = mfma16(kf[dk], QL ? qlds[(ct * NDK + dk) * 64 + lane] : qf[ct][dk], a);
      s[kt][ct] = a;
    }
  }
}
template <int NDT>
__device__ __forceinline__ void v_frags_lds(const lds_u8* stage, int hf, bf16x8 (&vf)[NDT], int lane) {
  const int r = lane & 15, grp = lane >> 4;
#pragma unroll
  for (int dt = 0; dt < NDT; ++dt)
    vf[dt] = *(const __attribute__((address_space(3))) bf16x8*)(stage + TILE_HALF + (16 * dt + r) * TILE_ROWB + (32 * hf + 8 * grp) * 2);
}
template <int NCT, int NDT>
__device__ __forceinline__ void pv_accum_lds(const bf16x8 (&vfp)[NDT], const f32x4 (&s)[2][NCT], f32x4 (&o)[NDT][NCT], int lane, f32x4 (&lacc)[NCT]) {
  const int r = lane & 15, grp = lane >> 4; (void)r; (void)grp;
  bf16x8 pb[NCT];
#pragma unroll
  for (int ct = 0; ct < NCT; ++ct) pb[ct] = pack8(s[0][ct], s[1][ct]);
  {
    const short one = (short)0x3F80;
    const bf16x8 ones = {one, one, one, one, one, one, one, one};
#pragma unroll
    for (int ct = 0; ct < NCT; ++ct) lacc[ct] = mfma16(ones, pb[ct], lacc[ct]);
  }
#pragma unroll
  for (int dt = 0; dt < NDT; ++dt) {
    const bf16x8 vf = vfp[dt];
#pragma unroll
    for (int ct = 0; ct < NCT; ++ct) o[dt][ct] = mfma16(vf, pb[ct], o[dt][ct]);
  }
}
__device__ __forceinline__ int next_bit(unsigned long long lo, unsigned long long hi, int from) {
  if (from < 64) { const unsigned long long mm = lo & (~0ull << from); if (mm) return __ffsll(mm) - 1; from = 64; }
  if (from < 128) { const unsigned long long mm = hi & (~0ull << (from - 64)); if (mm) return 64 + __ffsll(mm) - 1; }
  return 128;
}

__device__ __forceinline__ void nsa_wg_unit(const Params& p, int b, int g, int qi, float* imp, bf16x8* qlds, float* scr, lds_u8* tiles, unsigned* misc, bool st) {
  kparams_t kp_ = kparams(); (void)kp_;
  const int tid0 = tidx();
  const int wave = __builtin_amdgcn_readfirstlane(tid0 >> 6);
  const int lane0 = tid0 & 63;
  const int tq = qi * 8 + wave;
  const int t0 = tq * 16;
  const bf16x8 (&qf)[4][2] = *(const bf16x8 (*)[4][2])nullptr;
#define NSA_SECTION_VARS \
  int lane = lane0; asm volatile("" : "+v"(lane)); \
  const int r = lane & 15, grp = lane >> 4, t = t0 + r; \
  const size_t row = (size_t)b * T + t; \
  const float* gatep = WSP(float, OFF_GATE) + row * 24 + g * 12; (void)gatep; (void)grp; (void)t;
  {
    NSA_SECTION_VARS
#pragma unroll
    for (int ct = 0; ct < 4; ++ct)
#pragma unroll
      for (int dk = 0; dk < 2; ++dk)
        qlds[(ct * 2 + dk) * 64 + lane] = *(const bf16x8*)(WSP(bf16_t, OFF_QN) + row * 512 + (g * 4 + ct) * 64 + dk * 32 + grp * 8);
  }
  f32x4 o[4][4];
  float m[4], lsum[4];
  f32x4 lacc[4];
  {
    NSA_SECTION_VARS
    const bf16_t* kc = WSP(bf16_t, OFF_KCMP) + (size_t)((b * 2 + g) * 512) * 64;
    const bf16_t* vct = WSP(bf16_t, OFF_VCT) + (size_t)((b * 2 + g) * 64) * 512;
    const int nblk = (tq + 31) >> 5;
#pragma unroll
    for (int ct = 0; ct < 4; ++ct) { m[ct] = NEG_INF; lsum[ct] = 0.f; }
#pragma unroll 1
    for (int blk = 0; blk < nblk; ++blk) {
      f32x4 s[2][4];
      qk_scores<4, 2, true>(kc, 64, blk * 32, qf, s, lane, qlds);
#pragma unroll
      for (int kt = 0; kt < 2; ++kt)
#pragma unroll
        for (int i = 0; i < 4; ++i) {
          const int n = blk * 32 + 8 * grp + 4 * kt + i;
          const bool ok = (16 * n + 31 <= t);
#pragma unroll
          for (int ct = 0; ct < 4; ++ct) s[kt][ct][i] = ok ? s[kt][ct][i] : NEG_INF;
        }
      softmax_update<4, 4, false>(s, m, lsum, o);
    }
    float invl[4], msafe[4];
#pragma unroll
    for (int ct = 0; ct < 4; ++ct) { invl[ct] = finish_l(lsum[ct]); msafe[ct] = (m[ct] == NEG_INF) ? 0.f : m[ct]; }
    for (int e = lane; e < 16 * 132; e += 64) imp[e] = 0.f;
    __builtin_amdgcn_fence(__ATOMIC_SEQ_CST, "workgroup");
    __builtin_amdgcn_wave_barrier();
#pragma unroll
    for (int dt = 0; dt < 4; ++dt)
#pragma unroll
      for (int ct = 0; ct < 4; ++ct) o[dt][ct] = (f32x4){0.f, 0.f, 0.f, 0.f};
#pragma unroll 1
    for (int blk = 0; blk < nblk; ++blk) {
      f32x4 s[2][4];
      qk_scores<4, 2, true>(kc, 64, blk * 32, qf, s, lane, qlds);
      float pq[2][4];
#pragma unroll
      for (int kt = 0; kt < 2; ++kt)
#pragma unroll
        for (int i = 0; i < 4; ++i) {
          const int n = blk * 32 + 8 * grp + 4 * kt + i;
          const bool ok = (16 * n + 31 <= t);
          float acc_p = 0.f;
#pragma unroll
          for (int ct = 0; ct < 4; ++ct) {
            const float pv = ok ? __builtin_amdgcn_exp2f(s[kt][ct][i] - msafe[ct]) * invl[ct] : 0.f;
            s[kt][ct][i] = pv;
            acc_p += pv;
          }
          pq[kt][i] = acc_p;
        }
      float* ir = imp + r * 132 + blk * 8 + 2 * grp;
      ir[0] += pq[0][0] + pq[0][1] + pq[0][2] + 0.5f * pq[0][3];
      __builtin_amdgcn_fence(__ATOMIC_SEQ_CST, "workgroup");
      __builtin_amdgcn_wave_barrier();
      ir[1] += pq[1][0] + pq[1][1] + pq[1][2] + 0.5f * pq[1][3] + 0.5f * pq[0][3];
      __builtin_amdgcn_fence(__ATOMIC_SEQ_CST, "workgroup");
      __builtin_amdgcn_wave_barrier();
      ir[2] += 0.5f * pq[1][3];
      __builtin_amdgcn_fence(__ATOMIC_SEQ_CST, "workgroup");
      __builtin_amdgcn_wave_barrier();
      pv_accum<4, 4>(vct, 512, blk * 32, s, o, lane);
    }
    f32x4 gt[4];
#pragma unroll
    for (int ct = 0; ct < 4; ++ct) gt[ct][0] = gatep[ct * 3 + 0];
#pragma unroll
    for (int dt = 0; dt < 4; ++dt) {
#pragma unroll
      for (int ct = 0; ct < 4; ++ct)
#pragma unroll
        for (int i = 0; i < 4; ++i) scr[((dt * 4 + ct) * 4 + i) * 64 + lane] = o[dt][ct][i] * gt[ct][0];
      asm volatile("" ::: "memory");
    }
  }
  const int cur = t0 >> 6;
  unsigned long long sel_lo = 0ull, sel_hi = 0ull;
  {
  NSA_SECTION_VARS
  if (cur <= 15) {
    sel_lo = (1ull << (cur + 1)) - 1ull;
  } else {
    __builtin_amdgcn_fence(__ATOMIC_SEQ_CST, "workgroup");
    __builtin_amdgcn_wave_barrier();
    float v[32];
#pragma unroll
    for (int k = 0; k < 32; ++k) {
      const int j = grp + 4 * k;
      const float x = imp[r * 132 + j];
      v[k] = (j >= 1 && j <= cur - 2) ? x : NEG_INF;
    }
#pragma unroll 1
    for (int round = 0; round < 13; ++round) {
      float best = NEG_INF;
      int bj = 1 << 20;
#pragma unroll
      for (int k = 0; k < 32; ++k) {
        const bool tk = v[k] > best;
        best = tk ? v[k] : best;
        bj = tk ? (grp + 4 * k) : bj;
      }
#pragma unroll
      for (int off = 16; off <= 32; off <<= 1) {
        const float ob = __shfl_xor(best, off);
        const int oj = __shfl_xor(bj, off);
        const bool tk = (ob > best) || (ob == best && oj < bj);
        best = tk ? ob : best;
        bj = tk ? oj : bj;
      }
      if (bj < 64) sel_lo |= 1ull << bj; else if (bj < 128) sel_hi |= 1ull << (bj - 64);
#pragma unroll
      for (int k = 0; k < 32; ++k) v[k] = (bj == grp + 4 * k) ? NEG_INF : v[k];
    }
    sel_lo |= 1ull;
    if (cur < 64) sel_lo |= 1ull << cur; else sel_hi |= 1ull << (cur - 64);
    if (cur - 1 < 64) sel_lo |= 1ull << (cur - 1); else sel_hi |= 1ull << (cur - 1 - 64);
  }
  }
  asm volatile("" : "+v"(sel_lo), "+v"(sel_hi));
  atomicOr(&misc[4], (unsigned)sel_lo); atomicOr(&misc[5], (unsigned)(sel_lo >> 32));
  atomicOr(&misc[6], (unsigned)sel_hi); atomicOr(&misc[7], (unsigned)(sel_hi >> 32));
  __syncthreads();
  unsigned long long ulo, uhi;
  {
    const unsigned u0 = __builtin_amdgcn_readfirstlane(misc[4]), u1 = __builtin_amdgcn_readfirstlane(misc[5]);
    const unsigned u2 = __builtin_amdgcn_readfirstlane(misc[6]), u3 = __builtin_amdgcn_readfirstlane(misc[7]);
    ulo = ((unsigned long long)u1 << 32) | u0; uhi = ((unsigned long long)u3 << 32) | u2;
  }
  {
    NSA_SECTION_VARS
    const int tid = (wave << 6) | lane;
    const int hq = r >> 2, qq = r & 3;
    const bf16_t* ks = WSP(bf16_t, OFF_KS) + ((size_t)b * T) * 128 + g * 64;
    const bf16_t* vst = WSP(bf16_t, OFF_VST) + (size_t)((b * 2 + g) * 64) * T;
    bf16x8 qr[4][2];
    unsigned long long mlo[4], mhi[4];
#pragma unroll
    for (int ct = 0; ct < 4; ++ct) {
      const size_t rowq = (size_t)b * T + t0 + 4 * ct + qq;
#pragma unroll
      for (int dk = 0; dk < 2; ++dk)
        qr[ct][dk] = *(const bf16x8*)(WSP(bf16_t, OFF_QN) + rowq * 512 + (g * 4 + hq) * 64 + dk * 32 + grp * 8);
      const int srcl = (lane & 48) | (4 * ct + qq);
      mlo[ct] = __shfl(sel_lo, srcl);
      mhi[ct] = __shfl(sel_hi, srcl);
      m[ct] = NEG_INF; lacc[ct] = (f32x4){0.f, 0.f, 0.f, 0.f};
    }
#pragma unroll
    for (int dt = 0; dt < 4; ++dt)
#pragma unroll
      for (int ct = 0; ct < 4; ++ct) o[dt][ct] = (f32x4){0.f, 0.f, 0.f, 0.f};
    const short one_ = (short)0x3F80;
    const bf16x8 ones = {one_, one_, one_, one_, one_, one_, one_, one_};
    TileRegs tr, trb;
    int jA = next_bit(ulo, uhi, 0), it = 0;
    int jB = next_bit(ulo, uhi, jA + 1);
    tile_gload(tr, ks, 128, vst, T, 64 * jA, tid);
    if (jB < 128) tile_gload(trb, ks, 128, vst, T, 64 * jB, tid);
    tile_swrite(tr, tiles, tid);
    if (jB < 128) tile_swrite(trb, tiles + TILE_STAGE, tid);
    __syncthreads();
#pragma unroll 1
    while (jA < 128) {
      const int nA = (jB < 128) ? next_bit(ulo, uhi, jB + 1) : 128;
      const int nB = (nA < 128) ? next_bit(ulo, uhi, nA + 1) : 128;
      if (nA < 128) tile_gload(tr, ks, 128, vst, T, 64 * nA, tid);
      if (nB < 128) tile_gload(trb, ks, 128, vst, T, 64 * nB, tid);
#pragma unroll 1
      for (int sub = 0; sub < 2; ++sub) {
      const int j = sub ? jB : jA;
      if (j >= 128) break;
      const lds_u8* stage = tiles + (2 * (it & 1) + sub) * TILE_STAGE;
      bool mine[4], need[4], anyneed = false;
#pragma unroll
      for (int ct = 0; ct < 4; ++ct) {
        mine[ct] = ((j < 64 ? (mlo[ct] >> j) : (mhi[ct] >> (j - 64))) & 1ull) != 0ull;
        need[ct] = __any(mine[ct]) != 0;
        anyneed = anyneed || need[ct];
      }
      if (anyneed) {
#pragma unroll
        for (int hf = 0; hf < 2; ++hf) {
          const int key0 = j * 64 + hf * 32;
          bf16x8 kf[2][2];
#pragma unroll
          for (int kt = 0; kt < 2; ++kt) {
            const lds_u8* kp = stage + (32 * hf + 8 * (r >> 2) + 4 * kt + (r & 3)) * TILE_ROWB + grp * 16;
#pragma unroll
            for (int dk = 0; dk < 2; ++dk) kf[kt][dk] = *(const __attribute__((address_space(3))) bf16x8*)(kp + dk * 64);
          }
          bf16x8 vfr[4];
          v_frags_lds<4>(stage, hf, vfr, lane);
#pragma unroll
          for (int ct = 0; ct < 4; ++ct) {
            if (need[ct]) {
              const float mv = mine[ct] ? 0.f : NEG_INF;
              f32x4 s0 = {mv, mv, mv, mv}, s1 = {mv, mv, mv, mv};
              s0 = mfma16(kf[0][0], qr[ct][0], s0);
              s1 = mfma16(kf[1][0], qr[ct][0], s1);
              s0 = mfma16(kf[0][1], qr[ct][1], s0);
              s1 = mfma16(kf[1][1], qr[ct][1], s1);
              if (j == cur) {
                const int tct = t0 + 4 * ct + qq;
#pragma unroll
                for (int i = 0; i < 4; ++i) {
                  s0[i] = (key0 + 8 * grp + i <= tct) ? s0[i] : NEG_INF;
                  s1[i] = (key0 + 8 * grp + 4 + i <= tct) ? s1[i] : NEG_INF;
                }
              }
              float mx = fmaxf(fmaxf(fmaxf(s0[0], s0[1]), fmaxf(s0[2], s0[3])), fmaxf(fmaxf(s1[0], s1[1]), fmaxf(s1[2], s1[3])));
              mx = grp_max4(mx);
              const float mnew = fmaxf(m[ct], mx);
              if (__any(mnew > m[ct])) {
                const float ms = (mnew == NEG_INF) ? 0.f : mnew;
                const float alpha = __builtin_amdgcn_exp2f(m[ct] - ms);
                m[ct] = mnew;
                lacc[ct] = lacc[ct] * alpha;
#pragma unroll
                for (int dt = 0; dt < 4; ++dt) o[dt][ct] = o[dt][ct] * alpha;
              }
              const float msafe = (m[ct] == NEG_INF) ? 0.f : m[ct];
              const f32x4 d0 = s0 - msafe, d1 = s1 - msafe;
              f32x4 p0, p1;
#pragma unroll
              for (int i = 0; i < 4; ++i) { p0[i] = __builtin_amdgcn_exp2f(d0[i]); p1[i] = __builtin_amdgcn_exp2f(d1[i]); }
              const bf16x8 pb = pack8(p0, p1);
              lacc[ct] = mfma16(ones, pb, lacc[ct]);
#pragma unroll
              for (int dt = 0; dt < 4; ++dt) o[dt][ct] = mfma16(vfr[dt], pb, o[dt][ct]);
            }
          }
        }
      }
      }
      if (nA < 128) tile_swrite(tr, tiles + (2 * ((it + 1) & 1)) * TILE_STAGE, tid);
      if (nB < 128) tile_swrite(trb, tiles + (2 * ((it + 1) & 1) + 1) * TILE_STAGE, tid);
      __syncthreads();
      jA = nA; jB = nB; ++it;
    }
    float* scr2 = scr + (size_t)2048 * 4096;
#pragma unroll
    for (int ct = 0; ct < 4; ++ct) {
      const size_t rowq = (size_t)b * T + t0 + 4 * ct + qq;
      const float sc = (lacc[ct][0] > 0.f ? 1.0f / lacc[ct][0] : 0.f) * WSP(float, OFF_GATE)[rowq * 24 + (g * 4 + hq) * 3 + 1];
#pragma unroll
      for (int dt = 0; dt < 4; ++dt)
        *(f32x4*)(scr2 + (hq * 16 + 4 * ct + qq) * 64 + 16 * dt + 4 * grp) = o[dt][ct] * sc;
    }
    asm volatile("s_waitcnt vmcnt(0)" ::: "memory");
    __builtin_amdgcn_fence(__ATOMIC_SEQ_CST, "workgroup");
  }
  {
    NSA_SECTION_VARS
    const int tid = (wave << 6) | lane;
    const bf16_t* kw = WSP(bf16_t, OFF_KW) + ((size_t)b * T) * 128 + g * 64;
    const bf16_t* vwt = WSP(bf16_t, OFF_VWT) + (size_t)((b * 2 + g) * 64) * T;
#pragma unroll
    for (int ct = 0; ct < 4; ++ct) { m[ct] = NEG_INF; lsum[ct] = 0.f; lacc[ct] = (f32x4){0.f, 0.f, 0.f, 0.f}; }
#pragma unroll
    for (int dt = 0; dt < 4; ++dt)
#pragma unroll
      for (int ct = 0; ct < 4; ++ct) o[dt][ct] = (f32x4){0.f, 0.f, 0.f, 0.f};
    int kstart = qi * 128 - 512;
    if (kstart < 0) kstart = 0;
    const int kend = qi * 128 + 64;
    bf16x8 qr[4][2];
#pragma unroll
    for (int ct = 0; ct < 4; ++ct)
#pragma unroll
      for (int dk = 0; dk < 2; ++dk)
        qr[ct][dk] = *(const bf16x8*)(WSP(bf16_t, OFF_QN) + row * 512 + (g * 4 + ct) * 64 + dk * 32 + grp * 8);
    TileRegs tr;
    int it = 0;
    tile_gload(tr, kw, 128, vwt, T, kstart, tid);
    tile_swrite(tr, tiles, tid);
    __syncthreads();
#pragma unroll 1
    for (int k0 = kstart; k0 <= kend; k0 += 64, ++it) {
      if (k0 + 64 <= kend) tile_gload(tr, kw, 128, vwt, T, k0 + 64, tid);
      const lds_u8* stage = tiles + (it & 1) * TILE_STAGE;
      if (k0 <= t0 + 15 && k0 + 63 + 512 > t0) {
#pragma unroll
        for (int hf = 0; hf < 2; ++hf) {
          const int key0 = k0 + hf * 32;
          f32x4 s[2][4];
          const f32x4 cz = {0.f, 0.f, 0.f, 0.f};
          qk_scores_lds<4, 2, false>(stage, hf, qr, s, lane, nullptr, cz, cz);
          if (!(k0 + 63 <= t0 && k0 + 512 > t0 + 15)) {
#pragma unroll
            for (int kt = 0; kt < 2; ++kt)
#pragma unroll
              for (int i = 0; i < 4; ++i) {
                const int key = key0 + 8 * grp + 4 * kt + i;
                const bool ok = (key <= t) && (key + 512 > t);
#pragma unroll
                for (int ct = 0; ct < 4; ++ct) s[kt][ct][i] = ok ? s[kt][ct][i] : NEG_INF;
              }
          }
          bf16x8 vfr[4];
          v_frags_lds<4>(stage, hf, vfr, lane);
          softmax_update<4, 4, true, false>(s, m, lsum, o, &lacc);
          pv_accum_lds<4, 4>(vfr, s, o, lane, lacc);
        }
      }
      if (k0 + 64 <= kend) tile_swrite(tr, tiles + ((it + 1) & 1) * TILE_STAGE, tid);
      __syncthreads();
    }
    float sc2[4];
#pragma unroll
    for (int ct = 0; ct < 4; ++ct) sc2[ct] = (lacc[ct][0] > 0.f ? 1.0f / lacc[ct][0] : 0.f) * gatep[ct * 3 + 2];
    bf16_t* oa = WSP(bf16_t, OFF_OA) + row * 512 + g * 256;
#pragma unroll
    for (int dt = 0; dt < 4; ++dt)
#pragma unroll
      for (int ct = 0; ct < 4; ++ct) {
        bf16_t* ptr = oa + ct * 64 + 16 * dt + 4 * grp;
        const u32x2 sw = *(const u32x2*)ptr;
        float val[4];
        const f32x4 sv = *(const f32x4*)(scr + (size_t)2048 * 4096 + (ct * 16 + r) * 64 + 16 * dt + 4 * grp);
#pragma unroll
        for (int i = 0; i < 4; ++i) val[i] = scr[((dt * 4 + ct) * 4 + i) * 64 + lane] + sv[i] + o[dt][ct][i] * sc2[ct];
        u32x2 w = {cvtpk(val[0] * bflo(sw[0]), val[1] * bfhi(sw[0])), cvtpk(val[2] * bflo(sw[1]), val[3] * bfhi(sw[1]))};
        if (st) *(u32x2*)ptr = w;
        asm volatile("" ::: "memory");
      }
  }
#undef NSA_SECTION_VARS
}

__device__ __forceinline__ void fox_wg_unit(const Params& p, int l, int b, int h, int qb, lds_u8* tiles, bool st) {
  kparams_t kp_ = kparams(); (void)kp_;
  const int tid = tidx();
  const int wave = __builtin_amdgcn_readfirstlane(tid >> 6);
  const int lane = tid & 63, r = lane & 15, grp = lane >> 4;
  const int t0 = qb * 512 + wave * 64;
  bf16x8 qf[4][2];
  const float* fc = WSP(float, OFF_FC) + (size_t)(b * 8 + h) * T;
#pragma unroll
  for (int ct = 0; ct < 4; ++ct) {
    const size_t row = (size_t)b * T + t0 + 16 * ct + r;
#pragma unroll
    for (int dk = 0; dk < 2; ++dk)
      qf[ct][dk] = *(const bf16x8*)(WSP(bf16_t, OFF_FQ) + row * 512 + h * 64 + dk * 32 + grp * 8);
  }
  const bf16_t* kb = WSP(bf16_t, OFF_FK) + ((size_t)b * T) * 512 + h * 64;
  const bf16_t* vt = WSP(bf16_t, OFF_FVT) + (size_t)((b * 8 + h) * 64) * T;
  f32x4 o[4][4];
  float m[4], lsum[4];
  f32x4 lacc[4];
#pragma unroll
  for (int ct = 0; ct < 4; ++ct) { m[ct] = NEG_INF; lsum[ct] = 0.f; lacc[ct] = (f32x4){0.f, 0.f, 0.f, 0.f}; }
#pragma unroll
  for (int dt = 0; dt < 4; ++dt)
#pragma unroll
    for (int ct = 0; ct < 4; ++ct) o[dt][ct] = (f32x4){0.f, 0.f, 0.f, 0.f};
  const int ntiles = (qb + 1) * 8;
  int it0, itw0;
  {
    float gq = fabsf(kp_->fox_q_norm[l * 64 + lane]), gk = fabsf(kp_->fox_k_norm[l * 64 + lane]);
#pragma unroll
    for (int o_ = 1; o_ < 64; o_ <<= 1) { gq = fmaxf(gq, __shfl_xor(gq, o_)); gk = fmaxf(gk, __shfl_xor(gk, o_)); }
    const float B2 = 16.0f * gq * gk * 1.02f + 104.0f;
    const float thr_wg = fc[qb * 512] + B2, thr_w = fc[t0] + B2;
    const float c0 = (lane < ntiles) ? fc[64 * lane + 63] : -3.0e38f;
    const float c1 = (lane + 64 < ntiles) ? fc[64 * (lane + 64) + 63] : -3.0e38f;
    it0 = __popcll(__ballot(c0 > thr_wg)) + __popcll(__ballot(c1 > thr_wg));
    itw0 = __popcll(__ballot(c0 > thr_w)) + __popcll(__ballot(c1 > thr_w));
    it0 = __builtin_amdgcn_readfirstlane(it0);
    itw0 = __builtin_amdgcn_readfirstlane(itw0);
  }
  TileRegs tr;
  float ckr = 0.f;
  tile_gload(tr, kb, 512, vt, T, it0 * 64, tid);
  if (tid < 64) ckr = fc[it0 * 64 + tid] * (-LOG2E);
  tile_swrite(tr, tiles, tid);
  if (tid < 64) *(__attribute__((address_space(3))) float*)(tiles + 2 * TILE_HALF + tid * 4) = ckr;
  __syncthreads();
#pragma unroll 1
  for (int it = it0; it < ntiles; ++it) {
    const int k0 = it * 64;
    if (it + 1 < ntiles) { tile_gload(tr, kb, 512, vt, T, k0 + 64, tid); if (tid < 64) ckr = fc[k0 + 64 + tid] * (-LOG2E); }
    const lds_u8* stage = tiles + ((it - it0) & 1) * TILE_STAGE;
    if (k0 <= t0 + 63 && it >= itw0) {
      const bool diag = (k0 + 63 > t0);
#pragma unroll
      for (int hf = 0; hf < 2; ++hf) {
        const int key0 = k0 + hf * 32;
        f32x4 s[2][4];
        const f32x4 ck0 = *(const __attribute__((address_space(3))) f32x4*)(stage + 2 * TILE_HALF + (32 * hf + 8 * grp) * 4);
        const f32x4 ck1 = *(const __attribute__((address_space(3))) f32x4*)(stage + 2 * TILE_HALF + (32 * hf + 8 * grp + 4) * 4);
        qk_scores_lds<4, 2, false>(stage, hf, qf, s, lane, nullptr, ck0, ck1);
        if (diag) {
#pragma unroll
          for (int kt = 0; kt < 2; ++kt)
#pragma unroll
            for (int i = 0; i < 4; ++i) {
              const int key = key0 + 8 * grp + 4 * kt + i;
#pragma unroll
              for (int ct = 0; ct < 4; ++ct) s[kt][ct][i] = (key <= t0 + 16 * ct + r) ? s[kt][ct][i] : NEG_INF;
            }
        }
        bf16x8 vfr[4];
        v_frags_lds<4>(stage, hf, vfr, lane);
        softmax_update<4, 4, true, false>(s, m, lsum, o, &lacc);
        pv_accum_lds<4, 4>(vfr, s, o, lane, lacc);
      }
    }
    if (it + 1 < ntiles) {
      tile_swrite(tr, tiles + ((it - it0 + 1) & 1) * TILE_STAGE, tid);
      if (tid < 64) *(__attribute__((address_space(3))) float*)(tiles + ((it - it0 + 1) & 1) * TILE_STAGE + 2 * TILE_HALF + tid * 4) = ckr;
    }
    __syncthreads();
  }
  float invl[4];
#pragma unroll
  for (int ct = 0; ct < 4; ++ct) invl[ct] = lacc[ct][0] > 0.f ? 1.0f / lacc[ct][0] : 0.f;
#pragma unroll
  for (int ct = 0; ct < 4; ++ct) {
    bf16_t* ob = WSP(bf16_t, OFF_OB) + ((size_t)b * T + t0 + 16 * ct + r) * 512 + h * 64;
#pragma unroll
    for (int dt = 0; dt < 4; ++dt) {
      bf16_t* ptr = ob + 16 * dt + 4 * grp;
      const u32x2 sw = *(const u32x2*)ptr;
      const f32x4 v = o[dt][ct] * invl[ct];
      u32x2 w = {cvtpk(v[0] * bflo(sw[0]), v[1] * bfhi(sw[0])), cvtpk(v[2] * bflo(sw[1]), v[3] * bfhi(sw[1]))};
      if (st) *(u32x2*)ptr = w;
    }
  }
}

constexpr int MT_KPITCH = 272, MT_VOFF = 64 * MT_KPITCH, MT_STAGE = MT_VOFF + 128 * TILE_ROWB;
struct MemTileRegs { u32x4 k0, k1, v0, v1; };
__device__ __forceinline__ void mem_tile_gload(MemTileRegs& tr, const bf16_t* __restrict__ kb, const bf16_t* __restrict__ vt, int key0, int tid) {
  const int row = tid >> 3, ch = tid & 7;
  tr.k0 = *(const u32x4*)(kb + (size_t)(key0 + row) * 512 + ch * 8);
  tr.k1 = *(const u32x4*)(kb + (size_t)(key0 + row) * 512 + 64 + ch * 8);
  tr.v0 = *(const u32x4*)(vt + (size_t)row * 256 + key0 + ch * 8);
  tr.v1 = *(const u32x4*)(vt + (size_t)(row + 64) * 256 + key0 + ch * 8);
}
__device__ __forceinline__ void mem_tile_swrite(const MemTileRegs& tr, lds_u8* stage, int tid) {
  const int row = tid >> 3, ch = tid & 7;
  *(__attribute__((address_space(3))) u32x4*)(stage + row * MT_KPITCH + ch * 16) = tr.k0;
  *(__attribute__((address_space(3))) u32x4*)(stage + row * MT_KPITCH + 128 + ch * 16) = tr.k1;
  *(__attribute__((address_space(3))) u32x4*)(stage + MT_VOFF + row * TILE_ROWB + ch * 16) = tr.v0;
  *(__attribute__((address_space(3))) u32x4*)(stage + MT_VOFF + (row + 64) * TILE_ROWB + ch * 16) = tr.v1;
}
__device__ __forceinline__ void mem_wg_unit(const Params& p, int l, int b, int h, int qblk, lds_u8* tiles, bool st) {
  kparams_t kp_ = kparams(); (void)kp_;
  const int tid = tidx();
  const int wave = __builtin_amdgcn_readfirstlane(tid >> 6);
  const int lane = tid & 63, r = lane & 15, grp = lane >> 4;
  const int t0 = 256 * qblk + 32 * wave;
  const float SC = 0.08838834764831845f * LOG2E;
  const bf16_t* kb = WSP(bf16_t, OFF_MK) + ((size_t)b * 256) * 512 + h * 128;
  const bf16_t* vt = WSP(bf16_t, OFF_MVT) + (size_t)((b * 4 + h) * 128) * 256;
  MemTileRegs tr;
  mem_tile_gload(tr, kb, vt, 0, tid);
  bf16x8 qf[2][4];
  const float* gq = kp_->mem_q_norm + l * 128;
#pragma unroll
  for (int ct = 0; ct < 2; ++ct) {
    const size_t row = (size_t)b * T + t0 + 16 * ct + r;
    float v[4][8];
    float ss = 0.f;
#pragma unroll
    for (int dk = 0; dk < 4; ++dk) {
      const u32x4 w = *(const u32x4*)(WSP(bf16_t, OFF_MQ) + row * 512 + h * 128 + dk * 32 + grp * 8);
#pragma unroll
      for (int j = 0; j < 4; ++j) { v[dk][2 * j] = bflo(w[j]); v[dk][2 * j + 1] = bfhi(w[j]); }
#pragma unroll
      for (int j = 0; j < 8; ++j) ss += v[dk][j] * v[dk][j];
    }
    ss += __shfl_xor(ss, 16);
    ss += __shfl_xor(ss, 32);
    const float rstd = rsqrtf(ss * (1.0f / 128.0f) + EPS) * SC;
#pragma unroll
    for (int dk = 0; dk < 4; ++dk) {
      const f32x4 g0 = *(const f32x4*)(gq + dk * 32 + grp * 8), g1 = *(const f32x4*)(gq + dk * 32 + grp * 8 + 4);
      u32x4 w = {cvtpk(v[dk][0] * rstd * g0[0], v[dk][1] * rstd * g0[1]), cvtpk(v[dk][2] * rstd * g0[2], v[dk][3] * rstd * g0[3]),
                 cvtpk(v[dk][4] * rstd * g1[0], v[dk][5] * rstd * g1[1]), cvtpk(v[dk][6] * rstd * g1[2], v[dk][7] * rstd * g1[3])};
      qf[ct][dk] = __builtin_bit_cast(bf16x8, w);
    }
  }
  f32x4 o[8][2];
  f32x4 lacc[2];
  float m[2], lsum[2];
#pragma unroll
  for (int ct = 0; ct < 2; ++ct) { m[ct] = NEG_INF; lsum[ct] = 0.f; lacc[ct] = (f32x4){0.f, 0.f, 0.f, 0.f}; }
#pragma unroll
  for (int dt = 0; dt < 8; ++dt)
#pragma unroll
    for (int ct = 0; ct < 2; ++ct) o[dt][ct] = (f32x4){0.f, 0.f, 0.f, 0.f};
  mem_tile_swrite(tr, tiles, tid);
  __syncthreads();
#pragma unroll 1
  for (int it = 0; it < 4; ++it) {
    if (it + 1 < 4) mem_tile_gload(tr, kb, vt, 64 * (it + 1), tid);
    const lds_u8* stage = tiles + (it & 1) * MT_STAGE;
#pragma unroll
    for (int hf = 0; hf < 2; ++hf) {
      f32x4 s[2][2];
#pragma unroll
      for (int kt = 0; kt < 2; ++kt) {
        const lds_u8* kp = stage + (32 * hf + 8 * (r >> 2) + 4 * kt + (r & 3)) * MT_KPITCH + grp * 16;
        bf16x8 kf[4];
#pragma unroll
        for (int dk = 0; dk < 4; ++dk) kf[dk] = *(const __attribute__((address_space(3))) bf16x8*)(kp + dk * 64);
#pragma unroll
        for (int ct = 0; ct < 2; ++ct) {
          f32x4 a = {0.f, 0.f, 0.f, 0.f};
#pragma unroll
          for (int dk = 0; dk < 4; ++dk) a = mfma16(kf[dk], qf[ct][dk], a);
          s[kt][ct] = a;
        }
      }
      bf16x8 vfr[8];
      v_frags_lds<8>(stage + (MT_VOFF - TILE_HALF), hf, vfr, lane);
      softmax_update<2, 8, true, false>(s, m, lsum, o, &lacc);
      pv_accum_lds<2, 8>(vfr, s, o, lane, lacc);
    }
    if (it + 1 < 4) mem_tile_swrite(tr, tiles + ((it + 1) & 1) * MT_STAGE, tid);
    __syncthreads();
  }
#pragma unroll
  for (int ct = 0; ct < 2; ++ct) {
    const float invl = lacc[ct][0] > 0.f ? 1.0f / lacc[ct][0] : 0.f;
    bf16_t* om = WSP(bf16_t, OFF_OM) + ((size_t)b * T + t0 + 16 * ct + r) * 512 + h * 128;
#pragma unroll
    for (int dt = 0; dt < 8; ++dt) {
      bf16_t* ptr = om + 16 * dt + 4 * grp;
      const u32x2 sw = *(const u32x2*)ptr;
      const f32x4 v = o[dt][ct] * invl;
      u32x2 w = {cvtpk(v[0] * bflo(sw[0]), v[1] * bfhi(sw[0])), cvtpk(v[2] * bflo(sw[1]), v[3] * bfhi(sw[1]))};
      if (st) *(u32x2*)ptr = w;
    }
  }
}

__device__ __forceinline__ void phase_attn(const Params& p, int l, unsigned char* ldsraw, bool st, int cidx) {
  kparams_t kp_ = kparams(); (void)kp_;
  const int tid = tidx();
  const int wave = __builtin_amdgcn_readfirstlane(tid >> 6);
  float* imp = (float*)ldsraw + wave * 2112;
  lds_u8* tiles = (lds_u8*)ldsraw;
  bf16x8* qlds = (bf16x8*)(ldsraw + 69632 + wave * 8192);
  unsigned* misc = (unsigned*)(ldsraw + 135168);
  float* scr = WSP(float, OFF_SCR) + (size_t)(bidx() * NWAVES + wave) * 4096;
  const int myx = (int)(xb_xcc_id() & 7u);
  constexpr int QUNITS = 192;
  for (int qq = 0; qq < 8; ++qq) {
    const int x = (myx + qq) & 7;
    unsigned* ctr = WSP(unsigned, OFF_CTL) + cidx * 8 + x;
    for (;;) {
      __syncthreads();
      if (tid == 0) misc[0] = atomicAdd(ctr, 1u);
      if (tid >= 4 && tid < 8) misc[tid] = 0u;
      __syncthreads();
      const int u = __builtin_amdgcn_readfirstlane((int)misc[0]);
      if (u >= QUNITS) break;
      if (u < 64) {
        nsa_wg_unit(p, x >> 1, x & 1, 63 - u, imp, qlds, scr, tiles, misc, st);
      } else if (u < 128) {
        const int v_ = u - 64, bh = 4 * x + (v_ >> 4);
        fox_wg_unit(p, l, bh >> 3, bh & 7, 15 - (v_ & 15), tiles, st);
      } else {
        const int mu = u - 128, bh = 2 * x + (mu >> 5), qblk = mu & 31;
        mem_wg_unit(p, l, bh >> 2, bh & 3, qblk, tiles, st);
      }
    }
  }
}

__global__ void __launch_bounds__(NTHREADS) hybrid_megakernel(Params p) {
  kparams_t kp_ = kparams();
  cg::grid_group grid = cg::this_grid();
  extern __shared__ __attribute__((aligned(16))) unsigned char dynlds[];
  float* smem = (float*)dynlds;
  PG8_LAS unsigned char* glds = (PG8_LAS unsigned char*)dynlds;
  volatile LAS unsigned* bst = (volatile LAS unsigned*)(glds + 135168 + 64);
  if (threadIdx.x < 2) bst[threadIdx.x] = 0u;
  __syncthreads();
  grid.sync();
  const XcdBarrier xbar = xcd_barrier_post(WSP(unsigned, OFF_BAR), bst);
#pragma unroll 1
  for (int ph = 0; ph < 28; ++ph) {
    const int l = ph / 7, k = ph - 7 * l;
    if (k == 0) {
      phase_prep(p, l, smem);
    } else if (k == 1) {
      if (bidx() == gdim() - 1 && tidx() < 256) {
        const int t_ = tidx();
        const float* part = WSP(float, OFF_C1) + (size_t)(t_ >> 7) * 16 * 128 + (t_ & 127);
        float pv_[16];
#pragma unroll
        for (int ch = 0; ch < 16; ++ch) pv_[ch] = part[ch * 128];
        float s_ = 0.f;
#pragma unroll
        for (int ch = 0; ch < 16; ++ch) s_ += pv_[ch];
        WSP(float, OFF_C1 + 16384)[t_] = s_;
      }
      EpiIn E{&p, l};
      run_gemm(glds, WSP(bf16_t, OFF_H), WSP(bf16_t, OFF_W_IN), M, 5120, 1024, E);
      EpiMemKV E2{&p};
      run_gemm(glds, WSP(bf16_t, OFF_MEMN), WSP(bf16_t, OFF_W_MKV), 1024, 1024, 1024, E2);
    } else if (k == 2) {
      phase_mid(p, l, smem);
    } else if (k == 3) {
      phase_attn(p, l, dynlds, true, l);
    } else if (k == 4) {
      EpiGate E{WSP(bf16_t, OFF_G)};
      run_gemm(glds, WSP(bf16_t, OFF_H), WSP(bf16_t, OFF_W_G), M, 3072, 1024, E);
    } else if (k == 5) {
      EpiBranch Ea{WSP(bf16_t, OFF_G), WSP(bf16_t, OFF_U), 1};
      run_gemm(glds, WSP(bf16_t, OFF_OA), WSP(bf16_t, OFF_W_BR), M, 1024, 512, Ea);
      EpiBranch Eb{WSP(bf16_t, OFF_G) + (size_t)M * 1024, WSP(bf16_t, OFF_U), 0};
      run_gemm(glds, WSP(bf16_t, OFF_OB), WSP(bf16_t, OFF_W_BR + MiB), M, 1024, 512, Eb);
      EpiBranch Ec{WSP(bf16_t, OFF_G) + (size_t)2 * M * 1024, WSP(bf16_t, OFF_U), 0};
      run_gemm(glds, WSP(bf16_t, OFF_OM), WSP(bf16_t, OFF_W_BR + 2 * MiB), M, 1024, 512, Ec);
    } else {
      EpiOut E{l == 0 ? kp_->x : kp_->out, kp_->out};
      run_gemm(glds, WSP(bf16_t, OFF_U), WSP(bf16_t, OFF_W_OUT), M, 1024, 1024, E);
    }
    xcd_barrier(xbar);
  }
}

extern "C" void kernel_launch(void* const* d_in, const int* in_sizes, int n_in, void* d_out, int out_size, void* d_ws,
                              size_t ws_size, hipStream_t stream) {
  static int grid_blocks = 0;
  if (!grid_blocks) {
    int dev = 0, cus = 0, per_cu = 0;
    (void)hipGetDevice(&dev);
    (void)hipDeviceGetAttribute(&cus, hipDeviceAttributeMultiprocessorCount, dev);
    if (hipFuncSetAttribute((const void*)hybrid_megakernel, hipFuncAttributeMaxDynamicSharedMemorySize, LDS_BYTES) != hipSuccess)
      fprintf(stderr, "hipFuncSetAttribute(dynamic LDS %d) failed\n", LDS_BYTES);
    (void)hipOccupancyMaxActiveBlocksPerMultiprocessor(&per_cu, hybrid_megakernel, NTHREADS, LDS_BYTES);
    (void)hipGetLastError();
    grid_blocks = cus;
    if (grid_blocks > 256) grid_blocks = 256;
    if (ws_size < OFF_SCR + (size_t)64 * MiB) fprintf(stderr, "workspace too small: %zu\n", ws_size);
  }
  Params p{};
  const float** pp = (const float**)&p;
  for (int i = 0; i < 23; ++i) pp[i] = (const float*)d_in[i];
  p.out = (float*)d_out;
  p.ws = (char*)d_ws;
  void* args[] = {&p};
  (void)hipMemsetAsync((char*)d_ws + OFF_BAR, 0, XCD_BAR_WORDS * sizeof(unsigned), stream);
  hipError_t e = hipLaunchCooperativeKernel((void*)hybrid_megakernel, dim3(grid_blocks), dim3(NTHREADS), args, LDS_BYTES, stream);
  if (e != hipSuccess) fprintf(stderr, "cooperative launch failed: %s (grid %d)\n", hipGetErrorString(e), grid_blocks);
}
```

```cpp
#include <hip/hip_runtime.h>
#include <hip/hip_cooperative_groups.h>
#include <stdint.h>
#include <cstdio>
namespace cg = cooperative_groups;
typedef unsigned short bf16_t;
typedef short bf16x8 __attribute__((ext_vector_type(8)));
typedef float f32x4 __attribute__((ext_vector_type(4)));
typedef unsigned u32x2 __attribute__((ext_vector_type(2)));
typedef unsigned u32x4 __attribute__((ext_vector_type(4)));
typedef float f32x2_t __attribute__((ext_vector_type(2)));
typedef __bf16 bf16x2_t __attribute__((ext_vector_type(2)));

constexpr int NB = 4, T = 8192, M = NB * T;
constexpr int NTHREADS = 512, NWAVES = NTHREADS / 64;
constexpr int LDS_BYTES = 147456;
constexpr float EPS = 1e-6f;
constexpr float LOG2E = 1.4426950408889634f;
#define NEG_INF (-__builtin_inff())

constexpr size_t MiB = 1u << 20;
constexpr size_t OFF_CTL = 0;
constexpr size_t OFF_BAR = 64 * 1024;
constexpr size_t OFF_ROPE = 1 * MiB;
constexpr size_t OFF_W_IN = 3 * MiB;
constexpr size_t OFF_W_G = 13 * MiB;
constexpr size_t OFF_W_MKV = 19 * MiB;
constexpr size_t OFF_W_BR = 21 * MiB;
constexpr size_t OFF_W_OUT = 24 * MiB;
constexpr size_t OFF_W1 = 26 * MiB;
constexpr size_t OFF_W2 = 27 * MiB;
constexpr size_t OFF_C1 = 27 * MiB + 256 * 1024;
constexpr size_t OFF_MEMN = 28 * MiB;
constexpr size_t OFF_MK = 30 * MiB;
constexpr size_t OFF_MVT = 31 * MiB;
constexpr size_t OFF_H = 32 * MiB;
constexpr size_t OFF_U = OFF_H;
constexpr size_t OFF_OA = 96 * MiB;
constexpr size_t OFF_OB = 128 * MiB;
constexpr size_t OFF_OM = 160 * MiB;
constexpr size_t OFF_QN = 192 * MiB;
constexpr size_t OFF_G = 192 * MiB;
constexpr size_t OFF_KC = 224 * MiB;
constexpr size_t OFF_VC = 232 * MiB;
constexpr size_t OFF_KS = 240 * MiB;
constexpr size_t OFF_VST = 248 * MiB;
constexpr size_t OFF_KW = 256 * MiB;
constexpr size_t OFF_VWT = 264 * MiB;
constexpr size_t OFF_FQ = 272 * MiB;
constexpr size_t OFF_FK = 304 * MiB;
constexpr size_t OFF_FVT = 336 * MiB;
constexpr size_t OFF_MQ = 368 * MiB;
constexpr size_t OFF_GATE = 400 * MiB;
constexpr size_t OFF_FLOG = 403 * MiB;
constexpr size_t OFF_FC = 404 * MiB;
constexpr size_t OFF_KCMP = 405 * MiB;
constexpr size_t OFF_VCT = 405 * MiB + 512 * 1024;
constexpr size_t OFF_SCR = 406 * MiB;

struct Params {
  const float *x, *mem, *norm_g, *mem_norm_g, *w_in, *nsa_q_norm, *nsa_k_norm, *cmp_pe_k, *cmp_w1_k, *cmp_w2_k,
      *cmp_pe_v, *cmp_w1_v, *cmp_w2_v, *fox_q_norm, *fox_k_norm, *fox_f_bias, *mem_q_norm, *mem_k_norm, *w_mem_kv,
      *w_branch_a, *w_branch_b, *w_branch_m, *w_out;
  float* out;
  char* ws;
};
__device__ __forceinline__ char* ws_base(char* w) {
  unsigned lo = __builtin_amdgcn_readfirstlane((unsigned)(uintptr_t)w), hi = __builtin_amdgcn_readfirstlane((unsigned)((uintptr_t)w >> 32));
  asm volatile("" : "+s"(lo), "+s"(hi));
  return (char*)(__attribute__((address_space(1))) char*)(((uintptr_t)hi << 32) | (uintptr_t)lo);
}
typedef const __attribute__((address_space(4))) Params* kparams_t;
__device__ __forceinline__ kparams_t kparams() { kparams_t kp = (kparams_t)__builtin_amdgcn_kernarg_segment_ptr(); asm volatile("" : "+s"(kp)); return kp; }
#define WSP(TYPE, off) ((TYPE*)(ws_base(kp_->ws) + (off)))

__constant__ float c_inv_freq[32] = {
    1.000000000e+00f, 7.498942018e-01f, 5.623413324e-01f, 4.216965139e-01f, 3.162277639e-01f, 2.371373773e-01f,
    1.778279394e-01f, 1.333521456e-01f, 1.000000015e-01f, 7.498942316e-02f, 5.623413250e-02f, 4.216964915e-02f,
    3.162277490e-02f, 2.371373773e-02f, 1.778279431e-02f, 1.333521400e-02f, 9.999999776e-03f, 7.498942316e-03f,
    5.623413250e-03f, 4.216964822e-03f, 3.162277630e-03f, 2.371373819e-03f, 1.778279431e-03f, 1.333521446e-03f,
    1.000000047e-03f, 7.498941850e-04f, 5.623413017e-04f, 4.216965172e-04f, 3.162277571e-04f, 2.371373703e-04f,
    1.778279402e-04f, 1.333521504e-04f};

__device__ __forceinline__ int bidx() { int b = blockIdx.x; asm volatile("" : "+s"(b)); return b; }
__device__ __forceinline__ int gdim() { int g = gridDim.x; asm volatile("" : "+s"(g)); return g; }
__device__ __forceinline__ int tidx() { int t = threadIdx.x; asm volatile("" : "+v"(t)); return t; }
__device__ __forceinline__ unsigned cvtpk(float lo, float hi) {
  f32x2_t v = {lo, hi};
  bf16x2_t b = __builtin_convertvector(v, bf16x2_t);
  return __builtin_bit_cast(unsigned, b);
}
__device__ __forceinline__ float bf2f(unsigned short v) { return __uint_as_float(((unsigned)v) << 16); }
__device__ __forceinline__ float bflo(unsigned w) { return __uint_as_float(w << 16); }
__device__ __forceinline__ float bfhi(unsigned w) { return __uint_as_float(w & 0xffff0000u); }
__device__ __forceinline__ f32x4 mfma16(bf16x8 a, bf16x8 b, f32x4 c) {
  return __builtin_amdgcn_mfma_f32_16x16x32_bf16(a, b, c, 0, 0, 0);
}
__device__ __forceinline__ bf16x8 pack8(f32x4 a, f32x4 b) {
  u32x4 w = {cvtpk(a[0], a[1]), cvtpk(a[2], a[3]), cvtpk(b[0], b[1]), cvtpk(b[2], b[3])};
  return __builtin_bit_cast(bf16x8, w);
}
__device__ __forceinline__ float sigmoidf_(float v) { return __builtin_amdgcn_rcpf(1.0f + __builtin_amdgcn_exp2f(-LOG2E * v)); }
__device__ __forceinline__ float siluf_(float v) { return v * __builtin_amdgcn_rcpf(1.0f + __builtin_amdgcn_exp2f(-LOG2E * v)); }
__device__ __forceinline__ float grp_max4(float v) {
  auto a = __builtin_amdgcn_permlane32_swap(__float_as_uint(v), __float_as_uint(v), false, false);
  v = fmaxf(__uint_as_float(a[0]), __uint_as_float(a[1]));
  auto b = __builtin_amdgcn_permlane16_swap(__float_as_uint(v), __float_as_uint(v), false, false);
  return fmaxf(__uint_as_float(b[0]), __uint_as_float(b[1]));
}
__device__ __forceinline__ float wave_sum(float v) {
#pragma unroll
  for (int o = 1; o < 64; o <<= 1) v += __shfl_xor(v, o);
  return v;
}

#define LAS __attribute__((address_space(3)))
#define XB_TMO      128
#define XB_XCNT(j)  (256  + 64 * (j))
#define XB_XSUB(j)  (1280 + 64 * (j))
#define XB_XGEN(j)  (2304 + 64 * (j))
#define XB_TOP      3328
#define XB_TOPGEN   3392
#define XCD_BAR_WORDS 3456
#define XB_SPIN_CAP (1u << 18)

__device__ __forceinline__ unsigned xb_ld(unsigned* p)              { return __hip_atomic_load(p, __ATOMIC_RELAXED, __HIP_MEMORY_SCOPE_AGENT); }
__device__ __forceinline__ unsigned xb_add(unsigned* p, unsigned v) { return __hip_atomic_fetch_add(p, v, __ATOMIC_RELAXED, __HIP_MEMORY_SCOPE_AGENT); }
__device__ __forceinline__ unsigned xb_xcc_id() { return (unsigned)__builtin_amdgcn_s_getreg((3 << 11) | 20) & 0xFu; }
#define XB_SPIN(cond, bar) do { unsigned _sp = 0; while (cond) { __builtin_amdgcn_s_sleep(1); \
    if ((++_sp & 255u) == 0u) { if (xb_ld(&(bar)[XB_TMO])) break; if (_sp > XB_SPIN_CAP) { atomicAdd(&(bar)[XB_TMO], 1u); break; } } } } while (0)

struct XcdBarrier {
    unsigned* bar; unsigned x;
    volatile LAS unsigned* st;
};

__device__ __forceinline__ XcdBarrier xcd_barrier_post(unsigned* bar, volatile LAS unsigned* st) {
    XcdBarrier b; b.bar = bar; b.x = xb_xcc_id(); b.st = st;
    if (threadIdx.x == 0) (void)xb_add(&bar[XB_XCNT(b.x)], 1u);
    return b;
}
__device__ __forceinline__ void xcd_barrier_complete(unsigned* bar, unsigned x, unsigned& nloc, unsigned& nx) {
    const unsigned G = gridDim.x * gridDim.y * gridDim.z;
    unsigned sum, cnt, mine, sp = 0u;
    for (;;) {
        sum = 0u; cnt = 0u; mine = 0u;
#pragma unroll
        for (unsigned j = 0; j < 16; ++j) { const unsigned c = xb_ld(&bar[XB_XCNT(j)]); sum += c; cnt += (c > 0u) ? 1u : 0u; mine = (j == x) ? c : mine; }
        if (sum == G) break;
        __builtin_amdgcn_s_sleep(1);
        if ((++sp & 255u) == 0u) { if (xb_ld(&bar[XB_TMO])) break; if (sp > XB_SPIN_CAP) { atomicAdd(&bar[XB_TMO], 1u); break; } }
    }
    nloc = mine > 0u ? mine : 1u; nx = cnt > 0u ? cnt : 1u;
}

__device__ __forceinline__ void xcd_barrier(const XcdBarrier& b) {
    asm volatile("s_waitcnt vmcnt(0)" ::: "memory");
    __syncthreads();
    if (threadIdx.x == 0) {
        unsigned* bar = b.bar;
        __builtin_amdgcn_s_waitcnt(0);
        unsigned nloc = b.st[0], nx = b.st[1];
        if (nloc == 0u) { xcd_barrier_complete(bar, b.x, nloc, nx); b.st[0] = nloc; b.st[1] = nx; }
        const unsigned old = xb_add(&bar[XB_XSUB(b.x)], 1u);
        const unsigned gen = old / nloc;
        if (old + 1u == (gen + 1u) * nloc) {
            __builtin_amdgcn_fence(__ATOMIC_RELEASE, "agent");
            asm volatile("s_waitcnt vmcnt(0)" ::: "memory");
            const unsigned og = xb_add(&bar[XB_TOP], 1u);
            const unsigned tg = og / nx;
            if (og + 1u == (tg + 1u) * nx) xb_add(&bar[XB_TOPGEN], 1u);
            else XB_SPIN(xb_ld(&bar[XB_TOPGEN]) == tg, bar);
            __builtin_amdgcn_fence(__ATOMIC_ACQUIRE, "agent");
            xb_add(&bar[XB_XGEN(b.x)], 1u);
            asm volatile("s_waitcnt vmcnt(0)" ::: "memory");
        } else {
            XB_SPIN(xb_ld(&bar[XB_XGEN(b.x)]) == gen, bar);
            __builtin_amdgcn_fence(__ATOMIC_ACQUIRE, "agent");
            asm volatile("s_waitcnt vmcnt(0)" ::: "memory");
        }
    }
    __syncthreads();
}


namespace pg8 {
#define PG8_LAS __attribute__((address_space(3)))
typedef unsigned short bf16_t;
typedef short bf16x8 __attribute__((ext_vector_type(8)));
typedef float f32x4 __attribute__((ext_vector_type(4)));
typedef unsigned u32x4 __attribute__((ext_vector_type(4)));
constexpr int BM = 256, BK = 64, HALF = 128, HTB = HALF * BK * 2  , STAGE_BYTES = 8 * HTB, NXCD = 8, WGM = 8;

__host__ __device__ __forceinline__ int lds_byte(int r, int c) { const int st = (r >> 4) * 2 + (c >> 5), rr = r & 15, cc = c & 31, ob = rr * 64 + cc * 2; return st * 1024 + (ob ^ (((ob >> 9) & 1) << 5)); }
__host__ __device__ __forceinline__ void stage_rc(int b, int& R, int& C) { const int st = b / 1024, sb = b % 1024, swz = sb ^ (((sb >> 9) & 1) << 5); R = (st >> 1) * 16 + swz / 64; C = (st & 1) * 32 + (swz % 64) / 2; }
__host__ __device__ __forceinline__ int perm32(int rho) { const int n = rho >> 4, i = rho & 15; return 8 * (i >> 2) + 4 * n + (i & 3); }

struct Unit { int pm, pn; };
struct Gemm { const bf16_t* A; const bf16_t* Bt; int M, N, K; };

struct StaticOrder {
    int nM, nN, nwg, G, c;
    __host__ __device__ void init(int M, int N, int G_, int c_) { nM = M / BM; nN = N / BM; nwg = nM * nN; G = G_; c = c_; }
    __host__ __device__ bool next(int i, Unit& u) const {
        const long L = (long)i * G + c; if (L >= nwg) return false;
        int wgid = (int)L; { const int q = nwg / NXCD, r = nwg % NXCD, xcd = wgid % NXCD, off = wgid / NXCD; wgid = (xcd < r ? xcd * (q + 1) : r * (q + 1) + (xcd - r) * q) + off; }
        const int nig = WGM * nN, gid = wgid / nig, fm = gid * WGM, gsz = (nM - fm) < WGM ? (nM - fm) : WGM;
        u.pm = fm + ((wgid % nig) % gsz); u.pn = (wgid % nig) / gsz; return true;
    }
    __device__ __forceinline__ void a_ready(const Unit&) const {}
    __device__ __forceinline__ void done(const Unit&) const {}
};
__device__ __forceinline__ unsigned cvt_pk_bf16(float lo, float hi) { unsigned r; asm volatile("v_cvt_pk_bf16_f32 %0, %1, %2" : "=v"(r) : "v"(lo), "v"(hi)); return r; }
template <class Epi, class Sched, bool ALIGN_EPI = false, bool SP2 = false>
__device__ __forceinline__ void gemm_phase(PG8_LAS unsigned char* lds, const Gemm g, const Sched& S, const Epi& E) {
    const int tid = tidx(), wid = __builtin_amdgcn_readfirstlane(tid >> 6), lane = tid & 63, wr = wid >> 2, wc = wid & 3, fr = lane & 15, fq = lane >> 4;
    const int K = g.K, nt = K / BK;
    unsigned voffA[2], voffB[2];
#pragma unroll
    for (int i = 0; i < 2; ++i) { int R, C; stage_rc(tid * 16 + i * 8192, R, C); const int Rb = Epi::PERM ? ((R & ~31) + perm32(R & 31)) : R;
        voffA[i] = (unsigned)(R * K + C) * 2u; voffB[i] = (unsigned)(Rb * K + C) * 2u; }
    const size_t kstep = (size_t)(BK * 2);
    const size_t hstep = (size_t)HALF * K * 2;
    const size_t tstep = 2 * hstep;
    const unsigned ldsw = (unsigned)wid * 1024u;
    const int aoff = lds_byte(wr * 64 + fr, fq * 8), boff = lds_byte(wc * 32 + fr, fq * 8);
#define PG8_SA(b, h) (((b) * 2 + (h)) * HTB)
#define PG8_SB(b, h) ((4 + (b) * 2 + (h)) * HTB)
#define PG8_STAGE(bufoff, gbase, voff) do { _Pragma("unroll") for (int _i = 0; _i < 2; ++_i) \
        __builtin_amdgcn_global_load_lds((const unsigned*)((const char*)(gbase) + (voff)[_i]), (PG8_LAS unsigned*)(lds + (bufoff) + ldsw + _i * 8192), 16, 0, 0); } while (0)
#define PG8_LDA(dst, b, h) do { _Pragma("unroll") for (int m = 0; m < 4; ++m) _Pragma("unroll") for (int k = 0; k < 2; ++k) dst[m][k] = *(const PG8_LAS bf16x8*)(lds + PG8_SA(b, h) + aoff + m * 2048 + k * 1024); } while (0)
#define PG8_LDB(dst, b, h) do { _Pragma("unroll") for (int n = 0; n < 2; ++n) _Pragma("unroll") for (int k = 0; k < 2; ++k) dst[n][k] = *(const PG8_LAS bf16x8*)(lds + PG8_SB(b, h) + boff + n * 2048 + k * 1024); } while (0)
#define PG8_MMA(ai, bj, At, Bt) do { __builtin_amdgcn_s_setprio(1); _Pragma("unroll") for (int m = 0; m < 4; ++m) _Pragma("unroll") for (int n = 0; n < 2; ++n) _Pragma("unroll") for (int k = 0; k < 2; ++k) \
        acc[ai][bj][m][n] = __builtin_amdgcn_mfma_f32_16x16x32_bf16(Bt[n][k], At[m][k], acc[ai][bj][m][n], 0, 0, 0); __builtin_amdgcn_s_setprio(0); } while (0)
#define PG8_WAIT_V(n) asm volatile("s_waitcnt vmcnt(" #n ")" ::: "memory")
#define PG8_WAIT_L(n) asm volatile("s_waitcnt lgkmcnt(" #n ")" ::: "memory")
#define PG8_BAR __builtin_amdgcn_s_barrier()
#define PG8_SCHED __builtin_amdgcn_sched_barrier(0)
    Unit cur, nxt; int ui = 0;
    if (!S.next(0, cur)) return;
    f32x4 acc[2][2][4][2];
#pragma unroll
    for (int a = 0; a < 2; ++a)
#pragma unroll
        for (int b = 0; b < 2; ++b)
#pragma unroll
            for (int m = 0; m < 4; ++m)
#pragma unroll
                for (int n = 0; n < 2; ++n) acc[a][b][m][n] = (f32x4){0.f, 0.f, 0.f, 0.f};
    bf16x8 At[4][2], B0[2][2], B1[2][2];
    const char* cA = (const char*)g.A + (size_t)cur.pm * tstep; const char* cB = (const char*)g.Bt + (size_t)cur.pn * tstep;
    S.a_ready(cur);
    if constexpr (SP2) {
        PG8_STAGE(PG8_SB(0, 0), cB, voffB); PG8_STAGE(PG8_SB(0, 1), cB + hstep, voffB); PG8_STAGE(PG8_SA(0, 0), cA, voffA); PG8_STAGE(PG8_SA(0, 1), cA + hstep, voffA);
        if (wr == 1) PG8_BAR;
        PG8_WAIT_V(2); PG8_BAR;
        PG8_STAGE(PG8_SB(1, 0), cB + kstep, voffB); PG8_STAGE(PG8_SA(1, 0), cA + kstep, voffA); PG8_STAGE(PG8_SB(1, 1), cB + hstep + kstep, voffB);
        PG8_WAIT_V(6); PG8_BAR;
    } else {
        PG8_STAGE(PG8_SB(0, 0), cB, voffB); PG8_STAGE(PG8_SA(0, 0), cA, voffA); PG8_STAGE(PG8_SB(0, 1), cB + hstep, voffB); PG8_STAGE(PG8_SA(0, 1), cA + hstep, voffA);
        if (wr == 1) PG8_BAR;
        PG8_WAIT_V(4); PG8_BAR;
        PG8_STAGE(PG8_SB(1, 0), cB + kstep, voffB); PG8_STAGE(PG8_SA(1, 0), cA + kstep, voffA); PG8_STAGE(PG8_SB(1, 1), cB + hstep + kstep, voffB);
        PG8_WAIT_V(6); PG8_BAR;
    }
    for (;;) {
        const bool has_next = S.next(ui + 1, nxt);
        const char* nA = has_next ? (const char*)g.A + (size_t)nxt.pm * tstep : cA; const char* nB = has_next ? (const char*)g.Bt + (size_t)nxt.pn * tstep : cB;
        for (int t = 0; t < nt; t += 2) {
            const bool last = (t == nt - 2);
            const char* a1 = cA + (size_t)(t + 1) * kstep;
            const char* a2 = last ? nA : cA + (size_t)(t + 2) * kstep; const char* b2 = last ? nB : cB + (size_t)(t + 2) * kstep;
            const char* a3 = a2 + kstep; const char* b3 = b2 + kstep;
            if (last && has_next) S.a_ready(nxt);
            if constexpr (SP2) {
            PG8_LDB(B0, 0, 0); PG8_LDB(B1, 0, 1); PG8_SCHED; PG8_LDA(At, 0, 0); PG8_STAGE(PG8_SA(1, 1), a1 + hstep, voffA);
            PG8_WAIT_V(8); PG8_WAIT_L(0); PG8_BAR; PG8_MMA(0, 0, At, B0); PG8_MMA(0, 1, At, B1); PG8_BAR; PG8_SCHED;
            PG8_LDA(At, 0, 1); PG8_STAGE(PG8_SB(0, 0), b2, voffB); PG8_STAGE(PG8_SB(0, 1), b2 + hstep, voffB); PG8_STAGE(PG8_SA(0, 0), a2, voffA);
            PG8_WAIT_V(8); PG8_WAIT_L(0); PG8_BAR; PG8_MMA(1, 0, At, B0); PG8_MMA(1, 1, At, B1); PG8_BAR; PG8_SCHED;
            PG8_LDB(B0, 1, 0); PG8_LDB(B1, 1, 1); PG8_SCHED; PG8_LDA(At, 1, 0); PG8_STAGE(PG8_SA(0, 1), a2 + hstep, voffA);
            PG8_WAIT_V(8); PG8_WAIT_L(0); PG8_BAR; PG8_MMA(0, 0, At, B0); PG8_MMA(0, 1, At, B1); PG8_BAR; PG8_SCHED;
            PG8_LDA(At, 1, 1); PG8_STAGE(PG8_SB(1, 0), b3, voffB); PG8_STAGE(PG8_SB(1, 1), b3 + hstep, voffB); PG8_STAGE(PG8_SA(1, 0), a3, voffA);
            PG8_WAIT_V(8); PG8_WAIT_L(0); PG8_BAR; PG8_MMA(1, 0, At, B0); PG8_MMA(1, 1, At, B1); PG8_BAR; PG8_SCHED;
            } else {
            PG8_LDB(B0, 0, 0); PG8_SCHED; PG8_LDA(At, 0, 0); PG8_STAGE(PG8_SA(1, 1), a1 + hstep, voffA);
            PG8_WAIT_L(8); PG8_BAR; PG8_WAIT_L(0); PG8_MMA(0, 0, At, B0); PG8_BAR; PG8_SCHED;
            PG8_LDB(B1, 0, 1); PG8_STAGE(PG8_SB(0, 0), b2, voffB);
            PG8_BAR; PG8_WAIT_L(0); PG8_MMA(0, 1, At, B1); PG8_BAR;
            PG8_LDA(At, 0, 1); PG8_STAGE(PG8_SA(0, 0), a2, voffA);
            PG8_BAR; PG8_WAIT_L(0); PG8_MMA(1, 0, At, B0); PG8_BAR; PG8_SCHED;
            PG8_STAGE(PG8_SB(0, 1), b2 + hstep, voffB);
            PG8_WAIT_V(6); PG8_BAR; PG8_MMA(1, 1, At, B1); PG8_BAR;
            PG8_LDB(B0, 1, 0); PG8_SCHED; PG8_LDA(At, 1, 0); PG8_STAGE(PG8_SA(0, 1), a2 + hstep, voffA);
            PG8_WAIT_L(8); PG8_BAR; PG8_WAIT_L(0); PG8_MMA(0, 0, At, B0); PG8_BAR; PG8_SCHED;
            PG8_LDB(B1, 1, 1); PG8_STAGE(PG8_SB(1, 0), b3, voffB);
            PG8_BAR; PG8_WAIT_L(0); PG8_MMA(0, 1, At, B1); PG8_BAR;
            PG8_LDA(At, 1, 1); PG8_STAGE(PG8_SA(1, 0), a3, voffA);
            PG8_BAR; PG8_WAIT_L(0); PG8_MMA(1, 0, At, B0); PG8_BAR; PG8_SCHED;
            PG8_STAGE(PG8_SB(1, 1), b3 + hstep, voffB);
            PG8_WAIT_V(6); PG8_BAR; PG8_MMA(1, 1, At, B1); PG8_BAR;
            }
        }
        if constexpr (ALIGN_EPI) { if (wr == 0) PG8_BAR; }
        if constexpr (!Epi::AFTER_DRAIN) { E(acc, cur, wr, wc, fr, fq); S.done(cur); }
        if (!has_next) break;
#pragma unroll
        for (int a = 0; a < 2; ++a)
#pragma unroll
            for (int b = 0; b < 2; ++b)
#pragma unroll
                for (int m = 0; m < 4; ++m)
#pragma unroll
                    for (int n = 0; n < 2; ++n) acc[a][b][m][n] = (f32x4){0.f, 0.f, 0.f, 0.f};
        cur = nxt; cA = nA; cB = nB; ++ui;
        if constexpr (ALIGN_EPI) { if (wr == 1) PG8_BAR; }
    }
    PG8_WAIT_V(0);
    if constexpr (!ALIGN_EPI) { if (wr == 0) PG8_BAR; }
    PG8_BAR;
    if constexpr (Epi::AFTER_DRAIN) { E.fused(acc, cur, wr, wc, fr, fq, lds, wid, lane); S.done(cur); }
#undef PG8_SA
#undef PG8_SB
#undef PG8_STAGE
#undef PG8_LDA
#undef PG8_LDB
#undef PG8_MMA
#undef PG8_WAIT_V
#undef PG8_WAIT_L
#undef PG8_BAR
#undef PG8_SCHED
}
}

struct EpiIn {
  static constexpr bool PERM = false, AFTER_DRAIN = false;
  const Params* pp; int l;
  __device__ __forceinline__ void operator()(f32x4 (&acc)[2][2][4][2], const pg8::Unit& u, int wr, int wc, int fr, int fq) const {
    kparams_t kp_ = kparams(); (void)kp_;
    const int U = u.pn * 4 + wc;
    if (U >= 77) return;
    const int rowb = u.pm * 256 + wr * 64 + fr;
    const int bq = (u.pm * 256) / T, tb = rowb % T;
    bf16_t* dst = nullptr; int ld = 0, col0 = 0; const float* gain = nullptr; bool rope = false, silu = false;
    float post = 1.0f;
    bf16_t* vt = nullptr;
    if (U < 8) { dst = WSP(bf16_t, OFF_QN); ld = 512; col0 = U * 64; gain = kp_->nsa_q_norm + l * 64; rope = true; post = 0.125f * LOG2E; }
    else if (U < 10) { dst = WSP(bf16_t, OFF_KC); ld = 128; col0 = (U - 8) * 64; rope = true; }
    else if (U < 12) { dst = WSP(bf16_t, OFF_VC); ld = 128; col0 = (U - 10) * 64; }
    else if (U < 14) { dst = WSP(bf16_t, OFF_KS); ld = 128; col0 = (U - 12) * 64; gain = kp_->nsa_k_norm + (l * 3 + 1) * 64; rope = true; }
    else if (U < 16) { vt = WSP(bf16_t, OFF_VST) + (size_t)((bq * 2 + (U - 14)) * 64) * T; }
    else if (U < 18) { dst = WSP(bf16_t, OFF_KW); ld = 128; col0 = (U - 16) * 64; gain = kp_->nsa_k_norm + (l * 3 + 2) * 64; rope = true; }
    else if (U < 20) { vt = WSP(bf16_t, OFF_VWT) + (size_t)((bq * 2 + (U - 18)) * 64) * T; }
    else if (U < 28) { dst = WSP(bf16_t, OFF_OA); ld = 512; col0 = (U - 20) * 64; silu = true; }
    else if (U < 36) { dst = WSP(bf16_t, OFF_FQ); ld = 512; col0 = (U - 28) * 64; gain = kp_->fox_q_norm + l * 64; post = 0.125f * LOG2E; }
    else if (U < 44) { dst = WSP(bf16_t, OFF_FK); ld = 512; col0 = (U - 36) * 64; gain = kp_->fox_k_norm + l * 64; }
    else if (U < 52) { vt = WSP(bf16_t, OFF_FVT) + (size_t)((bq * 8 + (U - 44)) * 64) * T; }
    else if (U < 60) { dst = WSP(bf16_t, OFF_OB); ld = 512; col0 = (U - 52) * 64; silu = true; }
    else if (U < 68) { dst = WSP(bf16_t, OFF_MQ); ld = 512; col0 = (U - 60) * 64; }
    else if (U < 76) { dst = WSP(bf16_t, OFF_OM); ld = 512; col0 = (U - 68) * 64; silu = true; }
    if (U == 76) {
      float* gate = WSP(float, OFF_GATE);
      float* flog = WSP(float, OFF_FLOG);
#pragma unroll
      for (int ai = 0; ai < 2; ++ai)
#pragma unroll
        for (int m = 0; m < 4; ++m) {
          const size_t row = (size_t)rowb + 128 * ai + 16 * m;
#pragma unroll
          for (int n = 0; n < 2; ++n)
#pragma unroll
            for (int i = 0; i < 4; ++i) {
              const int e = 16 * n + 4 * fq + i;
              const float v = acc[ai][0][m][n][i];
              if (e < 24) gate[row * 24 + e] = sigmoidf_(v);
              else {
                const float xx = v + kp_->fox_f_bias[l * 8 + (e - 24)];
                flog[row * 8 + (e - 24)] = xx >= 0.f ? -log1pf(expf(-xx)) : xx - log1pf(expf(xx));
              }
            }
        }
      return;
    }
    if (vt) {
#pragma unroll
      for (int ai = 0; ai < 2; ++ai)
#pragma unroll
        for (int m = 0; m < 4; ++m) {
          const int t = tb + 128 * ai + 16 * m;
#pragma unroll
          for (int bj = 0; bj < 2; ++bj)
#pragma unroll
            for (int n = 0; n < 2; ++n) {
              const f32x4 v = acc[ai][bj][m][n];
              const unsigned w0 = cvtpk(v[0], v[1]), w1 = cvtpk(v[2], v[3]);
              const unsigned qo = (unsigned)((32 * bj + 16 * n + 4 * fq) * T + t);
              vt[qo] = (bf16_t)(w0 & 0xffffu); vt[qo + T] = (bf16_t)(w0 >> 16); vt[qo + 2 * T] = (bf16_t)(w1 & 0xffffu); vt[qo + 3 * T] = (bf16_t)(w1 >> 16);
            }
        }
      return;
    }
    const float* ropetab = WSP(float, OFF_ROPE);
    f32x4 gv[2][2];
    if (gain) {
#pragma unroll
      for (int bj = 0; bj < 2; ++bj)
#pragma unroll
        for (int n = 0; n < 2; ++n) gv[bj][n] = *(const f32x4*)(gain + 32 * bj + 16 * n + 4 * fq);
    }
#pragma unroll
    for (int ai = 0; ai < 2; ++ai)
#pragma unroll
      for (int m = 0; m < 4; ++m) {
        f32x4 v[2][2];
#pragma unroll
        for (int bj = 0; bj < 2; ++bj)
#pragma unroll
          for (int n = 0; n < 2; ++n) v[bj][n] = acc[ai][bj][m][n];
        const int row = rowb + 128 * ai + 16 * m;
        if (gain) {
          float ss = 0.f;
#pragma unroll
          for (int bj = 0; bj < 2; ++bj)
#pragma unroll
            for (int n = 0; n < 2; ++n)
#pragma unroll
              for (int i = 0; i < 4; ++i) ss += v[bj][n][i] * v[bj][n][i];
          ss += __shfl_xor(ss, 16);
          ss += __shfl_xor(ss, 32);
          const float rstd = rsqrtf(ss * (1.0f / 64.0f) + EPS);
#pragma unroll
          for (int bj = 0; bj < 2; ++bj)
#pragma unroll
            for (int n = 0; n < 2; ++n) v[bj][n] = v[bj][n] * rstd * gv[bj][n];
        }
        if (rope) {
          const int pos = row & (T - 1);
#pragma unroll
          for (int n = 0; n < 2; ++n) {
            const f32x4* tp = (const f32x4*)(ropetab + ((size_t)pos * 32 + 16 * n + 4 * fq) * 2);
            const f32x4 t0 = tp[0], t1 = tp[1];
            const float cs[4] = {t0[0], t0[2], t1[0], t1[2]}, sn[4] = {t0[1], t0[3], t1[1], t1[3]};
#pragma unroll
            for (int i = 0; i < 4; ++i) {
              const float y1 = v[0][n][i], y2 = v[1][n][i];
              v[0][n][i] = y1 * cs[i] - y2 * sn[i];
              v[1][n][i] = y2 * cs[i] + y1 * sn[i];
            }
          }
        }
#pragma unroll
        for (int bj = 0; bj < 2; ++bj)
#pragma unroll
          for (int n = 0; n < 2; ++n) {
            f32x4 y = v[bj][n] * post;
            if (silu) {
#pragma unroll
              for (int i = 0; i < 4; ++i) y[i] = siluf_(y[i]);
            }
            u32x2 w = {cvtpk(y[0], y[1]), cvtpk(y[2], y[3])};
            *(u32x2*)(dst + (size_t)row * ld + col0 + 32 * bj + 16 * n + 4 * fq) = w;
          }
      }
  }
};
struct EpiMemKV {
  static constexpr bool PERM = false, AFTER_DRAIN = false;
  const Params* pp;
  __device__ __forceinline__ void operator()(f32x4 (&acc)[2][2][4][2], const pg8::Unit& u, int wr, int wc, int fr, int fq) const {
    kparams_t kp_ = kparams(); (void)kp_;
    const int U = u.pn * 4 + wc;
    const int rowb = u.pm * 256 + wr * 64 + fr;
#pragma unroll
    for (int ai = 0; ai < 2; ++ai)
#pragma unroll
      for (int m = 0; m < 4; ++m) {
        const int row = rowb + 128 * ai + 16 * m;
#pragma unroll
        for (int bj = 0; bj < 2; ++bj)
#pragma unroll
          for (int n = 0; n < 2; ++n) {
            const f32x4 v = acc[ai][bj][m][n];
            const unsigned w0 = cvtpk(v[0], v[1]), w1 = cvtpk(v[2], v[3]);
            const int e = 32 * bj + 16 * n + 4 * fq;
            if (U < 8) {
              u32x2 w = {w0, w1};
              *(u32x2*)(WSP(bf16_t, OFF_MK) + (size_t)row * 512 + U * 64 + e) = w;
            } else {
              const int col = (U - 8) * 64 + e, h = col >> 7, d = col & 127, b = row >> 8, mm = row & 255;
              bf16_t* q = WSP(bf16_t, OFF_MVT) + (size_t)((b * 4 + h) * 128 + d) * 256 + mm;
              q[0] = (bf16_t)(w0 & 0xffffu); q[256] = (bf16_t)(w0 >> 16); q[512] = (bf16_t)(w1 & 0xffffu); q[768] = (bf16_t)(w1 >> 16);
            }
          }
      }
  }
};
struct EpiGate {
  static constexpr bool PERM = true, AFTER_DRAIN = false;
  bf16_t* G;
  __device__ __forceinline__ void operator()(f32x4 (&acc)[2][2][4][2], const pg8::Unit& u, int wr, int wc, int fr, int fq) const {
    const int br = u.pn >> 2, colt = (u.pn & 3) * 256 + wc * 32 + 8 * fq;
    bf16_t* base = G + (size_t)br * M * 1024;
    const int rowb = u.pm * 256 + wr * 64 + fr;
#pragma unroll
    for (int ai = 0; ai < 2; ++ai)
#pragma unroll
      for (int m = 0; m < 4; ++m) {
        bf16_t* rp = base + (size_t)(rowb + 128 * ai + 16 * m) * 1024 + colt;
#pragma unroll
        for (int bj = 0; bj < 2; ++bj) {
          const f32x4 v0 = acc[ai][bj][m][0], v1 = acc[ai][bj][m][1];
          u32x4 w = {cvtpk(sigmoidf_(v0[0]), sigmoidf_(v0[1])), cvtpk(sigmoidf_(v0[2]), sigmoidf_(v0[3])),
                     cvtpk(sigmoidf_(v1[0]), sigmoidf_(v1[1])), cvtpk(sigmoidf_(v1[2]), sigmoidf_(v1[3]))};
          *(u32x4*)(rp + 128 * bj) = w;
        }
      }
  }
};
struct EpiBranch {
  static constexpr bool PERM = true, AFTER_DRAIN = false;
  const bf16_t* G; bf16_t* Uo; int first;
  __device__ __forceinline__ void operator()(f32x4 (&acc)[2][2][4][2], const pg8::Unit& u, int wr, int wc, int fr, int fq) const {
    const int colt = u.pn * 256 + wc * 32 + 8 * fq;
    const int rowb = u.pm * 256 + wr * 64 + fr;
#pragma unroll
    for (int ai = 0; ai < 2; ++ai)
#pragma unroll
      for (int m = 0; m < 4; ++m) {
        const size_t ro = (size_t)(rowb + 128 * ai + 16 * m) * 1024 + colt;
#pragma unroll
        for (int bj = 0; bj < 2; ++bj) {
          const size_t off = ro + 128 * bj;
          const u32x4 gw = *(const u32x4*)(G + off);
          float y[8];
#pragma unroll
          for (int q = 0; q < 4; ++q) {
            const f32x4 v = acc[ai][bj][m][q >> 1];
            y[2 * q] = v[(2 * q) & 3] * bflo(gw[q]);
            y[2 * q + 1] = v[(2 * q + 1) & 3] * bfhi(gw[q]);
          }
          if (!first) {
            const u32x4 uw = *(const u32x4*)(Uo + off);
#pragma unroll
            for (int q = 0; q < 4; ++q) { y[2 * q] += bflo(uw[q]); y[2 * q + 1] += bfhi(uw[q]); }
          }
          u32x4 w = {cvtpk(y[0], y[1]), cvtpk(y[2], y[3]), cvtpk(y[4], y[5]), cvtpk(y[6], y[7])};
          *(u32x4*)(Uo + off) = w;
        }
      }
  }
};
struct EpiOut {
  static constexpr bool PERM = true, AFTER_DRAIN = false;
  const float* xin; float* xout;
  __device__ __forceinline__ void operator()(f32x4 (&acc)[2][2][4][2], const pg8::Unit& u, int wr, int wc, int fr, int fq) const {
    const int colt = u.pn * 256 + wc * 32 + 8 * fq;
    const int rowb = u.pm * 256 + wr * 64 + fr;
#pragma unroll
    for (int ai = 0; ai < 2; ++ai)
#pragma unroll
      for (int m = 0; m < 4; ++m) {
        const size_t ro = (size_t)(rowb + 128 * ai + 16 * m) * 1024 + colt;
#pragma unroll
        for (int bj = 0; bj < 2; ++bj) {
          const size_t off = ro + 128 * bj;
          const f32x4 x0 = *(const f32x4*)(xin + off), x1 = *(const f32x4*)(xin + off + 4);
          *(f32x4*)(xout + off) = x0 + acc[ai][bj][m][0];
          *(f32x4*)(xout + off + 4) = x1 + acc[ai][bj][m][1];
        }
      }
  }
};
template <class Epi>
__device__ __forceinline__ void run_gemm(PG8_LAS unsigned char* lds, const bf16_t* A, const bf16_t* Bt, int Mr, int Nc, int K, const Epi& E) {
  pg8::Gemm g{A, Bt, Mr, Nc, K};
  pg8::StaticOrder S;
  S.init(Mr, Nc, gdim(), bidx());
  pg8::gemm_phase<Epi, pg8::StaticOrder, true, true>(lds, g, S, E);
}

__device__ __forceinline__ int map_in(int n) {
  const int i = n >> 6, c = n & 63;
  if (i < 20) return n;
  if (i < 28) return 1304 + (n - 1280);
  if (i < 52) return 1816 + (n - 1792);
  if (i < 60) return 3360 + (n - 3328);
  if (i < 68) return 3872 + (n - 3840);
  if (i < 76) return 4384 + (n - 4352);
  if (i == 76) return c < 24 ? 1280 + c : (c < 32 ? 3352 + (c - 24) : -1);
  return -1;
}
__device__ __forceinline__ void wave_transpose_tile(const float* __restrict__ src, int ld_src, int k0, int n0, bf16_t* __restrict__ dst,
                                                    int Kdim, int maptype, int srccol0, float* tile, int lane) {
  int nlog = n0 + lane;
  if (maptype) { const int w = nlog & 255; nlog = (nlog & ~255) + (((w & 127) >> 5) << 6) + (((w >> 7) << 5) | (w & 31)); }
  const int sc = (maptype == 1) ? map_in(nlog) : srccol0 + nlog;
  const float* sp = src + (size_t)k0 * ld_src + (sc >= 0 ? sc : 0);
#pragma unroll 32
  for (int kk = 0; kk < 64; ++kk) {
    const float v = sp[(size_t)kk * ld_src];
    tile[kk * 65 + lane] = sc >= 0 ? v : 0.f;
  }
  __builtin_amdgcn_fence(__ATOMIC_SEQ_CST, "workgroup");
  __builtin_amdgcn_wave_barrier();
  const int rsub = lane >> 5, kp = lane & 31;
#pragma unroll 8
  for (int it = 0; it < 32; ++it) {
    const int row = 2 * it + rsub;
    const float a = tile[(2 * kp) * 65 + row], b = tile[(2 * kp + 1) * 65 + row];
    *(unsigned*)(dst + (size_t)(n0 + row) * Kdim + k0 + 2 * kp) = cvtpk(a, b);
  }
  __builtin_amdgcn_fence(__ATOMIC_SEQ_CST, "workgroup");
  __builtin_amdgcn_wave_barrier();
}
__device__ __forceinline__ void rmsnorm4(const float* __restrict__ x, const float* __restrict__ gain, bf16_t* __restrict__ dst, size_t row0, int lane) {
  f32x4 v[4][4];
  float ss[4];
#pragma unroll
  for (int rr = 0; rr < 4; ++rr)
#pragma unroll
    for (int i = 0; i < 4; ++i) v[rr][i] = *(const f32x4*)(x + (row0 + rr) * 1024 + lane * 4 + 256 * i);
  f32x4 gv[4];
#pragma unroll
  for (int i = 0; i < 4; ++i) gv[i] = *(const f32x4*)(gain + lane * 4 + 256 * i);
#pragma unroll
  for (int rr = 0; rr < 4; ++rr) {
    float s = 0.f;
#pragma unroll
    for (int i = 0; i < 4; ++i) s += v[rr][i][0] * v[rr][i][0] + v[rr][i][1] * v[rr][i][1] + v[rr][i][2] * v[rr][i][2] + v[rr][i][3] * v[rr][i][3];
    ss[rr] = s;
  }
#pragma unroll
  for (int o_ = 1; o_ < 64; o_ <<= 1) {
#pragma unroll
    for (int rr = 0; rr < 4; ++rr) ss[rr] += __shfl_xor(ss[rr], o_);
  }
#pragma unroll
  for (int rr = 0; rr < 4; ++rr) {
    const float rstd = rsqrtf(ss[rr] * (1.0f / 1024.0f) + EPS);
#pragma unroll
    for (int i = 0; i < 4; ++i) {
      const f32x4 y = v[rr][i] * rstd * gv[i];
      u32x2 w = {cvtpk(y[0], y[1]), cvtpk(y[2], y[3])};
      *(u32x2*)(dst + (row0 + rr) * 1024 + lane * 4 + 256 * i) = w;
    }
  }
}
__device__ __forceinline__ void phase_prep(const Params& p, int l, float* smem) {
  kparams_t kp_ = kparams(); (void)kp_;
  const int tid = tidx();
  const int wave = tid >> 6, lane = tid & 63;
  const int gw = wave * gdim() + bidx(), nw = NWAVES * gdim();
  if (l == 0 && bidx() == 0 && tid < 64) WSP(unsigned, OFF_CTL)[tid] = 0u;
  const float* xin = (l == 0) ? kp_->x : kp_->out;
  float* wtile = smem + wave * 4160;
  for (int u0 = gw; u0 < 3076; u0 += nw) {
    int u = u0;
    const float* src; int ld, kt, nt, Kd, mt = 0, c0 = 0; bf16_t* dst;
    if (u < 1280) { kt = u / 80; nt = u % 80; src = kp_->w_in + (size_t)l * 1024 * 7968; ld = 7968; Kd = 1024; dst = WSP(bf16_t, OFF_W_IN); mt = 1; }
    else if ((u -= 1280) < 768) { kt = u / 48; nt = u % 48; src = kp_->w_in + (size_t)l * 1024 * 7968; ld = 7968; Kd = 1024; dst = WSP(bf16_t, OFF_W_G); c0 = 4896; }
    else if ((u -= 768) < 256) { kt = u / 16; nt = u % 16; src = kp_->w_mem_kv + (size_t)l * 1024 * 1024; ld = 1024; Kd = 1024; dst = WSP(bf16_t, OFF_W_MKV); mt = 2; }
    else if ((u -= 256) < 384) { const int br = u / 128, uu = u % 128; kt = uu / 16; nt = uu % 16;
      src = (br == 0 ? kp_->w_branch_a : br == 1 ? kp_->w_branch_b : kp_->w_branch_m) + (size_t)l * 512 * 1024; ld = 1024; Kd = 512; dst = WSP(bf16_t, OFF_W_BR + (size_t)br * MiB); }
    else if ((u -= 384) < 256) { kt = u / 16; nt = u % 16; src = kp_->w_out + (size_t)l * 1024 * 1024; ld = 1024; Kd = 1024; dst = WSP(bf16_t, OFF_W_OUT); }
    else if ((u -= 256) < 128) { const int kv = u / 64, uu = u % 64; kt = uu / 2; nt = uu % 2;
      src = (kv ? kp_->cmp_w1_v : kp_->cmp_w1_k) + (size_t)l * 2048 * 128; ld = 128; Kd = 2048; dst = WSP(bf16_t, OFF_W1 + (size_t)kv * 512 * 1024); }
    else { u -= 128; const int kv = u / 2; kt = u % 2; nt = 0;
      src = (kv ? kp_->cmp_w2_v : kp_->cmp_w2_k) + (size_t)l * 128 * 64; ld = 64; Kd = 128; dst = WSP(bf16_t, OFF_W2 + (size_t)kv * 64 * 1024); }
    wave_transpose_tile(src, ld, kt * 64, nt * 64, dst, Kd, mt, c0, wtile, lane);
  }
  for (int grp = gw; grp < 8192 + 256; grp += nw) {
    if (grp < 8192) rmsnorm4(xin, kp_->norm_g + l * 1024, WSP(bf16_t, OFF_H), (size_t)grp * 4, lane);
    else rmsnorm4(kp_->mem, kp_->mem_norm_g + l * 1024, WSP(bf16_t, OFF_MEMN), (size_t)(grp - 8192) * 4, lane);
  }
  for (int u = gw; u < 32; u += nw) {
    const int kv = u >> 4, ch = u & 15;
    const float* pe = (kv ? kp_->cmp_pe_v : kp_->cmp_pe_k) + (size_t)l * 2048 + ch * 128;
    const float* w1 = (kv ? kp_->cmp_w1_v : kp_->cmp_w1_k) + (size_t)l * 2048 * 128 + (size_t)ch * 128 * 128;
    float s0 = 0.f, s1 = 0.f;
#pragma unroll 32
    for (int kk = 0; kk < 128; ++kk) {
      const float pv = pe[kk];
      s0 += pv * w1[(size_t)kk * 128 + lane];
      s1 += pv * w1[(size_t)kk * 128 + 64 + lane];
    }
    float* part = WSP(float, OFF_C1) + (size_t)(kv * 16 + ch) * 128;
    part[lane] = s0;
    part[64 + lane] = s1;
  }
  if (l == 0) {
    for (int u = bidx(); u < 512; u += gdim()) {
      for (int e = tid; e < 512; e += NTHREADS) {
        const int idx = u * 512 + e, pos = idx >> 5, f = idx & 31;
        const float ang = (float)pos * c_inv_freq[f];
        const double a = (double)ang;
        const double k = rint(a * 0.15915494309189535);
        const float rr = (float)(a - k * 6.283185307179586);
        float2 cs; cs.x = __cosf(rr); cs.y = __sinf(rr);
        WSP(float2, OFF_ROPE)[idx] = cs;
      }
    }
  }
}

__device__ __forceinline__ void compress_wg(const Params& p, int l, int up, float* smem) {
  kparams_t kp_ = kparams(); (void)kp_;
  const int wave_ = tidx() >> 6, kc = wave_ & 3, u = up * 2 + (wave_ >> 2);
  const int lane = tidx() & 63, r = lane & 15, g4 = lane >> 4;
  const int kv = u >> 7, rem = u & 127, b = rem >> 5, grp = (rem >> 4) & 1, it = rem & 15, i0 = it * 32;
  const bf16_t* src = WSP(bf16_t, kv ? OFF_VC : OFF_KC);
  const bf16_t* w1t = WSP(bf16_t, OFF_W1 + (size_t)kv * 512 * 1024);
  const bf16_t* w2t = WSP(bf16_t, OFF_W2 + (size_t)kv * 64 * 1024);
  const float* c1 = WSP(float, OFF_C1 + 16384) + kv * 128;
  const bf16_t* arow[2];
#pragma unroll
  for (int mt = 0; mt < 2; ++mt) {
    int i = i0 + 16 * mt + r;
    if (i > 510) i = 510;
    arow[mt] = src + ((size_t)b * T + 16 * i) * 128 + grp * 64 + g4 * 8;
  }
  f32x4 acc[2][8];
#pragma unroll
  for (int a = 0; a < 2; ++a)
#pragma unroll
    for (int c = 0; c < 8; ++c) acc[a][c] = (f32x4){0.f, 0.f, 0.f, 0.f};
  const bf16_t* bp = w1t + (size_t)r * 2048 + g4 * 8;
#pragma unroll 1
  for (int k0 = kc * 512; k0 < kc * 512 + 512; k0 += 32) {
    const int pp = k0 >> 6, d = k0 & 63;
    bf16x8 af[2], bf[8];
#pragma unroll
    for (int mt = 0; mt < 2; ++mt) af[mt] = *(const bf16x8*)(arow[mt] + (size_t)pp * 128 + d);
#pragma unroll
    for (int nt = 0; nt < 8; ++nt) bf[nt] = *(const bf16x8*)(bp + (size_t)nt * 16 * 2048 + k0);
#pragma unroll
    for (int mt = 0; mt < 2; ++mt)
#pragma unroll
      for (int nt = 0; nt < 8; ++nt) acc[mt][nt] = mfma16(bf[nt], af[mt], acc[mt][nt]);
  }
  {
    float* part = smem + wave_ * 4096;
#pragma unroll
    for (int a = 0; a < 2; ++a)
#pragma unroll
      for (int c = 0; c < 8; ++c)
#pragma unroll
        for (int i = 0; i < 4; ++i) part[((a * 8 + c) * 4 + i) * 64 + lane] = acc[a][c][i];
  }
  __syncthreads();
  if (kc != 0) return;
#pragma unroll 1
  for (int q = 1; q < 4; ++q) {
    const float* part = smem + (wave_ + q) * 4096;
#pragma unroll
    for (int a = 0; a < 2; ++a) {
#pragma unroll
      for (int c = 0; c < 8; ++c)
#pragma unroll
        for (int i = 0; i < 4; ++i) acc[a][c][i] += part[((a * 8 + c) * 4 + i) * 64 + lane];
      asm volatile("" ::: "memory");
    }
  }
#pragma unroll
  for (int nt = 0; nt < 8; ++nt) {
    const f32x4 cv = *(const f32x4*)(c1 + 16 * nt + 4 * g4);
#pragma unroll
    for (int mt = 0; mt < 2; ++mt)
#pragma unroll
      for (int i = 0; i < 4; ++i) acc[mt][nt][i] = siluf_(acc[mt][nt][i] + cv[i]);
  }
  bf16x8 wf[4][4];
#pragma unroll
  for (int ks = 0; ks < 4; ++ks)
#pragma unroll
    for (int et = 0; et < 4; ++et) {
      const bf16_t* wp = w2t + (size_t)(16 * et + r) * 128 + 32 * ks + 4 * g4;
      const u32x2 lo = *(const u32x2*)wp, hi = *(const u32x2*)(wp + 16);
      u32x4 w = {lo[0], lo[1], hi[0], hi[1]};
      wf[ks][et] = __builtin_bit_cast(bf16x8, w);
    }
  if (kv == 0) {
    const float* gain = kp_->nsa_k_norm + (size_t)(l * 3 + 0) * 64;
    bf16_t* dst = WSP(bf16_t, OFF_KCMP) + (size_t)((b * 2 + grp) * 512) * 64;
    f32x4 gv[4];
#pragma unroll
    for (int et = 0; et < 4; ++et) gv[et] = *(const f32x4*)(gain + 16 * et + 4 * g4);
#pragma unroll
    for (int mt = 0; mt < 2; ++mt) {
      f32x4 o[4];
#pragma unroll
      for (int et = 0; et < 4; ++et) o[et] = (f32x4){0.f, 0.f, 0.f, 0.f};
#pragma unroll
      for (int ks = 0; ks < 4; ++ks) {
        const bf16x8 xf = pack8(acc[mt][2 * ks], acc[mt][2 * ks + 1]);
#pragma unroll
        for (int et = 0; et < 4; ++et) o[et] = mfma16(wf[ks][et], xf, o[et]);
      }
      float ss = 0.f;
#pragma unroll
      for (int et = 0; et < 4; ++et)
#pragma unroll
        for (int i = 0; i < 4; ++i) ss += o[et][i] * o[et][i];
      ss += __shfl_xor(ss, 16);
      ss += __shfl_xor(ss, 32);
      const float rstd = rsqrtf(ss * (1.0f / 64.0f) + EPS);
      const int i = i0 + 16 * mt + r;
#pragma unroll
      for (int et = 0; et < 4; ++et) {
        f32x4 y = o[et] * rstd * gv[et];
        if (i > 510) y = (f32x4){0.f, 0.f, 0.f, 0.f};
        u32x2 w = {cvtpk(y[0], y[1]), cvtpk(y[2], y[3])};
        *(u32x2*)(dst + (size_t)i * 64 + 16 * et + 4 * g4) = w;
      }
    }
  } else {
    bf16_t* dst = WSP(bf16_t, OFF_VCT) + (size_t)((b * 2 + grp) * 64) * 512;
#pragma unroll
    for (int mt = 0; mt < 2; ++mt) {
      f32x4 o[4];
#pragma unroll
      for (int et = 0; et < 4; ++et) o[et] = (f32x4){0.f, 0.f, 0.f, 0.f};
#pragma unroll
      for (int ks = 0; ks < 4; ++ks) {
        const bf16x8 xf = pack8(acc[mt][2 * ks], acc[mt][2 * ks + 1]);
#pragma unroll
        for (int et = 0; et < 4; ++et) o[et] = mfma16(xf, wf[ks][et], o[et]);
      }
#pragma unroll
      for (int et = 0; et < 4; ++et) {
        f32x4 y = o[et];
        const int ib = i0 + 16 * mt + 4 * g4;
#pragma unroll
        for (int i = 0; i < 4; ++i)
          if (ib + i > 510) y[i] = 0.f;
        u32x2 w = {cvtpk(y[0], y[1]), cvtpk(y[2], y[3])};
        *(u32x2*)(dst + (size_t)(16 * et + r) * 512 + ib) = w;
      }
    }
  }
}
__device__ __forceinline__ void cumsum_wg(const Params& p, int u, float* smem) {
  kparams_t kp_ = kparams(); (void)kp_;
  const int tid = tidx(), lane = tid & 63, wave = tid >> 6, b = u >> 3, h = u & 7;
  const float* fl = WSP(float, OFF_FLOG) + ((size_t)b * T) * 8 + h;
  float* fc = WSP(float, OFF_FC) + (size_t)(b * 8 + h) * T;
  const int tb = tid * 16;
  float v[16];
#pragma unroll
  for (int i = 0; i < 16; ++i) v[i] = fl[(size_t)(tb + i) * 8];
  double s = 0.0;
#pragma unroll
  for (int i = 0; i < 16; ++i) s += (double)v[i];
  double incl = s;
#pragma unroll
  for (int o = 1; o < 64; o <<= 1) {
    const double y = __shfl_up(incl, o);
    if (lane >= o) incl += y;
  }
  double* wtot = (double*)smem;
  if (lane == 63) wtot[wave] = incl;
  __syncthreads();
  double base = 0.0;
  for (int w = 0; w < wave; ++w) base += wtot[w];
  double run = base + incl - s;
#pragma unroll
  for (int i = 0; i < 16; ++i) { run += (double)v[i]; v[i] = (float)run; }
#pragma unroll
  for (int i = 0; i < 4; ++i) *(f32x4*)(fc + tb + 4 * i) = (f32x4){v[4 * i], v[4 * i + 1], v[4 * i + 2], v[4 * i + 3]};
  __syncthreads();
}
__device__ __forceinline__ void memk_norm_unit(const Params& p, int l, int u) {
  kparams_t kp_ = kparams(); (void)kp_;
  const int lane = tidx() & 63;
  bf16_t* mk = WSP(bf16_t, OFF_MK);
  const float* gain = kp_->mem_k_norm + l * 128 + (lane & 15) * 8;
  for (int rr = 0; rr < 16; ++rr) {
    bf16_t* ptr = mk + (size_t)(u * 16 + rr) * 512 + lane * 8;
    const u32x4 w = *(const u32x4*)ptr;
    float v[8];
#pragma unroll
    for (int j = 0; j < 4; ++j) { v[2 * j] = bflo(w[j]); v[2 * j + 1] = bfhi(w[j]); }
    float ss = 0.f;
#pragma unroll
    for (int j = 0; j < 8; ++j) ss += v[j] * v[j];
#pragma unroll
    for (int o = 1; o < 16; o <<= 1) ss += __shfl_xor(ss, o);
    const float rstd = rsqrtf(ss * (1.0f / 128.0f) + EPS);
    u32x4 ow;
#pragma unroll
    for (int j = 0; j < 4; ++j) ow[j] = cvtpk(v[2 * j] * rstd * gain[2 * j], v[2 * j + 1] * rstd * gain[2 * j + 1]);
    *(u32x4*)ptr = ow;
  }
}
__device__ __forceinline__ void phase_mid(const Params& p, int l, float* smem) {
  const int wave = tidx() >> 6;
  for (int u = bidx(); u < 128 + 32 + 8; u += gdim()) {
    if (u < 128) { compress_wg(p, l, u, smem); __syncthreads(); }
    else if (u < 160) cumsum_wg(p, u - 128, smem);
    else memk_norm_unit(p, l, (u - 160) * 8 + wave);
  }
}

template <int NCT, int NDK, bool QL = false>
__device__ __forceinline__ void qk_scores(const bf16_t* __restrict__ kbase, int ldk, int key0,
                                          const bf16x8 (&qf)[NCT][NDK], f32x4 (&s)[2][NCT], int lane, const bf16x8* qlds = nullptr) {
  const int r = lane & 15, grp = lane >> 4;
#pragma unroll
  for (int kt = 0; kt < 2; ++kt) {
    const bf16_t* kp = kbase + (size_t)(key0 + 8 * (r >> 2) + 4 * kt + (r & 3)) * ldk + grp * 8;
    bf16x8 kf[NDK];
#pragma unroll
    for (int dk = 0; dk < NDK; ++dk) kf[dk] = *(const bf16x8*)(kp + dk * 32);
#pragma unroll
    for (int ct = 0; ct < NCT; ++ct) {
      f32x4 a = {0.f, 0.f, 0.f, 0.f};
#pragma unroll
      for (int dk = 0; dk < NDK; ++dk) a = mfma16(kf[dk], QL ? qlds[(ct * NDK + dk) * 64 + lane] : qf[ct][dk], a);
      s[kt][ct] = a;
    }
  }
}
template <int NCT, int NDT>
__device__ __forceinline__ void pv_accum(const bf16_t* __restrict__ vt, size_t ldv, int key0,
                                         const f32x4 (&s)[2][NCT], f32x4 (&o)[NDT][NCT], int lane) {
  const int r = lane & 15, grp = lane >> 4;
  bf16x8 pb[NCT];
#pragma unroll
  for (int ct = 0; ct < NCT; ++ct) pb[ct] = pack8(s[0][ct], s[1][ct]);
#pragma unroll
  for (int dt = 0; dt < NDT; ++dt) {
    const bf16x8 vf = *(const bf16x8*)(vt + (size_t)(16 * dt + r) * ldv + key0 + 8 * grp);
#pragma unroll
    for (int ct = 0; ct < NCT; ++ct) o[dt][ct] = mfma16(vf, pb[ct], o[dt][ct]);
  }
}
template <int NCT, int NDT, bool HAS_O, bool SUMS = true>
__device__ __forceinline__ void softmax_update(f32x4 (&s)[2][NCT], float (&m)[NCT], float (&lsum)[NCT],
                                               f32x4 (&o)[NDT][NCT], f32x4 (*lacc)[NCT] = nullptr) {
  float mnew[NCT];
  bool ch = false;
#pragma unroll
  for (int ct = 0; ct < NCT; ++ct) {
    float mx = fmaxf(fmaxf(fmaxf(s[0][ct][0], s[0][ct][1]), fmaxf(s[0][ct][2], s[0][ct][3])),
                     fmaxf(fmaxf(s[1][ct][0], s[1][ct][1]), fmaxf(s[1][ct][2], s[1][ct][3])));
    mx = grp_max4(mx);
    mnew[ct] = fmaxf(m[ct], mx);
    ch = ch || (mnew[ct] > m[ct]);
  }
  if (__any(ch)) {
#pragma unroll
    for (int ct = 0; ct < NCT; ++ct) {
      const float msafe = (mnew[ct] == NEG_INF) ? 0.f : mnew[ct];
      const float alpha = __builtin_amdgcn_exp2f(m[ct] - msafe);
      m[ct] = mnew[ct];
      if (SUMS) lsum[ct] *= alpha; else (*lacc)[ct] = (*lacc)[ct] * alpha;
      if (HAS_O) {
#pragma unroll
        for (int dt = 0; dt < NDT; ++dt) o[dt][ct] = o[dt][ct] * alpha;
      }
    }
  }
#pragma unroll
  for (int ct = 0; ct < NCT; ++ct) {
    const float msafe = (m[ct] == NEG_INF) ? 0.f : m[ct];
#pragma unroll
    for (int kt = 0; kt < 2; ++kt) {
      const f32x4 d = s[kt][ct] - msafe;
      f32x4 pv;
#pragma unroll
      for (int i = 0; i < 4; ++i) pv[i] = __builtin_amdgcn_exp2f(d[i]);
      s[kt][ct] = pv;
    }
    if (SUMS) {
      const f32x4 t4 = s[0][ct] + s[1][ct];
      lsum[ct] += (t4[0] + t4[1]) + (t4[2] + t4[3]);
    }
  }
}
__device__ __forceinline__ float finish_l(float lsum) {
  lsum += __shfl_xor(lsum, 16);
  lsum += __shfl_xor(lsum, 32);
  return lsum > 0.f ? 1.0f / lsum : 0.f;
}

typedef __attribute__((address_space(3))) unsigned char lds_u8;
constexpr int TILE_ROWB = 144, TILE_HALF = 64 * TILE_ROWB, TILE_STAGE = 2 * TILE_HALF + 256;
struct TileRegs { u32x4 k, v; };
__device__ __forceinline__ void tile_gload(TileRegs& tr, const bf16_t* __restrict__ kbase, int ldk, const bf16_t* __restrict__ vtbase,
                                           size_t ldv, int key0, int tid) {
  const int row = tid >> 3, ch = tid & 7;
  tr.k = *(const u32x4*)(kbase + (size_t)(key0 + row) * ldk + ch * 8);
  tr.v = *(const u32x4*)(vtbase + (size_t)row * ldv + key0 + ch * 8);
}
__device__ __forceinline__ void tile_swrite(const TileRegs& tr, lds_u8* stage, int tid) {
  const int row = tid >> 3, ch = tid & 7;
  *(__attribute__((address_space(3))) u32x4*)(stage + row * TILE_ROWB + ch * 16) = tr.k;
  *(__attribute__((address_space(3))) u32x4*)(stage + TILE_HALF + row * TILE_ROWB + ch * 16) = tr.v;
}
template <int NCT, int NDK, bool QL>
__device__ __forceinline__ void qk_scores_lds(const lds_u8* stage, int hf, const bf16x8 (&qf)[NCT][NDK], f32x4 (&s)[2][NCT], int lane,
                                              const bf16x8* qlds, const f32x4 c0, const f32x4 c1) {
  const int r = lane & 15, grp = lane >> 4;
#pragma unroll
  for (int kt = 0; kt < 2; ++kt) {
    const lds_u8* kp = stage + (32 * hf + 8 * (r >> 2) + 4 * kt + (r & 3)) * TILE_ROWB + grp * 16;
    bf16x8 kf[NDK];
#pragma unroll
    for (int dk = 0; dk < NDK; ++dk) kf[dk] = *(const __attribute__((address_space(3))) bf16x8*)(kp + dk * 64);
#pragma unroll
    for (int ct = 0; ct < NCT; ++ct) {
      f32x4 a = kt ? c1 : c0;
#pragma unroll
      for (int dk = 0; dk < NDK; ++dk) a = mfma16(kf[dk], QL ? qlds[(ct * NDK + dk) * 64 + lane] : qf[ct][dk], a);
      s[kt][ct] = a;
    }
  }
}
template <int NDT>
__device__ __forceinline__ void v_frags_lds(const lds_u8* stage, int hf, bf16x8 (&vf)[NDT], int lane) {
  const int r = lane & 15, grp = lane >> 4;
#pragma unroll
  for (int dt = 0; dt < NDT; ++dt)
    vf[dt] = *(const __attribute__((address_space(3))) bf16x8*)(stage + TILE_HALF + (16 * dt + r) * TILE_ROWB + (32 * hf + 8 * grp) * 2);
}
template <int NCT, int NDT>
__device__ __forceinline__ void pv_accum_lds(const bf16x8 (&vfp)[NDT], const f32x4 (&s)[2][NCT], f32x4 (&o)[NDT][NCT], int lane, f32x4 (&lacc)[NCT]) {
  const int r = lane & 15, grp = lane >> 4; (void)r; (void)grp;
  bf16x8 pb[NCT];
#pragma unroll
  for (int ct = 0; ct < NCT; ++ct) pb[ct] = pack8(s[0][ct], s[1][ct]);
  {
    const short one = (short)0x3F80;
    const bf16x8 ones = {one, one, one, one, one, one, one, one};
#pragma unroll
    for (int ct = 0; ct < NCT; ++ct) lacc[ct] = mfma16(ones, pb[ct], lacc[ct]);
  }
#pragma unroll
  for (int dt = 0; dt < NDT; ++dt) {
    const bf16x8 vf = vfp[dt];
#pragma unroll
    for (int ct = 0; ct < NCT; ++ct) o[dt][ct] = mfma16(vf, pb[ct], o[dt][ct]);
  }
}
__device__ __forceinline__ int next_bit(unsigned long long lo, unsigned long long hi, int from) {
  if (from < 64) { const unsigned long long mm = lo & (~0ull << from); if (mm) return __ffsll(mm) - 1; from = 64; }
  if (from < 128) { const unsigned long long mm = hi & (~0ull << (from - 64)); if (mm) return 64 + __ffsll(mm) - 1; }
  return 128;
}

__device__ __forceinline__ void nsa_wg_unit(const Params& p, int b, int g, int qi, float* imp, bf16x8* qlds, float* scr, lds_u8* tiles, unsigned* misc, bool st) {
  kparams_t kp_ = kparams(); (void)kp_;
  const int tid0 = tidx();
  const int wave = __builtin_amdgcn_readfirstlane(tid0 >> 6);
  const int lane0 = tid0 & 63;
  const int tq = qi * 8 + wave;
  const int t0 = tq * 16;
  const bf16x8 (&qf)[4][2] = *(const bf16x8 (*)[4][2])nullptr;
#define NSA_SECTION_VARS \
  int lane = lane0; asm volatile("" : "+v"(lane)); \
  const int r = lane & 15, grp = lane >> 4, t = t0 + r; \
  const size_t row = (size_t)b * T + t; \
  const float* gatep = WSP(float, OFF_GATE) + row * 24 + g * 12; (void)gatep; (void)grp; (void)t;
  {
    NSA_SECTION_VARS
#pragma unroll
    for (int ct = 0; ct < 4; ++ct)
#pragma unroll
      for (int dk = 0; dk < 2; ++dk)
        qlds[(ct * 2 + dk) * 64 + lane] = *(const bf16x8*)(WSP(bf16_t, OFF_QN) + row * 512 + (g * 4 + ct) * 64 + dk * 32 + grp * 8);
  }
  f32x4 o[4][4];
  float m[4], lsum[4];
  f32x4 lacc[4];
  {
    NSA_SECTION_VARS
    const bf16_t* kc = WSP(bf16_t, OFF_KCMP) + (size_t)((b * 2 + g) * 512) * 64;
    const bf16_t* vct = WSP(bf16_t, OFF_VCT) + (size_t)((b * 2 + g) * 64) * 512;
    const int nblk = (tq + 31) >> 5;
#pragma unroll
    for (int ct = 0; ct < 4; ++ct) { m[ct] = NEG_INF; lsum[ct] = 0.f; }
#pragma unroll 1
    for (int blk = 0; blk < nblk; ++blk) {
      f32x4 s[2][4];
      qk_scores<4, 2, true>(kc, 64, blk * 32, qf, s, lane, qlds);
#pragma unroll
      for (int kt = 0; kt < 2; ++kt)
#pragma unroll
        for (int i = 0; i < 4; ++i) {
          const int n = blk * 32 + 8 * grp + 4 * kt + i;
          const bool ok = (16 * n + 31 <= t);
#pragma unroll
          for (int ct = 0; ct < 4; ++ct) s[kt][ct][i] = ok ? s[kt][ct][i] : NEG_INF;
        }
      softmax_update<4, 4, false>(s, m, lsum, o);
    }
    float invl[4], msafe[4];
#pragma unroll
    for (int ct = 0; ct < 4; ++ct) { invl[ct] = finish_l(lsum[ct]); msafe[ct] = (m[ct] == NEG_INF) ? 0.f : m[ct]; }
    for (int e = lane; e < 16 * 132; e += 64) imp[e] = 0.f;
    __builtin_amdgcn_fence(__ATOMIC_SEQ_CST, "workgroup");
    __builtin_amdgcn_wave_barrier();
#pragma unroll
    for (int dt = 0; dt < 4; ++dt)
#pragma unroll
      for (int ct = 0; ct < 4; ++ct) o[dt][ct] = (f32x4){0.f, 0.f, 0.f, 0.f};
#pragma unroll 1
    for (int blk = 0; blk < nblk; ++blk) {
      f32x4 s[2][4];
      qk_scores<4, 2, true>(kc, 64, blk * 32, qf, s, lane, qlds);
      float pq[2][4];
#pragma unroll
      for (int kt = 0; kt < 2; ++kt)
#pragma unroll
        for (int i = 0; i < 4; ++i) {
          const int n = blk * 32 + 8 * grp + 4 * kt + i;
          const bool ok = (16 * n + 31 <= t);
          float acc_p = 0.f;
#pragma unroll
          for (int ct = 0; ct < 4; ++ct) {
            const float pv = ok ? __builtin_amdgcn_exp2f(s[kt][ct][i] - msafe[ct]) * invl[ct] : 0.f;
            s[kt][ct][i] = pv;
            acc_p += pv;
          }
          pq[kt][i] = acc_p;
        }
      float* ir = imp + r * 132 + blk * 8 + 2 * grp;
      ir[0] += pq[0][0] + pq[0][1] + pq[0][2] + 0.5f * pq[0][3];
      __builtin_amdgcn_fence(__ATOMIC_SEQ_CST, "workgroup");
      __builtin_amdgcn_wave_barrier();
      ir[1] += pq[1][0] + pq[1][1] + pq[1][2] + 0.5f * pq[1][3] + 0.5f * pq[0][3];
      __builtin_amdgcn_fence(__ATOMIC_SEQ_CST, "workgroup");
      __builtin_amdgcn_wave_barrier();
      ir[2] += 0.5f * pq[1][3];
      __builtin_amdgcn_fence(__ATOMIC_SEQ_CST, "workgroup");
      __builtin_amdgcn_wave_barrier();
      pv_accum<4, 4>(vct, 512, blk * 32, s, o, lane);
    }
    f32x4 gt[4];
#pragma unroll
    for (int ct = 0; ct < 4; ++ct) gt[ct][0] = gatep[ct * 3 + 0];
#pragma unroll
    for (int dt = 0; dt < 4; ++dt) {
#pragma unroll
      for (int ct = 0; ct < 4; ++ct)
#pragma unroll
        for (int i = 0; i < 4; ++i) scr[((dt * 4 + ct) * 4 + i) * 64 + lane] = o[dt][ct][i] * gt[ct][0];
      asm volatile("" ::: "memory");
    }
  }
  const int cur = t0 >> 6;
  unsigned long long sel_lo = 0ull, sel_hi = 0ull;
  {
  NSA_SECTION_VARS
  if (cur <= 15) {
    sel_lo = (1ull << (cur + 1)) - 1ull;
  } else {
    __builtin_amdgcn_fence(__ATOMIC_SEQ_CST, "workgroup");
    __builtin_amdgcn_wave_barrier();
    float v[32];
#pragma unroll
    for (int k = 0; k < 32; ++k) {
      const int j = grp + 4 * k;
      const float x = imp[r * 132 + j];
      v[k] = (j >= 1 && j <= cur - 2) ? x : NEG_INF;
    }
#pragma unroll 1
    for (int round = 0; round < 13; ++round) {
      float best = NEG_INF;
      int bj = 1 << 20;
#pragma unroll
      for (int k = 0; k < 32; ++k) {
        const bool tk = v[k] > best;
        best = tk ? v[k] : best;
        bj = tk ? (grp + 4 * k) : bj;
      }
#pragma unroll
      for (int off = 16; off <= 32; off <<= 1) {
        const float ob = __shfl_xor(best, off);
        const int oj = __shfl_xor(bj, off);
        const bool tk = (ob > best) || (ob == best && oj < bj);
        best = tk ? ob : best;
        bj = tk ? oj : bj;
      }
      if (bj < 64) sel_lo |= 1ull << bj; else if (bj < 128) sel_hi |= 1ull << (bj - 64);
#pragma unroll
      for (int k = 0; k < 32; ++k) v[k] = (bj == grp + 4 * k) ? NEG_INF : v[k];
    }
    sel_lo |= 1ull;
    if (cur < 64) sel_lo |= 1ull << cur; else sel_hi |= 1ull << (cur - 64);
    if (cur - 1 < 64) sel_lo |= 1ull << (cur - 1); else sel_hi |= 1ull << (cur - 1 - 64);
  }
  }
  asm volatile("" : "+v"(sel_lo), "+v"(sel_hi));
  atomicOr(&misc[4], (unsigned)sel_lo); atomicOr(&misc[5], (unsigned)(sel_lo >> 32));
  atomicOr(&misc[6], (unsigned)sel_hi); atomicOr(&misc[7], (unsigned)(sel_hi >> 32));
  __syncthreads();
  unsigned long long ulo, uhi;
  {
    const unsigned u0 = __builtin_amdgcn_readfirstlane(misc[4]), u1 = __builtin_amdgcn_readfirstlane(misc[5]);
    const unsigned u2 = __builtin_amdgcn_readfirstlane(misc[6]), u3 = __builtin_amdgcn_readfirstlane(misc[7]);
    ulo = ((unsigned long long)u1 << 32) | u0; uhi = ((unsigned long long)u3 << 32) | u2;
  }
  {
    NSA_SECTION_VARS
    const int tid = (wave << 6) | lane;
    const int hq = r >> 2, qq = r & 3;
    const bf16_t* ks = WSP(bf16_t, OFF_KS) + ((size_t)b * T) * 128 + g * 64;
    const bf16_t* vst = WSP(bf16_t, OFF_VST) + (size_t)((b * 2 + g) * 64) * T;
    bf16x8 qr[4][2];
    unsigned long long mlo[4], mhi[4];
#pragma unroll
    for (int ct = 0; ct < 4; ++ct) {
      const size_t rowq = (size_t)b * T + t0 + 4 * ct + qq;
#pragma unroll
      for (int dk = 0; dk < 2; ++dk)
        qr[ct][dk] = *(const bf16x8*)(WSP(bf16_t, OFF_QN) + rowq * 512 + (g * 4 + hq) * 64 + dk * 32 + grp * 8);
      const int srcl = (lane & 48) | (4 * ct + qq);
      mlo[ct] = __shfl(sel_lo, srcl);
      mhi[ct] = __shfl(sel_hi, srcl);
      m[ct] = NEG_INF; lacc[ct] = (f32x4){0.f, 0.f, 0.f, 0.f};
    }
#pragma unroll
    for (int dt = 0; dt < 4; ++dt)
#pragma unroll
      for (int ct = 0; ct < 4; ++ct) o[dt][ct] = (f32x4){0.f, 0.f, 0.f, 0.f};
    const short one_ = (short)0x3F80;
    const bf16x8 ones = {one_, one_, one_, one_, one_, one_, one_, one_};
    TileRegs tr, trb;
    int jA = next_bit(ulo, uhi, 0), it = 0;
    int jB = next_bit(ulo, uhi, jA + 1);
    tile_gload(tr, ks, 128, vst, T, 64 * jA, tid);
    if (jB < 128) tile_gload(trb, ks, 128, vst, T, 64 * jB, tid);
    tile_swrite(tr, tiles, tid);
    if (jB < 128) tile_swrite(trb, tiles + TILE_STAGE, tid);
    __syncthreads();
#pragma unroll 1
    while (jA < 128) {
      const int nA = (jB < 128) ? next_bit(ulo, uhi, jB + 1) : 128;
      const int nB = (nA < 128) ? next_bit(ulo, uhi, nA + 1) : 128;
      if (nA < 128) tile_gload(tr, ks, 128, vst, T, 64 * nA, tid);
      if (nB < 128) tile_gload(trb, ks, 128, vst, T, 64 * nB, tid);
#pragma unroll
      for (int sub = 0; sub < 2; ++sub) {
      const int j = sub ? jB : jA;
      if (j >= 128) break;
      const lds_u8* stage = tiles + (2 * (it & 1) + sub) * TILE_STAGE;
      bool mine[4], need[4], anyneed = false;
#pragma unroll
      for (int ct = 0; ct < 4; ++ct) {
        mine[ct] = ((j < 64 ? (mlo[ct] >> j) : (mhi[ct] >> (j - 64))) & 1ull) != 0ull;
        need[ct] = __any(mine[ct]) != 0;
        anyneed = anyneed || need[ct];
      }
      if (anyneed) {
#pragma unroll
        for (int hf = 0; hf < 2; ++hf) {
          const int key0 = j * 64 + hf * 32;
          bf16x8 kf[2][2];
#pragma unroll
          for (int kt = 0; kt < 2; ++kt) {
            const lds_u8* kp = stage + (32 * hf + 8 * (r >> 2) + 4 * kt + (r & 3)) * TILE_ROWB + grp * 16;
#pragma unroll
            for (int dk = 0; dk < 2; ++dk) kf[kt][dk] = *(const __attribute__((address_space(3))) bf16x8*)(kp + dk * 64);
          }
          bf16x8 vfr[4];
          v_frags_lds<4>(stage, hf, vfr, lane);
#pragma unroll
          for (int ct = 0; ct < 4; ++ct) {
            if (need[ct]) {
              const float mv = mine[ct] ? 0.f : NEG_INF;
              f32x4 s0 = {mv, mv, mv, mv}, s1 = {mv, mv, mv, mv};
              s0 = mfma16(kf[0][0], qr[ct][0], s0);
              s1 = mfma16(kf[1][0], qr[ct][0], s1);
              s0 = mfma16(kf[0][1], qr[ct][1], s0);
              s1 = mfma16(kf[1][1], qr[ct][1], s1);
              if (j == cur) {
                const int tct = t0 + 4 * ct + qq;
#pragma unroll
                for (int i = 0; i < 4; ++i) {
                  s0[i] = (key0 + 8 * grp + i <= tct) ? s0[i] : NEG_INF;
                  s1[i] = (key0 + 8 * grp + 4 + i <= tct) ? s1[i] : NEG_INF;
                }
              }
              float mx = fmaxf(fmaxf(fmaxf(s0[0], s0[1]), fmaxf(s0[2], s0[3])), fmaxf(fmaxf(s1[0], s1[1]), fmaxf(s1[2], s1[3])));
              mx = grp_max4(mx);
              const float mnew = fmaxf(m[ct], mx);
              if (__any(mnew > m[ct])) {
                const float ms = (mnew == NEG_INF) ? 0.f : mnew;
                const float alpha = __builtin_amdgcn_exp2f(m[ct] - ms);
                m[ct] = mnew;
                lacc[ct] = lacc[ct] * alpha;
#pragma unroll
                for (int dt = 0; dt < 4; ++dt) o[dt][ct] = o[dt][ct] * alpha;
              }
              const float msafe = (m[ct] == NEG_INF) ? 0.f : m[ct];
              const f32x4 d0 = s0 - msafe, d1 = s1 - msafe;
              f32x4 p0, p1;
#pragma unroll
              for (int i = 0; i < 4; ++i) { p0[i] = __builtin_amdgcn_exp2f(d0[i]); p1[i] = __builtin_amdgcn_exp2f(d1[i]); }
              const bf16x8 pb = pack8(p0, p1);
              lacc[ct] = mfma16(ones, pb, lacc[ct]);
#pragma unroll
              for (int dt = 0; dt < 4; ++dt) o[dt][ct] = mfma16(vfr[dt], pb, o[dt][ct]);
            }
          }
        }
      }
      }
      if (nA < 128) tile_swrite(tr, tiles + (2 * ((it + 1) & 1)) * TILE_STAGE, tid);
      if (nB < 128) tile_swrite(trb, tiles + (2 * ((it + 1) & 1) + 1) * TILE_STAGE, tid);
      __syncthreads();
      jA = nA; jB = nB; ++it;
    }
    float* scr2 = scr + (size_t)2048 * 4096;
#pragma unroll
    for (int ct = 0; ct < 4; ++ct) {
      const size_t rowq = (size_t)b * T + t0 + 4 * ct + qq;
      const float sc = (lacc[ct][0] > 0.f ? 1.0f / lacc[ct][0] : 0.f) * WSP(float, OFF_GATE)[rowq * 24 + (g * 4 + hq) * 3 + 1];
#pragma unroll
      for (int dt = 0; dt < 4; ++dt)
        *(f32x4*)(scr2 + (hq * 16 + 4 * ct + qq) * 64 + 16 * dt + 4 * grp) = o[dt][ct] * sc;
    }
    asm volatile("s_waitcnt vmcnt(0)" ::: "memory");
    __builtin_amdgcn_fence(__ATOMIC_SEQ_CST, "workgroup");
  }
  {
    NSA_SECTION_VARS
    const int tid = (wave << 6) | lane;
    const bf16_t* kw = WSP(bf16_t, OFF_KW) + ((size_t)b * T) * 128 + g * 64;
    const bf16_t* vwt = WSP(bf16_t, OFF_VWT) + (size_t)((b * 2 + g) * 64) * T;
#pragma unroll
    for (int ct = 0; ct < 4; ++ct) { m[ct] = NEG_INF; lsum[ct] = 0.f; lacc[ct] = (f32x4){0.f, 0.f, 0.f, 0.f}; }
#pragma unroll
    for (int dt = 0; dt < 4; ++dt)
#pragma unroll
      for (int ct = 0; ct < 4; ++ct) o[dt][ct] = (f32x4){0.f, 0.f, 0.f, 0.f};
    int kstart = qi * 128 - 512;
    if (kstart < 0) kstart = 0;
    const int kend = qi * 128 + 64;
    bf16x8 qr[4][2];
#pragma unroll
    for (int ct = 0; ct < 4; ++ct)
#pragma unroll
      for (int dk = 0; dk < 2; ++dk)
        qr[ct][dk] = *(const bf16x8*)(WSP(bf16_t, OFF_QN) + row * 512 + (g * 4 + ct) * 64 + dk * 32 + grp * 8);
    TileRegs tr;
    int it = 0;
    tile_gload(tr, kw, 128, vwt, T, kstart, tid);
    tile_swrite(tr, tiles, tid);
    __syncthreads();
#pragma unroll 1
    for (int k0 = kstart; k0 <= kend; k0 += 64, ++it) {
      if (k0 + 64 <= kend) tile_gload(tr, kw, 128, vwt, T, k0 + 64, tid);
      const lds_u8* stage = tiles + (it & 1) * TILE_STAGE;
      if (k0 <= t0 + 15 && k0 + 63 + 512 > t0) {
#pragma unroll
        for (int hf = 0; hf < 2; ++hf) {
          const int key0 = k0 + hf * 32;
          f32x4 s[2][4];
          const f32x4 cz = {0.f, 0.f, 0.f, 0.f};
          qk_scores_lds<4, 2, false>(stage, hf, qr, s, lane, nullptr, cz, cz);
          if (!(k0 + 63 <= t0 && k0 + 512 > t0 + 15)) {
#pragma unroll
            for (int kt = 0; kt < 2; ++kt)
#pragma unroll
              for (int i = 0; i < 4; ++i) {
                const int key = key0 + 8 * grp + 4 * kt + i;
                const bool ok = (key <= t) && (key + 512 > t);
#pragma unroll
                for (int ct = 0; ct < 4; ++ct) s[kt][ct][i] = ok ? s[kt][ct][i] : NEG_INF;
              }
          }
          bf16x8 vfr[4];
          v_frags_lds<4>(stage, hf, vfr, lane);
          softmax_update<4, 4, true, false>(s, m, lsum, o, &lacc);
          pv_accum_lds<4, 4>(vfr, s, o, lane, lacc);
        }
      }
      if (k0 + 64 <= kend) tile_swrite(tr, tiles + ((it + 1) & 1) * TILE_STAGE, tid);
      __syncthreads();
    }
    float sc2[4];
#pragma unroll
    for (int ct = 0; ct < 4; ++ct) sc2[ct] = (lacc[ct][0] > 0.f ? 1.0f / lacc[ct][0] : 0.f) * gatep[ct * 3 + 2];
    bf16_t* oa = WSP(bf16_t, OFF_OA) + row * 512 + g * 256;
#pragma unroll
    for (int dt = 0; dt < 4; ++dt)
#pragma unroll
      for (int ct = 0; ct < 4; ++ct) {
        bf16_t* ptr = oa + ct * 64 + 16 * dt + 4 * grp;
        const u32x2 sw = *(const u32x2*)ptr;
        float val[4];
        const f32x4 sv = *(const f32x4*)(scr + (size_t)2048 * 4096 + (ct * 16 + r) * 64 + 16 * dt + 4 * grp);
#pragma unroll
        for (int i = 0; i < 4; ++i) val[i] = scr[((dt * 4 + ct) * 4 + i) * 64 + lane] + sv[i] + o[dt][ct][i] * sc2[ct];
        u32x2 w = {cvtpk(val[0] * bflo(sw[0]), val[1] * bfhi(sw[0])), cvtpk(val[2] * bflo(sw[1]), val[3] * bfhi(sw[1]))};
        if (st) *(u32x2*)ptr = w;
        asm volatile("" ::: "memory");
      }
  }
#undef NSA_SECTION_VARS
}

__device__ __forceinline__ void fox_wg_unit(const Params& p, int l, int b, int h, int qb, lds_u8* tiles, bool st) {
  kparams_t kp_ = kparams(); (void)kp_;
  const int tid = tidx();
  const int wave = __builtin_amdgcn_readfirstlane(tid >> 6);
  const int lane = tid & 63, r = lane & 15, grp = lane >> 4;
  const int t0 = qb * 512 + wave * 64;
  bf16x8 qf[4][2];
  const float* fc = WSP(float, OFF_FC) + (size_t)(b * 8 + h) * T;
#pragma unroll
  for (int ct = 0; ct < 4; ++ct) {
    const size_t row = (size_t)b * T + t0 + 16 * ct + r;
#pragma unroll
    for (int dk = 0; dk < 2; ++dk)
      qf[ct][dk] = *(const bf16x8*)(WSP(bf16_t, OFF_FQ) + row * 512 + h * 64 + dk * 32 + grp * 8);
  }
  const bf16_t* kb = WSP(bf16_t, OFF_FK) + ((size_t)b * T) * 512 + h * 64;
  const bf16_t* vt = WSP(bf16_t, OFF_FVT) + (size_t)((b * 8 + h) * 64) * T;
  f32x4 o[4][4];
  float m[4], lsum[4];
  f32x4 lacc[4];
#pragma unroll
  for (int ct = 0; ct < 4; ++ct) { m[ct] = NEG_INF; lsum[ct] = 0.f; lacc[ct] = (f32x4){0.f, 0.f, 0.f, 0.f}; }
#pragma unroll
  for (int dt = 0; dt < 4; ++dt)
#pragma unroll
    for (int ct = 0; ct < 4; ++ct) o[dt][ct] = (f32x4){0.f, 0.f, 0.f, 0.f};
  const int ntiles = (qb + 1) * 8;
  int it0, itw0;
  {
    float gq = fabsf(kp_->fox_q_norm[l * 64 + lane]), gk = fabsf(kp_->fox_k_norm[l * 64 + lane]);
#pragma unroll
    for (int o_ = 1; o_ < 64; o_ <<= 1) { gq = fmaxf(gq, __shfl_xor(gq, o_)); gk = fmaxf(gk, __shfl_xor(gk, o_)); }
    const float B2 = 16.0f * gq * gk * 1.02f + 104.0f;
    const float thr_wg = fc[qb * 512] + B2, thr_w = fc[t0] + B2;
    const float c0 = (lane < ntiles) ? fc[64 * lane + 63] : -3.0e38f;
    const float c1 = (lane + 64 < ntiles) ? fc[64 * (lane + 64) + 63] : -3.0e38f;
    it0 = __popcll(__ballot(c0 > thr_wg)) + __popcll(__ballot(c1 > thr_wg));
    itw0 = __popcll(__ballot(c0 > thr_w)) + __popcll(__ballot(c1 > thr_w));
    it0 = __builtin_amdgcn_readfirstlane(it0);
    itw0 = __builtin_amdgcn_readfirstlane(itw0);
  }
  TileRegs tr;
  float ckr = 0.f;
  tile_gload(tr, kb, 512, vt, T, it0 * 64, tid);
  if (tid < 64) ckr = fc[it0 * 64 + tid] * (-LOG2E);
  tile_swrite(tr, tiles, tid);
  if (tid < 64) *(__attribute__((address_space(3))) float*)(tiles + 2 * TILE_HALF + tid * 4) = ckr;
  __syncthreads();
#pragma unroll 1
  for (int it = it0; it < ntiles; ++it) {
    const int k0 = it * 64;
    if (it + 1 < ntiles) { tile_gload(tr, kb, 512, vt, T, k0 + 64, tid); if (tid < 64) ckr = fc[k0 + 64 + tid] * (-LOG2E); }
    const lds_u8* stage = tiles + ((it - it0) & 1) * TILE_STAGE;
    if (k0 <= t0 + 63 && it >= itw0) {
      const bool diag = (k0 + 63 > t0);
#pragma unroll
      for (int hf = 0; hf < 2; ++hf) {
        const int key0 = k0 + hf * 32;
        f32x4 s[2][4];
        const f32x4 ck0 = *(const __attribute__((address_space(3))) f32x4*)(stage + 2 * TILE_HALF + (32 * hf + 8 * grp) * 4);
        const f32x4 ck1 = *(const __attribute__((address_space(3))) f32x4*)(stage + 2 * TILE_HALF + (32 * hf + 8 * grp + 4) * 4);
        qk_scores_lds<4, 2, false>(stage, hf, qf, s, lane, nullptr, ck0, ck1);
        if (diag) {
#pragma unroll
          for (int kt = 0; kt < 2; ++kt)
#pragma unroll
            for (int i = 0; i < 4; ++i) {
              const int key = key0 + 8 * grp + 4 * kt + i;
#pragma unroll
              for (int ct = 0; ct < 4; ++ct) s[kt][ct][i] = (key <= t0 + 16 * ct + r) ? s[kt][ct][i] : NEG_INF;
            }
        }
        bf16x8 vfr[4];
        v_frags_lds<4>(stage, hf, vfr, lane);
        softmax_update<4, 4, true, false>(s, m, lsum, o, &lacc);
        pv_accum_lds<4, 4>(vfr, s, o, lane, lacc);
      }
    }
    if (it + 1 < ntiles) {
      tile_swrite(tr, tiles + ((it - it0 + 1) & 1) * TILE_STAGE, tid);
      if (tid < 64) *(__attribute__((address_space(3))) float*)(tiles + ((it - it0 + 1) & 1) * TILE_STAGE + 2 * TILE_HALF + tid * 4) = ckr;
    }
    __syncthreads();
  }
  float invl[4];
#pragma unroll
  for (int ct = 0; ct < 4; ++ct) invl[ct] = lacc[ct][0] > 0.f ? 1.0f / lacc[ct][0] : 0.f;
#pragma unroll
  for (int ct = 0; ct < 4; ++ct) {
    bf16_t* ob = WSP(bf16_t, OFF_OB) + ((size_t)b * T + t0 + 16 * ct + r) * 512 + h * 64;
#pragma unroll
    for (int dt = 0; dt < 4; ++dt) {
      bf16_t* ptr = ob + 16 * dt + 4 * grp;
      const u32x2 sw = *(const u32x2*)ptr;
      const f32x4 v = o[dt][ct] * invl[ct];
      u32x2 w = {cvtpk(v[0] * bflo(sw[0]), v[1] * bfhi(sw[0])), cvtpk(v[2] * bflo(sw[1]), v[3] * bfhi(sw[1]))};
      if (st) *(u32x2*)ptr = w;
    }
  }
}

constexpr int MT_KPITCH = 272, MT_VOFF = 64 * MT_KPITCH, MT_STAGE = MT_VOFF + 128 * TILE_ROWB;
struct MemTileRegs { u32x4 k0, k1, v0, v1; };
__device__ __forceinline__ void mem_tile_gload(MemTileRegs& tr, const bf16_t* __restrict__ kb, const bf16_t* __restrict__ vt, int key0, int tid) {
  const int row = tid >> 3, ch = tid & 7;
  tr.k0 = *(const u32x4*)(kb + (size_t)(key0 + row) * 512 + ch * 8);
  tr.k1 = *(const u32x4*)(kb + (size_t)(key0 + row) * 512 + 64 + ch * 8);
  tr.v0 = *(const u32x4*)(vt + (size_t)row * 256 + key0 + ch * 8);
  tr.v1 = *(const u32x4*)(vt + (size_t)(row + 64) * 256 + key0 + ch * 8);
}
__device__ __forceinline__ void mem_tile_swrite(const MemTileRegs& tr, lds_u8* stage, int tid) {
  const int row = tid >> 3, ch = tid & 7;
  *(__attribute__((address_space(3))) u32x4*)(stage + row * MT_KPITCH + ch * 16) = tr.k0;
  *(__attribute__((address_space(3))) u32x4*)(stage + row * MT_KPITCH + 128 + ch * 16) = tr.k1;
  *(__attribute__((address_space(3))) u32x4*)(stage + MT_VOFF + row * TILE_ROWB + ch * 16) = tr.v0;
  *(__attribute__((address_space(3))) u32x4*)(stage + MT_VOFF + (row + 64) * TILE_ROWB + ch * 16) = tr.v1;
}
__device__ __forceinline__ void mem_wg_unit(const Params& p, int l, int b, int h, int qblk, lds_u8* tiles, bool st) {
  kparams_t kp_ = kparams(); (void)kp_;
  const int tid = tidx();
  const int wave = __builtin_amdgcn_readfirstlane(tid >> 6);
  const int lane = tid & 63, r = lane & 15, grp = lane >> 4;
  const int t0 = 256 * qblk + 32 * wave;
  const float SC = 0.08838834764831845f * LOG2E;
  const bf16_t* kb = WSP(bf16_t, OFF_MK) + ((size_t)b * 256) * 512 + h * 128;
  const bf16_t* vt = WSP(bf16_t, OFF_MVT) + (size_t)((b * 4 + h) * 128) * 256;
  MemTileRegs tr;
  mem_tile_gload(tr, kb, vt, 0, tid);
  bf16x8 qf[2][4];
  const float* gq = kp_->mem_q_norm + l * 128;
#pragma unroll
  for (int ct = 0; ct < 2; ++ct) {
    const size_t row = (size_t)b * T + t0 + 16 * ct + r;
    float v[4][8];
    float ss = 0.f;
#pragma unroll
    for (int dk = 0; dk < 4; ++dk) {
      const u32x4 w = *(const u32x4*)(WSP(bf16_t, OFF_MQ) + row * 512 + h * 128 + dk * 32 + grp * 8);
#pragma unroll
      for (int j = 0; j < 4; ++j) { v[dk][2 * j] = bflo(w[j]); v[dk][2 * j + 1] = bfhi(w[j]); }
#pragma unroll
      for (int j = 0; j < 8; ++j) ss += v[dk][j] * v[dk][j];
    }
    ss += __shfl_xor(ss, 16);
    ss += __shfl_xor(ss, 32);
    const float rstd = rsqrtf(ss * (1.0f / 128.0f) + EPS) * SC;
#pragma unroll
    for (int dk = 0; dk < 4; ++dk) {
      const f32x4 g0 = *(const f32x4*)(gq + dk * 32 + grp * 8), g1 = *(const f32x4*)(gq + dk * 32 + grp * 8 + 4);
      u32x4 w = {cvtpk(v[dk][0] * rstd * g0[0], v[dk][1] * rstd * g0[1]), cvtpk(v[dk][2] * rstd * g0[2], v[dk][3] * rstd * g0[3]),
                 cvtpk(v[dk][4] * rstd * g1[0], v[dk][5] * rstd * g1[1]), cvtpk(v[dk][6] * rstd * g1[2], v[dk][7] * rstd * g1[3])};
      qf[ct][dk] = __builtin_bit_cast(bf16x8, w);
    }
  }
  f32x4 o[8][2];
  f32x4 lacc[2];
  float m[2], lsum[2];
#pragma unroll
  for (int ct = 0; ct < 2; ++ct) { m[ct] = NEG_INF; lsum[ct] = 0.f; lacc[ct] = (f32x4){0.f, 0.f, 0.f, 0.f}; }
#pragma unroll
  for (int dt = 0; dt < 8; ++dt)
#pragma unroll
    for (int ct = 0; ct < 2; ++ct) o[dt][ct] = (f32x4){0.f, 0.f, 0.f, 0.f};
  mem_tile_swrite(tr, tiles, tid);
  __syncthreads();
#pragma unroll 1
  for (int it = 0; it < 4; ++it) {
    if (it + 1 < 4) mem_tile_gload(tr, kb, vt, 64 * (it + 1), tid);
    const lds_u8* stage = tiles + (it & 1) * MT_STAGE;
#pragma unroll
    for (int hf = 0; hf < 2; ++hf) {
      f32x4 s[2][2];
#pragma unroll
      for (int kt = 0; kt < 2; ++kt) {
        const lds_u8* kp = stage + (32 * hf + 8 * (r >> 2) + 4 * kt + (r & 3)) * MT_KPITCH + grp * 16;
        bf16x8 kf[4];
#pragma unroll
        for (int dk = 0; dk < 4; ++dk) kf[dk] = *(const __attribute__((address_space(3))) bf16x8*)(kp + dk * 64);
#pragma unroll
        for (int ct = 0; ct < 2; ++ct) {
          f32x4 a = {0.f, 0.f, 0.f, 0.f};
#pragma unroll
          for (int dk = 0; dk < 4; ++dk) a = mfma16(kf[dk], qf[ct][dk], a);
          s[kt][ct] = a;
        }
      }
      bf16x8 vfr[8];
      v_frags_lds<8>(stage + (MT_VOFF - TILE_HALF), hf, vfr, lane);
      softmax_update<2, 8, true, false>(s, m, lsum, o, &lacc);
      pv_accum_lds<2, 8>(vfr, s, o, lane, lacc);
    }
    if (it + 1 < 4) mem_tile_swrite(tr, tiles + ((it + 1) & 1) * MT_STAGE, tid);
    __syncthreads();
  }
#pragma unroll
  for (int ct = 0; ct < 2; ++ct) {
    const float invl = lacc[ct][0] > 0.f ? 1.0f / lacc[ct][0] : 0.f;
    bf16_t* om = WSP(bf16_t, OFF_OM) + ((size_t)b * T + t0 + 16 * ct + r) * 512 + h * 128;
#pragma unroll
    for (int dt = 0; dt < 8; ++dt) {
      bf16_t* ptr = om + 16 * dt + 4 * grp;
      const u32x2 sw = *(const u32x2*)ptr;
      const f32x4 v = o[dt][ct] * invl;
      u32x2 w = {cvtpk(v[0] * bflo(sw[0]), v[1] * bfhi(sw[0])), cvtpk(v[2] * bflo(sw[1]), v[3] * bfhi(sw[1]))};
      if (st) *(u32x2*)ptr = w;
    }
  }
}

__device__ __forceinline__ void phase_attn(const Params& p, int l, unsigned char* ldsraw, bool st, int cidx) {
  kparams_t kp_ = kparams(); (void)kp_;
  const int tid = tidx();
  const int wave = __builtin_amdgcn_readfirstlane(tid >> 6);
  float* imp = (float*)ldsraw + wave * 2112;
  lds_u8* tiles = (lds_u8*)ldsraw;
  bf16x8* qlds = (bf16x8*)(ldsraw + 69632 + wave * 8192);
  unsigned* misc = (unsigned*)(ldsraw + 135168);
  float* scr = WSP(float, OFF_SCR) + (size_t)(bidx() * NWAVES + wave) * 4096;
  const int myx = (int)(xb_xcc_id() & 7u);
  constexpr int QUNITS = 192;
  for (int qq = 0; qq < 8; ++qq) {
    const int x = (myx + qq) & 7;
    unsigned* ctr = WSP(unsigned, OFF_CTL) + cidx * 8 + x;
    for (;;) {
      __syncthreads();
      if (tid == 0) misc[0] = atomicAdd(ctr, 1u);
      if (tid >= 4 && tid < 8) misc[tid] = 0u;
      __syncthreads();
      const int u = __builtin_amdgcn_readfirstlane((int)misc[0]);
      if (u >= QUNITS) break;
      if (u < 64) {
        nsa_wg_unit(p, x >> 1, x & 1, 63 - u, imp, qlds, scr, tiles, misc, st);
      } else if (u < 128) {
        const int v_ = u - 64, bh = 4 * x + (v_ >> 4);
        fox_wg_unit(p, l, bh >> 3, bh & 7, 15 - (v_ & 15), tiles, st);
      } else {
        const int mu = u - 128, bh = 2 * x + (mu >> 5), qblk = mu & 31;
        mem_wg_unit(p, l, bh >> 2, bh & 3, qblk, tiles, st);
      }
    }
  }
}

__global__ void __launch_bounds__(NTHREADS) hybrid_megakernel(Params p) {
  kparams_t kp_ = kparams();
  cg::grid_group grid = cg::this_grid();
  extern __shared__ __attribute__((aligned(16))) unsigned char dynlds[];
  float* smem = (float*)dynlds;
  PG8_LAS unsigned char* glds = (PG8_LAS unsigned char*)dynlds;
  volatile LAS unsigned* bst = (volatile LAS unsigned*)(glds + 135168 + 64);
  if (threadIdx.x < 2) bst[threadIdx.x] = 0u;
  __syncthreads();
  grid.sync();
  const XcdBarrier xbar = xcd_barrier_post(WSP(unsigned, OFF_BAR), bst);
#pragma unroll 1
  for (int ph = 0; ph < 28; ++ph) {
    const int l = ph / 7, k = ph - 7 * l;
    if (k == 0) {
      phase_prep(p, l, smem);
    } else if (k == 1) {
      if (bidx() == gdim() - 1 && tidx() < 256) {
        const int t_ = tidx();
        const float* part = WSP(float, OFF_C1) + (size_t)(t_ >> 7) * 16 * 128 + (t_ & 127);
        float pv_[16];
#pragma unroll
        for (int ch = 0; ch < 16; ++ch) pv_[ch] = part[ch * 128];
        float s_ = 0.f;
#pragma unroll
        for (int ch = 0; ch < 16; ++ch) s_ += pv_[ch];
        WSP(float, OFF_C1 + 16384)[t_] = s_;
      }
      EpiIn E{&p, l};
      run_gemm(glds, WSP(bf16_t, OFF_H), WSP(bf16_t, OFF_W_IN), M, 5120, 1024, E);
      EpiMemKV E2{&p};
      run_gemm(glds, WSP(bf16_t, OFF_MEMN), WSP(bf16_t, OFF_W_MKV), 1024, 1024, 1024, E2);
    } else if (k == 2) {
      phase_mid(p, l, smem);
    } else if (k == 3) {
      phase_attn(p, l, dynlds, true, l);
    } else if (k == 4) {
      EpiGate E{WSP(bf16_t, OFF_G)};
      run_gemm(glds, WSP(bf16_t, OFF_H), WSP(bf16_t, OFF_W_G), M, 3072, 1024, E);
    } else if (k == 5) {
      EpiBranch Ea{WSP(bf16_t, OFF_G), WSP(bf16_t, OFF_U), 1};
      run_gemm(glds, WSP(bf16_t, OFF_OA), WSP(bf16_t, OFF_W_BR), M, 1024, 512, Ea);
      EpiBranch Eb{WSP(bf16_t, OFF_G) + (size_t)M * 1024, WSP(bf16_t, OFF_U), 0};
      run_gemm(glds, WSP(bf16_t, OFF_OB), WSP(bf16_t, OFF_W_BR + MiB), M, 1024, 512, Eb);
      EpiBranch Ec{WSP(bf16_t, OFF_G) + (size_t)2 * M * 1024, WSP(bf16_t, OFF_U), 0};
      run_gemm(glds, WSP(bf16_t, OFF_OM), WSP(bf16_t, OFF_W_BR + 2 * MiB), M, 1024, 512, Ec);
    } else {
      EpiOut E{l == 0 ? kp_->x : kp_->out, kp_->out};
      run_gemm(glds, WSP(bf16_t, OFF_U), WSP(bf16_t, OFF_W_OUT), M, 1024, 1024, E);
    }
    xcd_barrier(xbar);
  }
}

extern "C" void kernel_launch(void* const* d_in, const int* in_sizes, int n_in, void* d_out, int out_size, void* d_ws,
                              size_t ws_size, hipStream_t stream) {
  static int grid_blocks = 0;
  if (!grid_blocks) {
    int dev = 0, cus = 0, per_cu = 0;
    (void)hipGetDevice(&dev);
    (void)hipDeviceGetAttribute(&cus, hipDeviceAttributeMultiprocessorCount, dev);
    if (hipFuncSetAttribute((const void*)hybrid_megakernel, hipFuncAttributeMaxDynamicSharedMemorySize, LDS_BYTES) != hipSuccess)
      fprintf(stderr, "hipFuncSetAttribute(dynamic LDS %d) failed\n", LDS_BYTES);
    (void)hipOccupancyMaxActiveBlocksPerMultiprocessor(&per_cu, hybrid_megakernel, NTHREADS, LDS_BYTES);
    (void)hipGetLastError();
    grid_blocks = cus;
    if (grid_blocks > 256) grid_blocks = 256;
    if (ws_size < OFF_SCR + (size_t)64 * MiB) fprintf(stderr, "workspace too small: %zu\n", ws_size);
  }
  Params p{};
  const float** pp = (const float**)&p;
  for (int i = 0; i < 23; ++i) pp[i] = (const float*)d_in[i];
  p.out = (float*)d_out;
  p.ws = (char*)d_ws;
  void* args[] = {&p};
  (void)hipMemsetAsync((char*)d_ws + OFF_BAR, 0, XCD_BAR_WORDS * sizeof(unsigned), stream);
  hipError_t e = hipLaunchCooperativeKernel((void*)hybrid_megakernel, dim3(grid_blocks), dim3(NTHREADS), args, LDS_BYTES, stream);
  if (e != hipSuccess) fprintf(stderr, "cooperative launch failed: %s (grid %d)\n", hipGetErrorString(e), grid_blocks);
}
```

```cpp
#include <hip/hip_runtime.h>
#include <hip/hip_cooperative_groups.h>
#include <stdint.h>
#include <cstdio>
namespace cg = cooperative_groups;
typedef unsigned short bf16_t;
typedef short bf16x8 __attribute__((ext_vector_type(8)));
typedef float f32x4 __attribute__((ext_vector_type(4)));
typedef unsigned u32x2 __attribute__((ext_vector_type(2)));
typedef unsigned u32x4 __attribute__((ext_vector_type(4)));
typedef float f32x2_t __attribute__((ext_vector_type(2)));
typedef __bf16 bf16x2_t __attribute__((ext_vector_type(2)));

constexpr int NB = 4, T = 8192, M = NB * T;
constexpr int NTHREADS = 512, NWAVES = NTHREADS / 64;
constexpr int LDS_BYTES = 147456;
constexpr float EPS = 1e-6f;
constexpr float LOG2E = 1.4426950408889634f;
#define NEG_INF (-__builtin_inff())

constexpr size_t MiB = 1u << 20;
constexpr size_t OFF_CTL = 0;
constexpr size_t OFF_BAR = 64 * 1024;
constexpr size_t OFF_ROPE = 1 * MiB;
constexpr size_t OFF_W_IN = 3 * MiB;
constexpr size_t OFF_W_G = 13 * MiB;
constexpr size_t OFF_W_MKV = 19 * MiB;
constexpr size_t OFF_W_BR = 21 * MiB;
constexpr size_t OFF_W_OUT = 24 * MiB;
constexpr size_t OFF_W1 = 26 * MiB;
constexpr size_t OFF_W2 = 27 * MiB;
constexpr size_t OFF_C1 = 27 * MiB + 256 * 1024;
constexpr size_t OFF_MEMN = 28 * MiB;
constexpr size_t OFF_MK = 30 * MiB;
constexpr size_t OFF_MVT = 31 * MiB;
constexpr size_t OFF_H = 32 * MiB;
constexpr size_t OFF_U = OFF_H;
constexpr size_t OFF_OA = 96 * MiB;
constexpr size_t OFF_OB = 128 * MiB;
constexpr size_t OFF_OM = 160 * MiB;
constexpr size_t OFF_QN = 192 * MiB;
constexpr size_t OFF_G = 192 * MiB;
constexpr size_t OFF_KC = 224 * MiB;
constexpr size_t OFF_VC = 232 * MiB;
constexpr size_t OFF_KS = 240 * MiB;
constexpr size_t OFF_VST = 248 * MiB;
constexpr size_t OFF_KW = 256 * MiB;
constexpr size_t OFF_VWT = 264 * MiB;
constexpr size_t OFF_FQ = 272 * MiB;
constexpr size_t OFF_FK = 304 * MiB;
constexpr size_t OFF_FVT = 336 * MiB;
constexpr size_t OFF_MQ = 368 * MiB;
constexpr size_t OFF_GATE = 400 * MiB;
constexpr size_t OFF_FLOG = 403 * MiB;
constexpr size_t OFF_FC = 404 * MiB;
constexpr size_t OFF_KCMP = 405 * MiB;
constexpr size_t OFF_VCT = 405 * MiB + 512 * 1024;
constexpr size_t OFF_SCR = 406 * MiB;

struct Params {
  const float *x, *mem, *norm_g, *mem_norm_g, *w_in, *nsa_q_norm, *nsa_k_norm, *cmp_pe_k, *cmp_w1_k, *cmp_w2_k,
      *cmp_pe_v, *cmp_w1_v, *cmp_w2_v, *fox_q_norm, *fox_k_norm, *fox_f_bias, *mem_q_norm, *mem_k_norm, *w_mem_kv,
      *w_branch_a, *w_branch_b, *w_branch_m, *w_out;
  float* out;
  char* ws;
};
__device__ __forceinline__ char* ws_base(char* w) {
  unsigned lo = __builtin_amdgcn_readfirstlane((unsigned)(uintptr_t)w), hi = __builtin_amdgcn_readfirstlane((unsigned)((uintptr_t)w >> 32));
  asm volatile("" : "+s"(lo), "+s"(hi));
  return (char*)(__attribute__((address_space(1))) char*)(((uintptr_t)hi << 32) | (uintptr_t)lo);
}
typedef const __attribute__((address_space(4))) Params* kparams_t;
__device__ __forceinline__ kparams_t kparams() { kparams_t kp = (kparams_t)__builtin_amdgcn_kernarg_segment_ptr(); asm volatile("" : "+s"(kp)); return kp; }
#define WSP(TYPE, off) ((TYPE*)(ws_base(kp_->ws) + (off)))

__constant__ float c_inv_freq[32] = {
    1.000000000e+00f, 7.498942018e-01f, 5.623413324e-01f, 4.216965139e-01f, 3.162277639e-01f, 2.371373773e-01f,
    1.778279394e-01f, 1.333521456e-01f, 1.000000015e-01f, 7.498942316e-02f, 5.623413250e-02f, 4.216964915e-02f,
    3.162277490e-02f, 2.371373773e-02f, 1.778279431e-02f, 1.333521400e-02f, 9.999999776e-03f, 7.498942316e-03f,
    5.623413250e-03f, 4.216964822e-03f, 3.162277630e-03f, 2.371373819e-03f, 1.778279431e-03f, 1.333521446e-03f,
    1.000000047e-03f, 7.498941850e-04f, 5.623413017e-04f, 4.216965172e-04f, 3.162277571e-04f, 2.371373703e-04f,
    1.778279402e-04f, 1.333521504e-04f};

__device__ __forceinline__ int bidx() { int b = blockIdx.x; asm volatile("" : "+s"(b)); return b; }
__device__ __forceinline__ int gdim() { int g = gridDim.x; asm volatile("" : "+s"(g)); return g; }
__device__ __forceinline__ int tidx() { int t = threadIdx.x; asm volatile("" : "+v"(t)); return t; }
__device__ __forceinline__ unsigned cvtpk(float lo, float hi) {
  f32x2_t v = {lo, hi};
  bf16x2_t b = __builtin_convertvector(v, bf16x2_t);
  return __builtin_bit_cast(unsigned, b);
}
__device__ __forceinline__ float bf2f(unsigned short v) { return __uint_as_float(((unsigned)v) << 16); }
__device__ __forceinline__ float bflo(unsigned w) { return __uint_as_float(w << 16); }
__device__ __forceinline__ float bfhi(unsigned w) { return __uint_as_float(w & 0xffff0000u); }
__device__ __forceinline__ f32x4 mfma16(bf16x8 a, bf16x8 b, f32x4 c) {
  return __builtin_amdgcn_mfma_f32_16x16x32_bf16(a, b, c, 0, 0, 0);
}
__device__ __forceinline__ bf16x8 pack8(f32x4 a, f32x4 b) {
  u32x4 w = {cvtpk(a[0], a[1]), cvtpk(a[2], a[3]), cvtpk(b[0], b[1]), cvtpk(b[2], b[3])};
  return __builtin_bit_cast(bf16x8, w);
}
__device__ __forceinline__ float sigmoidf_(float v) { return __builtin_amdgcn_rcpf(1.0f + __builtin_amdgcn_exp2f(-LOG2E * v)); }
__device__ __forceinline__ float siluf_(float v) { return v * __builtin_amdgcn_rcpf(1.0f + __builtin_amdgcn_exp2f(-LOG2E * v)); }
__device__ __forceinline__ float grp_max4(float v) {
  auto a = __builtin_amdgcn_permlane32_swap(__float_as_uint(v), __float_as_uint(v), false, false);
  v = fmaxf(__uint_as_float(a[0]), __uint_as_float(a[1]));
  auto b = __builtin_amdgcn_permlane16_swap(__float_as_uint(v), __float_as_uint(v), false, false);
  return fmaxf(__uint_as_float(b[0]), __uint_as_float(b[1]));
}
__device__ __forceinline__ float wave_sum(float v) {
#pragma unroll
  for (int o = 1; o < 64; o <<= 1) v += __shfl_xor(v, o);
  return v;
}

#define LAS __attribute__((address_space(3)))
#define XB_TMO      128
#define XB_XCNT(j)  (256  + 64 * (j))
#define XB_XSUB(j)  (1280 + 64 * (j))
#define XB_XGEN(j)  (2304 + 64 * (j))
#define XB_TOP      3328
#define XB_TOPGEN   3392
#define XCD_BAR_WORDS 3456
#define XB_SPIN_CAP (1u << 18)

__device__ __forceinline__ unsigned xb_ld(unsigned* p)              { return __hip_atomic_load(p, __ATOMIC_RELAXED, __HIP_MEMORY_SCOPE_AGENT); }
__device__ __forceinline__ unsigned xb_add(unsigned* p, unsigned v) { return __hip_atomic_fetch_add(p, v, __ATOMIC_RELAXED, __HIP_MEMORY_SCOPE_AGENT); }
__device__ __forceinline__ unsigned xb_xcc_id() { return (unsigned)__builtin_amdgcn_s_getreg((3 << 11) | 20) & 0xFu; }
#define XB_SPIN(cond, bar) do { unsigned _sp = 0; while (cond) { __builtin_amdgcn_s_sleep(1); \
    if ((++_sp & 255u) == 0u) { if (xb_ld(&(bar)[XB_TMO])) break; if (_sp > XB_SPIN_CAP) { atomicAdd(&(bar)[XB_TMO], 1u); break; } } } } while (0)

struct XcdBarrier {
    unsigned* bar; unsigned x;
    volatile LAS unsigned* st;
};

__device__ __forceinline__ XcdBarrier xcd_barrier_post(unsigned* bar, volatile LAS unsigned* st) {
    XcdBarrier b; b.bar = bar; b.x = xb_xcc_id(); b.st = st;
    if (threadIdx.x == 0) (void)xb_add(&bar[XB_XCNT(b.x)], 1u);
    return b;
}
__device__ __forceinline__ void xcd_barrier_complete(unsigned* bar, unsigned x, unsigned& nloc, unsigned& nx) {
    const unsigned G = gridDim.x * gridDim.y * gridDim.z;
    unsigned sum, cnt, mine, sp = 0u;
    for (;;) {
        sum = 0u; cnt = 0u; mine = 0u;
#pragma unroll
        for (unsigned j = 0; j < 16; ++j) { const unsigned c = xb_ld(&bar[XB_XCNT(j)]); sum += c; cnt += (c > 0u) ? 1u : 0u; mine = (j == x) ? c : mine; }
        if (sum == G) break;
        __builtin_amdgcn_s_sleep(1);
        if ((++sp & 255u) == 0u) { if (xb_ld(&bar[XB_TMO])) break; if (sp > XB_SPIN_CAP) { atomicAdd(&bar[XB_TMO], 1u); break; } }
    }
    nloc = mine > 0u ? mine : 1u; nx = cnt > 0u ? cnt : 1u;
}

__device__ __forceinline__ void xcd_barrier(const XcdBarrier& b) {
    asm volatile("s_waitcnt vmcnt(0)" ::: "memory");
    __syncthreads();
    if (threadIdx.x == 0) {
        unsigned* bar = b.bar;
        __builtin_amdgcn_s_waitcnt(0);
        unsigned nloc = b.st[0], nx = b.st[1];
        if (nloc == 0u) { xcd_barrier_complete(bar, b.x, nloc, nx); b.st[0] = nloc; b.st[1] = nx; }
        const unsigned old = xb_add(&bar[XB_XSUB(b.x)], 1u);
        const unsigned gen = old / nloc;
        if (old + 1u == (gen + 1u) * nloc) {
            __builtin_amdgcn_fence(__ATOMIC_RELEASE, "agent");
            asm volatile("s_waitcnt vmcnt(0)" ::: "memory");
            const unsigned og = xb_add(&bar[XB_TOP], 1u);
            const unsigned tg = og / nx;
            if (og + 1u == (tg + 1u) * nx) xb_add(&bar[XB_TOPGEN], 1u);
            else XB_SPIN(xb_ld(&bar[XB_TOPGEN]) == tg, bar);
            __builtin_amdgcn_fence(__ATOMIC_ACQUIRE, "agent");
            xb_add(&bar[XB_XGEN(b.x)], 1u);
            asm volatile("s_waitcnt vmcnt(0)" ::: "memory");
        } else {
            XB_SPIN(xb_ld(&bar[XB_XGEN(b.x)]) == gen, bar);
            __builtin_amdgcn_fence(__ATOMIC_ACQUIRE, "agent");
            asm volatile("s_waitcnt vmcnt(0)" ::: "memory");
        }
    }
    __syncthreads();
}


namespace pg8 {
#define PG8_LAS __attribute__((address_space(3)))
typedef unsigned short bf16_t;
typedef short bf16x8 __attribute__((ext_vector_type(8)));
typedef float f32x4 __attribute__((ext_vector_type(4)));
typedef unsigned u32x4 __attribute__((ext_vector_type(4)));
constexpr int BM = 256, BK = 64, HALF = 128, HTB = HALF * BK * 2  , STAGE_BYTES = 8 * HTB, NXCD = 8, WGM = 8;

__host__ __device__ __forceinline__ int lds_byte(int r, int c) { const int st = (r >> 4) * 2 + (c >> 5), rr = r & 15, cc = c & 31, ob = rr * 64 + cc * 2; return st * 1024 + (ob ^ (((ob >> 9) & 1) << 5)); }
__host__ __device__ __forceinline__ void stage_rc(int b, int& R, int& C) { const int st = b / 1024, sb = b % 1024, swz = sb ^ (((sb >> 9) & 1) << 5); R = (st >> 1) * 16 + swz / 64; C = (st & 1) * 32 + (swz % 64) / 2; }
__host__ __device__ __forceinline__ int perm32(int rho) { const int n = rho >> 4, i = rho & 15; return 8 * (i >> 2) + 4 * n + (i & 3); }

struct Unit { int pm, pn; };
struct Gemm { const bf16_t* A; const bf16_t* Bt; int M, N, K; };

struct StaticOrder {
    int nM, nN, nwg, G, c;
    __host__ __device__ void init(int M, int N, int G_, int c_) { nM = M / BM; nN = N / BM; nwg = nM * nN; G = G_; c = c_; }
    __host__ __device__ bool next(int i, Unit& u) const {
        const long L = (long)i * G + c; if (L >= nwg) return false;
        int wgid = (int)L; { const int q = nwg / NXCD, r = nwg % NXCD, xcd = wgid % NXCD, off = wgid / NXCD; wgid = (xcd < r ? xcd * (q + 1) : r * (q + 1) + (xcd - r) * q) + off; }
        const int nig = WGM * nN, gid = wgid / nig, fm = gid * WGM, gsz = (nM - fm) < WGM ? (nM - fm) : WGM;
        u.pm = fm + ((wgid % nig) % gsz); u.pn = (wgid % nig) / gsz; return true;
    }
    __device__ __forceinline__ void a_ready(const Unit&) const {}
    __device__ __forceinline__ void done(const Unit&) const {}
};
__device__ __forceinline__ unsigned cvt_pk_bf16(float lo, float hi) { unsigned r; asm volatile("v_cvt_pk_bf16_f32 %0, %1, %2" : "=v"(r) : "v"(lo), "v"(hi)); return r; }
template <class Epi, class Sched, bool ALIGN_EPI = false, bool SP2 = false>
__device__ __forceinline__ void gemm_phase(PG8_LAS unsigned char* lds, const Gemm g, const Sched& S, const Epi& E) {
    const int tid = tidx(), wid = __builtin_amdgcn_readfirstlane(tid >> 6), lane = tid & 63, wr = wid >> 2, wc = wid & 3, fr = lane & 15, fq = lane >> 4;
    const int K = g.K, nt = K / BK;
    unsigned voffA[2], voffB[2];
#pragma unroll
    for (int i = 0; i < 2; ++i) { int R, C; stage_rc(tid * 16 + i * 8192, R, C); const int Rb = Epi::PERM ? ((R & ~31) + perm32(R & 31)) : R;
        voffA[i] = (unsigned)(R * K + C) * 2u; voffB[i] = (unsigned)(Rb * K + C) * 2u; }
    const size_t kstep = (size_t)(BK * 2);
    const size_t hstep = (size_t)HALF * K * 2;
    const size_t tstep = 2 * hstep;
    const unsigned ldsw = (unsigned)wid * 1024u;
    const int aoff = lds_byte(wr * 64 + fr, fq * 8), boff = lds_byte(wc * 32 + fr, fq * 8);
#define PG8_SA(b, h) (((b) * 2 + (h)) * HTB)
#define PG8_SB(b, h) ((4 + (b) * 2 + (h)) * HTB)
#define PG8_STAGE(bufoff, gbase, voff) do { _Pragma("unroll") for (int _i = 0; _i < 2; ++_i) \
        __builtin_amdgcn_global_load_lds((const unsigned*)((const char*)(gbase) + (voff)[_i]), (PG8_LAS unsigned*)(lds + (bufoff) + ldsw + _i * 8192), 16, 0, 0); } while (0)
#define PG8_LDA(dst, b, h) do { _Pragma("unroll") for (int m = 0; m < 4; ++m) _Pragma("unroll") for (int k = 0; k < 2; ++k) dst[m][k] = *(const PG8_LAS bf16x8*)(lds + PG8_SA(b, h) + aoff + m * 2048 + k * 1024); } while (0)
#define PG8_LDB(dst, b, h) do { _Pragma("unroll") for (int n = 0; n < 2; ++n) _Pragma("unroll") for (int k = 0; k < 2; ++k) dst[n][k] = *(const PG8_LAS bf16x8*)(lds + PG8_SB(b, h) + boff + n * 2048 + k * 1024); } while (0)
#define PG8_MMA(ai, bj, At, Bt) do { __builtin_amdgcn_s_setprio(1); _Pragma("unroll") for (int m = 0; m < 4; ++m) _Pragma("unroll") for (int n = 0; n < 2; ++n) _Pragma("unroll") for (int k = 0; k < 2; ++k) \
        acc[ai][bj][m][n] = __builtin_amdgcn_mfma_f32_16x16x32_bf16(Bt[n][k], At[m][k], acc[ai][bj][m][n], 0, 0, 0); __builtin_amdgcn_s_setprio(0); } while (0)
#define PG8_WAIT_V(n) asm volatile("s_waitcnt vmcnt(" #n ")" ::: "memory")
#define PG8_WAIT_L(n) asm volatile("s_waitcnt lgkmcnt(" #n ")" ::: "memory")
#define PG8_BAR __builtin_amdgcn_s_barrier()
#define PG8_SCHED __builtin_amdgcn_sched_barrier(0)
    Unit cur, nxt; int ui = 0;
    if (!S.next(0, cur)) return;
    f32x4 acc[2][2][4][2];
#pragma unroll
    for (int a = 0; a < 2; ++a)
#pragma unroll
        for (int b = 0; b < 2; ++b)
#pragma unroll
            for (int m = 0; m < 4; ++m)
#pragma unroll
                for (int n = 0; n < 2; ++n) acc[a][b][m][n] = (f32x4){0.f, 0.f, 0.f, 0.f};
    bf16x8 At[4][2], B0[2][2], B1[2][2];
    const char* cA = (const char*)g.A + (size_t)cur.pm * tstep; const char* cB = (const char*)g.Bt + (size_t)cur.pn * tstep;
    S.a_ready(cur);
    if constexpr (SP2) {
        PG8_STAGE(PG8_SB(0, 0), cB, voffB); PG8_STAGE(PG8_SB(0, 1), cB + hstep, voffB); PG8_STAGE(PG8_SA(0, 0), cA, voffA); PG8_STAGE(PG8_SA(0, 1), cA + hstep, voffA);
        if (wr == 1) PG8_BAR;
        PG8_WAIT_V(2); PG8_BAR;
        PG8_STAGE(PG8_SB(1, 0), cB + kstep, voffB); PG8_STAGE(PG8_SA(1, 0), cA + kstep, voffA); PG8_STAGE(PG8_SB(1, 1), cB + hstep + kstep, voffB);
        PG8_WAIT_V(6); PG8_BAR;
    } else {
        PG8_STAGE(PG8_SB(0, 0), cB, voffB); PG8_STAGE(PG8_SA(0, 0), cA, voffA); PG8_STAGE(PG8_SB(0, 1), cB + hstep, voffB); PG8_STAGE(PG8_SA(0, 1), cA + hstep, voffA);
        if (wr == 1) PG8_BAR;
        PG8_WAIT_V(4); PG8_BAR;
        PG8_STAGE(PG8_SB(1, 0), cB + kstep, voffB); PG8_STAGE(PG8_SA(1, 0), cA + kstep, voffA); PG8_STAGE(PG8_SB(1, 1), cB + hstep + kstep, voffB);
        PG8_WAIT_V(6); PG8_BAR;
    }
    for (;;) {
        const bool has_next = S.next(ui + 1, nxt);
        const char* nA = has_next ? (const char*)g.A + (size_t)nxt.pm * tstep : cA; const char* nB = has_next ? (const char*)g.Bt + (size_t)nxt.pn * tstep : cB;
        for (int t = 0; t < nt; t += 2) {
            const bool last = (t == nt - 2);
            const char* a1 = cA + (size_t)(t + 1) * kstep;
            const char* a2 = last ? nA : cA + (size_t)(t + 2) * kstep; const char* b2 = last ? nB : cB + (size_t)(t + 2) * kstep;
            const char* a3 = a2 + kstep; const char* b3 = b2 + kstep;
            if (last && has_next) S.a_ready(nxt);
            if constexpr (SP2) {
            PG8_LDB(B0, 0, 0); PG8_LDB(B1, 0, 1); PG8_SCHED; PG8_LDA(At, 0, 0); PG8_STAGE(PG8_SA(1, 1), a1 + hstep, voffA);
            PG8_WAIT_V(8); PG8_WAIT_L(0); PG8_BAR; PG8_MMA(0, 0, At, B0); PG8_MMA(0, 1, At, B1); PG8_BAR; PG8_SCHED;
            PG8_LDA(At, 0, 1); PG8_STAGE(PG8_SB(0, 0), b2, voffB); PG8_STAGE(PG8_SB(0, 1), b2 + hstep, voffB); PG8_STAGE(PG8_SA(0, 0), a2, voffA);
            PG8_WAIT_V(8); PG8_WAIT_L(0); PG8_BAR; PG8_MMA(1, 0, At, B0); PG8_MMA(1, 1, At, B1); PG8_BAR; PG8_SCHED;
            PG8_LDB(B0, 1, 0); PG8_LDB(B1, 1, 1); PG8_SCHED; PG8_LDA(At, 1, 0); PG8_STAGE(PG8_SA(0, 1), a2 + hstep, voffA);
            PG8_WAIT_V(8); PG8_WAIT_L(0); PG8_BAR; PG8_MMA(0, 0, At, B0); PG8_MMA(0, 1, At, B1); PG8_BAR; PG8_SCHED;
            PG8_LDA(At, 1, 1); PG8_STAGE(PG8_SB(1, 0), b3, voffB); PG8_STAGE(PG8_SB(1, 1), b3 + hstep, voffB); PG8_STAGE(PG8_SA(1, 0), a3, voffA);
            PG8_WAIT_V(8); PG8_WAIT_L(0); PG8_BAR; PG8_MMA(1, 0, At, B0); PG8_MMA(1, 1, At, B1); PG8_BAR; PG8_SCHED;
            } else {
            PG8_LDB(B0, 0, 0); PG8_SCHED; PG8_LDA(At, 0, 0); PG8_STAGE(PG8_SA(1, 1), a1 + hstep, voffA);
            PG8_WAIT_L(8); PG8_BAR; PG8_WAIT_L(0); PG8_MMA(0, 0, At, B0); PG8_BAR; PG8_SCHED;
            PG8_LDB(B1, 0, 1); PG8_STAGE(PG8_SB(0, 0), b2, voffB);
            PG8_BAR; PG8_WAIT_L(0); PG8_MMA(0, 1, At, B1); PG8_BAR;
            PG8_LDA(At, 0, 1); PG8_STAGE(PG8_SA(0, 0), a2, voffA);
            PG8_BAR; PG8_WAIT_L(0); PG8_MMA(1, 0, At, B0); PG8_BAR; PG8_SCHED;
            PG8_STAGE(PG8_SB(0, 1), b2 + hstep, voffB);
            PG8_WAIT_V(6); PG8_BAR; PG8_MMA(1, 1, At, B1); PG8_BAR;
            PG8_LDB(B0, 1, 0); PG8_SCHED; PG8_LDA(At, 1, 0); PG8_STAGE(PG8_SA(0, 1), a2 + hstep, voffA);
            PG8_WAIT_L(8); PG8_BAR; PG8_WAIT_L(0); PG8_MMA(0, 0, At, B0); PG8_BAR; PG8_SCHED;
            PG8_LDB(B1, 1, 1); PG8_STAGE(PG8_SB(1, 0), b3, voffB);
            PG8_BAR; PG8_WAIT_L(0); PG8_MMA(0, 1, At, B1); PG8_BAR;
            PG8_LDA(At, 1, 1); PG8_STAGE(PG8_SA(1, 0), a3, voffA);
            PG8_BAR; PG8_WAIT_L(0); PG8_MMA(1, 0, At, B0); PG8_BAR; PG8_SCHED;
            PG8_STAGE(PG8_SB(1, 1), b3 + hstep, voffB);
            PG8_WAIT_V(6); PG8_BAR; PG8_MMA(1, 1, At, B1); PG8_BAR;
            }
        }
        if constexpr (ALIGN_EPI) { if (wr == 0) PG8_BAR; }
        if constexpr (!Epi::AFTER_DRAIN) { E(acc, cur, wr, wc, fr, fq); S.done(cur); }
        if (!has_next) break;
#pragma unroll
        for (int a = 0; a < 2; ++a)
#pragma unroll
            for (int b = 0; b < 2; ++b)
#pragma unroll
                for (int m = 0; m < 4; ++m)
#pragma unroll
                    for (int n = 0; n < 2; ++n) acc[a][b][m][n] = (f32x4){0.f, 0.f, 0.f, 0.f};
        cur = nxt; cA = nA; cB = nB; ++ui;
        if constexpr (ALIGN_EPI) { if (wr == 1) PG8_BAR; }
    }
    PG8_WAIT_V(0);
    if constexpr (!ALIGN_EPI) { if (wr == 0) PG8_BAR; }
    PG8_BAR;
    if constexpr (Epi::AFTER_DRAIN) { E.fused(acc, cur, wr, wc, fr, fq, lds, wid, lane); S.done(cur); }
#undef PG8_SA
#undef PG8_SB
#undef PG8_STAGE
#undef PG8_LDA
#undef PG8_LDB
#undef PG8_MMA
#undef PG8_WAIT_V
#undef PG8_WAIT_L
#undef PG8_BAR
#undef PG8_SCHED
}
}

struct EpiIn {
  static constexpr bool PERM = false, AFTER_DRAIN = false;
  const Params* pp; int l;
  __device__ __forceinline__ void operator()(f32x4 (&acc)[2][2][4][2], const pg8::Unit& u, int wr, int wc, int fr, int fq) const {
    kparams_t kp_ = kparams(); (void)kp_;
    const int U = u.pn * 4 + wc;
    if (U >= 77) return;
    const int rowb = u.pm * 256 + wr * 64 + fr;
    const int bq = (u.pm * 256) / T, tb = rowb % T;
    bf16_t* dst = nullptr; int ld = 0, col0 = 0; const float* gain = nullptr; bool rope = false, silu = false;
    float post = 1.0f;
    bf16_t* vt = nullptr;
    if (U < 8) { dst = WSP(bf16_t, OFF_QN); ld = 512; col0 = U * 64; gain = kp_->nsa_q_norm + l * 64; rope = true; post = 0.125f * LOG2E; }
    else if (U < 10) { dst = WSP(bf16_t, OFF_KC); ld = 128; col0 = (U - 8) * 64; rope = true; }
    else if (U < 12) { dst = WSP(bf16_t, OFF_VC); ld = 128; col0 = (U - 10) * 64; }
    else if (U < 14) { dst = WSP(bf16_t, OFF_KS); ld = 128; col0 = (U - 12) * 64; gain = kp_->nsa_k_norm + (l * 3 + 1) * 64; rope = true; }
    else if (U < 16) { vt = WSP(bf16_t, OFF_VST) + (size_t)((bq * 2 + (U - 14)) * 64) * T; }
    else if (U < 18) { dst = WSP(bf16_t, OFF_KW); ld = 128; col0 = (U - 16) * 64; gain = kp_->nsa_k_norm + (l * 3 + 2) * 64; rope = true; }
    else if (U < 20) { vt = WSP(bf16_t, OFF_VWT) + (size_t)((bq * 2 + (U - 18)) * 64) * T; }
    else if (U < 28) { dst = WSP(bf16_t, OFF_OA); ld = 512; col0 = (U - 20) * 64; silu = true; }
    else if (U < 36) { dst = WSP(bf16_t, OFF_FQ); ld = 512; col0 = (U - 28) * 64; gain = kp_->fox_q_norm + l * 64; post = 0.125f * LOG2E; }
    else if (U < 44) { dst = WSP(bf16_t, OFF_FK); ld = 512; col0 = (U - 36) * 64; gain = kp_->fox_k_norm + l * 64; }
    else if (U < 52) { vt = WSP(bf16_t, OFF_FVT) + (size_t)((bq * 8 + (U - 44)) * 64) * T; }
    else if (U < 60) { dst = WSP(bf16_t, OFF_OB); ld = 512; col0 = (U - 52) * 64; silu = true; }
    else if (U < 68) { dst = WSP(bf16_t, OFF_MQ); ld = 512; col0 = (U - 60) * 64; }
    else if (U < 76) { dst = WSP(bf16_t, OFF_OM); ld = 512; col0 = (U - 68) * 64; silu = true; }
    if (U == 76) {
      float* gate = WSP(float, OFF_GATE);
      float* flog = WSP(float, OFF_FLOG);
#pragma unroll
      for (int ai = 0; ai < 2; ++ai)
#pragma unroll
        for (int m = 0; m < 4; ++m) {
          const size_t row = (size_t)rowb + 128 * ai + 16 * m;
#pragma unroll
          for (int n = 0; n < 2; ++n)
#pragma unroll
            for (int i = 0; i < 4; ++i) {
              const int e = 16 * n + 4 * fq + i;
              const float v = acc[ai][0][m][n][i];
              if (e < 24) gate[row * 24 + e] = sigmoidf_(v);
              else {
                const float xx = v + kp_->fox_f_bias[l * 8 + (e - 24)];
                flog[row * 8 + (e - 24)] = xx >= 0.f ? -log1pf(expf(-xx)) : xx - log1pf(expf(xx));
              }
            }
        }
      return;
    }
    if (vt) {
#pragma unroll
      for (int ai = 0; ai < 2; ++ai)
#pragma unroll
        for (int m = 0; m < 4; ++m) {
          const int t = tb + 128 * ai + 16 * m;
#pragma unroll
          for (int bj = 0; bj < 2; ++bj)
#pragma unroll
            for (int n = 0; n < 2; ++n) {
              const f32x4 v = acc[ai][bj][m][n];
              const unsigned w0 = cvtpk(v[0], v[1]), w1 = cvtpk(v[2], v[3]);
              const unsigned qo = (unsigned)((32 * bj + 16 * n + 4 * fq) * T + t);
              vt[qo] = (bf16_t)(w0 & 0xffffu); vt[qo + T] = (bf16_t)(w0 >> 16); vt[qo + 2 * T] = (bf16_t)(w1 & 0xffffu); vt[qo + 3 * T] = (bf16_t)(w1 >> 16);
            }
        }
      return;
    }
    const float* ropetab = WSP(float, OFF_ROPE);
    f32x4 gv[2][2];
    if (gain) {
#pragma unroll
      for (int bj = 0; bj < 2; ++bj)
#pragma unroll
        for (int n = 0; n < 2; ++n) gv[bj][n] = *(const f32x4*)(gain + 32 * bj + 16 * n + 4 * fq);
    }
#pragma unroll
    for (int ai = 0; ai < 2; ++ai)
#pragma unroll
      for (int m = 0; m < 4; ++m) {
        f32x4 v[2][2];
#pragma unroll
        for (int bj = 0; bj < 2; ++bj)
#pragma unroll
          for (int n = 0; n < 2; ++n) v[bj][n] = acc[ai][bj][m][n];
        const int row = rowb + 128 * ai + 16 * m;
        if (gain) {
          float ss = 0.f;
#pragma unroll
          for (int bj = 0; bj < 2; ++bj)
#pragma unroll
            for (int n = 0; n < 2; ++n)
#pragma unroll
              for (int i = 0; i < 4; ++i) ss += v[bj][n][i] * v[bj][n][i];
          ss += __shfl_xor(ss, 16);
          ss += __shfl_xor(ss, 32);
          const float rstd = rsqrtf(ss * (1.0f / 64.0f) + EPS);
#pragma unroll
          for (int bj = 0; bj < 2; ++bj)
#pragma unroll
            for (int n = 0; n < 2; ++n) v[bj][n] = v[bj][n] * rstd * gv[bj][n];
        }
        if (rope) {
          const int pos = row & (T - 1);
#pragma unroll
          for (int n = 0; n < 2; ++n) {
            const f32x4* tp = (const f32x4*)(ropetab + ((size_t)pos * 32 + 16 * n + 4 * fq) * 2);
            const f32x4 t0 = tp[0], t1 = tp[1];
            const float cs[4] = {t0[0], t0[2], t1[0], t1[2]}, sn[4] = {t0[1], t0[3], t1[1], t1[3]};
#pragma unroll
            for (int i = 0; i < 4; ++i) {
              const float y1 = v[0][n][i], y2 = v[1][n][i];
              v[0][n][i] = y1 * cs[i] - y2 * sn[i];
              v[1][n][i] = y2 * cs[i] + y1 * sn[i];
            }
          }
        }
#pragma unroll
        for (int bj = 0; bj < 2; ++bj)
#pragma unroll
          for (int n = 0; n < 2; ++n) {
            f32x4 y = v[bj][n] * post;
            if (silu) {
#pragma unroll
              for (int i = 0; i < 4; ++i) y[i] = siluf_(y[i]);
            }
            u32x2 w = {cvtpk(y[0], y[1]), cvtpk(y[2], y[3])};
            *(u32x2*)(dst + (size_t)row * ld + col0 + 32 * bj + 16 * n + 4 * fq) = w;
          }
      }
  }
};
struct EpiMemKV {
  static constexpr bool PERM = false, AFTER_DRAIN = false;
  const Params* pp;
  __device__ __forceinline__ void operator()(f32x4 (&acc)[2][2][4][2], const pg8::Unit& u, int wr, int wc, int fr, int fq) const {
    kparams_t kp_ = kparams(); (void)kp_;
    const int U = u.pn * 4 + wc;
    const int rowb = u.pm * 256 + wr * 64 + fr;
#pragma unroll
    for (int ai = 0; ai < 2; ++ai)
#pragma unroll
      for (int m = 0; m < 4; ++m) {
        const int row = rowb + 128 * ai + 16 * m;
#pragma unroll
        for (int bj = 0; bj < 2; ++bj)
#pragma unroll
          for (int n = 0; n < 2; ++n) {
            const f32x4 v = acc[ai][bj][m][n];
            const unsigned w0 = cvtpk(v[0], v[1]), w1 = cvtpk(v[2], v[3]);
            const int e = 32 * bj + 16 * n + 4 * fq;
            if (U < 8) {
              u32x2 w = {w0, w1};
              *(u32x2*)(WSP(bf16_t, OFF_MK) + (size_t)row * 512 + U * 64 + e) = w;
            } else {
              const int col = (U - 8) * 64 + e, h = col >> 7, d = col & 127, b = row >> 8, mm = row & 255;
              bf16_t* q = WSP(bf16_t, OFF_MVT) + (size_t)((b * 4 + h) * 128 + d) * 256 + mm;
              q[0] = (bf16_t)(w0 & 0xffffu); q[256] = (bf16_t)(w0 >> 16); q[512] = (bf16_t)(w1 & 0xffffu); q[768] = (bf16_t)(w1 >> 16);
            }
          }
      }
  }
};
struct EpiGate {
  static constexpr bool PERM = true, AFTER_DRAIN = false;
  bf16_t* G;
  __device__ __forceinline__ void operator()(f32x4 (&acc)[2][2][4][2], const pg8::Unit& u, int wr, int wc, int fr, int fq) const {
    const int br = u.pn >> 2, colt = (u.pn & 3) * 256 + wc * 32 + 8 * fq;
    bf16_t* base = G + (size_t)br * M * 1024;
    const int rowb = u.pm * 256 + wr * 64 + fr;
#pragma unroll
    for (int ai = 0; ai < 2; ++ai)
#pragma unroll
      for (int m = 0; m < 4; ++m) {
        bf16_t* rp = base + (size_t)(rowb + 128 * ai + 16 * m) * 1024 + colt;
#pragma unroll
        for (int bj = 0; bj < 2; ++bj) {
          const f32x4 v0 = acc[ai][bj][m][0], v1 = acc[ai][bj][m][1];
          u32x4 w = {cvtpk(sigmoidf_(v0[0]), sigmoidf_(v0[1])), cvtpk(sigmoidf_(v0[2]), sigmoidf_(v0[3])),
                     cvtpk(sigmoidf_(v1[0]), sigmoidf_(v1[1])), cvtpk(sigmoidf_(v1[2]), sigmoidf_(v1[3]))};
          *(u32x4*)(rp + 128 * bj) = w;
        }
      }
  }
};
struct EpiBranch {
  static constexpr bool PERM = true, AFTER_DRAIN = false;
  const bf16_t* G; bf16_t* Uo; int first;
  __device__ __forceinline__ void operator()(f32x4 (&acc)[2][2][4][2], const pg8::Unit& u, int wr, int wc, int fr, int fq) const {
    const int colt = u.pn * 256 + wc * 32 + 8 * fq;
    const int rowb = u.pm * 256 + wr * 64 + fr;
#pragma unroll
    for (int ai = 0; ai < 2; ++ai)
#pragma unroll
      for (int m = 0; m < 4; ++m) {
        const size_t ro = (size_t)(rowb + 128 * ai + 16 * m) * 1024 + colt;
#pragma unroll
        for (int bj = 0; bj < 2; ++bj) {
          const size_t off = ro + 128 * bj;
          const u32x4 gw = *(const u32x4*)(G + off);
          float y[8];
#pragma unroll
          for (int q = 0; q < 4; ++q) {
            const f32x4 v = acc[ai][bj][m][q >> 1];
            y[2 * q] = v[(2 * q) & 3] * bflo(gw[q]);
            y[2 * q + 1] = v[(2 * q + 1) & 3] * bfhi(gw[q]);
          }
          if (!first) {
            const u32x4 uw = *(const u32x4*)(Uo + off);
#pragma unroll
            for (int q = 0; q < 4; ++q) { y[2 * q] += bflo(uw[q]); y[2 * q + 1] += bfhi(uw[q]); }
          }
          u32x4 w = {cvtpk(y[0], y[1]), cvtpk(y[2], y[3]), cvtpk(y[4], y[5]), cvtpk(y[6], y[7])};
          *(u32x4*)(Uo + off) = w;
        }
      }
  }
};
struct EpiOut {
  static constexpr bool PERM = true, AFTER_DRAIN = false;
  const float* xin; float* xout;
  __device__ __forceinline__ void operator()(f32x4 (&acc)[2][2][4][2], const pg8::Unit& u, int wr, int wc, int fr, int fq) const {
    const int colt = u.pn * 256 + wc * 32 + 8 * fq;
    const int rowb = u.pm * 256 + wr * 64 + fr;
#pragma unroll
    for (int ai = 0; ai < 2; ++ai)
#pragma unroll
      for (int m = 0; m < 4; ++m) {
        const size_t ro = (size_t)(rowb + 128 * ai + 16 * m) * 1024 + colt;
#pragma unroll
        for (int bj = 0; bj < 2; ++bj) {
          const size_t off = ro + 128 * bj;
          const f32x4 x0 = *(const f32x4*)(xin + off), x1 = *(const f32x4*)(xin + off + 4);
          *(f32x4*)(xout + off) = x0 + acc[ai][bj][m][0];
          *(f32x4*)(xout + off + 4) = x1 + acc[ai][bj][m][1];
        }
      }
  }
};
template <class Epi>
__device__ __forceinline__ void run_gemm(PG8_LAS unsigned char* lds, const bf16_t* A, const bf16_t* Bt, int Mr, int Nc, int K, const Epi& E) {
  pg8::Gemm g{A, Bt, Mr, Nc, K};
  pg8::StaticOrder S;
  S.init(Mr, Nc, gdim(), bidx());
  pg8::gemm_phase<Epi, pg8::StaticOrder, true, true>(lds, g, S, E);
}

__device__ __forceinline__ int map_in(int n) {
  const int i = n >> 6, c = n & 63;
  if (i < 20) return n;
  if (i < 28) return 1304 + (n - 1280);
  if (i < 52) return 1816 + (n - 1792);
  if (i < 60) return 3360 + (n - 3328);
  if (i < 68) return 3872 + (n - 3840);
  if (i < 76) return 4384 + (n - 4352);
  if (i == 76) return c < 24 ? 1280 + c : (c < 32 ? 3352 + (c - 24) : -1);
  return -1;
}
__device__ __forceinline__ void wave_transpose_tile(const float* __restrict__ src, int ld_src, int k0, int n0, bf16_t* __restrict__ dst,
                                                    int Kdim, int maptype, int srccol0, float* tile, int lane) {
  int nlog = n0 + lane;
  if (maptype) { const int w = nlog & 255; nlog = (nlog & ~255) + (((w & 127) >> 5) << 6) + (((w >> 7) << 5) | (w & 31)); }
  const int sc = (maptype == 1) ? map_in(nlog) : srccol0 + nlog;
  const float* sp = src + (size_t)k0 * ld_src + (sc >= 0 ? sc : 0);
#pragma unroll 32
  for (int kk = 0; kk < 64; ++kk) {
    const float v = sp[(size_t)kk * ld_src];
    tile[kk * 65 + lane] = sc >= 0 ? v : 0.f;
  }
  __builtin_amdgcn_fence(__ATOMIC_SEQ_CST, "workgroup");
  __builtin_amdgcn_wave_barrier();
  const int rsub = lane >> 5, kp = lane & 31;
#pragma unroll 8
  for (int it = 0; it < 32; ++it) {
    const int row = 2 * it + rsub;
    const float a = tile[(2 * kp) * 65 + row], b = tile[(2 * kp + 1) * 65 + row];
    *(unsigned*)(dst + (size_t)(n0 + row) * Kdim + k0 + 2 * kp) = cvtpk(a, b);
  }
  __builtin_amdgcn_fence(__ATOMIC_SEQ_CST, "workgroup");
  __builtin_amdgcn_wave_barrier();
}
__device__ __forceinline__ void rmsnorm4(const float* __restrict__ x, const float* __restrict__ gain, bf16_t* __restrict__ dst, size_t row0, int lane) {
  f32x4 v[4][4];
  float ss[4];
#pragma unroll
  for (int rr = 0; rr < 4; ++rr)
#pragma unroll
    for (int i = 0; i < 4; ++i) v[rr][i] = *(const f32x4*)(x + (row0 + rr) * 1024 + lane * 4 + 256 * i);
  f32x4 gv[4];
#pragma unroll
  for (int i = 0; i < 4; ++i) gv[i] = *(const f32x4*)(gain + lane * 4 + 256 * i);
#pragma unroll
  for (int rr = 0; rr < 4; ++rr) {
    float s = 0.f;
#pragma unroll
    for (int i = 0; i < 4; ++i) s += v[rr][i][0] * v[rr][i][0] + v[rr][i][1] * v[rr][i][1] + v[rr][i][2] * v[rr][i][2] + v[rr][i][3] * v[rr][i][3];
    ss[rr] = s;
  }
#pragma unroll
  for (int o_ = 1; o_ < 64; o_ <<= 1) {
#pragma unroll
    for (int rr = 0; rr < 4; ++rr) ss[rr] += __shfl_xor(ss[rr], o_);
  }
#pragma unroll
  for (int rr = 0; rr < 4; ++rr) {
    const float rstd = rsqrtf(ss[rr] * (1.0f / 1024.0f) + EPS);
#pragma unroll
    for (int i = 0; i < 4; ++i) {
      const f32x4 y = v[rr][i] * rstd * gv[i];
      u32x2 w = {cvtpk(y[0], y[1]), cvtpk(y[2], y[3])};
      *(u32x2*)(dst + (row0 + rr) * 1024 + lane * 4 + 256 * i) = w;
    }
  }
}
__device__ __forceinline__ void phase_prep(const Params& p, int l, float* smem) {
  kparams_t kp_ = kparams(); (void)kp_;
  const int tid = tidx();
  const int wave = tid >> 6, lane = tid & 63;
  const int gw = wave * gdim() + bidx(), nw = NWAVES * gdim();
  if (l == 0 && bidx() == 0 && tid < 64) WSP(unsigned, OFF_CTL)[tid] = 0u;
  const float* xin = (l == 0) ? kp_->x : kp_->out;
  float* wtile = smem + wave * 4160;
  for (int u0 = gw; u0 < 3076; u0 += nw) {
    int u = u0;
    const float* src; int ld, kt, nt, Kd, mt = 0, c0 = 0; bf16_t* dst;
    if (u < 1280) { kt = u / 80; nt = u % 80; src = kp_->w_in + (size_t)l * 1024 * 7968; ld = 7968; Kd = 1024; dst = WSP(bf16_t, OFF_W_IN); mt = 1; }
    else if ((u -= 1280) < 768) { kt = u / 48; nt = u % 48; src = kp_->w_in + (size_t)l * 1024 * 7968; ld = 7968; Kd = 1024; dst = WSP(bf16_t, OFF_W_G); c0 = 4896; }
    else if ((u -= 768) < 256) { kt = u / 16; nt = u % 16; src = kp_->w_mem_kv + (size_t)l * 1024 * 1024; ld = 1024; Kd = 1024; dst = WSP(bf16_t, OFF_W_MKV); mt = 2; }
    else if ((u -= 256) < 384) { const int br = u / 128, uu = u % 128; kt = uu / 16; nt = uu % 16;
      src = (br == 0 ? kp_->w_branch_a : br == 1 ? kp_->w_branch_b : kp_->w_branch_m) + (size_t)l * 512 * 1024; ld = 1024; Kd = 512; dst = WSP(bf16_t, OFF_W_BR + (size_t)br * MiB); }
    else if ((u -= 384) < 256) { kt = u / 16; nt = u % 16; src = kp_->w_out + (size_t)l * 1024 * 1024; ld = 1024; Kd = 1024; dst = WSP(bf16_t, OFF_W_OUT); }
    else if ((u -= 256) < 128) { const int kv = u / 64, uu = u % 64; kt = uu / 2; nt = uu % 2;
      src = (kv ? kp_->cmp_w1_v : kp_->cmp_w1_k) + (size_t)l * 2048 * 128; ld = 128; Kd = 2048; dst = WSP(bf16_t, OFF_W1 + (size_t)kv * 512 * 1024); }
    else { u -= 128; const int kv = u / 2; kt = u % 2; nt = 0;
      src = (kv ? kp_->cmp_w2_v : kp_->cmp_w2_k) + (size_t)l * 128 * 64; ld = 64; Kd = 128; dst = WSP(bf16_t, OFF_W2 + (size_t)kv * 64 * 1024); }
    wave_transpose_tile(src, ld, kt * 64, nt * 64, dst, Kd, mt, c0, wtile, lane);
  }
  for (int grp = gw; grp < 8192 + 256; grp += nw) {
    if (grp < 8192) rmsnorm4(xin, kp_->norm_g + l * 1024, WSP(bf16_t, OFF_H), (size_t)grp * 4, lane);
    else rmsnorm4(kp_->mem, kp_->mem_norm_g + l * 1024, WSP(bf16_t, OFF_MEMN), (size_t)(grp - 8192) * 4, lane);
  }
  for (int u = gw; u < 32; u += nw) {
    const int kv = u >> 4, ch = u & 15;
    const float* pe = (kv ? kp_->cmp_pe_v : kp_->cmp_pe_k) + (size_t)l * 2048 + ch * 128;
    const float* w1 = (kv ? kp_->cmp_w1_v : kp_->cmp_w1_k) + (size_t)l * 2048 * 128 + (size_t)ch * 128 * 128;
    float s0 = 0.f, s1 = 0.f;
#pragma unroll 32
    for (int kk = 0; kk < 128; ++kk) {
      const float pv = pe[kk];
      s0 += pv * w1[(size_t)kk * 128 + lane];
      s1 += pv * w1[(size_t)kk * 128 + 64 + lane];
    }
    float* part = WSP(float, OFF_C1) + (size_t)(kv * 16 + ch) * 128;
    part[lane] = s0;
    part[64 + lane] = s1;
  }
  if (l == 0) {
    for (int u = bidx(); u < 512; u += gdim()) {
      for (int e = tid; e < 512; e += NTHREADS) {
        const int idx = u * 512 + e, pos = idx >> 5, f = idx & 31;
        const float ang = (float)pos * c_inv_freq[f];
        const double a = (double)ang;
        const double k = rint(a * 0.15915494309189535);
        const float rr = (float)(a - k * 6.283185307179586);
        float2 cs; cs.x = __cosf(rr); cs.y = __sinf(rr);
        WSP(float2, OFF_ROPE)[idx] = cs;
      }
    }
  }
}

__device__ __forceinline__ void compress_wg(const Params& p, int l, int up, float* smem) {
  kparams_t kp_ = kparams(); (void)kp_;
  const int wave_ = tidx() >> 6, kc = wave_ & 3, u = up * 2 + (wave_ >> 2);
  const int lane = tidx() & 63, r = lane & 15, g4 = lane >> 4;
  const int kv = u >> 7, rem = u & 127, b = rem >> 5, grp = (rem >> 4) & 1, it = rem & 15, i0 = it * 32;
  const bf16_t* src = WSP(bf16_t, kv ? OFF_VC : OFF_KC);
  const bf16_t* w1t = WSP(bf16_t, OFF_W1 + (size_t)kv * 512 * 1024);
  const bf16_t* w2t = WSP(bf16_t, OFF_W2 + (size_t)kv * 64 * 1024);
  const float* c1 = WSP(float, OFF_C1 + 16384) + kv * 128;
  const bf16_t* arow[2];
#pragma unroll
  for (int mt = 0; mt < 2; ++mt) {
    int i = i0 + 16 * mt + r;
    if (i > 510) i = 510;
    arow[mt] = src + ((size_t)b * T + 16 * i) * 128 + grp * 64 + g4 * 8;
  }
  f32x4 acc[2][8];
#pragma unroll
  for (int a = 0; a < 2; ++a)
#pragma unroll
    for (int c = 0; c < 8; ++c) acc[a][c] = (f32x4){0.f, 0.f, 0.f, 0.f};
  const bf16_t* bp = w1t + (size_t)r * 2048 + g4 * 8;
#pragma unroll 1
  for (int k0 = kc * 512; k0 < kc * 512 + 512; k0 += 32) {
    const int pp = k0 >> 6, d = k0 & 63;
    bf16x8 af[2], bf[8];
#pragma unroll
    for (int mt = 0; mt < 2; ++mt) af[mt] = *(const bf16x8*)(arow[mt] + (size_t)pp * 128 + d);
#pragma unroll
    for (int nt = 0; nt < 8; ++nt) bf[nt] = *(const bf16x8*)(bp + (size_t)nt * 16 * 2048 + k0);
#pragma unroll
    for (int mt = 0; mt < 2; ++mt)
#pragma unroll
      for (int nt = 0; nt < 8; ++nt) acc[mt][nt] = mfma16(bf[nt], af[mt], acc[mt][nt]);
  }
  {
    float* part = smem + wave_ * 4096;
#pragma unroll
    for (int a = 0; a < 2; ++a)
#pragma unroll
      for (int c = 0; c < 8; ++c)
#pragma unroll
        for (int i = 0; i < 4; ++i) part[((a * 8 + c) * 4 + i) * 64 + lane] = acc[a][c][i];
  }
  __syncthreads();
  if (kc != 0) return;
#pragma unroll 1
  for (int q = 1; q < 4; ++q) {
    const float* part = smem + (wave_ + q) * 4096;
#pragma unroll
    for (int a = 0; a < 2; ++a) {
#pragma unroll
      for (int c = 0; c < 8; ++c)
#pragma unroll
        for (int i = 0; i < 4; ++i) acc[a][c][i] += part[((a * 8 + c) * 4 + i) * 64 + lane];
      asm volatile("" ::: "memory");
    }
  }
#pragma unroll
  for (int nt = 0; nt < 8; ++nt) {
    const f32x4 cv = *(const f32x4*)(c1 + 16 * nt + 4 * g4);
#pragma unroll
    for (int mt = 0; mt < 2; ++mt)
#pragma unroll
      for (int i = 0; i < 4; ++i) acc[mt][nt][i] = siluf_(acc[mt][nt][i] + cv[i]);
  }
  bf16x8 wf[4][4];
#pragma unroll
  for (int ks = 0; ks < 4; ++ks)
#pragma unroll
    for (int et = 0; et < 4; ++et) {
      const bf16_t* wp = w2t + (size_t)(16 * et + r) * 128 + 32 * ks + 4 * g4;
      const u32x2 lo = *(const u32x2*)wp, hi = *(const u32x2*)(wp + 16);
      u32x4 w = {lo[0], lo[1], hi[0], hi[1]};
      wf[ks][et] = __builtin_bit_cast(bf16x8, w);
    }
  if (kv == 0) {
    const float* gain = kp_->nsa_k_norm + (size_t)(l * 3 + 0) * 64;
    bf16_t* dst = WSP(bf16_t, OFF_KCMP) + (size_t)((b * 2 + grp) * 512) * 64;
    f32x4 gv[4];
#pragma unroll
    for (int et = 0; et < 4; ++et) gv[et] = *(const f32x4*)(gain + 16 * et + 4 * g4);
#pragma unroll
    for (int mt = 0; mt < 2; ++mt) {
      f32x4 o[4];
#pragma unroll
      for (int et = 0; et < 4; ++et) o[et] = (f32x4){0.f, 0.f, 0.f, 0.f};
#pragma unroll
      for (int ks = 0; ks < 4; ++ks) {
        const bf16x8 xf = pack8(acc[mt][2 * ks], acc[mt][2 * ks + 1]);
#pragma unroll
        for (int et = 0; et < 4; ++et) o[et] = mfma16(wf[ks][et], xf, o[et]);
      }
      float ss = 0.f;
#pragma unroll
      for (int et = 0; et < 4; ++et)
#pragma unroll
        for (int i = 0; i < 4; ++i) ss += o[et][i] * o[et][i];
      ss += __shfl_xor(ss, 16);
      ss += __shfl_xor(ss, 32);
      const float rstd = rsqrtf(ss * (1.0f / 64.0f) + EPS);
      const int i = i0 + 16 * mt + r;
#pragma unroll
      for (int et = 0; et < 4; ++et) {
        f32x4 y = o[et] * rstd * gv[et];
        if (i > 510) y = (f32x4){0.f, 0.f, 0.f, 0.f};
        u32x2 w = {cvtpk(y[0], y[1]), cvtpk(y[2], y[3])};
        *(u32x2*)(dst + (size_t)i * 64 + 16 * et + 4 * g4) = w;
      }
    }
  } else {
    bf16_t* dst = WSP(bf16_t, OFF_VCT) + (size_t)((b * 2 + grp) * 64) * 512;
#pragma unroll
    for (int mt = 0; mt < 2; ++mt) {
      f32x4 o[4];
#pragma unroll
      for (int et = 0; et < 4; ++et) o[et] = (f32x4){0.f, 0.f, 0.f, 0.f};
#pragma unroll
      for (int ks = 0; ks < 4; ++ks) {
        const bf16x8 xf = pack8(acc[mt][2 * ks], acc[mt][2 * ks + 1]);
#pragma unroll
        for (int et = 0; et < 4; ++et) o[et] = mfma16(xf, wf[ks][et], o[et]);
      }
#pragma unroll
      for (int et = 0; et < 4; ++et) {
        f32x4 y = o[et];
        const int ib = i0 + 16 * mt + 4 * g4;
#pragma unroll
        for (int i = 0; i < 4; ++i)
          if (ib + i > 510) y[i] = 0.f;
        u32x2 w = {cvtpk(y[0], y[1]), cvtpk(y[2], y[3])};
        *(u32x2*)(dst + (size_t)(16 * et + r) * 512 + ib) = w;
      }
    }
  }
}
__device__ __forceinline__ void cumsum_wg(const Params& p, int u, float* smem) {
  kparams_t kp_ = kparams(); (void)kp_;
  const int tid = tidx(), lane = tid & 63, wave = tid >> 6, b = u >> 3, h = u & 7;
  const float* fl = WSP(float, OFF_FLOG) + ((size_t)b * T) * 8 + h;
  float* fc = WSP(float, OFF_FC) + (size_t)(b * 8 + h) * T;
  const int tb = tid * 16;
  float v[16];
#pragma unroll
  for (int i = 0; i < 16; ++i) v[i] = fl[(size_t)(tb + i) * 8];
  double s = 0.0;
#pragma unroll
  for (int i = 0; i < 16; ++i) s += (double)v[i];
  double incl = s;
#pragma unroll
  for (int o = 1; o < 64; o <<= 1) {
    const double y = __shfl_up(incl, o);
    if (lane >= o) incl += y;
  }
  double* wtot = (double*)smem;
  if (lane == 63) wtot[wave] = incl;
  __syncthreads();
  double base = 0.0;
  for (int w = 0; w < wave; ++w) base += wtot[w];
  double run = base + incl - s;
#pragma unroll
  for (int i = 0; i < 16; ++i) { run += (double)v[i]; v[i] = (float)run; }
#pragma unroll
  for (int i = 0; i < 4; ++i) *(f32x4*)(fc + tb + 4 * i) = (f32x4){v[4 * i], v[4 * i + 1], v[4 * i + 2], v[4 * i + 3]};
  __syncthreads();
}
__device__ __forceinline__ void memk_norm_unit(const Params& p, int l, int u) {
  kparams_t kp_ = kparams(); (void)kp_;
  const int lane = tidx() & 63;
  bf16_t* mk = WSP(bf16_t, OFF_MK);
  const float* gain = kp_->mem_k_norm + l * 128 + (lane & 15) * 8;
  for (int rr = 0; rr < 16; ++rr) {
    bf16_t* ptr = mk + (size_t)(u * 16 + rr) * 512 + lane * 8;
    const u32x4 w = *(const u32x4*)ptr;
    float v[8];
#pragma unroll
    for (int j = 0; j < 4; ++j) { v[2 * j] = bflo(w[j]); v[2 * j + 1] = bfhi(w[j]); }
    float ss = 0.f;
#pragma unroll
    for (int j = 0; j < 8; ++j) ss += v[j] * v[j];
#pragma unroll
    for (int o = 1; o < 16; o <<= 1) ss += __shfl_xor(ss, o);
    const float rstd = rsqrtf(ss * (1.0f / 128.0f) + EPS);
    u32x4 ow;
#pragma unroll
    for (int j = 0; j < 4; ++j) ow[j] = cvtpk(v[2 * j] * rstd * gain[2 * j], v[2 * j + 1] * rstd * gain[2 * j + 1]);
    *(u32x4*)ptr = ow;
  }
}
__device__ __forceinline__ void phase_mid(const Params& p, int l, float* smem) {
  const int wave = tidx() >> 6;
  for (int u = bidx(); u < 128 + 32 + 8; u += gdim()) {
    if (u < 128) { compress_wg(p, l, u, smem); __syncthreads(); }
    else if (u < 160) cumsum_wg(p, u - 128, smem);
    else memk_norm_unit(p, l, (u - 160) * 8 + wave);
  }
}

template <int NCT, int NDK, bool QL = false>
__device__ __forceinline__ void qk_scores(const bf16_t* __restrict__ kbase, int ldk, int key0,
                                          const bf16x8 (&qf)[NCT][NDK], f32x4 (&s)[2][NCT], int lane, const bf16x8* qlds = nullptr) {
  const int r = lane & 15, grp = lane >> 4;
#pragma unroll
  for (int kt = 0; kt < 2; ++kt) {
    const bf16_t* kp = kbase + (size_t)(key0 + 8 * (r >> 2) + 4 * kt + (r & 3)) * ldk + grp * 8;
    bf16x8 kf[NDK];
#pragma unroll
    for (int dk = 0; dk < NDK; ++dk) kf[dk] = *(const bf16x8*)(kp + dk * 32);
#pragma unroll
    for (int ct = 0; ct < NCT; ++ct) {
      f32x4 a = {0.f, 0.f, 0.f, 0.f};
#pragma unroll
      for (int dk = 0; dk < NDK; ++dk) a = mfma16(kf[dk], QL ? qlds[(ct * NDK + dk) * 64 + lane] : qf[ct][dk], a);
      s[kt][ct] = a;
    }
  }
}
template <int NCT, int NDT>
__device__ __forceinline__ void pv_accum(const bf16_t* __restrict__ vt, size_t ldv, int key0,
                                         const f32x4 (&s)[2][NCT], f32x4 (&o)[NDT][NCT], int lane) {
  const int r = lane & 15, grp = lane >> 4;
  bf16x8 pb[NCT];
#pragma unroll
  for (int ct = 0; ct < NCT; ++ct) pb[ct] = pack8(s[0][ct], s[1][ct]);
#pragma unroll
  for (int dt = 0; dt < NDT; ++dt) {
    const bf16x8 vf = *(const bf16x8*)(vt + (size_t)(16 * dt + r) * ldv + key0 + 8 * grp);
#pragma unroll
    for (int ct = 0; ct < NCT; ++ct) o[dt][ct] = mfma16(vf, pb[ct], o[dt][ct]);
  }
}
template <int NCT, int NDT, bool HAS_O, bool SUMS = true>
__device__ __forceinline__ void softmax_update(f32x4 (&s)[2][NCT], float (&m)[NCT], float (&lsum)[NCT],
                                               f32x4 (&o)[NDT][NCT], f32x4 (*lacc)[NCT] = nullptr) {
  float mnew[NCT];
  bool ch = false;
#pragma unroll
  for (int ct = 0; ct < NCT; ++ct) {
    float mx = fmaxf(fmaxf(fmaxf(s[0][ct][0], s[0][ct][1]), fmaxf(s[0][ct][2], s[0][ct][3])),
                     fmaxf(fmaxf(s[1][ct][0], s[1][ct][1]), fmaxf(s[1][ct][2], s[1][ct][3])));
    mx = grp_max4(mx);
    mnew[ct] = fmaxf(m[ct], mx);
    ch = ch || (mnew[ct] > m[ct]);
  }
  if (__any(ch)) {
#pragma unroll
    for (int ct = 0; ct < NCT; ++ct) {
      const float msafe = (mnew[ct] == NEG_INF) ? 0.f : mnew[ct];
      const float alpha = __builtin_amdgcn_exp2f(m[ct] - msafe);
      m[ct] = mnew[ct];
      if (SUMS) lsum[ct] *= alpha; else (*lacc)[ct] = (*lacc)[ct] * alpha;
      if (HAS_O) {
#pragma unroll
        for (int dt = 0; dt < NDT; ++dt) o[dt][ct] = o[dt][ct] * alpha;
      }
    }
  }
#pragma unroll
  for (int ct = 0; ct < NCT; ++ct) {
    const float msafe = (m[ct] == NEG_INF) ? 0.f : m[ct];
#pragma unroll
    for (int kt = 0; kt < 2; ++kt) {
      const f32x4 d = s[kt][ct] - msafe;
      f32x4 pv;
#pragma unroll
      for (int i = 0; i < 4; ++i) pv[i] = __builtin_amdgcn_exp2f(d[i]);
      s[kt][ct] = pv;
    }
    if (SUMS) {
      const f32x4 t4 = s[0][ct] + s[1][ct];
      lsum[ct] += (t4[0] + t4[1]) + (t4[2] + t4[3]);
    }
  }
}
__device__ __forceinline__ float finish_l(float lsum) {
  lsum += __shfl_xor(lsum, 16);
  lsum += __shfl_xor(lsum, 32);
  return lsum > 0.f ? 1.0f / lsum : 0.f;
}

typedef __attribute__((address_space(3))) unsigned char lds_u8;
constexpr int TILE_ROWB = 144, TILE_HALF = 64 * TILE_ROWB, TILE_STAGE = 2 * TILE_HALF + 256;
struct TileRegs { u32x4 k, v; };
__device__ __forceinline__ void tile_gload(TileRegs& tr, const bf16_t* __restrict__ kbase, int ldk, const bf16_t* __restrict__ vtbase,
                                           size_t ldv, int key0, int tid) {
  const int row = tid >> 3, ch = tid & 7;
  tr.k = *(const u32x4*)(kbase + (size_t)(key0 + row) * ldk + ch * 8);
  tr.v = *(const u32x4*)(vtbase + (size_t)row * ldv + key0 + ch * 8);
}
__device__ __forceinline__ void tile_swrite(const TileRegs& tr, lds_u8* stage, int tid) {
  const int row = tid >> 3, ch = tid & 7;
  *(__attribute__((address_space(3))) u32x4*)(stage + row * TILE_ROWB + ch * 16) = tr.k;
  *(__attribute__((address_space(3))) u32x4*)(stage + TILE_HALF + row * TILE_ROWB + ch * 16) = tr.v;
}
template <int NCT, int NDK, bool QL>
__device__ __forceinline__ void qk_scores_lds(const lds_u8* stage, int hf, const bf16x8 (&qf)[NCT][NDK], f32x4 (&s)[2][NCT], int lane,
                                              const bf16x8* qlds, const f32x4 c0, const f32x4 c1) {
  const int r = lane & 15, grp = lane >> 4;
#pragma unroll
  for (int kt = 0; kt < 2; ++kt) {
    const lds_u8* kp = stage + (32 * hf + 8 * (r >> 2) + 4 * kt + (r & 3)) * TILE_ROWB + grp * 16;
    bf16x8 kf[NDK];
#pragma unroll
    for (int dk = 0; dk < NDK; ++dk) kf[dk] = *(const __attribute__((address_space(3))) bf16x8*)(kp + dk * 64);
#pragma unroll
    for (int ct = 0; ct < NCT; ++ct) {
      f32x4 a = kt ? c1 : c0;
#pragma unroll
      for (int dk = 0; dk < NDK; ++dk) a = mfma16(kf[dk], QL ? qlds[(ct * NDK + dk) * 64 + lane] : qf[ct][dk], a);
      s[kt][ct] = a;
    }
  }
}
template <int NDT>
__device__ __forceinline__ void v_frags_lds(const lds_u8* stage, int hf, bf16x8 (&vf)[NDT], int lane) {
  const int r = lane & 15, grp = lane >> 4;
#pragma unroll
  for (int dt = 0; dt < NDT; ++dt)
    vf[dt] = *(const __attribute__((address_space(3))) bf16x8*)(stage + TILE_HALF + (16 * dt + r) * TILE_ROWB + (32 * hf + 8 * grp) * 2);
}
template <int NCT, int NDT>
__device__ __forceinline__ void pv_accum_lds(const bf16x8 (&vfp)[NDT], const f32x4 (&s)[2][NCT], f32x4 (&o)[NDT][NCT], int lane, f32x4 (&lacc)[NCT]) {
  const int r = lane & 15, grp = lane >> 4; (void)r; (void)grp;
  bf16x8 pb[NCT];
#pragma unroll
  for (int ct = 0; ct < NCT; ++ct) pb[ct] = pack8(s[0][ct], s[1][ct]);
  {
    const short one = (short)0x3F80;
    const bf16x8 ones = {one, one, one, one, one, one, one, one};
#pragma unroll
    for (int ct = 0; ct < NCT; ++ct) lacc[ct] = mfma16(ones, pb[ct], lacc[ct]);
  }
#pragma unroll
  for (int dt = 0; dt < NDT; ++dt) {
    const bf16x8 vf = vfp[dt];
#pragma unroll
    for (int ct = 0; ct < NCT; ++ct) o[dt][ct] = mfma16(vf, pb[ct], o[dt][ct]);
  }
}
__device__ __forceinline__ int next_bit(unsigned long long lo, unsigned long long hi, int from) {
  if (from < 64) { const unsigned long long mm = lo & (~0ull << from); if (mm) return __ffsll(mm) - 1; from = 64; }
  if (from < 128) { const unsigned long long mm = hi & (~0ull << (from - 64)); if (mm) return 64 + __ffsll(mm) - 1; }
  return 128;
}

__device__ __forceinline__ void nsa_wg_unit(const Params& p, int b, int g, int qi, float* imp, bf16x8* qlds, float* scr, lds_u8* tiles, unsigned* misc, bool st) {
  kparams_t kp_ = kparams(); (void)kp_;
  const int tid0 = tidx();
  const int wave = __builtin_amdgcn_readfirstlane(tid0 >> 6);
  const int lane0 = tid0 & 63;
  const int tq = qi * 8 + wave;
  const int t0 = tq * 16;
  const bf16x8 (&qf)[4][2] = *(const bf16x8 (*)[4][2])nullptr;
#define NSA_SECTION_VARS \
  int lane = lane0; asm volatile("" : "+v"(lane)); \
  const int r = lane & 15, grp = lane >> 4, t = t0 + r; \
  const size_t row = (size_t)b * T + t; \
  const float* gatep = WSP(float, OFF_GATE) + row * 24 + g * 12; (void)gatep; (void)grp; (void)t;
  {
    NSA_SECTION_VARS
#pragma unroll
    for (int ct = 0; ct < 4; ++ct)
#pragma unroll
      for (int dk = 0; dk < 2; ++dk)
        qlds[(ct * 2 + dk) * 64 + lane] = *(const bf16x8*)(WSP(bf16_t, OFF_QN) + row * 512 + (g * 4 + ct) * 64 + dk * 32 + grp * 8);
  }
  f32x4 o[4][4];
  float m[4], lsum[4];
  f32x4 lacc[4];
  {
    NSA_SECTION_VARS
    const bf16_t* kc = WSP(bf16_t, OFF_KCMP) + (size_t)((b * 2 + g) * 512) * 64;
    const bf16_t* vct = WSP(bf16_t, OFF_VCT) + (size_t)((b * 2 + g) * 64) * 512;
    const int nblk = (tq + 31) >> 5;
#pragma unroll
    for (int ct = 0; ct < 4; ++ct) { m[ct] = NEG_INF; lsum[ct] = 0.f; }
#pragma unroll 1
    for (int blk = 0; blk < nblk; ++blk) {
      f32x4 s[2][4];
      qk_scores<4, 2, true>(kc, 64, blk * 32, qf, s, lane, qlds);
#pragma unroll
      for (int kt = 0; kt < 2; ++kt)
#pragma unroll
        for (int i = 0; i < 4; ++i) {
          const int n = blk * 32 + 8 * grp + 4 * kt + i;
          const bool ok = (16 * n + 31 <= t);
#pragma unroll
          for (int ct = 0; ct < 4; ++ct) s[kt][ct][i] = ok ? s[kt][ct][i] : NEG_INF;
        }
      softmax_update<4, 4, false>(s, m, lsum, o);
    }
    float invl[4], msafe[4];
#pragma unroll
    for (int ct = 0; ct < 4; ++ct) { invl[ct] = finish_l(lsum[ct]); msafe[ct] = (m[ct] == NEG_INF) ? 0.f : m[ct]; }
    for (int e = lane; e < 16 * 132; e += 64) imp[e] = 0.f;
    __builtin_amdgcn_fence(__ATOMIC_SEQ_CST, "workgroup");
    __builtin_amdgcn_wave_barrier();
#pragma unroll
    for (int dt = 0; dt < 4; ++dt)
#pragma unroll
      for (int ct = 0; ct < 4; ++ct) o[dt][ct] = (f32x4){0.f, 0.f, 0.f, 0.f};
#pragma unroll 1
    for (int blk = 0; blk < nblk; ++blk) {
      f32x4 s[2][4];
      qk_scores<4, 2, true>(kc, 64, blk * 32, qf, s, lane, qlds);
      float pq[2][4];
#pragma unroll
      for (int kt = 0; kt < 2; ++kt)
#pragma unroll
        for (int i = 0; i < 4; ++i) {
          const int n = blk * 32 + 8 * grp + 4 * kt + i;
          const bool ok = (16 * n + 31 <= t);
          float acc_p = 0.f;
#pragma unroll
          for (int ct = 0; ct < 4; ++ct) {
            const float pv = ok ? __builtin_amdgcn_exp2f(s[kt][ct][i] - msafe[ct]) * invl[ct] : 0.f;
            s[kt][ct][i] = pv;
            acc_p += pv;
          }
          pq[kt][i] = acc_p;
        }
      float* ir = imp + r * 132 + blk * 8 + 2 * grp;
      ir[0] += pq[0][0] + pq[0][1] + pq[0][2] + 0.5f * pq[0][3];
      __builtin_amdgcn_fence(__ATOMIC_SEQ_CST, "workgroup");
      __builtin_amdgcn_wave_barrier();
      ir[1] += pq[1][0] + pq[1][1] + pq[1][2] + 0.5f * pq[1][3] + 0.5f * pq[0][3];
      __builtin_amdgcn_fence(__ATOMIC_SEQ_CST, "workgroup");
      __builtin_amdgcn_wave_barrier();
      ir[2] += 0.5f * pq[1][3];
      __builtin_amdgcn_fence(__ATOMIC_SEQ_CST, "workgroup");
      __builtin_amdgcn_wave_barrier();
      pv_accum<4, 4>(vct, 512, blk * 32, s, o, lane);
    }
    f32x4 gt[4];
#pragma unroll
    for (int ct = 0; ct < 4; ++ct) gt[ct][0] = gatep[ct * 3 + 0];
#pragma unroll
    for (int dt = 0; dt < 4; ++dt) {
#pragma unroll
      for (int ct = 0; ct < 4; ++ct)
#pragma unroll
        for (int i = 0; i < 4; ++i) scr[((dt * 4 + ct) * 4 + i) * 64 + lane] = o[dt][ct][i] * gt[ct][0];
      asm volatile("" ::: "memory");
    }
  }
  const int cur = t0 >> 6;
  unsigned long long sel_lo = 0ull, sel_hi = 0ull;
  {
  NSA_SECTION_VARS
  if (cur <= 15) {
    sel_lo = (1ull << (cur + 1)) - 1ull;
  } else {
    __builtin_amdgcn_fence(__ATOMIC_SEQ_CST, "workgroup");
    __builtin_amdgcn_wave_barrier();
    float v[32];
#pragma unroll
    for (int k = 0; k < 32; ++k) {
      const int j = grp + 4 * k;
      const float x = imp[r * 132 + j];
      v[k] = (j >= 1 && j <= cur - 2) ? x : NEG_INF;
    }
#pragma unroll 1
    for (int round = 0; round < 13; ++round) {
      float best = NEG_INF;
      int bj = 1 << 20;
#pragma unroll
      for (int k = 0; k < 32; ++k) {
        const bool tk = v[k] > best;
        best = tk ? v[k] : best;
        bj = tk ? (grp + 4 * k) : bj;
      }
#pragma unroll
      for (int off = 16; off <= 32; off <<= 1) {
        const float ob = __shfl_xor(best, off);
        const int oj = __shfl_xor(bj, off);
        const bool tk = (ob > best) || (ob == best && oj < bj);
        best = tk ? ob : best;
        bj = tk ? oj : bj;
      }
      if (bj < 64) sel_lo |= 1ull << bj; else if (bj < 128) sel_hi |= 1ull << (bj - 64);
#pragma unroll
      for (int k = 0; k < 32; ++k) v[k] = (bj == grp + 4 * k) ? NEG_INF : v[k];
    }
    sel_lo |= 1ull;
    if (cur < 64) sel_lo |= 1ull << cur; else sel_hi |= 1ull << (cur - 64);
    if (cur - 1 < 64) sel_lo |= 1ull << (cur - 1); else sel_hi |= 1ull << (cur - 1 - 64);
  }
  }
  asm volatile("" : "+v"(sel_lo), "+v"(sel_hi));
  atomicOr(&misc[4], (unsigned)sel_lo); atomicOr(&misc[5], (unsigned)(sel_lo >> 32));
  atomicOr(&misc[6], (unsigned)sel_hi); atomicOr(&misc[7], (unsigned)(sel_hi >> 32));
  __syncthreads();
  unsigned long long ulo, uhi;
  {
    const unsigned u0 = __builtin_amdgcn_readfirstlane(misc[4]), u1 = __builtin_amdgcn_readfirstlane(misc[5]);
    const unsigned u2 = __builtin_amdgcn_readfirstlane(misc[6]), u3 = __builtin_amdgcn_readfirstlane(misc[7]);
    ulo = ((unsigned long long)u1 << 32) | u0; uhi = ((unsigned long long)u3 << 32) | u2;
  }
  {
    NSA_SECTION_VARS
    const int tid = (wave << 6) | lane;
    const int hq = r >> 2, qq = r & 3;
    const bf16_t* ks = WSP(bf16_t, OFF_KS) + ((size_t)b * T) * 128 + g * 64;
    const bf16_t* vst = WSP(bf16_t, OFF_VST) + (size_t)((b * 2 + g) * 64) * T;
    bf16x8 qr[4][2];
    unsigned long long mlo[4], mhi[4];
#pragma unroll
    for (int ct = 0; ct < 4; ++ct) {
      const size_t rowq = (size_t)b * T + t0 + 4 * ct + qq;
#pragma unroll
      for (int dk = 0; dk < 2; ++dk)
        qr[ct][dk] = *(const bf16x8*)(WSP(bf16_t, OFF_QN) + rowq * 512 + (g * 4 + hq) * 64 + dk * 32 + grp * 8);
      const int srcl = (lane & 48) | (4 * ct + qq);
      mlo[ct] = __shfl(sel_lo, srcl);
      mhi[ct] = __shfl(sel_hi, srcl);
      m[ct] = NEG_INF; lacc[ct] = (f32x4){0.f, 0.f, 0.f, 0.f};
    }
#pragma unroll
    for (int dt = 0; dt < 4; ++dt)
#pragma unroll
      for (int ct = 0; ct < 4; ++ct) o[dt][ct] = (f32x4){0.f, 0.f, 0.f, 0.f};
    const short one_ = (short)0x3F80;
    const bf16x8 ones = {one_, one_, one_, one_, one_, one_, one_, one_};
    TileRegs tr, trb;
    int jA = next_bit(ulo, uhi, 0), it = 0;
    int jB = next_bit(ulo, uhi, jA + 1);
    tile_gload(tr, ks, 128, vst, T, 64 * jA, tid);
    if (jB < 128) tile_gload(trb, ks, 128, vst, T, 64 * jB, tid);
    tile_swrite(tr, tiles, tid);
    if (jB < 128) tile_swrite(trb, tiles + TILE_STAGE, tid);
    __syncthreads();
#pragma unroll 1
    while (jA < 128) {
      const int nA = (jB < 128) ? next_bit(ulo, uhi, jB + 1) : 128;
      const int nB = (nA < 128) ? next_bit(ulo, uhi, nA + 1) : 128;
      if (nA < 128) tile_gload(tr, ks, 128, vst, T, 64 * nA, tid);
      if (nB < 128) tile_gload(trb, ks, 128, vst, T, 64 * nB, tid);
#pragma unroll
      for (int sub = 0; sub < 2; ++sub) {
      const int j = sub ? jB : jA;
      if (j >= 128) break;
      const lds_u8* stage = tiles + (2 * (it & 1) + sub) * TILE_STAGE;
      bool mine[4], need[4], anyneed = false;
#pragma unroll
      for (int ct = 0; ct < 4; ++ct) {
        mine[ct] = ((j < 64 ? (mlo[ct] >> j) : (mhi[ct] >> (j - 64))) & 1ull) != 0ull;
        need[ct] = __any(mine[ct]) != 0;
        anyneed = anyneed || need[ct];
      }
      if (anyneed) {
#pragma unroll
        for (int hf = 0; hf < 2; ++hf) {
          const int key0 = j * 64 + hf * 32;
          bf16x8 kf[2][2];
#pragma unroll
          for (int kt = 0; kt < 2; ++kt) {
            const lds_u8* kp = stage + (32 * hf + 8 * (r >> 2) + 4 * kt + (r & 3)) * TILE_ROWB + grp * 16;
#pragma unroll
            for (int dk = 0; dk < 2; ++dk) kf[kt][dk] = *(const __attribute__((address_space(3))) bf16x8*)(kp + dk * 64);
          }
          bf16x8 vfr[4];
          v_frags_lds<4>(stage, hf, vfr, lane);
#pragma unroll
          for (int ct = 0; ct < 4; ++ct) {
            if (need[ct]) {
              const float mv = mine[ct] ? 0.f : NEG_INF;
              f32x4 s0 = {mv, mv, mv, mv}, s1 = {mv, mv, mv, mv};
              s0 = mfma16(kf[0][0], qr[ct][0], s0);
              s1 = mfma16(kf[1][0], qr[ct][0], s1);
              s0 = mfma16(kf[0][1], qr[ct][1], s0);
              s1 = mfma16(kf[1][1], qr[ct][1], s1);
              if (j == cur) {
                const int tct = t0 + 4 * ct + qq;
#pragma unroll
                for (int i = 0; i < 4; ++i) {
                  s0[i] = (key0 + 8 * grp + i <= tct) ? s0[i] : NEG_INF;
                  s1[i] = (key0 + 8 * grp + 4 + i <= tct) ? s1[i] : NEG_INF;
                }
              }
              float mx = fmaxf(fmaxf(fmaxf(s0[0], s0[1]), fmaxf(s0[2], s0[3])), fmaxf(fmaxf(s1[0], s1[1]), fmaxf(s1[2], s1[3])));
              mx = grp_max4(mx);
              const float mnew = fmaxf(m[ct], mx);
              if (__any(mnew > m[ct])) {
                const float ms = (mnew == NEG_INF) ? 0.f : mnew;
                const float alpha = __builtin_amdgcn_exp2f(m[ct] - ms);
                m[ct] = mnew;
                lacc[ct] = lacc[ct] * alpha;
#pragma unroll
                for (int dt = 0; dt < 4; ++dt) o[dt][ct] = o[dt][ct] * alpha;
              }
              const float msafe = (m[ct] == NEG_INF) ? 0.f : m[ct];
              const f32x4 d0 = s0 - msafe, d1 = s1 - msafe;
              f32x4 p0, p1;
#pragma unroll
              for (int i = 0; i < 4; ++i) { p0[i] = __builtin_amdgcn_exp2f(d0[i]); p1[i] = __builtin_amdgcn_exp2f(d1[i]); }
              const bf16x8 pb = pack8(p0, p1);
              lacc[ct] = mfma16(ones, pb, lacc[ct]);
#pragma unroll
              for (int dt = 0; dt < 4; ++dt) o[dt][ct] = mfma16(vfr[dt], pb, o[dt][ct]);
            }
          }
        }
      }
      }
      if (nA < 128) tile_swrite(tr, tiles + (2 * ((it + 1) & 1)) * TILE_STAGE, tid);
      if (nB < 128) tile_swrite(trb, tiles + (2 * ((it + 1) & 1) + 1) * TILE_STAGE, tid);
      __syncthreads();
      jA = nA; jB = nB; ++it;
    }
    float* scr2 = scr + (size_t)2048 * 4096;
#pragma unroll
    for (int ct = 0; ct < 4; ++ct) {
      const size_t rowq = (size_t)b * T + t0 + 4 * ct + qq;
      const float sc = (lacc[ct][0] > 0.f ? 1.0f / lacc[ct][0] : 0.f) * WSP(float, OFF_GATE)[rowq * 24 + (g * 4 + hq) * 3 + 1];
#pragma unroll
      for (int dt = 0; dt < 4; ++dt)
        *(f32x4*)(scr2 + (hq * 16 + 4 * ct + qq) * 64 + 16 * dt + 4 * grp) = o[dt][ct] * sc;
    }
    asm volatile("s_waitcnt vmcnt(0)" ::: "memory");
    __builtin_amdgcn_fence(__ATOMIC_SEQ_CST, "workgroup");
  }
  {
    NSA_SECTION_VARS
    const int tid = (wave << 6) | lane;
    const bf16_t* kw = WSP(bf16_t, OFF_KW) + ((size_t)b * T) * 128 + g * 64;
    const bf16_t* vwt = WSP(bf16_t, OFF_VWT) + (size_t)((b * 2 + g) * 64) * T;
#pragma unroll
    for (int ct = 0; ct < 4; ++ct) { m[ct] = NEG_INF; lsum[ct] = 0.f; lacc[ct] = (f32x4){0.f, 0.f, 0.f, 0.f}; }
#pragma unroll
    for (int dt = 0; dt < 4; ++dt)
#pragma unroll
      for (int ct = 0; ct < 4; ++ct) o[dt][ct] = (f32x4){0.f, 0.f, 0.f, 0.f};
    int kstart = qi * 128 - 512;
    if (kstart < 0) kstart = 0;
    const int kend = qi * 128 + 64;
    bf16x8 qr[4][2];
#pragma unroll
    for (int ct = 0; ct < 4; ++ct)
#pragma unroll
      for (int dk = 0; dk < 2; ++dk)
        qr[ct][dk] = *(const bf16x8*)(WSP(bf16_t, OFF_QN) + row * 512 + (g * 4 + ct) * 64 + dk * 32 + grp * 8);
    TileRegs trw[2];
    int it = 0;
#pragma unroll
    for (int q = 0; q < 2; ++q) if (kstart + 64 * q <= kend) tile_gload(trw[q], kw, 128, vwt, T, kstart + 64 * q, tid);
#pragma unroll
    for (int q = 0; q < 2; ++q) if (kstart + 64 * q <= kend) tile_swrite(trw[q], tiles + q * TILE_STAGE, tid);
    __syncthreads();
#pragma unroll 1
    for (int kp0 = kstart; kp0 <= kend; kp0 += 128, ++it) {
#pragma unroll
      for (int q = 0; q < 2; ++q) if (kp0 + 128 + 64 * q <= kend) tile_gload(trw[q], kw, 128, vwt, T, kp0 + 128 + 64 * q, tid);
#pragma unroll
      for (int sub = 0; sub < 2; ++sub) {
      const int k0 = kp0 + 64 * sub;
      if (k0 > kend) break;
      const lds_u8* stage = tiles + (2 * (it & 1) + sub) * TILE_STAGE;
      if (k0 <= t0 + 15 && k0 + 63 + 512 > t0) {
#pragma unroll
        for (int hf = 0; hf < 2; ++hf) {
          const int key0 = k0 + hf * 32;
          f32x4 s[2][4];
          const f32x4 cz = {0.f, 0.f, 0.f, 0.f};
          qk_scores_lds<4, 2, false>(stage, hf, qr, s, lane, nullptr, cz, cz);
          if (!(k0 + 63 <= t0 && k0 + 512 > t0 + 15)) {
#pragma unroll
            for (int kt = 0; kt < 2; ++kt)
#pragma unroll
              for (int i = 0; i < 4; ++i) {
                const int key = key0 + 8 * grp + 4 * kt + i;
                const bool ok = (key <= t) && (key + 512 > t);
#pragma unroll
                for (int ct = 0; ct < 4; ++ct) s[kt][ct][i] = ok ? s[kt][ct][i] : NEG_INF;
              }
          }
          bf16x8 vfr[4];
          v_frags_lds<4>(stage, hf, vfr, lane);
          softmax_update<4, 4, true, false>(s, m, lsum, o, &lacc);
          pv_accum_lds<4, 4>(vfr, s, o, lane, lacc);
        }
      }
      }
#pragma unroll
      for (int q = 0; q < 2; ++q) if (kp0 + 128 + 64 * q <= kend) tile_swrite(trw[q], tiles + (2 * ((it + 1) & 1) + q) * TILE_STAGE, tid);
      __syncthreads();
    }
    float sc2[4];
#pragma unroll
    for (int ct = 0; ct < 4; ++ct) sc2[ct] = (lacc[ct][0] > 0.f ? 1.0f / lacc[ct][0] : 0.f) * gatep[ct * 3 + 2];
    bf16_t* oa = WSP(bf16_t, OFF_OA) + row * 512 + g * 256;
#pragma unroll
    for (int dt = 0; dt < 4; ++dt)
#pragma unroll
      for (int ct = 0; ct < 4; ++ct) {
        bf16_t* ptr = oa + ct * 64 + 16 * dt + 4 * grp;
        const u32x2 sw = *(const u32x2*)ptr;
        float val[4];
        const f32x4 sv = *(const f32x4*)(scr + (size_t)2048 * 4096 + (ct * 16 + r) * 64 + 16 * dt + 4 * grp);
#pragma unroll
        for (int i = 0; i < 4; ++i) val[i] = scr[((dt * 4 + ct) * 4 + i) * 64 + lane] + sv[i] + o[dt][ct][i] * sc2[ct];
        u32x2 w = {cvtpk(val[0] * bflo(sw[0]), val[1] * bfhi(sw[0])), cvtpk(val[2] * bflo(sw[1]), val[3] * bfhi(sw[1]))};
        if (st) *(u32x2*)ptr = w;
        asm volatile("" ::: "memory");
      }
  }
#undef NSA_SECTION_VARS
}

__device__ __forceinline__ void fox_wg_unit(const Params& p, int l, int b, int h, int qb, lds_u8* tiles, bool st) {
  kparams_t kp_ = kparams(); (void)kp_;
  const int tid = tidx();
  const int wave = __builtin_amdgcn_readfirstlane(tid >> 6);
  const int lane = tid & 63, r = lane & 15, grp = lane >> 4;
  const int t0 = qb * 512 + wave * 64;
  bf16x8 qf[4][2];
  const float* fc = WSP(float, OFF_FC) + (size_t)(b * 8 + h) * T;
#pragma unroll
  for (int ct = 0; ct < 4; ++ct) {
    const size_t row = (size_t)b * T + t0 + 16 * ct + r;
#pragma unroll
    for (int dk = 0; dk < 2; ++dk)
      qf[ct][dk] = *(const bf16x8*)(WSP(bf16_t, OFF_FQ) + row * 512 + h * 64 + dk * 32 + grp * 8);
  }
  const bf16_t* kb = WSP(bf16_t, OFF_FK) + ((size_t)b * T) * 512 + h * 64;
  const bf16_t* vt = WSP(bf16_t, OFF_FVT) + (size_t)((b * 8 + h) * 64) * T;
  f32x4 o[4][4];
  float m[4], lsum[4];
  f32x4 lacc[4];
#pragma unroll
  for (int ct = 0; ct < 4; ++ct) { m[ct] = NEG_INF; lsum[ct] = 0.f; lacc[ct] = (f32x4){0.f, 0.f, 0.f, 0.f}; }
#pragma unroll
  for (int dt = 0; dt < 4; ++dt)
#pragma unroll
    for (int ct = 0; ct < 4; ++ct) o[dt][ct] = (f32x4){0.f, 0.f, 0.f, 0.f};
  const int ntiles = (qb + 1) * 8;
  int it0, itw0;
  {
    float gq = fabsf(kp_->fox_q_norm[l * 64 + lane]), gk = fabsf(kp_->fox_k_norm[l * 64 + lane]);
#pragma unroll
    for (int o_ = 1; o_ < 64; o_ <<= 1) { gq = fmaxf(gq, __shfl_xor(gq, o_)); gk = fmaxf(gk, __shfl_xor(gk, o_)); }
    const float B2 = 16.0f * gq * gk * 1.02f + 104.0f;
    const float thr_wg = fc[qb * 512] + B2, thr_w = fc[t0] + B2;
    const float c0 = (lane < ntiles) ? fc[64 * lane + 63] : -3.0e38f;
    const float c1 = (lane + 64 < ntiles) ? fc[64 * (lane + 64) + 63] : -3.0e38f;
    it0 = __popcll(__ballot(c0 > thr_wg)) + __popcll(__ballot(c1 > thr_wg));
    itw0 = __popcll(__ballot(c0 > thr_w)) + __popcll(__ballot(c1 > thr_w));
    it0 = __builtin_amdgcn_readfirstlane(it0);
    itw0 = __builtin_amdgcn_readfirstlane(itw0);
  }
  TileRegs tr;
  float ckr = 0.f;
  tile_gload(tr, kb, 512, vt, T, it0 * 64, tid);
  if (tid < 64) ckr = fc[it0 * 64 + tid] * (-LOG2E);
  tile_swrite(tr, tiles, tid);
  if (tid < 64) *(__attribute__((address_space(3))) float*)(tiles + 2 * TILE_HALF + tid * 4) = ckr;
  __syncthreads();
#pragma unroll 1
  for (int it = it0; it < ntiles; ++it) {
    const int k0 = it * 64;
    if (it + 1 < ntiles) { tile_gload(tr, kb, 512, vt, T, k0 + 64, tid); if (tid < 64) ckr = fc[k0 + 64 + tid] * (-LOG2E); }
    const lds_u8* stage = tiles + ((it - it0) & 1) * TILE_STAGE;
    if (k0 <= t0 + 63 && it >= itw0) {
      const bool diag = (k0 + 63 > t0);
#pragma unroll
      for (int hf = 0; hf < 2; ++hf) {
        const int key0 = k0 + hf * 32;
        f32x4 s[2][4];
        const f32x4 ck0 = *(const __attribute__((address_space(3))) f32x4*)(stage + 2 * TILE_HALF + (32 * hf + 8 * grp) * 4);
        const f32x4 ck1 = *(const __attribute__((address_space(3))) f32x4*)(stage + 2 * TILE_HALF + (32 * hf + 8 * grp + 4) * 4);
        qk_scores_lds<4, 2, false>(stage, hf, qf, s, lane, nullptr, ck0, ck1);
        if (diag) {
#pragma unroll
          for (int kt = 0; kt < 2; ++kt)
#pragma unroll
            for (int i = 0; i < 4; ++i) {
              const int key = key0 + 8 * grp + 4 * kt + i;
#pragma unroll
              for (int ct = 0; ct < 4; ++ct) s[kt][ct][i] = (key <= t0 + 16 * ct + r) ? s[kt][ct][i] : NEG_INF;
            }
        }
        bf16x8 vfr[4];
        v_frags_lds<4>(stage, hf, vfr, lane);
        softmax_update<4, 4, true, false>(s, m, lsum, o, &lacc);
        pv_accum_lds<4, 4>(vfr, s, o, lane, lacc);
      }
    }
    if (it + 1 < ntiles) {
      tile_swrite(tr, tiles + ((it - it0 + 1) & 1) * TILE_STAGE, tid);
      if (tid < 64) *(__attribute__((address_space(3))) float*)(tiles + ((it - it0 + 1) & 1) * TILE_STAGE + 2 * TILE_HALF + tid * 4) = ckr;
    }
    __syncthreads();
  }
  float invl[4];
#pragma unroll
  for (int ct = 0; ct < 4; ++ct) invl[ct] = lacc[ct][0] > 0.f ? 1.0f / lacc[ct][0] : 0.f;
#pragma unroll
  for (int ct = 0; ct < 4; ++ct) {
    bf16_t* ob = WSP(bf16_t, OFF_OB) + ((size_t)b * T + t0 + 16 * ct + r) * 512 + h * 64;
#pragma unroll
    for (int dt = 0; dt < 4; ++dt) {
      bf16_t* ptr = ob + 16 * dt + 4 * grp;
      const u32x2 sw = *(const u32x2*)ptr;
      const f32x4 v = o[dt][ct] * invl[ct];
      u32x2 w = {cvtpk(v[0] * bflo(sw[0]), v[1] * bfhi(sw[0])), cvtpk(v[2] * bflo(sw[1]), v[3] * bfhi(sw[1]))};
      if (st) *(u32x2*)ptr = w;
    }
  }
}

constexpr int MT_KPITCH = 272, MT_VOFF = 64 * MT_KPITCH, MT_STAGE = MT_VOFF + 128 * TILE_ROWB;
struct MemTileRegs { u32x4 k0, k1, v0, v1; };
__device__ __forceinline__ void mem_tile_gload(MemTileRegs& tr, const bf16_t* __restrict__ kb, const bf16_t* __restrict__ vt, int key0, int tid) {
  const int row = tid >> 3, ch = tid & 7;
  tr.k0 = *(const u32x4*)(kb + (size_t)(key0 + row) * 512 + ch * 8);
  tr.k1 = *(const u32x4*)(kb + (size_t)(key0 + row) * 512 + 64 + ch * 8);
  tr.v0 = *(const u32x4*)(vt + (size_t)row * 256 + key0 + ch * 8);
  tr.v1 = *(const u32x4*)(vt + (size_t)(row + 64) * 256 + key0 + ch * 8);
}
__device__ __forceinline__ void mem_tile_swrite(const MemTileRegs& tr, lds_u8* stage, int tid) {
  const int row = tid >> 3, ch = tid & 7;
  *(__attribute__((address_space(3))) u32x4*)(stage + row * MT_KPITCH + ch * 16) = tr.k0;
  *(__attribute__((address_space(3))) u32x4*)(stage + row * MT_KPITCH + 128 + ch * 16) = tr.k1;
  *(__attribute__((address_space(3))) u32x4*)(stage + MT_VOFF + row * TILE_ROWB + ch * 16) = tr.v0;
  *(__attribute__((address_space(3))) u32x4*)(stage + MT_VOFF + (row + 64) * TILE_ROWB + ch * 16) = tr.v1;
}
__device__ __forceinline__ void mem_wg_unit(const Params& p, int l, int b, int h, int qblk, lds_u8* tiles, bool st) {
  kparams_t kp_ = kparams(); (void)kp_;
  const int tid = tidx();
  const int wave = __builtin_amdgcn_readfirstlane(tid >> 6);
  const int lane = tid & 63, r = lane & 15, grp = lane >> 4;
  const int t0 = 256 * qblk + 32 * wave;
  const float SC = 0.08838834764831845f * LOG2E;
  const bf16_t* kb = WSP(bf16_t, OFF_MK) + ((size_t)b * 256) * 512 + h * 128;
  const bf16_t* vt = WSP(bf16_t, OFF_MVT) + (size_t)((b * 4 + h) * 128) * 256;
  MemTileRegs tr;
  mem_tile_gload(tr, kb, vt, 0, tid);
  bf16x8 qf[2][4];
  const float* gq = kp_->mem_q_norm + l * 128;
#pragma unroll
  for (int ct = 0; ct < 2; ++ct) {
    const size_t row = (size_t)b * T + t0 + 16 * ct + r;
    float v[4][8];
    float ss = 0.f;
#pragma unroll
    for (int dk = 0; dk < 4; ++dk) {
      const u32x4 w = *(const u32x4*)(WSP(bf16_t, OFF_MQ) + row * 512 + h * 128 + dk * 32 + grp * 8);
#pragma unroll
      for (int j = 0; j < 4; ++j) { v[dk][2 * j] = bflo(w[j]); v[dk][2 * j + 1] = bfhi(w[j]); }
#pragma unroll
      for (int j = 0; j < 8; ++j) ss += v[dk][j] * v[dk][j];
    }
    ss += __shfl_xor(ss, 16);
    ss += __shfl_xor(ss, 32);
    const float rstd = rsqrtf(ss * (1.0f / 128.0f) + EPS) * SC;
#pragma unroll
    for (int dk = 0; dk < 4; ++dk) {
      const f32x4 g0 = *(const f32x4*)(gq + dk * 32 + grp * 8), g1 = *(const f32x4*)(gq + dk * 32 + grp * 8 + 4);
      u32x4 w = {cvtpk(v[dk][0] * rstd * g0[0], v[dk][1] * rstd * g0[1]), cvtpk(v[dk][2] * rstd * g0[2], v[dk][3] * rstd * g0[3]),
                 cvtpk(v[dk][4] * rstd * g1[0], v[dk][5] * rstd * g1[1]), cvtpk(v[dk][6] * rstd * g1[2], v[dk][7] * rstd * g1[3])};
      qf[ct][dk] = __builtin_bit_cast(bf16x8, w);
    }
  }
  f32x4 o[8][2];
  f32x4 lacc[2];
  float m[2], lsum[2];
#pragma unroll
  for (int ct = 0; ct < 2; ++ct) { m[ct] = NEG_INF; lsum[ct] = 0.f; lacc[ct] = (f32x4){0.f, 0.f, 0.f, 0.f}; }
#pragma unroll
  for (int dt = 0; dt < 8; ++dt)
#pragma unroll
    for (int ct = 0; ct < 2; ++ct) o[dt][ct] = (f32x4){0.f, 0.f, 0.f, 0.f};
  mem_tile_swrite(tr, tiles, tid);
  __syncthreads();
#pragma unroll 1
  for (int it = 0; it < 4; ++it) {
    if (it + 1 < 4) mem_tile_gload(tr, kb, vt, 64 * (it + 1), tid);
    const lds_u8* stage = tiles + (it & 1) * MT_STAGE;
#pragma unroll
    for (int hf = 0; hf < 2; ++hf) {
      f32x4 s[2][2];
#pragma unroll
      for (int kt = 0; kt < 2; ++kt) {
        const lds_u8* kp = stage + (32 * hf + 8 * (r >> 2) + 4 * kt + (r & 3)) * MT_KPITCH + grp * 16;
        bf16x8 kf[4];
#pragma unroll
        for (int dk = 0; dk < 4; ++dk) kf[dk] = *(const __attribute__((address_space(3))) bf16x8*)(kp + dk * 64);
#pragma unroll
        for (int ct = 0; ct < 2; ++ct) {
          f32x4 a = {0.f, 0.f, 0.f, 0.f};
#pragma unroll
          for (int dk = 0; dk < 4; ++dk) a = mfma16(kf[dk], qf[ct][dk], a);
          s[kt][ct] = a;
        }
      }
      bf16x8 vfr[8];
      v_frags_lds<8>(stage + (MT_VOFF - TILE_HALF), hf, vfr, lane);
      softmax_update<2, 8, true, false>(s, m, lsum, o, &lacc);
      pv_accum_lds<2, 8>(vfr, s, o, lane, lacc);
    }
    if (it + 1 < 4) mem_tile_swrite(tr, tiles + ((it + 1) & 1) * MT_STAGE, tid);
    __syncthreads();
  }
#pragma unroll
  for (int ct = 0; ct < 2; ++ct) {
    const float invl = lacc[ct][0] > 0.f ? 1.0f / lacc[ct][0] : 0.f;
    bf16_t* om = WSP(bf16_t, OFF_OM) + ((size_t)b * T + t0 + 16 * ct + r) * 512 + h * 128;
#pragma unroll
    for (int dt = 0; dt < 8; ++dt) {
      bf16_t* ptr = om + 16 * dt + 4 * grp;
      const u32x2 sw = *(const u32x2*)ptr;
      const f32x4 v = o[dt][ct] * invl;
      u32x2 w = {cvtpk(v[0] * bflo(sw[0]), v[1] * bfhi(sw[0])), cvtpk(v[2] * bflo(sw[1]), v[3] * bfhi(sw[1]))};
      if (st) *(u32x2*)ptr = w;
    }
  }
}

__device__ __forceinline__ void phase_attn(const Params& p, int l, unsigned char* ldsraw, bool st, int cidx) {
  kparams_t kp_ = kparams(); (void)kp_;
  const int tid = tidx();
  const int wave = __builtin_amdgcn_readfirstlane(tid >> 6);
  float* imp = (float*)ldsraw + wave * 2112;
  lds_u8* tiles = (lds_u8*)ldsraw;
  bf16x8* qlds = (bf16x8*)(ldsraw + 69632 + wave * 8192);
  unsigned* misc = (unsigned*)(ldsraw + 135168);
  float* scr = WSP(float, OFF_SCR) + (size_t)(bidx() * NWAVES + wave) * 4096;
  const int myx = (int)(xb_xcc_id() & 7u);
  constexpr int QUNITS = 192;
  for (int qq = 0; qq < 8; ++qq) {
    const int x = (myx + qq) & 7;
    unsigned* ctr = WSP(unsigned, OFF_CTL) + cidx * 8 + x;
    for (;;) {
      __syncthreads();
      if (tid == 0) misc[0] = atomicAdd(ctr, 1u);
      if (tid >= 4 && tid < 8) misc[tid] = 0u;
      __syncthreads();
      const int u = __builtin_amdgcn_readfirstlane((int)misc[0]);
      if (u >= QUNITS) break;
      if (u < 64) {
        nsa_wg_unit(p, x >> 1, x & 1, 63 - u, imp, qlds, scr, tiles, misc, st);
      } else if (u < 128) {
        const int v_ = u - 64, bh = 4 * x + (v_ >> 4);
        fox_wg_unit(p, l, bh >> 3, bh & 7, 15 - (v_ & 15), tiles, st);
      } else {
        const int mu = u - 128, bh = 2 * x + (mu >> 5), qblk = mu & 31;
        mem_wg_unit(p, l, bh >> 2, bh & 3, qblk, tiles, st);
      }
    }
  }
}

__global__ void __launch_bounds__(NTHREADS) hybrid_megakernel(Params p) {
  kparams_t kp_ = kparams();
  cg::grid_group grid = cg::this_grid();
  extern __shared__ __attribute__((aligned(16))) unsigned char dynlds[];
  float* smem = (float*)dynlds;
  PG8_LAS unsigned char* glds = (PG8_LAS unsigned char*)dynlds;
  volatile LAS unsigned* bst = (volatile LAS unsigned*)(glds + 135168 + 64);
  if (threadIdx.x < 2) bst[threadIdx.x] = 0u;
  __syncthreads();
  grid.sync();
  const XcdBarrier xbar = xcd_barrier_post(WSP(unsigned, OFF_BAR), bst);
#pragma unroll 1
  for (int ph = 0; ph < 28; ++ph) {
    const int l = ph / 7, k = ph - 7 * l;
    if (k == 0) {
      phase_prep(p, l, smem);
    } else if (k == 1) {
      if (bidx() == gdim() - 1 && tidx() < 256) {
        const int t_ = tidx();
        const float* part = WSP(float, OFF_C1) + (size_t)(t_ >> 7) * 16 * 128 + (t_ & 127);
        float pv_[16];
#pragma unroll
        for (int ch = 0; ch < 16; ++ch) pv_[ch] = part[ch * 128];
        float s_ = 0.f;
#pragma unroll
        for (int ch = 0; ch < 16; ++ch) s_ += pv_[ch];
        WSP(float, OFF_C1 + 16384)[t_] = s_;
      }
      EpiIn E{&p, l};
      run_gemm(glds, WSP(bf16_t, OFF_H), WSP(bf16_t, OFF_W_IN), M, 5120, 1024, E);
      EpiMemKV E2{&p};
      run_gemm(glds, WSP(bf16_t, OFF_MEMN), WSP(bf16_t, OFF_W_MKV), 1024, 1024, 1024, E2);
    } else if (k == 2) {
      phase_mid(p, l, smem);
    } else if (k == 3) {
      phase_attn(p, l, dynlds, true, l);
    } else if (k == 4) {
      EpiGate E{WSP(bf16_t, OFF_G)};
      run_gemm(glds, WSP(bf16_t, OFF_H), WSP(bf16_t, OFF_W_G), M, 3072, 1024, E);
    } else if (k == 5) {
      EpiBranch Ea{WSP(bf16_t, OFF_G), WSP(bf16_t, OFF_U), 1};
      run_gemm(glds, WSP(bf16_t, OFF_OA), WSP(bf16_t, OFF_W_BR), M, 1024, 512, Ea);
      EpiBranch Eb{WSP(bf16_t, OFF_G) + (size_t)M * 1024, WSP(bf16_t, OFF_U), 0};
      run_gemm(glds, WSP(bf16_t, OFF_OB), WSP(bf16_t, OFF_W_BR + MiB), M, 1024, 512, Eb);
      EpiBranch Ec{WSP(bf16_t, OFF_G) + (size_t)2 * M * 1024, WSP(bf16_t, OFF_U), 0};
      run_gemm(glds, WSP(bf16_t, OFF_OM), WSP(bf16_t, OFF_W_BR + 2 * MiB), M, 1024, 512, Ec);
    } else {
      EpiOut E{l == 0 ? kp_->x : kp_->out, kp_->out};
      run_gemm(glds, WSP(bf16_t, OFF_U), WSP(bf16_t, OFF_W_OUT), M, 1024, 1024, E);
    }
    xcd_barrier(xbar);
  }
}

extern "C" void kernel_launch(void* const* d_in, const int* in_sizes, int n_in, void* d_out, int out_size, void* d_ws,
                              size_t ws_size, hipStream_t stream) {
  static int grid_blocks = 0;
  if (!grid_blocks) {
    int dev = 0, cus = 0, per_cu = 0;
    (void)hipGetDevice(&dev);
    (void)hipDeviceGetAttribute(&cus, hipDeviceAttributeMultiprocessorCount, dev);
    if (hipFuncSetAttribute((const void*)hybrid_megakernel, hipFuncAttributeMaxDynamicSharedMemorySize, LDS_BYTES) != hipSuccess)
      fprintf(stderr, "hipFuncSetAttribute(dynamic LDS %d) failed\n", LDS_BYTES);
    (void)hipOccupancyMaxActiveBlocksPerMultiprocessor(&per_cu, hybrid_megakernel, NTHREADS, LDS_BYTES);
    (void)hipGetLastError();
    grid_blocks = cus;
    if (grid_blocks > 256) grid_blocks = 256;
    if (ws_size < OFF_SCR + (size_t)64 * MiB) fprintf(stderr, "workspace too small: %zu\n", ws_size);
  }
  Params p{};
  const float** pp = (const float**)&p;
  for (int i = 0; i < 23; ++i) pp[i] = (const float*)d_in[i];
  p.out = (float*)d_out;
  p.ws = (char*)d_ws;
  void* args[] = {&p};
  (void)hipMemsetAsync((char*)d_ws + OFF_BAR, 0, XCD_BAR_WORDS * sizeof(unsigned), stream);
  hipError_t e = hipLaunchCooperativeKernel((void*)hybrid_megakernel, dim3(grid_blocks), dim3(NTHREADS), args, LDS_BYTES, stream);
  if (e != hipSuccess) fprintf(stderr, "cooperative launch failed: %s (grid %d)\n", hipGetErrorString(e), grid_blocks);
}
```
